# Optimizing an MI355X kernel written in HIP

```python
import jax, jax.numpy as jnp
from jax import lax
import numpy as np

D_MODEL = 1024
BATCH = 32
SEQ = 256
DEPTH = 2
DEC_BATCH = 4
DEC_SEQ = 1024
PAST_LEN = 512

GRID_W = 64
EPS = 1e-6
H_RET = 4
DK_RET = 64
DV_RET = 128
RET_W = H_RET * DV_RET
RET_CHUNK = 64
H_MLA = 8
Q_LORA = 384
KV_LORA = 256
D_NOPE = 64
D_ROPE = 32
D_VMLA = 64
MLA_W = H_MLA * D_VMLA
ROPE_BASE = 10000.0
Q_BLOCK = 128
F_GROUPS = 4
F_GROUP_W = 128
FOURIER_W = F_GROUPS * F_GROUP_W
N_BRANCH = 3
BRANCH_W = 512
SPLITS = [H_RET * DK_RET, H_RET * DK_RET, RET_W, RET_W,
          Q_LORA, KV_LORA, D_ROPE, MLA_W,
          FOURIER_W, FOURIER_W,
          N_BRANCH * D_MODEL]
IN_W = 256 + 256 + 512 + 512 + 384 + 256 + 32 + 512 + 512 + 512 + 3 * D_MODEL

kernel_name = "hybrid_diffusion_retention_mla_fourier_step"


def rms_norm(x, g):
    xf = x.astype(jnp.float32)
    y = xf * lax.rsqrt(jnp.mean(xf * xf, axis=-1, keepdims=True) + EPS)
    return (y * g.astype(jnp.float32)).astype(x.dtype)


def head_norm(o):
    of = o.astype(jnp.float32)
    mu = jnp.mean(of, axis=-1, keepdims=True)
    var = jnp.mean((of - mu) ** 2, axis=-1, keepdims=True)
    return ((of - mu) * lax.rsqrt(var + EPS)).astype(o.dtype)


def axial_rope(x):
    T = x.shape[1]
    rows = T // GRID_W
    row = jnp.repeat(jnp.arange(rows), GRID_W)
    col = jnp.tile(jnp.arange(GRID_W), rows)
    half = D_ROPE // 2
    nfreq = half // 2
    inv = ROPE_BASE ** (-jnp.arange(nfreq, dtype=jnp.float32) / nfreq)

    def rot(xa, pos):
        ang = pos.astype(jnp.float32)[:, None] * inv[None, :]
        cos = jnp.cos(ang)[None, :, None, :]
        sin = jnp.sin(ang)[None, :, None, :]
        x1, x2 = xa[..., :nfreq], xa[..., nfreq:]
        return jnp.concatenate([x1 * cos - x2 * sin, x1 * sin + x2 * cos], axis=-1)

    xf = x.astype(jnp.float32)
    out = jnp.concatenate([rot(xf[..., :half], row), rot(xf[..., half:], col)], axis=-1)
    return out.astype(x.dtype)


def retention_dir(q, k, v, log_gamma, s0):
    B, T, H, dk = q.shape
    dv = v.shape[-1]
    C = RET_CHUNK
    n = T // C
    dt = q.dtype
    lg = log_gamma.astype(jnp.float32)
    i = jnp.arange(C, dtype=jnp.float32)
    diff = i[:, None] - i[None, :]
    dmask = jnp.where(diff[None] >= 0,
                      jnp.exp(jnp.maximum(diff, 0.0)[None] * lg[:, None, None]), 0.0).astype(dt)
    xi = jnp.exp((i[:, None] + 1.0) * lg[None, :]).astype(dt)
    zeta = jnp.exp((C - 1.0 - i)[:, None] * lg[None, :]).astype(dt)
    chunk_decay = jnp.exp(C * lg).astype(dt)
    qc = q.reshape(B, n, C, H, dk)
    kc = k.reshape(B, n, C, H, dk)
    vc = v.reshape(B, n, C, H, dv)
    scores = jnp.einsum('bnihd,bnjhd->bnhij', qc, kc) * dmask[None, None]
    o_intra = jnp.einsum('bnhij,bnjhe->bnihe', scores, vc)
    kv = jnp.einsum('bnjhd,jh,bnjhe->nbhde', kc, zeta, vc)

    def step(s, kv_n):
        return s * chunk_decay[None, :, None, None] + kv_n, s

    s_final, s_before = lax.scan(step, s0.astype(dt), kv)
    o_cross = jnp.einsum('bnihd,nbhde->bnihe', qc, s_before) * xi[None, None, :, :, None]
    return (o_intra + o_cross).reshape(B, T, H, dv), s_final


def mla_attend(q_nope, q_rope, k_nope, k_rope, v):
    B, Tq, H, _ = q_nope.shape
    nb = Tq // Q_BLOCK
    scale = (D_NOPE + D_ROPE) ** -0.5

    def to_blocks(t):
        return t.reshape(B, nb, Q_BLOCK, H, t.shape[-1]).transpose(1, 0, 2, 3, 4)

    def block(qs):
        qn, qr = qs
        s = jnp.einsum('bqhd,bkhd->bhqk', qn, k_nope) + jnp.einsum('bqhd,bkd->bhqk', qr, k_rope)
        p = jax.nn.softmax(s.astype(jnp.float32) * scale, axis=-1).astype(v.dtype)
        return jnp.einsum('bhqk,bkhd->bqhd', p, v)

    o = lax.map(block, (to_blocks(q_nope), to_blocks(q_rope)))
    return o.transpose(1, 0, 2, 3, 4).reshape(B, Tq, H, v.shape[-1])


def fourier_mix(u):
    B, T, _ = u.shape
    ug = u.astype(jnp.float32).reshape(B, T, F_GROUPS, F_GROUP_W)
    f = jnp.fft.fft2(ug, axes=(1, 3)).real * ((T * F_GROUP_W) ** -0.5)
    return f.reshape(B, T, FOURIER_W).astype(u.dtype)


def layer(x, cvec, ctx, norm_g, w_mod, b_mod, w_in, ret_logit, q_norm_g, w_q_up,
          kv_norm_g, w_kv_up, w_branch, w_out):
    B, T, _ = x.shape
    mod = jax.nn.silu(cvec) @ w_mod + b_mod
    shift, scale, gate = jnp.split(mod[:, None, :], 3, axis=-1)
    h = rms_norm(x, norm_g) * (1 + scale) + shift
    split_at = np.cumsum(SPLITS)[:-1].tolist()
    rq, rk, rv, rz, q_lat, kv_lat, k_r, mz, fu, fz, gl = jnp.split(h @ w_in, split_at, axis=-1)

    rq = rq.reshape(B, T, H_RET, DK_RET)
    rk = rk.reshape(B, T, H_RET, DK_RET) * (DK_RET ** -0.5)
    rv = rv.reshape(B, T, H_RET, DV_RET)
    log_g = jax.nn.log_sigmoid(ret_logit.astype(jnp.float32))
    if ctx is None:
        s0f = jnp.zeros((B, H_RET, DK_RET, DV_RET), x.dtype)
        s0b = s0f
    else:
        ctx_ckv, ctx_kr, ctx_ret = ctx
        s0f, s0b = ctx_ret[:, 0], ctx_ret[:, 1]
    o_fw, s_f = retention_dir(rq, rk, rv, log_g[0], s0f)
    o_bw, s_b = retention_dir(rq[:, ::-1], rk[:, ::-1], rv[:, ::-1], log_g[1], s0b)
    o_r = head_norm(o_fw + o_bw[:, ::-1]).reshape(B, T, RET_W)

    q = (rms_norm(q_lat, q_norm_g) @ w_q_up).reshape(B, T, H_MLA, D_NOPE + D_ROPE)
    q_nope, q_rope = q[..., :D_NOPE], q[..., D_NOPE:]
    ckv = rms_norm(kv_lat, kv_norm_g)
    if ctx is None:
        keys_ckv, keys_kr = ckv, k_r
    else:
        q_rope = axial_rope(q_rope)
        keys_ckv = jnp.concatenate([ctx_ckv.astype(ckv.dtype), ckv], axis=1)
        keys_kr = jnp.concatenate([ctx_kr.astype(k_r.dtype),
                                   axial_rope(k_r[:, :, None, :])[:, :, 0]], axis=1)
    kv = (keys_ckv @ w_kv_up).reshape(B, -1, H_MLA, D_NOPE + D_VMLA)
    o_m = mla_attend(q_nope, q_rope, kv[..., :D_NOPE], keys_kr, kv[..., D_NOPE:]).reshape(B, T, MLA_W)

    o_f = fourier_mix(fu)

    branches = jnp.stack([o_r * jax.nn.silu(rz), o_m * jax.nn.silu(mz), o_f * jax.nn.silu(fz)], axis=2)
    proj = jnp.einsum('btnw,nwd->btnd', branches, w_branch)
    merged = jnp.sum(proj * jax.nn.sigmoid(gl.reshape(B, T, N_BRANCH, D_MODEL)), axis=2)
    x = x + gate * (merged @ w_out)
    new = (ckv, k_r, jnp.stack([s_f, s_b], axis=1)) if ctx is None else None
    return x, new


def setup_inputs(seed: int = 0) -> dict:
    key = jax.random.key(seed)
    ks = jax.random.split(key, 20)
    f32 = jnp.float32
    nrm = lambda k, shape, s: jax.random.normal(k, shape, f32) * s
    gam = 1.0 - 2.0 ** (-5.0 - jnp.arange(H_RET, dtype=f32))
    logit = jnp.log(gam) - jnp.log1p(-gam)
    return {
        "x_prompt": nrm(ks[0], (BATCH, SEQ, D_MODEL), 1.0),
        "x_sample": nrm(ks[1], (DEC_BATCH, DEC_SEQ, D_MODEL), 1.0),
        "cache_ckv": nrm(ks[2], (DEC_BATCH, DEPTH, PAST_LEN, KV_LORA), 1.0),
        "cache_krope": nrm(ks[3], (DEC_BATCH, DEPTH, PAST_LEN, D_ROPE), 1.0),
        "state_ret": nrm(ks[4], (DEC_BATCH, DEPTH, 2, H_RET, DK_RET, DV_RET), 0.5),
        "c": nrm(ks[5], (DEC_BATCH, D_MODEL), 1.0),
        "c_ctx": nrm(ks[6], (D_MODEL,), 1.0),
        "norm_g": 1.0 + nrm(ks[7], (DEPTH, D_MODEL), 0.02),
        "w_mod": nrm(ks[8], (DEPTH, D_MODEL, 3 * D_MODEL), 0.3 * D_MODEL ** -0.5),
        "b_mod": nrm(ks[9], (DEPTH, 3 * D_MODEL), 0.01),
        "w_in": nrm(ks[10], (DEPTH, D_MODEL, IN_W), D_MODEL ** -0.5),
        "ret_decay_logit": logit[None, None, :] + nrm(ks[11], (DEPTH, 2, H_RET), 0.05),
        "q_norm_g": 1.0 + nrm(ks[12], (DEPTH, Q_LORA), 0.02),
        "w_q_up": nrm(ks[13], (DEPTH, Q_LORA, H_MLA * (D_NOPE + D_ROPE)), Q_LORA ** -0.5),
        "kv_norm_g": 1.0 + nrm(ks[14], (DEPTH, KV_LORA), 0.02),
        "w_kv_up": nrm(ks[15], (DEPTH, KV_LORA, H_MLA * (D_NOPE + D_VMLA)), KV_LORA ** -0.5),
        "w_branch": nrm(ks[16], (DEPTH, N_BRANCH, BRANCH_W, D_MODEL), BRANCH_W ** -0.5),
        "w_out": nrm(ks[17], (DEPTH, D_MODEL, D_MODEL), D_MODEL ** -0.5),
        "final_norm_g": 1.0 + nrm(ks[18], (D_MODEL,), 0.02),
    }


def reference(x_prompt, x_sample, cache_ckv, cache_krope, state_ret, c, c_ctx, norm_g, w_mod,
              b_mod, w_in, ret_decay_logit, q_norm_g, w_q_up, kv_norm_g, w_kv_up, w_branch,
              w_out, final_norm_g):
    h = x_prompt
    ckvs, krs, rets = [], [], []
    for l in range(DEPTH):
        h, (ckv, kr, st) = layer(h, c_ctx[None, :], None, norm_g[l], w_mod[l], b_mod[l], w_in[l],
                                 ret_decay_logit[l], q_norm_g[l], w_q_up[l], kv_norm_g[l],
                                 w_kv_up[l], w_branch[l], w_out[l])
        ckvs.append(ckv)
        krs.append(kr)
        rets.append(st)
    y_prompt = rms_norm(h, final_norm_g)
    new_ckv = jnp.stack(ckvs, axis=1)
    new_krope = jnp.stack(krs, axis=1)
    new_ret = jnp.stack(rets, axis=1)

    z = x_sample
    for l in range(DEPTH):
        ctx = (cache_ckv[:, l], cache_krope[:, l], state_ret[:, l])
        z, _ = layer(z, c, ctx, norm_g[l], w_mod[l], b_mod[l], w_in[l], ret_decay_logit[l],
                     q_norm_g[l], w_q_up[l], kv_norm_g[l], w_kv_up[l], w_branch[l], w_out[l])
    y_sample = rms_norm(z, final_norm_g)
    return (y_prompt, y_sample, new_ckv, new_krope, new_ret)
```

```cpp
#include <hip/hip_runtime.h>
#include <hip/hip_cooperative_groups.h>
#include <stdint.h>
#include <stdio.h>
namespace cg = cooperative_groups;

#ifndef ONE_LAUNCH
#define ONE_LAUNCH 1
#endif

typedef unsigned short bf16_t;
typedef short bf16x8 __attribute__((ext_vector_type(8)));
typedef float f32x4 __attribute__((ext_vector_type(4)));
typedef unsigned u32x4 __attribute__((ext_vector_type(4)));
typedef unsigned u32x2 __attribute__((ext_vector_type(2)));

constexpr int NTOK = 12288, NPR = 8192, NKEY = 14336;
constexpr float EPSN = 1e-6f;

constexpr size_t O_WIN   = 0;
constexpr size_t O_WQ    = O_WIN   + (size_t)2 * 6912 * 1024 * 2;
constexpr size_t O_WKV   = O_WQ    + (size_t)2 * 768 * 384 * 2;
constexpr size_t O_WBR   = O_WKV   + (size_t)2 * 1024 * 256 * 2;
constexpr size_t O_WO    = O_WBR   + (size_t)6 * 1024 * 512 * 2;
constexpr size_t O_CS    = O_WO    + (size_t)2 * 1024 * 1024 * 2;
constexpr size_t O_D256  = O_CS    + (size_t)256 * 128 * 2;
constexpr size_t O_D1024 = O_D256  + (size_t)256 * 512 * 2;
constexpr size_t O_S0T   = O_D1024 + (size_t)1024 * 2048 * 2;
constexpr size_t O_MOD   = O_S0T   + (size_t)64 * 128 * 64 * 2;
constexpr size_t O_H     = O_MOD   + (size_t)2 * 5 * 3072 * 4;
constexpr size_t O_UT    = O_H     + (size_t)NTOK * 1024 * 2;
constexpr size_t O_RQ    = O_UT    + (size_t)NTOK * 1024 * 2;
constexpr size_t O_RK    = O_RQ    + (size_t)NTOK * 256 * 2;
constexpr size_t O_RKT   = O_RK    + (size_t)NTOK * 256 * 2;
constexpr size_t O_RVT   = O_RKT   + (size_t)NPR * 256 * 2;
constexpr size_t O_KVLAT = O_RVT   + (size_t)NTOK * 512 * 2;
constexpr size_t O_KR    = O_KVLAT + (size_t)NTOK * 256 * 4;
constexpr size_t O_R2END = O_KR    + (size_t)NTOK * 32 * 4;
constexpr size_t O_QB    = O_RQ;
constexpr size_t O_VT    = O_QB    + (size_t)NTOK * 768 * 2;
static_assert(O_VT + (size_t)NKEY * 512 * 2 <= O_R2END, "alias overflow");
constexpr size_t O_RZ    = O_R2END;
constexpr size_t O_MZ    = O_RZ    + (size_t)NTOK * 512 * 2;
constexpr size_t O_FZ    = O_MZ    + (size_t)NTOK * 512 * 2;
constexpr size_t O_FU    = O_FZ    + (size_t)NTOK * 512 * 2;
constexpr size_t O_QLAT  = O_FU    + (size_t)NTOK * 512 * 2;
constexpr size_t O_CKVA  = O_QLAT  + (size_t)NTOK * 384 * 2;
constexpr size_t O_KB    = O_CKVA  + (size_t)NKEY * 256 * 2;
constexpr size_t O_KRA   = O_KB    + (size_t)NKEY * 512 * 2;
constexpr size_t O_END   = O_KRA   + (size_t)NKEY * 32 * 2;
static_assert(O_END <= (size_t)256 * 1024 * 1024, "workspace too large");

constexpr size_t OUT_CKV = (size_t)NTOK * 1024;
constexpr size_t OUT_KR  = OUT_CKV + (size_t)32 * 2 * 256 * 256;
constexpr size_t OUT_RET = OUT_KR + (size_t)32 * 2 * 256 * 32;

struct Params {
  const float *x_prompt, *x_sample, *cache_ckv, *cache_krope, *state_ret, *c, *c_ctx, *norm_g, *w_mod, *b_mod,
      *w_in, *ret_logit, *q_norm_g, *w_q_up, *kv_norm_g, *w_kv_up, *w_branch, *w_out, *final_g;
  float* out;
  char* ws;
};

constexpr int PANEL = 128 * 64;
constexpr int ABYTES = 2 * PANEL;
constexpr int STAGE = 2 * ABYTES;
constexpr int LDS_GEMM = 2 * STAGE;
constexpr int LDS_TOTAL = LDS_GEMM;
static_assert(LDS_TOTAL <= 65536, "static LDS");

typedef float f32x2 __attribute__((ext_vector_type(2)));
typedef __bf16 bf16x2v __attribute__((ext_vector_type(2)));
__device__ __forceinline__ unsigned pk2(float lo, float hi) { const f32x2 v = {lo, hi}; return __builtin_bit_cast(unsigned, __builtin_convertvector(v, bf16x2v)); }
__device__ __forceinline__ bf16_t tobf(float x) { return (bf16_t)(pk2(x, 0.f) & 0xffffu); }
__device__ __forceinline__ float bflo(unsigned u) { return __uint_as_float(u << 16); }
__device__ __forceinline__ float bfhi(unsigned u) { return __uint_as_float(u & 0xffff0000u); }
__device__ __forceinline__ float silu_f(float x) { return x / (1.f + __expf(-x)); }
__device__ __forceinline__ float sigm_f(float x) { return 1.f / (1.f + __expf(-x)); }
__device__ __forceinline__ u32x2 pk4(f32x4 v) { u32x2 r; r.x = pk2(v[0], v[1]); r.y = pk2(v[2], v[3]); return r; }
__device__ __forceinline__ int tidx() { int t = threadIdx.x; asm volatile("" : "+v"(t)); return t; }
__device__ __forceinline__ char* wsp(const char* w) { unsigned long long v = (unsigned long long)w; asm volatile("" : "+s"(v)); return (char*)v; }
__device__ __forceinline__ int swz(int r) { return (0 - ((r >> 2) & 3)) & 3; }
__device__ __forceinline__ float wave_sum(float v) {
#pragma unroll
  for (int o = 1; o < 64; o <<= 1) v += __shfl_xor(v, o);
  return v;
}
__device__ __forceinline__ f32x4 mfma16(bf16x8 a, bf16x8 b, f32x4 c) { return __builtin_amdgcn_mfma_f32_16x16x32_bf16(a, b, c, 0, 0, 0); }
__device__ __forceinline__ bf16x8 as_bf8(u32x4 v) { return __builtin_bit_cast(bf16x8, v); }

__device__ __forceinline__ void zero_acc(f32x4 (&acc)[4][4]) {
#pragma unroll
  for (int i = 0; i < 4; ++i)
#pragma unroll
    for (int j = 0; j < 4; ++j) acc[i][j] = (f32x4){0.f, 0.f, 0.f, 0.f};
}

template <bool SWAP, int NJ = 4>
__device__ __forceinline__ void gemm_core(const bf16_t* __restrict__ A, int lda, const bf16_t* __restrict__ B, int ldb, int K,
                                          f32x4 (&acc)[4][NJ], char* lds) {
  const int tid = tidx(), lane = tid & 63, wid = tid >> 6, wm = wid >> 1, wn = wid & 1;
  const int srow = tid >> 3, sc = tid & 7;
  const int soff = (sc >> 2) * PANEL + srow * 64 + (((sc & 3) ^ swz(srow)) << 4);
  const bf16_t* gA = A + (size_t)srow * lda + sc * 8;
  const bf16_t* gB = B + (size_t)srow * ldb + sc * 8;
  const int fr = lane & 15, fq = lane >> 4;
  const int fa = (wm * 64 + fr) * 64 + ((fq ^ swz(fr)) << 4);
  const int fb = ABYTES + (wn * NJ * 16 + fr) * 64 + ((fq ^ swz(fr)) << 4);
  u32x4 ra[4], rb[NJ];
  const int nk = K >> 6;
#pragma unroll
  for (int i = 0; i < 4; ++i) ra[i] = *(const u32x4*)(gA + (size_t)(32 * i) * lda);
#pragma unroll
  for (int i = 0; i < NJ; ++i) rb[i] = *(const u32x4*)(gB + (size_t)(32 * i) * ldb);
#pragma unroll
  for (int i = 0; i < 4; ++i) *(u32x4*)(lds + soff + i * 2048) = ra[i];
#pragma unroll
  for (int i = 0; i < NJ; ++i) *(u32x4*)(lds + ABYTES + soff + i * 2048) = rb[i];
  __syncthreads();
  for (int kt = 0; kt < nk; ++kt) {
    char* cur = lds + (kt & 1) * STAGE;
    const bool more = (kt + 1) < nk;
    if (more) {
      const int k0 = (kt + 1) << 6;
#pragma unroll
      for (int i = 0; i < 4; ++i) ra[i] = *(const u32x4*)(gA + (size_t)(32 * i) * lda + k0);
#pragma unroll
      for (int i = 0; i < NJ; ++i) rb[i] = *(const u32x4*)(gB + (size_t)(32 * i) * ldb + k0);
    }
#pragma unroll
    for (int ks = 0; ks < 2; ++ks) {
      bf16x8 af[4], bfr[NJ];
#pragma unroll
      for (int i = 0; i < 4; ++i) af[i] = *(const bf16x8*)(cur + ks * PANEL + fa + i * 1024);
#pragma unroll
      for (int j = 0; j < NJ; ++j) bfr[j] = *(const bf16x8*)(cur + ks * PANEL + fb + j * 1024);
#pragma unroll
      for (int i = 0; i < 4; ++i)
#pragma unroll
        for (int j = 0; j < NJ; ++j) acc[i][j] = SWAP ? mfma16(bfr[j], af[i], acc[i][j]) : mfma16(af[i], bfr[j], acc[i][j]);
    }
    if (more) {
      char* nx = lds + ((kt + 1) & 1) * STAGE;
#pragma unroll
      for (int i = 0; i < 4; ++i) *(u32x4*)(nx + soff + i * 2048) = ra[i];
#pragma unroll
      for (int i = 0; i < NJ; ++i) *(u32x4*)(nx + ABYTES + soff + i * 2048) = rb[i];
    }
    __syncthreads();
  }
}

__device__ __forceinline__ void tr_tile(const float* __restrict__ src, int lds_, int k0, int ns0, bf16_t* __restrict__ dst, int ldd, int nd0,
                                        const float* __restrict__ ksc, char* lds) {
  bf16_t* T = (bf16_t*)lds;
  const int tid = tidx();
  __syncthreads();
#pragma unroll
  for (int i = 0; i < 2; ++i) {
    const int kk = (tid >> 3) + 32 * i, nn4 = (tid & 7) * 4;
    const f32x4 v = *(const f32x4*)(src + (size_t)(k0 + kk) * lds_ + ns0 + nn4);
    const float s = ksc ? ksc[k0 + kk] : 1.f;
#pragma unroll
    for (int e = 0; e < 4; ++e) T[(nn4 + e) * 72 + kk] = tobf(v[e] * s);
  }
  __syncthreads();
  const int nn = tid >> 3, kc = (tid & 7) * 8;
  const u32x4 w = *(const u32x4*)(T + nn * 72 + kc);
  *(u32x4*)(dst + (size_t)(nd0 + nn) * ldd + k0 + kc) = w;
}

constexpr int P0_GEMV = 96, P0_WIN = 6816, P0_WQ = 288, P0_WKV = 256, P0_WBR = 1536, P0_WO = 1024, P0_S0 = 256, P0_PAD = 96, P0_TAB = 1104;
constexpr int P0_N = P0_GEMV + P0_WIN + P0_WQ + P0_WKV + P0_WBR + P0_WO + P0_S0 + P0_PAD + P0_TAB;

__device__ __forceinline__ void phase0_item(const Params& p, int j, char* lds) {
  const int tid = tidx();
  char* ws = wsp(p.ws);
  if (j < P0_GEMV) {
    const int l = j / 48, cgi = j % 48;
    float* sv = (float*)lds;
    float* red = (float*)(lds + 20480);
    __syncthreads();
    for (int i = tid; i < 5120; i += 256) { const int v = i >> 10, k = i & 1023; const float x = (v == 0) ? p.c_ctx[k] : p.c[(v - 1) * 1024 + k]; sv[i] = silu_f(x); }
    __syncthreads();
    const int cc = tid & 63, kg = tid >> 6;
    const float* w = p.w_mod + (size_t)l * 1024 * 3072 + cgi * 64 + cc;
    float a0 = 0.f, a1 = 0.f, a2 = 0.f, a3 = 0.f, a4 = 0.f;
#pragma unroll 8
    for (int k = kg * 256; k < kg * 256 + 256; ++k) {
      const float wv = w[(size_t)k * 3072];
      a0 += sv[k] * wv; a1 += sv[1024 + k] * wv; a2 += sv[2048 + k] * wv; a3 += sv[3072 + k] * wv; a4 += sv[4096 + k] * wv;
    }
    red[(kg * 5 + 0) * 64 + cc] = a0; red[(kg * 5 + 1) * 64 + cc] = a1; red[(kg * 5 + 2) * 64 + cc] = a2; red[(kg * 5 + 3) * 64 + cc] = a3; red[(kg * 5 + 4) * 64 + cc] = a4;
    __syncthreads();
    for (int o = tid; o < 320; o += 256) {
      const int v = o >> 6, c2 = o & 63;
      float s = p.b_mod[l * 3072 + cgi * 64 + c2];
#pragma unroll
      for (int g = 0; g < 4; ++g) s += red[(g * 5 + v) * 64 + c2];
      ((float*)(ws + O_MOD))[(l * 5 + v) * 3072 + cgi * 64 + c2] = s;
    }
    return;
  }
  j -= P0_GEMV;
  if (j < P0_WIN) {
    const int l = j / 3408, r = j % 3408, kt = r / 213, nt = r % 213, c0 = nt * 32;
    const int nd0 = c0 < 2176 ? c0 : (c0 < 2208 ? 3712 + (c0 - 2176) : (c0 < 3744 ? c0 - 32 : c0 + 96));
    tr_tile(p.w_in + (size_t)l * 1024 * 6816, 6816, kt * 64, c0, (bf16_t*)(ws + O_WIN) + (size_t)l * 6912 * 1024, 1024, nd0, nullptr, lds);
    return;
  }
  j -= P0_WIN;
  if (j < P0_WQ) {
    const int l = j / 144, r = j % 144, kt = r / 24, nt = r % 24;
    tr_tile(p.w_q_up + (size_t)l * 384 * 768, 768, kt * 64, nt * 32, (bf16_t*)(ws + O_WQ) + (size_t)l * 768 * 384, 384, nt * 32, p.q_norm_g + l * 384, lds);
    return;
  }
  j -= P0_WQ;
  if (j < P0_WKV) {
    const int l = j / 128, r = j % 128, kt = r / 32, nt = r % 32, c0 = nt * 32, h = c0 >> 7, e = c0 & 127;
    const int nd0 = e < 64 ? h * 64 + e : 512 + h * 64 + (e - 64);
    tr_tile(p.w_kv_up + (size_t)l * 256 * 1024, 1024, kt * 64, c0, (bf16_t*)(ws + O_WKV) + (size_t)l * 1024 * 256, 256, nd0, nullptr, lds);
    return;
  }
  j -= P0_WKV;
  if (j < P0_WBR) {
    const int mat = j / 256, r = j % 256, kt = r / 32, nt = r % 32;
    tr_tile(p.w_branch + (size_t)mat * 512 * 1024, 1024, kt * 64, nt * 32, (bf16_t*)(ws + O_WBR) + (size_t)mat * 1024 * 512, 512, nt * 32, nullptr, lds);
    return;
  }
  j -= P0_WBR;
  if (j < P0_WO) {
    const int l = j / 512, r = j % 512, kt = r / 32, nt = r % 32;
    tr_tile(p.w_out + (size_t)l * 1024 * 1024, 1024, kt * 64, nt * 32, (bf16_t*)(ws + O_WO) + (size_t)l * 1024 * 1024, 1024, nt * 32, nullptr, lds);
    return;
  }
  j -= P0_WO;
  if (j < P0_S0) {
    const int mat = j >> 2, nt = j & 3;
    tr_tile(p.state_ret + (size_t)mat * 64 * 128, 128, 0, nt * 32, (bf16_t*)(ws + O_S0T) + (size_t)mat * 128 * 64, 64, nt * 32, nullptr, lds);
    return;
  }
  j -= P0_S0;
  if (j < P0_PAD) {
    const int l = j / 48, r = j % 48;
    bf16_t* d = (bf16_t*)(ws + O_WIN) + ((size_t)l * 6912 + 3744) * 1024 + (size_t)r * 2048 + tid * 8;
    *(u32x4*)d = (u32x4){0u, 0u, 0u, 0u};
    return;
  }
  j -= P0_PAD;
  {
    float v[8];
    bf16_t* dst;
    if (j < 16) {
      const int e0 = j * 2048 + tid * 8; dst = (bf16_t*)(ws + O_CS) + e0;
      const int n = e0 >> 7, k = e0 & 127;
#pragma unroll
      for (int e = 0; e < 8; ++e) {
        const float fr = (float)(((n & 127) * (k + e)) & 127) * (1.f / 128.f);
        v[e] = (n < 128) ? __builtin_amdgcn_cosf(fr) : __builtin_amdgcn_sinf(fr);
      }
    } else if (j < 80) {
      const int e0 = (j - 16) * 2048 + tid * 8; dst = (bf16_t*)(ws + O_D256) + e0;
      const int k1 = e0 >> 9, kk = e0 & 511;
#pragma unroll
      for (int e = 0; e < 8; ++e) {
        const int t = (kk + e) & 255;
        const float fr = (float)((k1 * t) & 255) * (1.f / 256.f);
        v[e] = (kk < 256) ? __builtin_amdgcn_cosf(fr) : -__builtin_amdgcn_sinf(fr);
      }
    } else {
      const int e0 = (j - 80) * 2048 + tid * 8; dst = (bf16_t*)(ws + O_D1024) + e0;
      const int k1 = e0 >> 11, kk = e0 & 2047;
#pragma unroll
      for (int e = 0; e < 8; ++e) {
        const int t = (kk + e) & 1023;
        const float fr = (float)((k1 * t) & 1023) * (1.f / 1024.f);
        v[e] = (kk < 1024) ? __builtin_amdgcn_cosf(fr) : -__builtin_amdgcn_sinf(fr);
      }
    }
    u32x4 w; w.x = pk2(v[0], v[1]); w.y = pk2(v[2], v[3]); w.z = pk2(v[4], v[5]); w.w = pk2(v[6], v[7]);
    *(u32x4*)dst = w;
  }
}

__device__ __forceinline__ void norm_item(const Params& p, int l, int item, const float* xp, const float* xs) {
  const int tid = tidx(), lane = tid & 63, wid = tid >> 6;
  bf16_t* H = (bf16_t*)(p.ws + O_H);
#pragma unroll 1
  for (int i = 0; i < 4; ++i) {
    const int row = item * 16 + wid * 4 + i;
    const float* src = row < NPR ? xp + (size_t)row * 1024 : xs + (size_t)(row - NPR) * 1024;
    const int v = row < NPR ? 0 : 1 + ((row - NPR) >> 10);
    const float* mod = (const float*)(p.ws + O_MOD) + (l * 5 + v) * 3072;
    f32x4 x[4]; float ss = 0.f;
#pragma unroll
    for (int q = 0; q < 4; ++q) { x[q] = *(const f32x4*)(src + (q * 64 + lane) * 4); ss += x[q][0] * x[q][0] + x[q][1] * x[q][1] + x[q][2] * x[q][2] + x[q][3] * x[q][3]; }
    ss = wave_sum(ss);
    const float rstd = rsqrtf(ss * (1.f / 1024.f) + EPSN);
#pragma unroll
    for (int q = 0; q < 4; ++q) {
      const int col = (q * 64 + lane) * 4;
      const f32x4 g = *(const f32x4*)(p.norm_g + l * 1024 + col), sc = *(const f32x4*)(mod + 1024 + col), sh = *(const f32x4*)(mod + col);
      f32x4 h;
#pragma unroll
      for (int e = 0; e < 4; ++e) h[e] = x[q][e] * rstd * g[e] * (1.f + sc[e]) + sh[e];
      *(u32x2*)(H + (size_t)row * 1024 + col) = pk4(h);
    }
  }
}
__device__ __forceinline__ void final_item(const Params& p, int item) {
  const int tid = tidx(), lane = tid & 63, wid = tid >> 6;
#pragma unroll 1
  for (int i = 0; i < 4; ++i) {
    const int row = item * 16 + wid * 4 + i;
    float* src = p.out + (size_t)row * 1024;
    f32x4 x[4]; float ss = 0.f;
#pragma unroll
    for (int q = 0; q < 4; ++q) { x[q] = *(const f32x4*)(src + (q * 64 + lane) * 4); ss += x[q][0] * x[q][0] + x[q][1] * x[q][1] + x[q][2] * x[q][2] + x[q][3] * x[q][3]; }
    ss = wave_sum(ss);
    const float rstd = rsqrtf(ss * (1.f / 1024.f) + EPSN);
#pragma unroll
    for (int q = 0; q < 4; ++q) {
      const int col = (q * 64 + lane) * 4;
      const f32x4 g = *(const f32x4*)(p.final_g + col);
      f32x4 y;
#pragma unroll
      for (int e = 0; e < 4; ++e) y[e] = x[q][e] * rstd * g[e];
      *(f32x4*)(src + col) = y;
    }
  }
}

__device__ __forceinline__ void s2_tile(const Params& p, int l, int tile, char* lds) {
  const int tid = tidx(), lane = tid & 63, wid = tid >> 6, wm = wid >> 1, wn = wid & 1, fr = lane & 15, fq = lane >> 4;
  const int m = tile % 96, nt = tile / 96, m0 = m * 128, n0 = nt * 128;
  char* ws = wsp(p.ws);
  const bf16_t* A = (const bf16_t*)(ws + O_H) + (size_t)m0 * 1024;
  const bf16_t* B = (const bf16_t*)(ws + O_WIN) + ((size_t)l * 6912 + n0) * 1024;
  f32x4 acc[4][4];
  zero_acc(acc);
  if (nt >= 4 && nt < 8) {
    gemm_core<false>(A, 1024, B, 1024, 1024, acc, lds);
    bf16_t* RVT = (bf16_t*)(ws + O_RVT);
#pragma unroll
    for (int i = 0; i < 4; ++i) {
      const int tok = m0 + wm * 64 + i * 16 + fq * 4;
      size_t base; int T, b, t;
      if (tok < NPR) { b = tok >> 8; t = tok & 255; T = 256; base = 0; } else { const int s = tok - NPR; b = s >> 10; t = s & 1023; T = 1024; base = (size_t)NPR * 512; }
#pragma unroll
      for (int j = 0; j < 4; ++j) {
        const int c = n0 - 512 + wn * 64 + j * 16 + fr, h = c >> 7, vd = c & 127;
        *(u32x2*)(RVT + base + ((size_t)(b * 4 + h) * 128 + vd) * T + t) = pk4(acc[i][j]);
      }
    }
    return;
  }
  gemm_core<true>(A, 1024, B, 1024, 1024, acc, lds);
  bf16_t* dst = nullptr; int ld = 0, c0 = 0, op = 0;
  if (nt < 2) { dst = (bf16_t*)(ws + O_RQ); ld = 256; c0 = 0; }
  else if (nt < 4) { dst = (bf16_t*)(ws + O_RK); ld = 256; c0 = 256; op = 2; }
  else if (nt < 12) { dst = (bf16_t*)(ws + O_RZ); ld = 512; c0 = 1024; op = 1; }
  else if (nt < 15) { dst = (bf16_t*)(ws + O_QLAT); ld = 384; c0 = 1536; }
  else if (nt < 17) { ld = 256; c0 = 1920; op = 3; }
  else if (nt < 21) { dst = (bf16_t*)(ws + O_MZ); ld = 512; c0 = 2176; op = 1; }
  else if (nt < 25) { dst = (bf16_t*)(ws + O_FU); ld = 512; c0 = 2688; }
  else if (nt < 29) { dst = (bf16_t*)(ws + O_FZ); ld = 512; c0 = 3200; op = 1; }
  else { ld = 32; c0 = 3712; op = 4; }
#pragma unroll
  for (int i = 0; i < 4; ++i) {
    const int tok = m0 + wm * 64 + i * 16 + fr;
#pragma unroll
    for (int j = 0; j < 4; ++j) {
      const int col = n0 - c0 + wn * 64 + j * 16 + fq * 4;
      f32x4 v = acc[i][j];
      if (op == 3) { *(f32x4*)((float*)(ws + O_KVLAT) + (size_t)tok * 256 + col) = v; continue; }
      if (op == 4) { if (col < 32) *(f32x4*)((float*)(ws + O_KR) + (size_t)tok * 32 + col) = v; continue; }
      if (op == 1) {
#pragma unroll
        for (int e = 0; e < 4; ++e) v[e] = silu_f(v[e]);
      } else if (op == 2) {
#pragma unroll
        for (int e = 0; e < 4; ++e) v[e] *= 0.125f;
      }
      const u32x2 w = pk4(v);
      *(u32x2*)(dst + (size_t)tok * ld + col) = w;
      if (op == 2 && tok < NPR) {
        bf16_t* RKT = (bf16_t*)(ws + O_RKT);
        const int b = tok >> 8, t = tok & 255, h = col >> 6, dk = col & 63;
        bf16_t* q = RKT + ((size_t)(b * 4 + h) * 64 + dk) * 256 + t;
        q[0] = (bf16_t)(w.x & 0xffffu); q[256] = (bf16_t)(w.x >> 16); q[512] = (bf16_t)(w.y & 0xffffu); q[768] = (bf16_t)(w.y >> 16);
      }
    }
  }
}

template <int MODE>
__device__ __forceinline__ void attn_item(const Params& p, int l, int item, char* lds) {
  constexpr int NKP = MODE == 0 ? 3 : 2;
  constexpr int NVB = MODE == 0 ? 4 : 8;
  constexpr int PV = NVB * 16 * 64;
  constexpr int KOFF = NKP * 4096;
  constexpr int BUF = KOFF + 2 * PV;
  const int tid = tidx(), lane = tid & 63, wid = tid >> 6, fr = lane & 15, fq = lane >> 4;
  char* ws = wsp(p.ws);
  int smp, b, h, qblk, T, Tk, tok0;
  const bf16_t *kbase, *rbase = nullptr, *vbase, *qbase;
  int kstride, qstride;
  if (MODE == 0) {
    if (item < 256) { smp = 1; b = item >> 6; h = (item >> 3) & 7; qblk = item & 7; T = 1024; Tk = 1536; tok0 = NPR + b * 1024 + qblk * 128; }
    else { const int it = item - 256; smp = 0; b = it >> 4; h = (it >> 1) & 7; qblk = it & 1; T = 256; Tk = 256; tok0 = b * 256 + qblk * 128; }
    const int keyrow0 = smp ? NPR + b * 1536 : b * 256;
    kbase = (const bf16_t*)(ws + O_KB) + (size_t)keyrow0 * 512 + h * 64; kstride = 512;
    rbase = (const bf16_t*)(ws + O_KRA) + (size_t)keyrow0 * 32;
    vbase = (const bf16_t*)(ws + O_VT) + (smp ? (size_t)NPR * 512 + (size_t)(b * 8 + h) * 64 * 1536 : (size_t)(b * 8 + h) * 64 * 256);
    qbase = (const bf16_t*)(ws + O_QB) + (size_t)tok0 * 768 + h * 96; qstride = 768;
  } else {
    if (item < 128) { smp = 1; b = item >> 5; h = (item >> 3) & 3; qblk = item & 7; T = 1024; tok0 = NPR + b * 1024 + qblk * 128; }
    else { const int it = item - 128; smp = 0; b = it >> 3; h = (it >> 1) & 3; qblk = it & 1; T = 256; tok0 = b * 256 + qblk * 128; }
    Tk = T;
    const int ktok0 = smp ? NPR + b * 1024 : b * 256;
    kbase = (const bf16_t*)(ws + O_RK) + (size_t)ktok0 * 256 + h * 64; kstride = 256;
    vbase = (const bf16_t*)(ws + O_RVT) + (smp ? (size_t)NPR * 512 + (size_t)(b * 4 + h) * 128 * 1024 : (size_t)(b * 4 + h) * 128 * 256);
    qbase = (const bf16_t*)(ws + O_RQ) + (size_t)tok0 * 256 + h * 64; qstride = 256;
  }
  const int nkt = Tk >> 6;
  bf16x8 qf[2][NKP];
#pragma unroll
  for (int qb = 0; qb < 2; ++qb)
#pragma unroll
    for (int ks = 0; ks < NKP; ++ks) qf[qb][ks] = *(const bf16x8*)(qbase + (size_t)(wid * 32 + qb * 16 + fr) * qstride + ks * 32 + fq * 8);
  f32x4 o[NVB][2];
#pragma unroll
  for (int vb = 0; vb < NVB; ++vb) { o[vb][0] = (f32x4){0.f, 0.f, 0.f, 0.f}; o[vb][1] = (f32x4){0.f, 0.f, 0.f, 0.f}; }
  float lgf = 0.f, lgb = 0.f;
  float mrow[2] = {-INFINITY, -INFINITY}, lrow[2] = {0.f, 0.f};
  const int tq0 = qblk * 128 + wid * 32 + fr;
  if (MODE == 1) {
    const float xf = p.ret_logit[(l * 2 + 0) * 4 + h], xb = p.ret_logit[(l * 2 + 1) * 4 + h];
    lgf = -log1pf(expf(-xf)) * 1.44269504089f; lgb = -log1pf(expf(-xb)) * 1.44269504089f;
    if (smp) {
      const bf16_t* s0 = (const bf16_t*)(ws + O_S0T);
#pragma unroll
      for (int dir = 0; dir < 2; ++dir) {
        const bf16_t* sb = s0 + ((size_t)(((b * 2 + l) * 2 + dir) * 4 + h) * 128) * 64;
        float dec[2];
#pragma unroll
        for (int qb = 0; qb < 2; ++qb) { const int tq = tq0 + qb * 16; dec[qb] = dir == 0 ? exp2f((float)(tq + 1) * lgf) : exp2f((float)(T - tq) * lgb); }
#pragma unroll
        for (int vb = 0; vb < NVB; ++vb) {
          f32x4 t0 = (f32x4){0.f, 0.f, 0.f, 0.f}, t1 = (f32x4){0.f, 0.f, 0.f, 0.f};
#pragma unroll
          for (int ks = 0; ks < 2; ++ks) {
            const bf16x8 sf = *(const bf16x8*)(sb + (size_t)(vb * 16 + fr) * 64 + ks * 32 + fq * 8);
            t0 = mfma16(sf, qf[0][ks], t0); t1 = mfma16(sf, qf[1][ks], t1);
          }
          o[vb][0] += t0 * dec[0]; o[vb][1] += t1 * dec[1];
        }
      }
    }
  }
  u32x4 kreg[2], rreg, vreg[NVB / 2];
  auto gload = [&](int kt) {
#pragma unroll
    for (int i = 0; i < 2; ++i) { const int idx = tid + 256 * i, key = idx >> 3, c = idx & 7; kreg[i] = *(const u32x4*)(kbase + (size_t)(kt * 64 + key) * kstride + c * 8); }
    if (MODE == 0) { const int key = tid >> 2, c = tid & 3; rreg = *(const u32x4*)(rbase + (size_t)(kt * 64 + key) * 32 + c * 8); }
#pragma unroll
    for (int i = 0; i < NVB / 2; ++i) { const int idx = tid + 256 * i, vd = idx >> 3, g = idx & 7; vreg[i] = *(const u32x4*)(vbase + (size_t)vd * Tk + kt * 64 + g * 8); }
  };
  auto lstore = [&](char* buf) {
#pragma unroll
    for (int i = 0; i < 2; ++i) { const int idx = tid + 256 * i, key = idx >> 3, c = idx & 7; *(u32x4*)(buf + (c >> 2) * 4096 + key * 64 + (((c & 3) ^ swz(key)) << 4)) = kreg[i]; }
    if (MODE == 0) { const int key = tid >> 2, c = tid & 3; *(u32x4*)(buf + 2 * 4096 + key * 64 + ((c ^ swz(key)) << 4)) = rreg; }
#pragma unroll
    for (int i = 0; i < NVB / 2; ++i) {
      const int idx = tid + 256 * i, vd = idx >> 3, g = idx & 7, pnl = g >> 2, g4 = g & 3, hi = g4 >> 1, q0 = 2 * (g4 & 1);
      char* base = buf + KOFF + pnl * PV + vd * 64 + hi * 8;
      *(u32x2*)(base + ((q0 ^ swz(vd)) << 4)) = (u32x2){vreg[i].x, vreg[i].y};
      *(u32x2*)(base + (((q0 + 1) ^ swz(vd)) << 4)) = (u32x2){vreg[i].z, vreg[i].w};
    }
  };
  __syncthreads();
  gload(0); lstore(lds);
  __syncthreads();
  const int foff = fr * 64 + ((fq ^ swz(fr)) << 4);
  for (int kt = 0; kt < nkt; ++kt) {
    char* cur = lds + (kt & 1) * BUF;
    const bool more = (kt + 1) < nkt;
    if (more) gload(kt + 1);
    f32x4 s[4][2];
#pragma unroll
    for (int kb = 0; kb < 4; ++kb) {
      s[kb][0] = (f32x4){0.f, 0.f, 0.f, 0.f}; s[kb][1] = (f32x4){0.f, 0.f, 0.f, 0.f};
#pragma unroll
      for (int ks = 0; ks < NKP; ++ks) {
        const bf16x8 kf = *(const bf16x8*)(cur + ks * 4096 + kb * 1024 + foff);
        s[kb][0] = mfma16(kf, qf[0][ks], s[kb][0]); s[kb][1] = mfma16(kf, qf[1][ks], s[kb][1]);
      }
    }
    bf16x8 pf[2][2];
#pragma unroll
    for (int qb = 0; qb < 2; ++qb) {
      if (MODE == 0) {
        float mx = s[0][qb][0];
#pragma unroll
        for (int kb = 0; kb < 4; ++kb)
#pragma unroll
          for (int r = 0; r < 4; ++r) mx = fmaxf(mx, s[kb][qb][r]);
        mx = fmaxf(mx, __shfl_xor(mx, 16)); mx = fmaxf(mx, __shfl_xor(mx, 32));
        const float mn = fmaxf(mrow[qb], mx), alpha = exp2f(mrow[qb] - mn);
        mrow[qb] = mn;
        float ls = 0.f;
#pragma unroll
        for (int kb = 0; kb < 4; ++kb)
#pragma unroll
          for (int r = 0; r < 4; ++r) { const float e = exp2f(s[kb][qb][r] - mn); s[kb][qb][r] = e; ls += e; }
        lrow[qb] = lrow[qb] * alpha + ls;
#pragma unroll
        for (int vb = 0; vb < NVB; ++vb) o[vb][qb] *= alpha;
      } else {
        const int tq = tq0 + qb * 16;
#pragma unroll
        for (int kb = 0; kb < 4; ++kb)
#pragma unroll
          for (int r = 0; r < 4; ++r) {
            const int d = tq - (kt * 64 + kb * 16 + fq * 4 + r);
            const float dec = d > 0 ? exp2f((float)d * lgf) : (d < 0 ? exp2f((float)(-d) * lgb) : 2.f);
            s[kb][qb][r] *= dec;
          }
      }
#pragma unroll
      for (int g = 0; g < 2; ++g) {
        u32x4 w; w.x = pk2(s[2 * g][qb][0], s[2 * g][qb][1]); w.y = pk2(s[2 * g][qb][2], s[2 * g][qb][3]);
        w.z = pk2(s[2 * g + 1][qb][0], s[2 * g + 1][qb][1]); w.w = pk2(s[2 * g + 1][qb][2], s[2 * g + 1][qb][3]);
        pf[qb][g] = as_bf8(w);
      }
    }
#pragma unroll
    for (int vb = 0; vb < NVB; ++vb)
#pragma unroll
      for (int g = 0; g < 2; ++g) {
        const bf16x8 vf = *(const bf16x8*)(cur + KOFF + g * PV + vb * 1024 + foff);
        o[vb][0] = mfma16(vf, pf[0][g], o[vb][0]); o[vb][1] = mfma16(vf, pf[1][g], o[vb][1]);
      }
    if (more) lstore(lds + ((kt + 1) & 1) * BUF);
    __syncthreads();
  }
  bf16_t* G = (bf16_t*)(ws + (MODE == 0 ? O_MZ : O_RZ));
#pragma unroll
  for (int qb = 0; qb < 2; ++qb) {
    const int tok = tok0 + wid * 32 + qb * 16 + fr;
    float mul, sub;
    if (MODE == 0) {
      float lt = lrow[qb]; lt += __shfl_xor(lt, 16); lt += __shfl_xor(lt, 32);
      mul = 1.f / lt; sub = 0.f;
    } else {
      float sm = 0.f;
#pragma unroll
      for (int vb = 0; vb < NVB; ++vb) sm += (o[vb][qb][0] + o[vb][qb][1]) + (o[vb][qb][2] + o[vb][qb][3]);
      sm += __shfl_xor(sm, 16); sm += __shfl_xor(sm, 32);
      const float mu = sm * (1.f / 128.f);
      float vs = 0.f;
#pragma unroll
      for (int vb = 0; vb < NVB; ++vb)
#pragma unroll
        for (int r = 0; r < 4; ++r) { const float dd = o[vb][qb][r] - mu; vs += dd * dd; }
      vs += __shfl_xor(vs, 16); vs += __shfl_xor(vs, 32);
      mul = rsqrtf(vs * (1.f / 128.f) + EPSN); sub = mu;
    }
#pragma unroll
    for (int vb = 0; vb < NVB; ++vb) {
      bf16_t* gp = G + (size_t)tok * 512 + h * (NVB * 16) + vb * 16 + fq * 4;
      const u32x2 gz = *(const u32x2*)gp;
      f32x4 y;
      y[0] = (o[vb][qb][0] - sub) * mul * bflo(gz.x); y[1] = (o[vb][qb][1] - sub) * mul * bfhi(gz.x);
      y[2] = (o[vb][qb][2] - sub) * mul * bflo(gz.y); y[3] = (o[vb][qb][3] - sub) * mul * bfhi(gz.y);
      *(u32x2*)gp = pk4(y);
    }
  }
}

__device__ __forceinline__ bf16x8 scale8(u32x4 raw, const float (&d)[8]) {
  u32x4 w;
  w.x = pk2(bflo(raw.x) * d[0], bfhi(raw.x) * d[1]); w.y = pk2(bflo(raw.y) * d[2], bfhi(raw.y) * d[3]);
  w.z = pk2(bflo(raw.z) * d[4], bfhi(raw.z) * d[5]); w.w = pk2(bflo(raw.w) * d[6], bfhi(raw.w) * d[7]);
  return as_bf8(w);
}
__device__ __forceinline__ void state_item(const Params& p, int l, int item) {
  const int tid = tidx(), lane = tid & 63, wid = tid >> 6, fr = lane & 15, fq = lane >> 4;
  const int b = item >> 2, h = item & 3;
  const bf16_t* RVT = (const bf16_t*)(p.ws + O_RVT) + (size_t)(b * 4 + h) * 128 * 256;
  const bf16_t* RKT = (const bf16_t*)(p.ws + O_RKT) + (size_t)(b * 4 + h) * 64 * 256;
  const float xf = p.ret_logit[(l * 2 + 0) * 4 + h], xb = p.ret_logit[(l * 2 + 1) * 4 + h];
  const float lgf = -log1pf(expf(-xf)) * 1.44269504089f, lgb = -log1pf(expf(-xb)) * 1.44269504089f;
  f32x4 acc[2][2][4];
#pragma unroll
  for (int d = 0; d < 2; ++d)
#pragma unroll
    for (int v = 0; v < 2; ++v)
#pragma unroll
      for (int k = 0; k < 4; ++k) acc[d][v][k] = (f32x4){0.f, 0.f, 0.f, 0.f};
#pragma unroll 1
  for (int ks = 0; ks < 8; ++ks) {
    const int j0 = ks * 32 + fq * 8;
    float df[8], db[8];
#pragma unroll
    for (int e = 0; e < 8; ++e) { df[e] = exp2f((float)(255 - j0 - e) * lgf); db[e] = exp2f((float)(j0 + e) * lgb); }
    bf16x8 af[2];
#pragma unroll
    for (int v = 0; v < 2; ++v) af[v] = *(const bf16x8*)(RVT + (size_t)((wid * 2 + v) * 16 + fr) * 256 + j0);
#pragma unroll
    for (int k = 0; k < 4; ++k) {
      const u32x4 raw = *(const u32x4*)(RKT + (size_t)(k * 16 + fr) * 256 + j0);
      const bf16x8 kf = scale8(raw, df), kb = scale8(raw, db);
#pragma unroll
      for (int v = 0; v < 2; ++v) { acc[0][v][k] = mfma16(af[v], kf, acc[0][v][k]); acc[1][v][k] = mfma16(af[v], kb, acc[1][v][k]); }
    }
  }
  float* O = p.out + OUT_RET;
#pragma unroll
  for (int d = 0; d < 2; ++d)
#pragma unroll
    for (int v = 0; v < 2; ++v)
#pragma unroll
      for (int k = 0; k < 4; ++k) {
        const int dk = k * 16 + fr, vd = (wid * 2 + v) * 16 + fq * 4;
        *(f32x4*)(O + ((size_t)((((b * 2 + l) * 2 + d) * 4 + h) * 64 + dk)) * 128 + vd) = acc[d][v][k];
      }
}

__device__ __forceinline__ void keyprep_item(const Params& p, int l, int item) {
  const int tid = tidx(), lane = tid & 63, wid = tid >> 6;
  char* ws = wsp(p.ws);
  bf16_t* CKVA = (bf16_t*)(ws + O_CKVA);
  bf16_t* KRA = (bf16_t*)(ws + O_KRA);
#pragma unroll 1
  for (int i = 0; i < 16; ++i) {
    const int R = item * 64 + wid * 16 + i;
    int smp = 0, b, t = 0, tok = 0, ctx = 0, pp = 0;
    if (R < NPR) { tok = R; b = R >> 8; t = R & 255; }
    else { smp = 1; const int s = R - NPR; b = s / 1536; pp = s - b * 1536; if (pp < 512) ctx = 1; else { t = pp - 512; tok = NPR + b * 1024 + t; } }
    if (ctx) {
      const f32x4 v = *(const f32x4*)(p.cache_ckv + ((size_t)((b * 2 + l) * 512 + pp)) * 256 + lane * 4);
      *(u32x2*)(CKVA + (size_t)R * 256 + lane * 4) = pk4(v);
      if (lane < 32) KRA[(size_t)R * 32 + lane] = tobf(p.cache_krope[((size_t)((b * 2 + l) * 512 + pp)) * 32 + lane]);
      continue;
    }
    const f32x4 v = *(const f32x4*)((const float*)(ws + O_KVLAT) + (size_t)tok * 256 + lane * 4);
    float ss = v[0] * v[0] + v[1] * v[1] + v[2] * v[2] + v[3] * v[3];
    ss = wave_sum(ss);
    const float rstd = rsqrtf(ss * (1.f / 256.f) + EPSN);
    const f32x4 g = *(const f32x4*)(p.kv_norm_g + l * 256 + lane * 4);
    f32x4 y;
#pragma unroll
    for (int e = 0; e < 4; ++e) y[e] = v[e] * rstd * g[e];
    *(u32x2*)(CKVA + (size_t)R * 256 + lane * 4) = pk4(y);
    if (!smp) *(f32x4*)(p.out + OUT_CKV + ((size_t)((b * 2 + l) * 256 + t)) * 256 + lane * 4) = y;
    const int d = lane & 31;
    const float x = ((const float*)(ws + O_KR))[(size_t)tok * 32 + d];
    float yk = x;
    if (smp) {
      const float pr = __shfl_xor(x, 8);
      const int hd = d >> 4, i16 = d & 15, f = i16 & 7;
      const float pos = (float)(hd ? (t & 63) : (t >> 6));
      const float ang = pos * exp2f(-(float)f * 1.66096404744f);
      const float cs = __cosf(ang), sn = __sinf(ang);
      yk = i16 < 8 ? x * cs - pr * sn : pr * sn + x * cs;
    } else if (lane < 32) {
      p.out[OUT_KR + ((size_t)((b * 2 + l) * 256 + t)) * 32 + d] = x;
    }
    if (lane < 32) KRA[(size_t)R * 32 + d] = tobf(yk);
  }
}

__device__ __forceinline__ void f1_tile(const Params& p, int tile, char* lds) {
  const int tid = tidx(), lane = tid & 63, wid = tid >> 6, wm = wid >> 1, wn = wid & 1, fr = lane & 15, fq = lane >> 4;
  const int m = tile >> 3, g = (tile >> 1) & 3, nh = tile & 1, m0 = m * 128;
  char* ws = wsp(p.ws);
  f32x4 acc[4][4];
  zero_acc(acc);
  gemm_core<false>((const bf16_t*)(ws + O_FU) + (size_t)m0 * 512 + g * 128, 512, (const bf16_t*)(ws + O_CS) + (size_t)nh * 128 * 128, 128, 128, acc, lds);
  bf16_t* UT = (bf16_t*)(ws + O_UT);
#pragma unroll
  for (int i = 0; i < 4; ++i) {
    const int tok = m0 + wm * 64 + i * 16 + fq * 4;
    size_t base; int T, b, t;
    if (tok < NPR) { b = tok >> 8; t = tok & 255; T = 256; base = 0; } else { const int s = tok - NPR; b = s >> 10; t = s & 1023; T = 1024; base = (size_t)NPR * 1024; }
#pragma unroll
    for (int j = 0; j < 4; ++j) {
      const int k2 = wn * 64 + j * 16 + fr;
      *(u32x2*)(UT + base + ((size_t)(b * 4 + g) * 128 + k2) * (2 * T) + nh * T + t) = pk4(acc[i][j]);
    }
  }
}

__device__ __forceinline__ void qup_tile(const Params& p, int l, int tile, char* lds) {
  const int tid = tidx(), lane = tid & 63, wid = tid >> 6, wm = wid >> 1, wn = wid & 1, fr = lane & 15, fq = lane >> 4;
  const int m = tile % 96, nt = tile / 96, m0 = m * 128, n0 = nt * 128;
  char* ws = wsp(p.ws);
  const bf16_t* QL = (const bf16_t*)(ws + O_QLAT) + (size_t)m0 * 384;
  float rsv;
  {
    const bf16_t* q = QL + (size_t)(wm * 64 + lane) * 384;
    float ss = 0.f;
#pragma unroll 4
    for (int i = 0; i < 48; ++i) {
      const u32x4 w = *(const u32x4*)(q + i * 8);
      ss += bflo(w.x) * bflo(w.x) + bfhi(w.x) * bfhi(w.x) + bflo(w.y) * bflo(w.y) + bfhi(w.y) * bfhi(w.y) + bflo(w.z) * bflo(w.z) + bfhi(w.z) * bfhi(w.z) + bflo(w.w) * bflo(w.w) + bfhi(w.w) * bfhi(w.w);
    }
    rsv = rsqrtf(ss * (1.f / 384.f) + EPSN);
  }
  f32x4 acc[4][4];
  zero_acc(acc);
  gemm_core<true>(QL, 384, (const bf16_t*)(ws + O_WQ) + ((size_t)l * 768 + n0) * 384, 384, 384, acc, lds);
  bf16_t* QB = (bf16_t*)(ws + O_QB);
  const float qscale = 0.10206207261596577f * 1.44269504089f;
#pragma unroll
  for (int i = 0; i < 4; ++i) {
    const int rl = wm * 64 + i * 16 + fr, tok = m0 + rl;
    const float sc = __shfl(rsv, i * 16 + fr) * qscale;
    const int smp = tok >= NPR, t = (tok - NPR) & 1023;
#pragma unroll
    for (int j = 0; j < 4; ++j) {
      const int cb = n0 + wn * 64 + j * 16, within = cb % 96;
      f32x4 v = acc[i][j] * sc;
      if (within >= 64) {
        f32x4 pr;
#pragma unroll
        for (int e = 0; e < 4; ++e) pr[e] = __shfl_xor(v[e], 32);
        if (smp) {
          const float pos = (float)(within >= 80 ? (t & 63) : (t >> 6));
#pragma unroll
          for (int e = 0; e < 4; ++e) {
            const int f = (fq & 1) * 4 + e;
            const float ang = pos * exp2f(-(float)f * 1.66096404744f);
            const float cs = __cosf(ang), sn = __sinf(ang);
            v[e] = fq < 2 ? v[e] * cs - pr[e] * sn : pr[e] * sn + v[e] * cs;
          }
        }
      }
      *(u32x2*)(QB + (size_t)tok * 768 + cb + fq * 4) = pk4(v);
    }
  }
}

__device__ __forceinline__ void kvup_tile(const Params& p, int l, int tile, char* lds) {
  const int tid = tidx(), lane = tid & 63, wid = tid >> 6, wm = wid >> 1, wn = wid & 1, fr = lane & 15, fq = lane >> 4;
  const int m = tile % 112, nt = tile / 112, m0 = m * 128, n0 = nt * 128;
  char* ws = wsp(p.ws);
  const bf16_t* A = (const bf16_t*)(ws + O_CKVA) + (size_t)m0 * 256;
  const bf16_t* B = (const bf16_t*)(ws + O_WKV) + ((size_t)l * 1024 + n0) * 256;
  f32x4 acc[4][4];
  zero_acc(acc);
  if (nt < 4) {
    gemm_core<true>(A, 256, B, 256, 256, acc, lds);
    bf16_t* KB = (bf16_t*)(ws + O_KB);
#pragma unroll
    for (int i = 0; i < 4; ++i) {
      const int R = m0 + wm * 64 + i * 16 + fr;
#pragma unroll
      for (int j = 0; j < 4; ++j) *(u32x2*)(KB + (size_t)R * 512 + n0 + wn * 64 + j * 16 + fq * 4) = pk4(acc[i][j]);
    }
  } else {
    gemm_core<false>(A, 256, B, 256, 256, acc, lds);
    bf16_t* VT = (bf16_t*)(ws + O_VT);
#pragma unroll
    for (int i = 0; i < 4; ++i) {
      const int R = m0 + wm * 64 + i * 16 + fq * 4;
      size_t base; int Tk, b, k;
      if (R < NPR) { b = R >> 8; k = R & 255; Tk = 256; base = 0; } else { const int s = R - NPR; b = s / 1536; k = s - b * 1536; Tk = 1536; base = (size_t)NPR * 512; }
#pragma unroll
      for (int j = 0; j < 4; ++j) {
        const int c = n0 - 512 + wn * 64 + j * 16 + fr, h = c >> 6, vd = c & 63;
        *(u32x2*)(VT + base + ((size_t)(b * 8 + h) * 64 + vd) * Tk + k) = pk4(acc[i][j]);
      }
    }
  }
}

__device__ __forceinline__ void f2_tile(const Params& p, int tile, char* lds) {
  const int tid = tidx(), lane = tid & 63, wid = tid >> 6, wm = wid >> 1, wn = wid & 1, fr = lane & 15, fq = lane >> 4;
  char* ws = wsp(p.ws);
  const bf16_t *A, *B; int K, tokb, g; float scale;
  if (tile < 128) {
    const int b = tile >> 5, mt = tile & 7; g = (tile >> 3) & 3;
    A = (const bf16_t*)(ws + O_D1024) + (size_t)mt * 128 * 2048; K = 2048;
    B = (const bf16_t*)(ws + O_UT) + (size_t)NPR * 1024 + (size_t)(b * 4 + g) * 128 * 2048;
    tokb = NPR + b * 1024 + mt * 128; scale = 0.00276213586400995f;
  } else {
    const int it = tile - 128, b = it >> 3, mt = it & 1; g = (it >> 1) & 3;
    A = (const bf16_t*)(ws + O_D256) + (size_t)mt * 128 * 512; K = 512;
    B = (const bf16_t*)(ws + O_UT) + (size_t)(b * 4 + g) * 128 * 512;
    tokb = b * 256 + mt * 128; scale = 0.0055242717280199f;
  }
  f32x4 acc[4][4];
  zero_acc(acc);
  gemm_core<true>(A, K, B, K, K, acc, lds);
  bf16_t* FZ = (bf16_t*)(ws + O_FZ);
#pragma unroll
  for (int i = 0; i < 4; ++i) {
    const int tok = tokb + wm * 64 + i * 16 + fr;
#pragma unroll
    for (int j = 0; j < 4; ++j) {
      bf16_t* gp = FZ + (size_t)tok * 512 + g * 128 + wn * 64 + j * 16 + fq * 4;
      const u32x2 gz = *(const u32x2*)gp;
      f32x4 y;
      y[0] = acc[i][j][0] * scale * bflo(gz.x); y[1] = acc[i][j][1] * scale * bfhi(gz.x);
      y[2] = acc[i][j][2] * scale * bflo(gz.y); y[3] = acc[i][j][3] * scale * bfhi(gz.y);
      *(u32x2*)gp = pk4(y);
    }
  }
}

__device__ __forceinline__ void s6_tile(const Params& p, int l, int tile, char* lds) {
  const int tid = tidx(), lane = tid & 63, wid = tid >> 6, wm = wid >> 1, wn = wid & 1, fr = lane & 15, fq = lane >> 4;
  const int m = tile % 96, nt = tile / 96, m0 = m * 128, n0 = nt * 64;
  char* ws = wsp(p.ws);
  f32x4 tot[4][2], acc[4][2];
  u32x2 sg[4][2];
#pragma unroll
  for (int i = 0; i < 4; ++i) { tot[i][0] = (f32x4){0.f, 0.f, 0.f, 0.f}; tot[i][1] = (f32x4){0.f, 0.f, 0.f, 0.f}; }
#pragma unroll 1
  for (int nb = 0; nb < 3; ++nb) {
#pragma unroll
    for (int i = 0; i < 4; ++i) { acc[i][0] = (f32x4){0.f, 0.f, 0.f, 0.f}; acc[i][1] = (f32x4){0.f, 0.f, 0.f, 0.f}; }
    gemm_core<true, 2>((const bf16_t*)(ws + O_H) + (size_t)m0 * 1024, 1024,
                       (const bf16_t*)(ws + O_WIN) + ((size_t)l * 6912 + 3840 + nb * 1024 + n0) * 1024, 1024, 1024, acc, lds);
#pragma unroll
    for (int i = 0; i < 4; ++i)
#pragma unroll
      for (int j = 0; j < 2; ++j) { f32x4 sv;
#pragma unroll
        for (int e = 0; e < 4; ++e) sv[e] = sigm_f(acc[i][j][e]);
        sg[i][j] = pk4(sv); }
#pragma unroll
    for (int i = 0; i < 4; ++i) { acc[i][0] = (f32x4){0.f, 0.f, 0.f, 0.f}; acc[i][1] = (f32x4){0.f, 0.f, 0.f, 0.f}; }
    const size_t boff = nb == 0 ? O_RZ : (nb == 1 ? O_MZ : O_FZ);
    gemm_core<true, 2>((const bf16_t*)(ws + boff) + (size_t)m0 * 512, 512,
                       (const bf16_t*)(ws + O_WBR) + ((size_t)(l * 3 + nb) * 1024 + n0) * 512, 512, 512, acc, lds);
#pragma unroll
    for (int i = 0; i < 4; ++i)
#pragma unroll
      for (int j = 0; j < 2; ++j) {
        tot[i][j][0] += acc[i][j][0] * bflo(sg[i][j].x); tot[i][j][1] += acc[i][j][1] * bfhi(sg[i][j].x);
        tot[i][j][2] += acc[i][j][2] * bflo(sg[i][j].y); tot[i][j][3] += acc[i][j][3] * bfhi(sg[i][j].y);
      }
  }
  bf16_t* MG = (bf16_t*)(ws + O_UT);
#pragma unroll
  for (int i = 0; i < 4; ++i) {
    const int tok = m0 + wm * 64 + i * 16 + fr;
#pragma unroll
    for (int j = 0; j < 2; ++j) *(u32x2*)(MG + (size_t)tok * 1024 + n0 + wn * 32 + j * 16 + fq * 4) = pk4(tot[i][j]);
  }
}

__device__ __forceinline__ void s7_tile(const Params& p, int l, int tile, const float* xp, const float* xs, char* lds) {
  const int tid = tidx(), lane = tid & 63, wid = tid >> 6, wm = wid >> 1, wn = wid & 1, fr = lane & 15, fq = lane >> 4;
  const int m = tile % 96, nt = tile / 96, m0 = m * 128, n0 = nt * 128;
  char* ws = wsp(p.ws);
  f32x4 acc[4][4];
  zero_acc(acc);
  gemm_core<true>((const bf16_t*)(ws + O_UT) + (size_t)m0 * 1024, 1024, (const bf16_t*)(ws + O_WO) + ((size_t)l * 1024 + n0) * 1024, 1024, 1024, acc, lds);
#pragma unroll
  for (int i = 0; i < 4; ++i) {
    const int tok = m0 + wm * 64 + i * 16 + fr;
    const float* src = tok < NPR ? xp + (size_t)tok * 1024 : xs + (size_t)(tok - NPR) * 1024;
    const int v = tok < NPR ? 0 : 1 + ((tok - NPR) >> 10);
    const float* gate = (const float*)(ws + O_MOD) + (l * 5 + v) * 3072 + 2048;
#pragma unroll
    for (int j = 0; j < 4; ++j) {
      const int col = n0 + wn * 64 + j * 16 + fq * 4;
      const f32x4 x = *(const f32x4*)(src + col), gt = *(const f32x4*)(gate + col);
      f32x4 y;
#pragma unroll
      for (int e = 0; e < 4; ++e) y[e] = x[e] + gt[e] * acc[i][j][e];
      *(f32x4*)(p.out + (size_t)tok * 1024 + col) = y;
    }
  }
}

constexpr int NPHASE = 16;
__device__ __forceinline__ void run_phase(const Params& p, int ph, char* lds) {
  const int bid = blockIdx.x, nb = gridDim.x;
  if (ph == 0) { for (int i = bid; i < P0_N; i += nb) phase0_item(p, i, lds); return; }
  if (ph == 15) { for (int i = bid; i < 768; i += nb) final_item(p, i); return; }
  const int l = (ph - 1) / 7, s = (ph - 1) % 7;
  const float* xp = l == 0 ? p.x_prompt : p.out;
  const float* xs = l == 0 ? p.x_sample : p.out + (size_t)NPR * 1024;
  switch (s) {
    case 0: for (int i = bid; i < 768; i += nb) norm_item(p, l, i, xp, xs); break;
    case 1: for (int i = bid; i < 2880; i += nb) s2_tile(p, l, i, lds); break;
    case 2:
      for (int i = bid; i < 1504; i += nb) {
        if (i < 384) attn_item<1>(p, l, i, lds);
        else if (i < 512) state_item(p, l, i - 384);
        else if (i < 736) keyprep_item(p, l, i - 512);
        else f1_tile(p, i - 736, lds);
      }
      break;
    case 3:
      for (int i = bid; i < 1856; i += nb) {
        if (i < 384) f2_tile(p, i, lds);
        else if (i < 1280) kvup_tile(p, l, i - 384, lds);
        else qup_tile(p, l, i - 1280, lds);
      }
      break;
    case 4: for (int i = bid; i < 768; i += nb) attn_item<0>(p, l, i, lds); break;
    case 5: for (int i = bid; i < 1536; i += nb) s6_tile(p, l, i, lds); break;
    case 6: for (int i = bid; i < 768; i += nb) s7_tile(p, l, i, xp, xs, lds); break;
  }
}

__global__ void __launch_bounds__(256, 2) mk_fwd(Params p) {
  __shared__ __attribute__((aligned(16))) char lds[LDS_TOTAL];
  cg::grid_group grid = cg::this_grid();
#pragma unroll 1
  for (int ph = 0; ph < NPHASE; ++ph) {
    run_phase(p, ph, lds);
    if (ph + 1 < NPHASE) grid.sync();
  }
}

__global__ void __launch_bounds__(256, 2) ph_fwd(Params p, int ph) {
  __shared__ __attribute__((aligned(16))) char lds[LDS_TOTAL];
  run_phase(p, ph, lds);
}

extern "C" void kernel_launch(void* const* d_in, const int* in_sizes, int n_in, void* d_out, int out_size, void* d_ws, size_t ws_size,
                              hipStream_t stream) {
  Params p{};
  p.x_prompt = (const float*)d_in[0]; p.x_sample = (const float*)d_in[1]; p.cache_ckv = (const float*)d_in[2]; p.cache_krope = (const float*)d_in[3];
  p.state_ret = (const float*)d_in[4]; p.c = (const float*)d_in[5]; p.c_ctx = (const float*)d_in[6]; p.norm_g = (const float*)d_in[7];
  p.w_mod = (const float*)d_in[8]; p.b_mod = (const float*)d_in[9]; p.w_in = (const float*)d_in[10]; p.ret_logit = (const float*)d_in[11];
  p.q_norm_g = (const float*)d_in[12]; p.w_q_up = (const float*)d_in[13]; p.kv_norm_g = (const float*)d_in[14]; p.w_kv_up = (const float*)d_in[15];
  p.w_branch = (const float*)d_in[16]; p.w_out = (const float*)d_in[17]; p.final_g = (const float*)d_in[18];
  p.out = (float*)d_out; p.ws = (char*)d_ws;
#if ONE_LAUNCH
  static int grid_blocks = 0;
  if (!grid_blocks) {
    int dev = 0, cus = 0, per_cu = 0;
    hipGetDevice(&dev);
    hipDeviceGetAttribute(&cus, hipDeviceAttributeMultiprocessorCount, dev);
    hipOccupancyMaxActiveBlocksPerMultiprocessor(&per_cu, mk_fwd, 256, 0);
    if (per_cu > 2) per_cu = 2;
    grid_blocks = cus * per_cu;
  }
  void* args[] = {&p};
  hipError_t e = hipLaunchCooperativeKernel((void*)mk_fwd, dim3(grid_blocks), dim3(256), args, 0, stream);
  if (e != hipSuccess) fprintf(stderr, "cooperative launch failed: %s (grid %d)\n", hipGetErrorString(e), grid_blocks);
#else
#ifndef STOP_AFTER
#define STOP_AFTER 15
#endif
  for (int ph = 0; ph <= STOP_AFTER; ++ph) ph_fwd<<<512, 256, 0, stream>>>(p, ph);
#endif
}
```

```cpp
#include <hip/hip_runtime.h>
#include <hip/hip_cooperative_groups.h>
#include <stdint.h>
#include <stdio.h>
namespace cg = cooperative_groups;

#ifndef ONE_LAUNCH
#define ONE_LAUNCH 1
#endif

typedef unsigned short bf16_t;
typedef short bf16x8 __attribute__((ext_vector_type(8)));
typedef float f32x4 __attribute__((ext_vector_type(4)));
typedef unsigned u32x4 __attribute__((ext_vector_type(4)));
typedef unsigned u32x2 __attribute__((ext_vector_type(2)));

constexpr int NTOK = 12288, NPR = 8192, NKEY = 14336;
constexpr float EPSN = 1e-6f;

constexpr size_t O_WIN   = 0;
constexpr size_t O_WQ    = O_WIN   + (size_t)2 * 6912 * 1024 * 2;
constexpr size_t O_WKV   = O_WQ    + (size_t)2 * 768 * 384 * 2;
constexpr size_t O_WBR   = O_WKV   + (size_t)2 * 1024 * 256 * 2;
constexpr size_t O_WO    = O_WBR   + (size_t)6 * 1024 * 512 * 2;
constexpr size_t O_CS    = O_WO    + (size_t)2 * 1024 * 1024 * 2;
constexpr size_t O_D256  = O_CS    + (size_t)256 * 128 * 2;
constexpr size_t O_D1024 = O_D256  + (size_t)256 * 512 * 2;
constexpr size_t O_S0T   = O_D1024 + (size_t)1024 * 2048 * 2;
constexpr size_t O_MOD   = O_S0T   + (size_t)64 * 128 * 64 * 2;
constexpr size_t O_H     = O_MOD   + (size_t)2 * 5 * 3072 * 4;
constexpr size_t O_UT    = O_H     + (size_t)NTOK * 1024 * 2;
constexpr size_t O_RQ    = O_UT    + (size_t)NTOK * 1024 * 2;
constexpr size_t O_RK    = O_RQ    + (size_t)NTOK * 256 * 2;
constexpr size_t O_RKT   = O_RK    + (size_t)NTOK * 256 * 2;
constexpr size_t O_RVT   = O_RKT   + (size_t)NPR * 256 * 2;
constexpr size_t O_KVLAT = O_RVT   + (size_t)NTOK * 512 * 2;
constexpr size_t O_KR    = O_KVLAT + (size_t)NTOK * 256 * 4;
constexpr size_t O_R2END = O_KR    + (size_t)NTOK * 32 * 4;
constexpr size_t O_QB    = O_RQ;
constexpr size_t O_VT    = O_QB    + (size_t)NTOK * 768 * 2;
static_assert(O_VT + (size_t)NKEY * 512 * 2 <= O_R2END, "alias overflow");
constexpr size_t O_RZ    = O_R2END;
constexpr size_t O_MZ    = O_RZ    + (size_t)NTOK * 512 * 2;
constexpr size_t O_FZ    = O_MZ    + (size_t)NTOK * 512 * 2;
constexpr size_t O_FU    = O_FZ    + (size_t)NTOK * 512 * 2;
constexpr size_t O_QLAT  = O_FU    + (size_t)NTOK * 512 * 2;
constexpr size_t O_CKVA  = O_QLAT  + (size_t)NTOK * 384 * 2;
constexpr size_t O_KB    = O_CKVA  + (size_t)NKEY * 256 * 2;
constexpr size_t O_KRA   = O_KB    + (size_t)NKEY * 512 * 2;
constexpr size_t O_END   = O_KRA   + (size_t)NKEY * 32 * 2;
constexpr size_t O_BAR   = (O_END + 255) & ~(size_t)255;
static_assert(O_BAR + 16384 <= (size_t)256 * 1024 * 1024, "workspace too large");

constexpr size_t OUT_CKV = (size_t)NTOK * 1024;
constexpr size_t OUT_KR  = OUT_CKV + (size_t)32 * 2 * 256 * 256;
constexpr size_t OUT_RET = OUT_KR + (size_t)32 * 2 * 256 * 32;

struct Params {
  const float *x_prompt, *x_sample, *cache_ckv, *cache_krope, *state_ret, *c, *c_ctx, *norm_g, *w_mod, *b_mod,
      *w_in, *ret_logit, *q_norm_g, *w_q_up, *kv_norm_g, *w_kv_up, *w_branch, *w_out, *final_g;
  float* out;
  char* ws;
};

constexpr int PANEL = 128 * 64;
constexpr int ABYTES = 2 * PANEL;
constexpr int STAGE = 2 * ABYTES;
constexpr int LDS_GEMM = 2 * STAGE;
constexpr int LDS_TOTAL = LDS_GEMM;
static_assert(LDS_TOTAL <= 65536, "static LDS");

typedef float f32x2 __attribute__((ext_vector_type(2)));
typedef __bf16 bf16x2v __attribute__((ext_vector_type(2)));
__device__ __forceinline__ unsigned pk2(float lo, float hi) { const f32x2 v = {lo, hi}; return __builtin_bit_cast(unsigned, __builtin_convertvector(v, bf16x2v)); }
__device__ __forceinline__ bf16_t tobf(float x) { return (bf16_t)(pk2(x, 0.f) & 0xffffu); }
__device__ __forceinline__ float bflo(unsigned u) { return __uint_as_float(u << 16); }
__device__ __forceinline__ float bfhi(unsigned u) { return __uint_as_float(u & 0xffff0000u); }
__device__ __forceinline__ float silu_f(float x) { return x / (1.f + __expf(-x)); }
__device__ __forceinline__ float sigm_f(float x) { return 1.f / (1.f + __expf(-x)); }
__device__ __forceinline__ u32x2 pk4(f32x4 v) { u32x2 r; r.x = pk2(v[0], v[1]); r.y = pk2(v[2], v[3]); return r; }
__device__ __forceinline__ int tidx() { int t = threadIdx.x; asm volatile("" : "+v"(t)); return t; }
__device__ __forceinline__ char* wsp(const char* w) { unsigned long long v = (unsigned long long)w; asm volatile("" : "+s"(v)); return (char*)v; }
__device__ __forceinline__ int swz(int r) { return (0 - ((r >> 2) & 3)) & 3; }
__device__ __forceinline__ float wave_sum(float v) {
#pragma unroll
  for (int o = 1; o < 64; o <<= 1) v += __shfl_xor(v, o);
  return v;
}
__device__ __forceinline__ f32x4 mfma16(bf16x8 a, bf16x8 b, f32x4 c) { return __builtin_amdgcn_mfma_f32_16x16x32_bf16(a, b, c, 0, 0, 0); }
__device__ __forceinline__ bf16x8 as_bf8(u32x4 v) { return __builtin_bit_cast(bf16x8, v); }

__device__ __forceinline__ void zero_acc(f32x4 (&acc)[4][4]) {
#pragma unroll
  for (int i = 0; i < 4; ++i)
#pragma unroll
    for (int j = 0; j < 4; ++j) acc[i][j] = (f32x4){0.f, 0.f, 0.f, 0.f};
}

template <bool SWAP, int NJ = 4>
__device__ __forceinline__ void gemm_core(const bf16_t* __restrict__ A, int lda, const bf16_t* __restrict__ B, int ldb, int K,
                                          f32x4 (&acc)[4][NJ], char* lds) {
  const int tid = tidx(), lane = tid & 63, wid = tid >> 6, wm = wid >> 1, wn = wid & 1;
  const int srow = tid >> 3, sc = tid & 7;
  const int soff = (sc >> 2) * PANEL + srow * 64 + (((sc & 3) ^ swz(srow)) << 4);
  const bf16_t* gA = A + (size_t)srow * lda + sc * 8;
  const bf16_t* gB = B + (size_t)srow * ldb + sc * 8;
  const int fr = lane & 15, fq = lane >> 4;
  const int fa = (wm * 64 + fr) * 64 + ((fq ^ swz(fr)) << 4);
  const int fb = ABYTES + (wn * NJ * 16 + fr) * 64 + ((fq ^ swz(fr)) << 4);
  u32x4 ra[4], rb[NJ];
  const int nk = K >> 6;
#pragma unroll
  for (int i = 0; i < 4; ++i) ra[i] = *(const u32x4*)(gA + (size_t)(32 * i) * lda);
#pragma unroll
  for (int i = 0; i < NJ; ++i) rb[i] = *(const u32x4*)(gB + (size_t)(32 * i) * ldb);
#pragma unroll
  for (int i = 0; i < 4; ++i) *(u32x4*)(lds + soff + i * 2048) = ra[i];
#pragma unroll
  for (int i = 0; i < NJ; ++i) *(u32x4*)(lds + ABYTES + soff + i * 2048) = rb[i];
  __syncthreads();
  for (int kt = 0; kt < nk; ++kt) {
    char* cur = lds + (kt & 1) * STAGE;
    const bool more = (kt + 1) < nk;
    if (more) {
      const int k0 = (kt + 1) << 6;
#pragma unroll
      for (int i = 0; i < 4; ++i) ra[i] = *(const u32x4*)(gA + (size_t)(32 * i) * lda + k0);
#pragma unroll
      for (int i = 0; i < NJ; ++i) rb[i] = *(const u32x4*)(gB + (size_t)(32 * i) * ldb + k0);
    }
#pragma unroll
    for (int ks = 0; ks < 2; ++ks) {
      bf16x8 af[4], bfr[NJ];
#pragma unroll
      for (int i = 0; i < 4; ++i) af[i] = *(const bf16x8*)(cur + ks * PANEL + fa + i * 1024);
#pragma unroll
      for (int j = 0; j < NJ; ++j) bfr[j] = *(const bf16x8*)(cur + ks * PANEL + fb + j * 1024);
#pragma unroll
      for (int i = 0; i < 4; ++i)
#pragma unroll
        for (int j = 0; j < NJ; ++j) acc[i][j] = SWAP ? mfma16(bfr[j], af[i], acc[i][j]) : mfma16(af[i], bfr[j], acc[i][j]);
    }
    if (more) {
      char* nx = lds + ((kt + 1) & 1) * STAGE;
#pragma unroll
      for (int i = 0; i < 4; ++i) *(u32x4*)(nx + soff + i * 2048) = ra[i];
#pragma unroll
      for (int i = 0; i < NJ; ++i) *(u32x4*)(nx + ABYTES + soff + i * 2048) = rb[i];
    }
    __syncthreads();
  }
}

__device__ __forceinline__ void tr_tile(const float* __restrict__ src, int lds_, int k0, int ns0, bf16_t* __restrict__ dst, int ldd, int nd0,
                                        const float* __restrict__ ksc, char* lds) {
  bf16_t* T = (bf16_t*)lds;
  const int tid = tidx();
  __syncthreads();
#pragma unroll
  for (int i = 0; i < 2; ++i) {
    const int kk = (tid >> 3) + 32 * i, nn4 = (tid & 7) * 4;
    const f32x4 v = *(const f32x4*)(src + (size_t)(k0 + kk) * lds_ + ns0 + nn4);
    const float s = ksc ? ksc[k0 + kk] : 1.f;
#pragma unroll
    for (int e = 0; e < 4; ++e) T[(nn4 + e) * 72 + kk] = tobf(v[e] * s);
  }
  __syncthreads();
  const int nn = tid >> 3, kc = (tid & 7) * 8;
  const u32x4 w = *(const u32x4*)(T + nn * 72 + kc);
  *(u32x4*)(dst + (size_t)(nd0 + nn) * ldd + k0 + kc) = w;
}

constexpr int P0_GEMV = 96, P0_WIN = 6816, P0_WQ = 288, P0_WKV = 256, P0_WBR = 1536, P0_WO = 1024, P0_S0 = 256, P0_PAD = 96, P0_TAB = 1104;
constexpr int P0_N = P0_GEMV + P0_WIN + P0_WQ + P0_WKV + P0_WBR + P0_WO + P0_S0 + P0_PAD + P0_TAB;

__device__ __forceinline__ void phase0_item(const Params& p, int j, char* lds) {
  const int tid = tidx();
  char* ws = wsp(p.ws);
  if (j < P0_GEMV) {
    const int l = j / 48, cgi = j % 48;
    float* sv = (float*)lds;
    float* red = (float*)(lds + 20480);
    __syncthreads();
    for (int i = tid; i < 5120; i += 256) { const int v = i >> 10, k = i & 1023; const float x = (v == 0) ? p.c_ctx[k] : p.c[(v - 1) * 1024 + k]; sv[i] = silu_f(x); }
    __syncthreads();
    const int cc = tid & 63, kg = tid >> 6;
    const float* w = p.w_mod + (size_t)l * 1024 * 3072 + cgi * 64 + cc;
    float a0 = 0.f, a1 = 0.f, a2 = 0.f, a3 = 0.f, a4 = 0.f;
#pragma unroll 8
    for (int k = kg * 256; k < kg * 256 + 256; ++k) {
      const float wv = w[(size_t)k * 3072];
      a0 += sv[k] * wv; a1 += sv[1024 + k] * wv; a2 += sv[2048 + k] * wv; a3 += sv[3072 + k] * wv; a4 += sv[4096 + k] * wv;
    }
    red[(kg * 5 + 0) * 64 + cc] = a0; red[(kg * 5 + 1) * 64 + cc] = a1; red[(kg * 5 + 2) * 64 + cc] = a2; red[(kg * 5 + 3) * 64 + cc] = a3; red[(kg * 5 + 4) * 64 + cc] = a4;
    __syncthreads();
    for (int o = tid; o < 320; o += 256) {
      const int v = o >> 6, c2 = o & 63;
      float s = p.b_mod[l * 3072 + cgi * 64 + c2];
#pragma unroll
      for (int g = 0; g < 4; ++g) s += red[(g * 5 + v) * 64 + c2];
      ((float*)(ws + O_MOD))[(l * 5 + v) * 3072 + cgi * 64 + c2] = s;
    }
    return;
  }
  j -= P0_GEMV;
  if (j < P0_WIN) {
    const int l = j / 3408, r = j % 3408, kt = r / 213, nt = r % 213, c0 = nt * 32;
    const int nd0 = c0 < 2176 ? c0 : (c0 < 2208 ? 3712 + (c0 - 2176) : (c0 < 3744 ? c0 - 32 : c0 + 96));
    tr_tile(p.w_in + (size_t)l * 1024 * 6816, 6816, kt * 64, c0, (bf16_t*)(ws + O_WIN) + (size_t)l * 6912 * 1024, 1024, nd0, nullptr, lds);
    return;
  }
  j -= P0_WIN;
  if (j < P0_WQ) {
    const int l = j / 144, r = j % 144, kt = r / 24, nt = r % 24;
    tr_tile(p.w_q_up + (size_t)l * 384 * 768, 768, kt * 64, nt * 32, (bf16_t*)(ws + O_WQ) + (size_t)l * 768 * 384, 384, nt * 32, p.q_norm_g + l * 384, lds);
    return;
  }
  j -= P0_WQ;
  if (j < P0_WKV) {
    const int l = j / 128, r = j % 128, kt = r / 32, nt = r % 32, c0 = nt * 32, h = c0 >> 7, e = c0 & 127;
    const int nd0 = e < 64 ? h * 64 + e : 512 + h * 64 + (e - 64);
    tr_tile(p.w_kv_up + (size_t)l * 256 * 1024, 1024, kt * 64, c0, (bf16_t*)(ws + O_WKV) + (size_t)l * 1024 * 256, 256, nd0, nullptr, lds);
    return;
  }
  j -= P0_WKV;
  if (j < P0_WBR) {
    const int mat = j / 256, r = j % 256, kt = r / 32, nt = r % 32;
    tr_tile(p.w_branch + (size_t)mat * 512 * 1024, 1024, kt * 64, nt * 32, (bf16_t*)(ws + O_WBR) + (size_t)mat * 1024 * 512, 512, nt * 32, nullptr, lds);
    return;
  }
  j -= P0_WBR;
  if (j < P0_WO) {
    const int l = j / 512, r = j % 512, kt = r / 32, nt = r % 32;
    tr_tile(p.w_out + (size_t)l * 1024 * 1024, 1024, kt * 64, nt * 32, (bf16_t*)(ws + O_WO) + (size_t)l * 1024 * 1024, 1024, nt * 32, nullptr, lds);
    return;
  }
  j -= P0_WO;
  if (j < P0_S0) {
    const int mat = j >> 2, nt = j & 3;
    tr_tile(p.state_ret + (size_t)mat * 64 * 128, 128, 0, nt * 32, (bf16_t*)(ws + O_S0T) + (size_t)mat * 128 * 64, 64, nt * 32, nullptr, lds);
    return;
  }
  j -= P0_S0;
  if (j < P0_PAD) {
    const int l = j / 48, r = j % 48;
    bf16_t* d = (bf16_t*)(ws + O_WIN) + ((size_t)l * 6912 + 3744) * 1024 + (size_t)r * 2048 + tid * 8;
    *(u32x4*)d = (u32x4){0u, 0u, 0u, 0u};
    return;
  }
  j -= P0_PAD;
  {
    float v[8];
    bf16_t* dst;
    if (j < 16) {
      const int e0 = j * 2048 + tid * 8; dst = (bf16_t*)(ws + O_CS) + e0;
      const int n = e0 >> 7, k = e0 & 127;
#pragma unroll
      for (int e = 0; e < 8; ++e) {
        const float fr = (float)(((n & 127) * (k + e)) & 127) * (1.f / 128.f);
        v[e] = (n < 128) ? __builtin_amdgcn_cosf(fr) : __builtin_amdgcn_sinf(fr);
      }
    } else if (j < 80) {
      const int e0 = (j - 16) * 2048 + tid * 8; dst = (bf16_t*)(ws + O_D256) + e0;
      const int k1 = e0 >> 9, kk = e0 & 511;
#pragma unroll
      for (int e = 0; e < 8; ++e) {
        const int t = (kk + e) & 255;
        const float fr = (float)((k1 * t) & 255) * (1.f / 256.f);
        v[e] = (kk < 256) ? __builtin_amdgcn_cosf(fr) : -__builtin_amdgcn_sinf(fr);
      }
    } else {
      const int e0 = (j - 80) * 2048 + tid * 8; dst = (bf16_t*)(ws + O_D1024) + e0;
      const int k1 = e0 >> 11, kk = e0 & 2047;
#pragma unroll
      for (int e = 0; e < 8; ++e) {
        const int t = (kk + e) & 1023;
        const float fr = (float)((k1 * t) & 1023) * (1.f / 1024.f);
        v[e] = (kk < 1024) ? __builtin_amdgcn_cosf(fr) : -__builtin_amdgcn_sinf(fr);
      }
    }
    u32x4 w; w.x = pk2(v[0], v[1]); w.y = pk2(v[2], v[3]); w.z = pk2(v[4], v[5]); w.w = pk2(v[6], v[7]);
    *(u32x4*)dst = w;
  }
}

__device__ __forceinline__ void norm_item(const Params& p, int l, int item, const float* xp, const float* xs) {
  const int tid = tidx(), lane = tid & 63, wid = tid >> 6;
  bf16_t* H = (bf16_t*)(p.ws + O_H);
#pragma unroll 1
  for (int i = 0; i < 4; ++i) {
    const int row = item * 16 + wid * 4 + i;
    const float* src = row < NPR ? xp + (size_t)row * 1024 : xs + (size_t)(row - NPR) * 1024;
    const int v = row < NPR ? 0 : 1 + ((row - NPR) >> 10);
    const float* mod = (const float*)(p.ws + O_MOD) + (l * 5 + v) * 3072;
    f32x4 x[4]; float ss = 0.f;
#pragma unroll
    for (int q = 0; q < 4; ++q) { x[q] = *(const f32x4*)(src + (q * 64 + lane) * 4); ss += x[q][0] * x[q][0] + x[q][1] * x[q][1] + x[q][2] * x[q][2] + x[q][3] * x[q][3]; }
    ss = wave_sum(ss);
    const float rstd = rsqrtf(ss * (1.f / 1024.f) + EPSN);
#pragma unroll
    for (int q = 0; q < 4; ++q) {
      const int col = (q * 64 + lane) * 4;
      const f32x4 g = *(const f32x4*)(p.norm_g + l * 1024 + col), sc = *(const f32x4*)(mod + 1024 + col), sh = *(const f32x4*)(mod + col);
      f32x4 h;
#pragma unroll
      for (int e = 0; e < 4; ++e) h[e] = x[q][e] * rstd * g[e] * (1.f + sc[e]) + sh[e];
      *(u32x2*)(H + (size_t)row * 1024 + col) = pk4(h);
    }
  }
}
__device__ __forceinline__ void final_item(const Params& p, int item) {
  const int tid = tidx(), lane = tid & 63, wid = tid >> 6;
#pragma unroll 1
  for (int i = 0; i < 4; ++i) {
    const int row = item * 16 + wid * 4 + i;
    float* src = p.out + (size_t)row * 1024;
    f32x4 x[4]; float ss = 0.f;
#pragma unroll
    for (int q = 0; q < 4; ++q) { x[q] = *(const f32x4*)(src + (q * 64 + lane) * 4); ss += x[q][0] * x[q][0] + x[q][1] * x[q][1] + x[q][2] * x[q][2] + x[q][3] * x[q][3]; }
    ss = wave_sum(ss);
    const float rstd = rsqrtf(ss * (1.f / 1024.f) + EPSN);
#pragma unroll
    for (int q = 0; q < 4; ++q) {
      const int col = (q * 64 + lane) * 4;
      const f32x4 g = *(const f32x4*)(p.final_g + col);
      f32x4 y;
#pragma unroll
      for (int e = 0; e < 4; ++e) y[e] = x[q][e] * rstd * g[e];
      *(f32x4*)(src + col) = y;
    }
  }
}

__device__ __forceinline__ void s2_tile(const Params& p, int l, int tile, char* lds) {
  const int tid = tidx(), lane = tid & 63, wid = tid >> 6, wm = wid >> 1, wn = wid & 1, fr = lane & 15, fq = lane >> 4;
  const int m = tile % 96, nt = tile / 96, m0 = m * 128, n0 = nt * 128;
  char* ws = wsp(p.ws);
  const bf16_t* A = (const bf16_t*)(ws + O_H) + (size_t)m0 * 1024;
  const bf16_t* B = (const bf16_t*)(ws + O_WIN) + ((size_t)l * 6912 + n0) * 1024;
  f32x4 acc[4][4];
  zero_acc(acc);
  if (nt >= 4 && nt < 8) {
    gemm_core<false>(A, 1024, B, 1024, 1024, acc, lds);
    bf16_t* RVT = (bf16_t*)(ws + O_RVT);
#pragma unroll
    for (int i = 0; i < 4; ++i) {
      const int tok = m0 + wm * 64 + i * 16 + fq * 4;
      size_t base; int T, b, t;
      if (tok < NPR) { b = tok >> 8; t = tok & 255; T = 256; base = 0; } else { const int s = tok - NPR; b = s >> 10; t = s & 1023; T = 1024; base = (size_t)NPR * 512; }
#pragma unroll
      for (int j = 0; j < 4; ++j) {
        const int c = n0 - 512 + wn * 64 + j * 16 + fr, h = c >> 7, vd = c & 127;
        *(u32x2*)(RVT + base + ((size_t)(b * 4 + h) * 128 + vd) * T + t) = pk4(acc[i][j]);
      }
    }
    return;
  }
  gemm_core<true>(A, 1024, B, 1024, 1024, acc, lds);
  bf16_t* dst = nullptr; int ld = 0, c0 = 0, op = 0;
  if (nt < 2) { dst = (bf16_t*)(ws + O_RQ); ld = 256; c0 = 0; }
  else if (nt < 4) { dst = (bf16_t*)(ws + O_RK); ld = 256; c0 = 256; op = 2; }
  else if (nt < 12) { dst = (bf16_t*)(ws + O_RZ); ld = 512; c0 = 1024; op = 1; }
  else if (nt < 15) { dst = (bf16_t*)(ws + O_QLAT); ld = 384; c0 = 1536; }
  else if (nt < 17) { ld = 256; c0 = 1920; op = 3; }
  else if (nt < 21) { dst = (bf16_t*)(ws + O_MZ); ld = 512; c0 = 2176; op = 1; }
  else if (nt < 25) { dst = (bf16_t*)(ws + O_FU); ld = 512; c0 = 2688; }
  else if (nt < 29) { dst = (bf16_t*)(ws + O_FZ); ld = 512; c0 = 3200; op = 1; }
  else { ld = 32; c0 = 3712; op = 4; }
#pragma unroll
  for (int i = 0; i < 4; ++i) {
    const int tok = m0 + wm * 64 + i * 16 + fr;
#pragma unroll
    for (int j = 0; j < 4; ++j) {
      const int col = n0 - c0 + wn * 64 + j * 16 + fq * 4;
      f32x4 v = acc[i][j];
      if (op == 3) { *(f32x4*)((float*)(ws + O_KVLAT) + (size_t)tok * 256 + col) = v; continue; }
      if (op == 4) { if (col < 32) *(f32x4*)((float*)(ws + O_KR) + (size_t)tok * 32 + col) = v; continue; }
      if (op == 1) {
#pragma unroll
        for (int e = 0; e < 4; ++e) v[e] = silu_f(v[e]);
      } else if (op == 2) {
#pragma unroll
        for (int e = 0; e < 4; ++e) v[e] *= 0.125f;
      }
      const u32x2 w = pk4(v);
      *(u32x2*)(dst + (size_t)tok * ld + col) = w;
      if (op == 2 && tok < NPR) {
        bf16_t* RKT = (bf16_t*)(ws + O_RKT);
        const int b = tok >> 8, t = tok & 255, h = col >> 6, dk = col & 63;
        bf16_t* q = RKT + ((size_t)(b * 4 + h) * 64 + dk) * 256 + t;
        q[0] = (bf16_t)(w.x & 0xffffu); q[256] = (bf16_t)(w.x >> 16); q[512] = (bf16_t)(w.y & 0xffffu); q[768] = (bf16_t)(w.y >> 16);
      }
    }
  }
}

template <int MODE>
__device__ __forceinline__ void attn_item(const Params& p, int l, int item, char* lds) {
  constexpr int NKP = MODE == 0 ? 3 : 2;
  constexpr int NVB = MODE == 0 ? 4 : 8;
  constexpr int PV = NVB * 16 * 64;
  constexpr int KOFF = NKP * 4096;
  constexpr int BUF = KOFF + 2 * PV;
  const int tid = tidx(), lane = tid & 63, wid = tid >> 6, fr = lane & 15, fq = lane >> 4;
  char* ws = wsp(p.ws);
  int smp, b, h, qblk, T, Tk, tok0;
  const bf16_t *kbase, *rbase = nullptr, *vbase, *qbase;
  int kstride, qstride;
  if (MODE == 0) {
    if (item < 256) { smp = 1; b = item >> 6; h = (item >> 3) & 7; qblk = item & 7; T = 1024; Tk = 1536; tok0 = NPR + b * 1024 + qblk * 128; }
    else { const int it = item - 256; smp = 0; b = it >> 4; h = (it >> 1) & 7; qblk = it & 1; T = 256; Tk = 256; tok0 = b * 256 + qblk * 128; }
    const int keyrow0 = smp ? NPR + b * 1536 : b * 256;
    kbase = (const bf16_t*)(ws + O_KB) + (size_t)keyrow0 * 512 + h * 64; kstride = 512;
    rbase = (const bf16_t*)(ws + O_KRA) + (size_t)keyrow0 * 32;
    vbase = (const bf16_t*)(ws + O_VT) + (smp ? (size_t)NPR * 512 + (size_t)(b * 8 + h) * 64 * 1536 : (size_t)(b * 8 + h) * 64 * 256);
    qbase = (const bf16_t*)(ws + O_QB) + (size_t)tok0 * 768 + h * 96; qstride = 768;
  } else {
    if (item < 128) { smp = 1; b = item >> 5; h = (item >> 3) & 3; qblk = item & 7; T = 1024; tok0 = NPR + b * 1024 + qblk * 128; }
    else { const int it = item - 128; smp = 0; b = it >> 3; h = (it >> 1) & 3; qblk = it & 1; T = 256; tok0 = b * 256 + qblk * 128; }
    Tk = T;
    const int ktok0 = smp ? NPR + b * 1024 : b * 256;
    kbase = (const bf16_t*)(ws + O_RK) + (size_t)ktok0 * 256 + h * 64; kstride = 256;
    vbase = (const bf16_t*)(ws + O_RVT) + (smp ? (size_t)NPR * 512 + (size_t)(b * 4 + h) * 128 * 1024 : (size_t)(b * 4 + h) * 128 * 256);
    qbase = (const bf16_t*)(ws + O_RQ) + (size_t)tok0 * 256 + h * 64; qstride = 256;
  }
  const int nkt = Tk >> 6;
  bf16x8 qf[2][NKP];
#pragma unroll
  for (int qb = 0; qb < 2; ++qb)
#pragma unroll
    for (int ks = 0; ks < NKP; ++ks) qf[qb][ks] = *(const bf16x8*)(qbase + (size_t)(wid * 32 + qb * 16 + fr) * qstride + ks * 32 + fq * 8);
  f32x4 o[NVB][2];
#pragma unroll
  for (int vb = 0; vb < NVB; ++vb) { o[vb][0] = (f32x4){0.f, 0.f, 0.f, 0.f}; o[vb][1] = (f32x4){0.f, 0.f, 0.f, 0.f}; }
  float lgf = 0.f, lgb = 0.f;
  float mrow[2] = {-INFINITY, -INFINITY}, lrow[2] = {0.f, 0.f};
  const int tq0 = qblk * 128 + wid * 32 + fr;
  if (MODE == 1) {
    const float xf = p.ret_logit[(l * 2 + 0) * 4 + h], xb = p.ret_logit[(l * 2 + 1) * 4 + h];
    lgf = -log1pf(expf(-xf)) * 1.44269504089f; lgb = -log1pf(expf(-xb)) * 1.44269504089f;
    if (smp) {
      const bf16_t* s0 = (const bf16_t*)(ws + O_S0T);
#pragma unroll
      for (int dir = 0; dir < 2; ++dir) {
        const bf16_t* sb = s0 + ((size_t)(((b * 2 + l) * 2 + dir) * 4 + h) * 128) * 64;
        float dec[2];
#pragma unroll
        for (int qb = 0; qb < 2; ++qb) { const int tq = tq0 + qb * 16; dec[qb] = dir == 0 ? exp2f((float)(tq + 1) * lgf) : exp2f((float)(T - tq) * lgb); }
#pragma unroll
        for (int vb = 0; vb < NVB; ++vb) {
          f32x4 t0 = (f32x4){0.f, 0.f, 0.f, 0.f}, t1 = (f32x4){0.f, 0.f, 0.f, 0.f};
#pragma unroll
          for (int ks = 0; ks < 2; ++ks) {
            const bf16x8 sf = *(const bf16x8*)(sb + (size_t)(vb * 16 + fr) * 64 + ks * 32 + fq * 8);
            t0 = mfma16(sf, qf[0][ks], t0); t1 = mfma16(sf, qf[1][ks], t1);
          }
          o[vb][0] += t0 * dec[0]; o[vb][1] += t1 * dec[1];
        }
      }
    }
  }
  u32x4 kreg[2], rreg, vreg[NVB / 2];
  auto gload = [&](int kt) {
#pragma unroll
    for (int i = 0; i < 2; ++i) { const int idx = tid + 256 * i, key = idx >> 3, c = idx & 7; kreg[i] = *(const u32x4*)(kbase + (size_t)(kt * 64 + key) * kstride + c * 8); }
    if (MODE == 0) { const int key = tid >> 2, c = tid & 3; rreg = *(const u32x4*)(rbase + (size_t)(kt * 64 + key) * 32 + c * 8); }
#pragma unroll
    for (int i = 0; i < NVB / 2; ++i) { const int idx = tid + 256 * i, vd = idx >> 3, g = idx & 7; vreg[i] = *(const u32x4*)(vbase + (size_t)vd * Tk + kt * 64 + g * 8); }
  };
  auto lstore = [&](char* buf) {
#pragma unroll
    for (int i = 0; i < 2; ++i) { const int idx = tid + 256 * i, key = idx >> 3, c = idx & 7; *(u32x4*)(buf + (c >> 2) * 4096 + key * 64 + (((c & 3) ^ swz(key)) << 4)) = kreg[i]; }
    if (MODE == 0) { const int key = tid >> 2, c = tid & 3; *(u32x4*)(buf + 2 * 4096 + key * 64 + ((c ^ swz(key)) << 4)) = rreg; }
#pragma unroll
    for (int i = 0; i < NVB / 2; ++i) {
      const int idx = tid + 256 * i, vd = idx >> 3, g = idx & 7, pnl = g >> 2, g4 = g & 3, hi = g4 >> 1, q0 = 2 * (g4 & 1);
      char* base = buf + KOFF + pnl * PV + vd * 64 + hi * 8;
      *(u32x2*)(base + ((q0 ^ swz(vd)) << 4)) = (u32x2){vreg[i].x, vreg[i].y};
      *(u32x2*)(base + (((q0 + 1) ^ swz(vd)) << 4)) = (u32x2){vreg[i].z, vreg[i].w};
    }
  };
  __syncthreads();
  gload(0); lstore(lds);
  __syncthreads();
  const int foff = fr * 64 + ((fq ^ swz(fr)) << 4);
  for (int kt = 0; kt < nkt; ++kt) {
    char* cur = lds + (kt & 1) * BUF;
    const bool more = (kt + 1) < nkt;
    if (more) gload(kt + 1);
    f32x4 s[4][2];
#pragma unroll
    for (int kb = 0; kb < 4; ++kb) {
      s[kb][0] = (f32x4){0.f, 0.f, 0.f, 0.f}; s[kb][1] = (f32x4){0.f, 0.f, 0.f, 0.f};
#pragma unroll
      for (int ks = 0; ks < NKP; ++ks) {
        const bf16x8 kf = *(const bf16x8*)(cur + ks * 4096 + kb * 1024 + foff);
        s[kb][0] = mfma16(kf, qf[0][ks], s[kb][0]); s[kb][1] = mfma16(kf, qf[1][ks], s[kb][1]);
      }
    }
    bf16x8 pf[2][2];
#pragma unroll
    for (int qb = 0; qb < 2; ++qb) {
      if (MODE == 0) {
        float mx = s[0][qb][0];
#pragma unroll
        for (int kb = 0; kb < 4; ++kb)
#pragma unroll
          for (int r = 0; r < 4; ++r) mx = fmaxf(mx, s[kb][qb][r]);
        mx = fmaxf(mx, __shfl_xor(mx, 16)); mx = fmaxf(mx, __shfl_xor(mx, 32));
        const float mn = fmaxf(mrow[qb], mx), alpha = exp2f(mrow[qb] - mn);
        mrow[qb] = mn;
        float ls = 0.f;
#pragma unroll
        for (int kb = 0; kb < 4; ++kb)
#pragma unroll
          for (int r = 0; r < 4; ++r) { const float e = exp2f(s[kb][qb][r] - mn); s[kb][qb][r] = e; ls += e; }
        lrow[qb] = lrow[qb] * alpha + ls;
#pragma unroll
        for (int vb = 0; vb < NVB; ++vb) o[vb][qb] *= alpha;
      } else {
        const int tq = tq0 + qb * 16;
#pragma unroll
        for (int kb = 0; kb < 4; ++kb)
#pragma unroll
          for (int r = 0; r < 4; ++r) {
            const int d = tq - (kt * 64 + kb * 16 + fq * 4 + r);
            const float dec = d > 0 ? exp2f((float)d * lgf) : (d < 0 ? exp2f((float)(-d) * lgb) : 2.f);
            s[kb][qb][r] *= dec;
          }
      }
#pragma unroll
      for (int g = 0; g < 2; ++g) {
        u32x4 w; w.x = pk2(s[2 * g][qb][0], s[2 * g][qb][1]); w.y = pk2(s[2 * g][qb][2], s[2 * g][qb][3]);
        w.z = pk2(s[2 * g + 1][qb][0], s[2 * g + 1][qb][1]); w.w = pk2(s[2 * g + 1][qb][2], s[2 * g + 1][qb][3]);
        pf[qb][g] = as_bf8(w);
      }
    }
#pragma unroll
    for (int vb = 0; vb < NVB; ++vb)
#pragma unroll
      for (int g = 0; g < 2; ++g) {
        const bf16x8 vf = *(const bf16x8*)(cur + KOFF + g * PV + vb * 1024 + foff);
        o[vb][0] = mfma16(vf, pf[0][g], o[vb][0]); o[vb][1] = mfma16(vf, pf[1][g], o[vb][1]);
      }
    if (more) lstore(lds + ((kt + 1) & 1) * BUF);
    __syncthreads();
  }
  bf16_t* G = (bf16_t*)(ws + (MODE == 0 ? O_MZ : O_RZ));
#pragma unroll
  for (int qb = 0; qb < 2; ++qb) {
    const int tok = tok0 + wid * 32 + qb * 16 + fr;
    float mul, sub;
    if (MODE == 0) {
      float lt = lrow[qb]; lt += __shfl_xor(lt, 16); lt += __shfl_xor(lt, 32);
      mul = 1.f / lt; sub = 0.f;
    } else {
      float sm = 0.f;
#pragma unroll
      for (int vb = 0; vb < NVB; ++vb) sm += (o[vb][qb][0] + o[vb][qb][1]) + (o[vb][qb][2] + o[vb][qb][3]);
      sm += __shfl_xor(sm, 16); sm += __shfl_xor(sm, 32);
      const float mu = sm * (1.f / 128.f);
      float vs = 0.f;
#pragma unroll
      for (int vb = 0; vb < NVB; ++vb)
#pragma unroll
        for (int r = 0; r < 4; ++r) { const float dd = o[vb][qb][r] - mu; vs += dd * dd; }
      vs += __shfl_xor(vs, 16); vs += __shfl_xor(vs, 32);
      mul = rsqrtf(vs * (1.f / 128.f) + EPSN); sub = mu;
    }
#pragma unroll
    for (int vb = 0; vb < NVB; ++vb) {
      bf16_t* gp = G + (size_t)tok * 512 + h * (NVB * 16) + vb * 16 + fq * 4;
      const u32x2 gz = *(const u32x2*)gp;
      f32x4 y;
      y[0] = (o[vb][qb][0] - sub) * mul * bflo(gz.x); y[1] = (o[vb][qb][1] - sub) * mul * bfhi(gz.x);
      y[2] = (o[vb][qb][2] - sub) * mul * bflo(gz.y); y[3] = (o[vb][qb][3] - sub) * mul * bfhi(gz.y);
      *(u32x2*)gp = pk4(y);
    }
  }
}

__device__ __forceinline__ bf16x8 scale8(u32x4 raw, const float (&d)[8]) {
  u32x4 w;
  w.x = pk2(bflo(raw.x) * d[0], bfhi(raw.x) * d[1]); w.y = pk2(bflo(raw.y) * d[2], bfhi(raw.y) * d[3]);
  w.z = pk2(bflo(raw.z) * d[4], bfhi(raw.z) * d[5]); w.w = pk2(bflo(raw.w) * d[6], bfhi(raw.w) * d[7]);
  return as_bf8(w);
}
__device__ __forceinline__ void state_item(const Params& p, int l, int item) {
  const int tid = tidx(), lane = tid & 63, wid = tid >> 6, fr = lane & 15, fq = lane >> 4;
  const int b = item >> 2, h = item & 3;
  const bf16_t* RVT = (const bf16_t*)(p.ws + O_RVT) + (size_t)(b * 4 + h) * 128 * 256;
  const bf16_t* RKT = (const bf16_t*)(p.ws + O_RKT) + (size_t)(b * 4 + h) * 64 * 256;
  const float xf = p.ret_logit[(l * 2 + 0) * 4 + h], xb = p.ret_logit[(l * 2 + 1) * 4 + h];
  const float lgf = -log1pf(expf(-xf)) * 1.44269504089f, lgb = -log1pf(expf(-xb)) * 1.44269504089f;
  f32x4 acc[2][2][4];
#pragma unroll
  for (int d = 0; d < 2; ++d)
#pragma unroll
    for (int v = 0; v < 2; ++v)
#pragma unroll
      for (int k = 0; k < 4; ++k) acc[d][v][k] = (f32x4){0.f, 0.f, 0.f, 0.f};
#pragma unroll 1
  for (int ks = 0; ks < 8; ++ks) {
    const int j0 = ks * 32 + fq * 8;
    float df[8], db[8];
#pragma unroll
    for (int e = 0; e < 8; ++e) { df[e] = exp2f((float)(255 - j0 - e) * lgf); db[e] = exp2f((float)(j0 + e) * lgb); }
    bf16x8 af[2];
#pragma unroll
    for (int v = 0; v < 2; ++v) af[v] = *(const bf16x8*)(RVT + (size_t)((wid * 2 + v) * 16 + fr) * 256 + j0);
#pragma unroll
    for (int k = 0; k < 4; ++k) {
      const u32x4 raw = *(const u32x4*)(RKT + (size_t)(k * 16 + fr) * 256 + j0);
      const bf16x8 kf = scale8(raw, df), kb = scale8(raw, db);
#pragma unroll
      for (int v = 0; v < 2; ++v) { acc[0][v][k] = mfma16(af[v], kf, acc[0][v][k]); acc[1][v][k] = mfma16(af[v], kb, acc[1][v][k]); }
    }
  }
  float* O = p.out + OUT_RET;
#pragma unroll
  for (int d = 0; d < 2; ++d)
#pragma unroll
    for (int v = 0; v < 2; ++v)
#pragma unroll
      for (int k = 0; k < 4; ++k) {
        const int dk = k * 16 + fr, vd = (wid * 2 + v) * 16 + fq * 4;
        *(f32x4*)(O + ((size_t)((((b * 2 + l) * 2 + d) * 4 + h) * 64 + dk)) * 128 + vd) = acc[d][v][k];
      }
}

__device__ __forceinline__ void keyprep_item(const Params& p, int l, int item) {
  const int tid = tidx(), lane = tid & 63, wid = tid >> 6;
  char* ws = wsp(p.ws);
  bf16_t* CKVA = (bf16_t*)(ws + O_CKVA);
  bf16_t* KRA = (bf16_t*)(ws + O_KRA);
#pragma unroll 1
  for (int i = 0; i < 16; ++i) {
    const int R = item * 64 + wid * 16 + i;
    int smp = 0, b, t = 0, tok = 0, ctx = 0, pp = 0;
    if (R < NPR) { tok = R; b = R >> 8; t = R & 255; }
    else { smp = 1; const int s = R - NPR; b = s / 1536; pp = s - b * 1536; if (pp < 512) ctx = 1; else { t = pp - 512; tok = NPR + b * 1024 + t; } }
    if (ctx) {
      const f32x4 v = *(const f32x4*)(p.cache_ckv + ((size_t)((b * 2 + l) * 512 + pp)) * 256 + lane * 4);
      *(u32x2*)(CKVA + (size_t)R * 256 + lane * 4) = pk4(v);
      if (lane < 32) KRA[(size_t)R * 32 + lane] = tobf(p.cache_krope[((size_t)((b * 2 + l) * 512 + pp)) * 32 + lane]);
      continue;
    }
    const f32x4 v = *(const f32x4*)((const float*)(ws + O_KVLAT) + (size_t)tok * 256 + lane * 4);
    float ss = v[0] * v[0] + v[1] * v[1] + v[2] * v[2] + v[3] * v[3];
    ss = wave_sum(ss);
    const float rstd = rsqrtf(ss * (1.f / 256.f) + EPSN);
    const f32x4 g = *(const f32x4*)(p.kv_norm_g + l * 256 + lane * 4);
    f32x4 y;
#pragma unroll
    for (int e = 0; e < 4; ++e) y[e] = v[e] * rstd * g[e];
    *(u32x2*)(CKVA + (size_t)R * 256 + lane * 4) = pk4(y);
    if (!smp) *(f32x4*)(p.out + OUT_CKV + ((size_t)((b * 2 + l) * 256 + t)) * 256 + lane * 4) = y;
    const int d = lane & 31;
    const float x = ((const float*)(ws + O_KR))[(size_t)tok * 32 + d];
    float yk = x;
    if (smp) {
      const float pr = __shfl_xor(x, 8);
      const int hd = d >> 4, i16 = d & 15, f = i16 & 7;
      const float pos = (float)(hd ? (t & 63) : (t >> 6));
      const float ang = pos * exp2f(-(float)f * 1.66096404744f);
      const float cs = __cosf(ang), sn = __sinf(ang);
      yk = i16 < 8 ? x * cs - pr * sn : pr * sn + x * cs;
    } else if (lane < 32) {
      p.out[OUT_KR + ((size_t)((b * 2 + l) * 256 + t)) * 32 + d] = x;
    }
    if (lane < 32) KRA[(size_t)R * 32 + d] = tobf(yk);
  }
}

__device__ __forceinline__ void f1_tile(const Params& p, int tile, char* lds) {
  const int tid = tidx(), lane = tid & 63, wid = tid >> 6, wm = wid >> 1, wn = wid & 1, fr = lane & 15, fq = lane >> 4;
  const int m = tile >> 3, g = (tile >> 1) & 3, nh = tile & 1, m0 = m * 128;
  char* ws = wsp(p.ws);
  f32x4 acc[4][4];
  zero_acc(acc);
  gemm_core<false>((const bf16_t*)(ws + O_FU) + (size_t)m0 * 512 + g * 128, 512, (const bf16_t*)(ws + O_CS) + (size_t)nh * 128 * 128, 128, 128, acc, lds);
  bf16_t* UT = (bf16_t*)(ws + O_UT);
#pragma unroll
  for (int i = 0; i < 4; ++i) {
    const int tok = m0 + wm * 64 + i * 16 + fq * 4;
    size_t base; int T, b, t;
    if (tok < NPR) { b = tok >> 8; t = tok & 255; T = 256; base = 0; } else { const int s = tok - NPR; b = s >> 10; t = s & 1023; T = 1024; base = (size_t)NPR * 1024; }
#pragma unroll
    for (int j = 0; j < 4; ++j) {
      const int k2 = wn * 64 + j * 16 + fr;
      *(u32x2*)(UT + base + ((size_t)(b * 4 + g) * 128 + k2) * (2 * T) + nh * T + t) = pk4(acc[i][j]);
    }
  }
}

__device__ __forceinline__ void qup_tile(const Params& p, int l, int tile, char* lds) {
  const int tid = tidx(), lane = tid & 63, wid = tid >> 6, wm = wid >> 1, wn = wid & 1, fr = lane & 15, fq = lane >> 4;
  const int m = tile % 96, nt = tile / 96, m0 = m * 128, n0 = nt * 128;
  char* ws = wsp(p.ws);
  const bf16_t* QL = (const bf16_t*)(ws + O_QLAT) + (size_t)m0 * 384;
  float rsv;
  {
    const bf16_t* q = QL + (size_t)(wm * 64 + lane) * 384;
    float ss = 0.f;
#pragma unroll 4
    for (int i = 0; i < 48; ++i) {
      const u32x4 w = *(const u32x4*)(q + i * 8);
      ss += bflo(w.x) * bflo(w.x) + bfhi(w.x) * bfhi(w.x) + bflo(w.y) * bflo(w.y) + bfhi(w.y) * bfhi(w.y) + bflo(w.z) * bflo(w.z) + bfhi(w.z) * bfhi(w.z) + bflo(w.w) * bflo(w.w) + bfhi(w.w) * bfhi(w.w);
    }
    rsv = rsqrtf(ss * (1.f / 384.f) + EPSN);
  }
  f32x4 acc[4][4];
  zero_acc(acc);
  gemm_core<true>(QL, 384, (const bf16_t*)(ws + O_WQ) + ((size_t)l * 768 + n0) * 384, 384, 384, acc, lds);
  bf16_t* QB = (bf16_t*)(ws + O_QB);
  const float qscale = 0.10206207261596577f * 1.44269504089f;
#pragma unroll
  for (int i = 0; i < 4; ++i) {
    const int rl = wm * 64 + i * 16 + fr, tok = m0 + rl;
    const float sc = __shfl(rsv, i * 16 + fr) * qscale;
    const int smp = tok >= NPR, t = (tok - NPR) & 1023;
#pragma unroll
    for (int j = 0; j < 4; ++j) {
      const int cb = n0 + wn * 64 + j * 16, within = cb % 96;
      f32x4 v = acc[i][j] * sc;
      if (within >= 64) {
        f32x4 pr;
#pragma unroll
        for (int e = 0; e < 4; ++e) pr[e] = __shfl_xor(v[e], 32);
        if (smp) {
          const float pos = (float)(within >= 80 ? (t & 63) : (t >> 6));
#pragma unroll
          for (int e = 0; e < 4; ++e) {
            const int f = (fq & 1) * 4 + e;
            const float ang = pos * exp2f(-(float)f * 1.66096404744f);
            const float cs = __cosf(ang), sn = __sinf(ang);
            v[e] = fq < 2 ? v[e] * cs - pr[e] * sn : pr[e] * sn + v[e] * cs;
          }
        }
      }
      *(u32x2*)(QB + (size_t)tok * 768 + cb + fq * 4) = pk4(v);
    }
  }
}

__device__ __forceinline__ void kvup_tile(const Params& p, int l, int tile, char* lds) {
  const int tid = tidx(), lane = tid & 63, wid = tid >> 6, wm = wid >> 1, wn = wid & 1, fr = lane & 15, fq = lane >> 4;
  const int m = tile % 112, nt = tile / 112, m0 = m * 128, n0 = nt * 128;
  char* ws = wsp(p.ws);
  const bf16_t* A = (const bf16_t*)(ws + O_CKVA) + (size_t)m0 * 256;
  const bf16_t* B = (const bf16_t*)(ws + O_WKV) + ((size_t)l * 1024 + n0) * 256;
  f32x4 acc[4][4];
  zero_acc(acc);
  if (nt < 4) {
    gemm_core<true>(A, 256, B, 256, 256, acc, lds);
    bf16_t* KB = (bf16_t*)(ws + O_KB);
#pragma unroll
    for (int i = 0; i < 4; ++i) {
      const int R = m0 + wm * 64 + i * 16 + fr;
#pragma unroll
      for (int j = 0; j < 4; ++j) *(u32x2*)(KB + (size_t)R * 512 + n0 + wn * 64 + j * 16 + fq * 4) = pk4(acc[i][j]);
    }
  } else {
    gemm_core<false>(A, 256, B, 256, 256, acc, lds);
    bf16_t* VT = (bf16_t*)(ws + O_VT);
#pragma unroll
    for (int i = 0; i < 4; ++i) {
      const int R = m0 + wm * 64 + i * 16 + fq * 4;
      size_t base; int Tk, b, k;
      if (R < NPR) { b = R >> 8; k = R & 255; Tk = 256; base = 0; } else { const int s = R - NPR; b = s / 1536; k = s - b * 1536; Tk = 1536; base = (size_t)NPR * 512; }
#pragma unroll
      for (int j = 0; j < 4; ++j) {
        const int c = n0 - 512 + wn * 64 + j * 16 + fr, h = c >> 6, vd = c & 63;
        *(u32x2*)(VT + base + ((size_t)(b * 8 + h) * 64 + vd) * Tk + k) = pk4(acc[i][j]);
      }
    }
  }
}

__device__ __forceinline__ void f2_tile(const Params& p, int tile, char* lds) {
  const int tid = tidx(), lane = tid & 63, wid = tid >> 6, wm = wid >> 1, wn = wid & 1, fr = lane & 15, fq = lane >> 4;
  char* ws = wsp(p.ws);
  const bf16_t *A, *B; int K, tokb, g; float scale;
  if (tile < 128) {
    const int b = tile >> 5, mt = tile & 7; g = (tile >> 3) & 3;
    A = (const bf16_t*)(ws + O_D1024) + (size_t)mt * 128 * 2048; K = 2048;
    B = (const bf16_t*)(ws + O_UT) + (size_t)NPR * 1024 + (size_t)(b * 4 + g) * 128 * 2048;
    tokb = NPR + b * 1024 + mt * 128; scale = 0.00276213586400995f;
  } else {
    const int it = tile - 128, b = it >> 3, mt = it & 1; g = (it >> 1) & 3;
    A = (const bf16_t*)(ws + O_D256) + (size_t)mt * 128 * 512; K = 512;
    B = (const bf16_t*)(ws + O_UT) + (size_t)(b * 4 + g) * 128 * 512;
    tokb = b * 256 + mt * 128; scale = 0.0055242717280199f;
  }
  f32x4 acc[4][4];
  zero_acc(acc);
  gemm_core<true>(A, K, B, K, K, acc, lds);
  bf16_t* FZ = (bf16_t*)(ws + O_FZ);
#pragma unroll
  for (int i = 0; i < 4; ++i) {
    const int tok = tokb + wm * 64 + i * 16 + fr;
#pragma unroll
    for (int j = 0; j < 4; ++j) {
      bf16_t* gp = FZ + (size_t)tok * 512 + g * 128 + wn * 64 + j * 16 + fq * 4;
      const u32x2 gz = *(const u32x2*)gp;
      f32x4 y;
      y[0] = acc[i][j][0] * scale * bflo(gz.x); y[1] = acc[i][j][1] * scale * bfhi(gz.x);
      y[2] = acc[i][j][2] * scale * bflo(gz.y); y[3] = acc[i][j][3] * scale * bfhi(gz.y);
      *(u32x2*)gp = pk4(y);
    }
  }
}

__device__ __forceinline__ void s6_tile(const Params& p, int l, int tile, char* lds) {
  const int tid = tidx(), lane = tid & 63, wid = tid >> 6, wm = wid >> 1, wn = wid & 1, fr = lane & 15, fq = lane >> 4;
  const int m = tile % 96, nt = tile / 96, m0 = m * 128, n0 = nt * 64;
  char* ws = wsp(p.ws);
  f32x4 tot[4][2], acc[4][2];
  u32x2 sg[4][2];
#pragma unroll
  for (int i = 0; i < 4; ++i) { tot[i][0] = (f32x4){0.f, 0.f, 0.f, 0.f}; tot[i][1] = (f32x4){0.f, 0.f, 0.f, 0.f}; }
#pragma unroll 1
  for (int nb = 0; nb < 3; ++nb) {
#pragma unroll
    for (int i = 0; i < 4; ++i) { acc[i][0] = (f32x4){0.f, 0.f, 0.f, 0.f}; acc[i][1] = (f32x4){0.f, 0.f, 0.f, 0.f}; }
    gemm_core<true, 2>((const bf16_t*)(ws + O_H) + (size_t)m0 * 1024, 1024,
                       (const bf16_t*)(ws + O_WIN) + ((size_t)l * 6912 + 3840 + nb * 1024 + n0) * 1024, 1024, 1024, acc, lds);
#pragma unroll
    for (int i = 0; i < 4; ++i)
#pragma unroll
      for (int j = 0; j < 2; ++j) { f32x4 sv;
#pragma unroll
        for (int e = 0; e < 4; ++e) sv[e] = sigm_f(acc[i][j][e]);
        sg[i][j] = pk4(sv); }
#pragma unroll
    for (int i = 0; i < 4; ++i) { acc[i][0] = (f32x4){0.f, 0.f, 0.f, 0.f}; acc[i][1] = (f32x4){0.f, 0.f, 0.f, 0.f}; }
    const size_t boff = nb == 0 ? O_RZ : (nb == 1 ? O_MZ : O_FZ);
    gemm_core<true, 2>((const bf16_t*)(ws + boff) + (size_t)m0 * 512, 512,
                       (const bf16_t*)(ws + O_WBR) + ((size_t)(l * 3 + nb) * 1024 + n0) * 512, 512, 512, acc, lds);
#pragma unroll
    for (int i = 0; i < 4; ++i)
#pragma unroll
      for (int j = 0; j < 2; ++j) {
        tot[i][j][0] += acc[i][j][0] * bflo(sg[i][j].x); tot[i][j][1] += acc[i][j][1] * bfhi(sg[i][j].x);
        tot[i][j][2] += acc[i][j][2] * bflo(sg[i][j].y); tot[i][j][3] += acc[i][j][3] * bfhi(sg[i][j].y);
      }
  }
  bf16_t* MG = (bf16_t*)(ws + O_UT);
#pragma unroll
  for (int i = 0; i < 4; ++i) {
    const int tok = m0 + wm * 64 + i * 16 + fr;
#pragma unroll
    for (int j = 0; j < 2; ++j) *(u32x2*)(MG + (size_t)tok * 1024 + n0 + wn * 32 + j * 16 + fq * 4) = pk4(tot[i][j]);
  }
}

__device__ __forceinline__ void s7_tile(const Params& p, int l, int tile, const float* xp, const float* xs, char* lds) {
  const int tid = tidx(), lane = tid & 63, wid = tid >> 6, wm = wid >> 1, wn = wid & 1, fr = lane & 15, fq = lane >> 4;
  const int m = tile % 96, nt = tile / 96, m0 = m * 128, n0 = nt * 128;
  char* ws = wsp(p.ws);
  f32x4 acc[4][4];
  zero_acc(acc);
  gemm_core<true>((const bf16_t*)(ws + O_UT) + (size_t)m0 * 1024, 1024, (const bf16_t*)(ws + O_WO) + ((size_t)l * 1024 + n0) * 1024, 1024, 1024, acc, lds);
#pragma unroll
  for (int i = 0; i < 4; ++i) {
    const int tok = m0 + wm * 64 + i * 16 + fr;
    const float* src = tok < NPR ? xp + (size_t)tok * 1024 : xs + (size_t)(tok - NPR) * 1024;
    const int v = tok < NPR ? 0 : 1 + ((tok - NPR) >> 10);
    const float* gate = (const float*)(ws + O_MOD) + (l * 5 + v) * 3072 + 2048;
#pragma unroll
    for (int j = 0; j < 4; ++j) {
      const int col = n0 + wn * 64 + j * 16 + fq * 4;
      const f32x4 x = *(const f32x4*)(src + col), gt = *(const f32x4*)(gate + col);
      f32x4 y;
#pragma unroll
      for (int e = 0; e < 4; ++e) y[e] = x[e] + gt[e] * acc[i][j][e];
      *(f32x4*)(p.out + (size_t)tok * 1024 + col) = y;
    }
  }
}

constexpr int NPHASE = 16;
__device__ __forceinline__ void run_phase(const Params& p, int ph, char* lds) {
  const int bid = blockIdx.x, nb = gridDim.x;
  if (ph == 0) { for (int i = bid; i < P0_N; i += nb) phase0_item(p, i, lds); return; }
  if (ph == 15) { for (int i = bid; i < 768; i += nb) final_item(p, i); return; }
  const int l = (ph - 1) / 7, s = (ph - 1) % 7;
  const float* xp = l == 0 ? p.x_prompt : p.out;
  const float* xs = l == 0 ? p.x_sample : p.out + (size_t)NPR * 1024;
  switch (s) {
    case 0: for (int i = bid; i < 768; i += nb) norm_item(p, l, i, xp, xs); break;
    case 1: for (int i = bid; i < 2880; i += nb) s2_tile(p, l, i, lds); break;
    case 2:
      for (int i = bid; i < 1504; i += nb) {
        if (i < 384) attn_item<1>(p, l, i, lds);
        else if (i < 512) state_item(p, l, i - 384);
        else if (i < 736) keyprep_item(p, l, i - 512);
        else f1_tile(p, i - 736, lds);
      }
      break;
    case 3:
      for (int i = bid; i < 1856; i += nb) {
        if (i < 384) f2_tile(p, i, lds);
        else if (i < 1280) kvup_tile(p, l, i - 384, lds);
        else qup_tile(p, l, i - 1280, lds);
      }
      break;
    case 4: for (int i = bid; i < 768; i += nb) attn_item<0>(p, l, i, lds); break;
    case 5: for (int i = bid; i < 1536; i += nb) s6_tile(p, l, i, lds); break;
    case 6: for (int i = bid; i < 768; i += nb) s7_tile(p, l, i, xp, xs, lds); break;
  }
}

#define XB_TMO      128
#define XB_XCNT(j)  (256  + 64 * (j))
#define XB_XSUB(j)  (1280 + 64 * (j))
#define XB_XGEN(j)  (2304 + 64 * (j))
#define XB_TOP      3328
#define XB_TOPGEN   3392
#define XCD_BAR_WORDS 3456
#define XB_SPIN_CAP (1u << 18)
__device__ __forceinline__ unsigned xb_ld(unsigned* p)              { return __hip_atomic_load(p, __ATOMIC_RELAXED, __HIP_MEMORY_SCOPE_AGENT); }
__device__ __forceinline__ unsigned xb_add(unsigned* p, unsigned v) { return __hip_atomic_fetch_add(p, v, __ATOMIC_RELAXED, __HIP_MEMORY_SCOPE_AGENT); }
__device__ __forceinline__ unsigned xb_xcc_id() { return (unsigned)__builtin_amdgcn_s_getreg((3 << 11) | 20) & 0xFu; }
#define XB_SPIN(cond, bar) do { unsigned _sp = 0; while (cond) { __builtin_amdgcn_s_sleep(1); \
    if ((++_sp & 255u) == 0u) { if (xb_ld(&(bar)[XB_TMO])) break; if (_sp > XB_SPIN_CAP) { atomicAdd(&(bar)[XB_TMO], 1u); break; } } } } while (0)
__device__ __forceinline__ void xcd_barrier_complete(unsigned* bar, unsigned x, unsigned& nloc, unsigned& nx) {
  const unsigned G = gridDim.x;
  unsigned sum, cnt, mine, sp = 0u;
  for (;;) {
    sum = 0u; cnt = 0u; mine = 0u;
#pragma unroll
    for (unsigned j = 0; j < 16; ++j) { const unsigned c = xb_ld(&bar[XB_XCNT(j)]); sum += c; cnt += (c > 0u) ? 1u : 0u; mine = (j == x) ? c : mine; }
    if (sum == G) break;
    __builtin_amdgcn_s_sleep(1);
    if ((++sp & 255u) == 0u) { if (xb_ld(&bar[XB_TMO])) break; if (sp > XB_SPIN_CAP) { atomicAdd(&bar[XB_TMO], 1u); break; } }
  }
  nloc = mine > 0u ? mine : 1u; nx = cnt > 0u ? cnt : 1u;
}
__device__ __forceinline__ void xcd_barrier(unsigned* bar, unsigned x, unsigned& nloc, unsigned& nx) {
  asm volatile("s_waitcnt vmcnt(0)" ::: "memory");
  __syncthreads();
  if (threadIdx.x == 0) {
    __builtin_amdgcn_s_waitcnt(0);
    if (nloc == 0u) xcd_barrier_complete(bar, x, nloc, nx);
    const unsigned old = xb_add(&bar[XB_XSUB(x)], 1u);
    const unsigned gen = old / nloc;
    if (old + 1u == (gen + 1u) * nloc) {
      __builtin_amdgcn_fence(__ATOMIC_RELEASE, "agent");
      asm volatile("s_waitcnt vmcnt(0)" ::: "memory");
      const unsigned og = xb_add(&bar[XB_TOP], 1u);
      const unsigned tg = og / nx;
      if (og + 1u == (tg + 1u) * nx) xb_add(&bar[XB_TOPGEN], 1u);
      else XB_SPIN(xb_ld(&bar[XB_TOPGEN]) == tg, bar);
      __builtin_amdgcn_fence(__ATOMIC_ACQUIRE, "agent");
      xb_add(&bar[XB_XGEN(x)], 1u);
      asm volatile("s_waitcnt vmcnt(0)" ::: "memory");
    } else {
      XB_SPIN(xb_ld(&bar[XB_XGEN(x)]) == gen, bar);
      __builtin_amdgcn_fence(__ATOMIC_ACQUIRE, "agent");
      asm volatile("s_waitcnt vmcnt(0)" ::: "memory");
    }
  }
  __syncthreads();
}

__global__ void __launch_bounds__(256, 2) mk_fwd(Params p) {
  __shared__ __attribute__((aligned(16))) char lds[LDS_TOTAL];
  cg::grid_group grid = cg::this_grid();
  unsigned* bar = (unsigned*)(p.ws + O_BAR);
  const unsigned xcc = xb_xcc_id();
  if (threadIdx.x == 0) (void)xb_add(&bar[XB_XCNT(xcc)], 1u);
  unsigned nloc = 0u, nx = 0u;
  if (gridDim.x == 0x7fffffffu) grid.sync();
#pragma unroll 1
  for (int ph = 0; ph < NPHASE; ++ph) {
    run_phase(p, ph, lds);
    if (ph + 1 < NPHASE) xcd_barrier(bar, xcc, nloc, nx);
  }
}

__global__ void __launch_bounds__(256, 2) ph_fwd(Params p, int ph) {
  __shared__ __attribute__((aligned(16))) char lds[LDS_TOTAL];
  run_phase(p, ph, lds);
}

extern "C" void kernel_launch(void* const* d_in, const int* in_sizes, int n_in, void* d_out, int out_size, void* d_ws, size_t ws_size,
                              hipStream_t stream) {
  Params p{};
  p.x_prompt = (const float*)d_in[0]; p.x_sample = (const float*)d_in[1]; p.cache_ckv = (const float*)d_in[2]; p.cache_krope = (const float*)d_in[3];
  p.state_ret = (const float*)d_in[4]; p.c = (const float*)d_in[5]; p.c_ctx = (const float*)d_in[6]; p.norm_g = (const float*)d_in[7];
  p.w_mod = (const float*)d_in[8]; p.b_mod = (const float*)d_in[9]; p.w_in = (const float*)d_in[10]; p.ret_logit = (const float*)d_in[11];
  p.q_norm_g = (const float*)d_in[12]; p.w_q_up = (const float*)d_in[13]; p.kv_norm_g = (const float*)d_in[14]; p.w_kv_up = (const float*)d_in[15];
  p.w_branch = (const float*)d_in[16]; p.w_out = (const float*)d_in[17]; p.final_g = (const float*)d_in[18];
  p.out = (float*)d_out; p.ws = (char*)d_ws;
#if ONE_LAUNCH
  static int grid_blocks = 0;
  if (!grid_blocks) {
    int dev = 0, cus = 0, per_cu = 0;
    hipGetDevice(&dev);
    hipDeviceGetAttribute(&cus, hipDeviceAttributeMultiprocessorCount, dev);
    hipOccupancyMaxActiveBlocksPerMultiprocessor(&per_cu, mk_fwd, 256, 0);
    if (per_cu > 2) per_cu = 2;
    grid_blocks = cus * per_cu;
  }
  hipMemsetAsync((char*)d_ws + O_BAR, 0, XCD_BAR_WORDS * 4, stream);
  void* args[] = {&p};
  hipError_t e = hipLaunchCooperativeKernel((void*)mk_fwd, dim3(grid_blocks), dim3(256), args, 0, stream);
  if (e != hipSuccess) fprintf(stderr, "cooperative launch failed: %s (grid %d)\n", hipGetErrorString(e), grid_blocks);
#else
#ifndef STOP_AFTER
#define STOP_AFTER 15
#endif
  for (int ph = 0; ph <= STOP_AFTER; ++ph) ph_fwd<<<512, 256, 0, stream>>>(p, ph);
#endif
}
```

```cpp
#include <hip/hip_runtime.h>
#include <hip/hip_cooperative_groups.h>
#include <stdint.h>
#include <stdio.h>
namespace cg = cooperative_groups;

#ifndef ONE_LAUNCH
#define ONE_LAUNCH 1
#endif

typedef unsigned short bf16_t;
typedef short bf16x8 __attribute__((ext_vector_type(8)));
typedef float f32x4 __attribute__((ext_vector_type(4)));
typedef unsigned u32x4 __attribute__((ext_vector_type(4)));
typedef unsigned u32x2 __attribute__((ext_vector_type(2)));

constexpr int NTOK = 12288, NPR = 8192, NKEY = 14336;
constexpr float EPSN = 1e-6f;

constexpr size_t O_WIN   = 0;
constexpr size_t O_WQ    = O_WIN   + (size_t)2 * 6912 * 1024 * 2;
constexpr size_t O_WKV   = O_WQ    + (size_t)2 * 768 * 384 * 2;
constexpr size_t O_WBR   = O_WKV   + (size_t)2 * 1024 * 256 * 2;
constexpr size_t O_WO    = O_WBR   + (size_t)6 * 1024 * 512 * 2;
constexpr size_t O_CS    = O_WO    + (size_t)2 * 1024 * 1024 * 2;
constexpr size_t O_D256  = O_CS    + (size_t)256 * 128 * 2;
constexpr size_t O_D1024 = O_D256  + (size_t)256 * 512 * 2;
constexpr size_t O_S0T   = O_D1024 + (size_t)1024 * 2048 * 2;
constexpr size_t O_MOD   = O_S0T   + (size_t)64 * 128 * 64 * 2;
constexpr size_t O_H     = O_MOD   + (size_t)2 * 5 * 3072 * 4;
constexpr size_t O_UT    = O_H     + (size_t)NTOK * 1024 * 2;
constexpr size_t O_RQ    = O_UT    + (size_t)NTOK * 1024 * 2;
constexpr size_t O_RK    = O_RQ    + (size_t)NTOK * 256 * 2;
constexpr size_t O_RKT   = O_RK    + (size_t)NTOK * 256 * 2;
constexpr size_t O_RVT   = O_RKT   + (size_t)NPR * 256 * 2;
constexpr size_t O_KVLAT = O_RVT   + (size_t)NTOK * 512 * 2;
constexpr size_t O_KR    = O_KVLAT + (size_t)NTOK * 256 * 4;
constexpr size_t O_R2END = O_KR    + (size_t)NTOK * 32 * 4;
constexpr size_t O_QB    = O_RQ;
constexpr size_t O_VT    = O_QB    + (size_t)NTOK * 768 * 2;
static_assert(O_VT + (size_t)NKEY * 512 * 2 <= O_R2END, "alias overflow");
constexpr size_t O_RZ    = O_R2END;
constexpr size_t O_MZ    = O_RZ    + (size_t)NTOK * 512 * 2;
constexpr size_t O_FZ    = O_MZ    + (size_t)NTOK * 512 * 2;
constexpr size_t O_FU    = O_FZ    + (size_t)NTOK * 512 * 2;
constexpr size_t O_QLAT  = O_FU    + (size_t)NTOK * 512 * 2;
constexpr size_t O_CKVA  = O_QLAT  + (size_t)NTOK * 384 * 2;
constexpr size_t O_KB    = O_CKVA  + (size_t)NKEY * 256 * 2;
constexpr size_t O_KRA   = O_KB    + (size_t)NKEY * 512 * 2;
constexpr size_t O_END   = O_KRA   + (size_t)NKEY * 32 * 2;
constexpr size_t O_BAR   = (O_END + 255) & ~(size_t)255;
static_assert(O_BAR + 16384 <= (size_t)256 * 1024 * 1024, "workspace too large");

constexpr size_t OUT_CKV = (size_t)NTOK * 1024;
constexpr size_t OUT_KR  = OUT_CKV + (size_t)32 * 2 * 256 * 256;
constexpr size_t OUT_RET = OUT_KR + (size_t)32 * 2 * 256 * 32;

struct Params {
  const float *x_prompt, *x_sample, *cache_ckv, *cache_krope, *state_ret, *c, *c_ctx, *norm_g, *w_mod, *b_mod,
      *w_in, *ret_logit, *q_norm_g, *w_q_up, *kv_norm_g, *w_kv_up, *w_branch, *w_out, *final_g;
  float* out;
  char* ws;
};

constexpr int PANEL = 128 * 64;
constexpr int ABYTES = 2 * PANEL;
constexpr int STAGE = 2 * ABYTES;
constexpr int LDS_GEMM = 2 * STAGE;
constexpr int LDS_TOTAL = LDS_GEMM;
static_assert(LDS_TOTAL <= 65536, "static LDS");

typedef float f32x2 __attribute__((ext_vector_type(2)));
typedef __bf16 bf16x2v __attribute__((ext_vector_type(2)));
__device__ __forceinline__ unsigned pk2(float lo, float hi) { const f32x2 v = {lo, hi}; return __builtin_bit_cast(unsigned, __builtin_convertvector(v, bf16x2v)); }
__device__ __forceinline__ bf16_t tobf(float x) { return (bf16_t)(pk2(x, 0.f) & 0xffffu); }
__device__ __forceinline__ float bflo(unsigned u) { return __uint_as_float(u << 16); }
__device__ __forceinline__ float bfhi(unsigned u) { return __uint_as_float(u & 0xffff0000u); }
__device__ __forceinline__ float silu_f(float x) { return x / (1.f + __expf(-x)); }
__device__ __forceinline__ float sigm_f(float x) { return 1.f / (1.f + __expf(-x)); }
__device__ __forceinline__ u32x2 pk4(f32x4 v) { u32x2 r; r.x = pk2(v[0], v[1]); r.y = pk2(v[2], v[3]); return r; }
#define GAS __attribute__((address_space(1)))
#define LAS __attribute__((address_space(3)))
__device__ __forceinline__ u32x4 ldg16(const void* p) { return *(const GAS u32x4*)p; }
__device__ __forceinline__ int tidx() { int t = threadIdx.x; asm volatile("" : "+v"(t)); return t; }
__device__ __forceinline__ char* wsp(const char* w) { unsigned long long v = (unsigned long long)w; asm volatile("" : "+s"(v)); return (char*)v; }
__device__ __forceinline__ int swz(int r) { return (0 - ((r >> 2) & 3)) & 3; }
__device__ __forceinline__ float wave_sum(float v) {
#pragma unroll
  for (int o = 1; o < 64; o <<= 1) v += __shfl_xor(v, o);
  return v;
}
__device__ __forceinline__ f32x4 mfma16(bf16x8 a, bf16x8 b, f32x4 c) { return __builtin_amdgcn_mfma_f32_16x16x32_bf16(a, b, c, 0, 0, 0); }
__device__ __forceinline__ bf16x8 as_bf8(u32x4 v) { return __builtin_bit_cast(bf16x8, v); }

__device__ __forceinline__ void zero_acc(f32x4 (&acc)[4][4]) {
#pragma unroll
  for (int i = 0; i < 4; ++i)
#pragma unroll
    for (int j = 0; j < 4; ++j) acc[i][j] = (f32x4){0.f, 0.f, 0.f, 0.f};
}

template <bool SWAP, int NJ = 4>
__device__ __forceinline__ void gemm_core(const bf16_t* __restrict__ A, int lda, const bf16_t* __restrict__ B, int ldb, int K,
                                          f32x4 (&acc)[4][NJ], char* lds) {
  const int tid = threadIdx.x, lane = tid & 63, wm = (tid >> 6) >> 1, wn = (tid >> 6) & 1;
  const int wid = __builtin_amdgcn_readfirstlane(tid >> 6);
  const int fr = lane & 15, fq = lane >> 4;
  const int fa = (wm * 64 + fr) * 64 + ((fq ^ swz(fr)) << 4);
  const int fb = ABYTES + (wn * NJ * 16 + fr) * 64 + ((fq ^ swz(fr)) << 4);
  const int lrow = lane >> 2, lchunk = (lane & 3) ^ swz(lrow);
  constexpr int NBL = NJ / 2;
  const GAS char* gA = (const GAS char*)(A + (size_t)(wid * 32 + lrow) * lda + lchunk * 8);
  const GAS char* gB = (const GAS char*)(B + (size_t)(wid * NBL * 16 + lrow) * ldb + lchunk * 8);
  const size_t a16 = (size_t)16 * lda * 2, b16 = (size_t)16 * ldb * 2;
  LAS char* ldsA = (LAS char*)lds + wid * 2048;
  LAS char* ldsB = (LAS char*)lds + ABYTES + wid * NBL * 1024;
  const int nk = K >> 6;
#define GC_ISSUE(stage, kbyte) do { \
    _Pragma("unroll") for (int g = 0; g < 2; ++g) _Pragma("unroll") for (int pn = 0; pn < 2; ++pn) \
      __builtin_amdgcn_global_load_lds((const GAS unsigned*)(gA + g * a16 + (kbyte) + pn * 64), (LAS unsigned*)(ldsA + (stage) + pn * PANEL + g * 1024), 16, 0, 0); \
    _Pragma("unroll") for (int g = 0; g < NBL; ++g) _Pragma("unroll") for (int pn = 0; pn < 2; ++pn) \
      __builtin_amdgcn_global_load_lds((const GAS unsigned*)(gB + g * b16 + (kbyte) + pn * 64), (LAS unsigned*)(ldsB + (stage) + pn * PANEL + g * 1024), 16, 0, 0); \
  } while (0)
  GC_ISSUE(0, 0);
  asm volatile("s_waitcnt vmcnt(0)" ::: "memory");
  __syncthreads();
  for (int kt = 0; kt < nk; ++kt) {
    char* cur = lds + (kt & 1) * STAGE;
    if (kt + 1 < nk) GC_ISSUE(((kt + 1) & 1) * STAGE, (size_t)(kt + 1) * 128);
    __builtin_amdgcn_sched_barrier(0);
#pragma unroll
    for (int ks = 0; ks < 2; ++ks) {
      bf16x8 af[4], bfr[NJ];
#pragma unroll
      for (int i = 0; i < 4; ++i) af[i] = *(const bf16x8*)(cur + ks * PANEL + fa + i * 1024);
#pragma unroll
      for (int j = 0; j < NJ; ++j) bfr[j] = *(const bf16x8*)(cur + ks * PANEL + fb + j * 1024);
#pragma unroll
      for (int i = 0; i < 4; ++i)
#pragma unroll
        for (int j = 0; j < NJ; ++j) acc[i][j] = SWAP ? mfma16(bfr[j], af[i], acc[i][j]) : mfma16(af[i], bfr[j], acc[i][j]);
    }
    __builtin_amdgcn_sched_barrier(0);
    asm volatile("s_waitcnt vmcnt(0)" ::: "memory");
    __syncthreads();
  }
#undef GC_ISSUE
}

__device__ __forceinline__ void tr_tile(const float* __restrict__ src, int lds_, int k0, int ns0, bf16_t* __restrict__ dst, int ldd, int nd0,
                                        const float* __restrict__ ksc, char* lds) {
  bf16_t* T = (bf16_t*)lds;
  const int tid = tidx();
  __syncthreads();
#pragma unroll
  for (int i = 0; i < 2; ++i) {
    const int kk = (tid >> 3) + 32 * i, nn4 = (tid & 7) * 4;
    const f32x4 v = *(const f32x4*)(src + (size_t)(k0 + kk) * lds_ + ns0 + nn4);
    const float s = ksc ? ksc[k0 + kk] : 1.f;
#pragma unroll
    for (int e = 0; e < 4; ++e) T[(nn4 + e) * 72 + kk] = tobf(v[e] * s);
  }
  __syncthreads();
  const int nn = tid >> 3, kc = (tid & 7) * 8;
  const u32x4 w = *(const u32x4*)(T + nn * 72 + kc);
  *(u32x4*)(dst + (size_t)(nd0 + nn) * ldd + k0 + kc) = w;
}

constexpr int P0_GEMV = 96, P0_WIN = 6816, P0_WQ = 288, P0_WKV = 256, P0_WBR = 1536, P0_WO = 1024, P0_S0 = 256, P0_PAD = 96, P0_TAB = 1104;
constexpr int P0_N = P0_GEMV + P0_WIN + P0_WQ + P0_WKV + P0_WBR + P0_WO + P0_S0 + P0_PAD + P0_TAB;

__device__ __forceinline__ void phase0_item(const Params& p, int j, char* lds) {
  const int tid = tidx();
  char* ws = wsp(p.ws);
  if (j < P0_GEMV) {
    const int l = j / 48, cgi = j % 48;
    float* sv = (float*)lds;
    float* red = (float*)(lds + 20480);
    __syncthreads();
    for (int i = tid; i < 5120; i += 256) { const int v = i >> 10, k = i & 1023; const float x = (v == 0) ? p.c_ctx[k] : p.c[(v - 1) * 1024 + k]; sv[i] = silu_f(x); }
    __syncthreads();
    const int cc = tid & 63, kg = tid >> 6;
    const float* w = p.w_mod + (size_t)l * 1024 * 3072 + cgi * 64 + cc;
    float a0 = 0.f, a1 = 0.f, a2 = 0.f, a3 = 0.f, a4 = 0.f;
#pragma unroll 8
    for (int k = kg * 256; k < kg * 256 + 256; ++k) {
      const float wv = w[(size_t)k * 3072];
      a0 += sv[k] * wv; a1 += sv[1024 + k] * wv; a2 += sv[2048 + k] * wv; a3 += sv[3072 + k] * wv; a4 += sv[4096 + k] * wv;
    }
    red[(kg * 5 + 0) * 64 + cc] = a0; red[(kg * 5 + 1) * 64 + cc] = a1; red[(kg * 5 + 2) * 64 + cc] = a2; red[(kg * 5 + 3) * 64 + cc] = a3; red[(kg * 5 + 4) * 64 + cc] = a4;
    __syncthreads();
    for (int o = tid; o < 320; o += 256) {
      const int v = o >> 6, c2 = o & 63;
      float s = p.b_mod[l * 3072 + cgi * 64 + c2];
#pragma unroll
      for (int g = 0; g < 4; ++g) s += red[(g * 5 + v) * 64 + c2];
      ((float*)(ws + O_MOD))[(l * 5 + v) * 3072 + cgi * 64 + c2] = s;
    }
    return;
  }
  j -= P0_GEMV;
  if (j < P0_WIN) {
    const int l = j / 3408, r = j % 3408, kt = r / 213, nt = r % 213, c0 = nt * 32;
    const int nd0 = c0 < 2176 ? c0 : (c0 < 2208 ? 3712 + (c0 - 2176) : (c0 < 3744 ? c0 - 32 : c0 + 96));
    tr_tile(p.w_in + (size_t)l * 1024 * 6816, 6816, kt * 64, c0, (bf16_t*)(ws + O_WIN) + (size_t)l * 6912 * 1024, 1024, nd0, nullptr, lds);
    return;
  }
  j -= P0_WIN;
  if (j < P0_WQ) {
    const int l = j / 144, r = j % 144, kt = r / 24, nt = r % 24;
    tr_tile(p.w_q_up + (size_t)l * 384 * 768, 768, kt * 64, nt * 32, (bf16_t*)(ws + O_WQ) + (size_t)l * 768 * 384, 384, nt * 32, p.q_norm_g + l * 384, lds);
    return;
  }
  j -= P0_WQ;
  if (j < P0_WKV) {
    const int l = j / 128, r = j % 128, kt = r / 32, nt = r % 32, c0 = nt * 32, h = c0 >> 7, e = c0 & 127;
    const int nd0 = e < 64 ? h * 64 + e : 512 + h * 64 + (e - 64);
    tr_tile(p.w_kv_up + (size_t)l * 256 * 1024, 1024, kt * 64, c0, (bf16_t*)(ws + O_WKV) + (size_t)l * 1024 * 256, 256, nd0, nullptr, lds);
    return;
  }
  j -= P0_WKV;
  if (j < P0_WBR) {
    const int mat = j / 256, r = j % 256, kt = r / 32, nt = r % 32;
    tr_tile(p.w_branch + (size_t)mat * 512 * 1024, 1024, kt * 64, nt * 32, (bf16_t*)(ws + O_WBR) + (size_t)mat * 1024 * 512, 512, nt * 32, nullptr, lds);
    return;
  }
  j -= P0_WBR;
  if (j < P0_WO) {
    const int l = j / 512, r = j % 512, kt = r / 32, nt = r % 32;
    tr_tile(p.w_out + (size_t)l * 1024 * 1024, 1024, kt * 64, nt * 32, (bf16_t*)(ws + O_WO) + (size_t)l * 1024 * 1024, 1024, nt * 32, nullptr, lds);
    return;
  }
  j -= P0_WO;
  if (j < P0_S0) {
    const int mat = j >> 2, nt = j & 3;
    tr_tile(p.state_ret + (size_t)mat * 64 * 128, 128, 0, nt * 32, (bf16_t*)(ws + O_S0T) + (size_t)mat * 128 * 64, 64, nt * 32, nullptr, lds);
    return;
  }
  j -= P0_S0;
  if (j < P0_PAD) {
    const int l = j / 48, r = j % 48;
    bf16_t* d = (bf16_t*)(ws + O_WIN) + ((size_t)l * 6912 + 3744) * 1024 + (size_t)r * 2048 + tid * 8;
    *(u32x4*)d = (u32x4){0u, 0u, 0u, 0u};
    return;
  }
  j -= P0_PAD;
  {
    float v[8];
    bf16_t* dst;
    if (j < 16) {
      const int e0 = j * 2048 + tid * 8; dst = (bf16_t*)(ws + O_CS) + e0;
      const int n = e0 >> 7, k = e0 & 127;
#pragma unroll
      for (int e = 0; e < 8; ++e) {
        const float fr = (float)(((n & 127) * (k + e)) & 127) * (1.f / 128.f);
        v[e] = (n < 128) ? __builtin_amdgcn_cosf(fr) : __builtin_amdgcn_sinf(fr);
      }
    } else if (j < 80) {
      const int e0 = (j - 16) * 2048 + tid * 8; dst = (bf16_t*)(ws + O_D256) + e0;
      const int k1 = e0 >> 9, kk = e0 & 511;
#pragma unroll
      for (int e = 0; e < 8; ++e) {
        const int t = (kk + e) & 255;
        const float fr = (float)((k1 * t) & 255) * (1.f / 256.f);
        v[e] = (kk < 256) ? __builtin_amdgcn_cosf(fr) : -__builtin_amdgcn_sinf(fr);
      }
    } else {
      const int e0 = (j - 80) * 2048 + tid * 8; dst = (bf16_t*)(ws + O_D1024) + e0;
      const int k1 = e0 >> 11, kk = e0 & 2047;
#pragma unroll
      for (int e = 0; e < 8; ++e) {
        const int t = (kk + e) & 1023;
        const float fr = (float)((k1 * t) & 1023) * (1.f / 1024.f);
        v[e] = (kk < 1024) ? __builtin_amdgcn_cosf(fr) : -__builtin_amdgcn_sinf(fr);
      }
    }
    u32x4 w; w.x = pk2(v[0], v[1]); w.y = pk2(v[2], v[3]); w.z = pk2(v[4], v[5]); w.w = pk2(v[6], v[7]);
    *(u32x4*)dst = w;
  }
}

__device__ __forceinline__ void norm_item(const Params& p, int l, int item, const float* xp, const float* xs) {
  const int tid = tidx(), lane = tid & 63, wid = tid >> 6;
  bf16_t* H = (bf16_t*)(p.ws + O_H);
#pragma unroll 1
  for (int i = 0; i < 4; ++i) {
    const int row = item * 16 + wid * 4 + i;
    const float* src = row < NPR ? xp + (size_t)row * 1024 : xs + (size_t)(row - NPR) * 1024;
    const int v = row < NPR ? 0 : 1 + ((row - NPR) >> 10);
    const float* mod = (const float*)(p.ws + O_MOD) + (l * 5 + v) * 3072;
    f32x4 x[4]; float ss = 0.f;
#pragma unroll
    for (int q = 0; q < 4; ++q) { x[q] = *(const f32x4*)(src + (q * 64 + lane) * 4); ss += x[q][0] * x[q][0] + x[q][1] * x[q][1] + x[q][2] * x[q][2] + x[q][3] * x[q][3]; }
    ss = wave_sum(ss);
    const float rstd = rsqrtf(ss * (1.f / 1024.f) + EPSN);
#pragma unroll
    for (int q = 0; q < 4; ++q) {
      const int col = (q * 64 + lane) * 4;
      const f32x4 g = *(const f32x4*)(p.norm_g + l * 1024 + col), sc = *(const f32x4*)(mod + 1024 + col), sh = *(const f32x4*)(mod + col);
      f32x4 h;
#pragma unroll
      for (int e = 0; e < 4; ++e) h[e] = x[q][e] * rstd * g[e] * (1.f + sc[e]) + sh[e];
      *(u32x2*)(H + (size_t)row * 1024 + col) = pk4(h);
    }
  }
}
__device__ __forceinline__ void final_item(const Params& p, int item) {
  const int tid = tidx(), lane = tid & 63, wid = tid >> 6;
#pragma unroll 1
  for (int i = 0; i < 4; ++i) {
    const int row = item * 16 + wid * 4 + i;
    float* src = p.out + (size_t)row * 1024;
    f32x4 x[4]; float ss = 0.f;
#pragma unroll
    for (int q = 0; q < 4; ++q) { x[q] = *(const f32x4*)(src + (q * 64 + lane) * 4); ss += x[q][0] * x[q][0] + x[q][1] * x[q][1] + x[q][2] * x[q][2] + x[q][3] * x[q][3]; }
    ss = wave_sum(ss);
    const float rstd = rsqrtf(ss * (1.f / 1024.f) + EPSN);
#pragma unroll
    for (int q = 0; q < 4; ++q) {
      const int col = (q * 64 + lane) * 4;
      const f32x4 g = *(const f32x4*)(p.final_g + col);
      f32x4 y;
#pragma unroll
      for (int e = 0; e < 4; ++e) y[e] = x[q][e] * rstd * g[e];
      *(f32x4*)(src + col) = y;
    }
  }
}

__device__ __forceinline__ void s2_tile(const Params& p, int l, int tile, char* lds) {
  const int tid = tidx(), lane = tid & 63, wid = tid >> 6, wm = wid >> 1, wn = wid & 1, fr = lane & 15, fq = lane >> 4;
  const int m = tile % 96, nt = tile / 96, m0 = m * 128, n0 = nt * 128;
  char* ws = wsp(p.ws);
  const bf16_t* A = (const bf16_t*)(ws + O_H) + (size_t)m0 * 1024;
  const bf16_t* B = (const bf16_t*)(ws + O_WIN) + ((size_t)l * 6912 + n0) * 1024;
  f32x4 acc[4][4];
  zero_acc(acc);
  if (nt >= 4 && nt < 8) {
    gemm_core<false>(A, 1024, B, 1024, 1024, acc, lds);
    bf16_t* RVT = (bf16_t*)(ws + O_RVT);
#pragma unroll
    for (int i = 0; i < 4; ++i) {
      const int tok = m0 + wm * 64 + i * 16 + fq * 4;
      size_t base; int T, b, t;
      if (tok < NPR) { b = tok >> 8; t = tok & 255; T = 256; base = 0; } else { const int s = tok - NPR; b = s >> 10; t = s & 1023; T = 1024; base = (size_t)NPR * 512; }
#pragma unroll
      for (int j = 0; j < 4; ++j) {
        const int c = n0 - 512 + wn * 64 + j * 16 + fr, h = c >> 7, vd = c & 127;
        *(u32x2*)(RVT + base + ((size_t)(b * 4 + h) * 128 + vd) * T + t) = pk4(acc[i][j]);
      }
    }
    return;
  }
  gemm_core<true>(A, 1024, B, 1024, 1024, acc, lds);
  bf16_t* dst = nullptr; int ld = 0, c0 = 0, op = 0;
  if (nt < 2) { dst = (bf16_t*)(ws + O_RQ); ld = 256; c0 = 0; }
  else if (nt < 4) { dst = (bf16_t*)(ws + O_RK); ld = 256; c0 = 256; op = 2; }
  else if (nt < 12) { dst = (bf16_t*)(ws + O_RZ); ld = 512; c0 = 1024; op = 1; }
  else if (nt < 15) { dst = (bf16_t*)(ws + O_QLAT); ld = 384; c0 = 1536; }
  else if (nt < 17) { ld = 256; c0 = 1920; op = 3; }
  else if (nt < 21) { dst = (bf16_t*)(ws + O_MZ); ld = 512; c0 = 2176; op = 1; }
  else if (nt < 25) { dst = (bf16_t*)(ws + O_FU); ld = 512; c0 = 2688; }
  else if (nt < 29) { dst = (bf16_t*)(ws + O_FZ); ld = 512; c0 = 3200; op = 1; }
  else { ld = 32; c0 = 3712; op = 4; }
#pragma unroll
  for (int i = 0; i < 4; ++i) {
    const int tok = m0 + wm * 64 + i * 16 + fr;
#pragma unroll
    for (int j = 0; j < 4; ++j) {
      const int col = n0 - c0 + wn * 64 + j * 16 + fq * 4;
      f32x4 v = acc[i][j];
      if (op == 3) { *(f32x4*)((float*)(ws + O_KVLAT) + (size_t)tok * 256 + col) = v; continue; }
      if (op == 4) { if (col < 32) *(f32x4*)((float*)(ws + O_KR) + (size_t)tok * 32 + col) = v; continue; }
      if (op == 1) {
#pragma unroll
        for (int e = 0; e < 4; ++e) v[e] = silu_f(v[e]);
      } else if (op == 2) {
#pragma unroll
        for (int e = 0; e < 4; ++e) v[e] *= 0.125f;
      }
      const u32x2 w = pk4(v);
      *(u32x2*)(dst + (size_t)tok * ld + col) = w;
      if (op == 2 && tok < NPR) {
        bf16_t* RKT = (bf16_t*)(ws + O_RKT);
        const int b = tok >> 8, t = tok & 255, h = col >> 6, dk = col & 63;
        bf16_t* q = RKT + ((size_t)(b * 4 + h) * 64 + dk) * 256 + t;
        q[0] = (bf16_t)(w.x & 0xffffu); q[256] = (bf16_t)(w.x >> 16); q[512] = (bf16_t)(w.y & 0xffffu); q[768] = (bf16_t)(w.y >> 16);
      }
    }
  }
}

template <int MODE>
__device__ __forceinline__ void attn_item(const Params& p, int l, int item, char* lds) {
  constexpr int NKP = MODE == 0 ? 3 : 2;
  constexpr int NVB = MODE == 0 ? 4 : 8;
  constexpr int PV = NVB * 16 * 64;
  constexpr int KOFF = NKP * 4096;
  constexpr int BUF = KOFF + 2 * PV;
  const int tid = tidx(), lane = tid & 63, wid = tid >> 6, fr = lane & 15, fq = lane >> 4;
  char* ws = wsp(p.ws);
  int smp, b, h, qblk, T, Tk, tok0;
  const bf16_t *kbase, *rbase = nullptr, *vbase, *qbase;
  int kstride, qstride;
  if (MODE == 0) {
    if (item < 256) { smp = 1; b = item >> 6; h = (item >> 3) & 7; qblk = item & 7; T = 1024; Tk = 1536; tok0 = NPR + b * 1024 + qblk * 128; }
    else { const int it = item - 256; smp = 0; b = it >> 4; h = (it >> 1) & 7; qblk = it & 1; T = 256; Tk = 256; tok0 = b * 256 + qblk * 128; }
    const int keyrow0 = smp ? NPR + b * 1536 : b * 256;
    kbase = (const bf16_t*)(ws + O_KB) + (size_t)keyrow0 * 512 + h * 64; kstride = 512;
    rbase = (const bf16_t*)(ws + O_KRA) + (size_t)keyrow0 * 32;
    vbase = (const bf16_t*)(ws + O_VT) + (smp ? (size_t)NPR * 512 + (size_t)(b * 8 + h) * 64 * 1536 : (size_t)(b * 8 + h) * 64 * 256);
    qbase = (const bf16_t*)(ws + O_QB) + (size_t)tok0 * 768 + h * 96; qstride = 768;
  } else {
    if (item < 128) { smp = 1; b = item >> 5; h = (item >> 3) & 3; qblk = item & 7; T = 1024; tok0 = NPR + b * 1024 + qblk * 128; }
    else { const int it = item - 128; smp = 0; b = it >> 3; h = (it >> 1) & 3; qblk = it & 1; T = 256; tok0 = b * 256 + qblk * 128; }
    Tk = T;
    const int ktok0 = smp ? NPR + b * 1024 : b * 256;
    kbase = (const bf16_t*)(ws + O_RK) + (size_t)ktok0 * 256 + h * 64; kstride = 256;
    vbase = (const bf16_t*)(ws + O_RVT) + (smp ? (size_t)NPR * 512 + (size_t)(b * 4 + h) * 128 * 1024 : (size_t)(b * 4 + h) * 128 * 256);
    qbase = (const bf16_t*)(ws + O_RQ) + (size_t)tok0 * 256 + h * 64; qstride = 256;
  }
  const int nkt = Tk >> 6;
  bf16x8 qf[2][NKP];
#pragma unroll
  for (int qb = 0; qb < 2; ++qb)
#pragma unroll
    for (int ks = 0; ks < NKP; ++ks) qf[qb][ks] = *(const bf16x8*)(qbase + (size_t)(wid * 32 + qb * 16 + fr) * qstride + ks * 32 + fq * 8);
  f32x4 o[NVB][2];
#pragma unroll
  for (int vb = 0; vb < NVB; ++vb) { o[vb][0] = (f32x4){0.f, 0.f, 0.f, 0.f}; o[vb][1] = (f32x4){0.f, 0.f, 0.f, 0.f}; }
  float lgf = 0.f, lgb = 0.f;
  float mrow[2] = {-INFINITY, -INFINITY}, lrow[2] = {0.f, 0.f};
  const int tq0 = qblk * 128 + wid * 32 + fr;
  if (MODE == 1) {
    const float xf = p.ret_logit[(l * 2 + 0) * 4 + h], xb = p.ret_logit[(l * 2 + 1) * 4 + h];
    lgf = -log1pf(expf(-xf)) * 1.44269504089f; lgb = -log1pf(expf(-xb)) * 1.44269504089f;
    if (smp) {
      const bf16_t* s0 = (const bf16_t*)(ws + O_S0T);
#pragma unroll
      for (int dir = 0; dir < 2; ++dir) {
        const bf16_t* sb = s0 + ((size_t)(((b * 2 + l) * 2 + dir) * 4 + h) * 128) * 64;
        float dec[2];
#pragma unroll
        for (int qb = 0; qb < 2; ++qb) { const int tq = tq0 + qb * 16; dec[qb] = dir == 0 ? exp2f((float)(tq + 1) * lgf) : exp2f((float)(T - tq) * lgb); }
#pragma unroll
        for (int vb = 0; vb < NVB; ++vb) {
          f32x4 t0 = (f32x4){0.f, 0.f, 0.f, 0.f}, t1 = (f32x4){0.f, 0.f, 0.f, 0.f};
#pragma unroll
          for (int ks = 0; ks < 2; ++ks) {
            const bf16x8 sf = *(const bf16x8*)(sb + (size_t)(vb * 16 + fr) * 64 + ks * 32 + fq * 8);
            t0 = mfma16(sf, qf[0][ks], t0); t1 = mfma16(sf, qf[1][ks], t1);
          }
          o[vb][0] += t0 * dec[0]; o[vb][1] += t1 * dec[1];
        }
      }
    }
  }
  u32x4 kreg[2], rreg, vreg[NVB / 2];
  auto gload = [&](int kt) {
#pragma unroll
    for (int i = 0; i < 2; ++i) { const int idx = tid + 256 * i, key = idx >> 3, c = idx & 7; kreg[i] = ldg16(kbase + (size_t)(kt * 64 + key) * kstride + c * 8); }
    if (MODE == 0) { const int key = tid >> 2, c = tid & 3; rreg = ldg16(rbase + (size_t)(kt * 64 + key) * 32 + c * 8); }
#pragma unroll
    for (int i = 0; i < NVB / 2; ++i) { const int idx = tid + 256 * i, vd = idx >> 3, g = idx & 7; vreg[i] = ldg16(vbase + (size_t)vd * Tk + kt * 64 + g * 8); }
  };
  auto lstore = [&](char* buf) {
#pragma unroll
    for (int i = 0; i < 2; ++i) { const int idx = tid + 256 * i, key = idx >> 3, c = idx & 7; *(u32x4*)(buf + (c >> 2) * 4096 + key * 64 + (((c & 3) ^ swz(key)) << 4)) = kreg[i]; }
    if (MODE == 0) { const int key = tid >> 2, c = tid & 3; *(u32x4*)(buf + 2 * 4096 + key * 64 + ((c ^ swz(key)) << 4)) = rreg; }
#pragma unroll
    for (int i = 0; i < NVB / 2; ++i) {
      const int idx = tid + 256 * i, vd = idx >> 3, g = idx & 7, pnl = g >> 2, g4 = g & 3, hi = g4 >> 1, q0 = 2 * (g4 & 1);
      char* base = buf + KOFF + pnl * PV + vd * 64 + hi * 8;
      *(u32x2*)(base + ((q0 ^ swz(vd)) << 4)) = (u32x2){vreg[i].x, vreg[i].y};
      *(u32x2*)(base + (((q0 + 1) ^ swz(vd)) << 4)) = (u32x2){vreg[i].z, vreg[i].w};
    }
  };
  __syncthreads();
  gload(0); lstore(lds);
  __syncthreads();
  const int foff = fr * 64 + ((fq ^ swz(fr)) << 4);
  for (int kt = 0; kt < nkt; ++kt) {
    char* cur = lds + (kt & 1) * BUF;
    const bool more = (kt + 1) < nkt;
    if (more) gload(kt + 1);
    __builtin_amdgcn_sched_barrier(0);
    f32x4 s[4][2];
#pragma unroll
    for (int kb = 0; kb < 4; ++kb) {
      s[kb][0] = (f32x4){0.f, 0.f, 0.f, 0.f}; s[kb][1] = (f32x4){0.f, 0.f, 0.f, 0.f};
#pragma unroll
      for (int ks = 0; ks < NKP; ++ks) {
        const bf16x8 kf = *(const bf16x8*)(cur + ks * 4096 + kb * 1024 + foff);
        s[kb][0] = mfma16(kf, qf[0][ks], s[kb][0]); s[kb][1] = mfma16(kf, qf[1][ks], s[kb][1]);
      }
    }
    bf16x8 pf[2][2];
#pragma unroll
    for (int qb = 0; qb < 2; ++qb) {
      if (MODE == 0) {
        float mx = s[0][qb][0];
#pragma unroll
        for (int kb = 0; kb < 4; ++kb)
#pragma unroll
          for (int r = 0; r < 4; ++r) mx = fmaxf(mx, s[kb][qb][r]);
        mx = fmaxf(mx, __shfl_xor(mx, 16)); mx = fmaxf(mx, __shfl_xor(mx, 32));
        const float mn = fmaxf(mrow[qb], mx), alpha = exp2f(mrow[qb] - mn);
        mrow[qb] = mn;
        float ls = 0.f;
#pragma unroll
        for (int kb = 0; kb < 4; ++kb)
#pragma unroll
          for (int r = 0; r < 4; ++r) { const float e = exp2f(s[kb][qb][r] - mn); s[kb][qb][r] = e; ls += e; }
        lrow[qb] = lrow[qb] * alpha + ls;
#pragma unroll
        for (int vb = 0; vb < NVB; ++vb) o[vb][qb] *= alpha;
      } else {
        const int tq = tq0 + qb * 16;
#pragma unroll
        for (int kb = 0; kb < 4; ++kb)
#pragma unroll
          for (int r = 0; r < 4; ++r) {
            const int d = tq - (kt * 64 + kb * 16 + fq * 4 + r);
            const float dec = d > 0 ? exp2f((float)d * lgf) : (d < 0 ? exp2f((float)(-d) * lgb) : 2.f);
            s[kb][qb][r] *= dec;
          }
      }
#pragma unroll
      for (int g = 0; g < 2; ++g) {
        u32x4 w; w.x = pk2(s[2 * g][qb][0], s[2 * g][qb][1]); w.y = pk2(s[2 * g][qb][2], s[2 * g][qb][3]);
        w.z = pk2(s[2 * g + 1][qb][0], s[2 * g + 1][qb][1]); w.w = pk2(s[2 * g + 1][qb][2], s[2 * g + 1][qb][3]);
        pf[qb][g] = as_bf8(w);
      }
    }
#pragma unroll
    for (int vb = 0; vb < NVB; ++vb)
#pragma unroll
      for (int g = 0; g < 2; ++g) {
        const bf16x8 vf = *(const bf16x8*)(cur + KOFF + g * PV + vb * 1024 + foff);
        o[vb][0] = mfma16(vf, pf[0][g], o[vb][0]); o[vb][1] = mfma16(vf, pf[1][g], o[vb][1]);
      }
    __builtin_amdgcn_sched_barrier(0);
    if (more) lstore(lds + ((kt + 1) & 1) * BUF);
    __syncthreads();
  }
  bf16_t* G = (bf16_t*)(ws + (MODE == 0 ? O_MZ : O_RZ));
#pragma unroll
  for (int qb = 0; qb < 2; ++qb) {
    const int tok = tok0 + wid * 32 + qb * 16 + fr;
    float mul, sub;
    if (MODE == 0) {
      float lt = lrow[qb]; lt += __shfl_xor(lt, 16); lt += __shfl_xor(lt, 32);
      mul = 1.f / lt; sub = 0.f;
    } else {
      float sm = 0.f;
#pragma unroll
      for (int vb = 0; vb < NVB; ++vb) sm += (o[vb][qb][0] + o[vb][qb][1]) + (o[vb][qb][2] + o[vb][qb][3]);
      sm += __shfl_xor(sm, 16); sm += __shfl_xor(sm, 32);
      const float mu = sm * (1.f / 128.f);
      float vs = 0.f;
#pragma unroll
      for (int vb = 0; vb < NVB; ++vb)
#pragma unroll
        for (int r = 0; r < 4; ++r) { const float dd = o[vb][qb][r] - mu; vs += dd * dd; }
      vs += __shfl_xor(vs, 16); vs += __shfl_xor(vs, 32);
      mul = rsqrtf(vs * (1.f / 128.f) + EPSN); sub = mu;
    }
#pragma unroll
    for (int vb = 0; vb < NVB; ++vb) {
      bf16_t* gp = G + (size_t)tok * 512 + h * (NVB * 16) + vb * 16 + fq * 4;
      const u32x2 gz = *(const u32x2*)gp;
      f32x4 y;
      y[0] = (o[vb][qb][0] - sub) * mul * bflo(gz.x); y[1] = (o[vb][qb][1] - sub) * mul * bfhi(gz.x);
      y[2] = (o[vb][qb][2] - sub) * mul * bflo(gz.y); y[3] = (o[vb][qb][3] - sub) * mul * bfhi(gz.y);
      *(u32x2*)gp = pk4(y);
    }
  }
}

__device__ __forceinline__ bf16x8 scale8(u32x4 raw, const float (&d)[8]) {
  u32x4 w;
  w.x = pk2(bflo(raw.x) * d[0], bfhi(raw.x) * d[1]); w.y = pk2(bflo(raw.y) * d[2], bfhi(raw.y) * d[3]);
  w.z = pk2(bflo(raw.z) * d[4], bfhi(raw.z) * d[5]); w.w = pk2(bflo(raw.w) * d[6], bfhi(raw.w) * d[7]);
  return as_bf8(w);
}
__device__ __forceinline__ void state_item(const Params& p, int l, int item) {
  const int tid = tidx(), lane = tid & 63, wid = tid >> 6, fr = lane & 15, fq = lane >> 4;
  const int b = item >> 2, h = item & 3;
  const bf16_t* RVT = (const bf16_t*)(p.ws + O_RVT) + (size_t)(b * 4 + h) * 128 * 256;
  const bf16_t* RKT = (const bf16_t*)(p.ws + O_RKT) + (size_t)(b * 4 + h) * 64 * 256;
  const float xf = p.ret_logit[(l * 2 + 0) * 4 + h], xb = p.ret_logit[(l * 2 + 1) * 4 + h];
  const float lgf = -log1pf(expf(-xf)) * 1.44269504089f, lgb = -log1pf(expf(-xb)) * 1.44269504089f;
  f32x4 acc[2][2][4];
#pragma unroll
  for (int d = 0; d < 2; ++d)
#pragma unroll
    for (int v = 0; v < 2; ++v)
#pragma unroll
      for (int k = 0; k < 4; ++k) acc[d][v][k] = (f32x4){0.f, 0.f, 0.f, 0.f};
#pragma unroll 1
  for (int ks = 0; ks < 8; ++ks) {
    const int j0 = ks * 32 + fq * 8;
    float df[8], db[8];
#pragma unroll
    for (int e = 0; e < 8; ++e) { df[e] = exp2f((float)(255 - j0 - e) * lgf); db[e] = exp2f((float)(j0 + e) * lgb); }
    bf16x8 af[2];
#pragma unroll
    for (int v = 0; v < 2; ++v) af[v] = *(const bf16x8*)(RVT + (size_t)((wid * 2 + v) * 16 + fr) * 256 + j0);
#pragma unroll
    for (int k = 0; k < 4; ++k) {
      const u32x4 raw = *(const u32x4*)(RKT + (size_t)(k * 16 + fr) * 256 + j0);
      const bf16x8 kf = scale8(raw, df), kb = scale8(raw, db);
#pragma unroll
      for (int v = 0; v < 2; ++v) { acc[0][v][k] = mfma16(af[v], kf, acc[0][v][k]); acc[1][v][k] = mfma16(af[v], kb, acc[1][v][k]); }
    }
  }
  float* O = p.out + OUT_RET;
#pragma unroll
  for (int d = 0; d < 2; ++d)
#pragma unroll
    for (int v = 0; v < 2; ++v)
#pragma unroll
      for (int k = 0; k < 4; ++k) {
        const int dk = k * 16 + fr, vd = (wid * 2 + v) * 16 + fq * 4;
        *(f32x4*)(O + ((size_t)((((b * 2 + l) * 2 + d) * 4 + h) * 64 + dk)) * 128 + vd) = acc[d][v][k];
      }
}

__device__ __forceinline__ void keyprep_item(const Params& p, int l, int item) {
  const int tid = tidx(), lane = tid & 63, wid = tid >> 6;
  char* ws = wsp(p.ws);
  bf16_t* CKVA = (bf16_t*)(ws + O_CKVA);
  bf16_t* KRA = (bf16_t*)(ws + O_KRA);
#pragma unroll 1
  for (int i = 0; i < 16; ++i) {
    const int R = item * 64 + wid * 16 + i;
    int smp = 0, b, t = 0, tok = 0, ctx = 0, pp = 0;
    if (R < NPR) { tok = R; b = R >> 8; t = R & 255; }
    else { smp = 1; const int s = R - NPR; b = s / 1536; pp = s - b * 1536; if (pp < 512) ctx = 1; else { t = pp - 512; tok = NPR + b * 1024 + t; } }
    if (ctx) {
      const f32x4 v = *(const f32x4*)(p.cache_ckv + ((size_t)((b * 2 + l) * 512 + pp)) * 256 + lane * 4);
      *(u32x2*)(CKVA + (size_t)R * 256 + lane * 4) = pk4(v);
      if (lane < 32) KRA[(size_t)R * 32 + lane] = tobf(p.cache_krope[((size_t)((b * 2 + l) * 512 + pp)) * 32 + lane]);
      continue;
    }
    const f32x4 v = *(const f32x4*)((const float*)(ws + O_KVLAT) + (size_t)tok * 256 + lane * 4);
    float ss = v[0] * v[0] + v[1] * v[1] + v[2] * v[2] + v[3] * v[3];
    ss = wave_sum(ss);
    const float rstd = rsqrtf(ss * (1.f / 256.f) + EPSN);
    const f32x4 g = *(const f32x4*)(p.kv_norm_g + l * 256 + lane * 4);
    f32x4 y;
#pragma unroll
    for (int e = 0; e < 4; ++e) y[e] = v[e] * rstd * g[e];
    *(u32x2*)(CKVA + (size_t)R * 256 + lane * 4) = pk4(y);
    if (!smp) *(f32x4*)(p.out + OUT_CKV + ((size_t)((b * 2 + l) * 256 + t)) * 256 + lane * 4) = y;
    const int d = lane & 31;
    const float x = ((const float*)(ws + O_KR))[(size_t)tok * 32 + d];
    float yk = x;
    if (smp) {
      const float pr = __shfl_xor(x, 8);
      const int hd = d >> 4, i16 = d & 15, f = i16 & 7;
      const float pos = (float)(hd ? (t & 63) : (t >> 6));
      const float ang = pos * exp2f(-(float)f * 1.66096404744f);
      const float cs = __cosf(ang), sn = __sinf(ang);
      yk = i16 < 8 ? x * cs - pr * sn : pr * sn + x * cs;
    } else if (lane < 32) {
      p.out[OUT_KR + ((size_t)((b * 2 + l) * 256 + t)) * 32 + d] = x;
    }
    if (lane < 32) KRA[(size_t)R * 32 + d] = tobf(yk);
  }
}

__device__ __forceinline__ void f1_tile(const Params& p, int tile, char* lds) {
  const int tid = tidx(), lane = tid & 63, wid = tid >> 6, wm = wid >> 1, wn = wid & 1, fr = lane & 15, fq = lane >> 4;
  const int m = tile >> 3, g = (tile >> 1) & 3, nh = tile & 1, m0 = m * 128;
  char* ws = wsp(p.ws);
  f32x4 acc[4][4];
  zero_acc(acc);
  gemm_core<false>((const bf16_t*)(ws + O_FU) + (size_t)m0 * 512 + g * 128, 512, (const bf16_t*)(ws + O_CS) + (size_t)nh * 128 * 128, 128, 128, acc, lds);
  bf16_t* UT = (bf16_t*)(ws + O_UT);
#pragma unroll
  for (int i = 0; i < 4; ++i) {
    const int tok = m0 + wm * 64 + i * 16 + fq * 4;
    size_t base; int T, b, t;
    if (tok < NPR) { b = tok >> 8; t = tok & 255; T = 256; base = 0; } else { const int s = tok - NPR; b = s >> 10; t = s & 1023; T = 1024; base = (size_t)NPR * 1024; }
#pragma unroll
    for (int j = 0; j < 4; ++j) {
      const int k2 = wn * 64 + j * 16 + fr;
      *(u32x2*)(UT + base + ((size_t)(b * 4 + g) * 128 + k2) * (2 * T) + nh * T + t) = pk4(acc[i][j]);
    }
  }
}

__device__ __forceinline__ void qup_tile(const Params& p, int l, int tile, char* lds) {
  const int tid = tidx(), lane = tid & 63, wid = tid >> 6, wm = wid >> 1, wn = wid & 1, fr = lane & 15, fq = lane >> 4;
  const int m = tile % 96, nt = tile / 96, m0 = m * 128, n0 = nt * 128;
  char* ws = wsp(p.ws);
  const bf16_t* QL = (const bf16_t*)(ws + O_QLAT) + (size_t)m0 * 384;
  float rsv;
  {
    const bf16_t* q = QL + (size_t)(wm * 64 + lane) * 384;
    float ss = 0.f;
#pragma unroll 4
    for (int i = 0; i < 48; ++i) {
      const u32x4 w = *(const u32x4*)(q + i * 8);
      ss += bflo(w.x) * bflo(w.x) + bfhi(w.x) * bfhi(w.x) + bflo(w.y) * bflo(w.y) + bfhi(w.y) * bfhi(w.y) + bflo(w.z) * bflo(w.z) + bfhi(w.z) * bfhi(w.z) + bflo(w.w) * bflo(w.w) + bfhi(w.w) * bfhi(w.w);
    }
    rsv = rsqrtf(ss * (1.f / 384.f) + EPSN);
  }
  f32x4 acc[4][4];
  zero_acc(acc);
  gemm_core<true>(QL, 384, (const bf16_t*)(ws + O_WQ) + ((size_t)l * 768 + n0) * 384, 384, 384, acc, lds);
  bf16_t* QB = (bf16_t*)(ws + O_QB);
  const float qscale = 0.10206207261596577f * 1.44269504089f;
#pragma unroll
  for (int i = 0; i < 4; ++i) {
    const int rl = wm * 64 + i * 16 + fr, tok = m0 + rl;
    const float sc = __shfl(rsv, i * 16 + fr) * qscale;
    const int smp = tok >= NPR, t = (tok - NPR) & 1023;
#pragma unroll
    for (int j = 0; j < 4; ++j) {
      const int cb = n0 + wn * 64 + j * 16, within = cb % 96;
      f32x4 v = acc[i][j] * sc;
      if (within >= 64) {
        f32x4 pr;
#pragma unroll
        for (int e = 0; e < 4; ++e) pr[e] = __shfl_xor(v[e], 32);
        if (smp) {
          const float pos = (float)(within >= 80 ? (t & 63) : (t >> 6));
#pragma unroll
          for (int e = 0; e < 4; ++e) {
            const int f = (fq & 1) * 4 + e;
            const float ang = pos * exp2f(-(float)f * 1.66096404744f);
            const float cs = __cosf(ang), sn = __sinf(ang);
            v[e] = fq < 2 ? v[e] * cs - pr[e] * sn : pr[e] * sn + v[e] * cs;
          }
        }
      }
      *(u32x2*)(QB + (size_t)tok * 768 + cb + fq * 4) = pk4(v);
    }
  }
}

__device__ __forceinline__ void kvup_tile(const Params& p, int l, int tile, char* lds) {
  const int tid = tidx(), lane = tid & 63, wid = tid >> 6, wm = wid >> 1, wn = wid & 1, fr = lane & 15, fq = lane >> 4;
  const int m = tile % 112, nt = tile / 112, m0 = m * 128, n0 = nt * 128;
  char* ws = wsp(p.ws);
  const bf16_t* A = (const bf16_t*)(ws + O_CKVA) + (size_t)m0 * 256;
  const bf16_t* B = (const bf16_t*)(ws + O_WKV) + ((size_t)l * 1024 + n0) * 256;
  f32x4 acc[4][4];
  zero_acc(acc);
  if (nt < 4) {
    gemm_core<true>(A, 256, B, 256, 256, acc, lds);
    bf16_t* KB = (bf16_t*)(ws + O_KB);
#pragma unroll
    for (int i = 0; i < 4; ++i) {
      const int R = m0 + wm * 64 + i * 16 + fr;
#pragma unroll
      for (int j = 0; j < 4; ++j) *(u32x2*)(KB + (size_t)R * 512 + n0 + wn * 64 + j * 16 + fq * 4) = pk4(acc[i][j]);
    }
  } else {
    gemm_core<false>(A, 256, B, 256, 256, acc, lds);
    bf16_t* VT = (bf16_t*)(ws + O_VT);
#pragma unroll
    for (int i = 0; i < 4; ++i) {
      const int R = m0 + wm * 64 + i * 16 + fq * 4;
      size_t base; int Tk, b, k;
      if (R < NPR) { b = R >> 8; k = R & 255; Tk = 256; base = 0; } else { const int s = R - NPR; b = s / 1536; k = s - b * 1536; Tk = 1536; base = (size_t)NPR * 512; }
#pragma unroll
      for (int j = 0; j < 4; ++j) {
        const int c = n0 - 512 + wn * 64 + j * 16 + fr, h = c >> 6, vd = c & 63;
        *(u32x2*)(VT + base + ((size_t)(b * 8 + h) * 64 + vd) * Tk + k) = pk4(acc[i][j]);
      }
    }
  }
}

__device__ __forceinline__ void f2_tile(const Params& p, int tile, char* lds) {
  const int tid = tidx(), lane = tid & 63, wid = tid >> 6, wm = wid >> 1, wn = wid & 1, fr = lane & 15, fq = lane >> 4;
  char* ws = wsp(p.ws);
  const bf16_t *A, *B; int K, tokb, g; float scale;
  if (tile < 128) {
    const int b = tile >> 5, mt = tile & 7; g = (tile >> 3) & 3;
    A = (const bf16_t*)(ws + O_D1024) + (size_t)mt * 128 * 2048; K = 2048;
    B = (const bf16_t*)(ws + O_UT) + (size_t)NPR * 1024 + (size_t)(b * 4 + g) * 128 * 2048;
    tokb = NPR + b * 1024 + mt * 128; scale = 0.00276213586400995f;
  } else {
    const int it = tile - 128, b = it >> 3, mt = it & 1; g = (it >> 1) & 3;
    A = (const bf16_t*)(ws + O_D256) + (size_t)mt * 128 * 512; K = 512;
    B = (const bf16_t*)(ws + O_UT) + (size_t)(b * 4 + g) * 128 * 512;
    tokb = b * 256 + mt * 128; scale = 0.0055242717280199f;
  }
  f32x4 acc[4][4];
  zero_acc(acc);
  gemm_core<true>(A, K, B, K, K, acc, lds);
  bf16_t* FZ = (bf16_t*)(ws + O_FZ);
#pragma unroll
  for (int i = 0; i < 4; ++i) {
    const int tok = tokb + wm * 64 + i * 16 + fr;
#pragma unroll
    for (int j = 0; j < 4; ++j) {
      bf16_t* gp = FZ + (size_t)tok * 512 + g * 128 + wn * 64 + j * 16 + fq * 4;
      const u32x2 gz = *(const u32x2*)gp;
      f32x4 y;
      y[0] = acc[i][j][0] * scale * bflo(gz.x); y[1] = acc[i][j][1] * scale * bfhi(gz.x);
      y[2] = acc[i][j][2] * scale * bflo(gz.y); y[3] = acc[i][j][3] * scale * bfhi(gz.y);
      *(u32x2*)gp = pk4(y);
    }
  }
}

__device__ __forceinline__ void s6_tile(const Params& p, int l, int tile, char* lds) {
  const int tid = tidx(), lane = tid & 63, wid = tid >> 6, wm = wid >> 1, wn = wid & 1, fr = lane & 15, fq = lane >> 4;
  const int m = tile % 96, nt = tile / 96, m0 = m * 128, n0 = nt * 64;
  char* ws = wsp(p.ws);
  f32x4 tot[4][2], acc[4][2];
  u32x2 sg[4][2];
#pragma unroll
  for (int i = 0; i < 4; ++i) { tot[i][0] = (f32x4){0.f, 0.f, 0.f, 0.f}; tot[i][1] = (f32x4){0.f, 0.f, 0.f, 0.f}; }
#pragma unroll 1
  for (int nb = 0; nb < 3; ++nb) {
#pragma unroll
    for (int i = 0; i < 4; ++i) { acc[i][0] = (f32x4){0.f, 0.f, 0.f, 0.f}; acc[i][1] = (f32x4){0.f, 0.f, 0.f, 0.f}; }
    gemm_core<true, 2>((const bf16_t*)(ws + O_H) + (size_t)m0 * 1024, 1024,
                       (const bf16_t*)(ws + O_WIN) + ((size_t)l * 6912 + 3840 + nb * 1024 + n0) * 1024, 1024, 1024, acc, lds);
#pragma unroll
    for (int i = 0; i < 4; ++i)
#pragma unroll
      for (int j = 0; j < 2; ++j) { f32x4 sv;
#pragma unroll
        for (int e = 0; e < 4; ++e) sv[e] = sigm_f(acc[i][j][e]);
        sg[i][j] = pk4(sv); }
#pragma unroll
    for (int i = 0; i < 4; ++i) { acc[i][0] = (f32x4){0.f, 0.f, 0.f, 0.f}; acc[i][1] = (f32x4){0.f, 0.f, 0.f, 0.f}; }
    const size_t boff = nb == 0 ? O_RZ : (nb == 1 ? O_MZ : O_FZ);
    gemm_core<true, 2>((const bf16_t*)(ws + boff) + (size_t)m0 * 512, 512,
                       (const bf16_t*)(ws + O_WBR) + ((size_t)(l * 3 + nb) * 1024 + n0) * 512, 512, 512, acc, lds);
#pragma unroll
    for (int i = 0; i < 4; ++i)
#pragma unroll
      for (int j = 0; j < 2; ++j) {
        tot[i][j][0] += acc[i][j][0] * bflo(sg[i][j].x); tot[i][j][1] += acc[i][j][1] * bfhi(sg[i][j].x);
        tot[i][j][2] += acc[i][j][2] * bflo(sg[i][j].y); tot[i][j][3] += acc[i][j][3] * bfhi(sg[i][j].y);
      }
  }
  bf16_t* MG = (bf16_t*)(ws + O_UT);
#pragma unroll
  for (int i = 0; i < 4; ++i) {
    const int tok = m0 + wm * 64 + i * 16 + fr;
#pragma unroll
    for (int j = 0; j < 2; ++j) *(u32x2*)(MG + (size_t)tok * 1024 + n0 + wn * 32 + j * 16 + fq * 4) = pk4(tot[i][j]);
  }
}

__device__ __forceinline__ void s7_tile(const Params& p, int l, int tile, const float* xp, const float* xs, char* lds) {
  const int tid = tidx(), lane = tid & 63, wid = tid >> 6, wm = wid >> 1, wn = wid & 1, fr = lane & 15, fq = lane >> 4;
  const int m = tile % 96, nt = tile / 96, m0 = m * 128, n0 = nt * 128;
  char* ws = wsp(p.ws);
  f32x4 acc[4][4];
  zero_acc(acc);
  gemm_core<true>((const bf16_t*)(ws + O_UT) + (size_t)m0 * 1024, 1024, (const bf16_t*)(ws + O_WO) + ((size_t)l * 1024 + n0) * 1024, 1024, 1024, acc, lds);
#pragma unroll
  for (int i = 0; i < 4; ++i) {
    const int tok = m0 + wm * 64 + i * 16 + fr;
    const float* src = tok < NPR ? xp + (size_t)tok * 1024 : xs + (size_t)(tok - NPR) * 1024;
    const int v = tok < NPR ? 0 : 1 + ((tok - NPR) >> 10);
    const float* gate = (const float*)(ws + O_MOD) + (l * 5 + v) * 3072 + 2048;
#pragma unroll
    for (int j = 0; j < 4; ++j) {
      const int col = n0 + wn * 64 + j * 16 + fq * 4;
      const f32x4 x = *(const f32x4*)(src + col), gt = *(const f32x4*)(gate + col);
      f32x4 y;
#pragma unroll
      for (int e = 0; e < 4; ++e) y[e] = x[e] + gt[e] * acc[i][j][e];
      *(f32x4*)(p.out + (size_t)tok * 1024 + col) = y;
    }
  }
}

constexpr int NPHASE = 16;
__device__ __forceinline__ void run_phase(const Params& p, int ph, char* lds) {
  const int bid = blockIdx.x, nb = gridDim.x;
  if (ph == 0) { for (int i = bid; i < P0_N; i += nb) phase0_item(p, i, lds); return; }
  if (ph == 15) { for (int i = bid; i < 768; i += nb) final_item(p, i); return; }
  const int l = (ph - 1) / 7, s = (ph - 1) % 7;
  const float* xp = l == 0 ? p.x_prompt : p.out;
  const float* xs = l == 0 ? p.x_sample : p.out + (size_t)NPR * 1024;
  switch (s) {
    case 0: for (int i = bid; i < 768; i += nb) norm_item(p, l, i, xp, xs); break;
    case 1: for (int i = bid; i < 2880; i += nb) s2_tile(p, l, i, lds); break;
    case 2:
      for (int i = bid; i < 1504; i += nb) {
        if (i < 384) attn_item<1>(p, l, i, lds);
        else if (i < 512) state_item(p, l, i - 384);
        else if (i < 736) keyprep_item(p, l, i - 512);
        else f1_tile(p, i - 736, lds);
      }
      break;
    case 3:
      for (int i = bid; i < 1856; i += nb) {
        if (i < 384) f2_tile(p, i, lds);
        else if (i < 1280) kvup_tile(p, l, i - 384, lds);
        else qup_tile(p, l, i - 1280, lds);
      }
      break;
    case 4: for (int i = bid; i < 768; i += nb) attn_item<0>(p, l, i, lds); break;
    case 5: for (int i = bid; i < 1536; i += nb) s6_tile(p, l, i, lds); break;
    case 6: for (int i = bid; i < 768; i += nb) s7_tile(p, l, i, xp, xs, lds); break;
  }
}

#define XB_TMO      128
#define XB_XCNT(j)  (256  + 64 * (j))
#define XB_XSUB(j)  (1280 + 64 * (j))
#define XB_XGEN(j)  (2304 + 64 * (j))
#define XB_TOP      3328
#define XB_TOPGEN   3392
#define XCD_BAR_WORDS 3456
#define XB_SPIN_CAP (1u << 18)
__device__ __forceinline__ unsigned xb_ld(unsigned* p)              { return __hip_atomic_load(p, __ATOMIC_RELAXED, __HIP_MEMORY_SCOPE_AGENT); }
__device__ __forceinline__ unsigned xb_add(unsigned* p, unsigned v) { return __hip_atomic_fetch_add(p, v, __ATOMIC_RELAXED, __HIP_MEMORY_SCOPE_AGENT); }
__device__ __forceinline__ unsigned xb_xcc_id() { return (unsigned)__builtin_amdgcn_s_getreg((3 << 11) | 20) & 0xFu; }
#define XB_SPIN(cond, bar) do { unsigned _sp = 0; while (cond) { __builtin_amdgcn_s_sleep(1); \
    if ((++_sp & 255u) == 0u) { if (xb_ld(&(bar)[XB_TMO])) break; if (_sp > XB_SPIN_CAP) { atomicAdd(&(bar)[XB_TMO], 1u); break; } } } } while (0)
__device__ __forceinline__ void xcd_barrier_complete(unsigned* bar, unsigned x, unsigned& nloc, unsigned& nx) {
  const unsigned G = gridDim.x;
  unsigned sum, cnt, mine, sp = 0u;
  for (;;) {
    sum = 0u; cnt = 0u; mine = 0u;
#pragma unroll
    for (unsigned j = 0; j < 16; ++j) { const unsigned c = xb_ld(&bar[XB_XCNT(j)]); sum += c; cnt += (c > 0u) ? 1u : 0u; mine = (j == x) ? c : mine; }
    if (sum == G) break;
    __builtin_amdgcn_s_sleep(1);
    if ((++sp & 255u) == 0u) { if (xb_ld(&bar[XB_TMO])) break; if (sp > XB_SPIN_CAP) { atomicAdd(&bar[XB_TMO], 1u); break; } }
  }
  nloc = mine > 0u ? mine : 1u; nx = cnt > 0u ? cnt : 1u;
}
__device__ __forceinline__ void xcd_barrier(unsigned* bar, unsigned x, unsigned& nloc, unsigned& nx) {
  asm volatile("s_waitcnt vmcnt(0)" ::: "memory");
  __syncthreads();
  if (threadIdx.x == 0) {
    __builtin_amdgcn_s_waitcnt(0);
    if (nloc == 0u) xcd_barrier_complete(bar, x, nloc, nx);
    const unsigned old = xb_add(&bar[XB_XSUB(x)], 1u);
    const unsigned gen = old / nloc;
    if (old + 1u == (gen + 1u) * nloc) {
      __builtin_amdgcn_fence(__ATOMIC_RELEASE, "agent");
      asm volatile("s_waitcnt vmcnt(0)" ::: "memory");
      const unsigned og = xb_add(&bar[XB_TOP], 1u);
      const unsigned tg = og / nx;
      if (og + 1u == (tg + 1u) * nx) xb_add(&bar[XB_TOPGEN], 1u);
      else XB_SPIN(xb_ld(&bar[XB_TOPGEN]) == tg, bar);
      __builtin_amdgcn_fence(__ATOMIC_ACQUIRE, "agent");
      xb_add(&bar[XB_XGEN(x)], 1u);
      asm volatile("s_waitcnt vmcnt(0)" ::: "memory");
    } else {
      XB_SPIN(xb_ld(&bar[XB_XGEN(x)]) == gen, bar);
      __builtin_amdgcn_fence(__ATOMIC_ACQUIRE, "agent");
      asm volatile("s_waitcnt vmcnt(0)" ::: "memory");
    }
  }
  __syncthreads();
}

__global__ void __launch_bounds__(256, 2) mk_fwd(Params p) {
  __shared__ __attribute__((aligned(16))) char lds[LDS_TOTAL];
  cg::grid_group grid = cg::this_grid();
  unsigned* bar = (unsigned*)(p.ws + O_BAR);
  const unsigned xcc = xb_xcc_id();
  if (threadIdx.x == 0) (void)xb_add(&bar[XB_XCNT(xcc)], 1u);
  unsigned nloc = 0u, nx = 0u;
  if (gridDim.x == 0x7fffffffu) grid.sync();
#pragma unroll 1
  for (int ph = 0; ph < NPHASE; ++ph) {
    run_phase(p, ph, lds);
    if (ph + 1 < NPHASE) xcd_barrier(bar, xcc, nloc, nx);
  }
}

__global__ void __launch_bounds__(256, 2) ph_fwd(Params p, int ph) {
  __shared__ __attribute__((aligned(16))) char lds[LDS_TOTAL];
  run_phase(p, ph, lds);
}

extern "C" void kernel_launch(void* const* d_in, const int* in_sizes, int n_in, void* d_out, int out_size, void* d_ws, size_t ws_size,
                              hipStream_t stream) {
  Params p{};
  p.x_prompt = (const float*)d_in[0]; p.x_sample = (const float*)d_in[1]; p.cache_ckv = (const float*)d_in[2]; p.cache_krope = (const float*)d_in[3];
  p.state_ret = (const float*)d_in[4]; p.c = (const float*)d_in[5]; p.c_ctx = (const float*)d_in[6]; p.norm_g = (const float*)d_in[7];
  p.w_mod = (const float*)d_in[8]; p.b_mod = (const float*)d_in[9]; p.w_in = (const float*)d_in[10]; p.ret_logit = (const float*)d_in[11];
  p.q_norm_g = (const float*)d_in[12]; p.w_q_up = (const float*)d_in[13]; p.kv_norm_g = (const float*)d_in[14]; p.w_kv_up = (const float*)d_in[15];
  p.w_branch = (const float*)d_in[16]; p.w_out = (const float*)d_in[17]; p.final_g = (const float*)d_in[18];
  p.out = (float*)d_out; p.ws = (char*)d_ws;
#if ONE_LAUNCH
  static int grid_blocks = 0;
  if (!grid_blocks) {
    int dev = 0, cus = 0, per_cu = 0;
    hipGetDevice(&dev);
    hipDeviceGetAttribute(&cus, hipDeviceAttributeMultiprocessorCount, dev);
    hipOccupancyMaxActiveBlocksPerMultiprocessor(&per_cu, mk_fwd, 256, 0);
    if (per_cu > 2) per_cu = 2;
    grid_blocks = cus * per_cu;
  }
  hipMemsetAsync((char*)d_ws + O_BAR, 0, XCD_BAR_WORDS * 4, stream);
  void* args[] = {&p};
  hipError_t e = hipLaunchCooperativeKernel((void*)mk_fwd, dim3(grid_blocks), dim3(256), args, 0, stream);
  if (e != hipSuccess) fprintf(stderr, "cooperative launch failed: %s (grid %d)\n", hipGetErrorString(e), grid_blocks);
#else
#ifndef STOP_AFTER
#define STOP_AFTER 15
#endif
  for (int ph = 0; ph <= STOP_AFTER; ++ph) ph_fwd<<<512, 256, 0, stream>>>(p, ph);
#endif
}
```

```cpp
#include <hip/hip_runtime.h>
#include <hip/hip_cooperative_groups.h>
#include <stdint.h>
#include <stdio.h>
namespace cg = cooperative_groups;

#ifndef ONE_LAUNCH
#define ONE_LAUNCH 1
#endif

typedef unsigned short bf16_t;
typedef short bf16x8 __attribute__((ext_vector_type(8)));
typedef float f32x4 __attribute__((ext_vector_type(4)));
typedef unsigned u32x4 __attribute__((ext_vector_type(4)));
typedef unsigned u32x2 __attribute__((ext_vector_type(2)));

constexpr int NTOK = 12288, NPR = 8192, NKEY = 14336;
constexpr float EPSN = 1e-6f;

constexpr size_t O_WIN   = 0;
constexpr size_t O_WQ    = O_WIN   + (size_t)2 * 6912 * 1024 * 2;
constexpr size_t O_WKV   = O_WQ    + (size_t)2 * 768 * 384 * 2;
constexpr size_t O_WBR   = O_WKV   + (size_t)2 * 1024 * 256 * 2;
constexpr size_t O_WO    = O_WBR   + (size_t)6 * 1024 * 512 * 2;
constexpr size_t O_CS    = O_WO    + (size_t)2 * 1024 * 1024 * 2;
constexpr size_t O_D256  = O_CS    + (size_t)256 * 128 * 2;
constexpr size_t O_D1024 = O_D256  + (size_t)256 * 512 * 2;
constexpr size_t O_S0T   = O_D1024 + (size_t)1024 * 2048 * 2;
constexpr size_t O_MOD   = O_S0T   + (size_t)64 * 128 * 64 * 2;
constexpr size_t O_H     = O_MOD   + (size_t)2 * 5 * 3072 * 4;
constexpr size_t O_UT    = O_H     + (size_t)NTOK * 1024 * 2;
constexpr size_t O_RQ    = O_UT    + (size_t)NTOK * 1024 * 2;
constexpr size_t O_RK    = O_RQ    + (size_t)NTOK * 256 * 2;
constexpr size_t O_RKT   = O_RK    + (size_t)NTOK * 256 * 2;
constexpr size_t O_RVT   = O_RKT   + (size_t)NPR * 256 * 2;
constexpr size_t O_KVLAT = O_RVT   + (size_t)NTOK * 512 * 2;
constexpr size_t O_KR    = O_KVLAT + (size_t)NTOK * 256 * 4;
constexpr size_t O_R2END = O_KR    + (size_t)NTOK * 32 * 4;
constexpr size_t O_QB    = O_RQ;
constexpr size_t O_VT    = O_QB    + (size_t)NTOK * 768 * 2;
static_assert(O_VT + (size_t)NKEY * 512 * 2 <= O_R2END, "alias overflow");
constexpr size_t O_RZ    = O_R2END;
constexpr size_t O_MZ    = O_RZ    + (size_t)NTOK * 512 * 2;
constexpr size_t O_FZ    = O_MZ    + (size_t)NTOK * 512 * 2;
constexpr size_t O_FU    = O_FZ    + (size_t)NTOK * 512 * 2;
constexpr size_t O_QLAT  = O_FU    + (size_t)NTOK * 512 * 2;
constexpr size_t O_CKVA  = O_QLAT  + (size_t)NTOK * 384 * 2;
constexpr size_t O_KB    = O_CKVA  + (size_t)NKEY * 256 * 2;
constexpr size_t O_KRA   = O_KB    + (size_t)NKEY * 512 * 2;
constexpr size_t O_END   = O_KRA   + (size_t)NKEY * 32 * 2;
constexpr size_t O_BAR   = (O_END + 255) & ~(size_t)255;
static_assert(O_BAR + 16384 <= (size_t)256 * 1024 * 1024, "workspace too large");

constexpr size_t OUT_CKV = (size_t)NTOK * 1024;
constexpr size_t OUT_KR  = OUT_CKV + (size_t)32 * 2 * 256 * 256;
constexpr size_t OUT_RET = OUT_KR + (size_t)32 * 2 * 256 * 32;

struct Params {
  const float *x_prompt, *x_sample, *cache_ckv, *cache_krope, *state_ret, *c, *c_ctx, *norm_g, *w_mod, *b_mod,
      *w_in, *ret_logit, *q_norm_g, *w_q_up, *kv_norm_g, *w_kv_up, *w_branch, *w_out, *final_g;
  float* out;
  char* ws;
};

constexpr int PANEL = 128 * 64;
constexpr int ABYTES = 2 * PANEL;
constexpr int STAGE = 2 * ABYTES;
constexpr int LDS_GEMM = 2 * STAGE;
constexpr int LDS_TOTAL = LDS_GEMM;
static_assert(LDS_TOTAL <= 65536, "static LDS");

typedef float f32x2 __attribute__((ext_vector_type(2)));
typedef __bf16 bf16x2v __attribute__((ext_vector_type(2)));
__device__ __forceinline__ unsigned pk2(float lo, float hi) { const f32x2 v = {lo, hi}; return __builtin_bit_cast(unsigned, __builtin_convertvector(v, bf16x2v)); }
__device__ __forceinline__ bf16_t tobf(float x) { return (bf16_t)(pk2(x, 0.f) & 0xffffu); }
__device__ __forceinline__ float bflo(unsigned u) { return __uint_as_float(u << 16); }
__device__ __forceinline__ float bfhi(unsigned u) { return __uint_as_float(u & 0xffff0000u); }
__device__ __forceinline__ float silu_f(float x) { return x / (1.f + __expf(-x)); }
__device__ __forceinline__ float sigm_f(float x) { return 1.f / (1.f + __expf(-x)); }
__device__ __forceinline__ u32x2 pk4(f32x4 v) { u32x2 r; r.x = pk2(v[0], v[1]); r.y = pk2(v[2], v[3]); return r; }
#define GAS __attribute__((address_space(1)))
#define LAS __attribute__((address_space(3)))
__device__ __forceinline__ u32x4 ldg16(const void* p) { return *(const GAS u32x4*)p; }
__device__ __forceinline__ int tidx() { int t = threadIdx.x; asm volatile("" : "+v"(t)); return t; }
__device__ __forceinline__ char* wsp(const char* w) { unsigned long long v = (unsigned long long)w; asm volatile("" : "+s"(v)); return (char*)v; }
__device__ __forceinline__ int swz(int r) { return (0 - ((r >> 2) & 3)) & 3; }
__device__ __forceinline__ float wave_sum(float v) {
#pragma unroll
  for (int o = 1; o < 64; o <<= 1) v += __shfl_xor(v, o);
  return v;
}
__device__ __forceinline__ f32x4 mfma16(bf16x8 a, bf16x8 b, f32x4 c) { return __builtin_amdgcn_mfma_f32_16x16x32_bf16(a, b, c, 0, 0, 0); }
__device__ __forceinline__ bf16x8 as_bf8(u32x4 v) { return __builtin_bit_cast(bf16x8, v); }

__device__ __forceinline__ void zero_acc(f32x4 (&acc)[4][4]) {
#pragma unroll
  for (int i = 0; i < 4; ++i)
#pragma unroll
    for (int j = 0; j < 4; ++j) acc[i][j] = (f32x4){0.f, 0.f, 0.f, 0.f};
}

template <bool SWAP, int NJ = 4>
__device__ __forceinline__ void gemm_core(const bf16_t* __restrict__ A, int lda, const bf16_t* __restrict__ B, int ldb, int K,
                                          f32x4 (&acc)[4][NJ], char* lds) {
  const int tid = tidx(), lane = tid & 63, wm = (tid >> 6) >> 1, wn = (tid >> 6) & 1;
  const int wid = __builtin_amdgcn_readfirstlane(tid >> 6);
  const int fr = lane & 15, fq = lane >> 4;
  const int fa = (wm * 64 + fr) * 64 + ((fq ^ swz(fr)) << 4);
  const int fb = ABYTES + (wn * NJ * 16 + fr) * 64 + ((fq ^ swz(fr)) << 4);
  const int lrow = lane >> 2, lchunk = (lane & 3) ^ swz(lrow);
  constexpr int NBL = NJ / 2;
  const GAS char* gA = (const GAS char*)(A + (size_t)(wid * 32 + lrow) * lda + lchunk * 8);
  const GAS char* gB = (const GAS char*)(B + (size_t)(wid * NBL * 16 + lrow) * ldb + lchunk * 8);
  const size_t a16 = (size_t)16 * lda * 2, b16 = (size_t)16 * ldb * 2;
  LAS char* ldsA = (LAS char*)lds + wid * 2048;
  LAS char* ldsB = (LAS char*)lds + ABYTES + wid * NBL * 1024;
  const int nk = K >> 6;
#define GC_ISSUE(stage, kbyte) do { \
    _Pragma("unroll") for (int g = 0; g < 2; ++g) _Pragma("unroll") for (int pn = 0; pn < 2; ++pn) \
      __builtin_amdgcn_global_load_lds((const GAS unsigned*)(gA + g * a16 + (kbyte) + pn * 64), (LAS unsigned*)(ldsA + (stage) + pn * PANEL + g * 1024), 16, 0, 0); \
    _Pragma("unroll") for (int g = 0; g < NBL; ++g) _Pragma("unroll") for (int pn = 0; pn < 2; ++pn) \
      __builtin_amdgcn_global_load_lds((const GAS unsigned*)(gB + g * b16 + (kbyte) + pn * 64), (LAS unsigned*)(ldsB + (stage) + pn * PANEL + g * 1024), 16, 0, 0); \
  } while (0)
  GC_ISSUE(0, 0);
  asm volatile("s_waitcnt vmcnt(0)" ::: "memory");
  __syncthreads();
  for (int kt = 0; kt < nk; ++kt) {
    char* cur = lds + (kt & 1) * STAGE;
    if (kt + 1 < nk) GC_ISSUE(((kt + 1) & 1) * STAGE, (size_t)(kt + 1) * 128);
    __builtin_amdgcn_sched_barrier(0);
#pragma unroll
    for (int ks = 0; ks < 2; ++ks) {
      bf16x8 af[4], bfr[NJ];
#pragma unroll
      for (int i = 0; i < 4; ++i) af[i] = *(const bf16x8*)(cur + ks * PANEL + fa + i * 1024);
#pragma unroll
      for (int j = 0; j < NJ; ++j) bfr[j] = *(const bf16x8*)(cur + ks * PANEL + fb + j * 1024);
#pragma unroll
      for (int i = 0; i < 4; ++i)
#pragma unroll
        for (int j = 0; j < NJ; ++j) acc[i][j] = SWAP ? mfma16(bfr[j], af[i], acc[i][j]) : mfma16(af[i], bfr[j], acc[i][j]);
    }
    __builtin_amdgcn_sched_barrier(0);
    asm volatile("s_waitcnt vmcnt(0)" ::: "memory");
    __syncthreads();
  }
#undef GC_ISSUE
}

__device__ __forceinline__ void tr_tile(const float* __restrict__ src, int lds_, int k0, int ns0, bf16_t* __restrict__ dst, int ldd, int nd0,
                                        const float* __restrict__ ksc, char* lds) {
  bf16_t* T = (bf16_t*)lds;
  const int tid = tidx();
  __syncthreads();
#pragma unroll
  for (int i = 0; i < 2; ++i) {
    const int kk = (tid >> 3) + 32 * i, nn4 = (tid & 7) * 4;
    const f32x4 v = *(const f32x4*)(src + (size_t)(k0 + kk) * lds_ + ns0 + nn4);
    const float s = ksc ? ksc[k0 + kk] : 1.f;
#pragma unroll
    for (int e = 0; e < 4; ++e) T[(nn4 + e) * 72 + kk] = tobf(v[e] * s);
  }
  __syncthreads();
  const int nn = tid >> 3, kc = (tid & 7) * 8;
  const u32x4 w = *(const u32x4*)(T + nn * 72 + kc);
  *(u32x4*)(dst + (size_t)(nd0 + nn) * ldd + k0 + kc) = w;
}

constexpr int P0_GEMV = 192, P0_WIN = 6816, P0_WQ = 288, P0_WKV = 256, P0_WBR = 1536, P0_WO = 1024, P0_S0 = 256, P0_PAD = 96, P0_TAB = 1104;
constexpr int P0_N = P0_GEMV + P0_WIN + P0_WQ + P0_WKV + P0_WBR + P0_WO + P0_S0 + P0_PAD + P0_TAB;

__device__ __forceinline__ void phase0_item(const Params& p, int j, char* lds) {
  const int tid = tidx();
  char* ws = wsp(p.ws);
  if (j < P0_GEMV) {
    const int l = j / 96, cgi = j % 96;
    float* sv = (float*)lds;
    float* red = (float*)(lds + 20480);
    __syncthreads();
    for (int i = tid; i < 5120; i += 256) { const int v = i >> 10, k = i & 1023; const float x = (v == 0) ? p.c_ctx[k] : p.c[(v - 1) * 1024 + k]; sv[i] = silu_f(x); }
    __syncthreads();
    const int c4 = tid & 7, kg = tid >> 3;
    const float* w = p.w_mod + (size_t)l * 1024 * 3072 + cgi * 32 + c4 * 4;
    f32x4 a0 = {0.f, 0.f, 0.f, 0.f}, a1 = a0, a2 = a0, a3 = a0, a4 = a0;
#pragma unroll 8
    for (int k = kg * 32; k < kg * 32 + 32; ++k) {
      const f32x4 wv = *(const GAS f32x4*)(w + (size_t)k * 3072);
      a0 += wv * sv[k]; a1 += wv * sv[1024 + k]; a2 += wv * sv[2048 + k]; a3 += wv * sv[3072 + k]; a4 += wv * sv[4096 + k];
    }
    *(f32x4*)(red + (kg * 5 + 0) * 32 + c4 * 4) = a0; *(f32x4*)(red + (kg * 5 + 1) * 32 + c4 * 4) = a1; *(f32x4*)(red + (kg * 5 + 2) * 32 + c4 * 4) = a2;
    *(f32x4*)(red + (kg * 5 + 3) * 32 + c4 * 4) = a3; *(f32x4*)(red + (kg * 5 + 4) * 32 + c4 * 4) = a4;
    __syncthreads();
    if (tid < 160) {
      const int v = tid >> 5, c2 = tid & 31;
      float sm = p.b_mod[l * 3072 + cgi * 32 + c2];
#pragma unroll 8
      for (int g = 0; g < 32; ++g) sm += red[(g * 5 + v) * 32 + c2];
      ((float*)(ws + O_MOD))[(l * 5 + v) * 3072 + cgi * 32 + c2] = sm;
    }
    return;
  }
  j -= P0_GEMV;
  if (j < P0_WIN) {
    const int l = j / 3408, r = j % 3408, kt = r / 213, nt = r % 213, c0 = nt * 32;
    const int nd0 = c0 < 2176 ? c0 : (c0 < 2208 ? 3712 + (c0 - 2176) : (c0 < 3744 ? c0 - 32 : c0 + 96));
    tr_tile(p.w_in + (size_t)l * 1024 * 6816, 6816, kt * 64, c0, (bf16_t*)(ws + O_WIN) + (size_t)l * 6912 * 1024, 1024, nd0, nullptr, lds);
    return;
  }
  j -= P0_WIN;
  if (j < P0_WQ) {
    const int l = j / 144, r = j % 144, kt = r / 24, nt = r % 24;
    tr_tile(p.w_q_up + (size_t)l * 384 * 768, 768, kt * 64, nt * 32, (bf16_t*)(ws + O_WQ) + (size_t)l * 768 * 384, 384, nt * 32, p.q_norm_g + l * 384, lds);
    return;
  }
  j -= P0_WQ;
  if (j < P0_WKV) {
    const int l = j / 128, r = j % 128, kt = r / 32, nt = r % 32, c0 = nt * 32, h = c0 >> 7, e = c0 & 127;
    const int nd0 = e < 64 ? h * 64 + e : 512 + h * 64 + (e - 64);
    tr_tile(p.w_kv_up + (size_t)l * 256 * 1024, 1024, kt * 64, c0, (bf16_t*)(ws + O_WKV) + (size_t)l * 1024 * 256, 256, nd0, nullptr, lds);
    return;
  }
  j -= P0_WKV;
  if (j < P0_WBR) {
    const int mat = j / 256, r = j % 256, kt = r / 32, nt = r % 32;
    tr_tile(p.w_branch + (size_t)mat * 512 * 1024, 1024, kt * 64, nt * 32, (bf16_t*)(ws + O_WBR) + (size_t)mat * 1024 * 512, 512, nt * 32, nullptr, lds);
    return;
  }
  j -= P0_WBR;
  if (j < P0_WO) {
    const int l = j / 512, r = j % 512, kt = r / 32, nt = r % 32;
    tr_tile(p.w_out + (size_t)l * 1024 * 1024, 1024, kt * 64, nt * 32, (bf16_t*)(ws + O_WO) + (size_t)l * 1024 * 1024, 1024, nt * 32, nullptr, lds);
    return;
  }
  j -= P0_WO;
  if (j < P0_S0) {
    const int mat = j >> 2, nt = j & 3;
    tr_tile(p.state_ret + (size_t)mat * 64 * 128, 128, 0, nt * 32, (bf16_t*)(ws + O_S0T) + (size_t)mat * 128 * 64, 64, nt * 32, nullptr, lds);
    return;
  }
  j -= P0_S0;
  if (j < P0_PAD) {
    const int l = j / 48, r = j % 48;
    bf16_t* d = (bf16_t*)(ws + O_WIN) + ((size_t)l * 6912 + 3744) * 1024 + (size_t)r * 2048 + tid * 8;
    *(u32x4*)d = (u32x4){0u, 0u, 0u, 0u};
    return;
  }
  j -= P0_PAD;
  {
    float v[8];
    bf16_t* dst;
    if (j < 16) {
      const int e0 = j * 2048 + tid * 8; dst = (bf16_t*)(ws + O_CS) + e0;
      const int n = e0 >> 7, k = e0 & 127;
#pragma unroll
      for (int e = 0; e < 8; ++e) {
        const float fr = (float)(((n & 127) * (k + e)) & 127) * (1.f / 128.f);
        v[e] = (n < 128) ? __builtin_amdgcn_cosf(fr) : __builtin_amdgcn_sinf(fr);
      }
    } else if (j < 80) {
      const int e0 = (j - 16) * 2048 + tid * 8; dst = (bf16_t*)(ws + O_D256) + e0;
      const int k1 = e0 >> 9, kk = e0 & 511;
#pragma unroll
      for (int e = 0; e < 8; ++e) {
        const int t = (kk + e) & 255;
        const float fr = (float)((k1 * t) & 255) * (1.f / 256.f);
        v[e] = (kk < 256) ? __builtin_amdgcn_cosf(fr) : -__builtin_amdgcn_sinf(fr);
      }
    } else {
      const int e0 = (j - 80) * 2048 + tid * 8; dst = (bf16_t*)(ws + O_D1024) + e0;
      const int k1 = e0 >> 11, kk = e0 & 2047;
#pragma unroll
      for (int e = 0; e < 8; ++e) {
        const int t = (kk + e) & 1023;
        const float fr = (float)((k1 * t) & 1023) * (1.f / 1024.f);
        v[e] = (kk < 1024) ? __builtin_amdgcn_cosf(fr) : -__builtin_amdgcn_sinf(fr);
      }
    }
    u32x4 w; w.x = pk2(v[0], v[1]); w.y = pk2(v[2], v[3]); w.z = pk2(v[4], v[5]); w.w = pk2(v[6], v[7]);
    *(u32x4*)dst = w;
  }
}

__device__ __forceinline__ void norm_item(const Params& p, int l, int item, const float* xp, const float* xs) {
  const int tid = tidx(), lane = tid & 63, wid = tid >> 6;
  bf16_t* H = (bf16_t*)(p.ws + O_H);
#pragma unroll
  for (int i = 0; i < 4; ++i) {
    const int row = item * 16 + wid * 4 + i;
    const float* src = row < NPR ? xp + (size_t)row * 1024 : xs + (size_t)(row - NPR) * 1024;
    const int v = row < NPR ? 0 : 1 + ((row - NPR) >> 10);
    const float* mod = (const float*)(p.ws + O_MOD) + (l * 5 + v) * 3072;
    f32x4 x[4]; float ss = 0.f;
#pragma unroll
    for (int q = 0; q < 4; ++q) { x[q] = *(const f32x4*)(src + (q * 64 + lane) * 4); ss += x[q][0] * x[q][0] + x[q][1] * x[q][1] + x[q][2] * x[q][2] + x[q][3] * x[q][3]; }
    ss = wave_sum(ss);
    const float rstd = rsqrtf(ss * (1.f / 1024.f) + EPSN);
#pragma unroll
    for (int q = 0; q < 4; ++q) {
      const int col = (q * 64 + lane) * 4;
      const f32x4 g = *(const f32x4*)(p.norm_g + l * 1024 + col), sc = *(const f32x4*)(mod + 1024 + col), sh = *(const f32x4*)(mod + col);
      f32x4 h;
#pragma unroll
      for (int e = 0; e < 4; ++e) h[e] = x[q][e] * rstd * g[e] * (1.f + sc[e]) + sh[e];
      *(u32x2*)(H + (size_t)row * 1024 + col) = pk4(h);
    }
  }
}
__device__ __forceinline__ void final_item(const Params& p, int item) {
  const int tid = tidx(), lane = tid & 63, wid = tid >> 6;
#pragma unroll
  for (int i = 0; i < 4; ++i) {
    const int row = item * 16 + wid * 4 + i;
    float* src = p.out + (size_t)row * 1024;
    f32x4 x[4]; float ss = 0.f;
#pragma unroll
    for (int q = 0; q < 4; ++q) { x[q] = *(const f32x4*)(src + (q * 64 + lane) * 4); ss += x[q][0] * x[q][0] + x[q][1] * x[q][1] + x[q][2] * x[q][2] + x[q][3] * x[q][3]; }
    ss = wave_sum(ss);
    const float rstd = rsqrtf(ss * (1.f / 1024.f) + EPSN);
#pragma unroll
    for (int q = 0; q < 4; ++q) {
      const int col = (q * 64 + lane) * 4;
      const f32x4 g = *(const f32x4*)(p.final_g + col);
      f32x4 y;
#pragma unroll
      for (int e = 0; e < 4; ++e) y[e] = x[q][e] * rstd * g[e];
      *(f32x4*)(src + col) = y;
    }
  }
}

__device__ __forceinline__ void s2_tile(const Params& p, int l, int tile, char* lds) {
  const int tid = tidx(), lane = tid & 63, wid = tid >> 6, wm = wid >> 1, wn = wid & 1, fr = lane & 15, fq = lane >> 4;
  const int m = tile % 96, nt = tile / 96, m0 = m * 128, n0 = nt * 128;
  char* ws = wsp(p.ws);
  const bf16_t* A = (const bf16_t*)(ws + O_H) + (size_t)m0 * 1024;
  const bf16_t* B = (const bf16_t*)(ws + O_WIN) + ((size_t)l * 6912 + n0) * 1024;
  f32x4 acc[4][4];
  zero_acc(acc);
  if (nt >= 4 && nt < 8) {
    gemm_core<false>(A, 1024, B, 1024, 1024, acc, lds);
    bf16_t* RVT = (bf16_t*)(ws + O_RVT);
#pragma unroll
    for (int i = 0; i < 4; ++i) {
      const int tok = m0 + wm * 64 + i * 16 + fq * 4;
      size_t base; int T, b, t;
      if (tok < NPR) { b = tok >> 8; t = tok & 255; T = 256; base = 0; } else { const int s = tok - NPR; b = s >> 10; t = s & 1023; T = 1024; base = (size_t)NPR * 512; }
#pragma unroll
      for (int j = 0; j < 4; ++j) {
        const int c = n0 - 512 + wn * 64 + j * 16 + fr, h = c >> 7, vd = c & 127;
        *(u32x2*)(RVT + base + ((size_t)(b * 4 + h) * 128 + vd) * T + t) = pk4(acc[i][j]);
      }
    }
    return;
  }
  gemm_core<true>(A, 1024, B, 1024, 1024, acc, lds);
  bf16_t* dst = nullptr; int ld = 0, c0 = 0, op = 0;
  if (nt < 2) { dst = (bf16_t*)(ws + O_RQ); ld = 256; c0 = 0; }
  else if (nt < 4) { dst = (bf16_t*)(ws + O_RK); ld = 256; c0 = 256; op = 2; }
  else if (nt < 12) { dst = (bf16_t*)(ws + O_RZ); ld = 512; c0 = 1024; op = 1; }
  else if (nt < 15) { dst = (bf16_t*)(ws + O_QLAT); ld = 384; c0 = 1536; }
  else if (nt < 17) { ld = 256; c0 = 1920; op = 3; }
  else if (nt < 21) { dst = (bf16_t*)(ws + O_MZ); ld = 512; c0 = 2176; op = 1; }
  else if (nt < 25) { dst = (bf16_t*)(ws + O_FU); ld = 512; c0 = 2688; }
  else if (nt < 29) { dst = (bf16_t*)(ws + O_FZ); ld = 512; c0 = 3200; op = 1; }
  else { ld = 32; c0 = 3712; op = 4; }
#pragma unroll
  for (int i = 0; i < 4; ++i) {
    const int tok = m0 + wm * 64 + i * 16 + fr;
#pragma unroll
    for (int j = 0; j < 4; ++j) {
      const int col = n0 - c0 + wn * 64 + j * 16 + fq * 4;
      f32x4 v = acc[i][j];
      if (op == 3) { *(f32x4*)((float*)(ws + O_KVLAT) + (size_t)tok * 256 + col) = v; continue; }
      if (op == 4) { if (col < 32) *(f32x4*)((float*)(ws + O_KR) + (size_t)tok * 32 + col) = v; continue; }
      if (op == 1) {
#pragma unroll
        for (int e = 0; e < 4; ++e) v[e] = silu_f(v[e]);
      } else if (op == 2) {
#pragma unroll
        for (int e = 0; e < 4; ++e) v[e] *= 0.125f;
      }
      const u32x2 w = pk4(v);
      *(u32x2*)(dst + (size_t)tok * ld + col) = w;
      if (op == 2 && tok < NPR) {
        bf16_t* RKT = (bf16_t*)(ws + O_RKT);
        const int b = tok >> 8, t = tok & 255, h = col >> 6, dk = col & 63;
        bf16_t* q = RKT + ((size_t)(b * 4 + h) * 64 + dk) * 256 + t;
        q[0] = (bf16_t)(w.x & 0xffffu); q[256] = (bf16_t)(w.x >> 16); q[512] = (bf16_t)(w.y & 0xffffu); q[768] = (bf16_t)(w.y >> 16);
      }
    }
  }
}

template <int MODE>
__device__ __forceinline__ void attn_item(const Params& p, int l, int item, char* lds) {
  constexpr int NKP = MODE == 0 ? 3 : 2;
  constexpr int NVB = MODE == 0 ? 4 : 8;
  constexpr int PV = NVB * 16 * 64;
  constexpr int KOFF = NKP * 4096;
  constexpr int BUF = KOFF + 2 * PV;
  const int tid = tidx(), lane = tid & 63, wid = tid >> 6, fr = lane & 15, fq = lane >> 4;
  char* ws = wsp(p.ws);
  int smp, b, h, qblk, T, Tk, tok0;
  const bf16_t *kbase, *rbase = nullptr, *vbase, *qbase;
  int kstride, qstride;
  if (MODE == 0) {
    if (item < 256) { smp = 1; b = item >> 6; h = (item >> 3) & 7; qblk = item & 7; T = 1024; Tk = 1536; tok0 = NPR + b * 1024 + qblk * 128; }
    else { const int it = item - 256; smp = 0; b = it >> 4; h = (it >> 1) & 7; qblk = it & 1; T = 256; Tk = 256; tok0 = b * 256 + qblk * 128; }
    const int keyrow0 = smp ? NPR + b * 1536 : b * 256;
    kbase = (const bf16_t*)(ws + O_KB) + (size_t)keyrow0 * 512 + h * 64; kstride = 512;
    rbase = (const bf16_t*)(ws + O_KRA) + (size_t)keyrow0 * 32;
    vbase = (const bf16_t*)(ws + O_VT) + (smp ? (size_t)NPR * 512 + (size_t)(b * 8 + h) * 64 * 1536 : (size_t)(b * 8 + h) * 64 * 256);
    qbase = (const bf16_t*)(ws + O_QB) + (size_t)tok0 * 768 + h * 96; qstride = 768;
  } else {
    if (item < 128) { smp = 1; b = item >> 5; h = (item >> 3) & 3; qblk = item & 7; T = 1024; tok0 = NPR + b * 1024 + qblk * 128; }
    else { const int it = item - 128; smp = 0; b = it >> 3; h = (it >> 1) & 3; qblk = it & 1; T = 256; tok0 = b * 256 + qblk * 128; }
    Tk = T;
    const int ktok0 = smp ? NPR + b * 1024 : b * 256;
    kbase = (const bf16_t*)(ws + O_RK) + (size_t)ktok0 * 256 + h * 64; kstride = 256;
    vbase = (const bf16_t*)(ws + O_RVT) + (smp ? (size_t)NPR * 512 + (size_t)(b * 4 + h) * 128 * 1024 : (size_t)(b * 4 + h) * 128 * 256);
    qbase = (const bf16_t*)(ws + O_RQ) + (size_t)tok0 * 256 + h * 64; qstride = 256;
  }
  const int nkt = Tk >> 6;
  bf16x8 qf[2][NKP];
#pragma unroll
  for (int qb = 0; qb < 2; ++qb)
#pragma unroll
    for (int ks = 0; ks < NKP; ++ks) qf[qb][ks] = *(const bf16x8*)(qbase + (size_t)(wid * 32 + qb * 16 + fr) * qstride + ks * 32 + fq * 8);
  f32x4 o[NVB][2];
#pragma unroll
  for (int vb = 0; vb < NVB; ++vb) { o[vb][0] = (f32x4){0.f, 0.f, 0.f, 0.f}; o[vb][1] = (f32x4){0.f, 0.f, 0.f, 0.f}; }
  float lgf = 0.f, lgb = 0.f;
  float mrow[2] = {-INFINITY, -INFINITY}, lrow[2] = {0.f, 0.f};
  const int tq0 = qblk * 128 + wid * 32 + fr;
  if (MODE == 1) {
    const float xf = p.ret_logit[(l * 2 + 0) * 4 + h], xb = p.ret_logit[(l * 2 + 1) * 4 + h];
    lgf = -log1pf(expf(-xf)) * 1.44269504089f; lgb = -log1pf(expf(-xb)) * 1.44269504089f;
    if (smp) {
      const bf16_t* s0 = (const bf16_t*)(ws + O_S0T);
#pragma unroll
      for (int dir = 0; dir < 2; ++dir) {
        const bf16_t* sb = s0 + ((size_t)(((b * 2 + l) * 2 + dir) * 4 + h) * 128) * 64;
        float dec[2];
#pragma unroll
        for (int qb = 0; qb < 2; ++qb) { const int tq = tq0 + qb * 16; dec[qb] = dir == 0 ? exp2f((float)(tq + 1) * lgf) : exp2f((float)(T - tq) * lgb); }
#pragma unroll
        for (int vb = 0; vb < NVB; ++vb) {
          f32x4 t0 = (f32x4){0.f, 0.f, 0.f, 0.f}, t1 = (f32x4){0.f, 0.f, 0.f, 0.f};
#pragma unroll
          for (int ks = 0; ks < 2; ++ks) {
            const bf16x8 sf = *(const bf16x8*)(sb + (size_t)(vb * 16 + fr) * 64 + ks * 32 + fq * 8);
            t0 = mfma16(sf, qf[0][ks], t0); t1 = mfma16(sf, qf[1][ks], t1);
          }
          o[vb][0] += t0 * dec[0]; o[vb][1] += t1 * dec[1];
        }
      }
    }
  }
  u32x4 vreg[NVB / 2];
  const int uw = __builtin_amdgcn_readfirstlane(wid);
  const int dkey = lane >> 2, dchunk = (lane & 3) ^ swz(dkey);
  auto kdma = [&](int kt, char* buf) {
    const GAS bf16_t* kp = (const GAS bf16_t*)kbase + (size_t)(kt * 64 + uw * 16 + dkey) * kstride + dchunk * 8;
#pragma unroll
    for (int pn = 0; pn < 2; ++pn)
      __builtin_amdgcn_global_load_lds((const GAS unsigned*)(kp + pn * 32), (LAS unsigned*)((LAS char*)buf + pn * 4096 + uw * 1024), 16, 0, 0);
    if (MODE == 0) {
      const GAS bf16_t* rp = (const GAS bf16_t*)rbase + (size_t)(kt * 64 + uw * 16 + dkey) * 32 + dchunk * 8;
      __builtin_amdgcn_global_load_lds((const GAS unsigned*)rp, (LAS unsigned*)((LAS char*)buf + 2 * 4096 + uw * 1024), 16, 0, 0);
    }
  };
  auto gload = [&](int kt) {
#pragma unroll
    for (int i = 0; i < NVB / 2; ++i) { const int idx = tid + 256 * i, vd = idx >> 3, g = idx & 7; vreg[i] = ldg16(vbase + (size_t)vd * Tk + kt * 64 + g * 8); }
  };
  auto lstore = [&](char* buf) {
#pragma unroll
    for (int i = 0; i < NVB / 2; ++i) {
      const int idx = tid + 256 * i, vd = idx >> 3, g = idx & 7, pnl = g >> 2, g4 = g & 3, hi = g4 >> 1, q0 = 2 * (g4 & 1);
      char* base = buf + KOFF + pnl * PV + vd * 64 + hi * 8;
      *(u32x2*)(base + ((q0 ^ swz(vd)) << 4)) = (u32x2){vreg[i].x, vreg[i].y};
      *(u32x2*)(base + (((q0 + 1) ^ swz(vd)) << 4)) = (u32x2){vreg[i].z, vreg[i].w};
    }
  };
  __syncthreads();
  kdma(0, lds); gload(0); lstore(lds);
  asm volatile("s_waitcnt vmcnt(0)" ::: "memory");
  __syncthreads();
  const int foff = fr * 64 + ((fq ^ swz(fr)) << 4);
  for (int kt = 0; kt < nkt; ++kt) {
    char* cur = lds + (kt & 1) * BUF;
    const bool more = (kt + 1) < nkt;
    if (more) { kdma(kt + 1, lds + ((kt + 1) & 1) * BUF); gload(kt + 1); }
    __builtin_amdgcn_sched_barrier(0);
    f32x4 s[4][2];
#pragma unroll
    for (int kb = 0; kb < 4; ++kb) {
      s[kb][0] = (f32x4){0.f, 0.f, 0.f, 0.f}; s[kb][1] = (f32x4){0.f, 0.f, 0.f, 0.f};
#pragma unroll
      for (int ks = 0; ks < NKP; ++ks) {
        const bf16x8 kf = *(const bf16x8*)(cur + ks * 4096 + kb * 1024 + foff);
        s[kb][0] = mfma16(kf, qf[0][ks], s[kb][0]); s[kb][1] = mfma16(kf, qf[1][ks], s[kb][1]);
      }
    }
    bf16x8 pf[2][2];
#pragma unroll
    for (int qb = 0; qb < 2; ++qb) {
      if (MODE == 0) {
        float mx = s[0][qb][0];
#pragma unroll
        for (int kb = 0; kb < 4; ++kb)
#pragma unroll
          for (int r = 0; r < 4; ++r) mx = fmaxf(mx, s[kb][qb][r]);
        mx = fmaxf(mx, __shfl_xor(mx, 16)); mx = fmaxf(mx, __shfl_xor(mx, 32));
        const float mn = fmaxf(mrow[qb], mx), alpha = exp2f(mrow[qb] - mn);
        mrow[qb] = mn;
        float ls = 0.f;
#pragma unroll
        for (int kb = 0; kb < 4; ++kb)
#pragma unroll
          for (int r = 0; r < 4; ++r) { const float e = exp2f(s[kb][qb][r] - mn); s[kb][qb][r] = e; ls += e; }
        lrow[qb] = lrow[qb] * alpha + ls;
#pragma unroll
        for (int vb = 0; vb < NVB; ++vb) o[vb][qb] *= alpha;
      } else {
        const int tq = tq0 + qb * 16;
#pragma unroll
        for (int kb = 0; kb < 4; ++kb)
#pragma unroll
          for (int r = 0; r < 4; ++r) {
            const int d = tq - (kt * 64 + kb * 16 + fq * 4 + r);
            const float dec = d > 0 ? exp2f((float)d * lgf) : (d < 0 ? exp2f((float)(-d) * lgb) : 2.f);
            s[kb][qb][r] *= dec;
          }
      }
#pragma unroll
      for (int g = 0; g < 2; ++g) {
        u32x4 w; w.x = pk2(s[2 * g][qb][0], s[2 * g][qb][1]); w.y = pk2(s[2 * g][qb][2], s[2 * g][qb][3]);
        w.z = pk2(s[2 * g + 1][qb][0], s[2 * g + 1][qb][1]); w.w = pk2(s[2 * g + 1][qb][2], s[2 * g + 1][qb][3]);
        pf[qb][g] = as_bf8(w);
      }
    }
#pragma unroll
    for (int vb = 0; vb < NVB; ++vb)
#pragma unroll
      for (int g = 0; g < 2; ++g) {
        const bf16x8 vf = *(const bf16x8*)(cur + KOFF + g * PV + vb * 1024 + foff);
        o[vb][0] = mfma16(vf, pf[0][g], o[vb][0]); o[vb][1] = mfma16(vf, pf[1][g], o[vb][1]);
      }
    __builtin_amdgcn_sched_barrier(0);
    if (more) lstore(lds + ((kt + 1) & 1) * BUF);
    asm volatile("s_waitcnt vmcnt(0)" ::: "memory");
    __syncthreads();
  }
  bf16_t* G = (bf16_t*)(ws + (MODE == 0 ? O_MZ : O_RZ));
#pragma unroll
  for (int qb = 0; qb < 2; ++qb) {
    const int tok = tok0 + wid * 32 + qb * 16 + fr;
    float mul, sub;
    if (MODE == 0) {
      float lt = lrow[qb]; lt += __shfl_xor(lt, 16); lt += __shfl_xor(lt, 32);
      mul = 1.f / lt; sub = 0.f;
    } else {
      float sm = 0.f;
#pragma unroll
      for (int vb = 0; vb < NVB; ++vb) sm += (o[vb][qb][0] + o[vb][qb][1]) + (o[vb][qb][2] + o[vb][qb][3]);
      sm += __shfl_xor(sm, 16); sm += __shfl_xor(sm, 32);
      const float mu = sm * (1.f / 128.f);
      float vs = 0.f;
#pragma unroll
      for (int vb = 0; vb < NVB; ++vb)
#pragma unroll
        for (int r = 0; r < 4; ++r) { const float dd = o[vb][qb][r] - mu; vs += dd * dd; }
      vs += __shfl_xor(vs, 16); vs += __shfl_xor(vs, 32);
      mul = rsqrtf(vs * (1.f / 128.f) + EPSN); sub = mu;
    }
#pragma unroll
    for (int vb = 0; vb < NVB; ++vb) {
      bf16_t* gp = G + (size_t)tok * 512 + h * (NVB * 16) + vb * 16 + fq * 4;
      const u32x2 gz = *(const u32x2*)gp;
      f32x4 y;
      y[0] = (o[vb][qb][0] - sub) * mul * bflo(gz.x); y[1] = (o[vb][qb][1] - sub) * mul * bfhi(gz.x);
      y[2] = (o[vb][qb][2] - sub) * mul * bflo(gz.y); y[3] = (o[vb][qb][3] - sub) * mul * bfhi(gz.y);
      *(u32x2*)gp = pk4(y);
    }
  }
}

__device__ __forceinline__ bf16x8 scale8(u32x4 raw, const float (&d)[8]) {
  u32x4 w;
  w.x = pk2(bflo(raw.x) * d[0], bfhi(raw.x) * d[1]); w.y = pk2(bflo(raw.y) * d[2], bfhi(raw.y) * d[3]);
  w.z = pk2(bflo(raw.z) * d[4], bfhi(raw.z) * d[5]); w.w = pk2(bflo(raw.w) * d[6], bfhi(raw.w) * d[7]);
  return as_bf8(w);
}
__device__ __forceinline__ void state_item(const Params& p, int l, int item) {
  const int tid = tidx(), lane = tid & 63, wid = tid >> 6, fr = lane & 15, fq = lane >> 4;
  const int b = item >> 2, h = item & 3;
  const bf16_t* RVT = (const bf16_t*)(p.ws + O_RVT) + (size_t)(b * 4 + h) * 128 * 256;
  const bf16_t* RKT = (const bf16_t*)(p.ws + O_RKT) + (size_t)(b * 4 + h) * 64 * 256;
  const float xf = p.ret_logit[(l * 2 + 0) * 4 + h], xb = p.ret_logit[(l * 2 + 1) * 4 + h];
  const float lgf = -log1pf(expf(-xf)) * 1.44269504089f, lgb = -log1pf(expf(-xb)) * 1.44269504089f;
  f32x4 acc[2][2][4];
#pragma unroll
  for (int d = 0; d < 2; ++d)
#pragma unroll
    for (int v = 0; v < 2; ++v)
#pragma unroll
      for (int k = 0; k < 4; ++k) acc[d][v][k] = (f32x4){0.f, 0.f, 0.f, 0.f};
#pragma unroll 1
  for (int ks = 0; ks < 8; ++ks) {
    const int j0 = ks * 32 + fq * 8;
    float df[8], db[8];
#pragma unroll
    for (int e = 0; e < 8; ++e) { df[e] = exp2f((float)(255 - j0 - e) * lgf); db[e] = exp2f((float)(j0 + e) * lgb); }
    bf16x8 af[2];
#pragma unroll
    for (int v = 0; v < 2; ++v) af[v] = *(const bf16x8*)(RVT + (size_t)((wid * 2 + v) * 16 + fr) * 256 + j0);
#pragma unroll
    for (int k = 0; k < 4; ++k) {
      const u32x4 raw = *(const u32x4*)(RKT + (size_t)(k * 16 + fr) * 256 + j0);
      const bf16x8 kf = scale8(raw, df), kb = scale8(raw, db);
#pragma unroll
      for (int v = 0; v < 2; ++v) { acc[0][v][k] = mfma16(af[v], kf, acc[0][v][k]); acc[1][v][k] = mfma16(af[v], kb, acc[1][v][k]); }
    }
  }
  float* O = p.out + OUT_RET;
#pragma unroll
  for (int d = 0; d < 2; ++d)
#pragma unroll
    for (int v = 0; v < 2; ++v)
#pragma unroll
      for (int k = 0; k < 4; ++k) {
        const int dk = k * 16 + fr, vd = (wid * 2 + v) * 16 + fq * 4;
        *(f32x4*)(O + ((size_t)((((b * 2 + l) * 2 + d) * 4 + h) * 64 + dk)) * 128 + vd) = acc[d][v][k];
      }
}

__device__ __forceinline__ void keyprep_item(const Params& p, int l, int item) {
  const int tid = tidx(), lane = tid & 63, wid = tid >> 6;
  char* ws = wsp(p.ws);
  bf16_t* CKVA = (bf16_t*)(ws + O_CKVA);
  bf16_t* KRA = (bf16_t*)(ws + O_KRA);
#pragma unroll 1
  for (int i = 0; i < 4; ++i) {
    const int R = item * 16 + wid * 4 + i;
    int smp = 0, b, t = 0, tok = 0, ctx = 0, pp = 0;
    if (R < NPR) { tok = R; b = R >> 8; t = R & 255; }
    else { smp = 1; const int s = R - NPR; b = s / 1536; pp = s - b * 1536; if (pp < 512) ctx = 1; else { t = pp - 512; tok = NPR + b * 1024 + t; } }
    if (ctx) {
      const f32x4 v = *(const f32x4*)(p.cache_ckv + ((size_t)((b * 2 + l) * 512 + pp)) * 256 + lane * 4);
      *(u32x2*)(CKVA + (size_t)R * 256 + lane * 4) = pk4(v);
      if (lane < 32) KRA[(size_t)R * 32 + lane] = tobf(p.cache_krope[((size_t)((b * 2 + l) * 512 + pp)) * 32 + lane]);
      continue;
    }
    const f32x4 v = *(const f32x4*)((const float*)(ws + O_KVLAT) + (size_t)tok * 256 + lane * 4);
    float ss = v[0] * v[0] + v[1] * v[1] + v[2] * v[2] + v[3] * v[3];
    ss = wave_sum(ss);
    const float rstd = rsqrtf(ss * (1.f / 256.f) + EPSN);
    const f32x4 g = *(const f32x4*)(p.kv_norm_g + l * 256 + lane * 4);
    f32x4 y;
#pragma unroll
    for (int e = 0; e < 4; ++e) y[e] = v[e] * rstd * g[e];
    *(u32x2*)(CKVA + (size_t)R * 256 + lane * 4) = pk4(y);
    if (!smp) *(f32x4*)(p.out + OUT_CKV + ((size_t)((b * 2 + l) * 256 + t)) * 256 + lane * 4) = y;
    const int d = lane & 31;
    const float x = ((const float*)(ws + O_KR))[(size_t)tok * 32 + d];
    float yk = x;
    if (smp) {
      const float pr = __shfl_xor(x, 8);
      const int hd = d >> 4, i16 = d & 15, f = i16 & 7;
      const float pos = (float)(hd ? (t & 63) : (t >> 6));
      const float ang = pos * exp2f(-(float)f * 1.66096404744f);
      const float cs = __cosf(ang), sn = __sinf(ang);
      yk = i16 < 8 ? x * cs - pr * sn : pr * sn + x * cs;
    } else if (lane < 32) {
      p.out[OUT_KR + ((size_t)((b * 2 + l) * 256 + t)) * 32 + d] = x;
    }
    if (lane < 32) KRA[(size_t)R * 32 + d] = tobf(yk);
  }
}

__device__ __forceinline__ void f1_tile(const Params& p, int tile, char* lds) {
  const int tid = tidx(), lane = tid & 63, wid = tid >> 6, wm = wid >> 1, wn = wid & 1, fr = lane & 15, fq = lane >> 4;
  const int m = tile >> 3, g = (tile >> 1) & 3, nh = tile & 1, m0 = m * 128;
  char* ws = wsp(p.ws);
  f32x4 acc[4][4];
  zero_acc(acc);
  gemm_core<false>((const bf16_t*)(ws + O_FU) + (size_t)m0 * 512 + g * 128, 512, (const bf16_t*)(ws + O_CS) + (size_t)nh * 128 * 128, 128, 128, acc, lds);
  bf16_t* UT = (bf16_t*)(ws + O_UT);
#pragma unroll
  for (int i = 0; i < 4; ++i) {
    const int tok = m0 + wm * 64 + i * 16 + fq * 4;
    size_t base; int T, b, t;
    if (tok < NPR) { b = tok >> 8; t = tok & 255; T = 256; base = 0; } else { const int s = tok - NPR; b = s >> 10; t = s & 1023; T = 1024; base = (size_t)NPR * 1024; }
#pragma unroll
    for (int j = 0; j < 4; ++j) {
      const int k2 = wn * 64 + j * 16 + fr;
      *(u32x2*)(UT + base + ((size_t)(b * 4 + g) * 128 + k2) * (2 * T) + nh * T + t) = pk4(acc[i][j]);
    }
  }
}

__device__ __forceinline__ void qup_tile(const Params& p, int l, int tile, char* lds) {
  const int tid = tidx(), lane = tid & 63, wid = tid >> 6, wm = wid >> 1, wn = wid & 1, fr = lane & 15, fq = lane >> 4;
  const int m = tile % 96, nt = tile / 96, m0 = m * 128, n0 = nt * 128;
  char* ws = wsp(p.ws);
  const bf16_t* QL = (const bf16_t*)(ws + O_QLAT) + (size_t)m0 * 384;
  float rsv;
  {
    const bf16_t* q = QL + (size_t)(wm * 64 + lane) * 384;
    float ss = 0.f;
#pragma unroll 4
    for (int i = 0; i < 48; ++i) {
      const u32x4 w = *(const u32x4*)(q + i * 8);
      ss += bflo(w.x) * bflo(w.x) + bfhi(w.x) * bfhi(w.x) + bflo(w.y) * bflo(w.y) + bfhi(w.y) * bfhi(w.y) + bflo(w.z) * bflo(w.z) + bfhi(w.z) * bfhi(w.z) + bflo(w.w) * bflo(w.w) + bfhi(w.w) * bfhi(w.w);
    }
    rsv = rsqrtf(ss * (1.f / 384.f) + EPSN);
  }
  f32x4 acc[4][4];
  zero_acc(acc);
  gemm_core<true>(QL, 384, (const bf16_t*)(ws + O_WQ) + ((size_t)l * 768 + n0) * 384, 384, 384, acc, lds);
  bf16_t* QB = (bf16_t*)(ws + O_QB);
  const float qscale = 0.10206207261596577f * 1.44269504089f;
#pragma unroll
  for (int i = 0; i < 4; ++i) {
    const int rl = wm * 64 + i * 16 + fr, tok = m0 + rl;
    const float sc = __shfl(rsv, i * 16 + fr) * qscale;
    const int smp = tok >= NPR, t = (tok - NPR) & 1023;
#pragma unroll
    for (int j = 0; j < 4; ++j) {
      const int cb = n0 + wn * 64 + j * 16, within = cb % 96;
      f32x4 v = acc[i][j] * sc;
      if (within >= 64) {
        f32x4 pr;
#pragma unroll
        for (int e = 0; e < 4; ++e) pr[e] = __shfl_xor(v[e], 32);
        if (smp) {
          const float pos = (float)(within >= 80 ? (t & 63) : (t >> 6));
#pragma unroll
          for (int e = 0; e < 4; ++e) {
            const int f = (fq & 1) * 4 + e;
            const float ang = pos * exp2f(-(float)f * 1.66096404744f);
            const float cs = __cosf(ang), sn = __sinf(ang);
            v[e] = fq < 2 ? v[e] * cs - pr[e] * sn : pr[e] * sn + v[e] * cs;
          }
        }
      }
      *(u32x2*)(QB + (size_t)tok * 768 + cb + fq * 4) = pk4(v);
    }
  }
}

__device__ __forceinline__ void kvup_tile(const Params& p, int l, int tile, char* lds) {
  const int tid = tidx(), lane = tid & 63, wid = tid >> 6, wm = wid >> 1, wn = wid & 1, fr = lane & 15, fq = lane >> 4;
  const int m = tile % 112, nt = tile / 112, m0 = m * 128, n0 = nt * 128;
  char* ws = wsp(p.ws);
  const bf16_t* A = (const bf16_t*)(ws + O_CKVA) + (size_t)m0 * 256;
  const bf16_t* B = (const bf16_t*)(ws + O_WKV) + ((size_t)l * 1024 + n0) * 256;
  f32x4 acc[4][4];
  zero_acc(acc);
  if (nt < 4) {
    gemm_core<true>(A, 256, B, 256, 256, acc, lds);
    bf16_t* KB = (bf16_t*)(ws + O_KB);
#pragma unroll
    for (int i = 0; i < 4; ++i) {
      const int R = m0 + wm * 64 + i * 16 + fr;
#pragma unroll
      for (int j = 0; j < 4; ++j) *(u32x2*)(KB + (size_t)R * 512 + n0 + wn * 64 + j * 16 + fq * 4) = pk4(acc[i][j]);
    }
  } else {
    gemm_core<false>(A, 256, B, 256, 256, acc, lds);
    bf16_t* VT = (bf16_t*)(ws + O_VT);
#pragma unroll
    for (int i = 0; i < 4; ++i) {
      const int R = m0 + wm * 64 + i * 16 + fq * 4;
      size_t base; int Tk, b, k;
      if (R < NPR) { b = R >> 8; k = R & 255; Tk = 256; base = 0; } else { const int s = R - NPR; b = s / 1536; k = s - b * 1536; Tk = 1536; base = (size_t)NPR * 512; }
#pragma unroll
      for (int j = 0; j < 4; ++j) {
        const int c = n0 - 512 + wn * 64 + j * 16 + fr, h = c >> 6, vd = c & 63;
        *(u32x2*)(VT + base + ((size_t)(b * 8 + h) * 64 + vd) * Tk + k) = pk4(acc[i][j]);
      }
    }
  }
}

__device__ __forceinline__ void f2_tile(const Params& p, int tile, char* lds) {
  const int tid = tidx(), lane = tid & 63, wid = tid >> 6, wm = wid >> 1, wn = wid & 1, fr = lane & 15, fq = lane >> 4;
  char* ws = wsp(p.ws);
  const bf16_t *A, *B; int K, tokb, g; float scale;
  if (tile < 128) {
    const int b = tile >> 5, mt = tile & 7; g = (tile >> 3) & 3;
    A = (const bf16_t*)(ws + O_D1024) + (size_t)mt * 128 * 2048; K = 2048;
    B = (const bf16_t*)(ws + O_UT) + (size_t)NPR * 1024 + (size_t)(b * 4 + g) * 128 * 2048;
    tokb = NPR + b * 1024 + mt * 128; scale = 0.00276213586400995f;
  } else {
    const int it = tile - 128, b = it >> 3, mt = it & 1; g = (it >> 1) & 3;
    A = (const bf16_t*)(ws + O_D256) + (size_t)mt * 128 * 512; K = 512;
    B = (const bf16_t*)(ws + O_UT) + (size_t)(b * 4 + g) * 128 * 512;
    tokb = b * 256 + mt * 128; scale = 0.0055242717280199f;
  }
  f32x4 acc[4][4];
  zero_acc(acc);
  gemm_core<true>(A, K, B, K, K, acc, lds);
  bf16_t* FZ = (bf16_t*)(ws + O_FZ);
#pragma unroll
  for (int i = 0; i < 4; ++i) {
    const int tok = tokb + wm * 64 + i * 16 + fr;
#pragma unroll
    for (int j = 0; j < 4; ++j) {
      bf16_t* gp = FZ + (size_t)tok * 512 + g * 128 + wn * 64 + j * 16 + fq * 4;
      const u32x2 gz = *(const u32x2*)gp;
      f32x4 y;
      y[0] = acc[i][j][0] * scale * bflo(gz.x); y[1] = acc[i][j][1] * scale * bfhi(gz.x);
      y[2] = acc[i][j][2] * scale * bflo(gz.y); y[3] = acc[i][j][3] * scale * bfhi(gz.y);
      *(u32x2*)gp = pk4(y);
    }
  }
}

__device__ __forceinline__ void s6_tile(const Params& p, int l, int tile, char* lds) {
  const int tid = tidx(), lane = tid & 63, wid = tid >> 6, wm = wid >> 1, wn = wid & 1, fr = lane & 15, fq = lane >> 4;
  const int m = tile % 96, nt = tile / 96, m0 = m * 128, n0 = nt * 64;
  char* ws = wsp(p.ws);
  f32x4 tot[4][2], acc[4][2];
  u32x2 sg[4][2];
#pragma unroll
  for (int i = 0; i < 4; ++i) { tot[i][0] = (f32x4){0.f, 0.f, 0.f, 0.f}; tot[i][1] = (f32x4){0.f, 0.f, 0.f, 0.f}; }
#pragma unroll 1
  for (int nb = 0; nb < 3; ++nb) {
#pragma unroll
    for (int i = 0; i < 4; ++i) { acc[i][0] = (f32x4){0.f, 0.f, 0.f, 0.f}; acc[i][1] = (f32x4){0.f, 0.f, 0.f, 0.f}; }
    gemm_core<true, 2>((const bf16_t*)(ws + O_H) + (size_t)m0 * 1024, 1024,
                       (const bf16_t*)(ws + O_WIN) + ((size_t)l * 6912 + 3840 + nb * 1024 + n0) * 1024, 1024, 1024, acc, lds);
#pragma unroll
    for (int i = 0; i < 4; ++i)
#pragma unroll
      for (int j = 0; j < 2; ++j) { f32x4 sv;
#pragma unroll
        for (int e = 0; e < 4; ++e) sv[e] = sigm_f(acc[i][j][e]);
        sg[i][j] = pk4(sv); }
#pragma unroll
    for (int i = 0; i < 4; ++i) { acc[i][0] = (f32x4){0.f, 0.f, 0.f, 0.f}; acc[i][1] = (f32x4){0.f, 0.f, 0.f, 0.f}; }
    const size_t boff = nb == 0 ? O_RZ : (nb == 1 ? O_MZ : O_FZ);
    gemm_core<true, 2>((const bf16_t*)(ws + boff) + (size_t)m0 * 512, 512,
                       (const bf16_t*)(ws + O_WBR) + ((size_t)(l * 3 + nb) * 1024 + n0) * 512, 512, 512, acc, lds);
#pragma unroll
    for (int i = 0; i < 4; ++i)
#pragma unroll
      for (int j = 0; j < 2; ++j) {
        tot[i][j][0] += acc[i][j][0] * bflo(sg[i][j].x); tot[i][j][1] += acc[i][j][1] * bfhi(sg[i][j].x);
        tot[i][j][2] += acc[i][j][2] * bflo(sg[i][j].y); tot[i][j][3] += acc[i][j][3] * bfhi(sg[i][j].y);
      }
  }
  bf16_t* MG = (bf16_t*)(ws + O_UT);
#pragma unroll
  for (int i = 0; i < 4; ++i) {
    const int tok = m0 + wm * 64 + i * 16 + fr;
#pragma unroll
    for (int j = 0; j < 2; ++j) *(u32x2*)(MG + (size_t)tok * 1024 + n0 + wn * 32 + j * 16 + fq * 4) = pk4(tot[i][j]);
  }
}

__device__ __forceinline__ void s7_tile(const Params& p, int l, int tile, const float* xp, const float* xs, char* lds) {
  const int tid = tidx(), lane = tid & 63, wid = tid >> 6, wm = wid >> 1, wn = wid & 1, fr = lane & 15, fq = lane >> 4;
  const int m = tile % 96, nt = tile / 96, m0 = m * 128, n0 = nt * 64;
  char* ws = wsp(p.ws);
  f32x4 acc[4][2];
#pragma unroll
  for (int i = 0; i < 4; ++i) { acc[i][0] = (f32x4){0.f, 0.f, 0.f, 0.f}; acc[i][1] = (f32x4){0.f, 0.f, 0.f, 0.f}; }
  gemm_core<true, 2>((const bf16_t*)(ws + O_UT) + (size_t)m0 * 1024, 1024, (const bf16_t*)(ws + O_WO) + ((size_t)l * 1024 + n0) * 1024, 1024, 1024, acc, lds);
#pragma unroll
  for (int i = 0; i < 4; ++i) {
    const int tok = m0 + wm * 64 + i * 16 + fr;
    const float* src = tok < NPR ? xp + (size_t)tok * 1024 : xs + (size_t)(tok - NPR) * 1024;
    const int v = tok < NPR ? 0 : 1 + ((tok - NPR) >> 10);
    const float* gate = (const float*)(ws + O_MOD) + (l * 5 + v) * 3072 + 2048;
#pragma unroll
    for (int j = 0; j < 2; ++j) {
      const int col = n0 + wn * 32 + j * 16 + fq * 4;
      const f32x4 x = *(const f32x4*)(src + col), gt = *(const f32x4*)(gate + col);
      f32x4 y;
#pragma unroll
      for (int e = 0; e < 4; ++e) y[e] = x[e] + gt[e] * acc[i][j][e];
      *(f32x4*)(p.out + (size_t)tok * 1024 + col) = y;
    }
  }
}

constexpr int NPHASE = 16;
__device__ __forceinline__ int next_item(unsigned* ctr, char* lds) {
  __syncthreads();
  if (threadIdx.x == 0) *(volatile int*)lds = (int)__hip_atomic_fetch_add(ctr, 1u, __ATOMIC_RELAXED, __HIP_MEMORY_SCOPE_AGENT);
  __syncthreads();
  const int it = *(volatile int*)lds;
  __syncthreads();
  return it;
}
__device__ __forceinline__ void run_phase(const Params& p, int ph, char* lds, unsigned* qctr) {
  const int bid = blockIdx.x, nb = gridDim.x;
  if (ph == 0) { for (int i = bid; i < P0_N; i += nb) phase0_item(p, i, lds); return; }
  if (ph == 15) { for (int i = bid; i < 768; i += nb) final_item(p, i); return; }
  const int l = (ph - 1) / 7, s = (ph - 1) % 7;
  const float* xp = l == 0 ? p.x_prompt : p.out;
  const float* xs = l == 0 ? p.x_sample : p.out + (size_t)NPR * 1024;
  switch (s) {
    case 0: for (int i = bid; i < 768; i += nb) norm_item(p, l, i, xp, xs); break;
    case 1: for (int i = bid; i < 2880; i += nb) s2_tile(p, l, i, lds); break;
    case 2:
      for (;;) {
        const int i = qctr ? next_item(qctr + ph, lds) : -1;
        if (i < 0 || i >= 2176) break;
        if (i < 128) attn_item<1>(p, l, i, lds);
        else if (i < 1024) keyprep_item(p, l, i - 128);
        else if (i < 1280) attn_item<1>(p, l, 128 + (i - 1024), lds);
        else if (i < 1408) state_item(p, l, i - 1280);
        else f1_tile(p, i - 1408, lds);
      }
      break;
    case 3:
      for (;;) {
        const int i = qctr ? next_item(qctr + ph, lds) : -1;
        if (i < 0 || i >= 1856) break;
        if (i < 384) f2_tile(p, i, lds);
        else if (i < 960) qup_tile(p, l, i - 384, lds);
        else kvup_tile(p, l, i - 960, lds);
      }
      break;
    case 4:
      for (;;) {
        const int i = qctr ? next_item(qctr + ph, lds) : -1;
        if (i < 0 || i >= 768) break;
        attn_item<0>(p, l, i, lds);
      }
      break;
    case 5: for (int i = bid; i < 1536; i += nb) s6_tile(p, l, i, lds); break;
    case 6: for (int i = bid; i < 1536; i += nb) s7_tile(p, l, i, xp, xs, lds); break;
  }
}

#define XB_TMO      128
#define XB_XCNT(j)  (256  + 64 * (j))
#define XB_XSUB(j)  (1280 + 64 * (j))
#define XB_XGEN(j)  (2304 + 64 * (j))
#define XB_TOP      3328
#define XB_TOPGEN   3392
#define XCD_BAR_WORDS 3456
#define XB_SPIN_CAP (1u << 18)
__device__ __forceinline__ unsigned xb_ld(unsigned* p)              { return __hip_atomic_load(p, __ATOMIC_RELAXED, __HIP_MEMORY_SCOPE_AGENT); }
__device__ __forceinline__ unsigned xb_add(unsigned* p, unsigned v) { return __hip_atomic_fetch_add(p, v, __ATOMIC_RELAXED, __HIP_MEMORY_SCOPE_AGENT); }
__device__ __forceinline__ unsigned xb_xcc_id() { return (unsigned)__builtin_amdgcn_s_getreg((3 << 11) | 20) & 0xFu; }
#define XB_SPIN(cond, bar) do { unsigned _sp = 0; while (cond) { __builtin_amdgcn_s_sleep(1); \
    if ((++_sp & 255u) == 0u) { if (xb_ld(&(bar)[XB_TMO])) break; if (_sp > XB_SPIN_CAP) { atomicAdd(&(bar)[XB_TMO], 1u); break; } } } } while (0)
__device__ __forceinline__ void xcd_barrier_complete(unsigned* bar, unsigned x, unsigned& nloc, unsigned& nx) {
  const unsigned G = gridDim.x;
  unsigned sum, cnt, mine, sp = 0u;
  for (;;) {
    sum = 0u; cnt = 0u; mine = 0u;
#pragma unroll
    for (unsigned j = 0; j < 16; ++j) { const unsigned c = xb_ld(&bar[XB_XCNT(j)]); sum += c; cnt += (c > 0u) ? 1u : 0u; mine = (j == x) ? c : mine; }
    if (sum == G) break;
    __builtin_amdgcn_s_sleep(1);
    if ((++sp & 255u) == 0u) { if (xb_ld(&bar[XB_TMO])) break; if (sp > XB_SPIN_CAP) { atomicAdd(&bar[XB_TMO], 1u); break; } }
  }
  nloc = mine > 0u ? mine : 1u; nx = cnt > 0u ? cnt : 1u;
}
__device__ __forceinline__ void xcd_barrier(unsigned* bar, unsigned x, unsigned& nloc, unsigned& nx) {
  asm volatile("s_waitcnt vmcnt(0)" ::: "memory");
  __syncthreads();
  if (threadIdx.x == 0) {
    __builtin_amdgcn_s_waitcnt(0);
    if (nloc == 0u) xcd_barrier_complete(bar, x, nloc, nx);
    const unsigned old = xb_add(&bar[XB_XSUB(x)], 1u);
    const unsigned gen = old / nloc;
    if (old + 1u == (gen + 1u) * nloc) {
      __builtin_amdgcn_fence(__ATOMIC_RELEASE, "agent");
      asm volatile("s_waitcnt vmcnt(0)" ::: "memory");
      const unsigned og = xb_add(&bar[XB_TOP], 1u);
      const unsigned tg = og / nx;
      if (og + 1u == (tg + 1u) * nx) xb_add(&bar[XB_TOPGEN], 1u);
      else XB_SPIN(xb_ld(&bar[XB_TOPGEN]) == tg, bar);
      __builtin_amdgcn_fence(__ATOMIC_ACQUIRE, "agent");
      xb_add(&bar[XB_XGEN(x)], 1u);
      asm volatile("s_waitcnt vmcnt(0)" ::: "memory");
    } else {
      XB_SPIN(xb_ld(&bar[XB_XGEN(x)]) == gen, bar);
      __builtin_amdgcn_fence(__ATOMIC_ACQUIRE, "agent");
      asm volatile("s_waitcnt vmcnt(0)" ::: "memory");
    }
  }
  __syncthreads();
}

__global__ void __launch_bounds__(256, 2) mk_fwd(Params p) {
  __shared__ __attribute__((aligned(16))) char lds[LDS_TOTAL];
  cg::grid_group grid = cg::this_grid();
  unsigned* bar = (unsigned*)(p.ws + O_BAR);
  const unsigned xcc = xb_xcc_id();
  if (threadIdx.x == 0) (void)xb_add(&bar[XB_XCNT(xcc)], 1u);
  unsigned nloc = 0u, nx = 0u;
  if (gridDim.x == 0x7fffffffu) grid.sync();
#pragma unroll 1
  for (int ph = 0; ph < NPHASE; ++ph) {
    run_phase(p, ph, lds, bar);
    if (ph + 1 < NPHASE) xcd_barrier(bar, xcc, nloc, nx);
  }
}

extern "C" void kernel_launch(void* const* d_in, const int* in_sizes, int n_in, void* d_out, int out_size, void* d_ws, size_t ws_size,
                              hipStream_t stream) {
  Params p{};
  p.x_prompt = (const float*)d_in[0]; p.x_sample = (const float*)d_in[1]; p.cache_ckv = (const float*)d_in[2]; p.cache_krope = (const float*)d_in[3];
  p.state_ret = (const float*)d_in[4]; p.c = (const float*)d_in[5]; p.c_ctx = (const float*)d_in[6]; p.norm_g = (const float*)d_in[7];
  p.w_mod = (const float*)d_in[8]; p.b_mod = (const float*)d_in[9]; p.w_in = (const float*)d_in[10]; p.ret_logit = (const float*)d_in[11];
  p.q_norm_g = (const float*)d_in[12]; p.w_q_up = (const float*)d_in[13]; p.kv_norm_g = (const float*)d_in[14]; p.w_kv_up = (const float*)d_in[15];
  p.w_branch = (const float*)d_in[16]; p.w_out = (const float*)d_in[17]; p.final_g = (const float*)d_in[18];
  p.out = (float*)d_out; p.ws = (char*)d_ws;
#if ONE_LAUNCH
  static int grid_blocks = 0;
  if (!grid_blocks) {
    int dev = 0, cus = 0, per_cu = 0;
    hipGetDevice(&dev);
    hipDeviceGetAttribute(&cus, hipDeviceAttributeMultiprocessorCount, dev);
    hipOccupancyMaxActiveBlocksPerMultiprocessor(&per_cu, mk_fwd, 256, 0);
    if (per_cu > 2) per_cu = 2;
    grid_blocks = cus * per_cu;
  }
  hipMemsetAsync((char*)d_ws + O_BAR, 0, XCD_BAR_WORDS * 4, stream);
  void* args[] = {&p};
  hipError_t e = hipLaunchCooperativeKernel((void*)mk_fwd, dim3(grid_blocks), dim3(256), args, 0, stream);
  if (e != hipSuccess) fprintf(stderr, "cooperative launch failed: %s (grid %d)\n", hipGetErrorString(e), grid_blocks);
#endif
}
```

```cpp
#include <hip/hip_runtime.h>
#include <hip/hip_cooperative_groups.h>
#include <stdint.h>
#include <stdio.h>
namespace cg = cooperative_groups;

#ifndef ONE_LAUNCH
#define ONE_LAUNCH 1
#endif

typedef unsigned short bf16_t;
typedef short bf16x8 __attribute__((ext_vector_type(8)));
typedef float f32x4 __attribute__((ext_vector_type(4)));
typedef unsigned u32x4 __attribute__((ext_vector_type(4)));
typedef unsigned u32x2 __attribute__((ext_vector_type(2)));

constexpr int NTOK = 12288, NPR = 8192, NKEY = 14336;
constexpr float EPSN = 1e-6f;

constexpr size_t O_WIN   = 0;
constexpr size_t O_WQ    = O_WIN   + (size_t)2 * 6912 * 1024 * 2;
constexpr size_t O_WKV   = O_WQ    + (size_t)2 * 768 * 384 * 2;
constexpr size_t O_WBR   = O_WKV   + (size_t)2 * 1024 * 256 * 2;
constexpr size_t O_WO    = O_WBR   + (size_t)6 * 1024 * 512 * 2;
constexpr size_t O_CS    = O_WO    + (size_t)2 * 1024 * 1024 * 2;
constexpr size_t O_D256  = O_CS    + (size_t)256 * 128 * 2;
constexpr size_t O_D1024 = O_D256  + (size_t)256 * 512 * 2;
constexpr size_t O_S0T   = O_D1024 + (size_t)1024 * 2048 * 2;
constexpr size_t O_MOD   = O_S0T   + (size_t)64 * 128 * 64 * 2;
constexpr size_t O_H     = O_MOD   + (size_t)2 * 5 * 3072 * 4;
constexpr size_t O_UT    = O_H     + (size_t)NTOK * 1024 * 2;
constexpr size_t O_RQ    = O_UT    + (size_t)NTOK * 1024 * 2;
constexpr size_t O_RK    = O_RQ    + (size_t)NTOK * 256 * 2;
constexpr size_t O_RKT   = O_RK    + (size_t)NTOK * 256 * 2;
constexpr size_t O_RVT   = O_RKT   + (size_t)NPR * 256 * 2;
constexpr size_t O_KVLAT = O_RVT   + (size_t)NTOK * 512 * 2;
constexpr size_t O_KR    = O_KVLAT + (size_t)NTOK * 256 * 4;
constexpr size_t O_R2END = O_KR    + (size_t)NTOK * 32 * 4;
constexpr size_t O_VT    = O_RQ;
static_assert(O_VT + (size_t)NKEY * 512 * 2 <= O_R2END, "alias overflow");
constexpr size_t O_RZ    = O_R2END;
constexpr size_t O_MZ    = O_RZ    + (size_t)NTOK * 512 * 2;
constexpr size_t O_FZ    = O_MZ    + (size_t)NTOK * 512 * 2;
constexpr size_t O_FU    = O_FZ    + (size_t)NTOK * 512 * 2;
constexpr size_t O_QLAT  = O_FU    + (size_t)NTOK * 512 * 2;
constexpr size_t O_CKVA  = O_QLAT  + (size_t)NTOK * 384 * 2;
constexpr size_t O_KB    = O_CKVA  + (size_t)NKEY * 256 * 2;
constexpr size_t O_KRA   = O_KB    + (size_t)NKEY * 512 * 2;
constexpr size_t O_QB    = O_KRA   + (size_t)NKEY * 32 * 2;
constexpr size_t O_END   = O_QB    + (size_t)NTOK * 768 * 2;
constexpr size_t O_BAR   = (O_END + 255) & ~(size_t)255;
static_assert(O_BAR + 16384 <= (size_t)256 * 1024 * 1024, "workspace too large");

constexpr size_t OUT_CKV = (size_t)NTOK * 1024;
constexpr size_t OUT_KR  = OUT_CKV + (size_t)32 * 2 * 256 * 256;
constexpr size_t OUT_RET = OUT_KR + (size_t)32 * 2 * 256 * 32;

struct Params {
  const float *x_prompt, *x_sample, *cache_ckv, *cache_krope, *state_ret, *c, *c_ctx, *norm_g, *w_mod, *b_mod,
      *w_in, *ret_logit, *q_norm_g, *w_q_up, *kv_norm_g, *w_kv_up, *w_branch, *w_out, *final_g;
  float* out;
  char* ws;
};

constexpr int PANEL = 128 * 64;
constexpr int ABYTES = 2 * PANEL;
constexpr int STAGE = 2 * ABYTES;
constexpr int LDS_GEMM = 2 * STAGE;
constexpr int LDS_TOTAL = LDS_GEMM;
static_assert(LDS_TOTAL <= 65536, "static LDS");

typedef float f32x2 __attribute__((ext_vector_type(2)));
typedef __bf16 bf16x2v __attribute__((ext_vector_type(2)));
__device__ __forceinline__ unsigned pk2(float lo, float hi) { const f32x2 v = {lo, hi}; return __builtin_bit_cast(unsigned, __builtin_convertvector(v, bf16x2v)); }
__device__ __forceinline__ bf16_t tobf(float x) { return (bf16_t)(pk2(x, 0.f) & 0xffffu); }
__device__ __forceinline__ float bflo(unsigned u) { return __uint_as_float(u << 16); }
__device__ __forceinline__ float bfhi(unsigned u) { return __uint_as_float(u & 0xffff0000u); }
__device__ __forceinline__ float ex2(float x) { return __builtin_amdgcn_exp2f(x); }
__device__ __forceinline__ float silu_f(float x) { return x / (1.f + __expf(-x)); }
__device__ __forceinline__ float sigm_f(float x) { return 1.f / (1.f + __expf(-x)); }
__device__ __forceinline__ u32x2 pk4(f32x4 v) { u32x2 r; r.x = pk2(v[0], v[1]); r.y = pk2(v[2], v[3]); return r; }
#define GAS __attribute__((address_space(1)))
#define LAS __attribute__((address_space(3)))
__device__ __forceinline__ u32x4 ldg16(const void* p) { return *(const GAS u32x4*)p; }
__device__ __forceinline__ int tidx() { int t = threadIdx.x; asm volatile("" : "+v"(t)); return t; }
__device__ __forceinline__ char* wsp(const char* w) { unsigned long long v = (unsigned long long)w; asm volatile("" : "+s"(v)); return (char*)v; }
__device__ __forceinline__ int swz(int r) { return (0 - ((r >> 2) & 3)) & 3; }
__device__ __forceinline__ float wave_sum(float v) {
#pragma unroll
  for (int o = 1; o < 64; o <<= 1) v += __shfl_xor(v, o);
  return v;
}
__device__ __forceinline__ f32x4 mfma16(bf16x8 a, bf16x8 b, f32x4 c) { return __builtin_amdgcn_mfma_f32_16x16x32_bf16(a, b, c, 0, 0, 0); }
__device__ __forceinline__ bf16x8 as_bf8(u32x4 v) { return __builtin_bit_cast(bf16x8, v); }

__device__ __forceinline__ void zero_acc(f32x4 (&acc)[4][4]) {
#pragma unroll
  for (int i = 0; i < 4; ++i)
#pragma unroll
    for (int j = 0; j < 4; ++j) acc[i][j] = (f32x4){0.f, 0.f, 0.f, 0.f};
}

template <bool SWAP, int NJ = 4>
__device__ __forceinline__ void gemm_core(const bf16_t* __restrict__ A, int lda, const bf16_t* __restrict__ B, int ldb, int K,
                                          f32x4 (&acc)[4][NJ], char* lds, int& par, bool primed,
                                          const bf16_t* nA, int nlda, const bf16_t* nB, int nldb) {
  const int tid = tidx(), lane = tid & 63, wm = (tid >> 6) >> 1, wn = (tid >> 6) & 1;
  const int wid = __builtin_amdgcn_readfirstlane(tid >> 6);
  const int fr = lane & 15, fq = lane >> 4;
  const int fa = (wm * 64 + fr) * 64 + ((fq ^ swz(fr)) << 4);
  const int fb = ABYTES + (wn * NJ * 16 + fr) * 64 + ((fq ^ swz(fr)) << 4);
  const int lrow = lane >> 2, lchunk = (lane & 3) ^ swz(lrow);
  constexpr int NBL = NJ / 2;
  const GAS char* gA = (const GAS char*)(A + (size_t)(wid * 32 + lrow) * lda + lchunk * 8);
  const GAS char* gB = (const GAS char*)(B + (size_t)(wid * NBL * 16 + lrow) * ldb + lchunk * 8);
  const size_t a16 = (size_t)16 * lda * 2, b16 = (size_t)16 * ldb * 2;
  LAS char* ldsA = (LAS char*)lds + wid * 2048;
  LAS char* ldsB = (LAS char*)lds + ABYTES + wid * NBL * 1024;
  const int nk = K >> 6;
#define GC_ISSUE(pa, pb, sa, sb, stage, kbyte) do { \
    _Pragma("unroll") for (int g = 0; g < 2; ++g) _Pragma("unroll") for (int pn = 0; pn < 2; ++pn) \
      __builtin_amdgcn_global_load_lds((const GAS unsigned*)((pa) + g * (sa) + (kbyte) + pn * 64), (LAS unsigned*)(ldsA + (stage) + pn * PANEL + g * 1024), 16, 0, 0); \
    _Pragma("unroll") for (int g = 0; g < NBL; ++g) _Pragma("unroll") for (int pn = 0; pn < 2; ++pn) \
      __builtin_amdgcn_global_load_lds((const GAS unsigned*)((pb) + g * (sb) + (kbyte) + pn * 64), (LAS unsigned*)(ldsB + (stage) + pn * PANEL + g * 1024), 16, 0, 0); \
  } while (0)
  if (!primed) {
    GC_ISSUE(gA, gB, a16, b16, par * STAGE, 0);
    asm volatile("s_waitcnt vmcnt(0)" ::: "memory");
    __syncthreads();
  }
  for (int kt = 0; kt < nk; ++kt) {
    char* cur = lds + par * STAGE;
    if (kt + 1 < nk) GC_ISSUE(gA, gB, a16, b16, (par ^ 1) * STAGE, (size_t)(kt + 1) * 128);
    else if (nA) {
      const GAS char* hA = (const GAS char*)(nA + (size_t)(wid * 32 + lrow) * nlda + lchunk * 8);
      const GAS char* hB = (const GAS char*)(nB + (size_t)(wid * NBL * 16 + lrow) * nldb + lchunk * 8);
      GC_ISSUE(hA, hB, (size_t)16 * nlda * 2, (size_t)16 * nldb * 2, (par ^ 1) * STAGE, 0);
    }
    __builtin_amdgcn_sched_barrier(0);
#pragma unroll
    for (int ks = 0; ks < 2; ++ks) {
      bf16x8 af[4], bfr[NJ];
#pragma unroll
      for (int i = 0; i < 4; ++i) af[i] = *(const bf16x8*)(cur + ks * PANEL + fa + i * 1024);
#pragma unroll
      for (int j = 0; j < NJ; ++j) bfr[j] = *(const bf16x8*)(cur + ks * PANEL + fb + j * 1024);
#pragma unroll
      for (int i = 0; i < 4; ++i)
#pragma unroll
        for (int j = 0; j < NJ; ++j) acc[i][j] = SWAP ? mfma16(bfr[j], af[i], acc[i][j]) : mfma16(af[i], bfr[j], acc[i][j]);
    }
    __builtin_amdgcn_sched_barrier(0);
    asm volatile("s_waitcnt vmcnt(0)" ::: "memory");
    __syncthreads();
    par ^= 1;
  }
#undef GC_ISSUE
}
template <bool SWAP, int NJ = 4>
__device__ __forceinline__ void gemm_core(const bf16_t* __restrict__ A, int lda, const bf16_t* __restrict__ B, int ldb, int K,
                                          f32x4 (&acc)[4][NJ], char* lds) {
  int par = 0;
  gemm_core<SWAP, NJ>(A, lda, B, ldb, K, acc, lds, par, false, nullptr, 0, nullptr, 0);
}

__device__ __forceinline__ void tr_tile(const float* __restrict__ src, int lds_, int k0, int ns0, bf16_t* __restrict__ dst, int ldd, int nd0,
                                        const float* __restrict__ ksc, char* lds) {
  bf16_t* T = (bf16_t*)lds;
  const int tid = tidx();
  __syncthreads();
#pragma unroll
  for (int i = 0; i < 2; ++i) {
    const int kk = (tid >> 3) + 32 * i, nn4 = (tid & 7) * 4;
    const f32x4 v = *(const f32x4*)(src + (size_t)(k0 + kk) * lds_ + ns0 + nn4);
    const float s = ksc ? ksc[k0 + kk] : 1.f;
#pragma unroll
    for (int e = 0; e < 4; ++e) T[(nn4 + e) * 72 + kk] = tobf(v[e] * s);
  }
  __syncthreads();
  const int nn = tid >> 3, kc = (tid & 7) * 8;
  const u32x4 w = *(const u32x4*)(T + nn * 72 + kc);
  *(u32x4*)(dst + (size_t)(nd0 + nn) * ldd + k0 + kc) = w;
}

constexpr int P0_GEMV = 192, P0_WIN = 6816, P0_WQ = 288, P0_WKV = 256, P0_WBR = 1536, P0_WO = 1024, P0_S0 = 256, P0_PAD = 96, P0_TAB = 1104;
constexpr int P0_N = P0_GEMV + P0_WIN + P0_WQ + P0_WKV + P0_WBR + P0_WO + P0_S0 + P0_PAD + P0_TAB;

__device__ __forceinline__ void phase0_item(const Params& p, int j, char* lds) {
  const int tid = tidx();
  char* ws = wsp(p.ws);
  if (j < P0_GEMV) {
    const int l = j / 96, cgi = j % 96;
    float* sv = (float*)lds;
    float* red = (float*)(lds + 20480);
    __syncthreads();
    for (int i = tid; i < 5120; i += 256) { const int v = i >> 10, k = i & 1023; const float x = (v == 0) ? p.c_ctx[k] : p.c[(v - 1) * 1024 + k]; sv[i] = silu_f(x); }
    __syncthreads();
    const int c4 = tid & 7, kg = tid >> 3;
    const float* w = p.w_mod + (size_t)l * 1024 * 3072 + cgi * 32 + c4 * 4;
    f32x4 a0 = {0.f, 0.f, 0.f, 0.f}, a1 = a0, a2 = a0, a3 = a0, a4 = a0;
#pragma unroll 8
    for (int k = kg * 32; k < kg * 32 + 32; ++k) {
      const f32x4 wv = *(const GAS f32x4*)(w + (size_t)k * 3072);
      a0 += wv * sv[k]; a1 += wv * sv[1024 + k]; a2 += wv * sv[2048 + k]; a3 += wv * sv[3072 + k]; a4 += wv * sv[4096 + k];
    }
    *(f32x4*)(red + (kg * 5 + 0) * 32 + c4 * 4) = a0; *(f32x4*)(red + (kg * 5 + 1) * 32 + c4 * 4) = a1; *(f32x4*)(red + (kg * 5 + 2) * 32 + c4 * 4) = a2;
    *(f32x4*)(red + (kg * 5 + 3) * 32 + c4 * 4) = a3; *(f32x4*)(red + (kg * 5 + 4) * 32 + c4 * 4) = a4;
    __syncthreads();
    if (tid < 160) {
      const int v = tid >> 5, c2 = tid & 31;
      float sm = p.b_mod[l * 3072 + cgi * 32 + c2];
#pragma unroll 8
      for (int g = 0; g < 32; ++g) sm += red[(g * 5 + v) * 32 + c2];
      ((float*)(ws + O_MOD))[(l * 5 + v) * 3072 + cgi * 32 + c2] = sm;
    }
    return;
  }
  j -= P0_GEMV;
  if (j < P0_WIN) {
    const int l = j / 3408, r = j % 3408, kt = r / 213, nt = r % 213, c0 = nt * 32;
    const int nd0 = c0 < 2176 ? c0 : (c0 < 2208 ? 3712 + (c0 - 2176) : (c0 < 3744 ? c0 - 32 : c0 + 96));
    tr_tile(p.w_in + (size_t)l * 1024 * 6816, 6816, kt * 64, c0, (bf16_t*)(ws + O_WIN) + (size_t)l * 6912 * 1024, 1024, nd0, nullptr, lds);
    return;
  }
  j -= P0_WIN;
  if (j < P0_WQ) {
    const int l = j / 144, r = j % 144, kt = r / 24, nt = r % 24;
    tr_tile(p.w_q_up + (size_t)l * 384 * 768, 768, kt * 64, nt * 32, (bf16_t*)(ws + O_WQ) + (size_t)l * 768 * 384, 384, nt * 32, p.q_norm_g + l * 384, lds);
    return;
  }
  j -= P0_WQ;
  if (j < P0_WKV) {
    const int l = j / 128, r = j % 128, kt = r / 32, nt = r % 32, c0 = nt * 32, h = c0 >> 7, e = c0 & 127;
    const int nd0 = e < 64 ? h * 64 + e : 512 + h * 64 + (e - 64);
    tr_tile(p.w_kv_up + (size_t)l * 256 * 1024, 1024, kt * 64, c0, (bf16_t*)(ws + O_WKV) + (size_t)l * 1024 * 256, 256, nd0, nullptr, lds);
    return;
  }
  j -= P0_WKV;
  if (j < P0_WBR) {
    const int mat = j / 256, r = j % 256, kt = r / 32, nt = r % 32;
    tr_tile(p.w_branch + (size_t)mat * 512 * 1024, 1024, kt * 64, nt * 32, (bf16_t*)(ws + O_WBR) + (size_t)mat * 1024 * 512, 512, nt * 32, nullptr, lds);
    return;
  }
  j -= P0_WBR;
  if (j < P0_WO) {
    const int l = j / 512, r = j % 512, kt = r / 32, nt = r % 32;
    tr_tile(p.w_out + (size_t)l * 1024 * 1024, 1024, kt * 64, nt * 32, (bf16_t*)(ws + O_WO) + (size_t)l * 1024 * 1024, 1024, nt * 32, nullptr, lds);
    return;
  }
  j -= P0_WO;
  if (j < P0_S0) {
    const int mat = j >> 2, nt = j & 3;
    tr_tile(p.state_ret + (size_t)mat * 64 * 128, 128, 0, nt * 32, (bf16_t*)(ws + O_S0T) + (size_t)mat * 128 * 64, 64, nt * 32, nullptr, lds);
    return;
  }
  j -= P0_S0;
  if (j < P0_PAD) {
    const int l = j / 48, r = j % 48;
    bf16_t* d = (bf16_t*)(ws + O_WIN) + ((size_t)l * 6912 + 3744) * 1024 + (size_t)r * 2048 + tid * 8;
    *(u32x4*)d = (u32x4){0u, 0u, 0u, 0u};
    return;
  }
  j -= P0_PAD;
  {
    float v[8];
    bf16_t* dst;
    if (j < 16) {
      const int e0 = j * 2048 + tid * 8; dst = (bf16_t*)(ws + O_CS) + e0;
      const int n = e0 >> 7, k = e0 & 127;
#pragma unroll
      for (int e = 0; e < 8; ++e) {
        const float fr = (float)(((n & 127) * (k + e)) & 127) * (1.f / 128.f);
        v[e] = (n < 128) ? __builtin_amdgcn_cosf(fr) : __builtin_amdgcn_sinf(fr);
      }
    } else if (j < 80) {
      const int e0 = (j - 16) * 2048 + tid * 8; dst = (bf16_t*)(ws + O_D256) + e0;
      const int k1 = e0 >> 9, kk = e0 & 511;
#pragma unroll
      for (int e = 0; e < 8; ++e) {
        const int t = (kk + e) & 255;
        const float fr = (float)((k1 * t) & 255) * (1.f / 256.f);
        v[e] = (kk < 256) ? __builtin_amdgcn_cosf(fr) : -__builtin_amdgcn_sinf(fr);
      }
    } else {
      const int e0 = (j - 80) * 2048 + tid * 8; dst = (bf16_t*)(ws + O_D1024) + e0;
      const int k1 = e0 >> 11, kk = e0 & 2047;
#pragma unroll
      for (int e = 0; e < 8; ++e) {
        const int t = (kk + e) & 1023;
        const float fr = (float)((k1 * t) & 1023) * (1.f / 1024.f);
        v[e] = (kk < 1024) ? __builtin_amdgcn_cosf(fr) : -__builtin_amdgcn_sinf(fr);
      }
    }
    u32x4 w; w.x = pk2(v[0], v[1]); w.y = pk2(v[2], v[3]); w.z = pk2(v[4], v[5]); w.w = pk2(v[6], v[7]);
    *(u32x4*)dst = w;
  }
}

__device__ __forceinline__ void norm_item(const Params& p, int l, int item, const float* xp, const float* xs) {
  const int tid = tidx(), lane = tid & 63, wid = tid >> 6;
  bf16_t* H = (bf16_t*)(p.ws + O_H);
#pragma unroll 3
  for (int i = 0; i < 6; ++i) {
    const int row = item * 24 + wid * 6 + i;
    const float* src = row < NPR ? xp + (size_t)row * 1024 : xs + (size_t)(row - NPR) * 1024;
    const int v = row < NPR ? 0 : 1 + ((row - NPR) >> 10);
    const float* mod = (const float*)(p.ws + O_MOD) + (l * 5 + v) * 3072;
    f32x4 x[4]; float ss = 0.f;
#pragma unroll
    for (int q = 0; q < 4; ++q) { x[q] = *(const f32x4*)(src + (q * 64 + lane) * 4); ss += x[q][0] * x[q][0] + x[q][1] * x[q][1] + x[q][2] * x[q][2] + x[q][3] * x[q][3]; }
    ss = wave_sum(ss);
    const float rstd = rsqrtf(ss * (1.f / 1024.f) + EPSN);
#pragma unroll
    for (int q = 0; q < 4; ++q) {
      const int col = (q * 64 + lane) * 4;
      const f32x4 g = *(const f32x4*)(p.norm_g + l * 1024 + col), sc = *(const f32x4*)(mod + 1024 + col), sh = *(const f32x4*)(mod + col);
      f32x4 h;
#pragma unroll
      for (int e = 0; e < 4; ++e) h[e] = x[q][e] * rstd * g[e] * (1.f + sc[e]) + sh[e];
      *(u32x2*)(H + (size_t)row * 1024 + col) = pk4(h);
    }
  }
}
__device__ __forceinline__ void final_item(const Params& p, int item) {
  const int tid = tidx(), lane = tid & 63, wid = tid >> 6;
#pragma unroll 3
  for (int i = 0; i < 6; ++i) {
    const int row = item * 24 + wid * 6 + i;
    float* src = p.out + (size_t)row * 1024;
    f32x4 x[4]; float ss = 0.f;
#pragma unroll
    for (int q = 0; q < 4; ++q) { x[q] = *(const f32x4*)(src + (q * 64 + lane) * 4); ss += x[q][0] * x[q][0] + x[q][1] * x[q][1] + x[q][2] * x[q][2] + x[q][3] * x[q][3]; }
    ss = wave_sum(ss);
    const float rstd = rsqrtf(ss * (1.f / 1024.f) + EPSN);
#pragma unroll
    for (int q = 0; q < 4; ++q) {
      const int col = (q * 64 + lane) * 4;
      const f32x4 g = *(const f32x4*)(p.final_g + col);
      f32x4 y;
#pragma unroll
      for (int e = 0; e < 4; ++e) y[e] = x[q][e] * rstd * g[e];
      *(f32x4*)(src + col) = y;
    }
  }
}

__device__ __forceinline__ void s2_tile(const Params& p, int l, int tile, char* lds) {
  const int tid = tidx(), lane = tid & 63, wid = tid >> 6, wm = wid >> 1, wn = wid & 1, fr = lane & 15, fq = lane >> 4;
  const int m = tile % 96, nt = tile / 96, m0 = m * 128, n0 = nt * 128;
  char* ws = wsp(p.ws);
  const bf16_t* A = (const bf16_t*)(ws + O_H) + (size_t)m0 * 1024;
  const bf16_t* B = (const bf16_t*)(ws + O_WIN) + ((size_t)l * 6912 + n0) * 1024;
  f32x4 acc[4][4];
  zero_acc(acc);
  if (nt >= 4 && nt < 8) {
    gemm_core<false>(A, 1024, B, 1024, 1024, acc, lds);
    bf16_t* RVT = (bf16_t*)(ws + O_RVT);
#pragma unroll
    for (int i = 0; i < 4; ++i) {
      const int tok = m0 + wm * 64 + i * 16 + fq * 4;
      size_t base; int T, b, t;
      if (tok < NPR) { b = tok >> 8; t = tok & 255; T = 256; base = 0; } else { const int s = tok - NPR; b = s >> 10; t = s & 1023; T = 1024; base = (size_t)NPR * 512; }
#pragma unroll
      for (int j = 0; j < 4; ++j) {
        const int c = n0 - 512 + wn * 64 + j * 16 + fr, h = c >> 7, vd = c & 127;
        *(u32x2*)(RVT + base + ((size_t)(b * 4 + h) * 128 + vd) * T + t) = pk4(acc[i][j]);
      }
    }
    return;
  }
  gemm_core<true>(A, 1024, B, 1024, 1024, acc, lds);
  bf16_t* dst = nullptr; int ld = 0, c0 = 0, op = 0;
  if (nt < 2) { dst = (bf16_t*)(ws + O_RQ); ld = 256; c0 = 0; }
  else if (nt < 4) { dst = (bf16_t*)(ws + O_RK); ld = 256; c0 = 256; op = 2; }
  else if (nt < 12) { dst = (bf16_t*)(ws + O_RZ); ld = 512; c0 = 1024; op = 1; }
  else if (nt < 15) { dst = (bf16_t*)(ws + O_QLAT); ld = 384; c0 = 1536; }
  else if (nt < 17) { ld = 256; c0 = 1920; op = 3; }
  else if (nt < 21) { dst = (bf16_t*)(ws + O_MZ); ld = 512; c0 = 2176; op = 1; }
  else if (nt < 25) { dst = (bf16_t*)(ws + O_FU); ld = 512; c0 = 2688; }
  else if (nt < 29) { dst = (bf16_t*)(ws + O_FZ); ld = 512; c0 = 3200; op = 1; }
  else { ld = 32; c0 = 3712; op = 4; }
#pragma unroll
  for (int i = 0; i < 4; ++i) {
    const int tok = m0 + wm * 64 + i * 16 + fr;
#pragma unroll
    for (int j = 0; j < 4; ++j) {
      const int col = n0 - c0 + wn * 64 + j * 16 + fq * 4;
      f32x4 v = acc[i][j];
      if (op == 3) { *(f32x4*)((float*)(ws + O_KVLAT) + (size_t)tok * 256 + col) = v; continue; }
      if (op == 4) { if (col < 32) *(f32x4*)((float*)(ws + O_KR) + (size_t)tok * 32 + col) = v; continue; }
      if (op == 1) {
#pragma unroll
        for (int e = 0; e < 4; ++e) v[e] = silu_f(v[e]);
      } else if (op == 2) {
#pragma unroll
        for (int e = 0; e < 4; ++e) v[e] *= 0.125f;
      }
      const u32x2 w = pk4(v);
      *(u32x2*)(dst + (size_t)tok * ld + col) = w;
      if (op == 2 && tok < NPR) {
        bf16_t* RKT = (bf16_t*)(ws + O_RKT);
        const int b = tok >> 8, t = tok & 255, h = col >> 6, dk = col & 63;
        bf16_t* q = RKT + ((size_t)(b * 4 + h) * 64 + dk) * 256 + t;
        q[0] = (bf16_t)(w.x & 0xffffu); q[256] = (bf16_t)(w.x >> 16); q[512] = (bf16_t)(w.y & 0xffffu); q[768] = (bf16_t)(w.y >> 16);
      }
    }
  }
}

template <int MODE>
__device__ __forceinline__ void attn_item(const Params& p, int l, int item, char* lds) {
  constexpr int NKP = MODE == 0 ? 3 : 2;
  constexpr int NVB = MODE == 0 ? 4 : 8;
  constexpr int PV = NVB * 16 * 64;
  constexpr int KOFF = NKP * 4096;
  constexpr int BUF = KOFF + 2 * PV;
  const int tid = tidx(), lane = tid & 63, wid = tid >> 6, fr = lane & 15, fq = lane >> 4;
  char* ws = wsp(p.ws);
  int smp, b, h, qblk, T, Tk, tok0;
  const bf16_t *kbase, *rbase = nullptr, *vbase, *qbase;
  int kstride, qstride;
  if (MODE == 0) {
    if (item < 256) { smp = 1; b = item >> 6; h = (item >> 3) & 7; qblk = item & 7; T = 1024; Tk = 1536; tok0 = NPR + b * 1024 + qblk * 128; }
    else { const int it = item - 256; smp = 0; b = it >> 4; h = (it >> 1) & 7; qblk = it & 1; T = 256; Tk = 256; tok0 = b * 256 + qblk * 128; }
    const int keyrow0 = smp ? NPR + b * 1536 : b * 256;
    kbase = (const bf16_t*)(ws + O_KB) + (size_t)keyrow0 * 512 + h * 64; kstride = 512;
    rbase = (const bf16_t*)(ws + O_KRA) + (size_t)keyrow0 * 32;
    vbase = (const bf16_t*)(ws + O_VT) + (smp ? (size_t)NPR * 512 + (size_t)(b * 8 + h) * 64 * 1536 : (size_t)(b * 8 + h) * 64 * 256);
    qbase = (const bf16_t*)(ws + O_QB) + (size_t)tok0 * 768 + h * 96; qstride = 768;
  } else {
    if (item < 128) { smp = 1; b = item >> 5; h = (item >> 3) & 3; qblk = item & 7; T = 1024; tok0 = NPR + b * 1024 + qblk * 128; }
    else { const int it = item - 128; smp = 0; b = it >> 3; h = (it >> 1) & 3; qblk = it & 1; T = 256; tok0 = b * 256 + qblk * 128; }
    Tk = T;
    const int ktok0 = smp ? NPR + b * 1024 : b * 256;
    kbase = (const bf16_t*)(ws + O_RK) + (size_t)ktok0 * 256 + h * 64; kstride = 256;
    vbase = (const bf16_t*)(ws + O_RVT) + (smp ? (size_t)NPR * 512 + (size_t)(b * 4 + h) * 128 * 1024 : (size_t)(b * 4 + h) * 128 * 256);
    qbase = (const bf16_t*)(ws + O_RQ) + (size_t)tok0 * 256 + h * 64; qstride = 256;
  }
  const int nkt = Tk >> 6;
  bf16x8 qf[2][NKP];
#pragma unroll
  for (int qb = 0; qb < 2; ++qb)
#pragma unroll
    for (int ks = 0; ks < NKP; ++ks) qf[qb][ks] = *(const bf16x8*)(qbase + (size_t)(wid * 32 + qb * 16 + fr) * qstride + ks * 32 + fq * 8);
  f32x4 o[NVB][2];
#pragma unroll
  for (int vb = 0; vb < NVB; ++vb) { o[vb][0] = (f32x4){0.f, 0.f, 0.f, 0.f}; o[vb][1] = (f32x4){0.f, 0.f, 0.f, 0.f}; }
  float lgf = 0.f, lgb = 0.f;
  float mrow[2] = {-INFINITY, -INFINITY}, lrow[2] = {0.f, 0.f};
  const int tq0 = qblk * 128 + wid * 32 + fr;
  if (MODE == 1) {
    const float xf = p.ret_logit[(l * 2 + 0) * 4 + h], xb = p.ret_logit[(l * 2 + 1) * 4 + h];
    lgf = -log1pf(expf(-xf)) * 1.44269504089f; lgb = -log1pf(expf(-xb)) * 1.44269504089f;
    if (smp) {
      const bf16_t* s0 = (const bf16_t*)(ws + O_S0T);
#pragma unroll
      for (int dir = 0; dir < 2; ++dir) {
        const bf16_t* sb = s0 + ((size_t)(((b * 2 + l) * 2 + dir) * 4 + h) * 128) * 64;
        float dec[2];
#pragma unroll
        for (int qb = 0; qb < 2; ++qb) { const int tq = tq0 + qb * 16; dec[qb] = dir == 0 ? ex2((float)(tq + 1) * lgf) : ex2((float)(T - tq) * lgb); }
#pragma unroll
        for (int vb = 0; vb < NVB; ++vb) {
          f32x4 t0 = (f32x4){0.f, 0.f, 0.f, 0.f}, t1 = (f32x4){0.f, 0.f, 0.f, 0.f};
#pragma unroll
          for (int ks = 0; ks < 2; ++ks) {
            const bf16x8 sf = *(const bf16x8*)(sb + (size_t)(vb * 16 + fr) * 64 + ks * 32 + fq * 8);
            t0 = mfma16(sf, qf[0][ks], t0); t1 = mfma16(sf, qf[1][ks], t1);
          }
          o[vb][0] += t0 * dec[0]; o[vb][1] += t1 * dec[1];
        }
      }
    }
  }
  u32x4 vreg[NVB / 2];
  const int uw = __builtin_amdgcn_readfirstlane(wid);
  const int dkey = lane >> 2, dchunk = (lane & 3) ^ swz(dkey);
  auto kdma = [&](int kt, char* buf) {
    const GAS bf16_t* kp = (const GAS bf16_t*)kbase + (size_t)(kt * 64 + uw * 16 + dkey) * kstride + dchunk * 8;
#pragma unroll
    for (int pn = 0; pn < 2; ++pn)
      __builtin_amdgcn_global_load_lds((const GAS unsigned*)(kp + pn * 32), (LAS unsigned*)((LAS char*)buf + pn * 4096 + uw * 1024), 16, 0, 0);
    if (MODE == 0) {
      const GAS bf16_t* rp = (const GAS bf16_t*)rbase + (size_t)(kt * 64 + uw * 16 + dkey) * 32 + dchunk * 8;
      __builtin_amdgcn_global_load_lds((const GAS unsigned*)rp, (LAS unsigned*)((LAS char*)buf + 2 * 4096 + uw * 1024), 16, 0, 0);
    }
  };
  auto gload = [&](int kt) {
#pragma unroll
    for (int i = 0; i < NVB / 2; ++i) { const int idx = tid + 256 * i, vd = idx >> 3, g = idx & 7; vreg[i] = ldg16(vbase + (size_t)vd * Tk + kt * 64 + g * 8); }
  };
  auto lstore = [&](char* buf) {
#pragma unroll
    for (int i = 0; i < NVB / 2; ++i) {
      const int idx = tid + 256 * i, vd = idx >> 3, g = idx & 7, pnl = g >> 2, g4 = g & 3, hi = g4 >> 1, q0 = 2 * (g4 & 1);
      char* base = buf + KOFF + pnl * PV + vd * 64 + hi * 8;
      *(u32x2*)(base + ((q0 ^ swz(vd)) << 4)) = (u32x2){vreg[i].x, vreg[i].y};
      *(u32x2*)(base + (((q0 + 1) ^ swz(vd)) << 4)) = (u32x2){vreg[i].z, vreg[i].w};
    }
  };
  __syncthreads();
  kdma(0, lds); gload(0); lstore(lds);
  asm volatile("s_waitcnt vmcnt(0)" ::: "memory");
  __syncthreads();
  const int foff = fr * 64 + ((fq ^ swz(fr)) << 4);
  for (int kt = 0; kt < nkt; ++kt) {
    char* cur = lds + (kt & 1) * BUF;
    const bool more = (kt + 1) < nkt;
    if (more) { kdma(kt + 1, lds + ((kt + 1) & 1) * BUF); gload(kt + 1); }
    __builtin_amdgcn_sched_barrier(0);
    f32x4 s[4][2];
#pragma unroll
    for (int kb = 0; kb < 4; ++kb) {
      s[kb][0] = (f32x4){0.f, 0.f, 0.f, 0.f}; s[kb][1] = (f32x4){0.f, 0.f, 0.f, 0.f};
#pragma unroll
      for (int ks = 0; ks < NKP; ++ks) {
        const bf16x8 kf = *(const bf16x8*)(cur + ks * 4096 + kb * 1024 + foff);
        s[kb][0] = mfma16(kf, qf[0][ks], s[kb][0]); s[kb][1] = mfma16(kf, qf[1][ks], s[kb][1]);
      }
    }
    bf16x8 pf[2][2];
#pragma unroll
    for (int qb = 0; qb < 2; ++qb) {
      if (MODE == 0) {
        float mx = s[0][qb][0];
#pragma unroll
        for (int kb = 0; kb < 4; ++kb)
#pragma unroll
          for (int r = 0; r < 4; ++r) mx = fmaxf(mx, s[kb][qb][r]);
        mx = fmaxf(mx, __shfl_xor(mx, 16)); mx = fmaxf(mx, __shfl_xor(mx, 32));
        const float mn = fmaxf(mrow[qb], mx), alpha = ex2(mrow[qb] - mn);
        mrow[qb] = mn;
        float ls = 0.f;
#pragma unroll
        for (int kb = 0; kb < 4; ++kb)
#pragma unroll
          for (int r = 0; r < 4; ++r) { const float e = ex2(s[kb][qb][r] - mn); s[kb][qb][r] = e; ls += e; }
        lrow[qb] = lrow[qb] * alpha + ls;
#pragma unroll
        for (int vb = 0; vb < NVB; ++vb) o[vb][qb] *= alpha;
      } else {
        const int tq = tq0 + qb * 16;
#pragma unroll
        for (int kb = 0; kb < 4; ++kb)
#pragma unroll
          for (int r = 0; r < 4; ++r) {
            const int d = tq - (kt * 64 + kb * 16 + fq * 4 + r);
            const float dec = d > 0 ? ex2((float)d * lgf) : (d < 0 ? ex2((float)(-d) * lgb) : 2.f);
            s[kb][qb][r] *= dec;
          }
      }
#pragma unroll
      for (int g = 0; g < 2; ++g) {
        u32x4 w; w.x = pk2(s[2 * g][qb][0], s[2 * g][qb][1]); w.y = pk2(s[2 * g][qb][2], s[2 * g][qb][3]);
        w.z = pk2(s[2 * g + 1][qb][0], s[2 * g + 1][qb][1]); w.w = pk2(s[2 * g + 1][qb][2], s[2 * g + 1][qb][3]);
        pf[qb][g] = as_bf8(w);
      }
    }
#pragma unroll
    for (int vb = 0; vb < NVB; ++vb)
#pragma unroll
      for (int g = 0; g < 2; ++g) {
        const bf16x8 vf = *(const bf16x8*)(cur + KOFF + g * PV + vb * 1024 + foff);
        o[vb][0] = mfma16(vf, pf[0][g], o[vb][0]); o[vb][1] = mfma16(vf, pf[1][g], o[vb][1]);
      }
    __builtin_amdgcn_sched_barrier(0);
    if (more) lstore(lds + ((kt + 1) & 1) * BUF);
    asm volatile("s_waitcnt vmcnt(0)" ::: "memory");
    __syncthreads();
  }
  bf16_t* G = (bf16_t*)(ws + (MODE == 0 ? O_MZ : O_RZ));
#pragma unroll
  for (int qb = 0; qb < 2; ++qb) {
    const int tok = tok0 + wid * 32 + qb * 16 + fr;
    float mul, sub;
    if (MODE == 0) {
      float lt = lrow[qb]; lt += __shfl_xor(lt, 16); lt += __shfl_xor(lt, 32);
      mul = 1.f / lt; sub = 0.f;
    } else {
      float sm = 0.f;
#pragma unroll
      for (int vb = 0; vb < NVB; ++vb) sm += (o[vb][qb][0] + o[vb][qb][1]) + (o[vb][qb][2] + o[vb][qb][3]);
      sm += __shfl_xor(sm, 16); sm += __shfl_xor(sm, 32);
      const float mu = sm * (1.f / 128.f);
      float vs = 0.f;
#pragma unroll
      for (int vb = 0; vb < NVB; ++vb)
#pragma unroll
        for (int r = 0; r < 4; ++r) { const float dd = o[vb][qb][r] - mu; vs += dd * dd; }
      vs += __shfl_xor(vs, 16); vs += __shfl_xor(vs, 32);
      mul = rsqrtf(vs * (1.f / 128.f) + EPSN); sub = mu;
    }
#pragma unroll
    for (int vb = 0; vb < NVB; ++vb) {
      bf16_t* gp = G + (size_t)tok * 512 + h * (NVB * 16) + vb * 16 + fq * 4;
      const u32x2 gz = *(const u32x2*)gp;
      f32x4 y;
      y[0] = (o[vb][qb][0] - sub) * mul * bflo(gz.x); y[1] = (o[vb][qb][1] - sub) * mul * bfhi(gz.x);
      y[2] = (o[vb][qb][2] - sub) * mul * bflo(gz.y); y[3] = (o[vb][qb][3] - sub) * mul * bfhi(gz.y);
      *(u32x2*)gp = pk4(y);
    }
  }
}

__device__ __forceinline__ bf16x8 scale8(u32x4 raw, const float (&d)[8]) {
  u32x4 w;
  w.x = pk2(bflo(raw.x) * d[0], bfhi(raw.x) * d[1]); w.y = pk2(bflo(raw.y) * d[2], bfhi(raw.y) * d[3]);
  w.z = pk2(bflo(raw.z) * d[4], bfhi(raw.z) * d[5]); w.w = pk2(bflo(raw.w) * d[6], bfhi(raw.w) * d[7]);
  return as_bf8(w);
}
__device__ __forceinline__ void state_item(const Params& p, int l, int item) {
  const int tid = tidx(), lane = tid & 63, wid = tid >> 6, fr = lane & 15, fq = lane >> 4;
  const int b = item >> 2, h = item & 3;
  const bf16_t* RVT = (const bf16_t*)(p.ws + O_RVT) + (size_t)(b * 4 + h) * 128 * 256;
  const bf16_t* RKT = (const bf16_t*)(p.ws + O_RKT) + (size_t)(b * 4 + h) * 64 * 256;
  const float xf = p.ret_logit[(l * 2 + 0) * 4 + h], xb = p.ret_logit[(l * 2 + 1) * 4 + h];
  const float lgf = -log1pf(expf(-xf)) * 1.44269504089f, lgb = -log1pf(expf(-xb)) * 1.44269504089f;
  f32x4 acc[2][2][4];
#pragma unroll
  for (int d = 0; d < 2; ++d)
#pragma unroll
    for (int v = 0; v < 2; ++v)
#pragma unroll
      for (int k = 0; k < 4; ++k) acc[d][v][k] = (f32x4){0.f, 0.f, 0.f, 0.f};
#pragma unroll 2
  for (int ks = 0; ks < 8; ++ks) {
    const int j0 = ks * 32 + fq * 8;
    float df[8], db[8];
#pragma unroll
    for (int e = 0; e < 8; ++e) { df[e] = exp2f((float)(255 - j0 - e) * lgf); db[e] = exp2f((float)(j0 + e) * lgb); }
    bf16x8 af[2];
#pragma unroll
    for (int v = 0; v < 2; ++v) af[v] = *(const bf16x8*)(RVT + (size_t)((wid * 2 + v) * 16 + fr) * 256 + j0);
#pragma unroll
    for (int k = 0; k < 4; ++k) {
      const u32x4 raw = *(const u32x4*)(RKT + (size_t)(k * 16 + fr) * 256 + j0);
      const bf16x8 kf = scale8(raw, df), kb = scale8(raw, db);
#pragma unroll
      for (int v = 0; v < 2; ++v) { acc[0][v][k] = mfma16(af[v], kf, acc[0][v][k]); acc[1][v][k] = mfma16(af[v], kb, acc[1][v][k]); }
    }
  }
  float* O = p.out + OUT_RET;
#pragma unroll
  for (int d = 0; d < 2; ++d)
#pragma unroll
    for (int v = 0; v < 2; ++v)
#pragma unroll
      for (int k = 0; k < 4; ++k) {
        const int dk = k * 16 + fr, vd = (wid * 2 + v) * 16 + fq * 4;
        *(f32x4*)(O + ((size_t)((((b * 2 + l) * 2 + d) * 4 + h) * 64 + dk)) * 128 + vd) = acc[d][v][k];
      }
}

__device__ __forceinline__ void keyprep_item(const Params& p, int l, int item) {
  const int tid = tidx(), lane = tid & 63, wid = tid >> 6;
  char* ws = wsp(p.ws);
  bf16_t* CKVA = (bf16_t*)(ws + O_CKVA);
  bf16_t* KRA = (bf16_t*)(ws + O_KRA);
#pragma unroll
  for (int i = 0; i < 4; ++i) {
    const int R = item * 16 + wid * 4 + i;
    int smp = 0, b, t = 0, tok = 0, ctx = 0, pp = 0;
    if (R < NPR) { tok = R; b = R >> 8; t = R & 255; }
    else { smp = 1; const int s = R - NPR; b = s / 1536; pp = s - b * 1536; if (pp < 512) ctx = 1; else { t = pp - 512; tok = NPR + b * 1024 + t; } }
    if (ctx) {
      const f32x4 v = *(const f32x4*)(p.cache_ckv + ((size_t)((b * 2 + l) * 512 + pp)) * 256 + lane * 4);
      *(u32x2*)(CKVA + (size_t)R * 256 + lane * 4) = pk4(v);
      if (lane < 32) KRA[(size_t)R * 32 + lane] = tobf(p.cache_krope[((size_t)((b * 2 + l) * 512 + pp)) * 32 + lane]);
      continue;
    }
    const f32x4 v = *(const f32x4*)((const float*)(ws + O_KVLAT) + (size_t)tok * 256 + lane * 4);
    float ss = v[0] * v[0] + v[1] * v[1] + v[2] * v[2] + v[3] * v[3];
    ss = wave_sum(ss);
    const float rstd = rsqrtf(ss * (1.f / 256.f) + EPSN);
    const f32x4 g = *(const f32x4*)(p.kv_norm_g + l * 256 + lane * 4);
    f32x4 y;
#pragma unroll
    for (int e = 0; e < 4; ++e) y[e] = v[e] * rstd * g[e];
    *(u32x2*)(CKVA + (size_t)R * 256 + lane * 4) = pk4(y);
    if (!smp) *(f32x4*)(p.out + OUT_CKV + ((size_t)((b * 2 + l) * 256 + t)) * 256 + lane * 4) = y;
    const int d = lane & 31;
    const float x = ((const float*)(ws + O_KR))[(size_t)tok * 32 + d];
    float yk = x;
    if (smp) {
      const float pr = __shfl_xor(x, 8);
      const int hd = d >> 4, i16 = d & 15, f = i16 & 7;
      const float pos = (float)(hd ? (t & 63) : (t >> 6));
      const float ang = pos * exp2f(-(float)f * 1.66096404744f);
      const float cs = __cosf(ang), sn = __sinf(ang);
      yk = i16 < 8 ? x * cs - pr * sn : pr * sn + x * cs;
    } else if (lane < 32) {
      p.out[OUT_KR + ((size_t)((b * 2 + l) * 256 + t)) * 32 + d] = x;
    }
    if (lane < 32) KRA[(size_t)R * 32 + d] = tobf(yk);
  }
}

__device__ __forceinline__ void f1_tile(const Params& p, int tile, char* lds) {
  const int tid = tidx(), lane = tid & 63, wid = tid >> 6, wm = wid >> 1, wn = wid & 1, fr = lane & 15, fq = lane >> 4;
  const int m = tile >> 3, g = (tile >> 1) & 3, nh = tile & 1, m0 = m * 128;
  char* ws = wsp(p.ws);
  f32x4 acc[4][4];
  zero_acc(acc);
  gemm_core<false>((const bf16_t*)(ws + O_FU) + (size_t)m0 * 512 + g * 128, 512, (const bf16_t*)(ws + O_CS) + (size_t)nh * 128 * 128, 128, 128, acc, lds);
  bf16_t* UT = (bf16_t*)(ws + O_UT);
#pragma unroll
  for (int i = 0; i < 4; ++i) {
    const int tok = m0 + wm * 64 + i * 16 + fq * 4;
    size_t base; int T, b, t;
    if (tok < NPR) { b = tok >> 8; t = tok & 255; T = 256; base = 0; } else { const int s = tok - NPR; b = s >> 10; t = s & 1023; T = 1024; base = (size_t)NPR * 1024; }
#pragma unroll
    for (int j = 0; j < 4; ++j) {
      const int k2 = wn * 64 + j * 16 + fr;
      *(u32x2*)(UT + base + ((size_t)(b * 4 + g) * 128 + k2) * (2 * T) + nh * T + t) = pk4(acc[i][j]);
    }
  }
}

__device__ __forceinline__ void qup_tile(const Params& p, int l, int tile, char* lds) {
  const int tid = tidx(), lane = tid & 63, wid = tid >> 6, wm = wid >> 1, wn = wid & 1, fr = lane & 15, fq = lane >> 4;
  const int m = tile % 96, nt = tile / 96, m0 = m * 128, n0 = nt * 128;
  char* ws = wsp(p.ws);
  const bf16_t* QL = (const bf16_t*)(ws + O_QLAT) + (size_t)m0 * 384;
  float rsv;
  {
    const bf16_t* q = QL + (size_t)(wm * 64 + lane) * 384;
    float ss = 0.f;
#pragma unroll 4
    for (int i = 0; i < 48; ++i) {
      const u32x4 w = *(const u32x4*)(q + i * 8);
      ss += bflo(w.x) * bflo(w.x) + bfhi(w.x) * bfhi(w.x) + bflo(w.y) * bflo(w.y) + bfhi(w.y) * bfhi(w.y) + bflo(w.z) * bflo(w.z) + bfhi(w.z) * bfhi(w.z) + bflo(w.w) * bflo(w.w) + bfhi(w.w) * bfhi(w.w);
    }
    rsv = rsqrtf(ss * (1.f / 384.f) + EPSN);
  }
  f32x4 acc[4][4];
  zero_acc(acc);
  gemm_core<true>(QL, 384, (const bf16_t*)(ws + O_WQ) + ((size_t)l * 768 + n0) * 384, 384, 384, acc, lds);
  bf16_t* QB = (bf16_t*)(ws + O_QB);
  const float qscale = 0.10206207261596577f * 1.44269504089f;
#pragma unroll
  for (int i = 0; i < 4; ++i) {
    const int rl = wm * 64 + i * 16 + fr, tok = m0 + rl;
    const float sc = __shfl(rsv, i * 16 + fr) * qscale;
    const int smp = tok >= NPR, t = (tok - NPR) & 1023;
#pragma unroll
    for (int j = 0; j < 4; ++j) {
      const int cb = n0 + wn * 64 + j * 16, within = cb % 96;
      f32x4 v = acc[i][j] * sc;
      if (within >= 64) {
        f32x4 pr;
#pragma unroll
        for (int e = 0; e < 4; ++e) pr[e] = __shfl_xor(v[e], 32);
        if (smp) {
          const float pos = (float)(within >= 80 ? (t & 63) : (t >> 6));
#pragma unroll
          for (int e = 0; e < 4; ++e) {
            const int f = (fq & 1) * 4 + e;
            const float ang = pos * exp2f(-(float)f * 1.66096404744f);
            const float cs = __cosf(ang), sn = __sinf(ang);
            v[e] = fq < 2 ? v[e] * cs - pr[e] * sn : pr[e] * sn + v[e] * cs;
          }
        }
      }
      *(u32x2*)(QB + (size_t)tok * 768 + cb + fq * 4) = pk4(v);
    }
  }
}

__device__ __forceinline__ void kvup_tile(const Params& p, int l, int tile, char* lds) {
  const int tid = tidx(), lane = tid & 63, wid = tid >> 6, wm = wid >> 1, wn = wid & 1, fr = lane & 15, fq = lane >> 4;
  const int m = tile % 112, nt = tile / 112, m0 = m * 128, n0 = nt * 128;
  char* ws = wsp(p.ws);
  const bf16_t* A = (const bf16_t*)(ws + O_CKVA) + (size_t)m0 * 256;
  const bf16_t* B = (const bf16_t*)(ws + O_WKV) + ((size_t)l * 1024 + n0) * 256;
  f32x4 acc[4][4];
  zero_acc(acc);
  if (nt < 4) {
    gemm_core<true>(A, 256, B, 256, 256, acc, lds);
    bf16_t* KB = (bf16_t*)(ws + O_KB);
#pragma unroll
    for (int i = 0; i < 4; ++i) {
      const int R = m0 + wm * 64 + i * 16 + fr;
#pragma unroll
      for (int j = 0; j < 4; ++j) *(u32x2*)(KB + (size_t)R * 512 + n0 + wn * 64 + j * 16 + fq * 4) = pk4(acc[i][j]);
    }
  } else {
    gemm_core<false>(A, 256, B, 256, 256, acc, lds);
    bf16_t* VT = (bf16_t*)(ws + O_VT);
#pragma unroll
    for (int i = 0; i < 4; ++i) {
      const int R = m0 + wm * 64 + i * 16 + fq * 4;
      size_t base; int Tk, b, k;
      if (R < NPR) { b = R >> 8; k = R & 255; Tk = 256; base = 0; } else { const int s = R - NPR; b = s / 1536; k = s - b * 1536; Tk = 1536; base = (size_t)NPR * 512; }
#pragma unroll
      for (int j = 0; j < 4; ++j) {
        const int c = n0 - 512 + wn * 64 + j * 16 + fr, h = c >> 6, vd = c & 63;
        *(u32x2*)(VT + base + ((size_t)(b * 8 + h) * 64 + vd) * Tk + k) = pk4(acc[i][j]);
      }
    }
  }
}

__device__ __forceinline__ void f2_tile(const Params& p, int tile, char* lds) {
  const int tid = tidx(), lane = tid & 63, wid = tid >> 6, wm = wid >> 1, wn = wid & 1, fr = lane & 15, fq = lane >> 4;
  char* ws = wsp(p.ws);
  const bf16_t *A, *B; int K, tokb, g; float scale;
  if (tile < 128) {
    const int b = tile >> 5, mt = tile & 7; g = (tile >> 3) & 3;
    A = (const bf16_t*)(ws + O_D1024) + (size_t)mt * 128 * 2048; K = 2048;
    B = (const bf16_t*)(ws + O_UT) + (size_t)NPR * 1024 + (size_t)(b * 4 + g) * 128 * 2048;
    tokb = NPR + b * 1024 + mt * 128; scale = 0.00276213586400995f;
  } else {
    const int it = tile - 128, b = it >> 3, mt = it & 1; g = (it >> 1) & 3;
    A = (const bf16_t*)(ws + O_D256) + (size_t)mt * 128 * 512; K = 512;
    B = (const bf16_t*)(ws + O_UT) + (size_t)(b * 4 + g) * 128 * 512;
    tokb = b * 256 + mt * 128; scale = 0.0055242717280199f;
  }
  f32x4 acc[4][4];
  zero_acc(acc);
  gemm_core<true>(A, K, B, K, K, acc, lds);
  bf16_t* FZ = (bf16_t*)(ws + O_FZ);
#pragma unroll
  for (int i = 0; i < 4; ++i) {
    const int tok = tokb + wm * 64 + i * 16 + fr;
#pragma unroll
    for (int j = 0; j < 4; ++j) {
      bf16_t* gp = FZ + (size_t)tok * 512 + g * 128 + wn * 64 + j * 16 + fq * 4;
      const u32x2 gz = *(const u32x2*)gp;
      f32x4 y;
      y[0] = acc[i][j][0] * scale * bflo(gz.x); y[1] = acc[i][j][1] * scale * bfhi(gz.x);
      y[2] = acc[i][j][2] * scale * bflo(gz.y); y[3] = acc[i][j][3] * scale * bfhi(gz.y);
      *(u32x2*)gp = pk4(y);
    }
  }
}

__device__ __forceinline__ void s6_tile(const Params& p, int l, int tile, int ntile, char* lds, int& par, bool& primed) {
  const int tid = tidx(), lane = tid & 63, wid = tid >> 6, wm = wid >> 1, wn = wid & 1, fr = lane & 15, fq = lane >> 4;
  const int m = tile % 96, nt = tile / 96, m0 = m * 128, n0 = nt * 64;
  char* ws = wsp(p.ws);
  const bf16_t* Hh = (const bf16_t*)(ws + O_H);
  const bf16_t* Wg = (const bf16_t*)(ws + O_WIN) + ((size_t)l * 6912 + 3840) * 1024;
  const bf16_t* Wb = (const bf16_t*)(ws + O_WBR) + (size_t)(l * 3) * 1024 * 512;
  f32x4 tot[4][2], acc[4][2];
  u32x2 sg[4][2];
#pragma unroll
  for (int i = 0; i < 4; ++i) { tot[i][0] = (f32x4){0.f, 0.f, 0.f, 0.f}; tot[i][1] = (f32x4){0.f, 0.f, 0.f, 0.f}; }
#pragma unroll 1
  for (int nb = 0; nb < 3; ++nb) {
#pragma unroll
    for (int i = 0; i < 4; ++i) { acc[i][0] = (f32x4){0.f, 0.f, 0.f, 0.f}; acc[i][1] = (f32x4){0.f, 0.f, 0.f, 0.f}; }
    const size_t boff = nb == 0 ? O_RZ : (nb == 1 ? O_MZ : O_FZ);
    const bf16_t* brA = (const bf16_t*)(ws + boff) + (size_t)m0 * 512;
    const bf16_t* brB = Wb + ((size_t)nb * 1024 + n0) * 512;
    gemm_core<true, 2>(Hh + (size_t)m0 * 1024, 1024, Wg + ((size_t)nb * 1024 + n0) * 1024, 1024, 1024, acc, lds, par, primed, brA, 512, brB, 512);
#pragma unroll
    for (int i = 0; i < 4; ++i)
#pragma unroll
      for (int j = 0; j < 2; ++j) { f32x4 sv;
#pragma unroll
        for (int e = 0; e < 4; ++e) sv[e] = sigm_f(acc[i][j][e]);
        sg[i][j] = pk4(sv); }
#pragma unroll
    for (int i = 0; i < 4; ++i) { acc[i][0] = (f32x4){0.f, 0.f, 0.f, 0.f}; acc[i][1] = (f32x4){0.f, 0.f, 0.f, 0.f}; }
    const bf16_t *nA = nullptr, *nB = nullptr;
    if (nb < 2) { nA = Hh + (size_t)m0 * 1024; nB = Wg + ((size_t)(nb + 1) * 1024 + n0) * 1024; }
    else if (ntile >= 0) { nA = Hh + (size_t)((ntile % 96) * 128) * 1024; nB = Wg + (size_t)((ntile / 96) * 64) * 1024; }
    gemm_core<true, 2>(brA, 512, brB, 512, 512, acc, lds, par, true, nA, 1024, nB, 1024);
    primed = nA != nullptr;
#pragma unroll
    for (int i = 0; i < 4; ++i)
#pragma unroll
      for (int j = 0; j < 2; ++j) {
        tot[i][j][0] += acc[i][j][0] * bflo(sg[i][j].x); tot[i][j][1] += acc[i][j][1] * bfhi(sg[i][j].x);
        tot[i][j][2] += acc[i][j][2] * bflo(sg[i][j].y); tot[i][j][3] += acc[i][j][3] * bfhi(sg[i][j].y);
      }
  }
  bf16_t* MG = (bf16_t*)(ws + O_UT);
#pragma unroll
  for (int i = 0; i < 4; ++i) {
    const int tok = m0 + wm * 64 + i * 16 + fr;
#pragma unroll
    for (int j = 0; j < 2; ++j) *(u32x2*)(MG + (size_t)tok * 1024 + n0 + wn * 32 + j * 16 + fq * 4) = pk4(tot[i][j]);
  }
}

__device__ __forceinline__ void s7_tile(const Params& p, int l, int tile, const float* xp, const float* xs, char* lds) {
  const int tid = tidx(), lane = tid & 63, wid = tid >> 6, wm = wid >> 1, wn = wid & 1, fr = lane & 15, fq = lane >> 4;
  const int m = tile % 96, nt = tile / 96, m0 = m * 128, n0 = nt * 64;
  char* ws = wsp(p.ws);
  f32x4 acc[4][2];
#pragma unroll
  for (int i = 0; i < 4; ++i) { acc[i][0] = (f32x4){0.f, 0.f, 0.f, 0.f}; acc[i][1] = (f32x4){0.f, 0.f, 0.f, 0.f}; }
  gemm_core<true, 2>((const bf16_t*)(ws + O_UT) + (size_t)m0 * 1024, 1024, (const bf16_t*)(ws + O_WO) + ((size_t)l * 1024 + n0) * 1024, 1024, 1024, acc, lds);
#pragma unroll
  for (int i = 0; i < 4; ++i) {
    const int tok = m0 + wm * 64 + i * 16 + fr;
    const float* src = tok < NPR ? xp + (size_t)tok * 1024 : xs + (size_t)(tok - NPR) * 1024;
    const int v = tok < NPR ? 0 : 1 + ((tok - NPR) >> 10);
    const float* gate = (const float*)(ws + O_MOD) + (l * 5 + v) * 3072 + 2048;
#pragma unroll
    for (int j = 0; j < 2; ++j) {
      const int col = n0 + wn * 32 + j * 16 + fq * 4;
      const f32x4 x = *(const f32x4*)(src + col), gt = *(const f32x4*)(gate + col);
      f32x4 y;
#pragma unroll
      for (int e = 0; e < 4; ++e) y[e] = x[e] + gt[e] * acc[i][j][e];
      *(f32x4*)(p.out + (size_t)tok * 1024 + col) = y;
    }
  }
}

constexpr int NPHASE = 16;
__device__ __forceinline__ int q_issue(unsigned* ctr) {
  int v = 0;
  if (threadIdx.x == 0) v = (int)__hip_atomic_fetch_add(ctr, 1u, __ATOMIC_RELAXED, __HIP_MEMORY_SCOPE_AGENT);
  return v;
}
__device__ __forceinline__ int q_bcast(int v, char* lds) {
  __syncthreads();
  if (threadIdx.x == 0) *(volatile int*)lds = v;
  __syncthreads();
  const int it = *(volatile int*)lds;
  __syncthreads();
  return it;
}
__device__ __forceinline__ void run_phase(const Params& p, int ph, char* lds, unsigned* qctr) {
  const int bid = blockIdx.x, nb = gridDim.x;
  if (ph == 0) { for (int i = bid; i < P0_N; i += nb) phase0_item(p, i, lds); return; }
  if (ph == 15) { for (int i = bid; i < 512; i += nb) final_item(p, i); return; }
  const int l = (ph - 1) / 7, s = (ph - 1) % 7;
  const float* xp = l == 0 ? p.x_prompt : p.out;
  const float* xs = l == 0 ? p.x_sample : p.out + (size_t)NPR * 1024;
  switch (s) {
    case 0: for (int i = bid; i < 512; i += nb) norm_item(p, l, i, xp, xs); break;
    case 1: for (int i = bid; i < 2880; i += nb) s2_tile(p, l, i, lds); break;
    case 2:
      for (int i = q_bcast(q_issue(qctr + ph), lds); i < 2752;) {
        if (i < 128) attn_item<1>(p, l, i, lds);
        else if (i < 1024) keyprep_item(p, l, i - 128);
        else if (i < 1280) attn_item<1>(p, l, 128 + (i - 1024), lds);
        else if (i < 1408) state_item(p, l, i - 1280);
        else if (i < 1984) qup_tile(p, l, i - 1408, lds);
        else f1_tile(p, i - 1984, lds);
        i = q_bcast(q_issue(qctr + ph), lds);
      }
      break;
    case 3:
      for (int i = q_bcast(q_issue(qctr + ph), lds); i < 1280;) {
        if (i < 384) f2_tile(p, i, lds);
        else kvup_tile(p, l, i - 384, lds);
        i = q_bcast(q_issue(qctr + ph), lds);
      }
      break;
    case 4:
      for (int i = q_bcast(q_issue(qctr + ph), lds); i < 768;) {
        attn_item<0>(p, l, i, lds);
        i = q_bcast(q_issue(qctr + ph), lds);
      }
      break;
    case 5: { int par = 0; bool primed = false; for (int i = bid; i < 1536; i += nb) s6_tile(p, l, i, (i + nb < 1536) ? i + nb : -1, lds, par, primed); } break;
    case 6: for (int i = bid; i < 1536; i += nb) s7_tile(p, l, i, xp, xs, lds); break;
  }
}

#define XB_TMO      128
#define XB_XCNT(j)  (256  + 64 * (j))
#define XB_XSUB(j)  (1280 + 64 * (j))
#define XB_XGEN(j)  (2304 + 64 * (j))
#define XB_TOP      3328
#define XB_TOPGEN   3392
#define XCD_BAR_WORDS 3456
#define XB_SPIN_CAP (1u << 18)
__device__ __forceinline__ unsigned xb_ld(unsigned* p)              { return __hip_atomic_load(p, __ATOMIC_RELAXED, __HIP_MEMORY_SCOPE_AGENT); }
__device__ __forceinline__ unsigned xb_add(unsigned* p, unsigned v) { return __hip_atomic_fetch_add(p, v, __ATOMIC_RELAXED, __HIP_MEMORY_SCOPE_AGENT); }
__device__ __forceinline__ unsigned xb_xcc_id() { return (unsigned)__builtin_amdgcn_s_getreg((3 << 11) | 20) & 0xFu; }
#define XB_SPIN(cond, bar) do { unsigned _sp = 0; while (cond) { __builtin_amdgcn_s_sleep(1); \
    if ((++_sp & 255u) == 0u) { if (xb_ld(&(bar)[XB_TMO])) break; if (_sp > XB_SPIN_CAP) { atomicAdd(&(bar)[XB_TMO], 1u); break; } } } } while (0)
__device__ __forceinline__ void xcd_barrier_complete(unsigned* bar, unsigned x, unsigned& nloc, unsigned& nx) {
  const unsigned G = gridDim.x;
  unsigned sum, cnt, mine, sp = 0u;
  for (;;) {
    sum = 0u; cnt = 0u; mine = 0u;
#pragma unroll
    for (unsigned j = 0; j < 16; ++j) { const unsigned c = xb_ld(&bar[XB_XCNT(j)]); sum += c; cnt += (c > 0u) ? 1u : 0u; mine = (j == x) ? c : mine; }
    if (sum == G) break;
    __builtin_amdgcn_s_sleep(1);
    if ((++sp & 255u) == 0u) { if (xb_ld(&bar[XB_TMO])) break; if (sp > XB_SPIN_CAP) { atomicAdd(&bar[XB_TMO], 1u); break; } }
  }
  nloc = mine > 0u ? mine : 1u; nx = cnt > 0u ? cnt : 1u;
}
__device__ __forceinline__ void xcd_barrier(unsigned* bar, unsigned x, unsigned& nloc, unsigned& nx) {
  asm volatile("s_waitcnt vmcnt(0)" ::: "memory");
  __syncthreads();
  if (threadIdx.x == 0) {
    __builtin_amdgcn_s_waitcnt(0);
    if (nloc == 0u) xcd_barrier_complete(bar, x, nloc, nx);
    const unsigned old = xb_add(&bar[XB_XSUB(x)], 1u);
    const unsigned gen = old / nloc;
    if (old + 1u == (gen + 1u) * nloc) {
      __builtin_amdgcn_fence(__ATOMIC_RELEASE, "agent");
      asm volatile("s_waitcnt vmcnt(0)" ::: "memory");
      const unsigned og = xb_add(&bar[XB_TOP], 1u);
      const unsigned tg = og / nx;
      if (og + 1u == (tg + 1u) * nx) xb_add(&bar[XB_TOPGEN], 1u);
      else XB_SPIN(xb_ld(&bar[XB_TOPGEN]) == tg, bar);
      __builtin_amdgcn_fence(__ATOMIC_ACQUIRE, "agent");
      xb_add(&bar[XB_XGEN(x)], 1u);
      asm volatile("s_waitcnt vmcnt(0)" ::: "memory");
    } else {
      XB_SPIN(xb_ld(&bar[XB_XGEN(x)]) == gen, bar);
      __builtin_amdgcn_fence(__ATOMIC_ACQUIRE, "agent");
      asm volatile("s_waitcnt vmcnt(0)" ::: "memory");
    }
  }
  __syncthreads();
}

__global__ void __launch_bounds__(256, 2) mk_fwd(Params p) {
  __shared__ __attribute__((aligned(16))) char lds[LDS_TOTAL];
  cg::grid_group grid = cg::this_grid();
  unsigned* bar = (unsigned*)(p.ws + O_BAR);
  const unsigned xcc = xb_xcc_id();
  if (threadIdx.x == 0) (void)xb_add(&bar[XB_XCNT(xcc)], 1u);
  unsigned nloc = 0u, nx = 0u;
  if (gridDim.x == 0x7fffffffu) grid.sync();
#pragma unroll 1
  for (int ph = 0; ph < NPHASE; ++ph) {
    run_phase(p, ph, lds, bar);
    if (ph + 1 < NPHASE) xcd_barrier(bar, xcc, nloc, nx);
  }
}

extern "C" void kernel_launch(void* const* d_in, const int* in_sizes, int n_in, void* d_out, int out_size, void* d_ws, size_t ws_size,
                              hipStream_t stream) {
  Params p{};
  p.x_prompt = (const float*)d_in[0]; p.x_sample = (const float*)d_in[1]; p.cache_ckv = (const float*)d_in[2]; p.cache_krope = (const float*)d_in[3];
  p.state_ret = (const float*)d_in[4]; p.c = (const float*)d_in[5]; p.c_ctx = (const float*)d_in[6]; p.norm_g = (const float*)d_in[7];
  p.w_mod = (const float*)d_in[8]; p.b_mod = (const float*)d_in[9]; p.w_in = (const float*)d_in[10]; p.ret_logit = (const float*)d_in[11];
  p.q_norm_g = (const float*)d_in[12]; p.w_q_up = (const float*)d_in[13]; p.kv_norm_g = (const float*)d_in[14]; p.w_kv_up = (const float*)d_in[15];
  p.w_branch = (const float*)d_in[16]; p.w_out = (const float*)d_in[17]; p.final_g = (const float*)d_in[18];
  p.out = (float*)d_out; p.ws = (char*)d_ws;
#if ONE_LAUNCH
  static int grid_blocks = 0;
  if (!grid_blocks) {
    int dev = 0, cus = 0, per_cu = 0;
    hipGetDevice(&dev);
    hipDeviceGetAttribute(&cus, hipDeviceAttributeMultiprocessorCount, dev);
    hipOccupancyMaxActiveBlocksPerMultiprocessor(&per_cu, mk_fwd, 256, 0);
    if (per_cu > 2) per_cu = 2;
    grid_blocks = cus * per_cu;
  }
  hipMemsetAsync((char*)d_ws + O_BAR, 0, XCD_BAR_WORDS * 4, stream);
  void* args[] = {&p};
  hipError_t e = hipLaunchCooperativeKernel((void*)mk_fwd, dim3(grid_blocks), dim3(256), args, 0, stream);
  if (e != hipSuccess) fprintf(stderr, "cooperative launch failed: %s (grid %d)\n", hipGetErrorString(e), grid_blocks);
#endif
}
```

```cpp
#include <hip/hip_runtime.h>
#include <hip/hip_cooperative_groups.h>
#include <stdint.h>
#include <stdio.h>
namespace cg = cooperative_groups;

#ifndef ONE_LAUNCH
#define ONE_LAUNCH 1
#endif

typedef unsigned short bf16_t;
typedef short bf16x8 __attribute__((ext_vector_type(8)));
typedef float f32x4 __attribute__((ext_vector_type(4)));
typedef unsigned u32x4 __attribute__((ext_vector_type(4)));
typedef unsigned u32x2 __attribute__((ext_vector_type(2)));

constexpr int NTOK = 12288, NPR = 8192, NKEY = 14336;
constexpr float EPSN = 1e-6f;

constexpr size_t O_WIN   = 0;
constexpr size_t O_WQ    = O_WIN   + (size_t)2 * 6912 * 1024 * 2;
constexpr size_t O_WKV   = O_WQ    + (size_t)2 * 768 * 384 * 2;
constexpr size_t O_WBR   = O_WKV   + (size_t)2 * 1024 * 256 * 2;
constexpr size_t O_WO    = O_WBR   + (size_t)6 * 1024 * 512 * 2;
constexpr size_t O_CS    = O_WO    + (size_t)2 * 1024 * 1024 * 2;
constexpr size_t O_D256  = O_CS    + (size_t)256 * 128 * 2;
constexpr size_t O_D1024 = O_D256  + (size_t)256 * 512 * 2;
constexpr size_t O_S0T   = O_D1024 + (size_t)1024 * 2048 * 2;
constexpr size_t O_MOD   = O_S0T   + (size_t)64 * 128 * 64 * 2;
constexpr size_t O_H     = O_MOD   + (size_t)2 * 5 * 3072 * 4;
constexpr size_t O_UT    = O_H     + (size_t)NTOK * 1024 * 2;
constexpr size_t O_RQ    = O_UT    + (size_t)NTOK * 1024 * 2;
constexpr size_t O_RK    = O_RQ    + (size_t)NTOK * 256 * 2;
constexpr size_t O_RKT   = O_RK    + (size_t)NTOK * 256 * 2;
constexpr size_t O_RVT   = O_RKT   + (size_t)NPR * 256 * 2;
constexpr size_t O_KVLAT = O_RVT   + (size_t)NTOK * 512 * 2;
constexpr size_t O_KR    = O_KVLAT + (size_t)NTOK * 256 * 4;
constexpr size_t O_R2END = O_KR    + (size_t)NTOK * 32 * 4;
constexpr size_t O_VT    = O_RQ;
static_assert(O_VT + (size_t)NKEY * 512 * 2 <= O_R2END, "alias overflow");
constexpr size_t O_RZ    = O_R2END;
constexpr size_t O_MZ    = O_RZ    + (size_t)NTOK * 512 * 2;
constexpr size_t O_FZ    = O_MZ    + (size_t)NTOK * 512 * 2;
constexpr size_t O_FU    = O_FZ    + (size_t)NTOK * 512 * 2;
constexpr size_t O_QLAT  = O_FU    + (size_t)NTOK * 512 * 2;
constexpr size_t O_CKVA  = O_QLAT  + (size_t)NTOK * 384 * 2;
constexpr size_t O_KB    = O_CKVA  + (size_t)NKEY * 256 * 2;
constexpr size_t O_KRA   = O_KB    + (size_t)NKEY * 512 * 2;
constexpr size_t O_QB    = O_KRA   + (size_t)NKEY * 32 * 2;
constexpr size_t O_END   = O_QB    + (size_t)NTOK * 768 * 2;
constexpr size_t O_BAR   = (O_END + 255) & ~(size_t)255;
static_assert(O_BAR + 16384 <= (size_t)256 * 1024 * 1024, "workspace too large");

constexpr size_t OUT_CKV = (size_t)NTOK * 1024;
constexpr size_t OUT_KR  = OUT_CKV + (size_t)32 * 2 * 256 * 256;
constexpr size_t OUT_RET = OUT_KR + (size_t)32 * 2 * 256 * 32;

struct Params {
  const float *x_prompt, *x_sample, *cache_ckv, *cache_krope, *state_ret, *c, *c_ctx, *norm_g, *w_mod, *b_mod,
      *w_in, *ret_logit, *q_norm_g, *w_q_up, *kv_norm_g, *w_kv_up, *w_branch, *w_out, *final_g;
  float* out;
  char* ws;
};

constexpr int PANEL = 128 * 64;
constexpr int ABYTES = 2 * PANEL;
constexpr int STAGE = 2 * ABYTES;
constexpr int LDS_GEMM = 2 * STAGE;
constexpr int LDS_TOTAL = LDS_GEMM;
static_assert(LDS_TOTAL <= 65536, "static LDS");

typedef float f32x2 __attribute__((ext_vector_type(2)));
typedef __bf16 bf16x2v __attribute__((ext_vector_type(2)));
__device__ __forceinline__ unsigned pk2(float lo, float hi) { const f32x2 v = {lo, hi}; return __builtin_bit_cast(unsigned, __builtin_convertvector(v, bf16x2v)); }
__device__ __forceinline__ bf16_t tobf(float x) { return (bf16_t)(pk2(x, 0.f) & 0xffffu); }
__device__ __forceinline__ float bflo(unsigned u) { return __uint_as_float(u << 16); }
__device__ __forceinline__ float bfhi(unsigned u) { return __uint_as_float(u & 0xffff0000u); }
__device__ __forceinline__ float ex2(float x) { return __builtin_amdgcn_exp2f(x); }
__device__ __forceinline__ float silu_f(float x) { return x / (1.f + __expf(-x)); }
__device__ __forceinline__ float sigm_f(float x) { return 1.f / (1.f + __expf(-x)); }
__device__ __forceinline__ u32x2 pk4(f32x4 v) { u32x2 r; r.x = pk2(v[0], v[1]); r.y = pk2(v[2], v[3]); return r; }
#define GAS __attribute__((address_space(1)))
#define LAS __attribute__((address_space(3)))
__device__ __forceinline__ u32x4 ldg16(const void* p) { return *(const GAS u32x4*)p; }
__device__ __forceinline__ int tidx() { int t = threadIdx.x; asm volatile("" : "+v"(t)); return t; }
__device__ __forceinline__ char* wsp(const char* w) { unsigned long long v = (unsigned long long)w; asm volatile("" : "+s"(v)); return (char*)v; }
__device__ __forceinline__ int swz(int r) { return (0 - ((r >> 2) & 3)) & 3; }
__device__ __forceinline__ float wave_sum(float v) {
#pragma unroll
  for (int o = 1; o < 64; o <<= 1) v += __shfl_xor(v, o);
  return v;
}
__device__ __forceinline__ f32x4 mfma16(bf16x8 a, bf16x8 b, f32x4 c) { return __builtin_amdgcn_mfma_f32_16x16x32_bf16(a, b, c, 0, 0, 0); }
__device__ __forceinline__ bf16x8 as_bf8(u32x4 v) { return __builtin_bit_cast(bf16x8, v); }

__device__ __forceinline__ void zero_acc(f32x4 (&acc)[4][4]) {
#pragma unroll
  for (int i = 0; i < 4; ++i)
#pragma unroll
    for (int j = 0; j < 4; ++j) acc[i][j] = (f32x4){0.f, 0.f, 0.f, 0.f};
}

template <bool SWAP, int NJ = 4>
__device__ __forceinline__ void gemm_core(const bf16_t* __restrict__ A, int lda, const bf16_t* __restrict__ B, int ldb, int K,
                                          f32x4 (&acc)[4][NJ], char* lds, int& par, bool primed,
                                          const bf16_t* nA, int nlda, const bf16_t* nB, int nldb) {
  const int tid = tidx(), lane = tid & 63, wm = (tid >> 6) >> 1, wn = (tid >> 6) & 1;
  const int wid = __builtin_amdgcn_readfirstlane(tid >> 6);
  const int fr = lane & 15, fq = lane >> 4;
  const int fa = (wm * 64 + fr) * 64 + ((fq ^ swz(fr)) << 4);
  const int fb = ABYTES + (wn * NJ * 16 + fr) * 64 + ((fq ^ swz(fr)) << 4);
  const int lrow = lane >> 2, lchunk = (lane & 3) ^ swz(lrow);
  constexpr int NBL = NJ / 2;
  const GAS char* gA = (const GAS char*)(A + (size_t)(wid * 32 + lrow) * lda + lchunk * 8);
  const GAS char* gB = (const GAS char*)(B + (size_t)(wid * NBL * 16 + lrow) * ldb + lchunk * 8);
  const size_t a16 = (size_t)16 * lda * 2, b16 = (size_t)16 * ldb * 2;
  LAS char* ldsA = (LAS char*)lds + wid * 2048;
  LAS char* ldsB = (LAS char*)lds + ABYTES + wid * NBL * 1024;
  const int nk = K >> 6;
#define GC_ISSUE(pa, pb, sa, sb, stage, kbyte) do { \
    _Pragma("unroll") for (int g = 0; g < 2; ++g) _Pragma("unroll") for (int pn = 0; pn < 2; ++pn) \
      __builtin_amdgcn_global_load_lds((const GAS unsigned*)((pa) + g * (sa) + (kbyte) + pn * 64), (LAS unsigned*)(ldsA + (stage) + pn * PANEL + g * 1024), 16, 0, 0); \
    _Pragma("unroll") for (int g = 0; g < NBL; ++g) _Pragma("unroll") for (int pn = 0; pn < 2; ++pn) \
      __builtin_amdgcn_global_load_lds((const GAS unsigned*)((pb) + g * (sb) + (kbyte) + pn * 64), (LAS unsigned*)(ldsB + (stage) + pn * PANEL + g * 1024), 16, 0, 0); \
  } while (0)
  if (!primed) {
    GC_ISSUE(gA, gB, a16, b16, par * STAGE, 0);
    asm volatile("s_waitcnt vmcnt(0)" ::: "memory");
    __syncthreads();
  }
  for (int kt = 0; kt < nk; ++kt) {
    char* cur = lds + par * STAGE;
    if (kt + 1 < nk) GC_ISSUE(gA, gB, a16, b16, (par ^ 1) * STAGE, (size_t)(kt + 1) * 128);
    else if (nA) {
      const GAS char* hA = (const GAS char*)(nA + (size_t)(wid * 32 + lrow) * nlda + lchunk * 8);
      const GAS char* hB = (const GAS char*)(nB + (size_t)(wid * NBL * 16 + lrow) * nldb + lchunk * 8);
      GC_ISSUE(hA, hB, (size_t)16 * nlda * 2, (size_t)16 * nldb * 2, (par ^ 1) * STAGE, 0);
    }
    __builtin_amdgcn_sched_barrier(0);
#pragma unroll
    for (int ks = 0; ks < 2; ++ks) {
      bf16x8 af[4], bfr[NJ];
#pragma unroll
      for (int i = 0; i < 4; ++i) af[i] = *(const bf16x8*)(cur + ks * PANEL + fa + i * 1024);
#pragma unroll
      for (int j = 0; j < NJ; ++j) bfr[j] = *(const bf16x8*)(cur + ks * PANEL + fb + j * 1024);
#pragma unroll
      for (int i = 0; i < 4; ++i)
#pragma unroll
        for (int j = 0; j < NJ; ++j) acc[i][j] = SWAP ? mfma16(bfr[j], af[i], acc[i][j]) : mfma16(af[i], bfr[j], acc[i][j]);
    }
    __builtin_amdgcn_sched_barrier(0);
    asm volatile("s_waitcnt vmcnt(0)" ::: "memory");
    __syncthreads();
    par ^= 1;
  }
#undef GC_ISSUE
}
template <bool SWAP, int NJ = 4>
__device__ __forceinline__ void gemm_core(const bf16_t* __restrict__ A, int lda, const bf16_t* __restrict__ B, int ldb, int K,
                                          f32x4 (&acc)[4][NJ], char* lds) {
  int par = 0;
  gemm_core<SWAP, NJ>(A, lda, B, ldb, K, acc, lds, par, false, nullptr, 0, nullptr, 0);
}

__device__ __forceinline__ void tr_tile(const float* __restrict__ src, int lds_, int k0, int ns0, bf16_t* __restrict__ dst, int ldd, int nd0,
                                        const float* __restrict__ ksc, char* lds) {
  bf16_t* T = (bf16_t*)lds;
  const int tid = tidx();
  __syncthreads();
#pragma unroll
  for (int i = 0; i < 2; ++i) {
    const int kk = (tid >> 3) + 32 * i, nn4 = (tid & 7) * 4;
    const f32x4 v = *(const f32x4*)(src + (size_t)(k0 + kk) * lds_ + ns0 + nn4);
    const float s = ksc ? ksc[k0 + kk] : 1.f;
#pragma unroll
    for (int e = 0; e < 4; ++e) T[(nn4 + e) * 72 + kk] = tobf(v[e] * s);
  }
  __syncthreads();
  const int nn = tid >> 3, kc = (tid & 7) * 8;
  const u32x4 w = *(const u32x4*)(T + nn * 72 + kc);
  *(u32x4*)(dst + (size_t)(nd0 + nn) * ldd + k0 + kc) = w;
}

__device__ __forceinline__ void tr_tile2(const float* __restrict__ src, int lds_, int k0, int ns0, bf16_t* __restrict__ dst, int ldd, int nd0,
                                         const float* __restrict__ ksc, char* lds) {
  bf16_t* T = (bf16_t*)lds;
  const int tid = tidx();
  __syncthreads();
  f32x4 v[4];
#pragma unroll
  for (int i = 0; i < 4; ++i) v[i] = *(const GAS f32x4*)(src + (size_t)(k0 + (tid >> 3) + 32 * i) * lds_ + ns0 + (tid & 7) * 4);
#pragma unroll
  for (int i = 0; i < 4; ++i) {
    const int kk = (tid >> 3) + 32 * i, nn4 = (tid & 7) * 4;
    const float sc = ksc ? ksc[k0 + kk] : 1.f;
#pragma unroll
    for (int e = 0; e < 4; ++e) T[(nn4 + e) * 136 + kk] = tobf(v[i][e] * sc);
  }
  __syncthreads();
  const int nn = tid >> 3, kc = (tid & 7) * 16;
  const u32x4 w0 = *(const u32x4*)(T + nn * 136 + kc), w1 = *(const u32x4*)(T + nn * 136 + kc + 8);
  bf16_t* d = dst + (size_t)(nd0 + nn) * ldd + k0 + kc;
  *(u32x4*)d = w0; *(u32x4*)(d + 8) = w1;
}

constexpr int P0_GEMV = 192, P0_WIN = 3408, P0_WQ = 144, P0_WKV = 128, P0_WBR = 768, P0_WO = 512, P0_S0 = 256, P0_PAD = 96, P0_TAB = 1104;
constexpr int P0_N = P0_GEMV + P0_WIN + P0_WQ + P0_WKV + P0_WBR + P0_WO + P0_S0 + P0_PAD + P0_TAB;

__device__ __forceinline__ void phase0_item(const Params& p, int j, char* lds) {
  const int tid = tidx();
  char* ws = wsp(p.ws);
  if (j < P0_GEMV) {
    const int l = j / 96, cgi = j % 96;
    float* sv = (float*)lds;
    float* red = (float*)(lds + 20480);
    __syncthreads();
    for (int i = tid; i < 5120; i += 256) { const int v = i >> 10, k = i & 1023; const float x = (v == 0) ? p.c_ctx[k] : p.c[(v - 1) * 1024 + k]; sv[i] = silu_f(x); }
    __syncthreads();
    const int c4 = tid & 7, kg = tid >> 3;
    const float* w = p.w_mod + (size_t)l * 1024 * 3072 + cgi * 32 + c4 * 4;
    f32x4 a0 = {0.f, 0.f, 0.f, 0.f}, a1 = a0, a2 = a0, a3 = a0, a4 = a0;
#pragma unroll 8
    for (int k = kg * 32; k < kg * 32 + 32; ++k) {
      const f32x4 wv = *(const GAS f32x4*)(w + (size_t)k * 3072);
      a0 += wv * sv[k]; a1 += wv * sv[1024 + k]; a2 += wv * sv[2048 + k]; a3 += wv * sv[3072 + k]; a4 += wv * sv[4096 + k];
    }
    *(f32x4*)(red + (kg * 5 + 0) * 32 + c4 * 4) = a0; *(f32x4*)(red + (kg * 5 + 1) * 32 + c4 * 4) = a1; *(f32x4*)(red + (kg * 5 + 2) * 32 + c4 * 4) = a2;
    *(f32x4*)(red + (kg * 5 + 3) * 32 + c4 * 4) = a3; *(f32x4*)(red + (kg * 5 + 4) * 32 + c4 * 4) = a4;
    __syncthreads();
    if (tid < 160) {
      const int v = tid >> 5, c2 = tid & 31;
      float sm = p.b_mod[l * 3072 + cgi * 32 + c2];
#pragma unroll 8
      for (int g = 0; g < 32; ++g) sm += red[(g * 5 + v) * 32 + c2];
      ((float*)(ws + O_MOD))[(l * 5 + v) * 3072 + cgi * 32 + c2] = sm;
    }
    return;
  }
  j -= P0_GEMV;
  if (j < P0_WIN) {
    const int l = j / 1704, r = j % 1704, kt = r / 213, nt = r % 213, c0 = nt * 32;
    const int nd0 = c0 < 2176 ? c0 : (c0 < 2208 ? 3712 + (c0 - 2176) : (c0 < 3744 ? c0 - 32 : c0 + 96));
    tr_tile2(p.w_in + (size_t)l * 1024 * 6816, 6816, kt * 128, c0, (bf16_t*)(ws + O_WIN) + (size_t)l * 6912 * 1024, 1024, nd0, nullptr, lds);
    return;
  }
  j -= P0_WIN;
  if (j < P0_WQ) {
    const int l = j / 72, r = j % 72, kt = r / 24, nt = r % 24;
    tr_tile2(p.w_q_up + (size_t)l * 384 * 768, 768, kt * 128, nt * 32, (bf16_t*)(ws + O_WQ) + (size_t)l * 768 * 384, 384, nt * 32, p.q_norm_g + l * 384, lds);
    return;
  }
  j -= P0_WQ;
  if (j < P0_WKV) {
    const int l = j / 64, r = j % 64, kt = r / 32, nt = r % 32, c0 = nt * 32, h = c0 >> 7, e = c0 & 127;
    const int nd0 = e < 64 ? h * 64 + e : 512 + h * 64 + (e - 64);
    tr_tile2(p.w_kv_up + (size_t)l * 256 * 1024, 1024, kt * 128, c0, (bf16_t*)(ws + O_WKV) + (size_t)l * 1024 * 256, 256, nd0, nullptr, lds);
    return;
  }
  j -= P0_WKV;
  if (j < P0_WBR) {
    const int mat = j / 128, r = j % 128, kt = r / 32, nt = r % 32;
    tr_tile2(p.w_branch + (size_t)mat * 512 * 1024, 1024, kt * 128, nt * 32, (bf16_t*)(ws + O_WBR) + (size_t)mat * 1024 * 512, 512, nt * 32, nullptr, lds);
    return;
  }
  j -= P0_WBR;
  if (j < P0_WO) {
    const int l = j / 256, r = j % 256, kt = r / 32, nt = r % 32;
    tr_tile2(p.w_out + (size_t)l * 1024 * 1024, 1024, kt * 128, nt * 32, (bf16_t*)(ws + O_WO) + (size_t)l * 1024 * 1024, 1024, nt * 32, nullptr, lds);
    return;
  }
  j -= P0_WO;
  if (j < P0_S0) {
    const int mat = j >> 2, nt = j & 3;
    tr_tile(p.state_ret + (size_t)mat * 64 * 128, 128, 0, nt * 32, (bf16_t*)(ws + O_S0T) + (size_t)mat * 128 * 64, 64, nt * 32, nullptr, lds);
    return;
  }
  j -= P0_S0;
  if (j < P0_PAD) {
    const int l = j / 48, r = j % 48;
    bf16_t* d = (bf16_t*)(ws + O_WIN) + ((size_t)l * 6912 + 3744) * 1024 + (size_t)r * 2048 + tid * 8;
    *(u32x4*)d = (u32x4){0u, 0u, 0u, 0u};
    return;
  }
  j -= P0_PAD;
  {
    float v[8];
    bf16_t* dst;
    if (j < 16) {
      const int e0 = j * 2048 + tid * 8; dst = (bf16_t*)(ws + O_CS) + e0;
      const int n = e0 >> 7, k = e0 & 127;
#pragma unroll
      for (int e = 0; e < 8; ++e) {
        const float fr = (float)(((n & 127) * (k + e)) & 127) * (1.f / 128.f);
        v[e] = (n < 128) ? __builtin_amdgcn_cosf(fr) : __builtin_amdgcn_sinf(fr);
      }
    } else if (j < 80) {
      const int e0 = (j - 16) * 2048 + tid * 8; dst = (bf16_t*)(ws + O_D256) + e0;
      const int k1 = e0 >> 9, kk = e0 & 511;
#pragma unroll
      for (int e = 0; e < 8; ++e) {
        const int t = (kk + e) & 255;
        const float fr = (float)((k1 * t) & 255) * (1.f / 256.f);
        v[e] = (kk < 256) ? __builtin_amdgcn_cosf(fr) : -__builtin_amdgcn_sinf(fr);
      }
    } else {
      const int e0 = (j - 80) * 2048 + tid * 8; dst = (bf16_t*)(ws + O_D1024) + e0;
      const int k1 = e0 >> 11, kk = e0 & 2047;
#pragma unroll
      for (int e = 0; e < 8; ++e) {
        const int t = (kk + e) & 1023;
        const float fr = (float)((k1 * t) & 1023) * (1.f / 1024.f);
        v[e] = (kk < 1024) ? __builtin_amdgcn_cosf(fr) : -__builtin_amdgcn_sinf(fr);
      }
    }
    u32x4 w; w.x = pk2(v[0], v[1]); w.y = pk2(v[2], v[3]); w.z = pk2(v[4], v[5]); w.w = pk2(v[6], v[7]);
    *(u32x4*)dst = w;
  }
}

__device__ __forceinline__ void norm_item(const Params& p, int l, int item, const float* xp, const float* xs) {
  const int tid = tidx(), lane = tid & 63, wid = tid >> 6;
  bf16_t* H = (bf16_t*)(p.ws + O_H);
#pragma unroll 3
  for (int i = 0; i < 6; ++i) {
    const int row = item * 24 + wid * 6 + i;
    const float* src = row < NPR ? xp + (size_t)row * 1024 : xs + (size_t)(row - NPR) * 1024;
    const int v = row < NPR ? 0 : 1 + ((row - NPR) >> 10);
    const float* mod = (const float*)(p.ws + O_MOD) + (l * 5 + v) * 3072;
    f32x4 x[4]; float ss = 0.f;
#pragma unroll
    for (int q = 0; q < 4; ++q) { x[q] = *(const f32x4*)(src + (q * 64 + lane) * 4); ss += x[q][0] * x[q][0] + x[q][1] * x[q][1] + x[q][2] * x[q][2] + x[q][3] * x[q][3]; }
    ss = wave_sum(ss);
    const float rstd = rsqrtf(ss * (1.f / 1024.f) + EPSN);
#pragma unroll
    for (int q = 0; q < 4; ++q) {
      const int col = (q * 64 + lane) * 4;
      const f32x4 g = *(const f32x4*)(p.norm_g + l * 1024 + col), sc = *(const f32x4*)(mod + 1024 + col), sh = *(const f32x4*)(mod + col);
      f32x4 h;
#pragma unroll
      for (int e = 0; e < 4; ++e) h[e] = x[q][e] * rstd * g[e] * (1.f + sc[e]) + sh[e];
      *(u32x2*)(H + (size_t)row * 1024 + col) = pk4(h);
    }
  }
}
__device__ __forceinline__ void final_item(const Params& p, int item) {
  const int tid = tidx(), lane = tid & 63, wid = tid >> 6;
#pragma unroll 3
  for (int i = 0; i < 6; ++i) {
    const int row = item * 24 + wid * 6 + i;
    float* src = p.out + (size_t)row * 1024;
    f32x4 x[4]; float ss = 0.f;
#pragma unroll
    for (int q = 0; q < 4; ++q) { x[q] = *(const f32x4*)(src + (q * 64 + lane) * 4); ss += x[q][0] * x[q][0] + x[q][1] * x[q][1] + x[q][2] * x[q][2] + x[q][3] * x[q][3]; }
    ss = wave_sum(ss);
    const float rstd = rsqrtf(ss * (1.f / 1024.f) + EPSN);
#pragma unroll
    for (int q = 0; q < 4; ++q) {
      const int col = (q * 64 + lane) * 4;
      const f32x4 g = *(const f32x4*)(p.final_g + col);
      f32x4 y;
#pragma unroll
      for (int e = 0; e < 4; ++e) y[e] = x[q][e] * rstd * g[e];
      *(f32x4*)(src + col) = y;
    }
  }
}

__device__ __forceinline__ void s2_tile(const Params& p, int l, int tile, char* lds) {
  const int tid = tidx(), lane = tid & 63, wid = tid >> 6, wm = wid >> 1, wn = wid & 1, fr = lane & 15, fq = lane >> 4;
  const int m = tile % 96, nt = tile / 96, m0 = m * 128, n0 = nt * 128;
  char* ws = wsp(p.ws);
  const bf16_t* A = (const bf16_t*)(ws + O_H) + (size_t)m0 * 1024;
  const bf16_t* B = (const bf16_t*)(ws + O_WIN) + ((size_t)l * 6912 + n0) * 1024;
  f32x4 acc[4][4];
  zero_acc(acc);
  if (nt >= 4 && nt < 8) {
    gemm_core<false>(A, 1024, B, 1024, 1024, acc, lds);
    bf16_t* RVT = (bf16_t*)(ws + O_RVT);
#pragma unroll
    for (int i = 0; i < 4; ++i) {
      const int tok = m0 + wm * 64 + i * 16 + fq * 4;
      size_t base; int T, b, t;
      if (tok < NPR) { b = tok >> 8; t = tok & 255; T = 256; base = 0; } else { const int s = tok - NPR; b = s >> 10; t = s & 1023; T = 1024; base = (size_t)NPR * 512; }
#pragma unroll
      for (int j = 0; j < 4; ++j) {
        const int c = n0 - 512 + wn * 64 + j * 16 + fr, h = c >> 7, vd = c & 127;
        *(u32x2*)(RVT + base + ((size_t)(b * 4 + h) * 128 + vd) * T + t) = pk4(acc[i][j]);
      }
    }
    return;
  }
  gemm_core<true>(A, 1024, B, 1024, 1024, acc, lds);
  bf16_t* dst = nullptr; int ld = 0, c0 = 0, op = 0;
  if (nt < 2) { dst = (bf16_t*)(ws + O_RQ); ld = 256; c0 = 0; }
  else if (nt < 4) { dst = (bf16_t*)(ws + O_RK); ld = 256; c0 = 256; op = 2; }
  else if (nt < 12) { dst = (bf16_t*)(ws + O_RZ); ld = 512; c0 = 1024; op = 1; }
  else if (nt < 15) { dst = (bf16_t*)(ws + O_QLAT); ld = 384; c0 = 1536; }
  else if (nt < 17) { ld = 256; c0 = 1920; op = 3; }
  else if (nt < 21) { dst = (bf16_t*)(ws + O_MZ); ld = 512; c0 = 2176; op = 1; }
  else if (nt < 25) { dst = (bf16_t*)(ws + O_FU); ld = 512; c0 = 2688; }
  else if (nt < 29) { dst = (bf16_t*)(ws + O_FZ); ld = 512; c0 = 3200; op = 1; }
  else { ld = 32; c0 = 3712; op = 4; }
#pragma unroll
  for (int i = 0; i < 4; ++i) {
    const int tok = m0 + wm * 64 + i * 16 + fr;
#pragma unroll
    for (int j = 0; j < 4; ++j) {
      const int col = n0 - c0 + wn * 64 + j * 16 + fq * 4;
      f32x4 v = acc[i][j];
      if (op == 3) { *(f32x4*)((float*)(ws + O_KVLAT) + (size_t)tok * 256 + col) = v; continue; }
      if (op == 4) { if (col < 32) *(f32x4*)((float*)(ws + O_KR) + (size_t)tok * 32 + col) = v; continue; }
      if (op == 1) {
#pragma unroll
        for (int e = 0; e < 4; ++e) v[e] = silu_f(v[e]);
      } else if (op == 2) {
#pragma unroll
        for (int e = 0; e < 4; ++e) v[e] *= 0.125f;
      }
      const u32x2 w = pk4(v);
      *(u32x2*)(dst + (size_t)tok * ld + col) = w;
      if (op == 2 && tok < NPR) {
        bf16_t* RKT = (bf16_t*)(ws + O_RKT);
        const int b = tok >> 8, t = tok & 255, h = col >> 6, dk = col & 63;
        bf16_t* q = RKT + ((size_t)(b * 4 + h) * 64 + dk) * 256 + t;
        q[0] = (bf16_t)(w.x & 0xffffu); q[256] = (bf16_t)(w.x >> 16); q[512] = (bf16_t)(w.y & 0xffffu); q[768] = (bf16_t)(w.y >> 16);
      }
    }
  }
}

template <int MODE>
__device__ __forceinline__ void attn_item(const Params& p, int l, int item, char* lds) {
  constexpr int NKP = MODE == 0 ? 3 : 2;
  constexpr int NVB = MODE == 0 ? 4 : 8;
  constexpr int PV = NVB * 16 * 64;
  constexpr int KOFF = NKP * 4096;
  constexpr int BUF = KOFF + 2 * PV;
  const int tid = tidx(), lane = tid & 63, wid = tid >> 6, fr = lane & 15, fq = lane >> 4;
  char* ws = wsp(p.ws);
  int smp, b, h, qblk, T, Tk, tok0;
  const bf16_t *kbase, *rbase = nullptr, *vbase, *qbase;
  int kstride, qstride;
  if (MODE == 0) {
    if (item < 256) { smp = 1; b = item >> 6; h = (item >> 3) & 7; qblk = item & 7; T = 1024; Tk = 1536; tok0 = NPR + b * 1024 + qblk * 128; }
    else { const int it = item - 256; smp = 0; b = it >> 4; h = (it >> 1) & 7; qblk = it & 1; T = 256; Tk = 256; tok0 = b * 256 + qblk * 128; }
    const int keyrow0 = smp ? NPR + b * 1536 : b * 256;
    kbase = (const bf16_t*)(ws + O_KB) + (size_t)keyrow0 * 512 + h * 64; kstride = 512;
    rbase = (const bf16_t*)(ws + O_KRA) + (size_t)keyrow0 * 32;
    vbase = (const bf16_t*)(ws + O_VT) + (smp ? (size_t)NPR * 512 + (size_t)(b * 8 + h) * 64 * 1536 : (size_t)(b * 8 + h) * 64 * 256);
    qbase = (const bf16_t*)(ws + O_QB) + (size_t)tok0 * 768 + h * 96; qstride = 768;
  } else {
    if (item < 128) { smp = 1; b = item >> 5; h = (item >> 3) & 3; qblk = item & 7; T = 1024; tok0 = NPR + b * 1024 + qblk * 128; }
    else { const int it = item - 128; smp = 0; b = it >> 3; h = (it >> 1) & 3; qblk = it & 1; T = 256; tok0 = b * 256 + qblk * 128; }
    Tk = T;
    const int ktok0 = smp ? NPR + b * 1024 : b * 256;
    kbase = (const bf16_t*)(ws + O_RK) + (size_t)ktok0 * 256 + h * 64; kstride = 256;
    vbase = (const bf16_t*)(ws + O_RVT) + (smp ? (size_t)NPR * 512 + (size_t)(b * 4 + h) * 128 * 1024 : (size_t)(b * 4 + h) * 128 * 256);
    qbase = (const bf16_t*)(ws + O_RQ) + (size_t)tok0 * 256 + h * 64; qstride = 256;
  }
  const int nkt = Tk >> 6;
  bf16x8 qf[2][NKP];
#pragma unroll
  for (int qb = 0; qb < 2; ++qb)
#pragma unroll
    for (int ks = 0; ks < NKP; ++ks) qf[qb][ks] = *(const bf16x8*)(qbase + (size_t)(wid * 32 + qb * 16 + fr) * qstride + ks * 32 + fq * 8);
  f32x4 o[NVB][2];
#pragma unroll
  for (int vb = 0; vb < NVB; ++vb) { o[vb][0] = (f32x4){0.f, 0.f, 0.f, 0.f}; o[vb][1] = (f32x4){0.f, 0.f, 0.f, 0.f}; }
  float lgf = 0.f, lgb = 0.f;
  float mrow[2] = {-INFINITY, -INFINITY}, lrow[2] = {0.f, 0.f};
  const int tq0 = qblk * 128 + wid * 32 + fr;
  if (MODE == 1) {
    const float xf = p.ret_logit[(l * 2 + 0) * 4 + h], xb = p.ret_logit[(l * 2 + 1) * 4 + h];
    lgf = -log1pf(expf(-xf)) * 1.44269504089f; lgb = -log1pf(expf(-xb)) * 1.44269504089f;
    if (smp) {
      const bf16_t* s0 = (const bf16_t*)(ws + O_S0T);
#pragma unroll
      for (int dir = 0; dir < 2; ++dir) {
        const bf16_t* sb = s0 + ((size_t)(((b * 2 + l) * 2 + dir) * 4 + h) * 128) * 64;
        float dec[2];
#pragma unroll
        for (int qb = 0; qb < 2; ++qb) { const int tq = tq0 + qb * 16; dec[qb] = dir == 0 ? ex2((float)(tq + 1) * lgf) : ex2((float)(T - tq) * lgb); }
#pragma unroll
        for (int vb = 0; vb < NVB; ++vb) {
          f32x4 t0 = (f32x4){0.f, 0.f, 0.f, 0.f}, t1 = (f32x4){0.f, 0.f, 0.f, 0.f};
#pragma unroll
          for (int ks = 0; ks < 2; ++ks) {
            const bf16x8 sf = *(const bf16x8*)(sb + (size_t)(vb * 16 + fr) * 64 + ks * 32 + fq * 8);
            t0 = mfma16(sf, qf[0][ks], t0); t1 = mfma16(sf, qf[1][ks], t1);
          }
          o[vb][0] += t0 * dec[0]; o[vb][1] += t1 * dec[1];
        }
      }
    }
  }
  u32x4 vreg[NVB / 2];
  const int uw = __builtin_amdgcn_readfirstlane(wid);
  const int dkey = lane >> 2, dchunk = (lane & 3) ^ swz(dkey);
  auto kdma = [&](int kt, char* buf) {
    const GAS bf16_t* kp = (const GAS bf16_t*)kbase + (size_t)(kt * 64 + uw * 16 + dkey) * kstride + dchunk * 8;
#pragma unroll
    for (int pn = 0; pn < 2; ++pn)
      __builtin_amdgcn_global_load_lds((const GAS unsigned*)(kp + pn * 32), (LAS unsigned*)((LAS char*)buf + pn * 4096 + uw * 1024), 16, 0, 0);
    if (MODE == 0) {
      const GAS bf16_t* rp = (const GAS bf16_t*)rbase + (size_t)(kt * 64 + uw * 16 + dkey) * 32 + dchunk * 8;
      __builtin_amdgcn_global_load_lds((const GAS unsigned*)rp, (LAS unsigned*)((LAS char*)buf + 2 * 4096 + uw * 1024), 16, 0, 0);
    }
  };
  auto gload = [&](int kt) {
#pragma unroll
    for (int i = 0; i < NVB / 2; ++i) { const int idx = tid + 256 * i, vd = idx >> 3, g = idx & 7; vreg[i] = ldg16(vbase + (size_t)vd * Tk + kt * 64 + g * 8); }
  };
  auto lstore = [&](char* buf) {
#pragma unroll
    for (int i = 0; i < NVB / 2; ++i) {
      const int idx = tid + 256 * i, vd = idx >> 3, g = idx & 7, pnl = g >> 2, g4 = g & 3, hi = g4 >> 1, q0 = 2 * (g4 & 1);
      char* base = buf + KOFF + pnl * PV + vd * 64 + hi * 8;
      *(u32x2*)(base + ((q0 ^ swz(vd)) << 4)) = (u32x2){vreg[i].x, vreg[i].y};
      *(u32x2*)(base + (((q0 + 1) ^ swz(vd)) << 4)) = (u32x2){vreg[i].z, vreg[i].w};
    }
  };
  __syncthreads();
  kdma(0, lds); gload(0); lstore(lds);
  asm volatile("s_waitcnt vmcnt(0)" ::: "memory");
  __syncthreads();
  const int foff = fr * 64 + ((fq ^ swz(fr)) << 4);
  for (int kt = 0; kt < nkt; ++kt) {
    char* cur = lds + (kt & 1) * BUF;
    const bool more = (kt + 1) < nkt;
    if (more) { kdma(kt + 1, lds + ((kt + 1) & 1) * BUF); gload(kt + 1); }
    __builtin_amdgcn_sched_barrier(0);
    f32x4 s[4][2];
#pragma unroll
    for (int kb = 0; kb < 4; ++kb) {
      s[kb][0] = (f32x4){0.f, 0.f, 0.f, 0.f}; s[kb][1] = (f32x4){0.f, 0.f, 0.f, 0.f};
#pragma unroll
      for (int ks = 0; ks < NKP; ++ks) {
        const bf16x8 kf = *(const bf16x8*)(cur + ks * 4096 + kb * 1024 + foff);
        s[kb][0] = mfma16(kf, qf[0][ks], s[kb][0]); s[kb][1] = mfma16(kf, qf[1][ks], s[kb][1]);
      }
    }
    bf16x8 pf[2][2];
#pragma unroll
    for (int qb = 0; qb < 2; ++qb) {
      if (MODE == 0) {
        float mx = s[0][qb][0];
#pragma unroll
        for (int kb = 0; kb < 4; ++kb)
#pragma unroll
          for (int r = 0; r < 4; ++r) mx = fmaxf(mx, s[kb][qb][r]);
        mx = fmaxf(mx, __shfl_xor(mx, 16)); mx = fmaxf(mx, __shfl_xor(mx, 32));
        const float mn = fmaxf(mrow[qb], mx), alpha = ex2(mrow[qb] - mn);
        mrow[qb] = mn;
        float ls = 0.f;
#pragma unroll
        for (int kb = 0; kb < 4; ++kb)
#pragma unroll
          for (int r = 0; r < 4; ++r) { const float e = ex2(s[kb][qb][r] - mn); s[kb][qb][r] = e; ls += e; }
        lrow[qb] = lrow[qb] * alpha + ls;
#pragma unroll
        for (int vb = 0; vb < NVB; ++vb) o[vb][qb] *= alpha;
      } else {
        const int tq = tq0 + qb * 16;
#pragma unroll
        for (int kb = 0; kb < 4; ++kb)
#pragma unroll
          for (int r = 0; r < 4; ++r) {
            const int d = tq - (kt * 64 + kb * 16 + fq * 4 + r);
            const float dec = d > 0 ? ex2((float)d * lgf) : (d < 0 ? ex2((float)(-d) * lgb) : 2.f);
            s[kb][qb][r] *= dec;
          }
      }
#pragma unroll
      for (int g = 0; g < 2; ++g) {
        u32x4 w; w.x = pk2(s[2 * g][qb][0], s[2 * g][qb][1]); w.y = pk2(s[2 * g][qb][2], s[2 * g][qb][3]);
        w.z = pk2(s[2 * g + 1][qb][0], s[2 * g + 1][qb][1]); w.w = pk2(s[2 * g + 1][qb][2], s[2 * g + 1][qb][3]);
        pf[qb][g] = as_bf8(w);
      }
    }
#pragma unroll
    for (int vb = 0; vb < NVB; ++vb)
#pragma unroll
      for (int g = 0; g < 2; ++g) {
        const bf16x8 vf = *(const bf16x8*)(cur + KOFF + g * PV + vb * 1024 + foff);
        o[vb][0] = mfma16(vf, pf[0][g], o[vb][0]); o[vb][1] = mfma16(vf, pf[1][g], o[vb][1]);
      }
    __builtin_amdgcn_sched_barrier(0);
    if (more) lstore(lds + ((kt + 1) & 1) * BUF);
    asm volatile("s_waitcnt vmcnt(0)" ::: "memory");
    __syncthreads();
  }
  bf16_t* G = (bf16_t*)(ws + (MODE == 0 ? O_MZ : O_RZ));
#pragma unroll
  for (int qb = 0; qb < 2; ++qb) {
    const int tok = tok0 + wid * 32 + qb * 16 + fr;
    float mul, sub;
    if (MODE == 0) {
      float lt = lrow[qb]; lt += __shfl_xor(lt, 16); lt += __shfl_xor(lt, 32);
      mul = 1.f / lt; sub = 0.f;
    } else {
      float sm = 0.f;
#pragma unroll
      for (int vb = 0; vb < NVB; ++vb) sm += (o[vb][qb][0] + o[vb][qb][1]) + (o[vb][qb][2] + o[vb][qb][3]);
      sm += __shfl_xor(sm, 16); sm += __shfl_xor(sm, 32);
      const float mu = sm * (1.f / 128.f);
      float vs = 0.f;
#pragma unroll
      for (int vb = 0; vb < NVB; ++vb)
#pragma unroll
        for (int r = 0; r < 4; ++r) { const float dd = o[vb][qb][r] - mu; vs += dd * dd; }
      vs += __shfl_xor(vs, 16); vs += __shfl_xor(vs, 32);
      mul = rsqrtf(vs * (1.f / 128.f) + EPSN); sub = mu;
    }
#pragma unroll
    for (int vb = 0; vb < NVB; ++vb) {
      bf16_t* gp = G + (size_t)tok * 512 + h * (NVB * 16) + vb * 16 + fq * 4;
      const u32x2 gz = *(const u32x2*)gp;
      f32x4 y;
      y[0] = (o[vb][qb][0] - sub) * mul * bflo(gz.x); y[1] = (o[vb][qb][1] - sub) * mul * bfhi(gz.x);
      y[2] = (o[vb][qb][2] - sub) * mul * bflo(gz.y); y[3] = (o[vb][qb][3] - sub) * mul * bfhi(gz.y);
      *(u32x2*)gp = pk4(y);
    }
  }
}

__device__ __forceinline__ bf16x8 scale8(u32x4 raw, const float (&d)[8]) {
  u32x4 w;
  w.x = pk2(bflo(raw.x) * d[0], bfhi(raw.x) * d[1]); w.y = pk2(bflo(raw.y) * d[2], bfhi(raw.y) * d[3]);
  w.z = pk2(bflo(raw.z) * d[4], bfhi(raw.z) * d[5]); w.w = pk2(bflo(raw.w) * d[6], bfhi(raw.w) * d[7]);
  return as_bf8(w);
}
__device__ __forceinline__ void state_item(const Params& p, int l, int item) {
  const int tid = tidx(), lane = tid & 63, wid = tid >> 6, fr = lane & 15, fq = lane >> 4;
  const int b = item >> 2, h = item & 3;
  const bf16_t* RVT = (const bf16_t*)(p.ws + O_RVT) + (size_t)(b * 4 + h) * 128 * 256;
  const bf16_t* RKT = (const bf16_t*)(p.ws + O_RKT) + (size_t)(b * 4 + h) * 64 * 256;
  const float xf = p.ret_logit[(l * 2 + 0) * 4 + h], xb = p.ret_logit[(l * 2 + 1) * 4 + h];
  const float lgf = -log1pf(expf(-xf)) * 1.44269504089f, lgb = -log1pf(expf(-xb)) * 1.44269504089f;
  f32x4 acc[2][2][4];
#pragma unroll
  for (int d = 0; d < 2; ++d)
#pragma unroll
    for (int v = 0; v < 2; ++v)
#pragma unroll
      for (int k = 0; k < 4; ++k) acc[d][v][k] = (f32x4){0.f, 0.f, 0.f, 0.f};
#pragma unroll 2
  for (int ks = 0; ks < 8; ++ks) {
    const int j0 = ks * 32 + fq * 8;
    float df[8], db[8];
#pragma unroll
    for (int e = 0; e < 8; ++e) { df[e] = exp2f((float)(255 - j0 - e) * lgf); db[e] = exp2f((float)(j0 + e) * lgb); }
    bf16x8 af[2];
#pragma unroll
    for (int v = 0; v < 2; ++v) af[v] = *(const bf16x8*)(RVT + (size_t)((wid * 2 + v) * 16 + fr) * 256 + j0);
#pragma unroll
    for (int k = 0; k < 4; ++k) {
      const u32x4 raw = *(const u32x4*)(RKT + (size_t)(k * 16 + fr) * 256 + j0);
      const bf16x8 kf = scale8(raw, df), kb = scale8(raw, db);
#pragma unroll
      for (int v = 0; v < 2; ++v) { acc[0][v][k] = mfma16(af[v], kf, acc[0][v][k]); acc[1][v][k] = mfma16(af[v], kb, acc[1][v][k]); }
    }
  }
  float* O = p.out + OUT_RET;
#pragma unroll
  for (int d = 0; d < 2; ++d)
#pragma unroll
    for (int v = 0; v < 2; ++v)
#pragma unroll
      for (int k = 0; k < 4; ++k) {
        const int dk = k * 16 + fr, vd = (wid * 2 + v) * 16 + fq * 4;
        *(f32x4*)(O + ((size_t)((((b * 2 + l) * 2 + d) * 4 + h) * 64 + dk)) * 128 + vd) = acc[d][v][k];
      }
}

__device__ __forceinline__ void keyprep_item(const Params& p, int l, int item) {
  const int tid = tidx(), lane = tid & 63, wid = tid >> 6;
  char* ws = wsp(p.ws);
  bf16_t* CKVA = (bf16_t*)(ws + O_CKVA);
  bf16_t* KRA = (bf16_t*)(ws + O_KRA);
#pragma unroll
  for (int i = 0; i < 4; ++i) {
    const int R = item * 16 + wid * 4 + i;
    int smp = 0, b, t = 0, tok = 0, ctx = 0, pp = 0;
    if (R < NPR) { tok = R; b = R >> 8; t = R & 255; }
    else { smp = 1; const int s = R - NPR; b = s / 1536; pp = s - b * 1536; if (pp < 512) ctx = 1; else { t = pp - 512; tok = NPR + b * 1024 + t; } }
    if (ctx) {
      const f32x4 v = *(const f32x4*)(p.cache_ckv + ((size_t)((b * 2 + l) * 512 + pp)) * 256 + lane * 4);
      *(u32x2*)(CKVA + (size_t)R * 256 + lane * 4) = pk4(v);
      if (lane < 32) KRA[(size_t)R * 32 + lane] = tobf(p.cache_krope[((size_t)((b * 2 + l) * 512 + pp)) * 32 + lane]);
      continue;
    }
    const f32x4 v = *(const f32x4*)((const float*)(ws + O_KVLAT) + (size_t)tok * 256 + lane * 4);
    float ss = v[0] * v[0] + v[1] * v[1] + v[2] * v[2] + v[3] * v[3];
    ss = wave_sum(ss);
    const float rstd = rsqrtf(ss * (1.f / 256.f) + EPSN);
    const f32x4 g = *(const f32x4*)(p.kv_norm_g + l * 256 + lane * 4);
    f32x4 y;
#pragma unroll
    for (int e = 0; e < 4; ++e) y[e] = v[e] * rstd * g[e];
    *(u32x2*)(CKVA + (size_t)R * 256 + lane * 4) = pk4(y);
    if (!smp) *(f32x4*)(p.out + OUT_CKV + ((size_t)((b * 2 + l) * 256 + t)) * 256 + lane * 4) = y;
    const int d = lane & 31;
    const float x = ((const float*)(ws + O_KR))[(size_t)tok * 32 + d];
    float yk = x;
    if (smp) {
      const float pr = __shfl_xor(x, 8);
      const int hd = d >> 4, i16 = d & 15, f = i16 & 7;
      const float pos = (float)(hd ? (t & 63) : (t >> 6));
      const float ang = pos * exp2f(-(float)f * 1.66096404744f);
      const float cs = __cosf(ang), sn = __sinf(ang);
      yk = i16 < 8 ? x * cs - pr * sn : pr * sn + x * cs;
    } else if (lane < 32) {
      p.out[OUT_KR + ((size_t)((b * 2 + l) * 256 + t)) * 32 + d] = x;
    }
    if (lane < 32) KRA[(size_t)R * 32 + d] = tobf(yk);
  }
}

__device__ __forceinline__ void f1_tile(const Params& p, int tile, char* lds) {
  const int tid = tidx(), lane = tid & 63, wid = tid >> 6, wm = wid >> 1, wn = wid & 1, fr = lane & 15, fq = lane >> 4;
  const int m = tile >> 3, g = (tile >> 1) & 3, nh = tile & 1, m0 = m * 128;
  char* ws = wsp(p.ws);
  f32x4 acc[4][4];
  zero_acc(acc);
  gemm_core<false>((const bf16_t*)(ws + O_FU) + (size_t)m0 * 512 + g * 128, 512, (const bf16_t*)(ws + O_CS) + (size_t)nh * 128 * 128, 128, 128, acc, lds);
  bf16_t* UT = (bf16_t*)(ws + O_UT);
#pragma unroll
  for (int i = 0; i < 4; ++i) {
    const int tok = m0 + wm * 64 + i * 16 + fq * 4;
    size_t base; int T, b, t;
    if (tok < NPR) { b = tok >> 8; t = tok & 255; T = 256; base = 0; } else { const int s = tok - NPR; b = s >> 10; t = s & 1023; T = 1024; base = (size_t)NPR * 1024; }
#pragma unroll
    for (int j = 0; j < 4; ++j) {
      const int k2 = wn * 64 + j * 16 + fr;
      *(u32x2*)(UT + base + ((size_t)(b * 4 + g) * 128 + k2) * (2 * T) + nh * T + t) = pk4(acc[i][j]);
    }
  }
}

__device__ __forceinline__ void qup_tile(const Params& p, int l, int tile, char* lds) {
  const int tid = tidx(), lane = tid & 63, wid = tid >> 6, wm = wid >> 1, wn = wid & 1, fr = lane & 15, fq = lane >> 4;
  const int m = tile % 96, nt = tile / 96, m0 = m * 128, n0 = nt * 128;
  char* ws = wsp(p.ws);
  const bf16_t* QL = (const bf16_t*)(ws + O_QLAT) + (size_t)m0 * 384;
  float rsv;
  {
    const bf16_t* q = QL + (size_t)(wm * 64 + lane) * 384;
    float ss = 0.f;
#pragma unroll 4
    for (int i = 0; i < 48; ++i) {
      const u32x4 w = *(const u32x4*)(q + i * 8);
      ss += bflo(w.x) * bflo(w.x) + bfhi(w.x) * bfhi(w.x) + bflo(w.y) * bflo(w.y) + bfhi(w.y) * bfhi(w.y) + bflo(w.z) * bflo(w.z) + bfhi(w.z) * bfhi(w.z) + bflo(w.w) * bflo(w.w) + bfhi(w.w) * bfhi(w.w);
    }
    rsv = rsqrtf(ss * (1.f / 384.f) + EPSN);
  }
  f32x4 acc[4][4];
  zero_acc(acc);
  gemm_core<true>(QL, 384, (const bf16_t*)(ws + O_WQ) + ((size_t)l * 768 + n0) * 384, 384, 384, acc, lds);
  bf16_t* QB = (bf16_t*)(ws + O_QB);
  const float qscale = 0.10206207261596577f * 1.44269504089f;
#pragma unroll
  for (int i = 0; i < 4; ++i) {
    const int rl = wm * 64 + i * 16 + fr, tok = m0 + rl;
    const float sc = __shfl(rsv, i * 16 + fr) * qscale;
    const int smp = tok >= NPR, t = (tok - NPR) & 1023;
#pragma unroll
    for (int j = 0; j < 4; ++j) {
      const int cb = n0 + wn * 64 + j * 16, within = cb % 96;
      f32x4 v = acc[i][j] * sc;
      if (within >= 64) {
        f32x4 pr;
#pragma unroll
        for (int e = 0; e < 4; ++e) pr[e] = __shfl_xor(v[e], 32);
        if (smp) {
          const float pos = (float)(within >= 80 ? (t & 63) : (t >> 6));
#pragma unroll
          for (int e = 0; e < 4; ++e) {
            const int f = (fq & 1) * 4 + e;
            const float ang = pos * exp2f(-(float)f * 1.66096404744f);
            const float cs = __cosf(ang), sn = __sinf(ang);
            v[e] = fq < 2 ? v[e] * cs - pr[e] * sn : pr[e] * sn + v[e] * cs;
          }
        }
      }
      *(u32x2*)(QB + (size_t)tok * 768 + cb + fq * 4) = pk4(v);
    }
  }
}

__device__ __forceinline__ void kvup_tile(const Params& p, int l, int tile, char* lds) {
  const int tid = tidx(), lane = tid & 63, wid = tid >> 6, wm = wid >> 1, wn = wid & 1, fr = lane & 15, fq = lane >> 4;
  const int m = tile % 112, nt = tile / 112, m0 = m * 128, n0 = nt * 128;
  char* ws = wsp(p.ws);
  const bf16_t* A = (const bf16_t*)(ws + O_CKVA) + (size_t)m0 * 256;
  const bf16_t* B = (const bf16_t*)(ws + O_WKV) + ((size_t)l * 1024 + n0) * 256;
  f32x4 acc[4][4];
  zero_acc(acc);
  if (nt < 4) {
    gemm_core<true>(A, 256, B, 256, 256, acc, lds);
    bf16_t* KB = (bf16_t*)(ws + O_KB);
#pragma unroll
    for (int i = 0; i < 4; ++i) {
      const int R = m0 + wm * 64 + i * 16 + fr;
#pragma unroll
      for (int j = 0; j < 4; ++j) *(u32x2*)(KB + (size_t)R * 512 + n0 + wn * 64 + j * 16 + fq * 4) = pk4(acc[i][j]);
    }
  } else {
    gemm_core<false>(A, 256, B, 256, 256, acc, lds);
    bf16_t* VT = (bf16_t*)(ws + O_VT);
#pragma unroll
    for (int i = 0; i < 4; ++i) {
      const int R = m0 + wm * 64 + i * 16 + fq * 4;
      size_t base; int Tk, b, k;
      if (R < NPR) { b = R >> 8; k = R & 255; Tk = 256; base = 0; } else { const int s = R - NPR; b = s / 1536; k = s - b * 1536; Tk = 1536; base = (size_t)NPR * 512; }
#pragma unroll
      for (int j = 0; j < 4; ++j) {
        const int c = n0 - 512 + wn * 64 + j * 16 + fr, h = c >> 6, vd = c & 63;
        *(u32x2*)(VT + base + ((size_t)(b * 8 + h) * 64 + vd) * Tk + k) = pk4(acc[i][j]);
      }
    }
  }
}

template <int NJ>
__device__ __forceinline__ void f2_tile(const Params& p, int tile, char* lds) {
  const int tid = tidx(), lane = tid & 63, wid = tid >> 6, wm = wid >> 1, wn = wid & 1, fr = lane & 15, fq = lane >> 4;
  char* ws = wsp(p.ws);
  const bf16_t *A, *B; int K, tokb, g, nh = 0; float scale;
  if (NJ == 2) {
    const int b = tile >> 6, mt = (tile >> 1) & 7; g = (tile >> 4) & 3; nh = tile & 1;
    A = (const bf16_t*)(ws + O_D1024) + (size_t)mt * 128 * 2048; K = 2048;
    B = (const bf16_t*)(ws + O_UT) + (size_t)NPR * 1024 + ((size_t)(b * 4 + g) * 128 + nh * 64) * 2048;
    tokb = NPR + b * 1024 + mt * 128; scale = 0.00276213586400995f;
  } else {
    const int b = tile >> 3, mt = tile & 1; g = (tile >> 1) & 3;
    A = (const bf16_t*)(ws + O_D256) + (size_t)mt * 128 * 512; K = 512;
    B = (const bf16_t*)(ws + O_UT) + (size_t)(b * 4 + g) * 128 * 512;
    tokb = b * 256 + mt * 128; scale = 0.0055242717280199f;
  }
  f32x4 acc[4][NJ];
#pragma unroll
  for (int i = 0; i < 4; ++i)
#pragma unroll
    for (int j = 0; j < NJ; ++j) acc[i][j] = (f32x4){0.f, 0.f, 0.f, 0.f};
  gemm_core<true, NJ>(A, K, B, K, K, acc, lds);
  bf16_t* FZ = (bf16_t*)(ws + O_FZ);
#pragma unroll
  for (int i = 0; i < 4; ++i) {
    const int tok = tokb + wm * 64 + i * 16 + fr;
#pragma unroll
    for (int j = 0; j < NJ; ++j) {
      bf16_t* gp = FZ + (size_t)tok * 512 + g * 128 + nh * 64 + wn * (NJ * 16) + j * 16 + fq * 4;
      const u32x2 gz = *(const u32x2*)gp;
      f32x4 y;
      y[0] = acc[i][j][0] * scale * bflo(gz.x); y[1] = acc[i][j][1] * scale * bfhi(gz.x);
      y[2] = acc[i][j][2] * scale * bflo(gz.y); y[3] = acc[i][j][3] * scale * bfhi(gz.y);
      *(u32x2*)gp = pk4(y);
    }
  }
}

__device__ __forceinline__ void s6_tile(const Params& p, int l, int tile, int ntile, char* lds, int& par, bool& primed) {
  const int tid = tidx(), lane = tid & 63, wid = tid >> 6, wm = wid >> 1, wn = wid & 1, fr = lane & 15, fq = lane >> 4;
  const int m = tile % 96, nt = tile / 96, m0 = m * 128, n0 = nt * 64;
  char* ws = wsp(p.ws);
  const bf16_t* Hh = (const bf16_t*)(ws + O_H);
  const bf16_t* Wg = (const bf16_t*)(ws + O_WIN) + ((size_t)l * 6912 + 3840) * 1024;
  const bf16_t* Wb = (const bf16_t*)(ws + O_WBR) + (size_t)(l * 3) * 1024 * 512;
  f32x4 tot[4][2], acc[4][2];
  u32x2 sg[4][2];
#pragma unroll
  for (int i = 0; i < 4; ++i) { tot[i][0] = (f32x4){0.f, 0.f, 0.f, 0.f}; tot[i][1] = (f32x4){0.f, 0.f, 0.f, 0.f}; }
#pragma unroll 1
  for (int nb = 0; nb < 3; ++nb) {
#pragma unroll
    for (int i = 0; i < 4; ++i) { acc[i][0] = (f32x4){0.f, 0.f, 0.f, 0.f}; acc[i][1] = (f32x4){0.f, 0.f, 0.f, 0.f}; }
    const size_t boff = nb == 0 ? O_RZ : (nb == 1 ? O_MZ : O_FZ);
    const bf16_t* brA = (const bf16_t*)(ws + boff) + (size_t)m0 * 512;
    const bf16_t* brB = Wb + ((size_t)nb * 1024 + n0) * 512;
    gemm_core<true, 2>(Hh + (size_t)m0 * 1024, 1024, Wg + ((size_t)nb * 1024 + n0) * 1024, 1024, 1024, acc, lds, par, primed, brA, 512, brB, 512);
#pragma unroll
    for (int i = 0; i < 4; ++i)
#pragma unroll
      for (int j = 0; j < 2; ++j) { f32x4 sv;
#pragma unroll
        for (int e = 0; e < 4; ++e) sv[e] = sigm_f(acc[i][j][e]);
        sg[i][j] = pk4(sv); }
#pragma unroll
    for (int i = 0; i < 4; ++i) { acc[i][0] = (f32x4){0.f, 0.f, 0.f, 0.f}; acc[i][1] = (f32x4){0.f, 0.f, 0.f, 0.f}; }
    const bf16_t *nA = nullptr, *nB = nullptr;
    if (nb < 2) { nA = Hh + (size_t)m0 * 1024; nB = Wg + ((size_t)(nb + 1) * 1024 + n0) * 1024; }
    else if (ntile >= 0) { nA = Hh + (size_t)((ntile % 96) * 128) * 1024; nB = Wg + (size_t)((ntile / 96) * 64) * 1024; }
    gemm_core<true, 2>(brA, 512, brB, 512, 512, acc, lds, par, true, nA, 1024, nB, 1024);
    primed = nA != nullptr;
#pragma unroll
    for (int i = 0; i < 4; ++i)
#pragma unroll
      for (int j = 0; j < 2; ++j) {
        tot[i][j][0] += acc[i][j][0] * bflo(sg[i][j].x); tot[i][j][1] += acc[i][j][1] * bfhi(sg[i][j].x);
        tot[i][j][2] += acc[i][j][2] * bflo(sg[i][j].y); tot[i][j][3] += acc[i][j][3] * bfhi(sg[i][j].y);
      }
  }
  bf16_t* MG = (bf16_t*)(ws + O_UT);
#pragma unroll
  for (int i = 0; i < 4; ++i) {
    const int tok = m0 + wm * 64 + i * 16 + fr;
#pragma unroll
    for (int j = 0; j < 2; ++j) *(u32x2*)(MG + (size_t)tok * 1024 + n0 + wn * 32 + j * 16 + fq * 4) = pk4(tot[i][j]);
  }
}

__device__ __forceinline__ void s7_tile(const Params& p, int l, int tile, const float* xp, const float* xs, char* lds) {
  const int tid = tidx(), lane = tid & 63, wid = tid >> 6, wm = wid >> 1, wn = wid & 1, fr = lane & 15, fq = lane >> 4;
  const int m = tile % 96, nt = tile / 96, m0 = m * 128, n0 = nt * 64;
  char* ws = wsp(p.ws);
  f32x4 acc[4][2];
#pragma unroll
  for (int i = 0; i < 4; ++i) { acc[i][0] = (f32x4){0.f, 0.f, 0.f, 0.f}; acc[i][1] = (f32x4){0.f, 0.f, 0.f, 0.f}; }
  gemm_core<true, 2>((const bf16_t*)(ws + O_UT) + (size_t)m0 * 1024, 1024, (const bf16_t*)(ws + O_WO) + ((size_t)l * 1024 + n0) * 1024, 1024, 1024, acc, lds);
#pragma unroll
  for (int i = 0; i < 4; ++i) {
    const int tok = m0 + wm * 64 + i * 16 + fr;
    const float* src = tok < NPR ? xp + (size_t)tok * 1024 : xs + (size_t)(tok - NPR) * 1024;
    const int v = tok < NPR ? 0 : 1 + ((tok - NPR) >> 10);
    const float* gate = (const float*)(ws + O_MOD) + (l * 5 + v) * 3072 + 2048;
#pragma unroll
    for (int j = 0; j < 2; ++j) {
      const int col = n0 + wn * 32 + j * 16 + fq * 4;
      const f32x4 x = *(const f32x4*)(src + col), gt = *(const f32x4*)(gate + col);
      f32x4 y;
#pragma unroll
      for (int e = 0; e < 4; ++e) y[e] = x[e] + gt[e] * acc[i][j][e];
      *(f32x4*)(p.out + (size_t)tok * 1024 + col) = y;
    }
  }
}

constexpr int NPHASE = 16;
__device__ __forceinline__ int q_issue(unsigned* ctr) {
  int v = 0;
  if (threadIdx.x == 0) v = (int)__hip_atomic_fetch_add(ctr, 1u, __ATOMIC_RELAXED, __HIP_MEMORY_SCOPE_AGENT);
  return v;
}
__device__ __forceinline__ int q_bcast(int v, char* lds) {
  __syncthreads();
  if (threadIdx.x == 0) *(volatile int*)lds = v;
  __syncthreads();
  const int it = *(volatile int*)lds;
  __syncthreads();
  return it;
}
__device__ __forceinline__ void run_phase(const Params& p, int ph, char* lds, unsigned* qctr) {
  const int bid = blockIdx.x, nb = gridDim.x;
  if (ph == 0) { for (int i = bid; i < P0_N; i += nb) phase0_item(p, i, lds); return; }
  if (ph == 15) { for (int i = bid; i < 512; i += nb) final_item(p, i); return; }
  const int l = (ph - 1) / 7, s = (ph - 1) % 7;
  const float* xp = l == 0 ? p.x_prompt : p.out;
  const float* xs = l == 0 ? p.x_sample : p.out + (size_t)NPR * 1024;
  switch (s) {
    case 0: for (int i = bid; i < 512; i += nb) norm_item(p, l, i, xp, xs); break;
    case 1: for (int i = bid; i < 2880; i += nb) s2_tile(p, l, i, lds); break;
    case 2:
      for (int i = q_bcast(q_issue(qctr + ph), lds); i < 2752;) {
        if (i < 128) attn_item<1>(p, l, i, lds);
        else if (i < 1024) keyprep_item(p, l, i - 128);
        else if (i < 1280) attn_item<1>(p, l, 128 + (i - 1024), lds);
        else if (i < 1408) state_item(p, l, i - 1280);
        else if (i < 1984) qup_tile(p, l, i - 1408, lds);
        else f1_tile(p, i - 1984, lds);
        i = q_bcast(q_issue(qctr + ph), lds);
      }
      break;
    case 3:
      for (int i = q_bcast(q_issue(qctr + ph), lds); i < 1408;) {
        if (i < 256) f2_tile<2>(p, i, lds);
        else if (i < 512) f2_tile<4>(p, i - 256, lds);
        else kvup_tile(p, l, i - 512, lds);
        i = q_bcast(q_issue(qctr + ph), lds);
      }
      break;
    case 4:
      for (int i = q_bcast(q_issue(qctr + ph), lds); i < 768;) {
        attn_item<0>(p, l, i, lds);
        i = q_bcast(q_issue(qctr + ph), lds);
      }
      break;
    case 5: { int par = 0; bool primed = false; for (int i = bid; i < 1536; i += nb) s6_tile(p, l, i, (i + nb < 1536) ? i + nb : -1, lds, par, primed); } break;
    case 6: for (int i = bid; i < 1536; i += nb) s7_tile(p, l, i, xp, xs, lds); break;
  }
}

#define XB_TMO      128
#define XB_XCNT(j)  (256  + 64 * (j))
#define XB_XSUB(j)  (1280 + 64 * (j))
#define XB_XGEN(j)  (2304 + 64 * (j))
#define XB_TOP      3328
#define XB_TOPGEN   3392
#define XCD_BAR_WORDS 3456
#define XB_SPIN_CAP (1u << 18)
__device__ __forceinline__ unsigned xb_ld(unsigned* p)              { return __hip_atomic_load(p, __ATOMIC_RELAXED, __HIP_MEMORY_SCOPE_AGENT); }
__device__ __forceinline__ unsigned xb_add(unsigned* p, unsigned v) { return __hip_atomic_fetch_add(p, v, __ATOMIC_RELAXED, __HIP_MEMORY_SCOPE_AGENT); }
__device__ __forceinline__ unsigned xb_xcc_id() { return (unsigned)__builtin_amdgcn_s_getreg((3 << 11) | 20) & 0xFu; }
#define XB_SPIN(cond, bar) do { unsigned _sp = 0; while (cond) { __builtin_amdgcn_s_sleep(1); \
    if ((++_sp & 255u) == 0u) { if (xb_ld(&(bar)[XB_TMO])) break; if (_sp > XB_SPIN_CAP) { atomicAdd(&(bar)[XB_TMO], 1u); break; } } } } while (0)
__device__ __forceinline__ void xcd_barrier_complete(unsigned* bar, unsigned x, unsigned& nloc, unsigned& nx) {
  const unsigned G = gridDim.x;
  unsigned sum, cnt, mine, sp = 0u;
  for (;;) {
    sum = 0u; cnt = 0u; mine = 0u;
#pragma unroll
    for (unsigned j = 0; j < 16; ++j) { const unsigned c = xb_ld(&bar[XB_XCNT(j)]); sum += c; cnt += (c > 0u) ? 1u : 0u; mine = (j == x) ? c : mine; }
    if (sum == G) break;
    __builtin_amdgcn_s_sleep(1);
    if ((++sp & 255u) == 0u) { if (xb_ld(&bar[XB_TMO])) break; if (sp > XB_SPIN_CAP) { atomicAdd(&bar[XB_TMO], 1u); break; } }
  }
  nloc = mine > 0u ? mine : 1u; nx = cnt > 0u ? cnt : 1u;
}
__device__ __forceinline__ void xcd_barrier(unsigned* bar, unsigned x, unsigned& nloc, unsigned& nx) {
  asm volatile("s_waitcnt vmcnt(0)" ::: "memory");
  __syncthreads();
  if (threadIdx.x == 0) {
    __builtin_amdgcn_s_waitcnt(0);
    if (nloc == 0u) xcd_barrier_complete(bar, x, nloc, nx);
    const unsigned old = xb_add(&bar[XB_XSUB(x)], 1u);
    const unsigned gen = old / nloc;
    if (old + 1u == (gen + 1u) * nloc) {
      __builtin_amdgcn_fence(__ATOMIC_RELEASE, "agent");
      asm volatile("s_waitcnt vmcnt(0)" ::: "memory");
      const unsigned og = xb_add(&bar[XB_TOP], 1u);
      const unsigned tg = og / nx;
      if (og + 1u == (tg + 1u) * nx) xb_add(&bar[XB_TOPGEN], 1u);
      else XB_SPIN(xb_ld(&bar[XB_TOPGEN]) == tg, bar);
      __builtin_amdgcn_fence(__ATOMIC_ACQUIRE, "agent");
      xb_add(&bar[XB_XGEN(x)], 1u);
      asm volatile("s_waitcnt vmcnt(0)" ::: "memory");
    } else {
      XB_SPIN(xb_ld(&bar[XB_XGEN(x)]) == gen, bar);
      __builtin_amdgcn_fence(__ATOMIC_ACQUIRE, "agent");
      asm volatile("s_waitcnt vmcnt(0)" ::: "memory");
    }
  }
  __syncthreads();
}

__global__ void __launch_bounds__(256, 2) mk_fwd(Params p) {
  __shared__ __attribute__((aligned(16))) char lds[LDS_TOTAL];
  cg::grid_group grid = cg::this_grid();
  unsigned* bar = (unsigned*)(p.ws + O_BAR);
  const unsigned xcc = xb_xcc_id();
  if (threadIdx.x == 0) (void)xb_add(&bar[XB_XCNT(xcc)], 1u);
  unsigned nloc = 0u, nx = 0u;
  if (gridDim.x == 0x7fffffffu) grid.sync();
#pragma unroll 1
  for (int ph = 0; ph < NPHASE; ++ph) {
    run_phase(p, ph, lds, bar);
    if (ph + 1 < NPHASE) xcd_barrier(bar, xcc, nloc, nx);
  }
}

extern "C" void kernel_launch(void* const* d_in, const int* in_sizes, int n_in, void* d_out, int out_size, void* d_ws, size_t ws_size,
                              hipStream_t stream) {
  Params p{};
  p.x_prompt = (const float*)d_in[0]; p.x_sample = (const float*)d_in[1]; p.cache_ckv = (const float*)d_in[2]; p.cache_krope = (const float*)d_in[3];
  p.state_ret = (const float*)d_in[4]; p.c = (const float*)d_in[5]; p.c_ctx = (const float*)d_in[6]; p.norm_g = (const float*)d_in[7];
  p.w_mod = (const float*)d_in[8]; p.b_mod = (const float*)d_in[9]; p.w_in = (const float*)d_in[10]; p.ret_logit = (const float*)d_in[11];
  p.q_norm_g = (const float*)d_in[12]; p.w_q_up = (const float*)d_in[13]; p.kv_norm_g = (const float*)d_in[14]; p.w_kv_up = (const float*)d_in[15];
  p.w_branch = (const float*)d_in[16]; p.w_out = (const float*)d_in[17]; p.final_g = (const float*)d_in[18];
  p.out = (float*)d_out; p.ws = (char*)d_ws;
#if ONE_LAUNCH
  static int grid_blocks = 0;
  if (!grid_blocks) {
    int dev = 0, cus = 0, per_cu = 0;
    hipGetDevice(&dev);
    hipDeviceGetAttribute(&cus, hipDeviceAttributeMultiprocessorCount, dev);
    hipOccupancyMaxActiveBlocksPerMultiprocessor(&per_cu, mk_fwd, 256, 0);
    if (per_cu > 2) per_cu = 2;
    grid_blocks = cus * per_cu;
  }
  hipMemsetAsync((char*)d_ws + O_BAR, 0, XCD_BAR_WORDS * 4, stream);
  void* args[] = {&p};
  hipError_t e = hipLaunchCooperativeKernel((void*)mk_fwd, dim3(grid_blocks), dim3(256), args, 0, stream);
  if (e != hipSuccess) fprintf(stderr, "cooperative launch failed: %s (grid %d)\n", hipGetErrorString(e), grid_blocks);
#endif
}
```

```cpp
#include <hip/hip_runtime.h>
#include <hip/hip_cooperative_groups.h>
#include <stdint.h>
#include <stdio.h>
namespace cg = cooperative_groups;

#ifndef ONE_LAUNCH
#define ONE_LAUNCH 1
#endif

typedef unsigned short bf16_t;
typedef short bf16x8 __attribute__((ext_vector_type(8)));
typedef float f32x4 __attribute__((ext_vector_type(4)));
typedef unsigned u32x4 __attribute__((ext_vector_type(4)));
typedef unsigned u32x2 __attribute__((ext_vector_type(2)));

constexpr int NTOK = 12288, NPR = 8192, NKEY = 14336;
constexpr float EPSN = 1e-6f;

constexpr size_t O_WIN   = 0;
constexpr size_t O_WQ    = O_WIN   + (size_t)2 * 6912 * 1024 * 2;
constexpr size_t O_WKV   = O_WQ    + (size_t)2 * 768 * 384 * 2;
constexpr size_t O_WBR   = O_WKV   + (size_t)2 * 1024 * 256 * 2;
constexpr size_t O_WO    = O_WBR   + (size_t)6 * 1024 * 512 * 2;
constexpr size_t O_CS    = O_WO    + (size_t)2 * 1024 * 1024 * 2;
constexpr size_t O_D256  = O_CS    + (size_t)256 * 128 * 2;
constexpr size_t O_D1024 = O_D256  + (size_t)256 * 512 * 2;
constexpr size_t O_S0T   = O_D1024 + (size_t)1024 * 2048 * 2;
constexpr size_t O_MOD   = O_S0T   + (size_t)64 * 128 * 64 * 2;
constexpr size_t O_H     = O_MOD   + (size_t)2 * 5 * 3072 * 4;
constexpr size_t O_UT    = O_H     + (size_t)NTOK * 1024 * 2;
constexpr size_t O_RQ    = O_UT    + (size_t)NTOK * 1024 * 2;
constexpr size_t O_RK    = O_RQ    + (size_t)NTOK * 256 * 2;
constexpr size_t O_RKT   = O_RK    + (size_t)NTOK * 256 * 2;
constexpr size_t O_RVT   = O_RKT   + (size_t)NPR * 256 * 2;
constexpr size_t O_KVLAT = O_RVT   + (size_t)NTOK * 512 * 2;
constexpr size_t O_KR    = O_KVLAT + (size_t)NTOK * 256 * 4;
constexpr size_t O_R2END = O_KR    + (size_t)NTOK * 32 * 4;
constexpr size_t O_VT    = O_RQ;
static_assert(O_VT + (size_t)NKEY * 512 * 2 <= O_R2END, "alias overflow");
constexpr size_t O_RZ    = O_R2END;
constexpr size_t O_MZ    = O_RZ    + (size_t)NTOK * 512 * 2;
constexpr size_t O_FZ    = O_MZ    + (size_t)NTOK * 512 * 2;
constexpr size_t O_FU    = O_FZ    + (size_t)NTOK * 512 * 2;
constexpr size_t O_QLAT  = O_FU    + (size_t)NTOK * 512 * 2;
constexpr size_t O_CKVA  = O_QLAT  + (size_t)NTOK * 384 * 2;
constexpr size_t O_KB    = O_CKVA  + (size_t)NKEY * 256 * 2;
constexpr size_t O_KRA   = O_KB    + (size_t)NKEY * 512 * 2;
constexpr size_t O_QB    = O_KRA   + (size_t)NKEY * 32 * 2;
constexpr size_t O_END   = O_QB    + (size_t)NTOK * 768 * 2;
constexpr size_t O_BAR   = (O_END + 255) & ~(size_t)255;
static_assert(O_BAR + 16384 <= (size_t)256 * 1024 * 1024, "workspace too large");

constexpr size_t OUT_CKV = (size_t)NTOK * 1024;
constexpr size_t OUT_KR  = OUT_CKV + (size_t)32 * 2 * 256 * 256;
constexpr size_t OUT_RET = OUT_KR + (size_t)32 * 2 * 256 * 32;

struct Params {
  const float *x_prompt, *x_sample, *cache_ckv, *cache_krope, *state_ret, *c, *c_ctx, *norm_g, *w_mod, *b_mod,
      *w_in, *ret_logit, *q_norm_g, *w_q_up, *kv_norm_g, *w_kv_up, *w_branch, *w_out, *final_g;
  float* out;
  char* ws;
};

constexpr int PANEL = 128 * 64;
constexpr int ABYTES = 2 * PANEL;
constexpr int STAGE = 2 * ABYTES;
constexpr int LDS_GEMM = 2 * STAGE;
constexpr int LDS_TOTAL = LDS_GEMM;
static_assert(LDS_TOTAL <= 65536, "static LDS");

typedef float f32x2 __attribute__((ext_vector_type(2)));
typedef __bf16 bf16x2v __attribute__((ext_vector_type(2)));
__device__ __forceinline__ unsigned pk2(float lo, float hi) { const f32x2 v = {lo, hi}; return __builtin_bit_cast(unsigned, __builtin_convertvector(v, bf16x2v)); }
__device__ __forceinline__ bf16_t tobf(float x) { return (bf16_t)(pk2(x, 0.f) & 0xffffu); }
__device__ __forceinline__ float bflo(unsigned u) { return __uint_as_float(u << 16); }
__device__ __forceinline__ float bfhi(unsigned u) { return __uint_as_float(u & 0xffff0000u); }
__device__ __forceinline__ float ex2(float x) { return __builtin_amdgcn_exp2f(x); }
__device__ __forceinline__ float silu_f(float x) { return x / (1.f + __expf(-x)); }
__device__ __forceinline__ float sigm_f(float x) { return 1.f / (1.f + __expf(-x)); }
__device__ __forceinline__ u32x2 pk4(f32x4 v) { u32x2 r; r.x = pk2(v[0], v[1]); r.y = pk2(v[2], v[3]); return r; }
#define GAS __attribute__((address_space(1)))
#define LAS __attribute__((address_space(3)))
__device__ __forceinline__ u32x4 ldg16(const void* p) { return *(const GAS u32x4*)p; }
__device__ __forceinline__ int tidx() { int t = threadIdx.x; asm volatile("" : "+v"(t)); return t; }
__device__ __forceinline__ char* wsp(const char* w) { unsigned long long v = (unsigned long long)w; asm volatile("" : "+s"(v)); return (char*)v; }
__device__ __forceinline__ int swz(int r) { return (0 - ((r >> 2) & 3)) & 3; }
__device__ __forceinline__ float wave_sum(float v) {
#pragma unroll
  for (int o = 1; o < 64; o <<= 1) v += __shfl_xor(v, o);
  return v;
}
__device__ __forceinline__ f32x4 mfma16(bf16x8 a, bf16x8 b, f32x4 c) { return __builtin_amdgcn_mfma_f32_16x16x32_bf16(a, b, c, 0, 0, 0); }
__device__ __forceinline__ bf16x8 as_bf8(u32x4 v) { return __builtin_bit_cast(bf16x8, v); }

__device__ __forceinline__ void zero_acc(f32x4 (&acc)[4][4]) {
#pragma unroll
  for (int i = 0; i < 4; ++i)
#pragma unroll
    for (int j = 0; j < 4; ++j) acc[i][j] = (f32x4){0.f, 0.f, 0.f, 0.f};
}

template <bool SWAP, int NJ = 4>
__device__ __forceinline__ void gemm_core(const bf16_t* __restrict__ A, int lda, const bf16_t* __restrict__ B, int ldb, int K,
                                          f32x4 (&acc)[4][NJ], char* lds, int& par, bool primed,
                                          const bf16_t* nA, int nlda, const bf16_t* nB, int nldb) {
  const int tid = tidx(), lane = tid & 63, wm = (tid >> 6) >> 1, wn = (tid >> 6) & 1;
  const int wid = __builtin_amdgcn_readfirstlane(tid >> 6);
  const int fr = lane & 15, fq = lane >> 4;
  const int fa = (wm * 64 + fr) * 64 + ((fq ^ swz(fr)) << 4);
  const int fb = ABYTES + (wn * NJ * 16 + fr) * 64 + ((fq ^ swz(fr)) << 4);
  const int lrow = lane >> 2, lchunk = (lane & 3) ^ swz(lrow);
  constexpr int NBL = NJ / 2;
  const GAS char* gA = (const GAS char*)(A + (size_t)(wid * 32 + lrow) * lda + lchunk * 8);
  const GAS char* gB = (const GAS char*)(B + (size_t)(wid * NBL * 16 + lrow) * ldb + lchunk * 8);
  const size_t a16 = (size_t)16 * lda * 2, b16 = (size_t)16 * ldb * 2;
  LAS char* ldsA = (LAS char*)lds + wid * 2048;
  LAS char* ldsB = (LAS char*)lds + ABYTES + wid * NBL * 1024;
  const int nk = K >> 6;
#define GC_ISSUE(pa, pb, sa, sb, stage, kbyte) do { \
    _Pragma("unroll") for (int g = 0; g < 2; ++g) _Pragma("unroll") for (int pn = 0; pn < 2; ++pn) \
      __builtin_amdgcn_global_load_lds((const GAS unsigned*)((pa) + g * (sa) + (kbyte) + pn * 64), (LAS unsigned*)(ldsA + (stage) + pn * PANEL + g * 1024), 16, 0, 0); \
    _Pragma("unroll") for (int g = 0; g < NBL; ++g) _Pragma("unroll") for (int pn = 0; pn < 2; ++pn) \
      __builtin_amdgcn_global_load_lds((const GAS unsigned*)((pb) + g * (sb) + (kbyte) + pn * 64), (LAS unsigned*)(ldsB + (stage) + pn * PANEL + g * 1024), 16, 0, 0); \
  } while (0)
  if (!primed) {
    GC_ISSUE(gA, gB, a16, b16, par * STAGE, 0);
    asm volatile("s_waitcnt vmcnt(0)" ::: "memory");
    __syncthreads();
  }
  for (int kt = 0; kt < nk; ++kt) {
    char* cur = lds + par * STAGE;
    if (kt + 1 < nk) GC_ISSUE(gA, gB, a16, b16, (par ^ 1) * STAGE, (size_t)(kt + 1) * 128);
    else if (nA) {
      const GAS char* hA = (const GAS char*)(nA + (size_t)(wid * 32 + lrow) * nlda + lchunk * 8);
      const GAS char* hB = (const GAS char*)(nB + (size_t)(wid * NBL * 16 + lrow) * nldb + lchunk * 8);
      GC_ISSUE(hA, hB, (size_t)16 * nlda * 2, (size_t)16 * nldb * 2, (par ^ 1) * STAGE, 0);
    }
    __builtin_amdgcn_sched_barrier(0);
#pragma unroll
    for (int ks = 0; ks < 2; ++ks) {
      bf16x8 af[4], bfr[NJ];
#pragma unroll
      for (int i = 0; i < 4; ++i) af[i] = *(const bf16x8*)(cur + ks * PANEL + fa + i * 1024);
#pragma unroll
      for (int j = 0; j < NJ; ++j) bfr[j] = *(const bf16x8*)(cur + ks * PANEL + fb + j * 1024);
#pragma unroll
      for (int i = 0; i < 4; ++i)
#pragma unroll
        for (int j = 0; j < NJ; ++j) acc[i][j] = SWAP ? mfma16(bfr[j], af[i], acc[i][j]) : mfma16(af[i], bfr[j], acc[i][j]);
    }
    __builtin_amdgcn_sched_barrier(0);
    asm volatile("s_waitcnt vmcnt(0)" ::: "memory");
    __syncthreads();
    par ^= 1;
  }
#undef GC_ISSUE
}
template <bool SWAP, int NJ = 4>
__device__ __forceinline__ void gemm_core(const bf16_t* __restrict__ A, int lda, const bf16_t* __restrict__ B, int ldb, int K,
                                          f32x4 (&acc)[4][NJ], char* lds) {
  int par = 0;
  gemm_core<SWAP, NJ>(A, lda, B, ldb, K, acc, lds, par, false, nullptr, 0, nullptr, 0);
}

__device__ __forceinline__ void tr_tile(const float* __restrict__ src, int lds_, int k0, int ns0, bf16_t* __restrict__ dst, int ldd, int nd0,
                                        const float* __restrict__ ksc, char* lds) {
  bf16_t* T = (bf16_t*)lds;
  const int tid = tidx();
  __syncthreads();
#pragma unroll
  for (int i = 0; i < 2; ++i) {
    const int kk = (tid >> 3) + 32 * i, nn4 = (tid & 7) * 4;
    const f32x4 v = *(const f32x4*)(src + (size_t)(k0 + kk) * lds_ + ns0 + nn4);
    const float s = ksc ? ksc[k0 + kk] : 1.f;
#pragma unroll
    for (int e = 0; e < 4; ++e) T[(nn4 + e) * 72 + kk] = tobf(v[e] * s);
  }
  __syncthreads();
  const int nn = tid >> 3, kc = (tid & 7) * 8;
  const u32x4 w = *(const u32x4*)(T + nn * 72 + kc);
  *(u32x4*)(dst + (size_t)(nd0 + nn) * ldd + k0 + kc) = w;
}

__device__ __forceinline__ void tr_tile2(const float* __restrict__ src, int lds_, int k0, int ns0, bf16_t* __restrict__ dst, int ldd, int nd0,
                                         const float* __restrict__ ksc, char* lds) {
  bf16_t* T = (bf16_t*)lds;
  const int tid = tidx();
  __syncthreads();
  f32x4 v[4];
#pragma unroll
  for (int i = 0; i < 4; ++i) v[i] = *(const GAS f32x4*)(src + (size_t)(k0 + (tid >> 3) + 32 * i) * lds_ + ns0 + (tid & 7) * 4);
#pragma unroll
  for (int i = 0; i < 4; ++i) {
    const int kk = (tid >> 3) + 32 * i, nn4 = (tid & 7) * 4;
    const float sc = ksc ? ksc[k0 + kk] : 1.f;
#pragma unroll
    for (int e = 0; e < 4; ++e) T[(nn4 + e) * 136 + kk] = tobf(v[i][e] * sc);
  }
  __syncthreads();
  const int nn = tid >> 3, kc = (tid & 7) * 16;
  const u32x4 w0 = *(const u32x4*)(T + nn * 136 + kc), w1 = *(const u32x4*)(T + nn * 136 + kc + 8);
  bf16_t* d = dst + (size_t)(nd0 + nn) * ldd + k0 + kc;
  *(u32x4*)d = w0; *(u32x4*)(d + 8) = w1;
}

constexpr int P0_GEMV = 192, P0_WIN = 3408, P0_WQ = 144, P0_WKV = 128, P0_WBR = 768, P0_WO = 512, P0_S0 = 256, P0_PAD = 96, P0_TAB = 1104;
constexpr int P0_N = P0_GEMV + P0_WIN + P0_WQ + P0_WKV + P0_WBR + P0_WO + P0_S0 + P0_PAD + P0_TAB;

__device__ __forceinline__ void phase0_item(const Params& p, int j, char* lds) {
  const int tid = tidx();
  char* ws = wsp(p.ws);
  if (j < P0_GEMV) {
    const int l = j / 96, cgi = j % 96;
    float* sv = (float*)lds;
    float* red = (float*)(lds + 20480);
    __syncthreads();
    for (int i = tid; i < 5120; i += 256) { const int v = i >> 10, k = i & 1023; const float x = (v == 0) ? p.c_ctx[k] : p.c[(v - 1) * 1024 + k]; sv[i] = silu_f(x); }
    __syncthreads();
    const int c4 = tid & 7, kg = tid >> 3;
    const float* w = p.w_mod + (size_t)l * 1024 * 3072 + cgi * 32 + c4 * 4;
    f32x4 a0 = {0.f, 0.f, 0.f, 0.f}, a1 = a0, a2 = a0, a3 = a0, a4 = a0;
#pragma unroll 8
    for (int k = kg * 32; k < kg * 32 + 32; ++k) {
      const f32x4 wv = *(const GAS f32x4*)(w + (size_t)k * 3072);
      a0 += wv * sv[k]; a1 += wv * sv[1024 + k]; a2 += wv * sv[2048 + k]; a3 += wv * sv[3072 + k]; a4 += wv * sv[4096 + k];
    }
    *(f32x4*)(red + (kg * 5 + 0) * 32 + c4 * 4) = a0; *(f32x4*)(red + (kg * 5 + 1) * 32 + c4 * 4) = a1; *(f32x4*)(red + (kg * 5 + 2) * 32 + c4 * 4) = a2;
    *(f32x4*)(red + (kg * 5 + 3) * 32 + c4 * 4) = a3; *(f32x4*)(red + (kg * 5 + 4) * 32 + c4 * 4) = a4;
    __syncthreads();
    if (tid < 160) {
      const int v = tid >> 5, c2 = tid & 31;
      float sm = p.b_mod[l * 3072 + cgi * 32 + c2];
#pragma unroll 8
      for (int g = 0; g < 32; ++g) sm += red[(g * 5 + v) * 32 + c2];
      ((float*)(ws + O_MOD))[(l * 5 + v) * 3072 + cgi * 32 + c2] = sm;
    }
    return;
  }
  j -= P0_GEMV;
  if (j < P0_WIN) {
    const int l = j / 1704, r = j % 1704, kt = r / 213, nt = r % 213, c0 = nt * 32;
    const int nd0 = c0 < 2176 ? c0 : (c0 < 2208 ? 3712 + (c0 - 2176) : (c0 < 3744 ? c0 - 32 : c0 + 96));
    tr_tile2(p.w_in + (size_t)l * 1024 * 6816, 6816, kt * 128, c0, (bf16_t*)(ws + O_WIN) + (size_t)l * 6912 * 1024, 1024, nd0, nullptr, lds);
    return;
  }
  j -= P0_WIN;
  if (j < P0_WQ) {
    const int l = j / 72, r = j % 72, kt = r / 24, nt = r % 24;
    tr_tile2(p.w_q_up + (size_t)l * 384 * 768, 768, kt * 128, nt * 32, (bf16_t*)(ws + O_WQ) + (size_t)l * 768 * 384, 384, nt * 32, p.q_norm_g + l * 384, lds);
    return;
  }
  j -= P0_WQ;
  if (j < P0_WKV) {
    const int l = j / 64, r = j % 64, kt = r / 32, nt = r % 32, c0 = nt * 32, h = c0 >> 7, e = c0 & 127;
    const int nd0 = e < 64 ? h * 64 + e : 512 + h * 64 + (e - 64);
    tr_tile2(p.w_kv_up + (size_t)l * 256 * 1024, 1024, kt * 128, c0, (bf16_t*)(ws + O_WKV) + (size_t)l * 1024 * 256, 256, nd0, nullptr, lds);
    return;
  }
  j -= P0_WKV;
  if (j < P0_WBR) {
    const int mat = j / 128, r = j % 128, kt = r / 32, nt = r % 32;
    tr_tile2(p.w_branch + (size_t)mat * 512 * 1024, 1024, kt * 128, nt * 32, (bf16_t*)(ws + O_WBR) + (size_t)mat * 1024 * 512, 512, nt * 32, nullptr, lds);
    return;
  }
  j -= P0_WBR;
  if (j < P0_WO) {
    const int l = j / 256, r = j % 256, kt = r / 32, nt = r % 32;
    tr_tile2(p.w_out + (size_t)l * 1024 * 1024, 1024, kt * 128, nt * 32, (bf16_t*)(ws + O_WO) + (size_t)l * 1024 * 1024, 1024, nt * 32, nullptr, lds);
    return;
  }
  j -= P0_WO;
  if (j < P0_S0) {
    const int mat = j >> 2, nt = j & 3;
    tr_tile(p.state_ret + (size_t)mat * 64 * 128, 128, 0, nt * 32, (bf16_t*)(ws + O_S0T) + (size_t)mat * 128 * 64, 64, nt * 32, nullptr, lds);
    return;
  }
  j -= P0_S0;
  if (j < P0_PAD) {
    const int l = j / 48, r = j % 48;
    bf16_t* d = (bf16_t*)(ws + O_WIN) + ((size_t)l * 6912 + 3744) * 1024 + (size_t)r * 2048 + tid * 8;
    *(u32x4*)d = (u32x4){0u, 0u, 0u, 0u};
    return;
  }
  j -= P0_PAD;
  {
    float v[8];
    bf16_t* dst;
    if (j < 16) {
      const int e0 = j * 2048 + tid * 8; dst = (bf16_t*)(ws + O_CS) + e0;
      const int n = e0 >> 7, k = e0 & 127;
#pragma unroll
      for (int e = 0; e < 8; ++e) {
        const float fr = (float)(((n & 127) * (k + e)) & 127) * (1.f / 128.f);
        v[e] = (n < 128) ? __builtin_amdgcn_cosf(fr) : __builtin_amdgcn_sinf(fr);
      }
    } else if (j < 80) {
      const int e0 = (j - 16) * 2048 + tid * 8; dst = (bf16_t*)(ws + O_D256) + e0;
      const int k1 = e0 >> 9, kk = e0 & 511;
#pragma unroll
      for (int e = 0; e < 8; ++e) {
        const int t = (kk + e) & 255;
        const float fr = (float)((k1 * t) & 255) * (1.f / 256.f);
        v[e] = (kk < 256) ? __builtin_amdgcn_cosf(fr) : -__builtin_amdgcn_sinf(fr);
      }
    } else {
      const int e0 = (j - 80) * 2048 + tid * 8; dst = (bf16_t*)(ws + O_D1024) + e0;
      const int k1 = e0 >> 11, kk = e0 & 2047;
#pragma unroll
      for (int e = 0; e < 8; ++e) {
        const int t = (kk + e) & 1023;
        const float fr = (float)((k1 * t) & 1023) * (1.f / 1024.f);
        v[e] = (kk < 1024) ? __builtin_amdgcn_cosf(fr) : -__builtin_amdgcn_sinf(fr);
      }
    }
    u32x4 w; w.x = pk2(v[0], v[1]); w.y = pk2(v[2], v[3]); w.z = pk2(v[4], v[5]); w.w = pk2(v[6], v[7]);
    *(u32x4*)dst = w;
  }
}

__device__ __forceinline__ void norm_item(const Params& p, int l, int item, const float* xp, const float* xs) {
  const int tid = tidx(), lane = tid & 63, wid = tid >> 6;
  bf16_t* H = (bf16_t*)(p.ws + O_H);
#pragma unroll 3
  for (int i = 0; i < 6; ++i) {
    const int row = item * 24 + wid * 6 + i;
    const float* src = row < NPR ? xp + (size_t)row * 1024 : xs + (size_t)(row - NPR) * 1024;
    const int v = row < NPR ? 0 : 1 + ((row - NPR) >> 10);
    const float* mod = (const float*)(p.ws + O_MOD) + (l * 5 + v) * 3072;
    f32x4 x[4]; float ss = 0.f;
#pragma unroll
    for (int q = 0; q < 4; ++q) { x[q] = *(const f32x4*)(src + (q * 64 + lane) * 4); ss += x[q][0] * x[q][0] + x[q][1] * x[q][1] + x[q][2] * x[q][2] + x[q][3] * x[q][3]; }
    ss = wave_sum(ss);
    const float rstd = rsqrtf(ss * (1.f / 1024.f) + EPSN);
#pragma unroll
    for (int q = 0; q < 4; ++q) {
      const int col = (q * 64 + lane) * 4;
      const f32x4 g = *(const f32x4*)(p.norm_g + l * 1024 + col), sc = *(const f32x4*)(mod + 1024 + col), sh = *(const f32x4*)(mod + col);
      f32x4 h;
#pragma unroll
      for (int e = 0; e < 4; ++e) h[e] = x[q][e] * rstd * g[e] * (1.f + sc[e]) + sh[e];
      *(u32x2*)(H + (size_t)row * 1024 + col) = pk4(h);
    }
  }
}
__device__ __forceinline__ void final_item(const Params& p, int item) {
  const int tid = tidx(), lane = tid & 63, wid = tid >> 6;
#pragma unroll 3
  for (int i = 0; i < 6; ++i) {
    const int row = item * 24 + wid * 6 + i;
    float* src = p.out + (size_t)row * 1024;
    f32x4 x[4]; float ss = 0.f;
#pragma unroll
    for (int q = 0; q < 4; ++q) { x[q] = *(const f32x4*)(src + (q * 64 + lane) * 4); ss += x[q][0] * x[q][0] + x[q][1] * x[q][1] + x[q][2] * x[q][2] + x[q][3] * x[q][3]; }
    ss = wave_sum(ss);
    const float rstd = rsqrtf(ss * (1.f / 1024.f) + EPSN);
#pragma unroll
    for (int q = 0; q < 4; ++q) {
      const int col = (q * 64 + lane) * 4;
      const f32x4 g = *(const f32x4*)(p.final_g + col);
      f32x4 y;
#pragma unroll
      for (int e = 0; e < 4; ++e) y[e] = x[q][e] * rstd * g[e];
      *(f32x4*)(src + col) = y;
    }
  }
}

__device__ __forceinline__ void s2_tile(const Params& p, int l, int tile, char* lds) {
  const int tid = tidx(), lane = tid & 63, wid = tid >> 6, wm = wid >> 1, wn = wid & 1, fr = lane & 15, fq = lane >> 4;
  const int m = (tile / 480) * 16 + (tile % 16), nt = (tile % 480) / 16, m0 = m * 128, n0 = nt * 128;
  char* ws = wsp(p.ws);
  const bf16_t* A = (const bf16_t*)(ws + O_H) + (size_t)m0 * 1024;
  const bf16_t* B = (const bf16_t*)(ws + O_WIN) + ((size_t)l * 6912 + n0) * 1024;
  f32x4 acc[4][4];
  zero_acc(acc);
  if (nt >= 4 && nt < 8) {
    gemm_core<false>(A, 1024, B, 1024, 1024, acc, lds);
    bf16_t* RVT = (bf16_t*)(ws + O_RVT);
#pragma unroll
    for (int i = 0; i < 4; ++i) {
      const int tok = m0 + wm * 64 + i * 16 + fq * 4;
      size_t base; int T, b, t;
      if (tok < NPR) { b = tok >> 8; t = tok & 255; T = 256; base = 0; } else { const int s = tok - NPR; b = s >> 10; t = s & 1023; T = 1024; base = (size_t)NPR * 512; }
#pragma unroll
      for (int j = 0; j < 4; ++j) {
        const int c = n0 - 512 + wn * 64 + j * 16 + fr, h = c >> 7, vd = c & 127;
        *(u32x2*)(RVT + base + ((size_t)(b * 4 + h) * 128 + vd) * T + t) = pk4(acc[i][j]);
      }
    }
    return;
  }
  gemm_core<true>(A, 1024, B, 1024, 1024, acc, lds);
  bf16_t* dst = nullptr; int ld = 0, c0 = 0, op = 0;
  if (nt < 2) { dst = (bf16_t*)(ws + O_RQ); ld = 256; c0 = 0; }
  else if (nt < 4) { dst = (bf16_t*)(ws + O_RK); ld = 256; c0 = 256; op = 2; }
  else if (nt < 12) { dst = (bf16_t*)(ws + O_RZ); ld = 512; c0 = 1024; op = 1; }
  else if (nt < 15) { dst = (bf16_t*)(ws + O_QLAT); ld = 384; c0 = 1536; }
  else if (nt < 17) { ld = 256; c0 = 1920; op = 3; }
  else if (nt < 21) { dst = (bf16_t*)(ws + O_MZ); ld = 512; c0 = 2176; op = 1; }
  else if (nt < 25) { dst = (bf16_t*)(ws + O_FU); ld = 512; c0 = 2688; }
  else if (nt < 29) { dst = (bf16_t*)(ws + O_FZ); ld = 512; c0 = 3200; op = 1; }
  else { ld = 32; c0 = 3712; op = 4; }
#pragma unroll
  for (int i = 0; i < 4; ++i) {
    const int tok = m0 + wm * 64 + i * 16 + fr;
#pragma unroll
    for (int j = 0; j < 4; ++j) {
      const int col = n0 - c0 + wn * 64 + j * 16 + fq * 4;
      f32x4 v = acc[i][j];
      if (op == 3) { *(f32x4*)((float*)(ws + O_KVLAT) + (size_t)tok * 256 + col) = v; continue; }
      if (op == 4) { if (col < 32) *(f32x4*)((float*)(ws + O_KR) + (size_t)tok * 32 + col) = v; continue; }
      if (op == 1) {
#pragma unroll
        for (int e = 0; e < 4; ++e) v[e] = silu_f(v[e]);
      } else if (op == 2) {
#pragma unroll
        for (int e = 0; e < 4; ++e) v[e] *= 0.125f;
      }
      const u32x2 w = pk4(v);
      *(u32x2*)(dst + (size_t)tok * ld + col) = w;
      if (op == 2 && tok < NPR) {
        bf16_t* RKT = (bf16_t*)(ws + O_RKT);
        const int b = tok >> 8, t = tok & 255, h = col >> 6, dk = col & 63;
        bf16_t* q = RKT + ((size_t)(b * 4 + h) * 64 + dk) * 256 + t;
        q[0] = (bf16_t)(w.x & 0xffffu); q[256] = (bf16_t)(w.x >> 16); q[512] = (bf16_t)(w.y & 0xffffu); q[768] = (bf16_t)(w.y >> 16);
      }
    }
  }
}

template <int MODE>
__device__ __forceinline__ void attn_item(const Params& p, int l, int item, char* lds) {
  constexpr int NKP = MODE == 0 ? 3 : 2;
  constexpr int NVB = MODE == 0 ? 4 : 8;
  constexpr int PV = NVB * 16 * 64;
  constexpr int KOFF = NKP * 4096;
  constexpr int BUF = KOFF + 2 * PV;
  const int tid = tidx(), lane = tid & 63, wid = tid >> 6, fr = lane & 15, fq = lane >> 4;
  char* ws = wsp(p.ws);
  int smp, b, h, qblk, T, Tk, tok0;
  const bf16_t *kbase, *rbase = nullptr, *vbase, *qbase;
  int kstride, qstride;
  if (MODE == 0) {
    if (item < 256) { smp = 1; b = item >> 6; h = (item >> 3) & 7; qblk = item & 7; T = 1024; Tk = 1536; tok0 = NPR + b * 1024 + qblk * 128; }
    else { const int it = item - 256; smp = 0; b = it >> 4; h = (it >> 1) & 7; qblk = it & 1; T = 256; Tk = 256; tok0 = b * 256 + qblk * 128; }
    const int keyrow0 = smp ? NPR + b * 1536 : b * 256;
    kbase = (const bf16_t*)(ws + O_KB) + (size_t)keyrow0 * 512 + h * 64; kstride = 512;
    rbase = (const bf16_t*)(ws + O_KRA) + (size_t)keyrow0 * 32;
    vbase = (const bf16_t*)(ws + O_VT) + (smp ? (size_t)NPR * 512 + (size_t)(b * 8 + h) * 64 * 1536 : (size_t)(b * 8 + h) * 64 * 256);
    qbase = (const bf16_t*)(ws + O_QB) + (size_t)tok0 * 768 + h * 96; qstride = 768;
  } else {
    if (item < 128) { smp = 1; b = item >> 5; h = (item >> 3) & 3; qblk = item & 7; T = 1024; tok0 = NPR + b * 1024 + qblk * 128; }
    else { const int it = item - 128; smp = 0; b = it >> 3; h = (it >> 1) & 3; qblk = it & 1; T = 256; tok0 = b * 256 + qblk * 128; }
    Tk = T;
    const int ktok0 = smp ? NPR + b * 1024 : b * 256;
    kbase = (const bf16_t*)(ws + O_RK) + (size_t)ktok0 * 256 + h * 64; kstride = 256;
    vbase = (const bf16_t*)(ws + O_RVT) + (smp ? (size_t)NPR * 512 + (size_t)(b * 4 + h) * 128 * 1024 : (size_t)(b * 4 + h) * 128 * 256);
    qbase = (const bf16_t*)(ws + O_RQ) + (size_t)tok0 * 256 + h * 64; qstride = 256;
  }
  const int nkt = Tk >> 6;
  bf16x8 qf[2][NKP];
#pragma unroll
  for (int qb = 0; qb < 2; ++qb)
#pragma unroll
    for (int ks = 0; ks < NKP; ++ks) qf[qb][ks] = *(const bf16x8*)(qbase + (size_t)(wid * 32 + qb * 16 + fr) * qstride + ks * 32 + fq * 8);
  f32x4 o[NVB][2];
#pragma unroll
  for (int vb = 0; vb < NVB; ++vb) { o[vb][0] = (f32x4){0.f, 0.f, 0.f, 0.f}; o[vb][1] = (f32x4){0.f, 0.f, 0.f, 0.f}; }
  float lgf = 0.f, lgb = 0.f;
  float mrow[2] = {-INFINITY, -INFINITY}, lrow[2] = {0.f, 0.f};
  const int tq0 = qblk * 128 + wid * 32 + fr;
  if (MODE == 1) {
    const float xf = p.ret_logit[(l * 2 + 0) * 4 + h], xb = p.ret_logit[(l * 2 + 1) * 4 + h];
    lgf = -log1pf(expf(-xf)) * 1.44269504089f; lgb = -log1pf(expf(-xb)) * 1.44269504089f;
    if (smp) {
      const bf16_t* s0 = (const bf16_t*)(ws + O_S0T);
#pragma unroll
      for (int dir = 0; dir < 2; ++dir) {
        const bf16_t* sb = s0 + ((size_t)(((b * 2 + l) * 2 + dir) * 4 + h) * 128) * 64;
        float dec[2];
#pragma unroll
        for (int qb = 0; qb < 2; ++qb) { const int tq = tq0 + qb * 16; dec[qb] = dir == 0 ? ex2((float)(tq + 1) * lgf) : ex2((float)(T - tq) * lgb); }
#pragma unroll
        for (int vb = 0; vb < NVB; ++vb) {
          f32x4 t0 = (f32x4){0.f, 0.f, 0.f, 0.f}, t1 = (f32x4){0.f, 0.f, 0.f, 0.f};
#pragma unroll
          for (int ks = 0; ks < 2; ++ks) {
            const bf16x8 sf = *(const bf16x8*)(sb + (size_t)(vb * 16 + fr) * 64 + ks * 32 + fq * 8);
            t0 = mfma16(sf, qf[0][ks], t0); t1 = mfma16(sf, qf[1][ks], t1);
          }
          o[vb][0] += t0 * dec[0]; o[vb][1] += t1 * dec[1];
        }
      }
    }
  }
  u32x4 vreg[NVB / 2];
  const int uw = __builtin_amdgcn_readfirstlane(wid);
  const int dkey = lane >> 2, dchunk = (lane & 3) ^ swz(dkey);
  auto kdma = [&](int kt, char* buf) {
    const GAS bf16_t* kp = (const GAS bf16_t*)kbase + (size_t)(kt * 64 + uw * 16 + dkey) * kstride + dchunk * 8;
#pragma unroll
    for (int pn = 0; pn < 2; ++pn)
      __builtin_amdgcn_global_load_lds((const GAS unsigned*)(kp + pn * 32), (LAS unsigned*)((LAS char*)buf + pn * 4096 + uw * 1024), 16, 0, 0);
    if (MODE == 0) {
      const GAS bf16_t* rp = (const GAS bf16_t*)rbase + (size_t)(kt * 64 + uw * 16 + dkey) * 32 + dchunk * 8;
      __builtin_amdgcn_global_load_lds((const GAS unsigned*)rp, (LAS unsigned*)((LAS char*)buf + 2 * 4096 + uw * 1024), 16, 0, 0);
    }
  };
  auto gload = [&](int kt) {
#pragma unroll
    for (int i = 0; i < NVB / 2; ++i) { const int idx = tid + 256 * i, vd = idx >> 3, g = idx & 7; vreg[i] = ldg16(vbase + (size_t)vd * Tk + kt * 64 + g * 8); }
  };
  auto lstore = [&](char* buf) {
#pragma unroll
    for (int i = 0; i < NVB / 2; ++i) {
      const int idx = tid + 256 * i, vd = idx >> 3, g = idx & 7, pnl = g >> 2, g4 = g & 3, hi = g4 >> 1, q0 = 2 * (g4 & 1);
      char* base = buf + KOFF + pnl * PV + vd * 64 + hi * 8;
      *(u32x2*)(base + ((q0 ^ swz(vd)) << 4)) = (u32x2){vreg[i].x, vreg[i].y};
      *(u32x2*)(base + (((q0 + 1) ^ swz(vd)) << 4)) = (u32x2){vreg[i].z, vreg[i].w};
    }
  };
  __syncthreads();
  kdma(0, lds); gload(0); lstore(lds);
  asm volatile("s_waitcnt vmcnt(0)" ::: "memory");
  __syncthreads();
  const int foff = fr * 64 + ((fq ^ swz(fr)) << 4);
  for (int kt = 0; kt < nkt; ++kt) {
    char* cur = lds + (kt & 1) * BUF;
    const bool more = (kt + 1) < nkt;
    if (more) { kdma(kt + 1, lds + ((kt + 1) & 1) * BUF); gload(kt + 1); }
    __builtin_amdgcn_sched_barrier(0);
    f32x4 s[4][2];
#pragma unroll
    for (int kb = 0; kb < 4; ++kb) {
      s[kb][0] = (f32x4){0.f, 0.f, 0.f, 0.f}; s[kb][1] = (f32x4){0.f, 0.f, 0.f, 0.f};
#pragma unroll
      for (int ks = 0; ks < NKP; ++ks) {
        const bf16x8 kf = *(const bf16x8*)(cur + ks * 4096 + kb * 1024 + foff);
        s[kb][0] = mfma16(kf, qf[0][ks], s[kb][0]); s[kb][1] = mfma16(kf, qf[1][ks], s[kb][1]);
      }
    }
    bf16x8 pf[2][2];
#pragma unroll
    for (int qb = 0; qb < 2; ++qb) {
      if (MODE == 0) {
        float mx = s[0][qb][0];
#pragma unroll
        for (int kb = 0; kb < 4; ++kb)
#pragma unroll
          for (int r = 0; r < 4; ++r) mx = fmaxf(mx, s[kb][qb][r]);
        mx = fmaxf(mx, __shfl_xor(mx, 16)); mx = fmaxf(mx, __shfl_xor(mx, 32));
        const float mn = fmaxf(mrow[qb], mx), alpha = ex2(mrow[qb] - mn);
        mrow[qb] = mn;
        float ls = 0.f;
#pragma unroll
        for (int kb = 0; kb < 4; ++kb)
#pragma unroll
          for (int r = 0; r < 4; ++r) { const float e = ex2(s[kb][qb][r] - mn); s[kb][qb][r] = e; ls += e; }
        lrow[qb] = lrow[qb] * alpha + ls;
#pragma unroll
        for (int vb = 0; vb < NVB; ++vb) o[vb][qb] *= alpha;
      } else {
        const int tq = tq0 + qb * 16;
#pragma unroll
        for (int kb = 0; kb < 4; ++kb)
#pragma unroll
          for (int r = 0; r < 4; ++r) {
            const int d = tq - (kt * 64 + kb * 16 + fq * 4 + r);
            const float dec = d > 0 ? ex2((float)d * lgf) : (d < 0 ? ex2((float)(-d) * lgb) : 2.f);
            s[kb][qb][r] *= dec;
          }
      }
#pragma unroll
      for (int g = 0; g < 2; ++g) {
        u32x4 w; w.x = pk2(s[2 * g][qb][0], s[2 * g][qb][1]); w.y = pk2(s[2 * g][qb][2], s[2 * g][qb][3]);
        w.z = pk2(s[2 * g + 1][qb][0], s[2 * g + 1][qb][1]); w.w = pk2(s[2 * g + 1][qb][2], s[2 * g + 1][qb][3]);
        pf[qb][g] = as_bf8(w);
      }
    }
#pragma unroll
    for (int vb = 0; vb < NVB; ++vb)
#pragma unroll
      for (int g = 0; g < 2; ++g) {
        const bf16x8 vf = *(const bf16x8*)(cur + KOFF + g * PV + vb * 1024 + foff);
        o[vb][0] = mfma16(vf, pf[0][g], o[vb][0]); o[vb][1] = mfma16(vf, pf[1][g], o[vb][1]);
      }
    __builtin_amdgcn_sched_barrier(0);
    if (more) lstore(lds + ((kt + 1) & 1) * BUF);
    asm volatile("s_waitcnt vmcnt(0)" ::: "memory");
    __syncthreads();
  }
  bf16_t* G = (bf16_t*)(ws + (MODE == 0 ? O_MZ : O_RZ));
#pragma unroll
  for (int qb = 0; qb < 2; ++qb) {
    const int tok = tok0 + wid * 32 + qb * 16 + fr;
    float mul, sub;
    if (MODE == 0) {
      float lt = lrow[qb]; lt += __shfl_xor(lt, 16); lt += __shfl_xor(lt, 32);
      mul = 1.f / lt; sub = 0.f;
    } else {
      float sm = 0.f;
#pragma unroll
      for (int vb = 0; vb < NVB; ++vb) sm += (o[vb][qb][0] + o[vb][qb][1]) + (o[vb][qb][2] + o[vb][qb][3]);
      sm += __shfl_xor(sm, 16); sm += __shfl_xor(sm, 32);
      const float mu = sm * (1.f / 128.f);
      float vs = 0.f;
#pragma unroll
      for (int vb = 0; vb < NVB; ++vb)
#pragma unroll
        for (int r = 0; r < 4; ++r) { const float dd = o[vb][qb][r] - mu; vs += dd * dd; }
      vs += __shfl_xor(vs, 16); vs += __shfl_xor(vs, 32);
      mul = rsqrtf(vs * (1.f / 128.f) + EPSN); sub = mu;
    }
#pragma unroll
    for (int vb = 0; vb < NVB; ++vb) {
      bf16_t* gp = G + (size_t)tok * 512 + h * (NVB * 16) + vb * 16 + fq * 4;
      const u32x2 gz = *(const u32x2*)gp;
      f32x4 y;
      y[0] = (o[vb][qb][0] - sub) * mul * bflo(gz.x); y[1] = (o[vb][qb][1] - sub) * mul * bfhi(gz.x);
      y[2] = (o[vb][qb][2] - sub) * mul * bflo(gz.y); y[3] = (o[vb][qb][3] - sub) * mul * bfhi(gz.y);
      *(u32x2*)gp = pk4(y);
    }
  }
}

__device__ __forceinline__ bf16x8 scale8(u32x4 raw, const float (&d)[8]) {
  u32x4 w;
  w.x = pk2(bflo(raw.x) * d[0], bfhi(raw.x) * d[1]); w.y = pk2(bflo(raw.y) * d[2], bfhi(raw.y) * d[3]);
  w.z = pk2(bflo(raw.z) * d[4], bfhi(raw.z) * d[5]); w.w = pk2(bflo(raw.w) * d[6], bfhi(raw.w) * d[7]);
  return as_bf8(w);
}
__device__ __forceinline__ void state_item(const Params& p, int l, int item) {
  const int tid = tidx(), lane = tid & 63, wid = tid >> 6, fr = lane & 15, fq = lane >> 4;
  const int b = item >> 2, h = item & 3;
  const bf16_t* RVT = (const bf16_t*)(p.ws + O_RVT) + (size_t)(b * 4 + h) * 128 * 256;
  const bf16_t* RKT = (const bf16_t*)(p.ws + O_RKT) + (size_t)(b * 4 + h) * 64 * 256;
  const float xf = p.ret_logit[(l * 2 + 0) * 4 + h], xb = p.ret_logit[(l * 2 + 1) * 4 + h];
  const float lgf = -log1pf(expf(-xf)) * 1.44269504089f, lgb = -log1pf(expf(-xb)) * 1.44269504089f;
  f32x4 acc[2][2][4];
#pragma unroll
  for (int d = 0; d < 2; ++d)
#pragma unroll
    for (int v = 0; v < 2; ++v)
#pragma unroll
      for (int k = 0; k < 4; ++k) acc[d][v][k] = (f32x4){0.f, 0.f, 0.f, 0.f};
#pragma unroll 2
  for (int ks = 0; ks < 8; ++ks) {
    const int j0 = ks * 32 + fq * 8;
    float df[8], db[8];
#pragma unroll
    for (int e = 0; e < 8; ++e) { df[e] = exp2f((float)(255 - j0 - e) * lgf); db[e] = exp2f((float)(j0 + e) * lgb); }
    bf16x8 af[2];
#pragma unroll
    for (int v = 0; v < 2; ++v) af[v] = *(const bf16x8*)(RVT + (size_t)((wid * 2 + v) * 16 + fr) * 256 + j0);
#pragma unroll
    for (int k = 0; k < 4; ++k) {
      const u32x4 raw = *(const u32x4*)(RKT + (size_t)(k * 16 + fr) * 256 + j0);
      const bf16x8 kf = scale8(raw, df), kb = scale8(raw, db);
#pragma unroll
      for (int v = 0; v < 2; ++v) { acc[0][v][k] = mfma16(af[v], kf, acc[0][v][k]); acc[1][v][k] = mfma16(af[v], kb, acc[1][v][k]); }
    }
  }
  float* O = p.out + OUT_RET;
#pragma unroll
  for (int d = 0; d < 2; ++d)
#pragma unroll
    for (int v = 0; v < 2; ++v)
#pragma unroll
      for (int k = 0; k < 4; ++k) {
        const int dk = k * 16 + fr, vd = (wid * 2 + v) * 16 + fq * 4;
        *(f32x4*)(O + ((size_t)((((b * 2 + l) * 2 + d) * 4 + h) * 64 + dk)) * 128 + vd) = acc[d][v][k];
      }
}

__device__ __forceinline__ void keyprep_item(const Params& p, int l, int item) {
  const int tid = tidx(), lane = tid & 63, wid = tid >> 6;
  char* ws = wsp(p.ws);
  bf16_t* CKVA = (bf16_t*)(ws + O_CKVA);
  bf16_t* KRA = (bf16_t*)(ws + O_KRA);
#pragma unroll
  for (int i = 0; i < 4; ++i) {
    const int R = item * 16 + wid * 4 + i;
    int smp = 0, b, t = 0, tok = 0, ctx = 0, pp = 0;
    if (R < NPR) { tok = R; b = R >> 8; t = R & 255; }
    else { smp = 1; const int s = R - NPR; b = s / 1536; pp = s - b * 1536; if (pp < 512) ctx = 1; else { t = pp - 512; tok = NPR + b * 1024 + t; } }
    if (ctx) {
      const f32x4 v = *(const f32x4*)(p.cache_ckv + ((size_t)((b * 2 + l) * 512 + pp)) * 256 + lane * 4);
      *(u32x2*)(CKVA + (size_t)R * 256 + lane * 4) = pk4(v);
      if (lane < 32) KRA[(size_t)R * 32 + lane] = tobf(p.cache_krope[((size_t)((b * 2 + l) * 512 + pp)) * 32 + lane]);
      continue;
    }
    const f32x4 v = *(const f32x4*)((const float*)(ws + O_KVLAT) + (size_t)tok * 256 + lane * 4);
    float ss = v[0] * v[0] + v[1] * v[1] + v[2] * v[2] + v[3] * v[3];
    ss = wave_sum(ss);
    const float rstd = rsqrtf(ss * (1.f / 256.f) + EPSN);
    const f32x4 g = *(const f32x4*)(p.kv_norm_g + l * 256 + lane * 4);
    f32x4 y;
#pragma unroll
    for (int e = 0; e < 4; ++e) y[e] = v[e] * rstd * g[e];
    *(u32x2*)(CKVA + (size_t)R * 256 + lane * 4) = pk4(y);
    if (!smp) *(f32x4*)(p.out + OUT_CKV + ((size_t)((b * 2 + l) * 256 + t)) * 256 + lane * 4) = y;
    const int d = lane & 31;
    const float x = ((const float*)(ws + O_KR))[(size_t)tok * 32 + d];
    float yk = x;
    if (smp) {
      const float pr = __shfl_xor(x, 8);
      const int hd = d >> 4, i16 = d & 15, f = i16 & 7;
      const float pos = (float)(hd ? (t & 63) : (t >> 6));
      const float ang = pos * exp2f(-(float)f * 1.66096404744f);
      const float cs = __cosf(ang), sn = __sinf(ang);
      yk = i16 < 8 ? x * cs - pr * sn : pr * sn + x * cs;
    } else if (lane < 32) {
      p.out[OUT_KR + ((size_t)((b * 2 + l) * 256 + t)) * 32 + d] = x;
    }
    if (lane < 32) KRA[(size_t)R * 32 + d] = tobf(yk);
  }
}

__device__ __forceinline__ void f1_tile(const Params& p, int tile, char* lds) {
  const int tid = tidx(), lane = tid & 63, wid = tid >> 6, wm = wid >> 1, wn = wid & 1, fr = lane & 15, fq = lane >> 4;
  const int m = tile >> 3, g = (tile >> 1) & 3, nh = tile & 1, m0 = m * 128;
  char* ws = wsp(p.ws);
  f32x4 acc[4][4];
  zero_acc(acc);
  gemm_core<false>((const bf16_t*)(ws + O_FU) + (size_t)m0 * 512 + g * 128, 512, (const bf16_t*)(ws + O_CS) + (size_t)nh * 128 * 128, 128, 128, acc, lds);
  bf16_t* UT = (bf16_t*)(ws + O_UT);
#pragma unroll
  for (int i = 0; i < 4; ++i) {
    const int tok = m0 + wm * 64 + i * 16 + fq * 4;
    size_t base; int T, b, t;
    if (tok < NPR) { b = tok >> 8; t = tok & 255; T = 256; base = 0; } else { const int s = tok - NPR; b = s >> 10; t = s & 1023; T = 1024; base = (size_t)NPR * 1024; }
#pragma unroll
    for (int j = 0; j < 4; ++j) {
      const int k2 = wn * 64 + j * 16 + fr;
      *(u32x2*)(UT + base + ((size_t)(b * 4 + g) * 128 + k2) * (2 * T) + nh * T + t) = pk4(acc[i][j]);
    }
  }
}

__device__ __forceinline__ void qup_tile(const Params& p, int l, int tile, char* lds) {
  const int tid = tidx(), lane = tid & 63, wid = tid >> 6, wm = wid >> 1, wn = wid & 1, fr = lane & 15, fq = lane >> 4;
  const int m = tile % 96, nt = tile / 96, m0 = m * 128, n0 = nt * 128;
  char* ws = wsp(p.ws);
  const bf16_t* QL = (const bf16_t*)(ws + O_QLAT) + (size_t)m0 * 384;
  float rsv;
  {
    const bf16_t* q = QL + (size_t)(wm * 64 + lane) * 384;
    float ss = 0.f;
#pragma unroll 4
    for (int i = 0; i < 48; ++i) {
      const u32x4 w = *(const u32x4*)(q + i * 8);
      ss += bflo(w.x) * bflo(w.x) + bfhi(w.x) * bfhi(w.x) + bflo(w.y) * bflo(w.y) + bfhi(w.y) * bfhi(w.y) + bflo(w.z) * bflo(w.z) + bfhi(w.z) * bfhi(w.z) + bflo(w.w) * bflo(w.w) + bfhi(w.w) * bfhi(w.w);
    }
    rsv = rsqrtf(ss * (1.f / 384.f) + EPSN);
  }
  f32x4 acc[4][4];
  zero_acc(acc);
  gemm_core<true>(QL, 384, (const bf16_t*)(ws + O_WQ) + ((size_t)l * 768 + n0) * 384, 384, 384, acc, lds);
  bf16_t* QB = (bf16_t*)(ws + O_QB);
  const float qscale = 0.10206207261596577f * 1.44269504089f;
#pragma unroll
  for (int i = 0; i < 4; ++i) {
    const int rl = wm * 64 + i * 16 + fr, tok = m0 + rl;
    const float sc = __shfl(rsv, i * 16 + fr) * qscale;
    const int smp = tok >= NPR, t = (tok - NPR) & 1023;
#pragma unroll
    for (int j = 0; j < 4; ++j) {
      const int cb = n0 + wn * 64 + j * 16, within = cb % 96;
      f32x4 v = acc[i][j] * sc;
      if (within >= 64) {
        f32x4 pr;
#pragma unroll
        for (int e = 0; e < 4; ++e) pr[e] = __shfl_xor(v[e], 32);
        if (smp) {
          const float pos = (float)(within >= 80 ? (t & 63) : (t >> 6));
#pragma unroll
          for (int e = 0; e < 4; ++e) {
            const int f = (fq & 1) * 4 + e;
            const float ang = pos * exp2f(-(float)f * 1.66096404744f);
            const float cs = __cosf(ang), sn = __sinf(ang);
            v[e] = fq < 2 ? v[e] * cs - pr[e] * sn : pr[e] * sn + v[e] * cs;
          }
        }
      }
      *(u32x2*)(QB + (size_t)tok * 768 + cb + fq * 4) = pk4(v);
    }
  }
}

__device__ __forceinline__ void kvup_tile(const Params& p, int l, int tile, char* lds) {
  const int tid = tidx(), lane = tid & 63, wid = tid >> 6, wm = wid >> 1, wn = wid & 1, fr = lane & 15, fq = lane >> 4;
  const int m = tile % 112, nt = tile / 112, m0 = m * 128, n0 = nt * 128;
  char* ws = wsp(p.ws);
  const bf16_t* A = (const bf16_t*)(ws + O_CKVA) + (size_t)m0 * 256;
  const bf16_t* B = (const bf16_t*)(ws + O_WKV) + ((size_t)l * 1024 + n0) * 256;
  f32x4 acc[4][4];
  zero_acc(acc);
  if (nt < 4) {
    gemm_core<true>(A, 256, B, 256, 256, acc, lds);
    bf16_t* KB = (bf16_t*)(ws + O_KB);
#pragma unroll
    for (int i = 0; i < 4; ++i) {
      const int R = m0 + wm * 64 + i * 16 + fr;
#pragma unroll
      for (int j = 0; j < 4; ++j) *(u32x2*)(KB + (size_t)R * 512 + n0 + wn * 64 + j * 16 + fq * 4) = pk4(acc[i][j]);
    }
  } else {
    gemm_core<false>(A, 256, B, 256, 256, acc, lds);
    bf16_t* VT = (bf16_t*)(ws + O_VT);
#pragma unroll
    for (int i = 0; i < 4; ++i) {
      const int R = m0 + wm * 64 + i * 16 + fq * 4;
      size_t base; int Tk, b, k;
      if (R < NPR) { b = R >> 8; k = R & 255; Tk = 256; base = 0; } else { const int s = R - NPR; b = s / 1536; k = s - b * 1536; Tk = 1536; base = (size_t)NPR * 512; }
#pragma unroll
      for (int j = 0; j < 4; ++j) {
        const int c = n0 - 512 + wn * 64 + j * 16 + fr, h = c >> 6, vd = c & 63;
        *(u32x2*)(VT + base + ((size_t)(b * 8 + h) * 64 + vd) * Tk + k) = pk4(acc[i][j]);
      }
    }
  }
}

template <int NJ>
__device__ __forceinline__ void f2_tile(const Params& p, int tile, char* lds) {
  const int tid = tidx(), lane = tid & 63, wid = tid >> 6, wm = wid >> 1, wn = wid & 1, fr = lane & 15, fq = lane >> 4;
  char* ws = wsp(p.ws);
  const bf16_t *A, *B; int K, tokb, g, nh = 0; float scale;
  if (NJ == 2) {
    const int b = tile >> 6, mt = (tile >> 1) & 7; g = (tile >> 4) & 3; nh = tile & 1;
    A = (const bf16_t*)(ws + O_D1024) + (size_t)mt * 128 * 2048; K = 2048;
    B = (const bf16_t*)(ws + O_UT) + (size_t)NPR * 1024 + ((size_t)(b * 4 + g) * 128 + nh * 64) * 2048;
    tokb = NPR + b * 1024 + mt * 128; scale = 0.00276213586400995f;
  } else {
    const int b = tile >> 3, mt = tile & 1; g = (tile >> 1) & 3;
    A = (const bf16_t*)(ws + O_D256) + (size_t)mt * 128 * 512; K = 512;
    B = (const bf16_t*)(ws + O_UT) + (size_t)(b * 4 + g) * 128 * 512;
    tokb = b * 256 + mt * 128; scale = 0.0055242717280199f;
  }
  f32x4 acc[4][NJ];
#pragma unroll
  for (int i = 0; i < 4; ++i)
#pragma unroll
    for (int j = 0; j < NJ; ++j) acc[i][j] = (f32x4){0.f, 0.f, 0.f, 0.f};
  gemm_core<true, NJ>(A, K, B, K, K, acc, lds);
  bf16_t* FZ = (bf16_t*)(ws + O_FZ);
#pragma unroll
  for (int i = 0; i < 4; ++i) {
    const int tok = tokb + wm * 64 + i * 16 + fr;
#pragma unroll
    for (int j = 0; j < NJ; ++j) {
      bf16_t* gp = FZ + (size_t)tok * 512 + g * 128 + nh * 64 + wn * (NJ * 16) + j * 16 + fq * 4;
      const u32x2 gz = *(const u32x2*)gp;
      f32x4 y;
      y[0] = acc[i][j][0] * scale * bflo(gz.x); y[1] = acc[i][j][1] * scale * bfhi(gz.x);
      y[2] = acc[i][j][2] * scale * bflo(gz.y); y[3] = acc[i][j][3] * scale * bfhi(gz.y);
      *(u32x2*)gp = pk4(y);
    }
  }
}

__device__ __forceinline__ void s6_tile(const Params& p, int l, int tile, int ntile, char* lds, int& par, bool& primed) {
  const int tid = tidx(), lane = tid & 63, wid = tid >> 6, wm = wid >> 1, wn = wid & 1, fr = lane & 15, fq = lane >> 4;
  const int m = (tile / 512) * 32 + (tile % 32), nt = (tile % 512) / 32, m0 = m * 128, n0 = nt * 64;
  char* ws = wsp(p.ws);
  const bf16_t* Hh = (const bf16_t*)(ws + O_H);
  const bf16_t* Wg = (const bf16_t*)(ws + O_WIN) + ((size_t)l * 6912 + 3840) * 1024;
  const bf16_t* Wb = (const bf16_t*)(ws + O_WBR) + (size_t)(l * 3) * 1024 * 512;
  f32x4 tot[4][2], acc[4][2];
  u32x2 sg[4][2];
#pragma unroll
  for (int i = 0; i < 4; ++i) { tot[i][0] = (f32x4){0.f, 0.f, 0.f, 0.f}; tot[i][1] = (f32x4){0.f, 0.f, 0.f, 0.f}; }
#pragma unroll 1
  for (int nb = 0; nb < 3; ++nb) {
#pragma unroll
    for (int i = 0; i < 4; ++i) { acc[i][0] = (f32x4){0.f, 0.f, 0.f, 0.f}; acc[i][1] = (f32x4){0.f, 0.f, 0.f, 0.f}; }
    const size_t boff = nb == 0 ? O_RZ : (nb == 1 ? O_MZ : O_FZ);
    const bf16_t* brA = (const bf16_t*)(ws + boff) + (size_t)m0 * 512;
    const bf16_t* brB = Wb + ((size_t)nb * 1024 + n0) * 512;
    gemm_core<true, 2>(Hh + (size_t)m0 * 1024, 1024, Wg + ((size_t)nb * 1024 + n0) * 1024, 1024, 1024, acc, lds, par, primed, brA, 512, brB, 512);
#pragma unroll
    for (int i = 0; i < 4; ++i)
#pragma unroll
      for (int j = 0; j < 2; ++j) { f32x4 sv;
#pragma unroll
        for (int e = 0; e < 4; ++e) sv[e] = sigm_f(acc[i][j][e]);
        sg[i][j] = pk4(sv); }
#pragma unroll
    for (int i = 0; i < 4; ++i) { acc[i][0] = (f32x4){0.f, 0.f, 0.f, 0.f}; acc[i][1] = (f32x4){0.f, 0.f, 0.f, 0.f}; }
    const bf16_t *nA = nullptr, *nB = nullptr;
    if (nb < 2) { nA = Hh + (size_t)m0 * 1024; nB = Wg + ((size_t)(nb + 1) * 1024 + n0) * 1024; }
    else if (ntile >= 0) { nA = Hh + (size_t)(((ntile / 512) * 32 + (ntile % 32)) * 128) * 1024; nB = Wg + (size_t)(((ntile % 512) / 32) * 64) * 1024; }
    gemm_core<true, 2>(brA, 512, brB, 512, 512, acc, lds, par, true, nA, 1024, nB, 1024);
    primed = nA != nullptr;
#pragma unroll
    for (int i = 0; i < 4; ++i)
#pragma unroll
      for (int j = 0; j < 2; ++j) {
        tot[i][j][0] += acc[i][j][0] * bflo(sg[i][j].x); tot[i][j][1] += acc[i][j][1] * bfhi(sg[i][j].x);
        tot[i][j][2] += acc[i][j][2] * bflo(sg[i][j].y); tot[i][j][3] += acc[i][j][3] * bfhi(sg[i][j].y);
      }
  }
  bf16_t* MG = (bf16_t*)(ws + O_UT);
#pragma unroll
  for (int i = 0; i < 4; ++i) {
    const int tok = m0 + wm * 64 + i * 16 + fr;
#pragma unroll
    for (int j = 0; j < 2; ++j) *(u32x2*)(MG + (size_t)tok * 1024 + n0 + wn * 32 + j * 16 + fq * 4) = pk4(tot[i][j]);
  }
}

__device__ __forceinline__ void s7_tile(const Params& p, int l, int tile, const float* xp, const float* xs, char* lds) {
  const int tid = tidx(), lane = tid & 63, wid = tid >> 6, wm = wid >> 1, wn = wid & 1, fr = lane & 15, fq = lane >> 4;
  const int m = (tile / 512) * 32 + (tile % 32), nt = (tile % 512) / 32, m0 = m * 128, n0 = nt * 64;
  char* ws = wsp(p.ws);
  f32x4 acc[4][2];
#pragma unroll
  for (int i = 0; i < 4; ++i) { acc[i][0] = (f32x4){0.f, 0.f, 0.f, 0.f}; acc[i][1] = (f32x4){0.f, 0.f, 0.f, 0.f}; }
  gemm_core<true, 2>((const bf16_t*)(ws + O_UT) + (size_t)m0 * 1024, 1024, (const bf16_t*)(ws + O_WO) + ((size_t)l * 1024 + n0) * 1024, 1024, 1024, acc, lds);
#pragma unroll
  for (int i = 0; i < 4; ++i) {
    const int tok = m0 + wm * 64 + i * 16 + fr;
    const float* src = tok < NPR ? xp + (size_t)tok * 1024 : xs + (size_t)(tok - NPR) * 1024;
    const int v = tok < NPR ? 0 : 1 + ((tok - NPR) >> 10);
    const float* gate = (const float*)(ws + O_MOD) + (l * 5 + v) * 3072 + 2048;
#pragma unroll
    for (int j = 0; j < 2; ++j) {
      const int col = n0 + wn * 32 + j * 16 + fq * 4;
      const f32x4 x = *(const f32x4*)(src + col), gt = *(const f32x4*)(gate + col);
      f32x4 y;
#pragma unroll
      for (int e = 0; e < 4; ++e) y[e] = x[e] + gt[e] * acc[i][j][e];
      *(f32x4*)(p.out + (size_t)tok * 1024 + col) = y;
    }
  }
}

constexpr int NPHASE = 16;
__device__ __forceinline__ int q_issue(unsigned* ctr) {
  int v = 0;
  if (threadIdx.x == 0) v = (int)__hip_atomic_fetch_add(ctr, 1u, __ATOMIC_RELAXED, __HIP_MEMORY_SCOPE_AGENT);
  return v;
}
__device__ __forceinline__ int q_bcast(int v, char* lds) {
  __syncthreads();
  if (threadIdx.x == 0) *(volatile int*)lds = v;
  __syncthreads();
  const int it = *(volatile int*)lds;
  __syncthreads();
  return it;
}
__device__ __forceinline__ void run_phase(const Params& p, int ph, char* lds, unsigned* qctr) {
  const int bid = blockIdx.x, nb = gridDim.x;
  if (ph == 0) { for (int i = bid; i < P0_N; i += nb) phase0_item(p, i, lds); return; }
  if (ph == 15) { for (int i = bid; i < 512; i += nb) final_item(p, i); return; }
  const int l = (ph - 1) / 7, s = (ph - 1) % 7;
  const float* xp = l == 0 ? p.x_prompt : p.out;
  const float* xs = l == 0 ? p.x_sample : p.out + (size_t)NPR * 1024;
  switch (s) {
    case 0: for (int i = bid; i < 512; i += nb) norm_item(p, l, i, xp, xs); break;
    case 1: for (int i = bid; i < 2880; i += nb) s2_tile(p, l, i, lds); break;
    case 2:
      for (int i = q_bcast(q_issue(qctr + ph), lds); i < 2752;) {
        if (i < 128) attn_item<1>(p, l, i, lds);
        else if (i < 1024) keyprep_item(p, l, i - 128);
        else if (i < 1280) attn_item<1>(p, l, 128 + (i - 1024), lds);
        else if (i < 1408) state_item(p, l, i - 1280);
        else if (i < 1984) qup_tile(p, l, i - 1408, lds);
        else f1_tile(p, i - 1984, lds);
        i = q_bcast(q_issue(qctr + ph), lds);
      }
      break;
    case 3:
      for (int i = q_bcast(q_issue(qctr + ph), lds); i < 1408;) {
        if (i < 256) f2_tile<2>(p, i, lds);
        else if (i < 512) f2_tile<4>(p, i - 256, lds);
        else kvup_tile(p, l, i - 512, lds);
        i = q_bcast(q_issue(qctr + ph), lds);
      }
      break;
    case 4:
      for (int i = q_bcast(q_issue(qctr + ph), lds); i < 768;) {
        attn_item<0>(p, l, i, lds);
        i = q_bcast(q_issue(qctr + ph), lds);
      }
      break;
    case 5: { int par = 0; bool primed = false; for (int i = bid; i < 1536; i += nb) s6_tile(p, l, i, (i + nb < 1536) ? i + nb : -1, lds, par, primed); } break;
    case 6: for (int i = bid; i < 1536; i += nb) s7_tile(p, l, i, xp, xs, lds); break;
  }
}

#define XB_TMO      128
#define XB_XCNT(j)  (256  + 64 * (j))
#define XB_XSUB(j)  (1280 + 64 * (j))
#define XB_XGEN(j)  (2304 + 64 * (j))
#define XB_TOP      3328
#define XB_TOPGEN   3392
#define XCD_BAR_WORDS 3456
#define XB_SPIN_CAP (1u << 18)
__device__ __forceinline__ unsigned xb_ld(unsigned* p)              { return __hip_atomic_load(p, __ATOMIC_RELAXED, __HIP_MEMORY_SCOPE_AGENT); }
__device__ __forceinline__ unsigned xb_add(unsigned* p, unsigned v) { return __hip_atomic_fetch_add(p, v, __ATOMIC_RELAXED, __HIP_MEMORY_SCOPE_AGENT); }
__device__ __forceinline__ unsigned xb_xcc_id() { return (unsigned)__builtin_amdgcn_s_getreg((3 << 11) | 20) & 0xFu; }
#define XB_SPIN(cond, bar) do { unsigned _sp = 0; while (cond) { __builtin_amdgcn_s_sleep(1); \
    if ((++_sp & 255u) == 0u) { if (xb_ld(&(bar)[XB_TMO])) break; if (_sp > XB_SPIN_CAP) { atomicAdd(&(bar)[XB_TMO], 1u); break; } } } } while (0)
__device__ __forceinline__ void xcd_barrier_complete(unsigned* bar, unsigned x, unsigned& nloc, unsigned& nx) {
  const unsigned G = gridDim.x;
  unsigned sum, cnt, mine, sp = 0u;
  for (;;) {
    sum = 0u; cnt = 0u; mine = 0u;
#pragma unroll
    for (unsigned j = 0; j < 16; ++j) { const unsigned c = xb_ld(&bar[XB_XCNT(j)]); sum += c; cnt += (c > 0u) ? 1u : 0u; mine = (j == x) ? c : mine; }
    if (sum == G) break;
    __builtin_amdgcn_s_sleep(1);
    if ((++sp & 255u) == 0u) { if (xb_ld(&bar[XB_TMO])) break; if (sp > XB_SPIN_CAP) { atomicAdd(&bar[XB_TMO], 1u); break; } }
  }
  nloc = mine > 0u ? mine : 1u; nx = cnt > 0u ? cnt : 1u;
}
__device__ __forceinline__ void xcd_barrier(unsigned* bar, unsigned x, unsigned& nloc, unsigned& nx) {
  asm volatile("s_waitcnt vmcnt(0)" ::: "memory");
  __syncthreads();
  if (threadIdx.x == 0) {
    __builtin_amdgcn_s_waitcnt(0);
    if (nloc == 0u) xcd_barrier_complete(bar, x, nloc, nx);
    const unsigned old = xb_add(&bar[XB_XSUB(x)], 1u);
    const unsigned gen = old / nloc;
    if (old + 1u == (gen + 1u) * nloc) {
      __builtin_amdgcn_fence(__ATOMIC_RELEASE, "agent");
      asm volatile("s_waitcnt vmcnt(0)" ::: "memory");
      const unsigned og = xb_add(&bar[XB_TOP], 1u);
      const unsigned tg = og / nx;
      if (og + 1u == (tg + 1u) * nx) xb_add(&bar[XB_TOPGEN], 1u);
      else XB_SPIN(xb_ld(&bar[XB_TOPGEN]) == tg, bar);
      __builtin_amdgcn_fence(__ATOMIC_ACQUIRE, "agent");
      xb_add(&bar[XB_XGEN(x)], 1u);
      asm volatile("s_waitcnt vmcnt(0)" ::: "memory");
    } else {
      XB_SPIN(xb_ld(&bar[XB_XGEN(x)]) == gen, bar);
      __builtin_amdgcn_fence(__ATOMIC_ACQUIRE, "agent");
      asm volatile("s_waitcnt vmcnt(0)" ::: "memory");
    }
  }
  __syncthreads();
}

__global__ void __launch_bounds__(256, 2) mk_fwd(Params p) {
  __shared__ __attribute__((aligned(16))) char lds[LDS_TOTAL];
  cg::grid_group grid = cg::this_grid();
  unsigned* bar = (unsigned*)(p.ws + O_BAR);
  const unsigned xcc = xb_xcc_id();
  if (threadIdx.x == 0) (void)xb_add(&bar[XB_XCNT(xcc)], 1u);
  unsigned nloc = 0u, nx = 0u;
  if (gridDim.x == 0x7fffffffu) grid.sync();
#pragma unroll 1
  for (int ph = 0; ph < NPHASE; ++ph) {
    run_phase(p, ph, lds, bar);
    if (ph + 1 < NPHASE) xcd_barrier(bar, xcc, nloc, nx);
  }
}

extern "C" void kernel_launch(void* const* d_in, const int* in_sizes, int n_in, void* d_out, int out_size, void* d_ws, size_t ws_size,
                              hipStream_t stream) {
  Params p{};
  p.x_prompt = (const float*)d_in[0]; p.x_sample = (const float*)d_in[1]; p.cache_ckv = (const float*)d_in[2]; p.cache_krope = (const float*)d_in[3];
  p.state_ret = (const float*)d_in[4]; p.c = (const float*)d_in[5]; p.c_ctx = (const float*)d_in[6]; p.norm_g = (const float*)d_in[7];
  p.w_mod = (const float*)d_in[8]; p.b_mod = (const float*)d_in[9]; p.w_in = (const float*)d_in[10]; p.ret_logit = (const float*)d_in[11];
  p.q_norm_g = (const float*)d_in[12]; p.w_q_up = (const float*)d_in[13]; p.kv_norm_g = (const float*)d_in[14]; p.w_kv_up = (const float*)d_in[15];
  p.w_branch = (const float*)d_in[16]; p.w_out = (const float*)d_in[17]; p.final_g = (const float*)d_in[18];
  p.out = (float*)d_out; p.ws = (char*)d_ws;
#if ONE_LAUNCH
  static int grid_blocks = 0;
  if (!grid_blocks) {
    int dev = 0, cus = 0, per_cu = 0;
    hipGetDevice(&dev);
    hipDeviceGetAttribute(&cus, hipDeviceAttributeMultiprocessorCount, dev);
    hipOccupancyMaxActiveBlocksPerMultiprocessor(&per_cu, mk_fwd, 256, 0);
    if (per_cu > 2) per_cu = 2;
    grid_blocks = cus * per_cu;
  }
  hipMemsetAsync((char*)d_ws + O_BAR, 0, XCD_BAR_WORDS * 4, stream);
  void* args[] = {&p};
  hipError_t e = hipLaunchCooperativeKernel((void*)mk_fwd, dim3(grid_blocks), dim3(256), args, 0, stream);
  if (e != hipSuccess) fprintf(stderr, "cooperative launch failed: %s (grid %d)\n", hipGetErrorString(e), grid_blocks);
#endif
}
```

```cpp
#include <hip/hip_runtime.h>
#include <hip/hip_cooperative_groups.h>
#include <stdint.h>
#include <stdio.h>
namespace cg = cooperative_groups;

#ifndef ONE_LAUNCH
#define ONE_LAUNCH 1
#endif

typedef unsigned short bf16_t;
typedef short bf16x8 __attribute__((ext_vector_type(8)));
typedef float f32x4 __attribute__((ext_vector_type(4)));
typedef unsigned u32x4 __attribute__((ext_vector_type(4)));
typedef unsigned u32x2 __attribute__((ext_vector_type(2)));

constexpr int NTOK = 12288, NPR = 8192, NKEY = 14336;
constexpr float EPSN = 1e-6f;

constexpr size_t O_WIN   = 0;
constexpr size_t O_WQ    = O_WIN   + (size_t)2 * 6912 * 1024 * 2;
constexpr size_t O_WKV   = O_WQ    + (size_t)2 * 768 * 384 * 2;
constexpr size_t O_WBR   = O_WKV   + (size_t)2 * 1024 * 256 * 2;
constexpr size_t O_WO    = O_WBR   + (size_t)6 * 1024 * 512 * 2;
constexpr size_t O_CS    = O_WO    + (size_t)2 * 1024 * 1024 * 2;
constexpr size_t O_D256  = O_CS    + (size_t)256 * 128 * 2;
constexpr size_t O_D1024 = O_D256  + (size_t)256 * 512 * 2;
constexpr size_t O_S0T   = O_D1024 + (size_t)1024 * 2048 * 2;
constexpr size_t O_MOD   = O_S0T   + (size_t)64 * 128 * 64 * 2;
constexpr size_t O_H     = O_MOD   + (size_t)2 * 5 * 3072 * 4;
constexpr size_t O_UT    = O_H     + (size_t)NTOK * 1024 * 2;
constexpr size_t O_RQ    = O_UT    + (size_t)NTOK * 1024 * 2;
constexpr size_t O_RK    = O_RQ    + (size_t)NTOK * 256 * 2;
constexpr size_t O_RKT   = O_RK    + (size_t)NTOK * 256 * 2;
constexpr size_t O_RVT   = O_RKT   + (size_t)NPR * 256 * 2;
constexpr size_t O_KVLAT = O_RVT   + (size_t)NTOK * 512 * 2;
constexpr size_t O_KR    = O_KVLAT + (size_t)NTOK * 256 * 4;
constexpr size_t O_R2END = O_KR    + (size_t)NTOK * 32 * 4;
constexpr size_t O_VT    = O_RQ;
static_assert(O_VT + (size_t)NKEY * 512 * 2 <= O_R2END, "alias overflow");
constexpr size_t O_RZ    = O_R2END;
constexpr size_t O_MZ    = O_RZ    + (size_t)NTOK * 512 * 2;
constexpr size_t O_FZ    = O_MZ    + (size_t)NTOK * 512 * 2;
constexpr size_t O_FU    = O_FZ    + (size_t)NTOK * 512 * 2;
constexpr size_t O_QLAT  = O_FU    + (size_t)NTOK * 512 * 2;
constexpr size_t O_CKVA  = O_QLAT  + (size_t)NTOK * 384 * 2;
constexpr size_t O_KB    = O_CKVA  + (size_t)NKEY * 256 * 2;
constexpr size_t O_KRA   = O_KB    + (size_t)NKEY * 512 * 2;
constexpr size_t O_QB    = O_KRA   + (size_t)NKEY * 32 * 2;
constexpr size_t O_END   = O_QB    + (size_t)NTOK * 768 * 2;
constexpr size_t O_ROPE  = (O_END + 255) & ~(size_t)255;
constexpr size_t O_BAR   = O_ROPE + 4096;
static_assert(O_BAR + 16384 <= (size_t)256 * 1024 * 1024, "workspace too large");

constexpr size_t OUT_CKV = (size_t)NTOK * 1024;
constexpr size_t OUT_KR  = OUT_CKV + (size_t)32 * 2 * 256 * 256;
constexpr size_t OUT_RET = OUT_KR + (size_t)32 * 2 * 256 * 32;

struct Params {
  const float *x_prompt, *x_sample, *cache_ckv, *cache_krope, *state_ret, *c, *c_ctx, *norm_g, *w_mod, *b_mod,
      *w_in, *ret_logit, *q_norm_g, *w_q_up, *kv_norm_g, *w_kv_up, *w_branch, *w_out, *final_g;
  float* out;
  char* ws;
};

constexpr int PANEL = 128 * 64;
constexpr int ABYTES = 2 * PANEL;
constexpr int STAGE = 2 * ABYTES;
constexpr int LDS_GEMM = 2 * STAGE;
constexpr int LDS_TOTAL = LDS_GEMM;
static_assert(LDS_TOTAL <= 65536, "static LDS");

typedef float f32x2 __attribute__((ext_vector_type(2)));
typedef __bf16 bf16x2v __attribute__((ext_vector_type(2)));
__device__ __forceinline__ unsigned pk2(float lo, float hi) { const f32x2 v = {lo, hi}; return __builtin_bit_cast(unsigned, __builtin_convertvector(v, bf16x2v)); }
__device__ __forceinline__ bf16_t tobf(float x) { return (bf16_t)(pk2(x, 0.f) & 0xffffu); }
__device__ __forceinline__ float bflo(unsigned u) { return __uint_as_float(u << 16); }
__device__ __forceinline__ float bfhi(unsigned u) { return __uint_as_float(u & 0xffff0000u); }
__device__ __forceinline__ float ex2(float x) { return __builtin_amdgcn_exp2f(x); }
__device__ __forceinline__ float silu_f(float x) { return x / (1.f + __expf(-x)); }
__device__ __forceinline__ float sigm_f(float x) { return 1.f / (1.f + __expf(-x)); }
__device__ __forceinline__ u32x2 pk4(f32x4 v) { u32x2 r; r.x = pk2(v[0], v[1]); r.y = pk2(v[2], v[3]); return r; }
#define GAS __attribute__((address_space(1)))
#define LAS __attribute__((address_space(3)))
__device__ __forceinline__ u32x4 ldg16(const void* p) { return *(const GAS u32x4*)p; }
__device__ __forceinline__ int tidx() { int t = threadIdx.x; asm volatile("" : "+v"(t)); return t; }
__device__ __forceinline__ char* wsp(const char* w) { unsigned long long v = (unsigned long long)w; asm volatile("" : "+s"(v)); return (char*)v; }
__device__ __forceinline__ int swz(int r) { return (0 - ((r >> 2) & 3)) & 3; }
__device__ __forceinline__ float wave_sum(float v) {
#pragma unroll
  for (int o = 1; o < 64; o <<= 1) v += __shfl_xor(v, o);
  return v;
}
__device__ __forceinline__ f32x4 mfma16(bf16x8 a, bf16x8 b, f32x4 c) { return __builtin_amdgcn_mfma_f32_16x16x32_bf16(a, b, c, 0, 0, 0); }
__device__ __forceinline__ bf16x8 as_bf8(u32x4 v) { return __builtin_bit_cast(bf16x8, v); }

__device__ __forceinline__ void zero_acc(f32x4 (&acc)[4][4]) {
#pragma unroll
  for (int i = 0; i < 4; ++i)
#pragma unroll
    for (int j = 0; j < 4; ++j) acc[i][j] = (f32x4){0.f, 0.f, 0.f, 0.f};
}

template <bool SWAP, int NJ = 4>
__device__ __forceinline__ void gemm_core(const bf16_t* __restrict__ A, int lda, const bf16_t* __restrict__ B, int ldb, int K,
                                          f32x4 (&acc)[4][NJ], char* lds, int& par, bool primed,
                                          const bf16_t* nA, int nlda, const bf16_t* nB, int nldb) {
  const int tid = tidx(), lane = tid & 63, wm = (tid >> 6) >> 1, wn = (tid >> 6) & 1;
  const int wid = __builtin_amdgcn_readfirstlane(tid >> 6);
  const int fr = lane & 15, fq = lane >> 4;
  const int fa = (wm * 64 + fr) * 64 + ((fq ^ swz(fr)) << 4);
  const int fb = ABYTES + (wn * NJ * 16 + fr) * 64 + ((fq ^ swz(fr)) << 4);
  const int lrow = lane >> 2, lchunk = (lane & 3) ^ swz(lrow);
  constexpr int NBL = NJ / 2;
  const GAS char* gA = (const GAS char*)(A + (size_t)(wid * 32 + lrow) * lda + lchunk * 8);
  const GAS char* gB = (const GAS char*)(B + (size_t)(wid * NBL * 16 + lrow) * ldb + lchunk * 8);
  const size_t a16 = (size_t)16 * lda * 2, b16 = (size_t)16 * ldb * 2;
  LAS char* ldsA = (LAS char*)lds + wid * 2048;
  LAS char* ldsB = (LAS char*)lds + ABYTES + wid * NBL * 1024;
  const int nk = K >> 6;
#define GC_ISSUE(pa, pb, sa, sb, stage, kbyte) do { \
    _Pragma("unroll") for (int g = 0; g < 2; ++g) _Pragma("unroll") for (int pn = 0; pn < 2; ++pn) \
      __builtin_amdgcn_global_load_lds((const GAS unsigned*)((pa) + g * (sa) + (kbyte) + pn * 64), (LAS unsigned*)(ldsA + (stage) + pn * PANEL + g * 1024), 16, 0, 0); \
    _Pragma("unroll") for (int g = 0; g < NBL; ++g) _Pragma("unroll") for (int pn = 0; pn < 2; ++pn) \
      __builtin_amdgcn_global_load_lds((const GAS unsigned*)((pb) + g * (sb) + (kbyte) + pn * 64), (LAS unsigned*)(ldsB + (stage) + pn * PANEL + g * 1024), 16, 0, 0); \
  } while (0)
  if (!primed) {
    GC_ISSUE(gA, gB, a16, b16, par * STAGE, 0);
    asm volatile("s_waitcnt vmcnt(0)" ::: "memory");
    __syncthreads();
  }
  for (int kt = 0; kt < nk; ++kt) {
    char* cur = lds + par * STAGE;
    if (kt + 1 < nk) GC_ISSUE(gA, gB, a16, b16, (par ^ 1) * STAGE, (size_t)(kt + 1) * 128);
    else if (nA) {
      const GAS char* hA = (const GAS char*)(nA + (size_t)(wid * 32 + lrow) * nlda + lchunk * 8);
      const GAS char* hB = (const GAS char*)(nB + (size_t)(wid * NBL * 16 + lrow) * nldb + lchunk * 8);
      GC_ISSUE(hA, hB, (size_t)16 * nlda * 2, (size_t)16 * nldb * 2, (par ^ 1) * STAGE, 0);
    }
    __builtin_amdgcn_sched_barrier(0);
#pragma unroll
    for (int ks = 0; ks < 2; ++ks) {
      bf16x8 af[4], bfr[NJ];
#pragma unroll
      for (int i = 0; i < 4; ++i) af[i] = *(const bf16x8*)(cur + ks * PANEL + fa + i * 1024);
#pragma unroll
      for (int j = 0; j < NJ; ++j) bfr[j] = *(const bf16x8*)(cur + ks * PANEL + fb + j * 1024);
#pragma unroll
      for (int i = 0; i < 4; ++i)
#pragma unroll
        for (int j = 0; j < NJ; ++j) acc[i][j] = SWAP ? mfma16(bfr[j], af[i], acc[i][j]) : mfma16(af[i], bfr[j], acc[i][j]);
    }
    __builtin_amdgcn_sched_barrier(0);
    asm volatile("s_waitcnt vmcnt(0)" ::: "memory");
    __syncthreads();
    par ^= 1;
  }
#undef GC_ISSUE
}
template <bool SWAP, int NJ = 4>
__device__ __forceinline__ void gemm_core(const bf16_t* __restrict__ A, int lda, const bf16_t* __restrict__ B, int ldb, int K,
                                          f32x4 (&acc)[4][NJ], char* lds) {
  int par = 0;
  gemm_core<SWAP, NJ>(A, lda, B, ldb, K, acc, lds, par, false, nullptr, 0, nullptr, 0);
}

__device__ __forceinline__ void tr_tile(const float* __restrict__ src, int lds_, int k0, int ns0, bf16_t* __restrict__ dst, int ldd, int nd0,
                                        const float* __restrict__ ksc, char* lds) {
  bf16_t* T = (bf16_t*)lds;
  const int tid = tidx();
  __syncthreads();
#pragma unroll
  for (int i = 0; i < 2; ++i) {
    const int kk = (tid >> 3) + 32 * i, nn4 = (tid & 7) * 4;
    const f32x4 v = *(const f32x4*)(src + (size_t)(k0 + kk) * lds_ + ns0 + nn4);
    const float s = ksc ? ksc[k0 + kk] : 1.f;
#pragma unroll
    for (int e = 0; e < 4; ++e) T[(nn4 + e) * 72 + kk] = tobf(v[e] * s);
  }
  __syncthreads();
  const int nn = tid >> 3, kc = (tid & 7) * 8;
  const u32x4 w = *(const u32x4*)(T + nn * 72 + kc);
  *(u32x4*)(dst + (size_t)(nd0 + nn) * ldd + k0 + kc) = w;
}

__device__ __forceinline__ void tr_tile2(const float* __restrict__ src, int lds_, int k0, int ns0, bf16_t* __restrict__ dst, int ldd, int nd0,
                                         const float* __restrict__ ksc, char* lds) {
  bf16_t* T = (bf16_t*)lds;
  const int tid = tidx();
  __syncthreads();
  f32x4 v[4];
#pragma unroll
  for (int i = 0; i < 4; ++i) v[i] = *(const GAS f32x4*)(src + (size_t)(k0 + (tid >> 3) + 32 * i) * lds_ + ns0 + (tid & 7) * 4);
#pragma unroll
  for (int i = 0; i < 4; ++i) {
    const int kk = (tid >> 3) + 32 * i, nn4 = (tid & 7) * 4;
    const float sc = ksc ? ksc[k0 + kk] : 1.f;
#pragma unroll
    for (int e = 0; e < 4; ++e) T[(nn4 + e) * 136 + kk] = tobf(v[i][e] * sc);
  }
  __syncthreads();
  const int nn = tid >> 3, kc = (tid & 7) * 16;
  const u32x4 w0 = *(const u32x4*)(T + nn * 136 + kc), w1 = *(const u32x4*)(T + nn * 136 + kc + 8);
  bf16_t* d = dst + (size_t)(nd0 + nn) * ldd + k0 + kc;
  *(u32x4*)d = w0; *(u32x4*)(d + 8) = w1;
}

constexpr int P0_GEMV = 192, P0_WIN = 3408, P0_WQ = 144, P0_WKV = 128, P0_WBR = 768, P0_WO = 512, P0_S0 = 256, P0_PAD = 96, P0_TAB = 1105;
constexpr int P0_N = P0_GEMV + P0_WIN + P0_WQ + P0_WKV + P0_WBR + P0_WO + P0_S0 + P0_PAD + P0_TAB;

__device__ __forceinline__ void phase0_item(const Params& p, int j, char* lds) {
  const int tid = tidx();
  char* ws = wsp(p.ws);
  if (j < P0_GEMV) {
    const int l = j / 96, cgi = j % 96;
    float* sv = (float*)lds;
    float* red = (float*)(lds + 20480);
    __syncthreads();
    for (int i = tid; i < 5120; i += 256) { const int v = i >> 10, k = i & 1023; const float x = (v == 0) ? p.c_ctx[k] : p.c[(v - 1) * 1024 + k]; sv[i] = silu_f(x); }
    __syncthreads();
    const int c4 = tid & 7, kg = tid >> 3;
    const float* w = p.w_mod + (size_t)l * 1024 * 3072 + cgi * 32 + c4 * 4;
    f32x4 a0 = {0.f, 0.f, 0.f, 0.f}, a1 = a0, a2 = a0, a3 = a0, a4 = a0;
#pragma unroll 8
    for (int k = kg * 32; k < kg * 32 + 32; ++k) {
      const f32x4 wv = *(const GAS f32x4*)(w + (size_t)k * 3072);
      a0 += wv * sv[k]; a1 += wv * sv[1024 + k]; a2 += wv * sv[2048 + k]; a3 += wv * sv[3072 + k]; a4 += wv * sv[4096 + k];
    }
    *(f32x4*)(red + (kg * 5 + 0) * 32 + c4 * 4) = a0; *(f32x4*)(red + (kg * 5 + 1) * 32 + c4 * 4) = a1; *(f32x4*)(red + (kg * 5 + 2) * 32 + c4 * 4) = a2;
    *(f32x4*)(red + (kg * 5 + 3) * 32 + c4 * 4) = a3; *(f32x4*)(red + (kg * 5 + 4) * 32 + c4 * 4) = a4;
    __syncthreads();
    if (tid < 160) {
      const int v = tid >> 5, c2 = tid & 31;
      float sm = p.b_mod[l * 3072 + cgi * 32 + c2];
#pragma unroll 8
      for (int g = 0; g < 32; ++g) sm += red[(g * 5 + v) * 32 + c2];
      ((float*)(ws + O_MOD))[(l * 5 + v) * 3072 + cgi * 32 + c2] = sm;
    }
    return;
  }
  j -= P0_GEMV;
  if (j < P0_WIN) {
    const int l = j / 1704, r = j % 1704, kt = r / 213, nt = r % 213, c0 = nt * 32;
    const int nd0 = c0 < 2176 ? c0 : (c0 < 2208 ? 3712 + (c0 - 2176) : (c0 < 3744 ? c0 - 32 : c0 + 96));
    tr_tile2(p.w_in + (size_t)l * 1024 * 6816, 6816, kt * 128, c0, (bf16_t*)(ws + O_WIN) + (size_t)l * 6912 * 1024, 1024, nd0, nullptr, lds);
    return;
  }
  j -= P0_WIN;
  if (j < P0_WQ) {
    const int l = j / 72, r = j % 72, kt = r / 24, nt = r % 24;
    tr_tile2(p.w_q_up + (size_t)l * 384 * 768, 768, kt * 128, nt * 32, (bf16_t*)(ws + O_WQ) + (size_t)l * 768 * 384, 384, nt * 32, p.q_norm_g + l * 384, lds);
    return;
  }
  j -= P0_WQ;
  if (j < P0_WKV) {
    const int l = j / 64, r = j % 64, kt = r / 32, nt = r % 32, c0 = nt * 32, h = c0 >> 7, e = c0 & 127;
    const int nd0 = e < 64 ? h * 64 + e : 512 + h * 64 + (e - 64);
    tr_tile2(p.w_kv_up + (size_t)l * 256 * 1024, 1024, kt * 128, c0, (bf16_t*)(ws + O_WKV) + (size_t)l * 1024 * 256, 256, nd0, nullptr, lds);
    return;
  }
  j -= P0_WKV;
  if (j < P0_WBR) {
    const int mat = j / 128, r = j % 128, kt = r / 32, nt = r % 32;
    tr_tile2(p.w_branch + (size_t)mat * 512 * 1024, 1024, kt * 128, nt * 32, (bf16_t*)(ws + O_WBR) + (size_t)mat * 1024 * 512, 512, nt * 32, nullptr, lds);
    return;
  }
  j -= P0_WBR;
  if (j < P0_WO) {
    const int l = j / 256, r = j % 256, kt = r / 32, nt = r % 32;
    tr_tile2(p.w_out + (size_t)l * 1024 * 1024, 1024, kt * 128, nt * 32, (bf16_t*)(ws + O_WO) + (size_t)l * 1024 * 1024, 1024, nt * 32, nullptr, lds);
    return;
  }
  j -= P0_WO;
  if (j < P0_S0) {
    const int mat = j >> 2, nt = j & 3;
    tr_tile(p.state_ret + (size_t)mat * 64 * 128, 128, 0, nt * 32, (bf16_t*)(ws + O_S0T) + (size_t)mat * 128 * 64, 64, nt * 32, nullptr, lds);
    return;
  }
  j -= P0_S0;
  if (j < P0_PAD) {
    const int l = j / 48, r = j % 48;
    bf16_t* d = (bf16_t*)(ws + O_WIN) + ((size_t)l * 6912 + 3744) * 1024 + (size_t)r * 2048 + tid * 8;
    *(u32x4*)d = (u32x4){0u, 0u, 0u, 0u};
    return;
  }
  j -= P0_PAD;
  {
    float v[8];
    bf16_t* dst;
    if (j == 1104) {
      float* rt = (float*)(ws + O_ROPE);
#pragma unroll
      for (int q = 0; q < 2; ++q) {
        const int idx = tid * 2 + q, pos = idx >> 3, f = idx & 7;
        const float ang = (float)pos * exp2f(-(float)f * 1.66096404744f);
        rt[idx * 2] = cosf(ang); rt[idx * 2 + 1] = sinf(ang);
      }
      return;
    }
    if (j < 16) {
      const int e0 = j * 2048 + tid * 8; dst = (bf16_t*)(ws + O_CS) + e0;
      const int n = e0 >> 7, k = e0 & 127;
#pragma unroll
      for (int e = 0; e < 8; ++e) {
        const float fr = (float)(((n & 127) * (k + e)) & 127) * (1.f / 128.f);
        v[e] = (n < 128) ? __builtin_amdgcn_cosf(fr) : __builtin_amdgcn_sinf(fr);
      }
    } else if (j < 80) {
      const int e0 = (j - 16) * 2048 + tid * 8; dst = (bf16_t*)(ws + O_D256) + e0;
      const int k1 = e0 >> 9, kk = e0 & 511;
#pragma unroll
      for (int e = 0; e < 8; ++e) {
        const int t = (kk + e) & 255;
        const float fr = (float)((k1 * t) & 255) * (1.f / 256.f);
        v[e] = (kk < 256) ? __builtin_amdgcn_cosf(fr) : -__builtin_amdgcn_sinf(fr);
      }
    } else {
      const int e0 = (j - 80) * 2048 + tid * 8; dst = (bf16_t*)(ws + O_D1024) + e0;
      const int k1 = e0 >> 11, kk = e0 & 2047;
#pragma unroll
      for (int e = 0; e < 8; ++e) {
        const int t = (kk + e) & 1023;
        const float fr = (float)((k1 * t) & 1023) * (1.f / 1024.f);
        v[e] = (kk < 1024) ? __builtin_amdgcn_cosf(fr) : -__builtin_amdgcn_sinf(fr);
      }
    }
    u32x4 w; w.x = pk2(v[0], v[1]); w.y = pk2(v[2], v[3]); w.z = pk2(v[4], v[5]); w.w = pk2(v[6], v[7]);
    *(u32x4*)dst = w;
  }
}

__device__ __forceinline__ void norm_item(const Params& p, int l, int item, const float* xp, const float* xs) {
  const int tid = tidx(), lane = tid & 63, wid = tid >> 6;
  bf16_t* H = (bf16_t*)(p.ws + O_H);
#pragma unroll 3
  for (int i = 0; i < 6; ++i) {
    const int row = item * 24 + wid * 6 + i;
    const float* src = row < NPR ? xp + (size_t)row * 1024 : xs + (size_t)(row - NPR) * 1024;
    const int v = row < NPR ? 0 : 1 + ((row - NPR) >> 10);
    const float* mod = (const float*)(p.ws + O_MOD) + (l * 5 + v) * 3072;
    f32x4 x[4]; float ss = 0.f;
#pragma unroll
    for (int q = 0; q < 4; ++q) { x[q] = *(const f32x4*)(src + (q * 64 + lane) * 4); ss += x[q][0] * x[q][0] + x[q][1] * x[q][1] + x[q][2] * x[q][2] + x[q][3] * x[q][3]; }
    ss = wave_sum(ss);
    const float rstd = rsqrtf(ss * (1.f / 1024.f) + EPSN);
#pragma unroll
    for (int q = 0; q < 4; ++q) {
      const int col = (q * 64 + lane) * 4;
      const f32x4 g = *(const f32x4*)(p.norm_g + l * 1024 + col), sc = *(const f32x4*)(mod + 1024 + col), sh = *(const f32x4*)(mod + col);
      f32x4 h;
#pragma unroll
      for (int e = 0; e < 4; ++e) h[e] = x[q][e] * rstd * g[e] * (1.f + sc[e]) + sh[e];
      *(u32x2*)(H + (size_t)row * 1024 + col) = pk4(h);
    }
  }
}
__device__ __forceinline__ void final_item(const Params& p, int item) {
  const int tid = tidx(), lane = tid & 63, wid = tid >> 6;
#pragma unroll 3
  for (int i = 0; i < 6; ++i) {
    const int row = item * 24 + wid * 6 + i;
    float* src = p.out + (size_t)row * 1024;
    f32x4 x[4]; float ss = 0.f;
#pragma unroll
    for (int q = 0; q < 4; ++q) { x[q] = *(const f32x4*)(src + (q * 64 + lane) * 4); ss += x[q][0] * x[q][0] + x[q][1] * x[q][1] + x[q][2] * x[q][2] + x[q][3] * x[q][3]; }
    ss = wave_sum(ss);
    const float rstd = rsqrtf(ss * (1.f / 1024.f) + EPSN);
#pragma unroll
    for (int q = 0; q < 4; ++q) {
      const int col = (q * 64 + lane) * 4;
      const f32x4 g = *(const f32x4*)(p.final_g + col);
      f32x4 y;
#pragma unroll
      for (int e = 0; e < 4; ++e) y[e] = x[q][e] * rstd * g[e];
      *(f32x4*)(src + col) = y;
    }
  }
}

__device__ __forceinline__ void s2_tile(const Params& p, int l, int tile, char* lds) {
  const int tid = tidx(), lane = tid & 63, wid = tid >> 6, wm = wid >> 1, wn = wid & 1, fr = lane & 15, fq = lane >> 4;
  const int m = (tile / 480) * 16 + (tile % 16), nt = (tile % 480) / 16, m0 = m * 128, n0 = nt * 128;
  char* ws = wsp(p.ws);
  const bf16_t* A = (const bf16_t*)(ws + O_H) + (size_t)m0 * 1024;
  const bf16_t* B = (const bf16_t*)(ws + O_WIN) + ((size_t)l * 6912 + n0) * 1024;
  f32x4 acc[4][4];
  zero_acc(acc);
  if (nt >= 4 && nt < 8) {
    gemm_core<false>(A, 1024, B, 1024, 1024, acc, lds);
    bf16_t* RVT = (bf16_t*)(ws + O_RVT);
#pragma unroll
    for (int i = 0; i < 4; ++i) {
      const int tok = m0 + wm * 64 + i * 16 + fq * 4;
      size_t base; int T, b, t;
      if (tok < NPR) { b = tok >> 8; t = tok & 255; T = 256; base = 0; } else { const int s = tok - NPR; b = s >> 10; t = s & 1023; T = 1024; base = (size_t)NPR * 512; }
#pragma unroll
      for (int j = 0; j < 4; ++j) {
        const int c = n0 - 512 + wn * 64 + j * 16 + fr, h = c >> 7, vd = c & 127;
        *(u32x2*)(RVT + base + ((size_t)(b * 4 + h) * 128 + vd) * T + t) = pk4(acc[i][j]);
      }
    }
    return;
  }
  gemm_core<true>(A, 1024, B, 1024, 1024, acc, lds);
  bf16_t* dst = nullptr; int ld = 0, c0 = 0, op = 0;
  if (nt < 2) { dst = (bf16_t*)(ws + O_RQ); ld = 256; c0 = 0; }
  else if (nt < 4) { dst = (bf16_t*)(ws + O_RK); ld = 256; c0 = 256; op = 2; }
  else if (nt < 12) { dst = (bf16_t*)(ws + O_RZ); ld = 512; c0 = 1024; op = 1; }
  else if (nt < 15) { dst = (bf16_t*)(ws + O_QLAT); ld = 384; c0 = 1536; }
  else if (nt < 17) { ld = 256; c0 = 1920; op = 3; }
  else if (nt < 21) { dst = (bf16_t*)(ws + O_MZ); ld = 512; c0 = 2176; op = 1; }
  else if (nt < 25) { dst = (bf16_t*)(ws + O_FU); ld = 512; c0 = 2688; }
  else if (nt < 29) { dst = (bf16_t*)(ws + O_FZ); ld = 512; c0 = 3200; op = 1; }
  else { ld = 32; c0 = 3712; op = 4; }
#pragma unroll
  for (int i = 0; i < 4; ++i) {
    const int tok = m0 + wm * 64 + i * 16 + fr;
#pragma unroll
    for (int j = 0; j < 4; ++j) {
      const int col = n0 - c0 + wn * 64 + j * 16 + fq * 4;
      f32x4 v = acc[i][j];
      if (op == 3) { *(f32x4*)((float*)(ws + O_KVLAT) + (size_t)tok * 256 + col) = v; continue; }
      if (op == 4) { if (col < 32) *(f32x4*)((float*)(ws + O_KR) + (size_t)tok * 32 + col) = v; continue; }
      if (op == 1) {
#pragma unroll
        for (int e = 0; e < 4; ++e) v[e] = silu_f(v[e]);
      } else if (op == 2) {
#pragma unroll
        for (int e = 0; e < 4; ++e) v[e] *= 0.125f;
      }
      const u32x2 w = pk4(v);
      *(u32x2*)(dst + (size_t)tok * ld + col) = w;
      if (op == 2 && tok < NPR) {
        bf16_t* RKT = (bf16_t*)(ws + O_RKT);
        const int b = tok >> 8, t = tok & 255, h = col >> 6, dk = col & 63;
        bf16_t* q = RKT + ((size_t)(b * 4 + h) * 64 + dk) * 256 + t;
        q[0] = (bf16_t)(w.x & 0xffffu); q[256] = (bf16_t)(w.x >> 16); q[512] = (bf16_t)(w.y & 0xffffu); q[768] = (bf16_t)(w.y >> 16);
      }
    }
  }
}

template <int MODE>
__device__ __forceinline__ void attn_item(const Params& p, int l, int item, char* lds) {
  constexpr int NKP = MODE == 0 ? 3 : 2;
  constexpr int NVB = MODE == 0 ? 4 : 8;
  constexpr int PV = NVB * 16 * 64;
  constexpr int KOFF = NKP * 4096;
  constexpr int BUF = KOFF + 2 * PV;
  const int tid = tidx(), lane = tid & 63, wid = tid >> 6, fr = lane & 15, fq = lane >> 4;
  char* ws = wsp(p.ws);
  int smp, b, h, qblk, T, Tk, tok0;
  const bf16_t *kbase, *rbase = nullptr, *vbase, *qbase;
  int kstride, qstride;
  if (MODE == 0) {
    if (item < 256) { smp = 1; b = item >> 6; h = (item >> 3) & 7; qblk = item & 7; T = 1024; Tk = 1536; tok0 = NPR + b * 1024 + qblk * 128; }
    else { const int it = item - 256; smp = 0; b = it >> 4; h = (it >> 1) & 7; qblk = it & 1; T = 256; Tk = 256; tok0 = b * 256 + qblk * 128; }
    const int keyrow0 = smp ? NPR + b * 1536 : b * 256;
    kbase = (const bf16_t*)(ws + O_KB) + (size_t)keyrow0 * 512 + h * 64; kstride = 512;
    rbase = (const bf16_t*)(ws + O_KRA) + (size_t)keyrow0 * 32;
    vbase = (const bf16_t*)(ws + O_VT) + (smp ? (size_t)NPR * 512 + (size_t)(b * 8 + h) * 64 * 1536 : (size_t)(b * 8 + h) * 64 * 256);
    qbase = (const bf16_t*)(ws + O_QB) + (size_t)tok0 * 768 + h * 96; qstride = 768;
  } else {
    if (item < 128) { smp = 1; b = item >> 5; h = (item >> 3) & 3; qblk = item & 7; T = 1024; tok0 = NPR + b * 1024 + qblk * 128; }
    else { const int it = item - 128; smp = 0; b = it >> 3; h = (it >> 1) & 3; qblk = it & 1; T = 256; tok0 = b * 256 + qblk * 128; }
    Tk = T;
    const int ktok0 = smp ? NPR + b * 1024 : b * 256;
    kbase = (const bf16_t*)(ws + O_RK) + (size_t)ktok0 * 256 + h * 64; kstride = 256;
    vbase = (const bf16_t*)(ws + O_RVT) + (smp ? (size_t)NPR * 512 + (size_t)(b * 4 + h) * 128 * 1024 : (size_t)(b * 4 + h) * 128 * 256);
    qbase = (const bf16_t*)(ws + O_RQ) + (size_t)tok0 * 256 + h * 64; qstride = 256;
  }
  const int nkt = Tk >> 6;
  bf16x8 qf[2][NKP];
#pragma unroll
  for (int qb = 0; qb < 2; ++qb)
#pragma unroll
    for (int ks = 0; ks < NKP; ++ks) qf[qb][ks] = *(const bf16x8*)(qbase + (size_t)(wid * 32 + qb * 16 + fr) * qstride + ks * 32 + fq * 8);
  f32x4 o[NVB][2];
#pragma unroll
  for (int vb = 0; vb < NVB; ++vb) { o[vb][0] = (f32x4){0.f, 0.f, 0.f, 0.f}; o[vb][1] = (f32x4){0.f, 0.f, 0.f, 0.f}; }
  float lgf = 0.f, lgb = 0.f;
  float mrow[2] = {-INFINITY, -INFINITY}, lrow[2] = {0.f, 0.f};
  const int tq0 = qblk * 128 + wid * 32 + fr;
  if (MODE == 1) {
    const float xf = p.ret_logit[(l * 2 + 0) * 4 + h], xb = p.ret_logit[(l * 2 + 1) * 4 + h];
    lgf = -log1pf(expf(-xf)) * 1.44269504089f; lgb = -log1pf(expf(-xb)) * 1.44269504089f;
    if (smp) {
      const bf16_t* s0 = (const bf16_t*)(ws + O_S0T);
#pragma unroll
      for (int dir = 0; dir < 2; ++dir) {
        const bf16_t* sb = s0 + ((size_t)(((b * 2 + l) * 2 + dir) * 4 + h) * 128) * 64;
        float dec[2];
#pragma unroll
        for (int qb = 0; qb < 2; ++qb) { const int tq = tq0 + qb * 16; dec[qb] = dir == 0 ? ex2((float)(tq + 1) * lgf) : ex2((float)(T - tq) * lgb); }
#pragma unroll
        for (int vb = 0; vb < NVB; ++vb) {
          f32x4 t0 = (f32x4){0.f, 0.f, 0.f, 0.f}, t1 = (f32x4){0.f, 0.f, 0.f, 0.f};
#pragma unroll
          for (int ks = 0; ks < 2; ++ks) {
            const bf16x8 sf = *(const bf16x8*)(sb + (size_t)(vb * 16 + fr) * 64 + ks * 32 + fq * 8);
            t0 = mfma16(sf, qf[0][ks], t0); t1 = mfma16(sf, qf[1][ks], t1);
          }
          o[vb][0] += t0 * dec[0]; o[vb][1] += t1 * dec[1];
        }
      }
    }
  }
  u32x4 vreg[NVB / 2];
  const int uw = __builtin_amdgcn_readfirstlane(wid);
  const int dkey = lane >> 2, dchunk = (lane & 3) ^ swz(dkey);
  auto kdma = [&](int kt, char* buf) {
    const GAS bf16_t* kp = (const GAS bf16_t*)kbase + (size_t)(kt * 64 + uw * 16 + dkey) * kstride + dchunk * 8;
#pragma unroll
    for (int pn = 0; pn < 2; ++pn)
      __builtin_amdgcn_global_load_lds((const GAS unsigned*)(kp + pn * 32), (LAS unsigned*)((LAS char*)buf + pn * 4096 + uw * 1024), 16, 0, 0);
    if (MODE == 0) {
      const GAS bf16_t* rp = (const GAS bf16_t*)rbase + (size_t)(kt * 64 + uw * 16 + dkey) * 32 + dchunk * 8;
      __builtin_amdgcn_global_load_lds((const GAS unsigned*)rp, (LAS unsigned*)((LAS char*)buf + 2 * 4096 + uw * 1024), 16, 0, 0);
    }
  };
  auto gload = [&](int kt) {
#pragma unroll
    for (int i = 0; i < NVB / 2; ++i) { const int idx = tid + 256 * i, vd = idx >> 3, g = idx & 7; vreg[i] = ldg16(vbase + (size_t)vd * Tk + kt * 64 + g * 8); }
  };
  auto lstore = [&](char* buf) {
#pragma unroll
    for (int i = 0; i < NVB / 2; ++i) {
      const int idx = tid + 256 * i, vd = idx >> 3, g = idx & 7, pnl = g >> 2, g4 = g & 3, hi = g4 >> 1, q0 = 2 * (g4 & 1);
      char* base = buf + KOFF + pnl * PV + vd * 64 + hi * 8;
      *(u32x2*)(base + ((q0 ^ swz(vd)) << 4)) = (u32x2){vreg[i].x, vreg[i].y};
      *(u32x2*)(base + (((q0 + 1) ^ swz(vd)) << 4)) = (u32x2){vreg[i].z, vreg[i].w};
    }
  };
  __syncthreads();
  kdma(0, lds); gload(0); lstore(lds);
  asm volatile("s_waitcnt vmcnt(0)" ::: "memory");
  __syncthreads();
  const int foff = fr * 64 + ((fq ^ swz(fr)) << 4);
  for (int kt = 0; kt < nkt; ++kt) {
    char* cur = lds + (kt & 1) * BUF;
    const bool more = (kt + 1) < nkt;
    if (more) { kdma(kt + 1, lds + ((kt + 1) & 1) * BUF); gload(kt + 1); }
    __builtin_amdgcn_sched_barrier(0);
    f32x4 s[4][2];
#pragma unroll
    for (int kb = 0; kb < 4; ++kb) {
      s[kb][0] = (f32x4){0.f, 0.f, 0.f, 0.f}; s[kb][1] = (f32x4){0.f, 0.f, 0.f, 0.f};
#pragma unroll
      for (int ks = 0; ks < NKP; ++ks) {
        const bf16x8 kf = *(const bf16x8*)(cur + ks * 4096 + kb * 1024 + foff);
        s[kb][0] = mfma16(kf, qf[0][ks], s[kb][0]); s[kb][1] = mfma16(kf, qf[1][ks], s[kb][1]);
      }
    }
    bf16x8 pf[2][2];
#pragma unroll
    for (int qb = 0; qb < 2; ++qb) {
      if (MODE == 0) {
        float mx = s[0][qb][0];
#pragma unroll
        for (int kb = 0; kb < 4; ++kb)
#pragma unroll
          for (int r = 0; r < 4; ++r) mx = fmaxf(mx, s[kb][qb][r]);
        mx = fmaxf(mx, __shfl_xor(mx, 16)); mx = fmaxf(mx, __shfl_xor(mx, 32));
        const float mn = fmaxf(mrow[qb], mx), alpha = ex2(mrow[qb] - mn);
        mrow[qb] = mn;
        float ls = 0.f;
#pragma unroll
        for (int kb = 0; kb < 4; ++kb)
#pragma unroll
          for (int r = 0; r < 4; ++r) { const float e = ex2(s[kb][qb][r] - mn); s[kb][qb][r] = e; ls += e; }
        lrow[qb] = lrow[qb] * alpha + ls;
#pragma unroll
        for (int vb = 0; vb < NVB; ++vb) o[vb][qb] *= alpha;
      } else {
        const int tq = tq0 + qb * 16;
#pragma unroll
        for (int kb = 0; kb < 4; ++kb)
#pragma unroll
          for (int r = 0; r < 4; ++r) {
            const int d = tq - (kt * 64 + kb * 16 + fq * 4 + r);
            const float dec = d > 0 ? ex2((float)d * lgf) : (d < 0 ? ex2((float)(-d) * lgb) : 2.f);
            s[kb][qb][r] *= dec;
          }
      }
#pragma unroll
      for (int g = 0; g < 2; ++g) {
        u32x4 w; w.x = pk2(s[2 * g][qb][0], s[2 * g][qb][1]); w.y = pk2(s[2 * g][qb][2], s[2 * g][qb][3]);
        w.z = pk2(s[2 * g + 1][qb][0], s[2 * g + 1][qb][1]); w.w = pk2(s[2 * g + 1][qb][2], s[2 * g + 1][qb][3]);
        pf[qb][g] = as_bf8(w);
      }
    }
#pragma unroll
    for (int vb = 0; vb < NVB; ++vb)
#pragma unroll
      for (int g = 0; g < 2; ++g) {
        const bf16x8 vf = *(const bf16x8*)(cur + KOFF + g * PV + vb * 1024 + foff);
        o[vb][0] = mfma16(vf, pf[0][g], o[vb][0]); o[vb][1] = mfma16(vf, pf[1][g], o[vb][1]);
      }
    __builtin_amdgcn_sched_barrier(0);
    if (more) lstore(lds + ((kt + 1) & 1) * BUF);
    asm volatile("s_waitcnt vmcnt(0)" ::: "memory");
    __syncthreads();
  }
  bf16_t* G = (bf16_t*)(ws + (MODE == 0 ? O_MZ : O_RZ));
#pragma unroll
  for (int qb = 0; qb < 2; ++qb) {
    const int tok = tok0 + wid * 32 + qb * 16 + fr;
    float mul, sub;
    if (MODE == 0) {
      float lt = lrow[qb]; lt += __shfl_xor(lt, 16); lt += __shfl_xor(lt, 32);
      mul = 1.f / lt; sub = 0.f;
    } else {
      float sm = 0.f;
#pragma unroll
      for (int vb = 0; vb < NVB; ++vb) sm += (o[vb][qb][0] + o[vb][qb][1]) + (o[vb][qb][2] + o[vb][qb][3]);
      sm += __shfl_xor(sm, 16); sm += __shfl_xor(sm, 32);
      const float mu = sm * (1.f / 128.f);
      float vs = 0.f;
#pragma unroll
      for (int vb = 0; vb < NVB; ++vb)
#pragma unroll
        for (int r = 0; r < 4; ++r) { const float dd = o[vb][qb][r] - mu; vs += dd * dd; }
      vs += __shfl_xor(vs, 16); vs += __shfl_xor(vs, 32);
      mul = rsqrtf(vs * (1.f / 128.f) + EPSN); sub = mu;
    }
#pragma unroll
    for (int vb = 0; vb < NVB; ++vb) {
      bf16_t* gp = G + (size_t)tok * 512 + h * (NVB * 16) + vb * 16 + fq * 4;
      const u32x2 gz = *(const u32x2*)gp;
      f32x4 y;
      y[0] = (o[vb][qb][0] - sub) * mul * bflo(gz.x); y[1] = (o[vb][qb][1] - sub) * mul * bfhi(gz.x);
      y[2] = (o[vb][qb][2] - sub) * mul * bflo(gz.y); y[3] = (o[vb][qb][3] - sub) * mul * bfhi(gz.y);
      *(u32x2*)gp = pk4(y);
    }
  }
}

__device__ __forceinline__ bf16x8 scale8(u32x4 raw, const float (&d)[8]) {
  u32x4 w;
  w.x = pk2(bflo(raw.x) * d[0], bfhi(raw.x) * d[1]); w.y = pk2(bflo(raw.y) * d[2], bfhi(raw.y) * d[3]);
  w.z = pk2(bflo(raw.z) * d[4], bfhi(raw.z) * d[5]); w.w = pk2(bflo(raw.w) * d[6], bfhi(raw.w) * d[7]);
  return as_bf8(w);
}
__device__ __forceinline__ void state_item(const Params& p, int l, int item) {
  const int tid = tidx(), lane = tid & 63, wid = tid >> 6, fr = lane & 15, fq = lane >> 4;
  const int b = item >> 2, h = item & 3;
  const bf16_t* RVT = (const bf16_t*)(p.ws + O_RVT) + (size_t)(b * 4 + h) * 128 * 256;
  const bf16_t* RKT = (const bf16_t*)(p.ws + O_RKT) + (size_t)(b * 4 + h) * 64 * 256;
  const float xf = p.ret_logit[(l * 2 + 0) * 4 + h], xb = p.ret_logit[(l * 2 + 1) * 4 + h];
  const float lgf = -log1pf(expf(-xf)) * 1.44269504089f, lgb = -log1pf(expf(-xb)) * 1.44269504089f;
  f32x4 acc[2][2][4];
#pragma unroll
  for (int d = 0; d < 2; ++d)
#pragma unroll
    for (int v = 0; v < 2; ++v)
#pragma unroll
      for (int k = 0; k < 4; ++k) acc[d][v][k] = (f32x4){0.f, 0.f, 0.f, 0.f};
#pragma unroll 2
  for (int ks = 0; ks < 8; ++ks) {
    const int j0 = ks * 32 + fq * 8;
    float df[8], db[8];
#pragma unroll
    for (int e = 0; e < 8; ++e) { df[e] = exp2f((float)(255 - j0 - e) * lgf); db[e] = exp2f((float)(j0 + e) * lgb); }
    bf16x8 af[2];
#pragma unroll
    for (int v = 0; v < 2; ++v) af[v] = *(const bf16x8*)(RVT + (size_t)((wid * 2 + v) * 16 + fr) * 256 + j0);
#pragma unroll
    for (int k = 0; k < 4; ++k) {
      const u32x4 raw = *(const u32x4*)(RKT + (size_t)(k * 16 + fr) * 256 + j0);
      const bf16x8 kf = scale8(raw, df), kb = scale8(raw, db);
#pragma unroll
      for (int v = 0; v < 2; ++v) { acc[0][v][k] = mfma16(af[v], kf, acc[0][v][k]); acc[1][v][k] = mfma16(af[v], kb, acc[1][v][k]); }
    }
  }
  float* O = p.out + OUT_RET;
#pragma unroll
  for (int d = 0; d < 2; ++d)
#pragma unroll
    for (int v = 0; v < 2; ++v)
#pragma unroll
      for (int k = 0; k < 4; ++k) {
        const int dk = k * 16 + fr, vd = (wid * 2 + v) * 16 + fq * 4;
        *(f32x4*)(O + ((size_t)((((b * 2 + l) * 2 + d) * 4 + h) * 64 + dk)) * 128 + vd) = acc[d][v][k];
      }
}

__device__ __forceinline__ void keyprep_item(const Params& p, int l, int item) {
  const int tid = tidx(), lane = tid & 63, wid = tid >> 6;
  char* ws = wsp(p.ws);
  bf16_t* CKVA = (bf16_t*)(ws + O_CKVA);
  bf16_t* KRA = (bf16_t*)(ws + O_KRA);
#pragma unroll
  for (int i = 0; i < 4; ++i) {
    const int R = item * 16 + wid * 4 + i;
    int smp = 0, b, t = 0, tok = 0, ctx = 0, pp = 0;
    if (R < NPR) { tok = R; b = R >> 8; t = R & 255; }
    else { smp = 1; const int s = R - NPR; b = s / 1536; pp = s - b * 1536; if (pp < 512) ctx = 1; else { t = pp - 512; tok = NPR + b * 1024 + t; } }
    if (ctx) {
      const f32x4 v = *(const f32x4*)(p.cache_ckv + ((size_t)((b * 2 + l) * 512 + pp)) * 256 + lane * 4);
      *(u32x2*)(CKVA + (size_t)R * 256 + lane * 4) = pk4(v);
      if (lane < 32) KRA[(size_t)R * 32 + lane] = tobf(p.cache_krope[((size_t)((b * 2 + l) * 512 + pp)) * 32 + lane]);
      continue;
    }
    const f32x4 v = *(const f32x4*)((const float*)(ws + O_KVLAT) + (size_t)tok * 256 + lane * 4);
    float ss = v[0] * v[0] + v[1] * v[1] + v[2] * v[2] + v[3] * v[3];
    ss = wave_sum(ss);
    const float rstd = rsqrtf(ss * (1.f / 256.f) + EPSN);
    const f32x4 g = *(const f32x4*)(p.kv_norm_g + l * 256 + lane * 4);
    f32x4 y;
#pragma unroll
    for (int e = 0; e < 4; ++e) y[e] = v[e] * rstd * g[e];
    *(u32x2*)(CKVA + (size_t)R * 256 + lane * 4) = pk4(y);
    if (!smp) *(f32x4*)(p.out + OUT_CKV + ((size_t)((b * 2 + l) * 256 + t)) * 256 + lane * 4) = y;
    const int d = lane & 31;
    const float x = ((const float*)(ws + O_KR))[(size_t)tok * 32 + d];
    float yk = x;
    if (smp) {
      const float pr = __shfl_xor(x, 8);
      const int hd = d >> 4, i16 = d & 15, f = i16 & 7;
      const int pos = hd ? (t & 63) : (t >> 6);
      const float* rt = (const float*)(ws + O_ROPE) + (pos * 8 + f) * 2;
      const float cs = rt[0], sn = rt[1];
      yk = i16 < 8 ? x * cs - pr * sn : pr * sn + x * cs;
    } else if (lane < 32) {
      p.out[OUT_KR + ((size_t)((b * 2 + l) * 256 + t)) * 32 + d] = x;
    }
    if (lane < 32) KRA[(size_t)R * 32 + d] = tobf(yk);
  }
}

__device__ __forceinline__ void f1_tile(const Params& p, int tile, char* lds) {
  const int tid = tidx(), lane = tid & 63, wid = tid >> 6, wm = wid >> 1, wn = wid & 1, fr = lane & 15, fq = lane >> 4;
  const int m = tile >> 3, g = (tile >> 1) & 3, nh = tile & 1, m0 = m * 128;
  char* ws = wsp(p.ws);
  f32x4 acc[4][4];
  zero_acc(acc);
  gemm_core<false>((const bf16_t*)(ws + O_FU) + (size_t)m0 * 512 + g * 128, 512, (const bf16_t*)(ws + O_CS) + (size_t)nh * 128 * 128, 128, 128, acc, lds);
  bf16_t* UT = (bf16_t*)(ws + O_UT);
#pragma unroll
  for (int i = 0; i < 4; ++i) {
    const int tok = m0 + wm * 64 + i * 16 + fq * 4;
    size_t base; int T, b, t;
    if (tok < NPR) { b = tok >> 8; t = tok & 255; T = 256; base = 0; } else { const int s = tok - NPR; b = s >> 10; t = s & 1023; T = 1024; base = (size_t)NPR * 1024; }
#pragma unroll
    for (int j = 0; j < 4; ++j) {
      const int k2 = wn * 64 + j * 16 + fr;
      *(u32x2*)(UT + base + ((size_t)(b * 4 + g) * 128 + k2) * (2 * T) + nh * T + t) = pk4(acc[i][j]);
    }
  }
}

__device__ __forceinline__ void qup_tile(const Params& p, int l, int tile, char* lds) {
  const int tid = tidx(), lane = tid & 63, wid = tid >> 6, wm = wid >> 1, wn = wid & 1, fr = lane & 15, fq = lane >> 4;
  const int m = tile % 96, nt = tile / 96, m0 = m * 128, n0 = nt * 128;
  char* ws = wsp(p.ws);
  const bf16_t* QL = (const bf16_t*)(ws + O_QLAT) + (size_t)m0 * 384;
  float rsv4[4];
  {
    float* rs = (float*)lds;
    __syncthreads();
#pragma unroll 1
    for (int r0 = 0; r0 < 32; r0 += 4) {
      float ss[4];
#pragma unroll
      for (int u = 0; u < 4; ++u) {
        u32x4 w = (u32x4){0u, 0u, 0u, 0u};
        if (lane < 48) w = ldg16(QL + (size_t)(wid * 32 + r0 + u) * 384 + lane * 8);
        ss[u] = bflo(w.x) * bflo(w.x) + bfhi(w.x) * bfhi(w.x) + bflo(w.y) * bflo(w.y) + bfhi(w.y) * bfhi(w.y) + bflo(w.z) * bflo(w.z) + bfhi(w.z) * bfhi(w.z) + bflo(w.w) * bflo(w.w) + bfhi(w.w) * bfhi(w.w);
      }
#pragma unroll
      for (int u = 0; u < 4; ++u) { const float t = wave_sum(ss[u]); if (lane == 0) rs[wid * 32 + r0 + u] = rsqrtf(t * (1.f / 384.f) + EPSN); }
    }
    __syncthreads();
#pragma unroll
    for (int i = 0; i < 4; ++i) rsv4[i] = rs[wm * 64 + i * 16 + fr];
    __syncthreads();
  }
  f32x4 acc[4][4];
  zero_acc(acc);
  gemm_core<true>(QL, 384, (const bf16_t*)(ws + O_WQ) + ((size_t)l * 768 + n0) * 384, 384, 384, acc, lds);
  bf16_t* QB = (bf16_t*)(ws + O_QB);
  const float qscale = 0.10206207261596577f * 1.44269504089f;
#pragma unroll
  for (int i = 0; i < 4; ++i) {
    const int rl = wm * 64 + i * 16 + fr, tok = m0 + rl;
    const float sc = rsv4[i] * qscale;
    const int smp = tok >= NPR, t = (tok - NPR) & 1023;
#pragma unroll
    for (int j = 0; j < 4; ++j) {
      const int cb = n0 + wn * 64 + j * 16, within = cb % 96;
      f32x4 v = acc[i][j] * sc;
      if (within >= 64) {
        f32x4 pr;
#pragma unroll
        for (int e = 0; e < 4; ++e) pr[e] = __shfl_xor(v[e], 32);
        if (smp) {
          const int pos = within >= 80 ? (t & 63) : (t >> 6);
          const float* rt = (const float*)(ws + O_ROPE) + (pos * 8 + (fq & 1) * 4) * 2;
          const f32x4 c01 = *(const f32x4*)rt, c23 = *(const f32x4*)(rt + 4);
          const float cs4[4] = {c01[0], c01[2], c23[0], c23[2]}, sn4[4] = {c01[1], c01[3], c23[1], c23[3]};
#pragma unroll
          for (int e = 0; e < 4; ++e) v[e] = fq < 2 ? v[e] * cs4[e] - pr[e] * sn4[e] : pr[e] * sn4[e] + v[e] * cs4[e];
        }
      }
      *(u32x2*)(QB + (size_t)tok * 768 + cb + fq * 4) = pk4(v);
    }
  }
}

__device__ __forceinline__ void kvup_tile(const Params& p, int l, int tile, char* lds) {
  const int tid = tidx(), lane = tid & 63, wid = tid >> 6, wm = wid >> 1, wn = wid & 1, fr = lane & 15, fq = lane >> 4;
  const int m = tile % 112, nt = tile / 112, m0 = m * 128, n0 = nt * 128;
  char* ws = wsp(p.ws);
  const bf16_t* A = (const bf16_t*)(ws + O_CKVA) + (size_t)m0 * 256;
  const bf16_t* B = (const bf16_t*)(ws + O_WKV) + ((size_t)l * 1024 + n0) * 256;
  f32x4 acc[4][4];
  zero_acc(acc);
  if (nt < 4) {
    gemm_core<true>(A, 256, B, 256, 256, acc, lds);
    bf16_t* KB = (bf16_t*)(ws + O_KB);
#pragma unroll
    for (int i = 0; i < 4; ++i) {
      const int R = m0 + wm * 64 + i * 16 + fr;
#pragma unroll
      for (int j = 0; j < 4; ++j) *(u32x2*)(KB + (size_t)R * 512 + n0 + wn * 64 + j * 16 + fq * 4) = pk4(acc[i][j]);
    }
  } else {
    gemm_core<false>(A, 256, B, 256, 256, acc, lds);
    bf16_t* VT = (bf16_t*)(ws + O_VT);
#pragma unroll
    for (int i = 0; i < 4; ++i) {
      const int R = m0 + wm * 64 + i * 16 + fq * 4;
      size_t base; int Tk, b, k;
      if (R < NPR) { b = R >> 8; k = R & 255; Tk = 256; base = 0; } else { const int s = R - NPR; b = s / 1536; k = s - b * 1536; Tk = 1536; base = (size_t)NPR * 512; }
#pragma unroll
      for (int j = 0; j < 4; ++j) {
        const int c = n0 - 512 + wn * 64 + j * 16 + fr, h = c >> 6, vd = c & 63;
        *(u32x2*)(VT + base + ((size_t)(b * 8 + h) * 64 + vd) * Tk + k) = pk4(acc[i][j]);
      }
    }
  }
}

template <int NJ>
__device__ __forceinline__ void f2_tile(const Params& p, int tile, char* lds) {
  const int tid = tidx(), lane = tid & 63, wid = tid >> 6, wm = wid >> 1, wn = wid & 1, fr = lane & 15, fq = lane >> 4;
  char* ws = wsp(p.ws);
  const bf16_t *A, *B; int K, tokb, g, nh = 0; float scale;
  if (NJ == 2) {
    const int b = tile >> 6, mt = (tile >> 1) & 7; g = (tile >> 4) & 3; nh = tile & 1;
    A = (const bf16_t*)(ws + O_D1024) + (size_t)mt * 128 * 2048; K = 2048;
    B = (const bf16_t*)(ws + O_UT) + (size_t)NPR * 1024 + ((size_t)(b * 4 + g) * 128 + nh * 64) * 2048;
    tokb = NPR + b * 1024 + mt * 128; scale = 0.00276213586400995f;
  } else {
    const int b = tile >> 3, mt = tile & 1; g = (tile >> 1) & 3;
    A = (const bf16_t*)(ws + O_D256) + (size_t)mt * 128 * 512; K = 512;
    B = (const bf16_t*)(ws + O_UT) + (size_t)(b * 4 + g) * 128 * 512;
    tokb = b * 256 + mt * 128; scale = 0.0055242717280199f;
  }
  f32x4 acc[4][NJ];
#pragma unroll
  for (int i = 0; i < 4; ++i)
#pragma unroll
    for (int j = 0; j < NJ; ++j) acc[i][j] = (f32x4){0.f, 0.f, 0.f, 0.f};
  gemm_core<true, NJ>(A, K, B, K, K, acc, lds);
  bf16_t* FZ = (bf16_t*)(ws + O_FZ);
#pragma unroll
  for (int i = 0; i < 4; ++i) {
    const int tok = tokb + wm * 64 + i * 16 + fr;
#pragma unroll
    for (int j = 0; j < NJ; ++j) {
      bf16_t* gp = FZ + (size_t)tok * 512 + g * 128 + nh * 64 + wn * (NJ * 16) + j * 16 + fq * 4;
      const u32x2 gz = *(const u32x2*)gp;
      f32x4 y;
      y[0] = acc[i][j][0] * scale * bflo(gz.x); y[1] = acc[i][j][1] * scale * bfhi(gz.x);
      y[2] = acc[i][j][2] * scale * bflo(gz.y); y[3] = acc[i][j][3] * scale * bfhi(gz.y);
      *(u32x2*)gp = pk4(y);
    }
  }
}

template <int NJ>
__device__ __forceinline__ void s6_tile(const Params& p, int l, int tile, int ntile, char* lds, int& par, bool& primed) {
  const int tid = tidx(), lane = tid & 63, wid = tid >> 6, wm = wid >> 1, wn = wid & 1, fr = lane & 15, fq = lane >> 4;
  constexpr int NT = 32 / NJ, BN = NJ * 32;
  const int m = (tile / (32 * NT)) * 32 + (tile % 32), nt = (tile % (32 * NT)) / 32, m0 = m * 128, n0 = nt * BN;
  char* ws = wsp(p.ws);
  const bf16_t* Hh = (const bf16_t*)(ws + O_H);
  const bf16_t* Wg = (const bf16_t*)(ws + O_WIN) + ((size_t)l * 6912 + 3840) * 1024;
  const bf16_t* Wb = (const bf16_t*)(ws + O_WBR) + (size_t)(l * 3) * 1024 * 512;
  f32x4 tot[4][NJ], acc[4][NJ];
  u32x2 sg[4][NJ];
#pragma unroll
  for (int i = 0; i < 4; ++i)
#pragma unroll
    for (int j = 0; j < NJ; ++j) tot[i][j] = (f32x4){0.f, 0.f, 0.f, 0.f};
#pragma unroll 1
  for (int nb = 0; nb < 3; ++nb) {
#pragma unroll
    for (int i = 0; i < 4; ++i)
#pragma unroll
      for (int j = 0; j < NJ; ++j) acc[i][j] = (f32x4){0.f, 0.f, 0.f, 0.f};
    const size_t boff = nb == 0 ? O_RZ : (nb == 1 ? O_MZ : O_FZ);
    const bf16_t* brA = (const bf16_t*)(ws + boff) + (size_t)m0 * 512;
    const bf16_t* brB = Wb + ((size_t)nb * 1024 + n0) * 512;
    gemm_core<true, NJ>(Hh + (size_t)m0 * 1024, 1024, Wg + ((size_t)nb * 1024 + n0) * 1024, 1024, 1024, acc, lds, par, primed, brA, 512, brB, 512);
#pragma unroll
    for (int i = 0; i < 4; ++i)
#pragma unroll
      for (int j = 0; j < NJ; ++j) { f32x4 sv;
#pragma unroll
        for (int e = 0; e < 4; ++e) sv[e] = fmaxf(sigm_f(acc[i][j][e]), 1e-6f);
        sg[i][j] = pk4(sv);
        tot[i][j][0] *= __builtin_amdgcn_rcpf(bflo(sg[i][j].x)); tot[i][j][1] *= __builtin_amdgcn_rcpf(bfhi(sg[i][j].x));
        tot[i][j][2] *= __builtin_amdgcn_rcpf(bflo(sg[i][j].y)); tot[i][j][3] *= __builtin_amdgcn_rcpf(bfhi(sg[i][j].y)); }
    const bf16_t *nA = nullptr, *nB = nullptr;
    if (nb < 2) { nA = Hh + (size_t)m0 * 1024; nB = Wg + ((size_t)(nb + 1) * 1024 + n0) * 1024; }
    else if (ntile >= 0) { nA = Hh + (size_t)(((ntile / (32 * NT)) * 32 + (ntile % 32)) * 128) * 1024; nB = Wg + (size_t)(((ntile % (32 * NT)) / 32) * BN) * 1024; }
    gemm_core<true, NJ>(brA, 512, brB, 512, 512, tot, lds, par, true, nA, 1024, nB, 1024);
    primed = nA != nullptr;
#pragma unroll
    for (int i = 0; i < 4; ++i)
#pragma unroll
      for (int j = 0; j < NJ; ++j) {
        tot[i][j][0] *= bflo(sg[i][j].x); tot[i][j][1] *= bfhi(sg[i][j].x);
        tot[i][j][2] *= bflo(sg[i][j].y); tot[i][j][3] *= bfhi(sg[i][j].y);
      }
  }
  bf16_t* MG = (bf16_t*)(ws + O_UT);
#pragma unroll
  for (int i = 0; i < 4; ++i) {
    const int tok = m0 + wm * 64 + i * 16 + fr;
#pragma unroll
    for (int j = 0; j < NJ; ++j) *(u32x2*)(MG + (size_t)tok * 1024 + n0 + wn * (NJ * 16) + j * 16 + fq * 4) = pk4(tot[i][j]);
  }
}

__device__ __forceinline__ void s7_tile(const Params& p, int l, int tile, const float* xp, const float* xs, char* lds) {
  const int tid = tidx(), lane = tid & 63, wid = tid >> 6, wm = wid >> 1, wn = wid & 1, fr = lane & 15, fq = lane >> 4;
  const int m = (tile / 512) * 32 + (tile % 32), nt = (tile % 512) / 32, m0 = m * 128, n0 = nt * 64;
  char* ws = wsp(p.ws);
  f32x4 acc[4][2];
#pragma unroll
  for (int i = 0; i < 4; ++i) { acc[i][0] = (f32x4){0.f, 0.f, 0.f, 0.f}; acc[i][1] = (f32x4){0.f, 0.f, 0.f, 0.f}; }
  gemm_core<true, 2>((const bf16_t*)(ws + O_UT) + (size_t)m0 * 1024, 1024, (const bf16_t*)(ws + O_WO) + ((size_t)l * 1024 + n0) * 1024, 1024, 1024, acc, lds);
#pragma unroll
  for (int i = 0; i < 4; ++i) {
    const int tok = m0 + wm * 64 + i * 16 + fr;
    const float* src = tok < NPR ? xp + (size_t)tok * 1024 : xs + (size_t)(tok - NPR) * 1024;
    const int v = tok < NPR ? 0 : 1 + ((tok - NPR) >> 10);
    const float* gate = (const float*)(ws + O_MOD) + (l * 5 + v) * 3072 + 2048;
#pragma unroll
    for (int j = 0; j < 2; ++j) {
      const int col = n0 + wn * 32 + j * 16 + fq * 4;
      const f32x4 x = *(const f32x4*)(src + col), gt = *(const f32x4*)(gate + col);
      f32x4 y;
#pragma unroll
      for (int e = 0; e < 4; ++e) y[e] = x[e] + gt[e] * acc[i][j][e];
      *(f32x4*)(p.out + (size_t)tok * 1024 + col) = y;
    }
  }
}

constexpr int NPHASE = 16;
__device__ __forceinline__ int q_issue(unsigned* ctr) {
  int v = 0;
  if (threadIdx.x == 0) v = (int)__hip_atomic_fetch_add(ctr, 1u, __ATOMIC_RELAXED, __HIP_MEMORY_SCOPE_AGENT);
  return v;
}
__device__ __forceinline__ int q_bcast(int v, char* lds) {
  __syncthreads();
  if (threadIdx.x == 0) *(volatile int*)lds = v;
  __syncthreads();
  const int it = *(volatile int*)lds;
  __syncthreads();
  return it;
}
__device__ __forceinline__ void run_phase(const Params& p, int ph, char* lds, unsigned* qctr) {
  const int bid = blockIdx.x, nb = gridDim.x;
  if (ph == 0) { for (int i = bid; i < P0_N; i += nb) phase0_item(p, i, lds); return; }
  if (ph == 15) { for (int i = bid; i < 512; i += nb) final_item(p, i); return; }
  const int l = (ph - 1) / 7, s = (ph - 1) % 7;
  const float* xp = l == 0 ? p.x_prompt : p.out;
  const float* xs = l == 0 ? p.x_sample : p.out + (size_t)NPR * 1024;
  switch (s) {
    case 0: for (int i = bid; i < 512; i += nb) norm_item(p, l, i, xp, xs); break;
    case 1: for (int i = bid; i < 2880; i += nb) s2_tile(p, l, i, lds); break;
    case 2:
      for (int i = q_bcast(q_issue(qctr + ph), lds); i < 2752;) {
        if (i < 128) attn_item<1>(p, l, i, lds);
        else if (i < 1024) keyprep_item(p, l, i - 128);
        else if (i < 1280) attn_item<1>(p, l, 128 + (i - 1024), lds);
        else if (i < 1408) state_item(p, l, i - 1280);
        else if (i < 1984) qup_tile(p, l, i - 1408, lds);
        else f1_tile(p, i - 1984, lds);
        i = q_bcast(q_issue(qctr + ph), lds);
      }
      break;
    case 3:
      for (int i = q_bcast(q_issue(qctr + ph), lds); i < 1408;) {
        if (i < 256) f2_tile<2>(p, i, lds);
        else if (i < 512) f2_tile<4>(p, i - 256, lds);
        else kvup_tile(p, l, i - 512, lds);
        i = q_bcast(q_issue(qctr + ph), lds);
      }
      break;
    case 4:
      for (int i = q_bcast(q_issue(qctr + ph), lds); i < 768;) {
        attn_item<0>(p, l, i, lds);
        i = q_bcast(q_issue(qctr + ph), lds);
      }
      break;
    case 5: { int par = 0; bool primed = false; for (int i = bid; i < 768; i += nb) s6_tile<4>(p, l, i, (i + nb < 768) ? i + nb : -1, lds, par, primed); } break;
    case 6: for (int i = bid; i < 1536; i += nb) s7_tile(p, l, i, xp, xs, lds); break;
  }
}

#define XB_TMO      128
#define XB_XCNT(j)  (256  + 64 * (j))
#define XB_XSUB(j)  (1280 + 64 * (j))
#define XB_XGEN(j)  (2304 + 64 * (j))
#define XB_TOP      3328
#define XB_TOPGEN   3392
#define XCD_BAR_WORDS 3456
#define XB_SPIN_CAP (1u << 18)
__device__ __forceinline__ unsigned xb_ld(unsigned* p)              { return __hip_atomic_load(p, __ATOMIC_RELAXED, __HIP_MEMORY_SCOPE_AGENT); }
__device__ __forceinline__ unsigned xb_add(unsigned* p, unsigned v) { return __hip_atomic_fetch_add(p, v, __ATOMIC_RELAXED, __HIP_MEMORY_SCOPE_AGENT); }
__device__ __forceinline__ unsigned xb_xcc_id() { return (unsigned)__builtin_amdgcn_s_getreg((3 << 11) | 20) & 0xFu; }
#define XB_SPIN(cond, bar) do { unsigned _sp = 0; while (cond) { __builtin_amdgcn_s_sleep(1); \
    if ((++_sp & 255u) == 0u) { if (xb_ld(&(bar)[XB_TMO])) break; if (_sp > XB_SPIN_CAP) { atomicAdd(&(bar)[XB_TMO], 1u); break; } } } } while (0)
__device__ __forceinline__ void xcd_barrier_complete(unsigned* bar, unsigned x, unsigned& nloc, unsigned& nx) {
  const unsigned G = gridDim.x;
  unsigned sum, cnt, mine, sp = 0u;
  for (;;) {
    sum = 0u; cnt = 0u; mine = 0u;
#pragma unroll
    for (unsigned j = 0; j < 16; ++j) { const unsigned c = xb_ld(&bar[XB_XCNT(j)]); sum += c; cnt += (c > 0u) ? 1u : 0u; mine = (j == x) ? c : mine; }
    if (sum == G) break;
    __builtin_amdgcn_s_sleep(1);
    if ((++sp & 255u) == 0u) { if (xb_ld(&bar[XB_TMO])) break; if (sp > XB_SPIN_CAP) { atomicAdd(&bar[XB_TMO], 1u); break; } }
  }
  nloc = mine > 0u ? mine : 1u; nx = cnt > 0u ? cnt : 1u;
}
__device__ __forceinline__ void xcd_barrier(unsigned* bar, unsigned x, unsigned& nloc, unsigned& nx) {
  asm volatile("s_waitcnt vmcnt(0)" ::: "memory");
  __syncthreads();
  if (threadIdx.x == 0) {
    __builtin_amdgcn_s_waitcnt(0);
    if (nloc == 0u) xcd_barrier_complete(bar, x, nloc, nx);
    const unsigned old = xb_add(&bar[XB_XSUB(x)], 1u);
    const unsigned gen = old / nloc;
    if (old + 1u == (gen + 1u) * nloc) {
      __builtin_amdgcn_fence(__ATOMIC_RELEASE, "agent");
      asm volatile("s_waitcnt vmcnt(0)" ::: "memory");
      const unsigned og = xb_add(&bar[XB_TOP], 1u);
      const unsigned tg = og / nx;
      if (og + 1u == (tg + 1u) * nx) xb_add(&bar[XB_TOPGEN], 1u);
      else XB_SPIN(xb_ld(&bar[XB_TOPGEN]) == tg, bar);
      __builtin_amdgcn_fence(__ATOMIC_ACQUIRE, "agent");
      xb_add(&bar[XB_XGEN(x)], 1u);
      asm volatile("s_waitcnt vmcnt(0)" ::: "memory");
    } else {
      XB_SPIN(xb_ld(&bar[XB_XGEN(x)]) == gen, bar);
      __builtin_amdgcn_fence(__ATOMIC_ACQUIRE, "agent");
      asm volatile("s_waitcnt vmcnt(0)" ::: "memory");
    }
  }
  __syncthreads();
}

__global__ void __launch_bounds__(256, 2) mk_fwd(Params p) {
  __shared__ __attribute__((aligned(16))) char lds[LDS_TOTAL];
  cg::grid_group grid = cg::this_grid();
  unsigned* bar = (unsigned*)(p.ws + O_BAR);
  const unsigned xcc = xb_xcc_id();
  if (threadIdx.x == 0) (void)xb_add(&bar[XB_XCNT(xcc)], 1u);
  unsigned nloc = 0u, nx = 0u;
  if (gridDim.x == 0x7fffffffu) grid.sync();
#pragma unroll 1
  for (int ph = 0; ph < NPHASE; ++ph) {
    run_phase(p, ph, lds, bar);
    if (ph + 1 < NPHASE) xcd_barrier(bar, xcc, nloc, nx);
  }
}

extern "C" void kernel_launch(void* const* d_in, const int* in_sizes, int n_in, void* d_out, int out_size, void* d_ws, size_t ws_size,
                              hipStream_t stream) {
  Params p{};
  p.x_prompt = (const float*)d_in[0]; p.x_sample = (const float*)d_in[1]; p.cache_ckv = (const float*)d_in[2]; p.cache_krope = (const float*)d_in[3];
  p.state_ret = (const float*)d_in[4]; p.c = (const float*)d_in[5]; p.c_ctx = (const float*)d_in[6]; p.norm_g = (const float*)d_in[7];
  p.w_mod = (const float*)d_in[8]; p.b_mod = (const float*)d_in[9]; p.w_in = (const float*)d_in[10]; p.ret_logit = (const float*)d_in[11];
  p.q_norm_g = (const float*)d_in[12]; p.w_q_up = (const float*)d_in[13]; p.kv_norm_g = (const float*)d_in[14]; p.w_kv_up = (const float*)d_in[15];
  p.w_branch = (const float*)d_in[16]; p.w_out = (const float*)d_in[17]; p.final_g = (const float*)d_in[18];
  p.out = (float*)d_out; p.ws = (char*)d_ws;
#if ONE_LAUNCH
  static int grid_blocks = 0;
  if (!grid_blocks) {
    int dev = 0, cus = 0, per_cu = 0;
    hipGetDevice(&dev);
    hipDeviceGetAttribute(&cus, hipDeviceAttributeMultiprocessorCount, dev);
    hipOccupancyMaxActiveBlocksPerMultiprocessor(&per_cu, mk_fwd, 256, 0);
    if (per_cu > 2) per_cu = 2;
    grid_blocks = cus * per_cu;
  }
  hipMemsetAsync((char*)d_ws + O_BAR, 0, XCD_BAR_WORDS * 4, stream);
  void* args[] = {&p};
  hipError_t e = hipLaunchCooperativeKernel((void*)mk_fwd, dim3(grid_blocks), dim3(256), args, 0, stream);
  if (e != hipSuccess) fprintf(stderr, "cooperative launch failed: %s (grid %d)\n", hipGetErrorString(e), grid_blocks);
#endif
}
```

```cpp
#include <hip/hip_runtime.h>
#include <hip/hip_cooperative_groups.h>
#include <stdint.h>
#include <stdio.h>
namespace cg = cooperative_groups;

#ifndef ONE_LAUNCH
#define ONE_LAUNCH 1
#endif

typedef unsigned short bf16_t;
typedef short bf16x8 __attribute__((ext_vector_type(8)));
typedef float f32x4 __attribute__((ext_vector_type(4)));
typedef unsigned u32x4 __attribute__((ext_vector_type(4)));
typedef unsigned u32x2 __attribute__((ext_vector_type(2)));

constexpr int NTOK = 12288, NPR = 8192, NKEY = 14336;
constexpr float EPSN = 1e-6f;

constexpr size_t O_WIN   = 0;
constexpr size_t O_WQ    = O_WIN   + (size_t)2 * 6912 * 1024 * 2;
constexpr size_t O_WKV   = O_WQ    + (size_t)2 * 768 * 384 * 2;
constexpr size_t O_WBR   = O_WKV   + (size_t)2 * 1024 * 256 * 2;
constexpr size_t O_WO    = O_WBR   + (size_t)6 * 1024 * 512 * 2;
constexpr size_t O_CS    = O_WO    + (size_t)2 * 1024 * 1024 * 2;
constexpr size_t O_D256  = O_CS    + (size_t)256 * 128 * 2;
constexpr size_t O_D1024 = O_D256  + (size_t)256 * 512 * 2;
constexpr size_t O_S0T   = O_D1024 + (size_t)1024 * 2048 * 2;
constexpr size_t O_MOD   = O_S0T   + (size_t)64 * 128 * 64 * 2;
constexpr size_t O_H     = O_MOD   + (size_t)2 * 5 * 3072 * 4;
constexpr size_t O_UT    = O_H     + (size_t)NTOK * 1024 * 2;
constexpr size_t O_RQ    = O_UT    + (size_t)NTOK * 1024 * 2;
constexpr size_t O_RK    = O_RQ    + (size_t)NTOK * 256 * 2;
constexpr size_t O_RKT   = O_RK    + (size_t)NTOK * 256 * 2;
constexpr size_t O_RVT   = O_RKT   + (size_t)NPR * 256 * 2;
constexpr size_t O_KVLAT = O_RVT   + (size_t)NTOK * 512 * 2;
constexpr size_t O_KR    = O_KVLAT + (size_t)NTOK * 256 * 4;
constexpr size_t O_R2END = O_KR    + (size_t)NTOK * 32 * 4;
constexpr size_t O_VT    = O_RQ;
static_assert(O_VT + (size_t)NKEY * 512 * 2 <= O_R2END, "alias overflow");
constexpr size_t O_RZ    = O_R2END;
constexpr size_t O_MZ    = O_RZ    + (size_t)NTOK * 512 * 2;
constexpr size_t O_FZ    = O_MZ    + (size_t)NTOK * 512 * 2;
constexpr size_t O_FU    = O_FZ    + (size_t)NTOK * 512 * 2;
constexpr size_t O_QLAT  = O_FU    + (size_t)NTOK * 512 * 2;
constexpr size_t O_CKVA  = O_QLAT  + (size_t)NTOK * 384 * 2;
constexpr size_t O_KB    = O_CKVA  + (size_t)NKEY * 256 * 2;
constexpr size_t O_KRA   = O_KB    + (size_t)NKEY * 512 * 2;
constexpr size_t O_QB    = O_KRA   + (size_t)NKEY * 32 * 2;
constexpr size_t O_END   = O_QB    + (size_t)NTOK * 768 * 2;
constexpr size_t O_ROPE  = (O_END + 255) & ~(size_t)255;
constexpr size_t O_BAR   = O_ROPE + 4096;
static_assert(O_BAR + 16384 <= (size_t)256 * 1024 * 1024, "workspace too large");

constexpr size_t OUT_CKV = (size_t)NTOK * 1024;
constexpr size_t OUT_KR  = OUT_CKV + (size_t)32 * 2 * 256 * 256;
constexpr size_t OUT_RET = OUT_KR + (size_t)32 * 2 * 256 * 32;

struct Params {
  const float *x_prompt, *x_sample, *cache_ckv, *cache_krope, *state_ret, *c, *c_ctx, *norm_g, *w_mod, *b_mod,
      *w_in, *ret_logit, *q_norm_g, *w_q_up, *kv_norm_g, *w_kv_up, *w_branch, *w_out, *final_g;
  float* out;
  char* ws;
};

constexpr int PANEL = 128 * 64;
constexpr int ABYTES = 2 * PANEL;
constexpr int STAGE = 2 * ABYTES;
constexpr int LDS_GEMM = 2 * STAGE;
constexpr int LDS_TOTAL = LDS_GEMM;
static_assert(LDS_TOTAL <= 65536, "static LDS");

typedef float f32x2 __attribute__((ext_vector_type(2)));
typedef __bf16 bf16x2v __attribute__((ext_vector_type(2)));
__device__ __forceinline__ unsigned pk2(float lo, float hi) { const f32x2 v = {lo, hi}; return __builtin_bit_cast(unsigned, __builtin_convertvector(v, bf16x2v)); }
__device__ __forceinline__ bf16_t tobf(float x) { return (bf16_t)(pk2(x, 0.f) & 0xffffu); }
__device__ __forceinline__ float bflo(unsigned u) { return __uint_as_float(u << 16); }
__device__ __forceinline__ float bfhi(unsigned u) { return __uint_as_float(u & 0xffff0000u); }
__device__ __forceinline__ float ex2(float x) { return __builtin_amdgcn_exp2f(x); }
__device__ __forceinline__ float silu_f(float x) { return x / (1.f + __expf(-x)); }
__device__ __forceinline__ float sigm_f(float x) { return 1.f / (1.f + __expf(-x)); }
__device__ __forceinline__ u32x2 pk4(f32x4 v) { u32x2 r; r.x = pk2(v[0], v[1]); r.y = pk2(v[2], v[3]); return r; }
#define GAS __attribute__((address_space(1)))
#define LAS __attribute__((address_space(3)))
__device__ __forceinline__ u32x4 ldg16(const void* p) { return *(const GAS u32x4*)p; }
__device__ __forceinline__ int tidx() { int t = threadIdx.x; asm volatile("" : "+v"(t)); return t; }
__device__ __forceinline__ char* wsp(const char* w) { unsigned long long v = (unsigned long long)w; asm volatile("" : "+s"(v)); return (char*)v; }
__device__ __forceinline__ int swz(int r) { return (0 - ((r >> 2) & 3)) & 3; }
__device__ __forceinline__ float wave_sum(float v) {
#pragma unroll
  for (int o = 1; o < 64; o <<= 1) v += __shfl_xor(v, o);
  return v;
}
__device__ __forceinline__ f32x4 mfma16(bf16x8 a, bf16x8 b, f32x4 c) { return __builtin_amdgcn_mfma_f32_16x16x32_bf16(a, b, c, 0, 0, 0); }
__device__ __forceinline__ bf16x8 as_bf8(u32x4 v) { return __builtin_bit_cast(bf16x8, v); }

__device__ __forceinline__ void zero_acc(f32x4 (&acc)[4][4]) {
#pragma unroll
  for (int i = 0; i < 4; ++i)
#pragma unroll
    for (int j = 0; j < 4; ++j) acc[i][j] = (f32x4){0.f, 0.f, 0.f, 0.f};
}

template <bool SWAP, int NJ = 4, int PIPE = 1>
__device__ __forceinline__ void gemm_core(const bf16_t* __restrict__ A, int lda, const bf16_t* __restrict__ B, int ldb, int K,
                                          f32x4 (&acc)[4][NJ], char* lds, int& par, bool primed,
                                          const bf16_t* nA, int nlda, const bf16_t* nB, int nldb) {
  const int tid = tidx(), lane = tid & 63, wm = (tid >> 6) >> 1, wn = (tid >> 6) & 1;
  const int wid = __builtin_amdgcn_readfirstlane(tid >> 6);
  const int fr = lane & 15, fq = lane >> 4;
  const int fa = (wm * 64 + fr) * 64 + ((fq ^ swz(fr)) << 4);
  const int fb = ABYTES + (wn * NJ * 16 + fr) * 64 + ((fq ^ swz(fr)) << 4);
  const int lrow = lane >> 2, lchunk = (lane & 3) ^ swz(lrow);
  constexpr int NBL = NJ / 2;
  const GAS char* gA = (const GAS char*)(A + (size_t)(wid * 32 + lrow) * lda + lchunk * 8);
  const GAS char* gB = (const GAS char*)(B + (size_t)(wid * NBL * 16 + lrow) * ldb + lchunk * 8);
  const size_t a16 = (size_t)16 * lda * 2, b16 = (size_t)16 * ldb * 2;
  LAS char* ldsA = (LAS char*)lds + wid * 2048;
  LAS char* ldsB = (LAS char*)lds + ABYTES + wid * NBL * 1024;
  const int nk = K >> 6;
#define GC_ISSUE(pa, pb, sa, sb, stage, kbyte) do { \
    _Pragma("unroll") for (int g = 0; g < 2; ++g) _Pragma("unroll") for (int pn = 0; pn < 2; ++pn) \
      __builtin_amdgcn_global_load_lds((const GAS unsigned*)((pa) + g * (sa) + (kbyte) + pn * 64), (LAS unsigned*)(ldsA + (stage) + pn * PANEL + g * 1024), 16, 0, 0); \
    _Pragma("unroll") for (int g = 0; g < NBL; ++g) _Pragma("unroll") for (int pn = 0; pn < 2; ++pn) \
      __builtin_amdgcn_global_load_lds((const GAS unsigned*)((pb) + g * (sb) + (kbyte) + pn * 64), (LAS unsigned*)(ldsB + (stage) + pn * PANEL + g * 1024), 16, 0, 0); \
  } while (0)
  if (!primed) {
    GC_ISSUE(gA, gB, a16, b16, par * STAGE, 0);
    asm volatile("s_waitcnt vmcnt(0)" ::: "memory");
    __syncthreads();
  }
  for (int kt = 0; kt < nk; ++kt) {
    char* cur = lds + par * STAGE;
    if (kt + 1 < nk) GC_ISSUE(gA, gB, a16, b16, (par ^ 1) * STAGE, (size_t)(kt + 1) * 128);
    else if (nA) {
      const GAS char* hA = (const GAS char*)(nA + (size_t)(wid * 32 + lrow) * nlda + lchunk * 8);
      const GAS char* hB = (const GAS char*)(nB + (size_t)(wid * NBL * 16 + lrow) * nldb + lchunk * 8);
      GC_ISSUE(hA, hB, (size_t)16 * nlda * 2, (size_t)16 * nldb * 2, (par ^ 1) * STAGE, 0);
    }
    __builtin_amdgcn_sched_barrier(0);
    if (PIPE == 2) {
      bf16x8 af[2][4], bfr[NJ];
#pragma unroll
      for (int i = 0; i < 4; ++i) af[0][i] = *(const bf16x8*)(cur + fa + i * 1024);
#pragma unroll
      for (int j = 0; j < NJ; ++j) bfr[j] = *(const bf16x8*)(cur + fb + j * 1024);
#pragma unroll
      for (int i = 0; i < 4; ++i) af[1][i] = *(const bf16x8*)(cur + PANEL + fa + i * 1024);
      __builtin_amdgcn_sched_barrier(0);
#pragma unroll
      for (int i = 0; i < 4; ++i)
#pragma unroll
        for (int j = 0; j < NJ; ++j) acc[i][j] = SWAP ? mfma16(bfr[j], af[0][i], acc[i][j]) : mfma16(af[0][i], bfr[j], acc[i][j]);
#pragma unroll
      for (int j = 0; j < NJ; ++j) bfr[j] = *(const bf16x8*)(cur + PANEL + fb + j * 1024);
#pragma unroll
      for (int i = 0; i < 4; ++i)
#pragma unroll
        for (int j = 0; j < NJ; ++j) acc[i][j] = SWAP ? mfma16(bfr[j], af[1][i], acc[i][j]) : mfma16(af[1][i], bfr[j], acc[i][j]);
    } else if (PIPE == 1) {
      bf16x8 af[2][4], bfr[2][NJ];
#pragma unroll
      for (int ks = 0; ks < 2; ++ks) {
#pragma unroll
        for (int i = 0; i < 4; ++i) af[ks][i] = *(const bf16x8*)(cur + ks * PANEL + fa + i * 1024);
#pragma unroll
        for (int j = 0; j < NJ; ++j) bfr[ks][j] = *(const bf16x8*)(cur + ks * PANEL + fb + j * 1024);
      }
      __builtin_amdgcn_sched_barrier(0);
#pragma unroll
      for (int ks = 0; ks < 2; ++ks)
#pragma unroll
        for (int i = 0; i < 4; ++i)
#pragma unroll
          for (int j = 0; j < NJ; ++j) acc[i][j] = SWAP ? mfma16(bfr[ks][j], af[ks][i], acc[i][j]) : mfma16(af[ks][i], bfr[ks][j], acc[i][j]);
    } else {
#pragma unroll
      for (int ks = 0; ks < 2; ++ks) {
        bf16x8 af[4], bfr[NJ];
#pragma unroll
        for (int i = 0; i < 4; ++i) af[i] = *(const bf16x8*)(cur + ks * PANEL + fa + i * 1024);
#pragma unroll
        for (int j = 0; j < NJ; ++j) bfr[j] = *(const bf16x8*)(cur + ks * PANEL + fb + j * 1024);
#pragma unroll
        for (int i = 0; i < 4; ++i)
#pragma unroll
          for (int j = 0; j < NJ; ++j) acc[i][j] = SWAP ? mfma16(bfr[j], af[i], acc[i][j]) : mfma16(af[i], bfr[j], acc[i][j]);
      }
    }
    __builtin_amdgcn_sched_barrier(0);
    asm volatile("s_waitcnt vmcnt(0)" ::: "memory");
    __syncthreads();
    par ^= 1;
  }
#undef GC_ISSUE
}
template <bool SWAP, int NJ = 4>
__device__ __forceinline__ void gemm_core(const bf16_t* __restrict__ A, int lda, const bf16_t* __restrict__ B, int ldb, int K,
                                          f32x4 (&acc)[4][NJ], char* lds) {
  int par = 0;
  gemm_core<SWAP, NJ>(A, lda, B, ldb, K, acc, lds, par, false, nullptr, 0, nullptr, 0);
}

__device__ __forceinline__ void tr_tile(const float* __restrict__ src, int lds_, int k0, int ns0, bf16_t* __restrict__ dst, int ldd, int nd0,
                                        const float* __restrict__ ksc, char* lds) {
  bf16_t* T = (bf16_t*)lds;
  const int tid = tidx();
  __syncthreads();
#pragma unroll
  for (int i = 0; i < 2; ++i) {
    const int kk = (tid >> 3) + 32 * i, nn4 = (tid & 7) * 4;
    const f32x4 v = *(const f32x4*)(src + (size_t)(k0 + kk) * lds_ + ns0 + nn4);
    const float s = ksc ? ksc[k0 + kk] : 1.f;
#pragma unroll
    for (int e = 0; e < 4; ++e) T[(nn4 + e) * 72 + kk] = tobf(v[e] * s);
  }
  __syncthreads();
  const int nn = tid >> 3, kc = (tid & 7) * 8;
  const u32x4 w = *(const u32x4*)(T + nn * 72 + kc);
  *(u32x4*)(dst + (size_t)(nd0 + nn) * ldd + k0 + kc) = w;
}

__device__ __forceinline__ void tr_tile2(const float* __restrict__ src, int lds_, int k0, int ns0, bf16_t* __restrict__ dst, int ldd, int nd0,
                                         const float* __restrict__ ksc, char* lds) {
  bf16_t* T = (bf16_t*)lds;
  const int tid = tidx();
  __syncthreads();
  f32x4 v[4];
#pragma unroll
  for (int i = 0; i < 4; ++i) v[i] = *(const GAS f32x4*)(src + (size_t)(k0 + (tid >> 3) + 32 * i) * lds_ + ns0 + (tid & 7) * 4);
#pragma unroll
  for (int i = 0; i < 4; ++i) {
    const int kk = (tid >> 3) + 32 * i, nn4 = (tid & 7) * 4;
    const float sc = ksc ? ksc[k0 + kk] : 1.f;
#pragma unroll
    for (int e = 0; e < 4; ++e) T[(nn4 + e) * 136 + kk] = tobf(v[i][e] * sc);
  }
  __syncthreads();
  const int nn = tid >> 3, kc = (tid & 7) * 16;
  const u32x4 w0 = *(const u32x4*)(T + nn * 136 + kc), w1 = *(const u32x4*)(T + nn * 136 + kc + 8);
  bf16_t* d = dst + (size_t)(nd0 + nn) * ldd + k0 + kc;
  *(u32x4*)d = w0; *(u32x4*)(d + 8) = w1;
}

constexpr int P0_GEMV = 192, P0_WIN = 3408, P0_WQ = 144, P0_WKV = 128, P0_WBR = 768, P0_WO = 512, P0_S0 = 256, P0_PAD = 96, P0_TAB = 1105;
constexpr int P0_N = P0_GEMV + P0_WIN + P0_WQ + P0_WKV + P0_WBR + P0_WO + P0_S0 + P0_PAD + P0_TAB;

__device__ __forceinline__ void phase0_item(const Params& p, int j, char* lds) {
  const int tid = tidx();
  char* ws = wsp(p.ws);
  if (j < P0_GEMV) {
    const int l = j / 96, cgi = j % 96;
    float* sv = (float*)lds;
    float* red = (float*)(lds + 20480);
    __syncthreads();
    for (int i = tid; i < 5120; i += 256) { const int v = i >> 10, k = i & 1023; const float x = (v == 0) ? p.c_ctx[k] : p.c[(v - 1) * 1024 + k]; sv[i] = silu_f(x); }
    __syncthreads();
    const int c4 = tid & 7, kg = tid >> 3;
    const float* w = p.w_mod + (size_t)l * 1024 * 3072 + cgi * 32 + c4 * 4;
    f32x4 a0 = {0.f, 0.f, 0.f, 0.f}, a1 = a0, a2 = a0, a3 = a0, a4 = a0;
#pragma unroll 8
    for (int k = kg * 32; k < kg * 32 + 32; ++k) {
      const f32x4 wv = *(const GAS f32x4*)(w + (size_t)k * 3072);
      a0 += wv * sv[k]; a1 += wv * sv[1024 + k]; a2 += wv * sv[2048 + k]; a3 += wv * sv[3072 + k]; a4 += wv * sv[4096 + k];
    }
    *(f32x4*)(red + (kg * 5 + 0) * 32 + c4 * 4) = a0; *(f32x4*)(red + (kg * 5 + 1) * 32 + c4 * 4) = a1; *(f32x4*)(red + (kg * 5 + 2) * 32 + c4 * 4) = a2;
    *(f32x4*)(red + (kg * 5 + 3) * 32 + c4 * 4) = a3; *(f32x4*)(red + (kg * 5 + 4) * 32 + c4 * 4) = a4;
    __syncthreads();
    if (tid < 160) {
      const int v = tid >> 5, c2 = tid & 31;
      float sm = p.b_mod[l * 3072 + cgi * 32 + c2];
#pragma unroll 8
      for (int g = 0; g < 32; ++g) sm += red[(g * 5 + v) * 32 + c2];
      ((float*)(ws + O_MOD))[(l * 5 + v) * 3072 + cgi * 32 + c2] = sm;
    }
    return;
  }
  j -= P0_GEMV;
  if (j < P0_WIN) {
    const int l = j / 1704, r = j % 1704, kt = r / 213, nt = r % 213, c0 = nt * 32;
    const int nd0 = c0 < 2176 ? c0 : (c0 < 2208 ? 3712 + (c0 - 2176) : (c0 < 3744 ? c0 - 32 : c0 + 96));
    tr_tile2(p.w_in + (size_t)l * 1024 * 6816, 6816, kt * 128, c0, (bf16_t*)(ws + O_WIN) + (size_t)l * 6912 * 1024, 1024, nd0, nullptr, lds);
    return;
  }
  j -= P0_WIN;
  if (j < P0_WQ) {
    const int l = j / 72, r = j % 72, kt = r / 24, nt = r % 24;
    tr_tile2(p.w_q_up + (size_t)l * 384 * 768, 768, kt * 128, nt * 32, (bf16_t*)(ws + O_WQ) + (size_t)l * 768 * 384, 384, nt * 32, p.q_norm_g + l * 384, lds);
    return;
  }
  j -= P0_WQ;
  if (j < P0_WKV) {
    const int l = j / 64, r = j % 64, kt = r / 32, nt = r % 32, c0 = nt * 32, h = c0 >> 7, e = c0 & 127;
    const int nd0 = e < 64 ? h * 64 + e : 512 + h * 64 + (e - 64);
    tr_tile2(p.w_kv_up + (size_t)l * 256 * 1024, 1024, kt * 128, c0, (bf16_t*)(ws + O_WKV) + (size_t)l * 1024 * 256, 256, nd0, nullptr, lds);
    return;
  }
  j -= P0_WKV;
  if (j < P0_WBR) {
    const int mat = j / 128, r = j % 128, kt = r / 32, nt = r % 32;
    tr_tile2(p.w_branch + (size_t)mat * 512 * 1024, 1024, kt * 128, nt * 32, (bf16_t*)(ws + O_WBR) + (size_t)mat * 1024 * 512, 512, nt * 32, nullptr, lds);
    return;
  }
  j -= P0_WBR;
  if (j < P0_WO) {
    const int l = j / 256, r = j % 256, kt = r / 32, nt = r % 32;
    tr_tile2(p.w_out + (size_t)l * 1024 * 1024, 1024, kt * 128, nt * 32, (bf16_t*)(ws + O_WO) + (size_t)l * 1024 * 1024, 1024, nt * 32, nullptr, lds);
    return;
  }
  j -= P0_WO;
  if (j < P0_S0) {
    const int mat = j >> 2, nt = j & 3;
    tr_tile(p.state_ret + (size_t)mat * 64 * 128, 128, 0, nt * 32, (bf16_t*)(ws + O_S0T) + (size_t)mat * 128 * 64, 64, nt * 32, nullptr, lds);
    return;
  }
  j -= P0_S0;
  if (j < P0_PAD) {
    const int l = j / 48, r = j % 48;
    bf16_t* d = (bf16_t*)(ws + O_WIN) + ((size_t)l * 6912 + 3744) * 1024 + (size_t)r * 2048 + tid * 8;
    *(u32x4*)d = (u32x4){0u, 0u, 0u, 0u};
    return;
  }
  j -= P0_PAD;
  {
    float v[8];
    bf16_t* dst;
    if (j == 1104) {
      float* rt = (float*)(ws + O_ROPE);
#pragma unroll
      for (int q = 0; q < 2; ++q) {
        const int idx = tid * 2 + q, pos = idx >> 3, f = idx & 7;
        const float ang = (float)pos * exp2f(-(float)f * 1.66096404744f);
        rt[idx * 2] = cosf(ang); rt[idx * 2 + 1] = sinf(ang);
      }
      return;
    }
    if (j < 16) {
      const int e0 = j * 2048 + tid * 8; dst = (bf16_t*)(ws + O_CS) + e0;
      const int n = e0 >> 7, k = e0 & 127;
#pragma unroll
      for (int e = 0; e < 8; ++e) {
        const float fr = (float)(((n & 127) * (k + e)) & 127) * (1.f / 128.f);
        v[e] = (n < 128) ? __builtin_amdgcn_cosf(fr) : __builtin_amdgcn_sinf(fr);
      }
    } else if (j < 80) {
      const int e0 = (j - 16) * 2048 + tid * 8; dst = (bf16_t*)(ws + O_D256) + e0;
      const int k1 = e0 >> 9, kk = e0 & 511;
#pragma unroll
      for (int e = 0; e < 8; ++e) {
        const int t = (kk + e) & 255;
        const float fr = (float)((k1 * t) & 255) * (1.f / 256.f);
        v[e] = (kk < 256) ? __builtin_amdgcn_cosf(fr) : -__builtin_amdgcn_sinf(fr);
      }
    } else {
      const int e0 = (j - 80) * 2048 + tid * 8; dst = (bf16_t*)(ws + O_D1024) + e0;
      const int k1 = e0 >> 11, kk = e0 & 2047;
#pragma unroll
      for (int e = 0; e < 8; ++e) {
        const int t = (kk + e) & 1023;
        const float fr = (float)((k1 * t) & 1023) * (1.f / 1024.f);
        v[e] = (kk < 1024) ? __builtin_amdgcn_cosf(fr) : -__builtin_amdgcn_sinf(fr);
      }
    }
    u32x4 w; w.x = pk2(v[0], v[1]); w.y = pk2(v[2], v[3]); w.z = pk2(v[4], v[5]); w.w = pk2(v[6], v[7]);
    *(u32x4*)dst = w;
  }
}

__device__ __forceinline__ void norm_item(const Params& p, int l, int item, const float* xp, const float* xs) {
  const int tid = tidx(), lane = tid & 63, wid = tid >> 6;
  bf16_t* H = (bf16_t*)(p.ws + O_H);
#pragma unroll 3
  for (int i = 0; i < 6; ++i) {
    const int row = item * 24 + wid * 6 + i;
    const float* src = row < NPR ? xp + (size_t)row * 1024 : xs + (size_t)(row - NPR) * 1024;
    const int v = row < NPR ? 0 : 1 + ((row - NPR) >> 10);
    const float* mod = (const float*)(p.ws + O_MOD) + (l * 5 + v) * 3072;
    f32x4 x[4]; float ss = 0.f;
#pragma unroll
    for (int q = 0; q < 4; ++q) { x[q] = *(const f32x4*)(src + (q * 64 + lane) * 4); ss += x[q][0] * x[q][0] + x[q][1] * x[q][1] + x[q][2] * x[q][2] + x[q][3] * x[q][3]; }
    ss = wave_sum(ss);
    const float rstd = rsqrtf(ss * (1.f / 1024.f) + EPSN);
#pragma unroll
    for (int q = 0; q < 4; ++q) {
      const int col = (q * 64 + lane) * 4;
      const f32x4 g = *(const f32x4*)(p.norm_g + l * 1024 + col), sc = *(const f32x4*)(mod + 1024 + col), sh = *(const f32x4*)(mod + col);
      f32x4 h;
#pragma unroll
      for (int e = 0; e < 4; ++e) h[e] = x[q][e] * rstd * g[e] * (1.f + sc[e]) + sh[e];
      *(u32x2*)(H + (size_t)row * 1024 + col) = pk4(h);
    }
  }
}
__device__ __forceinline__ void final_item(const Params& p, int item) {
  const int tid = tidx(), lane = tid & 63, wid = tid >> 6;
#pragma unroll 3
  for (int i = 0; i < 6; ++i) {
    const int row = item * 24 + wid * 6 + i;
    float* src = p.out + (size_t)row * 1024;
    f32x4 x[4]; float ss = 0.f;
#pragma unroll
    for (int q = 0; q < 4; ++q) { x[q] = *(const f32x4*)(src + (q * 64 + lane) * 4); ss += x[q][0] * x[q][0] + x[q][1] * x[q][1] + x[q][2] * x[q][2] + x[q][3] * x[q][3]; }
    ss = wave_sum(ss);
    const float rstd = rsqrtf(ss * (1.f / 1024.f) + EPSN);
#pragma unroll
    for (int q = 0; q < 4; ++q) {
      const int col = (q * 64 + lane) * 4;
      const f32x4 g = *(const f32x4*)(p.final_g + col);
      f32x4 y;
#pragma unroll
      for (int e = 0; e < 4; ++e) y[e] = x[q][e] * rstd * g[e];
      *(f32x4*)(src + col) = y;
    }
  }
}

__device__ __forceinline__ void s2_tile(const Params& p, int l, int tile, char* lds) {
  const int tid = tidx(), lane = tid & 63, wid = tid >> 6, wm = wid >> 1, wn = wid & 1, fr = lane & 15, fq = lane >> 4;
  const int m = (tile / 480) * 16 + (tile % 16), nt = (tile % 480) / 16, m0 = m * 128, n0 = nt * 128;
  char* ws = wsp(p.ws);
  const bf16_t* A = (const bf16_t*)(ws + O_H) + (size_t)m0 * 1024;
  const bf16_t* B = (const bf16_t*)(ws + O_WIN) + ((size_t)l * 6912 + n0) * 1024;
  f32x4 acc[4][4];
  zero_acc(acc);
  if (nt >= 4 && nt < 8) {
    gemm_core<false>(A, 1024, B, 1024, 1024, acc, lds);
    bf16_t* RVT = (bf16_t*)(ws + O_RVT);
#pragma unroll
    for (int i = 0; i < 4; ++i) {
      const int tok = m0 + wm * 64 + i * 16 + fq * 4;
      size_t base; int T, b, t;
      if (tok < NPR) { b = tok >> 8; t = tok & 255; T = 256; base = 0; } else { const int s = tok - NPR; b = s >> 10; t = s & 1023; T = 1024; base = (size_t)NPR * 512; }
#pragma unroll
      for (int j = 0; j < 4; ++j) {
        const int c = n0 - 512 + wn * 64 + j * 16 + fr, h = c >> 7, vd = c & 127;
        *(u32x2*)(RVT + base + ((size_t)(b * 4 + h) * 128 + vd) * T + t) = pk4(acc[i][j]);
      }
    }
    return;
  }
  gemm_core<true>(A, 1024, B, 1024, 1024, acc, lds);
  bf16_t* dst = nullptr; int ld = 0, c0 = 0, op = 0;
  if (nt < 2) { dst = (bf16_t*)(ws + O_RQ); ld = 256; c0 = 0; }
  else if (nt < 4) { dst = (bf16_t*)(ws + O_RK); ld = 256; c0 = 256; op = 2; }
  else if (nt < 12) { dst = (bf16_t*)(ws + O_RZ); ld = 512; c0 = 1024; op = 1; }
  else if (nt < 15) { dst = (bf16_t*)(ws + O_QLAT); ld = 384; c0 = 1536; }
  else if (nt < 17) { ld = 256; c0 = 1920; op = 3; }
  else if (nt < 21) { dst = (bf16_t*)(ws + O_MZ); ld = 512; c0 = 2176; op = 1; }
  else if (nt < 25) { dst = (bf16_t*)(ws + O_FU); ld = 512; c0 = 2688; }
  else if (nt < 29) { dst = (bf16_t*)(ws + O_FZ); ld = 512; c0 = 3200; op = 1; }
  else { ld = 32; c0 = 3712; op = 4; }
#pragma unroll
  for (int i = 0; i < 4; ++i) {
    const int tok = m0 + wm * 64 + i * 16 + fr;
#pragma unroll
    for (int j = 0; j < 4; ++j) {
      const int col = n0 - c0 + wn * 64 + j * 16 + fq * 4;
      f32x4 v = acc[i][j];
      if (op == 3) { *(f32x4*)((float*)(ws + O_KVLAT) + (size_t)tok * 256 + col) = v; continue; }
      if (op == 4) { if (col < 32) *(f32x4*)((float*)(ws + O_KR) + (size_t)tok * 32 + col) = v; continue; }
      if (op == 1) {
#pragma unroll
        for (int e = 0; e < 4; ++e) v[e] = silu_f(v[e]);
      } else if (op == 2) {
#pragma unroll
        for (int e = 0; e < 4; ++e) v[e] *= 0.125f;
      }
      const u32x2 w = pk4(v);
      *(u32x2*)(dst + (size_t)tok * ld + col) = w;
      if (op == 2 && tok < NPR) {
        bf16_t* RKT = (bf16_t*)(ws + O_RKT);
        const int b = tok >> 8, t = tok & 255, h = col >> 6, dk = col & 63;
        bf16_t* q = RKT + ((size_t)(b * 4 + h) * 64 + dk) * 256 + t;
        q[0] = (bf16_t)(w.x & 0xffffu); q[256] = (bf16_t)(w.x >> 16); q[512] = (bf16_t)(w.y & 0xffffu); q[768] = (bf16_t)(w.y >> 16);
      }
    }
  }
}

template <int MODE>
__device__ __forceinline__ void attn_item(const Params& p, int l, int item, char* lds) {
  constexpr int NKP = MODE == 0 ? 3 : 2;
  constexpr int NVB = MODE == 0 ? 4 : 8;
  constexpr int PV = NVB * 16 * 64;
  constexpr int KOFF = NKP * 4096;
  constexpr int BUF = KOFF + 2 * PV;
  const int tid = tidx(), lane = tid & 63, wid = tid >> 6, fr = lane & 15, fq = lane >> 4;
  char* ws = wsp(p.ws);
  int smp, b, h, qblk, T, Tk, tok0;
  const bf16_t *kbase, *rbase = nullptr, *vbase, *qbase;
  int kstride, qstride;
  if (MODE == 0) {
    if (item < 256) { smp = 1; b = item >> 6; h = (item >> 3) & 7; qblk = item & 7; T = 1024; Tk = 1536; tok0 = NPR + b * 1024 + qblk * 128; }
    else { const int it = item - 256; smp = 0; b = it >> 4; h = (it >> 1) & 7; qblk = it & 1; T = 256; Tk = 256; tok0 = b * 256 + qblk * 128; }
    const int keyrow0 = smp ? NPR + b * 1536 : b * 256;
    kbase = (const bf16_t*)(ws + O_KB) + (size_t)keyrow0 * 512 + h * 64; kstride = 512;
    rbase = (const bf16_t*)(ws + O_KRA) + (size_t)keyrow0 * 32;
    vbase = (const bf16_t*)(ws + O_VT) + (smp ? (size_t)NPR * 512 + (size_t)(b * 8 + h) * 64 * 1536 : (size_t)(b * 8 + h) * 64 * 256);
    qbase = (const bf16_t*)(ws + O_QB) + (size_t)tok0 * 768 + h * 96; qstride = 768;
  } else {
    if (item < 128) { smp = 1; b = item >> 5; h = (item >> 3) & 3; qblk = item & 7; T = 1024; tok0 = NPR + b * 1024 + qblk * 128; }
    else { const int it = item - 128; smp = 0; b = it >> 3; h = (it >> 1) & 3; qblk = it & 1; T = 256; tok0 = b * 256 + qblk * 128; }
    Tk = T;
    const int ktok0 = smp ? NPR + b * 1024 : b * 256;
    kbase = (const bf16_t*)(ws + O_RK) + (size_t)ktok0 * 256 + h * 64; kstride = 256;
    vbase = (const bf16_t*)(ws + O_RVT) + (smp ? (size_t)NPR * 512 + (size_t)(b * 4 + h) * 128 * 1024 : (size_t)(b * 4 + h) * 128 * 256);
    qbase = (const bf16_t*)(ws + O_RQ) + (size_t)tok0 * 256 + h * 64; qstride = 256;
  }
  const int nkt = Tk >> 6;
  bf16x8 qf[2][NKP];
#pragma unroll
  for (int qb = 0; qb < 2; ++qb)
#pragma unroll
    for (int ks = 0; ks < NKP; ++ks) qf[qb][ks] = *(const bf16x8*)(qbase + (size_t)(wid * 32 + qb * 16 + fr) * qstride + ks * 32 + fq * 8);
  f32x4 o[NVB][2];
#pragma unroll
  for (int vb = 0; vb < NVB; ++vb) { o[vb][0] = (f32x4){0.f, 0.f, 0.f, 0.f}; o[vb][1] = (f32x4){0.f, 0.f, 0.f, 0.f}; }
  float lgf = 0.f, lgb = 0.f;
  float mrow[2] = {-INFINITY, -INFINITY}, lrow[2] = {0.f, 0.f};
  const int tq0 = qblk * 128 + wid * 32 + fr;
  if (MODE == 1) {
    const float xf = p.ret_logit[(l * 2 + 0) * 4 + h], xb = p.ret_logit[(l * 2 + 1) * 4 + h];
    lgf = -log1pf(expf(-xf)) * 1.44269504089f; lgb = -log1pf(expf(-xb)) * 1.44269504089f;
    if (smp) {
      const bf16_t* s0 = (const bf16_t*)(ws + O_S0T);
#pragma unroll
      for (int dir = 0; dir < 2; ++dir) {
        const bf16_t* sb = s0 + ((size_t)(((b * 2 + l) * 2 + dir) * 4 + h) * 128) * 64;
        float dec[2];
#pragma unroll
        for (int qb = 0; qb < 2; ++qb) { const int tq = tq0 + qb * 16; dec[qb] = dir == 0 ? ex2((float)(tq + 1) * lgf) : ex2((float)(T - tq) * lgb); }
#pragma unroll
        for (int vb = 0; vb < NVB; ++vb) {
          f32x4 t0 = (f32x4){0.f, 0.f, 0.f, 0.f}, t1 = (f32x4){0.f, 0.f, 0.f, 0.f};
#pragma unroll
          for (int ks = 0; ks < 2; ++ks) {
            const bf16x8 sf = *(const bf16x8*)(sb + (size_t)(vb * 16 + fr) * 64 + ks * 32 + fq * 8);
            t0 = mfma16(sf, qf[0][ks], t0); t1 = mfma16(sf, qf[1][ks], t1);
          }
          o[vb][0] += t0 * dec[0]; o[vb][1] += t1 * dec[1];
        }
      }
    }
  }
  u32x4 vreg[NVB / 2];
  const int uw = __builtin_amdgcn_readfirstlane(wid);
  const int dkey = lane >> 2, dchunk = (lane & 3) ^ swz(dkey);
  auto kdma = [&](int kt, char* buf) {
    const GAS bf16_t* kp = (const GAS bf16_t*)kbase + (size_t)(kt * 64 + uw * 16 + dkey) * kstride + dchunk * 8;
#pragma unroll
    for (int pn = 0; pn < 2; ++pn)
      __builtin_amdgcn_global_load_lds((const GAS unsigned*)(kp + pn * 32), (LAS unsigned*)((LAS char*)buf + pn * 4096 + uw * 1024), 16, 0, 0);
    if (MODE == 0) {
      const GAS bf16_t* rp = (const GAS bf16_t*)rbase + (size_t)(kt * 64 + uw * 16 + dkey) * 32 + dchunk * 8;
      __builtin_amdgcn_global_load_lds((const GAS unsigned*)rp, (LAS unsigned*)((LAS char*)buf + 2 * 4096 + uw * 1024), 16, 0, 0);
    }
  };
  auto gload = [&](int kt) {
#pragma unroll
    for (int i = 0; i < NVB / 2; ++i) { const int idx = tid + 256 * i, vd = idx >> 3, g = idx & 7; vreg[i] = ldg16(vbase + (size_t)vd * Tk + kt * 64 + g * 8); }
  };
  auto lstore = [&](char* buf) {
#pragma unroll
    for (int i = 0; i < NVB / 2; ++i) {
      const int idx = tid + 256 * i, vd = idx >> 3, g = idx & 7, pnl = g >> 2, g4 = g & 3, hi = g4 >> 1, q0 = 2 * (g4 & 1);
      char* base = buf + KOFF + pnl * PV + vd * 64 + hi * 8;
      *(u32x2*)(base + ((q0 ^ swz(vd)) << 4)) = (u32x2){vreg[i].x, vreg[i].y};
      *(u32x2*)(base + (((q0 + 1) ^ swz(vd)) << 4)) = (u32x2){vreg[i].z, vreg[i].w};
    }
  };
  __syncthreads();
  kdma(0, lds); gload(0); lstore(lds);
  asm volatile("s_waitcnt vmcnt(0)" ::: "memory");
  __syncthreads();
  const int foff = fr * 64 + ((fq ^ swz(fr)) << 4);
  for (int kt = 0; kt < nkt; ++kt) {
    char* cur = lds + (kt & 1) * BUF;
    const bool more = (kt + 1) < nkt;
    if (more) { kdma(kt + 1, lds + ((kt + 1) & 1) * BUF); gload(kt + 1); }
    __builtin_amdgcn_sched_barrier(0);
    f32x4 s[4][2];
#pragma unroll
    for (int kb = 0; kb < 4; ++kb) {
      s[kb][0] = (f32x4){0.f, 0.f, 0.f, 0.f}; s[kb][1] = (f32x4){0.f, 0.f, 0.f, 0.f};
#pragma unroll
      for (int ks = 0; ks < NKP; ++ks) {
        const bf16x8 kf = *(const bf16x8*)(cur + ks * 4096 + kb * 1024 + foff);
        s[kb][0] = mfma16(kf, qf[0][ks], s[kb][0]); s[kb][1] = mfma16(kf, qf[1][ks], s[kb][1]);
      }
    }
    bf16x8 pf[2][2];
#pragma unroll
    for (int qb = 0; qb < 2; ++qb) {
      if (MODE == 0) {
        float mx = s[0][qb][0];
#pragma unroll
        for (int kb = 0; kb < 4; ++kb)
#pragma unroll
          for (int r = 0; r < 4; ++r) mx = fmaxf(mx, s[kb][qb][r]);
        mx = fmaxf(mx, __shfl_xor(mx, 16)); mx = fmaxf(mx, __shfl_xor(mx, 32));
        const float mn = fmaxf(mrow[qb], mx), alpha = ex2(mrow[qb] - mn);
        mrow[qb] = mn;
        float ls = 0.f;
#pragma unroll
        for (int kb = 0; kb < 4; ++kb)
#pragma unroll
          for (int r = 0; r < 4; ++r) { const float e = ex2(s[kb][qb][r] - mn); s[kb][qb][r] = e; ls += e; }
        lrow[qb] = lrow[qb] * alpha + ls;
#pragma unroll
        for (int vb = 0; vb < NVB; ++vb) o[vb][qb] *= alpha;
      } else {
        const int tq = tq0 + qb * 16;
#pragma unroll
        for (int kb = 0; kb < 4; ++kb)
#pragma unroll
          for (int r = 0; r < 4; ++r) {
            const int d = tq - (kt * 64 + kb * 16 + fq * 4 + r);
            const float dec = d > 0 ? ex2((float)d * lgf) : (d < 0 ? ex2((float)(-d) * lgb) : 2.f);
            s[kb][qb][r] *= dec;
          }
      }
#pragma unroll
      for (int g = 0; g < 2; ++g) {
        u32x4 w; w.x = pk2(s[2 * g][qb][0], s[2 * g][qb][1]); w.y = pk2(s[2 * g][qb][2], s[2 * g][qb][3]);
        w.z = pk2(s[2 * g + 1][qb][0], s[2 * g + 1][qb][1]); w.w = pk2(s[2 * g + 1][qb][2], s[2 * g + 1][qb][3]);
        pf[qb][g] = as_bf8(w);
      }
    }
#pragma unroll
    for (int vb = 0; vb < NVB; ++vb)
#pragma unroll
      for (int g = 0; g < 2; ++g) {
        const bf16x8 vf = *(const bf16x8*)(cur + KOFF + g * PV + vb * 1024 + foff);
        o[vb][0] = mfma16(vf, pf[0][g], o[vb][0]); o[vb][1] = mfma16(vf, pf[1][g], o[vb][1]);
      }
    __builtin_amdgcn_sched_barrier(0);
    if (more) lstore(lds + ((kt + 1) & 1) * BUF);
    asm volatile("s_waitcnt vmcnt(0)" ::: "memory");
    __syncthreads();
  }
  bf16_t* G = (bf16_t*)(ws + (MODE == 0 ? O_MZ : O_RZ));
#pragma unroll
  for (int qb = 0; qb < 2; ++qb) {
    const int tok = tok0 + wid * 32 + qb * 16 + fr;
    float mul, sub;
    if (MODE == 0) {
      float lt = lrow[qb]; lt += __shfl_xor(lt, 16); lt += __shfl_xor(lt, 32);
      mul = 1.f / lt; sub = 0.f;
    } else {
      float sm = 0.f;
#pragma unroll
      for (int vb = 0; vb < NVB; ++vb) sm += (o[vb][qb][0] + o[vb][qb][1]) + (o[vb][qb][2] + o[vb][qb][3]);
      sm += __shfl_xor(sm, 16); sm += __shfl_xor(sm, 32);
      const float mu = sm * (1.f / 128.f);
      float vs = 0.f;
#pragma unroll
      for (int vb = 0; vb < NVB; ++vb)
#pragma unroll
        for (int r = 0; r < 4; ++r) { const float dd = o[vb][qb][r] - mu; vs += dd * dd; }
      vs += __shfl_xor(vs, 16); vs += __shfl_xor(vs, 32);
      mul = rsqrtf(vs * (1.f / 128.f) + EPSN); sub = mu;
    }
#pragma unroll
    for (int vb = 0; vb < NVB; ++vb) {
      bf16_t* gp = G + (size_t)tok * 512 + h * (NVB * 16) + vb * 16 + fq * 4;
      const u32x2 gz = *(const u32x2*)gp;
      f32x4 y;
      y[0] = (o[vb][qb][0] - sub) * mul * bflo(gz.x); y[1] = (o[vb][qb][1] - sub) * mul * bfhi(gz.x);
      y[2] = (o[vb][qb][2] - sub) * mul * bflo(gz.y); y[3] = (o[vb][qb][3] - sub) * mul * bfhi(gz.y);
      *(u32x2*)gp = pk4(y);
    }
  }
}

__device__ __forceinline__ bf16x8 scale8(u32x4 raw, const float (&d)[8]) {
  u32x4 w;
  w.x = pk2(bflo(raw.x) * d[0], bfhi(raw.x) * d[1]); w.y = pk2(bflo(raw.y) * d[2], bfhi(raw.y) * d[3]);
  w.z = pk2(bflo(raw.z) * d[4], bfhi(raw.z) * d[5]); w.w = pk2(bflo(raw.w) * d[6], bfhi(raw.w) * d[7]);
  return as_bf8(w);
}
__device__ __forceinline__ void state_item(const Params& p, int l, int item) {
  const int tid = tidx(), lane = tid & 63, wid = tid >> 6, fr = lane & 15, fq = lane >> 4;
  const int b = item >> 2, h = item & 3;
  const bf16_t* RVT = (const bf16_t*)(p.ws + O_RVT) + (size_t)(b * 4 + h) * 128 * 256;
  const bf16_t* RKT = (const bf16_t*)(p.ws + O_RKT) + (size_t)(b * 4 + h) * 64 * 256;
  const float xf = p.ret_logit[(l * 2 + 0) * 4 + h], xb = p.ret_logit[(l * 2 + 1) * 4 + h];
  const float lgf = -log1pf(expf(-xf)) * 1.44269504089f, lgb = -log1pf(expf(-xb)) * 1.44269504089f;
  f32x4 acc[2][2][4];
#pragma unroll
  for (int d = 0; d < 2; ++d)
#pragma unroll
    for (int v = 0; v < 2; ++v)
#pragma unroll
      for (int k = 0; k < 4; ++k) acc[d][v][k] = (f32x4){0.f, 0.f, 0.f, 0.f};
#pragma unroll 2
  for (int ks = 0; ks < 8; ++ks) {
    const int j0 = ks * 32 + fq * 8;
    float df[8], db[8];
#pragma unroll
    for (int e = 0; e < 8; ++e) { df[e] = exp2f((float)(255 - j0 - e) * lgf); db[e] = exp2f((float)(j0 + e) * lgb); }
    bf16x8 af[2];
#pragma unroll
    for (int v = 0; v < 2; ++v) af[v] = *(const bf16x8*)(RVT + (size_t)((wid * 2 + v) * 16 + fr) * 256 + j0);
#pragma unroll
    for (int k = 0; k < 4; ++k) {
      const u32x4 raw = *(const u32x4*)(RKT + (size_t)(k * 16 + fr) * 256 + j0);
      const bf16x8 kf = scale8(raw, df), kb = scale8(raw, db);
#pragma unroll
      for (int v = 0; v < 2; ++v) { acc[0][v][k] = mfma16(af[v], kf, acc[0][v][k]); acc[1][v][k] = mfma16(af[v], kb, acc[1][v][k]); }
    }
  }
  float* O = p.out + OUT_RET;
#pragma unroll
  for (int d = 0; d < 2; ++d)
#pragma unroll
    for (int v = 0; v < 2; ++v)
#pragma unroll
      for (int k = 0; k < 4; ++k) {
        const int dk = k * 16 + fr, vd = (wid * 2 + v) * 16 + fq * 4;
        *(f32x4*)(O + ((size_t)((((b * 2 + l) * 2 + d) * 4 + h) * 64 + dk)) * 128 + vd) = acc[d][v][k];
      }
}

__device__ __forceinline__ void keyprep_item(const Params& p, int l, int item) {
  const int tid = tidx(), lane = tid & 63, wid = tid >> 6;
  char* ws = wsp(p.ws);
  bf16_t* CKVA = (bf16_t*)(ws + O_CKVA);
  bf16_t* KRA = (bf16_t*)(ws + O_KRA);
#pragma unroll
  for (int i = 0; i < 4; ++i) {
    const int R = item * 16 + wid * 4 + i;
    int smp = 0, b, t = 0, tok = 0, ctx = 0, pp = 0;
    if (R < NPR) { tok = R; b = R >> 8; t = R & 255; }
    else { smp = 1; const int s = R - NPR; b = s / 1536; pp = s - b * 1536; if (pp < 512) ctx = 1; else { t = pp - 512; tok = NPR + b * 1024 + t; } }
    if (ctx) {
      const f32x4 v = *(const f32x4*)(p.cache_ckv + ((size_t)((b * 2 + l) * 512 + pp)) * 256 + lane * 4);
      *(u32x2*)(CKVA + (size_t)R * 256 + lane * 4) = pk4(v);
      if (lane < 32) KRA[(size_t)R * 32 + lane] = tobf(p.cache_krope[((size_t)((b * 2 + l) * 512 + pp)) * 32 + lane]);
      continue;
    }
    const f32x4 v = *(const f32x4*)((const float*)(ws + O_KVLAT) + (size_t)tok * 256 + lane * 4);
    float ss = v[0] * v[0] + v[1] * v[1] + v[2] * v[2] + v[3] * v[3];
    ss = wave_sum(ss);
    const float rstd = rsqrtf(ss * (1.f / 256.f) + EPSN);
    const f32x4 g = *(const f32x4*)(p.kv_norm_g + l * 256 + lane * 4);
    f32x4 y;
#pragma unroll
    for (int e = 0; e < 4; ++e) y[e] = v[e] * rstd * g[e];
    *(u32x2*)(CKVA + (size_t)R * 256 + lane * 4) = pk4(y);
    if (!smp) *(f32x4*)(p.out + OUT_CKV + ((size_t)((b * 2 + l) * 256 + t)) * 256 + lane * 4) = y;
    const int d = lane & 31;
    const float x = ((const float*)(ws + O_KR))[(size_t)tok * 32 + d];
    float yk = x;
    if (smp) {
      const float pr = __shfl_xor(x, 8);
      const int hd = d >> 4, i16 = d & 15, f = i16 & 7;
      const int pos = hd ? (t & 63) : (t >> 6);
      const float* rt = (const float*)(ws + O_ROPE) + (pos * 8 + f) * 2;
      const float cs = rt[0], sn = rt[1];
      yk = i16 < 8 ? x * cs - pr * sn : pr * sn + x * cs;
    } else if (lane < 32) {
      p.out[OUT_KR + ((size_t)((b * 2 + l) * 256 + t)) * 32 + d] = x;
    }
    if (lane < 32) KRA[(size_t)R * 32 + d] = tobf(yk);
  }
}

__device__ __forceinline__ void f1_tile(const Params& p, int tile, char* lds) {
  const int tid = tidx(), lane = tid & 63, wid = tid >> 6, wm = wid >> 1, wn = wid & 1, fr = lane & 15, fq = lane >> 4;
  const int m = tile >> 3, g = (tile >> 1) & 3, nh = tile & 1, m0 = m * 128;
  char* ws = wsp(p.ws);
  f32x4 acc[4][4];
  zero_acc(acc);
  gemm_core<false>((const bf16_t*)(ws + O_FU) + (size_t)m0 * 512 + g * 128, 512, (const bf16_t*)(ws + O_CS) + (size_t)nh * 128 * 128, 128, 128, acc, lds);
  bf16_t* UT = (bf16_t*)(ws + O_UT);
#pragma unroll
  for (int i = 0; i < 4; ++i) {
    const int tok = m0 + wm * 64 + i * 16 + fq * 4;
    size_t base; int T, b, t;
    if (tok < NPR) { b = tok >> 8; t = tok & 255; T = 256; base = 0; } else { const int s = tok - NPR; b = s >> 10; t = s & 1023; T = 1024; base = (size_t)NPR * 1024; }
#pragma unroll
    for (int j = 0; j < 4; ++j) {
      const int k2 = wn * 64 + j * 16 + fr;
      *(u32x2*)(UT + base + ((size_t)(b * 4 + g) * 128 + k2) * (2 * T) + nh * T + t) = pk4(acc[i][j]);
    }
  }
}

__device__ __forceinline__ void qup_tile(const Params& p, int l, int tile, char* lds) {
  const int tid = tidx(), lane = tid & 63, wid = tid >> 6, wm = wid >> 1, wn = wid & 1, fr = lane & 15, fq = lane >> 4;
  const int m = tile % 96, nt = tile / 96, m0 = m * 128, n0 = nt * 128;
  char* ws = wsp(p.ws);
  const bf16_t* QL = (const bf16_t*)(ws + O_QLAT) + (size_t)m0 * 384;
  float rsv4[4];
  {
    float* rs = (float*)lds;
    __syncthreads();
#pragma unroll 1
    for (int r0 = 0; r0 < 32; r0 += 4) {
      float ss[4];
#pragma unroll
      for (int u = 0; u < 4; ++u) {
        u32x4 w = (u32x4){0u, 0u, 0u, 0u};
        if (lane < 48) w = ldg16(QL + (size_t)(wid * 32 + r0 + u) * 384 + lane * 8);
        ss[u] = bflo(w.x) * bflo(w.x) + bfhi(w.x) * bfhi(w.x) + bflo(w.y) * bflo(w.y) + bfhi(w.y) * bfhi(w.y) + bflo(w.z) * bflo(w.z) + bfhi(w.z) * bfhi(w.z) + bflo(w.w) * bflo(w.w) + bfhi(w.w) * bfhi(w.w);
      }
#pragma unroll
      for (int u = 0; u < 4; ++u) { const float t = wave_sum(ss[u]); if (lane == 0) rs[wid * 32 + r0 + u] = rsqrtf(t * (1.f / 384.f) + EPSN); }
    }
    __syncthreads();
#pragma unroll
    for (int i = 0; i < 4; ++i) rsv4[i] = rs[wm * 64 + i * 16 + fr];
    __syncthreads();
  }
  f32x4 acc[4][4];
  zero_acc(acc);
  gemm_core<true>(QL, 384, (const bf16_t*)(ws + O_WQ) + ((size_t)l * 768 + n0) * 384, 384, 384, acc, lds);
  bf16_t* QB = (bf16_t*)(ws + O_QB);
  const float qscale = 0.10206207261596577f * 1.44269504089f;
#pragma unroll
  for (int i = 0; i < 4; ++i) {
    const int rl = wm * 64 + i * 16 + fr, tok = m0 + rl;
    const float sc = rsv4[i] * qscale;
    const int smp = tok >= NPR, t = (tok - NPR) & 1023;
#pragma unroll
    for (int j = 0; j < 4; ++j) {
      const int cb = n0 + wn * 64 + j * 16, within = cb % 96;
      f32x4 v = acc[i][j] * sc;
      if (within >= 64) {
        f32x4 pr;
#pragma unroll
        for (int e = 0; e < 4; ++e) pr[e] = __shfl_xor(v[e], 32);
        if (smp) {
          const int pos = within >= 80 ? (t & 63) : (t >> 6);
          const float* rt = (const float*)(ws + O_ROPE) + (pos * 8 + (fq & 1) * 4) * 2;
          const f32x4 c01 = *(const f32x4*)rt, c23 = *(const f32x4*)(rt + 4);
          const float cs4[4] = {c01[0], c01[2], c23[0], c23[2]}, sn4[4] = {c01[1], c01[3], c23[1], c23[3]};
#pragma unroll
          for (int e = 0; e < 4; ++e) v[e] = fq < 2 ? v[e] * cs4[e] - pr[e] * sn4[e] : pr[e] * sn4[e] + v[e] * cs4[e];
        }
      }
      *(u32x2*)(QB + (size_t)tok * 768 + cb + fq * 4) = pk4(v);
    }
  }
}

__device__ __forceinline__ void kvup_tile(const Params& p, int l, int tile, char* lds) {
  const int tid = tidx(), lane = tid & 63, wid = tid >> 6, wm = wid >> 1, wn = wid & 1, fr = lane & 15, fq = lane >> 4;
  const int m = tile % 112, nt = tile / 112, m0 = m * 128, n0 = nt * 128;
  char* ws = wsp(p.ws);
  const bf16_t* A = (const bf16_t*)(ws + O_CKVA) + (size_t)m0 * 256;
  const bf16_t* B = (const bf16_t*)(ws + O_WKV) + ((size_t)l * 1024 + n0) * 256;
  f32x4 acc[4][4];
  zero_acc(acc);
  if (nt < 4) {
    gemm_core<true>(A, 256, B, 256, 256, acc, lds);
    bf16_t* KB = (bf16_t*)(ws + O_KB);
#pragma unroll
    for (int i = 0; i < 4; ++i) {
      const int R = m0 + wm * 64 + i * 16 + fr;
#pragma unroll
      for (int j = 0; j < 4; ++j) *(u32x2*)(KB + (size_t)R * 512 + n0 + wn * 64 + j * 16 + fq * 4) = pk4(acc[i][j]);
    }
  } else {
    gemm_core<false>(A, 256, B, 256, 256, acc, lds);
    bf16_t* VT = (bf16_t*)(ws + O_VT);
#pragma unroll
    for (int i = 0; i < 4; ++i) {
      const int R = m0 + wm * 64 + i * 16 + fq * 4;
      size_t base; int Tk, b, k;
      if (R < NPR) { b = R >> 8; k = R & 255; Tk = 256; base = 0; } else { const int s = R - NPR; b = s / 1536; k = s - b * 1536; Tk = 1536; base = (size_t)NPR * 512; }
#pragma unroll
      for (int j = 0; j < 4; ++j) {
        const int c = n0 - 512 + wn * 64 + j * 16 + fr, h = c >> 6, vd = c & 63;
        *(u32x2*)(VT + base + ((size_t)(b * 8 + h) * 64 + vd) * Tk + k) = pk4(acc[i][j]);
      }
    }
  }
}

template <int NJ>
__device__ __forceinline__ void f2_tile(const Params& p, int tile, char* lds) {
  const int tid = tidx(), lane = tid & 63, wid = tid >> 6, wm = wid >> 1, wn = wid & 1, fr = lane & 15, fq = lane >> 4;
  char* ws = wsp(p.ws);
  const bf16_t *A, *B; int K, tokb, g, nh = 0; float scale;
  if (NJ == 2) {
    const int b = tile >> 6, mt = (tile >> 1) & 7; g = (tile >> 4) & 3; nh = tile & 1;
    A = (const bf16_t*)(ws + O_D1024) + (size_t)mt * 128 * 2048; K = 2048;
    B = (const bf16_t*)(ws + O_UT) + (size_t)NPR * 1024 + ((size_t)(b * 4 + g) * 128 + nh * 64) * 2048;
    tokb = NPR + b * 1024 + mt * 128; scale = 0.00276213586400995f;
  } else {
    const int b = tile >> 3, mt = tile & 1; g = (tile >> 1) & 3;
    A = (const bf16_t*)(ws + O_D256) + (size_t)mt * 128 * 512; K = 512;
    B = (const bf16_t*)(ws + O_UT) + (size_t)(b * 4 + g) * 128 * 512;
    tokb = b * 256 + mt * 128; scale = 0.0055242717280199f;
  }
  f32x4 acc[4][NJ];
#pragma unroll
  for (int i = 0; i < 4; ++i)
#pragma unroll
    for (int j = 0; j < NJ; ++j) acc[i][j] = (f32x4){0.f, 0.f, 0.f, 0.f};
  gemm_core<true, NJ>(A, K, B, K, K, acc, lds);
  bf16_t* FZ = (bf16_t*)(ws + O_FZ);
#pragma unroll
  for (int i = 0; i < 4; ++i) {
    const int tok = tokb + wm * 64 + i * 16 + fr;
#pragma unroll
    for (int j = 0; j < NJ; ++j) {
      bf16_t* gp = FZ + (size_t)tok * 512 + g * 128 + nh * 64 + wn * (NJ * 16) + j * 16 + fq * 4;
      const u32x2 gz = *(const u32x2*)gp;
      f32x4 y;
      y[0] = acc[i][j][0] * scale * bflo(gz.x); y[1] = acc[i][j][1] * scale * bfhi(gz.x);
      y[2] = acc[i][j][2] * scale * bflo(gz.y); y[3] = acc[i][j][3] * scale * bfhi(gz.y);
      *(u32x2*)gp = pk4(y);
    }
  }
}

template <int NJ>
__device__ __forceinline__ void s6_tile(const Params& p, int l, int tile, int ntile, char* lds, int& par, bool& primed) {
  const int tid = tidx(), lane = tid & 63, wid = tid >> 6, wm = wid >> 1, wn = wid & 1, fr = lane & 15, fq = lane >> 4;
  constexpr int NT = 32 / NJ, BN = NJ * 32;
  const int m = (tile / (32 * NT)) * 32 + (tile % 32), nt = (tile % (32 * NT)) / 32, m0 = m * 128, n0 = nt * BN;
  char* ws = wsp(p.ws);
  const bf16_t* Hh = (const bf16_t*)(ws + O_H);
  const bf16_t* Wg = (const bf16_t*)(ws + O_WIN) + ((size_t)l * 6912 + 3840) * 1024;
  const bf16_t* Wb = (const bf16_t*)(ws + O_WBR) + (size_t)(l * 3) * 1024 * 512;
  f32x4 tot[4][NJ], acc[4][NJ];
  u32x2 sg[4][NJ];
#pragma unroll
  for (int i = 0; i < 4; ++i)
#pragma unroll
    for (int j = 0; j < NJ; ++j) tot[i][j] = (f32x4){0.f, 0.f, 0.f, 0.f};
#pragma unroll 1
  for (int nb = 0; nb < 3; ++nb) {
#pragma unroll
    for (int i = 0; i < 4; ++i)
#pragma unroll
      for (int j = 0; j < NJ; ++j) acc[i][j] = (f32x4){0.f, 0.f, 0.f, 0.f};
    const size_t boff = nb == 0 ? O_RZ : (nb == 1 ? O_MZ : O_FZ);
    const bf16_t* brA = (const bf16_t*)(ws + boff) + (size_t)m0 * 512;
    const bf16_t* brB = Wb + ((size_t)nb * 1024 + n0) * 512;
    gemm_core<true, NJ, 2>(Hh + (size_t)m0 * 1024, 1024, Wg + ((size_t)nb * 1024 + n0) * 1024, 1024, 1024, acc, lds, par, primed, brA, 512, brB, 512);
#pragma unroll
    for (int i = 0; i < 4; ++i)
#pragma unroll
      for (int j = 0; j < NJ; ++j) { f32x4 sv;
#pragma unroll
        for (int e = 0; e < 4; ++e) sv[e] = fmaxf(sigm_f(acc[i][j][e]), 1e-6f);
        sg[i][j] = pk4(sv);
        tot[i][j][0] *= __builtin_amdgcn_rcpf(bflo(sg[i][j].x)); tot[i][j][1] *= __builtin_amdgcn_rcpf(bfhi(sg[i][j].x));
        tot[i][j][2] *= __builtin_amdgcn_rcpf(bflo(sg[i][j].y)); tot[i][j][3] *= __builtin_amdgcn_rcpf(bfhi(sg[i][j].y)); }
    const bf16_t *nA = nullptr, *nB = nullptr;
    if (nb < 2) { nA = Hh + (size_t)m0 * 1024; nB = Wg + ((size_t)(nb + 1) * 1024 + n0) * 1024; }
    else if (ntile >= 0) { nA = Hh + (size_t)(((ntile / (32 * NT)) * 32 + (ntile % 32)) * 128) * 1024; nB = Wg + (size_t)(((ntile % (32 * NT)) / 32) * BN) * 1024; }
    gemm_core<true, NJ, 2>(brA, 512, brB, 512, 512, tot, lds, par, true, nA, 1024, nB, 1024);
    primed = nA != nullptr;
#pragma unroll
    for (int i = 0; i < 4; ++i)
#pragma unroll
      for (int j = 0; j < NJ; ++j) {
        tot[i][j][0] *= bflo(sg[i][j].x); tot[i][j][1] *= bfhi(sg[i][j].x);
        tot[i][j][2] *= bflo(sg[i][j].y); tot[i][j][3] *= bfhi(sg[i][j].y);
      }
  }
  bf16_t* MG = (bf16_t*)(ws + O_UT);
#pragma unroll
  for (int i = 0; i < 4; ++i) {
    const int tok = m0 + wm * 64 + i * 16 + fr;
#pragma unroll
    for (int j = 0; j < NJ; ++j) *(u32x2*)(MG + (size_t)tok * 1024 + n0 + wn * (NJ * 16) + j * 16 + fq * 4) = pk4(tot[i][j]);
  }
}

__device__ __forceinline__ void s7_tile(const Params& p, int l, int tile, const float* xp, const float* xs, char* lds) {
  const int tid = tidx(), lane = tid & 63, wid = tid >> 6, wm = wid >> 1, wn = wid & 1, fr = lane & 15, fq = lane >> 4;
  const int m = (tile / 512) * 32 + (tile % 32), nt = (tile % 512) / 32, m0 = m * 128, n0 = nt * 64;
  char* ws = wsp(p.ws);
  f32x4 acc[4][2];
#pragma unroll
  for (int i = 0; i < 4; ++i) { acc[i][0] = (f32x4){0.f, 0.f, 0.f, 0.f}; acc[i][1] = (f32x4){0.f, 0.f, 0.f, 0.f}; }
  gemm_core<true, 2>((const bf16_t*)(ws + O_UT) + (size_t)m0 * 1024, 1024, (const bf16_t*)(ws + O_WO) + ((size_t)l * 1024 + n0) * 1024, 1024, 1024, acc, lds);
#pragma unroll
  for (int i = 0; i < 4; ++i) {
    const int tok = m0 + wm * 64 + i * 16 + fr;
    const float* src = tok < NPR ? xp + (size_t)tok * 1024 : xs + (size_t)(tok - NPR) * 1024;
    const int v = tok < NPR ? 0 : 1 + ((tok - NPR) >> 10);
    const float* gate = (const float*)(ws + O_MOD) + (l * 5 + v) * 3072 + 2048;
#pragma unroll
    for (int j = 0; j < 2; ++j) {
      const int col = n0 + wn * 32 + j * 16 + fq * 4;
      const f32x4 x = *(const f32x4*)(src + col), gt = *(const f32x4*)(gate + col);
      f32x4 y;
#pragma unroll
      for (int e = 0; e < 4; ++e) y[e] = x[e] + gt[e] * acc[i][j][e];
      *(f32x4*)(p.out + (size_t)tok * 1024 + col) = y;
    }
  }
}

constexpr int NPHASE = 16;
__device__ __forceinline__ int q_issue(unsigned* ctr) {
  int v = 0;
  if (threadIdx.x == 0) v = (int)__hip_atomic_fetch_add(ctr, 1u, __ATOMIC_RELAXED, __HIP_MEMORY_SCOPE_AGENT);
  return v;
}
__device__ __forceinline__ int q_bcast(int v, char* lds) {
  __syncthreads();
  if (threadIdx.x == 0) *(volatile int*)lds = v;
  __syncthreads();
  const int it = *(volatile int*)lds;
  __syncthreads();
  return it;
}
__device__ __forceinline__ void run_phase(const Params& p, int ph, char* lds, unsigned* qctr) {
  const int bid = blockIdx.x, nb = gridDim.x;
  if (ph == 0) { for (int i = bid; i < P0_N; i += nb) phase0_item(p, i, lds); return; }
  if (ph == 15) { for (int i = bid; i < 512; i += nb) final_item(p, i); return; }
  const int l = (ph - 1) / 7, s = (ph - 1) % 7;
  const float* xp = l == 0 ? p.x_prompt : p.out;
  const float* xs = l == 0 ? p.x_sample : p.out + (size_t)NPR * 1024;
  switch (s) {
    case 0: for (int i = bid; i < 512; i += nb) norm_item(p, l, i, xp, xs); break;
    case 1: for (int i = bid; i < 2880; i += nb) s2_tile(p, l, i, lds); break;
    case 2:
      for (int i = q_bcast(q_issue(qctr + ph), lds); i < 2752;) {
        if (i < 128) attn_item<1>(p, l, i, lds);
        else if (i < 1024) keyprep_item(p, l, i - 128);
        else if (i < 1280) attn_item<1>(p, l, 128 + (i - 1024), lds);
        else if (i < 1408) state_item(p, l, i - 1280);
        else if (i < 1984) qup_tile(p, l, i - 1408, lds);
        else f1_tile(p, i - 1984, lds);
        i = q_bcast(q_issue(qctr + ph), lds);
      }
      break;
    case 3:
      for (int i = q_bcast(q_issue(qctr + ph), lds); i < 1408;) {
        if (i < 256) f2_tile<2>(p, i, lds);
        else if (i < 512) f2_tile<4>(p, i - 256, lds);
        else kvup_tile(p, l, i - 512, lds);
        i = q_bcast(q_issue(qctr + ph), lds);
      }
      break;
    case 4:
      for (int i = q_bcast(q_issue(qctr + ph), lds); i < 768;) {
        attn_item<0>(p, l, i, lds);
        i = q_bcast(q_issue(qctr + ph), lds);
      }
      break;
    case 5: { int par = 0; bool primed = false; for (int i = bid; i < 768; i += nb) s6_tile<4>(p, l, i, (i + nb < 768) ? i + nb : -1, lds, par, primed); } break;
    case 6: for (int i = bid; i < 1536; i += nb) s7_tile(p, l, i, xp, xs, lds); break;
  }
}

#define XB_TMO      128
#define XB_XCNT(j)  (256  + 64 * (j))
#define XB_XSUB(j)  (1280 + 64 * (j))
#define XB_XGEN(j)  (2304 + 64 * (j))
#define XB_TOP      3328
#define XB_TOPGEN   3392
#define XCD_BAR_WORDS 3456
#define XB_SPIN_CAP (1u << 18)
__device__ __forceinline__ unsigned xb_ld(unsigned* p)              { return __hip_atomic_load(p, __ATOMIC_RELAXED, __HIP_MEMORY_SCOPE_AGENT); }
__device__ __forceinline__ unsigned xb_add(unsigned* p, unsigned v) { return __hip_atomic_fetch_add(p, v, __ATOMIC_RELAXED, __HIP_MEMORY_SCOPE_AGENT); }
__device__ __forceinline__ unsigned xb_xcc_id() { return (unsigned)__builtin_amdgcn_s_getreg((3 << 11) | 20) & 0xFu; }
#define XB_SPIN(cond, bar) do { unsigned _sp = 0; while (cond) { __builtin_amdgcn_s_sleep(1); \
    if ((++_sp & 255u) == 0u) { if (xb_ld(&(bar)[XB_TMO])) break; if (_sp > XB_SPIN_CAP) { atomicAdd(&(bar)[XB_TMO], 1u); break; } } } } while (0)
__device__ __forceinline__ void xcd_barrier_complete(unsigned* bar, unsigned x, unsigned& nloc, unsigned& nx) {
  const unsigned G = gridDim.x;
  unsigned sum, cnt, mine, sp = 0u;
  for (;;) {
    sum = 0u; cnt = 0u; mine = 0u;
#pragma unroll
    for (unsigned j = 0; j < 16; ++j) { const unsigned c = xb_ld(&bar[XB_XCNT(j)]); sum += c; cnt += (c > 0u) ? 1u : 0u; mine = (j == x) ? c : mine; }
    if (sum == G) break;
    __builtin_amdgcn_s_sleep(1);
    if ((++sp & 255u) == 0u) { if (xb_ld(&bar[XB_TMO])) break; if (sp > XB_SPIN_CAP) { atomicAdd(&bar[XB_TMO], 1u); break; } }
  }
  nloc = mine > 0u ? mine : 1u; nx = cnt > 0u ? cnt : 1u;
}
__device__ __forceinline__ void xcd_barrier(unsigned* bar, unsigned x, unsigned& nloc, unsigned& nx) {
  asm volatile("s_waitcnt vmcnt(0)" ::: "memory");
  __syncthreads();
  if (threadIdx.x == 0) {
    __builtin_amdgcn_s_waitcnt(0);
    if (nloc == 0u) xcd_barrier_complete(bar, x, nloc, nx);
    const unsigned old = xb_add(&bar[XB_XSUB(x)], 1u);
    const unsigned gen = old / nloc;
    if (old + 1u == (gen + 1u) * nloc) {
      __builtin_amdgcn_fence(__ATOMIC_RELEASE, "agent");
      asm volatile("s_waitcnt vmcnt(0)" ::: "memory");
      const unsigned og = xb_add(&bar[XB_TOP], 1u);
      const unsigned tg = og / nx;
      if (og + 1u == (tg + 1u) * nx) xb_add(&bar[XB_TOPGEN], 1u);
      else XB_SPIN(xb_ld(&bar[XB_TOPGEN]) == tg, bar);
      __builtin_amdgcn_fence(__ATOMIC_ACQUIRE, "agent");
      xb_add(&bar[XB_XGEN(x)], 1u);
      asm volatile("s_waitcnt vmcnt(0)" ::: "memory");
    } else {
      XB_SPIN(xb_ld(&bar[XB_XGEN(x)]) == gen, bar);
      __builtin_amdgcn_fence(__ATOMIC_ACQUIRE, "agent");
      asm volatile("s_waitcnt vmcnt(0)" ::: "memory");
    }
  }
  __syncthreads();
}

__global__ void __launch_bounds__(256, 2) mk_fwd(Params p) {
  __shared__ __attribute__((aligned(16))) char lds[LDS_TOTAL];
  cg::grid_group grid = cg::this_grid();
  unsigned* bar = (unsigned*)(p.ws + O_BAR);
  const unsigned xcc = xb_xcc_id();
  if (threadIdx.x == 0) (void)xb_add(&bar[XB_XCNT(xcc)], 1u);
  unsigned nloc = 0u, nx = 0u;
  if (gridDim.x == 0x7fffffffu) grid.sync();
#pragma unroll 1
  for (int ph = 0; ph < NPHASE; ++ph) {
    run_phase(p, ph, lds, bar);
    if (ph + 1 < NPHASE) xcd_barrier(bar, xcc, nloc, nx);
  }
}

extern "C" void kernel_launch(void* const* d_in, const int* in_sizes, int n_in, void* d_out, int out_size, void* d_ws, size_t ws_size,
                              hipStream_t stream) {
  Params p{};
  p.x_prompt = (const float*)d_in[0]; p.x_sample = (const float*)d_in[1]; p.cache_ckv = (const float*)d_in[2]; p.cache_krope = (const float*)d_in[3];
  p.state_ret = (const float*)d_in[4]; p.c = (const float*)d_in[5]; p.c_ctx = (const float*)d_in[6]; p.norm_g = (const float*)d_in[7];
  p.w_mod = (const float*)d_in[8]; p.b_mod = (const float*)d_in[9]; p.w_in = (const float*)d_in[10]; p.ret_logit = (const float*)d_in[11];
  p.q_norm_g = (const float*)d_in[12]; p.w_q_up = (const float*)d_in[13]; p.kv_norm_g = (const float*)d_in[14]; p.w_kv_up = (const float*)d_in[15];
  p.w_branch = (const float*)d_in[16]; p.w_out = (const float*)d_in[17]; p.final_g = (const float*)d_in[18];
  p.out = (float*)d_out; p.ws = (char*)d_ws;
#if ONE_LAUNCH
  static int grid_blocks = 0;
  if (!grid_blocks) {
    int dev = 0, cus = 0, per_cu = 0;
    hipGetDevice(&dev);
    hipDeviceGetAttribute(&cus, hipDeviceAttributeMultiprocessorCount, dev);
    hipOccupancyMaxActiveBlocksPerMultiprocessor(&per_cu, mk_fwd, 256, 0);
    if (per_cu > 2) per_cu = 2;
    grid_blocks = cus * per_cu;
  }
  hipMemsetAsync((char*)d_ws + O_BAR, 0, XCD_BAR_WORDS * 4, stream);
  void* args[] = {&p};
  hipError_t e = hipLaunchCooperativeKernel((void*)mk_fwd, dim3(grid_blocks), dim3(256), args, 0, stream);
  if (e != hipSuccess) fprintf(stderr, "cooperative launch failed: %s (grid %d)\n", hipGetErrorString(e), grid_blocks);
#endif
}
```

```cpp
#include <hip/hip_runtime.h>
#include <hip/hip_cooperative_groups.h>
#include <stdint.h>
#include <stdio.h>
namespace cg = cooperative_groups;

#ifndef ONE_LAUNCH
#define ONE_LAUNCH 1
#endif

typedef unsigned short bf16_t;
typedef short bf16x8 __attribute__((ext_vector_type(8)));
typedef float f32x4 __attribute__((ext_vector_type(4)));
typedef unsigned u32x4 __attribute__((ext_vector_type(4)));
typedef unsigned u32x2 __attribute__((ext_vector_type(2)));

constexpr int NTOK = 12288, NPR = 8192, NKEY = 14336;
constexpr float EPSN = 1e-6f;

constexpr size_t O_WIN   = 0;
constexpr size_t O_WQ    = O_WIN   + (size_t)2 * 6912 * 1024 * 2;
constexpr size_t O_WKV   = O_WQ    + (size_t)2 * 768 * 384 * 2;
constexpr size_t O_WBR   = O_WKV   + (size_t)2 * 1024 * 256 * 2;
constexpr size_t O_WO    = O_WBR   + (size_t)6 * 1024 * 512 * 2;
constexpr size_t O_CS    = O_WO    + (size_t)2 * 1024 * 1024 * 2;
constexpr size_t O_D256  = O_CS    + (size_t)256 * 128 * 2;
constexpr size_t O_D1024 = O_D256  + (size_t)256 * 512 * 2;
constexpr size_t O_S0T   = O_D1024 + (size_t)1024 * 2048 * 2;
constexpr size_t O_MOD   = O_S0T   + (size_t)64 * 128 * 64 * 2;
constexpr size_t O_H     = O_MOD   + (size_t)2 * 5 * 3072 * 4;
constexpr size_t O_UT    = O_H     + (size_t)NTOK * 1024 * 2;
constexpr size_t O_RQ    = O_UT    + (size_t)NTOK * 1024 * 2;
constexpr size_t O_RK    = O_RQ    + (size_t)NTOK * 256 * 2;
constexpr size_t O_RKT   = O_RK    + (size_t)NTOK * 256 * 2;
constexpr size_t O_RVT   = O_RKT   + (size_t)NPR * 256 * 2;
constexpr size_t O_KVLAT = O_RVT   + (size_t)NTOK * 512 * 2;
constexpr size_t O_KR    = O_KVLAT + (size_t)NTOK * 256 * 4;
constexpr size_t O_R2END = O_KR    + (size_t)NTOK * 32 * 4;
constexpr size_t O_VT    = O_RQ;
static_assert(O_VT + (size_t)NKEY * 512 * 2 <= O_R2END, "alias overflow");
constexpr size_t O_RZ    = O_R2END;
constexpr size_t O_MZ    = O_RZ    + (size_t)NTOK * 512 * 2;
constexpr size_t O_FZ    = O_MZ    + (size_t)NTOK * 512 * 2;
constexpr size_t O_FU    = O_FZ    + (size_t)NTOK * 512 * 2;
constexpr size_t O_QLAT  = O_FU    + (size_t)NTOK * 512 * 2;
constexpr size_t O_CKVA  = O_QLAT  + (size_t)NTOK * 384 * 2;
constexpr size_t O_KB    = O_CKVA  + (size_t)NKEY * 256 * 2;
constexpr size_t O_KRA   = O_KB    + (size_t)NKEY * 512 * 2;
constexpr size_t O_QB    = O_KRA   + (size_t)NKEY * 32 * 2;
constexpr size_t O_H8    = O_QB    + (size_t)NTOK * 768 * 2;
constexpr size_t O_WG8   = O_H8    + (size_t)NTOK * 1024;
constexpr size_t O_END   = O_WG8   + (size_t)2 * 3072 * 1024;
constexpr size_t O_ROPE  = (O_END + 255) & ~(size_t)255;
constexpr size_t O_BAR   = O_ROPE + 4096;
static_assert(O_BAR + 16384 <= (size_t)256 * 1024 * 1024, "workspace too large");

constexpr size_t OUT_CKV = (size_t)NTOK * 1024;
constexpr size_t OUT_KR  = OUT_CKV + (size_t)32 * 2 * 256 * 256;
constexpr size_t OUT_RET = OUT_KR + (size_t)32 * 2 * 256 * 32;

struct Params {
  const float *x_prompt, *x_sample, *cache_ckv, *cache_krope, *state_ret, *c, *c_ctx, *norm_g, *w_mod, *b_mod,
      *w_in, *ret_logit, *q_norm_g, *w_q_up, *kv_norm_g, *w_kv_up, *w_branch, *w_out, *final_g;
  float* out;
  char* ws;
};

constexpr int PANEL = 128 * 64;
constexpr int ABYTES = 2 * PANEL;
constexpr int STAGE = 2 * ABYTES;
constexpr int LDS_GEMM = 2 * STAGE;
constexpr int LDS_TOTAL = LDS_GEMM;
static_assert(LDS_TOTAL <= 65536, "static LDS");

typedef float f32x2 __attribute__((ext_vector_type(2)));
typedef __bf16 bf16x2v __attribute__((ext_vector_type(2)));
__device__ __forceinline__ unsigned pk2(float lo, float hi) { const f32x2 v = {lo, hi}; return __builtin_bit_cast(unsigned, __builtin_convertvector(v, bf16x2v)); }
__device__ __forceinline__ bf16_t tobf(float x) { return (bf16_t)(pk2(x, 0.f) & 0xffffu); }
typedef int v8i __attribute__((ext_vector_type(8)));
__device__ __forceinline__ unsigned pk4f8(float a, float b, float c, float d) { unsigned w = 0; w = __builtin_amdgcn_cvt_pk_fp8_f32(a, b, w, false); w = __builtin_amdgcn_cvt_pk_fp8_f32(c, d, w, true); return w; }
__device__ __forceinline__ float bflo(unsigned u) { return __uint_as_float(u << 16); }
__device__ __forceinline__ float bfhi(unsigned u) { return __uint_as_float(u & 0xffff0000u); }
__device__ __forceinline__ float ex2(float x) { return __builtin_amdgcn_exp2f(x); }
__device__ __forceinline__ float silu_f(float x) { return x / (1.f + __expf(-x)); }
__device__ __forceinline__ float sigm_f(float x) { return 1.f / (1.f + __expf(-x)); }
__device__ __forceinline__ u32x2 pk4(f32x4 v) { u32x2 r; r.x = pk2(v[0], v[1]); r.y = pk2(v[2], v[3]); return r; }
#define GAS __attribute__((address_space(1)))
#define LAS __attribute__((address_space(3)))
__device__ __forceinline__ u32x4 ldg16(const void* p) { return *(const GAS u32x4*)p; }
__device__ __forceinline__ int tidx() { int t = threadIdx.x; asm volatile("" : "+v"(t)); return t; }
__device__ __forceinline__ char* wsp(const char* w) { unsigned long long v = (unsigned long long)w; asm volatile("" : "+s"(v)); return (char*)v; }
__device__ __forceinline__ int swz(int r) { return (0 - ((r >> 2) & 3)) & 3; }
__device__ __forceinline__ float wave_sum(float v) {
#pragma unroll
  for (int o = 1; o < 64; o <<= 1) v += __shfl_xor(v, o);
  return v;
}
__device__ __forceinline__ f32x4 mfma16(bf16x8 a, bf16x8 b, f32x4 c) { return __builtin_amdgcn_mfma_f32_16x16x32_bf16(a, b, c, 0, 0, 0); }
__device__ __forceinline__ bf16x8 as_bf8(u32x4 v) { return __builtin_bit_cast(bf16x8, v); }

__device__ __forceinline__ void zero_acc(f32x4 (&acc)[4][4]) {
#pragma unroll
  for (int i = 0; i < 4; ++i)
#pragma unroll
    for (int j = 0; j < 4; ++j) acc[i][j] = (f32x4){0.f, 0.f, 0.f, 0.f};
}

template <bool SWAP, int NJ, int PIPE, bool F8>
__device__ __forceinline__ void gemm_bytes(const char* __restrict__ A, int lda, const char* __restrict__ B, int ldb, int Kb,
                                           f32x4 (&acc)[4][NJ], char* lds, int& par, bool primed,
                                           const char* nA, int nlda, const char* nB, int nldb) {
  const int tid = tidx(), lane = tid & 63, wm = (tid >> 6) >> 1, wn = (tid >> 6) & 1;
  const int wid = __builtin_amdgcn_readfirstlane(tid >> 6);
  const int fr = lane & 15, fq = lane >> 4;
  const int fa = (wm * 64 + fr) * 64 + ((fq ^ swz(fr)) << 4);
  const int fb = ABYTES + (wn * NJ * 16 + fr) * 64 + ((fq ^ swz(fr)) << 4);
  const int lrow = lane >> 2, lchunk = (lane & 3) ^ swz(lrow);
  constexpr int NBL = NJ / 2;
  const GAS char* gA = (const GAS char*)(A + (size_t)(wid * 32 + lrow) * lda + lchunk * 16);
  const GAS char* gB = (const GAS char*)(B + (size_t)(wid * NBL * 16 + lrow) * ldb + lchunk * 16);
  const size_t a16 = (size_t)16 * lda, b16 = (size_t)16 * ldb;
  LAS char* ldsA = (LAS char*)lds + wid * 2048;
  LAS char* ldsB = (LAS char*)lds + ABYTES + wid * NBL * 1024;
  const int nk = Kb >> 7;
#define GC_ISSUE(pa, pb, sa, sb, stage, kbyte) do { \
    _Pragma("unroll") for (int g = 0; g < 2; ++g) _Pragma("unroll") for (int pn = 0; pn < 2; ++pn) \
      __builtin_amdgcn_global_load_lds((const GAS unsigned*)((pa) + g * (sa) + (kbyte) + pn * 64), (LAS unsigned*)(ldsA + (stage) + pn * PANEL + g * 1024), 16, 0, 0); \
    _Pragma("unroll") for (int g = 0; g < NBL; ++g) _Pragma("unroll") for (int pn = 0; pn < 2; ++pn) \
      __builtin_amdgcn_global_load_lds((const GAS unsigned*)((pb) + g * (sb) + (kbyte) + pn * 64), (LAS unsigned*)(ldsB + (stage) + pn * PANEL + g * 1024), 16, 0, 0); \
  } while (0)
  if (!primed) {
    GC_ISSUE(gA, gB, a16, b16, par * STAGE, 0);
    asm volatile("s_waitcnt vmcnt(0)" ::: "memory");
    __syncthreads();
  }
  for (int kt = 0; kt < nk; ++kt) {
    char* cur = lds + par * STAGE;
    if (kt + 1 < nk) GC_ISSUE(gA, gB, a16, b16, (par ^ 1) * STAGE, (size_t)(kt + 1) * 128);
    else if (nA) {
      const GAS char* hA = (const GAS char*)(nA + (size_t)(wid * 32 + lrow) * nlda + lchunk * 16);
      const GAS char* hB = (const GAS char*)(nB + (size_t)(wid * NBL * 16 + lrow) * nldb + lchunk * 16);
      GC_ISSUE(hA, hB, (size_t)16 * nlda, (size_t)16 * nldb, (par ^ 1) * STAGE, 0);
    }
    __builtin_amdgcn_sched_barrier(0);
    if (F8) {
#pragma unroll
      for (int ih = 0; ih < 2; ++ih) {
        v8i av[2];
#pragma unroll
        for (int ii = 0; ii < 2; ++ii) {
          const u32x4 a0 = *(const u32x4*)(cur + fa + (ih * 2 + ii) * 1024), a1 = *(const u32x4*)(cur + PANEL + fa + (ih * 2 + ii) * 1024);
          av[ii] = (v8i){(int)a0.x, (int)a0.y, (int)a0.z, (int)a0.w, (int)a1.x, (int)a1.y, (int)a1.z, (int)a1.w};
        }
#pragma unroll
        for (int j = 0; j < NJ; ++j) {
          const u32x4 b0 = *(const u32x4*)(cur + fb + j * 1024), b1 = *(const u32x4*)(cur + PANEL + fb + j * 1024);
          const v8i bv = {(int)b0.x, (int)b0.y, (int)b0.z, (int)b0.w, (int)b1.x, (int)b1.y, (int)b1.z, (int)b1.w};
#pragma unroll
          for (int ii = 0; ii < 2; ++ii)
            acc[ih * 2 + ii][j] = SWAP ? __builtin_amdgcn_mfma_scale_f32_16x16x128_f8f6f4(bv, av[ii], acc[ih * 2 + ii][j], 0, 0, 0, 0x7f7f7f7f, 0, 0x7f7f7f7f)
                                       : __builtin_amdgcn_mfma_scale_f32_16x16x128_f8f6f4(av[ii], bv, acc[ih * 2 + ii][j], 0, 0, 0, 0x7f7f7f7f, 0, 0x7f7f7f7f);
        }
      }
    } else if (PIPE == 2) {
      bf16x8 af[2][4], bfr[NJ];
#pragma unroll
      for (int i = 0; i < 4; ++i) af[0][i] = *(const bf16x8*)(cur + fa + i * 1024);
#pragma unroll
      for (int j = 0; j < NJ; ++j) bfr[j] = *(const bf16x8*)(cur + fb + j * 1024);
#pragma unroll
      for (int i = 0; i < 4; ++i) af[1][i] = *(const bf16x8*)(cur + PANEL + fa + i * 1024);
      __builtin_amdgcn_sched_barrier(0);
#pragma unroll
      for (int i = 0; i < 4; ++i)
#pragma unroll
        for (int j = 0; j < NJ; ++j) acc[i][j] = SWAP ? mfma16(bfr[j], af[0][i], acc[i][j]) : mfma16(af[0][i], bfr[j], acc[i][j]);
#pragma unroll
      for (int j = 0; j < NJ; ++j) bfr[j] = *(const bf16x8*)(cur + PANEL + fb + j * 1024);
#pragma unroll
      for (int i = 0; i < 4; ++i)
#pragma unroll
        for (int j = 0; j < NJ; ++j) acc[i][j] = SWAP ? mfma16(bfr[j], af[1][i], acc[i][j]) : mfma16(af[1][i], bfr[j], acc[i][j]);
    } else if (PIPE == 1) {
      bf16x8 af[2][4], bfr[2][NJ];
#pragma unroll
      for (int ks = 0; ks < 2; ++ks) {
#pragma unroll
        for (int i = 0; i < 4; ++i) af[ks][i] = *(const bf16x8*)(cur + ks * PANEL + fa + i * 1024);
#pragma unroll
        for (int j = 0; j < NJ; ++j) bfr[ks][j] = *(const bf16x8*)(cur + ks * PANEL + fb + j * 1024);
      }
      __builtin_amdgcn_sched_barrier(0);
#pragma unroll
      for (int ks = 0; ks < 2; ++ks)
#pragma unroll
        for (int i = 0; i < 4; ++i)
#pragma unroll
          for (int j = 0; j < NJ; ++j) acc[i][j] = SWAP ? mfma16(bfr[ks][j], af[ks][i], acc[i][j]) : mfma16(af[ks][i], bfr[ks][j], acc[i][j]);
    } else {
#pragma unroll
      for (int ks = 0; ks < 2; ++ks) {
        bf16x8 af[4], bfr[NJ];
#pragma unroll
        for (int i = 0; i < 4; ++i) af[i] = *(const bf16x8*)(cur + ks * PANEL + fa + i * 1024);
#pragma unroll
        for (int j = 0; j < NJ; ++j) bfr[j] = *(const bf16x8*)(cur + ks * PANEL + fb + j * 1024);
#pragma unroll
        for (int i = 0; i < 4; ++i)
#pragma unroll
          for (int j = 0; j < NJ; ++j) acc[i][j] = SWAP ? mfma16(bfr[j], af[i], acc[i][j]) : mfma16(af[i], bfr[j], acc[i][j]);
      }
    }
    __builtin_amdgcn_sched_barrier(0);
    asm volatile("s_waitcnt vmcnt(0)" ::: "memory");
    __syncthreads();
    par ^= 1;
  }
#undef GC_ISSUE
}
template <bool SWAP, int NJ = 4, int PIPE = 1>
__device__ __forceinline__ void gemm_core(const bf16_t* __restrict__ A, int lda, const bf16_t* __restrict__ B, int ldb, int K,
                                          f32x4 (&acc)[4][NJ], char* lds, int& par, bool primed,
                                          const bf16_t* nA, int nlda, const bf16_t* nB, int nldb) {
  gemm_bytes<SWAP, NJ, PIPE, false>((const char*)A, lda * 2, (const char*)B, ldb * 2, K * 2, acc, lds, par, primed, (const char*)nA, nlda * 2, (const char*)nB, nldb * 2);
}
template <bool SWAP, int NJ = 4>
__device__ __forceinline__ void gemm_core(const bf16_t* __restrict__ A, int lda, const bf16_t* __restrict__ B, int ldb, int K,
                                          f32x4 (&acc)[4][NJ], char* lds) {
  int par = 0;
  gemm_core<SWAP, NJ>(A, lda, B, ldb, K, acc, lds, par, false, nullptr, 0, nullptr, 0);
}

__device__ __forceinline__ void tr_tile(const float* __restrict__ src, int lds_, int k0, int ns0, bf16_t* __restrict__ dst, int ldd, int nd0,
                                        const float* __restrict__ ksc, char* lds) {
  bf16_t* T = (bf16_t*)lds;
  const int tid = tidx();
  __syncthreads();
#pragma unroll
  for (int i = 0; i < 2; ++i) {
    const int kk = (tid >> 3) + 32 * i, nn4 = (tid & 7) * 4;
    const f32x4 v = *(const f32x4*)(src + (size_t)(k0 + kk) * lds_ + ns0 + nn4);
    const float s = ksc ? ksc[k0 + kk] : 1.f;
#pragma unroll
    for (int e = 0; e < 4; ++e) T[(nn4 + e) * 72 + kk] = tobf(v[e] * s);
  }
  __syncthreads();
  const int nn = tid >> 3, kc = (tid & 7) * 8;
  const u32x4 w = *(const u32x4*)(T + nn * 72 + kc);
  *(u32x4*)(dst + (size_t)(nd0 + nn) * ldd + k0 + kc) = w;
}

__device__ __forceinline__ void tr_tile2(const float* __restrict__ src, int lds_, int k0, int ns0, bf16_t* __restrict__ dst, int ldd, int nd0,
                                         const float* __restrict__ ksc, char* lds, unsigned char* dst8 = nullptr) {
  bf16_t* T = (bf16_t*)lds;
  unsigned char* T8 = (unsigned char*)lds + 8704;
  const int tid = tidx();
  __syncthreads();
  f32x4 v[4];
#pragma unroll
  for (int i = 0; i < 4; ++i) v[i] = *(const GAS f32x4*)(src + (size_t)(k0 + (tid >> 3) + 32 * i) * lds_ + ns0 + (tid & 7) * 4);
#pragma unroll
  for (int i = 0; i < 4; ++i) {
    const int kk = (tid >> 3) + 32 * i, nn4 = (tid & 7) * 4;
    const float sc = ksc ? ksc[k0 + kk] : 1.f;
#pragma unroll
    for (int e = 0; e < 4; ++e) T[(nn4 + e) * 136 + kk] = tobf(v[i][e] * sc);
    if (dst8) {
#pragma unroll
      for (int e = 0; e < 4; ++e) T8[(nn4 + e) * 144 + kk] = (unsigned char)(__builtin_amdgcn_cvt_pk_fp8_f32(v[i][e] * 32.f, 0.f, 0, false) & 0xff);
    }
  }
  __syncthreads();
  const int nn = tid >> 3, kc = (tid & 7) * 16;
  if (dst8) *(u32x4*)(dst8 + (size_t)nn * 1024 + k0 + kc) = *(const u32x4*)(T8 + nn * 144 + kc);
  const u32x4 w0 = *(const u32x4*)(T + nn * 136 + kc), w1 = *(const u32x4*)(T + nn * 136 + kc + 8);
  bf16_t* d = dst + (size_t)(nd0 + nn) * ldd + k0 + kc;
  *(u32x4*)d = w0; *(u32x4*)(d + 8) = w1;
}

constexpr int P0_GEMV = 192, P0_WIN = 3408, P0_WQ = 144, P0_WKV = 128, P0_WBR = 768, P0_WO = 512, P0_S0 = 256, P0_PAD = 96, P0_TAB = 1105;
constexpr int P0_N = P0_GEMV + P0_WIN + P0_WQ + P0_WKV + P0_WBR + P0_WO + P0_S0 + P0_PAD + P0_TAB;

__device__ __forceinline__ void phase0_item(const Params& p, int j, char* lds) {
  const int tid = tidx();
  char* ws = wsp(p.ws);
  if (j < P0_GEMV) {
    const int l = j / 96, cgi = j % 96;
    float* sv = (float*)lds;
    float* red = (float*)(lds + 20480);
    __syncthreads();
    for (int i = tid; i < 5120; i += 256) { const int v = i >> 10, k = i & 1023; const float x = (v == 0) ? p.c_ctx[k] : p.c[(v - 1) * 1024 + k]; sv[i] = silu_f(x); }
    __syncthreads();
    const int c4 = tid & 7, kg = tid >> 3;
    const float* w = p.w_mod + (size_t)l * 1024 * 3072 + cgi * 32 + c4 * 4;
    f32x4 a0 = {0.f, 0.f, 0.f, 0.f}, a1 = a0, a2 = a0, a3 = a0, a4 = a0;
#pragma unroll 8
    for (int k = kg * 32; k < kg * 32 + 32; ++k) {
      const f32x4 wv = *(const GAS f32x4*)(w + (size_t)k * 3072);
      a0 += wv * sv[k]; a1 += wv * sv[1024 + k]; a2 += wv * sv[2048 + k]; a3 += wv * sv[3072 + k]; a4 += wv * sv[4096 + k];
    }
    *(f32x4*)(red + (kg * 5 + 0) * 32 + c4 * 4) = a0; *(f32x4*)(red + (kg * 5 + 1) * 32 + c4 * 4) = a1; *(f32x4*)(red + (kg * 5 + 2) * 32 + c4 * 4) = a2;
    *(f32x4*)(red + (kg * 5 + 3) * 32 + c4 * 4) = a3; *(f32x4*)(red + (kg * 5 + 4) * 32 + c4 * 4) = a4;
    __syncthreads();
    if (tid < 160) {
      const int v = tid >> 5, c2 = tid & 31;
      float sm = p.b_mod[l * 3072 + cgi * 32 + c2];
#pragma unroll 8
      for (int g = 0; g < 32; ++g) sm += red[(g * 5 + v) * 32 + c2];
      ((float*)(ws + O_MOD))[(l * 5 + v) * 3072 + cgi * 32 + c2] = sm;
    }
    return;
  }
  j -= P0_GEMV;
  if (j < P0_WIN) {
    const int l = j / 1704, r = j % 1704, kt = r / 213, nt = r % 213, c0 = nt * 32;
    const int nd0 = c0 < 2176 ? c0 : (c0 < 2208 ? 3712 + (c0 - 2176) : (c0 < 3744 ? c0 - 32 : c0 + 96));
    tr_tile2(p.w_in + (size_t)l * 1024 * 6816, 6816, kt * 128, c0, (bf16_t*)(ws + O_WIN) + (size_t)l * 6912 * 1024, 1024, nd0, nullptr, lds,
             nd0 >= 3840 ? (unsigned char*)(ws + O_WG8) + ((size_t)l * 3072 + (nd0 - 3840)) * 1024 : nullptr);
    return;
  }
  j -= P0_WIN;
  if (j < P0_WQ) {
    const int l = j / 72, r = j % 72, kt = r / 24, nt = r % 24;
    tr_tile2(p.w_q_up + (size_t)l * 384 * 768, 768, kt * 128, nt * 32, (bf16_t*)(ws + O_WQ) + (size_t)l * 768 * 384, 384, nt * 32, p.q_norm_g + l * 384, lds);
    return;
  }
  j -= P0_WQ;
  if (j < P0_WKV) {
    const int l = j / 64, r = j % 64, kt = r / 32, nt = r % 32, c0 = nt * 32, h = c0 >> 7, e = c0 & 127;
    const int nd0 = e < 64 ? h * 64 + e : 512 + h * 64 + (e - 64);
    tr_tile2(p.w_kv_up + (size_t)l * 256 * 1024, 1024, kt * 128, c0, (bf16_t*)(ws + O_WKV) + (size_t)l * 1024 * 256, 256, nd0, nullptr, lds);
    return;
  }
  j -= P0_WKV;
  if (j < P0_WBR) {
    const int mat = j / 128, r = j % 128, kt = r / 32, nt = r % 32;
    tr_tile2(p.w_branch + (size_t)mat * 512 * 1024, 1024, kt * 128, nt * 32, (bf16_t*)(ws + O_WBR) + (size_t)mat * 1024 * 512, 512, nt * 32, nullptr, lds);
    return;
  }
  j -= P0_WBR;
  if (j < P0_WO) {
    const int l = j / 256, r = j % 256, kt = r / 32, nt = r % 32;
    tr_tile2(p.w_out + (size_t)l * 1024 * 1024, 1024, kt * 128, nt * 32, (bf16_t*)(ws + O_WO) + (size_t)l * 1024 * 1024, 1024, nt * 32, nullptr, lds);
    return;
  }
  j -= P0_WO;
  if (j < P0_S0) {
    const int mat = j >> 2, nt = j & 3;
    tr_tile(p.state_ret + (size_t)mat * 64 * 128, 128, 0, nt * 32, (bf16_t*)(ws + O_S0T) + (size_t)mat * 128 * 64, 64, nt * 32, nullptr, lds);
    return;
  }
  j -= P0_S0;
  if (j < P0_PAD) {
    const int l = j / 48, r = j % 48;
    bf16_t* d = (bf16_t*)(ws + O_WIN) + ((size_t)l * 6912 + 3744) * 1024 + (size_t)r * 2048 + tid * 8;
    *(u32x4*)d = (u32x4){0u, 0u, 0u, 0u};
    return;
  }
  j -= P0_PAD;
  {
    float v[8];
    bf16_t* dst;
    if (j == 1104) {
      float* rt = (float*)(ws + O_ROPE);
#pragma unroll
      for (int q = 0; q < 2; ++q) {
        const int idx = tid * 2 + q, pos = idx >> 3, f = idx & 7;
        const float ang = (float)pos * exp2f(-(float)f * 1.66096404744f);
        rt[idx * 2] = cosf(ang); rt[idx * 2 + 1] = sinf(ang);
      }
      return;
    }
    if (j < 16) {
      const int e0 = j * 2048 + tid * 8; dst = (bf16_t*)(ws + O_CS) + e0;
      const int n = e0 >> 7, k = e0 & 127;
#pragma unroll
      for (int e = 0; e < 8; ++e) {
        const float fr = (float)(((n & 127) * (k + e)) & 127) * (1.f / 128.f);
        v[e] = (n < 128) ? __builtin_amdgcn_cosf(fr) : __builtin_amdgcn_sinf(fr);
      }
    } else if (j < 80) {
      const int e0 = (j - 16) * 2048 + tid * 8; dst = (bf16_t*)(ws + O_D256) + e0;
      const int k1 = e0 >> 9, kk = e0 & 511;
#pragma unroll
      for (int e = 0; e < 8; ++e) {
        const int t = (kk + e) & 255;
        const float fr = (float)((k1 * t) & 255) * (1.f / 256.f);
        v[e] = (kk < 256) ? __builtin_amdgcn_cosf(fr) : -__builtin_amdgcn_sinf(fr);
      }
    } else {
      const int e0 = (j - 80) * 2048 + tid * 8; dst = (bf16_t*)(ws + O_D1024) + e0;
      const int k1 = e0 >> 11, kk = e0 & 2047;
#pragma unroll
      for (int e = 0; e < 8; ++e) {
        const int t = (kk + e) & 1023;
        const float fr = (float)((k1 * t) & 1023) * (1.f / 1024.f);
        v[e] = (kk < 1024) ? __builtin_amdgcn_cosf(fr) : -__builtin_amdgcn_sinf(fr);
      }
    }
    u32x4 w; w.x = pk2(v[0], v[1]); w.y = pk2(v[2], v[3]); w.z = pk2(v[4], v[5]); w.w = pk2(v[6], v[7]);
    *(u32x4*)dst = w;
  }
}

__device__ __forceinline__ void norm_item(const Params& p, int l, int item, const float* xp, const float* xs) {
  const int tid = tidx(), lane = tid & 63, wid = tid >> 6;
  bf16_t* H = (bf16_t*)(p.ws + O_H);
#pragma unroll 3
  for (int i = 0; i < 6; ++i) {
    const int row = item * 24 + wid * 6 + i;
    const float* src = row < NPR ? xp + (size_t)row * 1024 : xs + (size_t)(row - NPR) * 1024;
    const int v = row < NPR ? 0 : 1 + ((row - NPR) >> 10);
    const float* mod = (const float*)(p.ws + O_MOD) + (l * 5 + v) * 3072;
    f32x4 x[4]; float ss = 0.f;
#pragma unroll
    for (int q = 0; q < 4; ++q) { x[q] = *(const f32x4*)(src + (q * 64 + lane) * 4); ss += x[q][0] * x[q][0] + x[q][1] * x[q][1] + x[q][2] * x[q][2] + x[q][3] * x[q][3]; }
    ss = wave_sum(ss);
    const float rstd = rsqrtf(ss * (1.f / 1024.f) + EPSN);
#pragma unroll
    for (int q = 0; q < 4; ++q) {
      const int col = (q * 64 + lane) * 4;
      const f32x4 g = *(const f32x4*)(p.norm_g + l * 1024 + col), sc = *(const f32x4*)(mod + 1024 + col), sh = *(const f32x4*)(mod + col);
      f32x4 h;
#pragma unroll
      for (int e = 0; e < 4; ++e) h[e] = x[q][e] * rstd * g[e] * (1.f + sc[e]) + sh[e];
      *(u32x2*)(H + (size_t)row * 1024 + col) = pk4(h);
      *(unsigned*)(p.ws + O_H8 + (size_t)row * 1024 + col) = pk4f8(h[0], h[1], h[2], h[3]);
    }
  }
}
__device__ __forceinline__ void final_item(const Params& p, int item) {
  const int tid = tidx(), lane = tid & 63, wid = tid >> 6;
#pragma unroll 3
  for (int i = 0; i < 6; ++i) {
    const int row = item * 24 + wid * 6 + i;
    float* src = p.out + (size_t)row * 1024;
    f32x4 x[4]; float ss = 0.f;
#pragma unroll
    for (int q = 0; q < 4; ++q) { x[q] = *(const f32x4*)(src + (q * 64 + lane) * 4); ss += x[q][0] * x[q][0] + x[q][1] * x[q][1] + x[q][2] * x[q][2] + x[q][3] * x[q][3]; }
    ss = wave_sum(ss);
    const float rstd = rsqrtf(ss * (1.f / 1024.f) + EPSN);
#pragma unroll
    for (int q = 0; q < 4; ++q) {
      const int col = (q * 64 + lane) * 4;
      const f32x4 g = *(const f32x4*)(p.final_g + col);
      f32x4 y;
#pragma unroll
      for (int e = 0; e < 4; ++e) y[e] = x[q][e] * rstd * g[e];
      *(f32x4*)(src + col) = y;
    }
  }
}

__device__ __forceinline__ void s2_tile(const Params& p, int l, int tile, char* lds) {
  const int tid = tidx(), lane = tid & 63, wid = tid >> 6, wm = wid >> 1, wn = wid & 1, fr = lane & 15, fq = lane >> 4;
  const int m = (tile / 480) * 16 + (tile % 16), nt = (tile % 480) / 16, m0 = m * 128, n0 = nt * 128;
  char* ws = wsp(p.ws);
  const bf16_t* A = (const bf16_t*)(ws + O_H) + (size_t)m0 * 1024;
  const bf16_t* B = (const bf16_t*)(ws + O_WIN) + ((size_t)l * 6912 + n0) * 1024;
  f32x4 acc[4][4];
  zero_acc(acc);
  if (nt >= 4 && nt < 8) {
    gemm_core<false>(A, 1024, B, 1024, 1024, acc, lds);
    bf16_t* RVT = (bf16_t*)(ws + O_RVT);
#pragma unroll
    for (int i = 0; i < 4; ++i) {
      const int tok = m0 + wm * 64 + i * 16 + fq * 4;
      size_t base; int T, b, t;
      if (tok < NPR) { b = tok >> 8; t = tok & 255; T = 256; base = 0; } else { const int s = tok - NPR; b = s >> 10; t = s & 1023; T = 1024; base = (size_t)NPR * 512; }
#pragma unroll
      for (int j = 0; j < 4; ++j) {
        const int c = n0 - 512 + wn * 64 + j * 16 + fr, h = c >> 7, vd = c & 127;
        *(u32x2*)(RVT + base + ((size_t)(b * 4 + h) * 128 + vd) * T + t) = pk4(acc[i][j]);
      }
    }
    return;
  }
  gemm_core<true>(A, 1024, B, 1024, 1024, acc, lds);
  bf16_t* dst = nullptr; int ld = 0, c0 = 0, op = 0;
  if (nt < 2) { dst = (bf16_t*)(ws + O_RQ); ld = 256; c0 = 0; }
  else if (nt < 4) { dst = (bf16_t*)(ws + O_RK); ld = 256; c0 = 256; op = 2; }
  else if (nt < 12) { dst = (bf16_t*)(ws + O_RZ); ld = 512; c0 = 1024; op = 1; }
  else if (nt < 15) { dst = (bf16_t*)(ws + O_QLAT); ld = 384; c0 = 1536; }
  else if (nt < 17) { ld = 256; c0 = 1920; op = 3; }
  else if (nt < 21) { dst = (bf16_t*)(ws + O_MZ); ld = 512; c0 = 2176; op = 1; }
  else if (nt < 25) { dst = (bf16_t*)(ws + O_FU); ld = 512; c0 = 2688; }
  else if (nt < 29) { dst = (bf16_t*)(ws + O_FZ); ld = 512; c0 = 3200; op = 1; }
  else { ld = 32; c0 = 3712; op = 4; }
#pragma unroll
  for (int i = 0; i < 4; ++i) {
    const int tok = m0 + wm * 64 + i * 16 + fr;
#pragma unroll
    for (int j = 0; j < 4; ++j) {
      const int col = n0 - c0 + wn * 64 + j * 16 + fq * 4;
      f32x4 v = acc[i][j];
      if (op == 3) { *(f32x4*)((float*)(ws + O_KVLAT) + (size_t)tok * 256 + col) = v; continue; }
      if (op == 4) { if (col < 32) *(f32x4*)((float*)(ws + O_KR) + (size_t)tok * 32 + col) = v; continue; }
      if (op == 1) {
#pragma unroll
        for (int e = 0; e < 4; ++e) v[e] = silu_f(v[e]);
      } else if (op == 2) {
#pragma unroll
        for (int e = 0; e < 4; ++e) v[e] *= 0.125f;
      }
      const u32x2 w = pk4(v);
      *(u32x2*)(dst + (size_t)tok * ld + col) = w;
      if (op == 2 && tok < NPR) {
        bf16_t* RKT = (bf16_t*)(ws + O_RKT);
        const int b = tok >> 8, t = tok & 255, h = col >> 6, dk = col & 63;
        bf16_t* q = RKT + ((size_t)(b * 4 + h) * 64 + dk) * 256 + t;
        q[0] = (bf16_t)(w.x & 0xffffu); q[256] = (bf16_t)(w.x >> 16); q[512] = (bf16_t)(w.y & 0xffffu); q[768] = (bf16_t)(w.y >> 16);
      }
    }
  }
}

template <int MODE>
__device__ __forceinline__ void attn_item(const Params& p, int l, int item, char* lds) {
  constexpr int NKP = MODE == 0 ? 3 : 2;
  constexpr int NVB = MODE == 0 ? 4 : 8;
  constexpr int PV = NVB * 16 * 64;
  constexpr int KOFF = NKP * 4096;
  constexpr int BUF = KOFF + 2 * PV;
  const int tid = tidx(), lane = tid & 63, wid = tid >> 6, fr = lane & 15, fq = lane >> 4;
  char* ws = wsp(p.ws);
  int smp, b, h, qblk, T, Tk, tok0;
  const bf16_t *kbase, *rbase = nullptr, *vbase, *qbase;
  int kstride, qstride;
  if (MODE == 0) {
    if (item < 256) { smp = 1; b = item >> 6; h = (item >> 3) & 7; qblk = item & 7; T = 1024; Tk = 1536; tok0 = NPR + b * 1024 + qblk * 128; }
    else { const int it = item - 256; smp = 0; b = it >> 4; h = (it >> 1) & 7; qblk = it & 1; T = 256; Tk = 256; tok0 = b * 256 + qblk * 128; }
    const int keyrow0 = smp ? NPR + b * 1536 : b * 256;
    kbase = (const bf16_t*)(ws + O_KB) + (size_t)keyrow0 * 512 + h * 64; kstride = 512;
    rbase = (const bf16_t*)(ws + O_KRA) + (size_t)keyrow0 * 32;
    vbase = (const bf16_t*)(ws + O_VT) + (smp ? (size_t)NPR * 512 + (size_t)(b * 8 + h) * 64 * 1536 : (size_t)(b * 8 + h) * 64 * 256);
    qbase = (const bf16_t*)(ws + O_QB) + (size_t)tok0 * 768 + h * 96; qstride = 768;
  } else {
    if (item < 128) { smp = 1; b = item >> 5; h = (item >> 3) & 3; qblk = item & 7; T = 1024; tok0 = NPR + b * 1024 + qblk * 128; }
    else { const int it = item - 128; smp = 0; b = it >> 3; h = (it >> 1) & 3; qblk = it & 1; T = 256; tok0 = b * 256 + qblk * 128; }
    Tk = T;
    const int ktok0 = smp ? NPR + b * 1024 : b * 256;
    kbase = (const bf16_t*)(ws + O_RK) + (size_t)ktok0 * 256 + h * 64; kstride = 256;
    vbase = (const bf16_t*)(ws + O_RVT) + (smp ? (size_t)NPR * 512 + (size_t)(b * 4 + h) * 128 * 1024 : (size_t)(b * 4 + h) * 128 * 256);
    qbase = (const bf16_t*)(ws + O_RQ) + (size_t)tok0 * 256 + h * 64; qstride = 256;
  }
  const int nkt = Tk >> 6;
  bf16x8 qf[2][NKP];
#pragma unroll
  for (int qb = 0; qb < 2; ++qb)
#pragma unroll
    for (int ks = 0; ks < NKP; ++ks) qf[qb][ks] = *(const bf16x8*)(qbase + (size_t)(wid * 32 + qb * 16 + fr) * qstride + ks * 32 + fq * 8);
  f32x4 o[NVB][2];
#pragma unroll
  for (int vb = 0; vb < NVB; ++vb) { o[vb][0] = (f32x4){0.f, 0.f, 0.f, 0.f}; o[vb][1] = (f32x4){0.f, 0.f, 0.f, 0.f}; }
  float lgf = 0.f, lgb = 0.f;
  float mrow[2] = {-INFINITY, -INFINITY}, lrow[2] = {0.f, 0.f};
  const int tq0 = qblk * 128 + wid * 32 + fr;
  if (MODE == 1) {
    const float xf = p.ret_logit[(l * 2 + 0) * 4 + h], xb = p.ret_logit[(l * 2 + 1) * 4 + h];
    lgf = -log1pf(expf(-xf)) * 1.44269504089f; lgb = -log1pf(expf(-xb)) * 1.44269504089f;
    if (smp) {
      const bf16_t* s0 = (const bf16_t*)(ws + O_S0T);
#pragma unroll
      for (int dir = 0; dir < 2; ++dir) {
        const bf16_t* sb = s0 + ((size_t)(((b * 2 + l) * 2 + dir) * 4 + h) * 128) * 64;
        float dec[2];
#pragma unroll
        for (int qb = 0; qb < 2; ++qb) { const int tq = tq0 + qb * 16; dec[qb] = dir == 0 ? ex2((float)(tq + 1) * lgf) : ex2((float)(T - tq) * lgb); }
#pragma unroll
        for (int vb = 0; vb < NVB; ++vb) {
          f32x4 t0 = (f32x4){0.f, 0.f, 0.f, 0.f}, t1 = (f32x4){0.f, 0.f, 0.f, 0.f};
#pragma unroll
          for (int ks = 0; ks < 2; ++ks) {
            const bf16x8 sf = *(const bf16x8*)(sb + (size_t)(vb * 16 + fr) * 64 + ks * 32 + fq * 8);
            t0 = mfma16(sf, qf[0][ks], t0); t1 = mfma16(sf, qf[1][ks], t1);
          }
          o[vb][0] += t0 * dec[0]; o[vb][1] += t1 * dec[1];
        }
      }
    }
  }
  u32x4 vreg[NVB / 2];
  const int uw = __builtin_amdgcn_readfirstlane(wid);
  const int dkey = lane >> 2, dchunk = (lane & 3) ^ swz(dkey);
  auto kdma = [&](int kt, char* buf) {
    const GAS bf16_t* kp = (const GAS bf16_t*)kbase + (size_t)(kt * 64 + uw * 16 + dkey) * kstride + dchunk * 8;
#pragma unroll
    for (int pn = 0; pn < 2; ++pn)
      __builtin_amdgcn_global_load_lds((const GAS unsigned*)(kp + pn * 32), (LAS unsigned*)((LAS char*)buf + pn * 4096 + uw * 1024), 16, 0, 0);
    if (MODE == 0) {
      const GAS bf16_t* rp = (const GAS bf16_t*)rbase + (size_t)(kt * 64 + uw * 16 + dkey) * 32 + dchunk * 8;
      __builtin_amdgcn_global_load_lds((const GAS unsigned*)rp, (LAS unsigned*)((LAS char*)buf + 2 * 4096 + uw * 1024), 16, 0, 0);
    }
  };
  auto gload = [&](int kt) {
#pragma unroll
    for (int i = 0; i < NVB / 2; ++i) { const int idx = tid + 256 * i, vd = idx >> 3, g = idx & 7; vreg[i] = ldg16(vbase + (size_t)vd * Tk + kt * 64 + g * 8); }
  };
  auto lstore = [&](char* buf) {
#pragma unroll
    for (int i = 0; i < NVB / 2; ++i) {
      const int idx = tid + 256 * i, vd = idx >> 3, g = idx & 7, pnl = g >> 2, g4 = g & 3, hi = g4 >> 1, q0 = 2 * (g4 & 1);
      char* base = buf + KOFF + pnl * PV + vd * 64 + hi * 8;
      *(u32x2*)(base + ((q0 ^ swz(vd)) << 4)) = (u32x2){vreg[i].x, vreg[i].y};
      *(u32x2*)(base + (((q0 + 1) ^ swz(vd)) << 4)) = (u32x2){vreg[i].z, vreg[i].w};
    }
  };
  __syncthreads();
  kdma(0, lds); gload(0); lstore(lds);
  asm volatile("s_waitcnt vmcnt(0)" ::: "memory");
  __syncthreads();
  const int foff = fr * 64 + ((fq ^ swz(fr)) << 4);
  for (int kt = 0; kt < nkt; ++kt) {
    char* cur = lds + (kt & 1) * BUF;
    const bool more = (kt + 1) < nkt;
    if (more) { kdma(kt + 1, lds + ((kt + 1) & 1) * BUF); gload(kt + 1); }
    __builtin_amdgcn_sched_barrier(0);
    f32x4 s[4][2];
#pragma unroll
    for (int kb = 0; kb < 4; ++kb) {
      s[kb][0] = (f32x4){0.f, 0.f, 0.f, 0.f}; s[kb][1] = (f32x4){0.f, 0.f, 0.f, 0.f};
#pragma unroll
      for (int ks = 0; ks < NKP; ++ks) {
        const bf16x8 kf = *(const bf16x8*)(cur + ks * 4096 + kb * 1024 + foff);
        s[kb][0] = mfma16(kf, qf[0][ks], s[kb][0]); s[kb][1] = mfma16(kf, qf[1][ks], s[kb][1]);
      }
    }
    bf16x8 pf[2][2];
#pragma unroll
    for (int qb = 0; qb < 2; ++qb) {
      if (MODE == 0) {
        float mx = s[0][qb][0];
#pragma unroll
        for (int kb = 0; kb < 4; ++kb)
#pragma unroll
          for (int r = 0; r < 4; ++r) mx = fmaxf(mx, s[kb][qb][r]);
        mx = fmaxf(mx, __shfl_xor(mx, 16)); mx = fmaxf(mx, __shfl_xor(mx, 32));
        const float mn = fmaxf(mrow[qb], mx), alpha = ex2(mrow[qb] - mn);
        mrow[qb] = mn;
        float ls = 0.f;
#pragma unroll
        for (int kb = 0; kb < 4; ++kb)
#pragma unroll
          for (int r = 0; r < 4; ++r) { const float e = ex2(s[kb][qb][r] - mn); s[kb][qb][r] = e; ls += e; }
        lrow[qb] = lrow[qb] * alpha + ls;
#pragma unroll
        for (int vb = 0; vb < NVB; ++vb) o[vb][qb] *= alpha;
      } else {
        const int tq = tq0 + qb * 16;
#pragma unroll
        for (int kb = 0; kb < 4; ++kb)
#pragma unroll
          for (int r = 0; r < 4; ++r) {
            const int d = tq - (kt * 64 + kb * 16 + fq * 4 + r);
            const float dec = d > 0 ? ex2((float)d * lgf) : (d < 0 ? ex2((float)(-d) * lgb) : 2.f);
            s[kb][qb][r] *= dec;
          }
      }
#pragma unroll
      for (int g = 0; g < 2; ++g) {
        u32x4 w; w.x = pk2(s[2 * g][qb][0], s[2 * g][qb][1]); w.y = pk2(s[2 * g][qb][2], s[2 * g][qb][3]);
        w.z = pk2(s[2 * g + 1][qb][0], s[2 * g + 1][qb][1]); w.w = pk2(s[2 * g + 1][qb][2], s[2 * g + 1][qb][3]);
        pf[qb][g] = as_bf8(w);
      }
    }
#pragma unroll
    for (int vb = 0; vb < NVB; ++vb)
#pragma unroll
      for (int g = 0; g < 2; ++g) {
        const bf16x8 vf = *(const bf16x8*)(cur + KOFF + g * PV + vb * 1024 + foff);
        o[vb][0] = mfma16(vf, pf[0][g], o[vb][0]); o[vb][1] = mfma16(vf, pf[1][g], o[vb][1]);
      }
    __builtin_amdgcn_sched_barrier(0);
    if (more) lstore(lds + ((kt + 1) & 1) * BUF);
    asm volatile("s_waitcnt vmcnt(0)" ::: "memory");
    __syncthreads();
  }
  bf16_t* G = (bf16_t*)(ws + (MODE == 0 ? O_MZ : O_RZ));
#pragma unroll
  for (int qb = 0; qb < 2; ++qb) {
    const int tok = tok0 + wid * 32 + qb * 16 + fr;
    float mul, sub;
    if (MODE == 0) {
      float lt = lrow[qb]; lt += __shfl_xor(lt, 16); lt += __shfl_xor(lt, 32);
      mul = 1.f / lt; sub = 0.f;
    } else {
      float sm = 0.f;
#pragma unroll
      for (int vb = 0; vb < NVB; ++vb) sm += (o[vb][qb][0] + o[vb][qb][1]) + (o[vb][qb][2] + o[vb][qb][3]);
      sm += __shfl_xor(sm, 16); sm += __shfl_xor(sm, 32);
      const float mu = sm * (1.f / 128.f);
      float vs = 0.f;
#pragma unroll
      for (int vb = 0; vb < NVB; ++vb)
#pragma unroll
        for (int r = 0; r < 4; ++r) { const float dd = o[vb][qb][r] - mu; vs += dd * dd; }
      vs += __shfl_xor(vs, 16); vs += __shfl_xor(vs, 32);
      mul = rsqrtf(vs * (1.f / 128.f) + EPSN); sub = mu;
    }
#pragma unroll
    for (int vb = 0; vb < NVB; ++vb) {
      bf16_t* gp = G + (size_t)tok * 512 + h * (NVB * 16) + vb * 16 + fq * 4;
      const u32x2 gz = *(const u32x2*)gp;
      f32x4 y;
      y[0] = (o[vb][qb][0] - sub) * mul * bflo(gz.x); y[1] = (o[vb][qb][1] - sub) * mul * bfhi(gz.x);
      y[2] = (o[vb][qb][2] - sub) * mul * bflo(gz.y); y[3] = (o[vb][qb][3] - sub) * mul * bfhi(gz.y);
      *(u32x2*)gp = pk4(y);
    }
  }
}

__device__ __forceinline__ bf16x8 scale8(u32x4 raw, const float (&d)[8]) {
  u32x4 w;
  w.x = pk2(bflo(raw.x) * d[0], bfhi(raw.x) * d[1]); w.y = pk2(bflo(raw.y) * d[2], bfhi(raw.y) * d[3]);
  w.z = pk2(bflo(raw.z) * d[4], bfhi(raw.z) * d[5]); w.w = pk2(bflo(raw.w) * d[6], bfhi(raw.w) * d[7]);
  return as_bf8(w);
}
__device__ __forceinline__ void state_item(const Params& p, int l, int item) {
  const int tid = tidx(), lane = tid & 63, wid = tid >> 6, fr = lane & 15, fq = lane >> 4;
  const int b = item >> 2, h = item & 3;
  const bf16_t* RVT = (const bf16_t*)(p.ws + O_RVT) + (size_t)(b * 4 + h) * 128 * 256;
  const bf16_t* RKT = (const bf16_t*)(p.ws + O_RKT) + (size_t)(b * 4 + h) * 64 * 256;
  const float xf = p.ret_logit[(l * 2 + 0) * 4 + h], xb = p.ret_logit[(l * 2 + 1) * 4 + h];
  const float lgf = -log1pf(expf(-xf)) * 1.44269504089f, lgb = -log1pf(expf(-xb)) * 1.44269504089f;
  f32x4 acc[2][2][4];
#pragma unroll
  for (int d = 0; d < 2; ++d)
#pragma unroll
    for (int v = 0; v < 2; ++v)
#pragma unroll
      for (int k = 0; k < 4; ++k) acc[d][v][k] = (f32x4){0.f, 0.f, 0.f, 0.f};
#pragma unroll 2
  for (int ks = 0; ks < 8; ++ks) {
    const int j0 = ks * 32 + fq * 8;
    float df[8], db[8];
#pragma unroll
    for (int e = 0; e < 8; ++e) { df[e] = exp2f((float)(255 - j0 - e) * lgf); db[e] = exp2f((float)(j0 + e) * lgb); }
    bf16x8 af[2];
#pragma unroll
    for (int v = 0; v < 2; ++v) af[v] = *(const bf16x8*)(RVT + (size_t)((wid * 2 + v) * 16 + fr) * 256 + j0);
#pragma unroll
    for (int k = 0; k < 4; ++k) {
      const u32x4 raw = *(const u32x4*)(RKT + (size_t)(k * 16 + fr) * 256 + j0);
      const bf16x8 kf = scale8(raw, df), kb = scale8(raw, db);
#pragma unroll
      for (int v = 0; v < 2; ++v) { acc[0][v][k] = mfma16(af[v], kf, acc[0][v][k]); acc[1][v][k] = mfma16(af[v], kb, acc[1][v][k]); }
    }
  }
  float* O = p.out + OUT_RET;
#pragma unroll
  for (int d = 0; d < 2; ++d)
#pragma unroll
    for (int v = 0; v < 2; ++v)
#pragma unroll
      for (int k = 0; k < 4; ++k) {
        const int dk = k * 16 + fr, vd = (wid * 2 + v) * 16 + fq * 4;
        *(f32x4*)(O + ((size_t)((((b * 2 + l) * 2 + d) * 4 + h) * 64 + dk)) * 128 + vd) = acc[d][v][k];
      }
}

__device__ __forceinline__ void keyprep_item(const Params& p, int l, int item) {
  const int tid = tidx(), lane = tid & 63, wid = tid >> 6;
  char* ws = wsp(p.ws);
  bf16_t* CKVA = (bf16_t*)(ws + O_CKVA);
  bf16_t* KRA = (bf16_t*)(ws + O_KRA);
#pragma unroll
  for (int i = 0; i < 4; ++i) {
    const int R = item * 16 + wid * 4 + i;
    int smp = 0, b, t = 0, tok = 0, ctx = 0, pp = 0;
    if (R < NPR) { tok = R; b = R >> 8; t = R & 255; }
    else { smp = 1; const int s = R - NPR; b = s / 1536; pp = s - b * 1536; if (pp < 512) ctx = 1; else { t = pp - 512; tok = NPR + b * 1024 + t; } }
    if (ctx) {
      const f32x4 v = *(const f32x4*)(p.cache_ckv + ((size_t)((b * 2 + l) * 512 + pp)) * 256 + lane * 4);
      *(u32x2*)(CKVA + (size_t)R * 256 + lane * 4) = pk4(v);
      if (lane < 32) KRA[(size_t)R * 32 + lane] = tobf(p.cache_krope[((size_t)((b * 2 + l) * 512 + pp)) * 32 + lane]);
      continue;
    }
    const f32x4 v = *(const f32x4*)((const float*)(ws + O_KVLAT) + (size_t)tok * 256 + lane * 4);
    float ss = v[0] * v[0] + v[1] * v[1] + v[2] * v[2] + v[3] * v[3];
    ss = wave_sum(ss);
    const float rstd = rsqrtf(ss * (1.f / 256.f) + EPSN);
    const f32x4 g = *(const f32x4*)(p.kv_norm_g + l * 256 + lane * 4);
    f32x4 y;
#pragma unroll
    for (int e = 0; e < 4; ++e) y[e] = v[e] * rstd * g[e];
    *(u32x2*)(CKVA + (size_t)R * 256 + lane * 4) = pk4(y);
    if (!smp) *(f32x4*)(p.out + OUT_CKV + ((size_t)((b * 2 + l) * 256 + t)) * 256 + lane * 4) = y;
    const int d = lane & 31;
    const float x = ((const float*)(ws + O_KR))[(size_t)tok * 32 + d];
    float yk = x;
    if (smp) {
      const float pr = __shfl_xor(x, 8);
      const int hd = d >> 4, i16 = d & 15, f = i16 & 7;
      const int pos = hd ? (t & 63) : (t >> 6);
      const float* rt = (const float*)(ws + O_ROPE) + (pos * 8 + f) * 2;
      const float cs = rt[0], sn = rt[1];
      yk = i16 < 8 ? x * cs - pr * sn : pr * sn + x * cs;
    } else if (lane < 32) {
      p.out[OUT_KR + ((size_t)((b * 2 + l) * 256 + t)) * 32 + d] = x;
    }
    if (lane < 32) KRA[(size_t)R * 32 + d] = tobf(yk);
  }
}

__device__ __forceinline__ void f1_tile(const Params& p, int tile, char* lds) {
  const int tid = tidx(), lane = tid & 63, wid = tid >> 6, wm = wid >> 1, wn = wid & 1, fr = lane & 15, fq = lane >> 4;
  const int m = tile >> 3, g = (tile >> 1) & 3, nh = tile & 1, m0 = m * 128;
  char* ws = wsp(p.ws);
  f32x4 acc[4][4];
  zero_acc(acc);
  gemm_core<false>((const bf16_t*)(ws + O_FU) + (size_t)m0 * 512 + g * 128, 512, (const bf16_t*)(ws + O_CS) + (size_t)nh * 128 * 128, 128, 128, acc, lds);
  bf16_t* UT = (bf16_t*)(ws + O_UT);
#pragma unroll
  for (int i = 0; i < 4; ++i) {
    const int tok = m0 + wm * 64 + i * 16 + fq * 4;
    size_t base; int T, b, t;
    if (tok < NPR) { b = tok >> 8; t = tok & 255; T = 256; base = 0; } else { const int s = tok - NPR; b = s >> 10; t = s & 1023; T = 1024; base = (size_t)NPR * 1024; }
#pragma unroll
    for (int j = 0; j < 4; ++j) {
      const int k2 = wn * 64 + j * 16 + fr;
      *(u32x2*)(UT + base + ((size_t)(b * 4 + g) * 128 + k2) * (2 * T) + nh * T + t) = pk4(acc[i][j]);
    }
  }
}

__device__ __forceinline__ void qup_tile(const Params& p, int l, int tile, char* lds) {
  const int tid = tidx(), lane = tid & 63, wid = tid >> 6, wm = wid >> 1, wn = wid & 1, fr = lane & 15, fq = lane >> 4;
  const int m = tile % 96, nt = tile / 96, m0 = m * 128, n0 = nt * 128;
  char* ws = wsp(p.ws);
  const bf16_t* QL = (const bf16_t*)(ws + O_QLAT) + (size_t)m0 * 384;
  float rsv4[4];
  {
    float* rs = (float*)lds;
    __syncthreads();
#pragma unroll 1
    for (int r0 = 0; r0 < 32; r0 += 4) {
      float ss[4];
#pragma unroll
      for (int u = 0; u < 4; ++u) {
        u32x4 w = (u32x4){0u, 0u, 0u, 0u};
        if (lane < 48) w = ldg16(QL + (size_t)(wid * 32 + r0 + u) * 384 + lane * 8);
        ss[u] = bflo(w.x) * bflo(w.x) + bfhi(w.x) * bfhi(w.x) + bflo(w.y) * bflo(w.y) + bfhi(w.y) * bfhi(w.y) + bflo(w.z) * bflo(w.z) + bfhi(w.z) * bfhi(w.z) + bflo(w.w) * bflo(w.w) + bfhi(w.w) * bfhi(w.w);
      }
#pragma unroll
      for (int u = 0; u < 4; ++u) { const float t = wave_sum(ss[u]); if (lane == 0) rs[wid * 32 + r0 + u] = rsqrtf(t * (1.f / 384.f) + EPSN); }
    }
    __syncthreads();
#pragma unroll
    for (int i = 0; i < 4; ++i) rsv4[i] = rs[wm * 64 + i * 16 + fr];
    __syncthreads();
  }
  f32x4 acc[4][4];
  zero_acc(acc);
  gemm_core<true>(QL, 384, (const bf16_t*)(ws + O_WQ) + ((size_t)l * 768 + n0) * 384, 384, 384, acc, lds);
  bf16_t* QB = (bf16_t*)(ws + O_QB);
  const float qscale = 0.10206207261596577f * 1.44269504089f;
#pragma unroll
  for (int i = 0; i < 4; ++i) {
    const int rl = wm * 64 + i * 16 + fr, tok = m0 + rl;
    const float sc = rsv4[i] * qscale;
    const int smp = tok >= NPR, t = (tok - NPR) & 1023;
#pragma unroll
    for (int j = 0; j < 4; ++j) {
      const int cb = n0 + wn * 64 + j * 16, within = cb % 96;
      f32x4 v = acc[i][j] * sc;
      if (within >= 64) {
        f32x4 pr;
#pragma unroll
        for (int e = 0; e < 4; ++e) pr[e] = __shfl_xor(v[e], 32);
        if (smp) {
          const int pos = within >= 80 ? (t & 63) : (t >> 6);
          const float* rt = (const float*)(ws + O_ROPE) + (pos * 8 + (fq & 1) * 4) * 2;
          const f32x4 c01 = *(const f32x4*)rt, c23 = *(const f32x4*)(rt + 4);
          const float cs4[4] = {c01[0], c01[2], c23[0], c23[2]}, sn4[4] = {c01[1], c01[3], c23[1], c23[3]};
#pragma unroll
          for (int e = 0; e < 4; ++e) v[e] = fq < 2 ? v[e] * cs4[e] - pr[e] * sn4[e] : pr[e] * sn4[e] + v[e] * cs4[e];
        }
      }
      *(u32x2*)(QB + (size_t)tok * 768 + cb + fq * 4) = pk4(v);
    }
  }
}

__device__ __forceinline__ void kvup_tile(const Params& p, int l, int tile, char* lds) {
  const int tid = tidx(), lane = tid & 63, wid = tid >> 6, wm = wid >> 1, wn = wid & 1, fr = lane & 15, fq = lane >> 4;
  const int m = tile % 112, nt = tile / 112, m0 = m * 128, n0 = nt * 128;
  char* ws = wsp(p.ws);
  const bf16_t* A = (const bf16_t*)(ws + O_CKVA) + (size_t)m0 * 256;
  const bf16_t* B = (const bf16_t*)(ws + O_WKV) + ((size_t)l * 1024 + n0) * 256;
  f32x4 acc[4][4];
  zero_acc(acc);
  if (nt < 4) {
    gemm_core<true>(A, 256, B, 256, 256, acc, lds);
    bf16_t* KB = (bf16_t*)(ws + O_KB);
#pragma unroll
    for (int i = 0; i < 4; ++i) {
      const int R = m0 + wm * 64 + i * 16 + fr;
#pragma unroll
      for (int j = 0; j < 4; ++j) *(u32x2*)(KB + (size_t)R * 512 + n0 + wn * 64 + j * 16 + fq * 4) = pk4(acc[i][j]);
    }
  } else {
    gemm_core<false>(A, 256, B, 256, 256, acc, lds);
    bf16_t* VT = (bf16_t*)(ws + O_VT);
#pragma unroll
    for (int i = 0; i < 4; ++i) {
      const int R = m0 + wm * 64 + i * 16 + fq * 4;
      size_t base; int Tk, b, k;
      if (R < NPR) { b = R >> 8; k = R & 255; Tk = 256; base = 0; } else { const int s = R - NPR; b = s / 1536; k = s - b * 1536; Tk = 1536; base = (size_t)NPR * 512; }
#pragma unroll
      for (int j = 0; j < 4; ++j) {
        const int c = n0 - 512 + wn * 64 + j * 16 + fr, h = c >> 6, vd = c & 63;
        *(u32x2*)(VT + base + ((size_t)(b * 8 + h) * 64 + vd) * Tk + k) = pk4(acc[i][j]);
      }
    }
  }
}

template <int NJ>
__device__ __forceinline__ void f2_tile(const Params& p, int tile, char* lds) {
  const int tid = tidx(), lane = tid & 63, wid = tid >> 6, wm = wid >> 1, wn = wid & 1, fr = lane & 15, fq = lane >> 4;
  char* ws = wsp(p.ws);
  const bf16_t *A, *B; int K, tokb, g, nh = 0; float scale;
  if (NJ == 2) {
    const int b = tile >> 6, mt = (tile >> 1) & 7; g = (tile >> 4) & 3; nh = tile & 1;
    A = (const bf16_t*)(ws + O_D1024) + (size_t)mt * 128 * 2048; K = 2048;
    B = (const bf16_t*)(ws + O_UT) + (size_t)NPR * 1024 + ((size_t)(b * 4 + g) * 128 + nh * 64) * 2048;
    tokb = NPR + b * 1024 + mt * 128; scale = 0.00276213586400995f;
  } else {
    const int b = tile >> 3, mt = tile & 1; g = (tile >> 1) & 3;
    A = (const bf16_t*)(ws + O_D256) + (size_t)mt * 128 * 512; K = 512;
    B = (const bf16_t*)(ws + O_UT) + (size_t)(b * 4 + g) * 128 * 512;
    tokb = b * 256 + mt * 128; scale = 0.0055242717280199f;
  }
  f32x4 acc[4][NJ];
#pragma unroll
  for (int i = 0; i < 4; ++i)
#pragma unroll
    for (int j = 0; j < NJ; ++j) acc[i][j] = (f32x4){0.f, 0.f, 0.f, 0.f};
  gemm_core<true, NJ>(A, K, B, K, K, acc, lds);
  bf16_t* FZ = (bf16_t*)(ws + O_FZ);
#pragma unroll
  for (int i = 0; i < 4; ++i) {
    const int tok = tokb + wm * 64 + i * 16 + fr;
#pragma unroll
    for (int j = 0; j < NJ; ++j) {
      bf16_t* gp = FZ + (size_t)tok * 512 + g * 128 + nh * 64 + wn * (NJ * 16) + j * 16 + fq * 4;
      const u32x2 gz = *(const u32x2*)gp;
      f32x4 y;
      y[0] = acc[i][j][0] * scale * bflo(gz.x); y[1] = acc[i][j][1] * scale * bfhi(gz.x);
      y[2] = acc[i][j][2] * scale * bflo(gz.y); y[3] = acc[i][j][3] * scale * bfhi(gz.y);
      *(u32x2*)gp = pk4(y);
    }
  }
}

template <int NJ>
__device__ __forceinline__ void s6_tile(const Params& p, int l, int tile, int ntile, char* lds, int& par, bool& primed) {
  const int tid = tidx(), lane = tid & 63, wid = tid >> 6, wm = wid >> 1, wn = wid & 1, fr = lane & 15, fq = lane >> 4;
  constexpr int NT = 32 / NJ, BN = NJ * 32;
  const int m = (tile / (32 * NT)) * 32 + (tile % 32), nt = (tile % (32 * NT)) / 32, m0 = m * 128, n0 = nt * BN;
  char* ws = wsp(p.ws);
  const char* H8 = (const char*)(ws + O_H8);
  const char* W8 = (const char*)(ws + O_WG8) + (size_t)l * 3072 * 1024;
  const bf16_t* Wb = (const bf16_t*)(ws + O_WBR) + (size_t)(l * 3) * 1024 * 512;
  f32x4 tot[4][NJ], acc[4][NJ];
  unsigned sg[4][NJ];
#pragma unroll
  for (int i = 0; i < 4; ++i)
#pragma unroll
    for (int j = 0; j < NJ; ++j) tot[i][j] = (f32x4){0.f, 0.f, 0.f, 0.f};
#pragma unroll 1
  for (int nb = 0; nb < 3; ++nb) {
    u32x2 totp[4][NJ];
#pragma unroll
    for (int i = 0; i < 4; ++i)
#pragma unroll
      for (int j = 0; j < NJ; ++j) { totp[i][j] = pk4(tot[i][j]); acc[i][j] = (f32x4){0.f, 0.f, 0.f, 0.f}; }
    const size_t boff = nb == 0 ? O_RZ : (nb == 1 ? O_MZ : O_FZ);
    const bf16_t* brA = (const bf16_t*)(ws + boff) + (size_t)m0 * 512;
    const bf16_t* brB = Wb + ((size_t)nb * 1024 + n0) * 512;
    gemm_bytes<true, NJ, 2, true>(H8 + (size_t)m0 * 1024, 1024, W8 + ((size_t)nb * 1024 + n0) * 1024, 1024, 1024, acc, lds, par, primed, (const char*)brA, 1024, (const char*)brB, 1024);
#pragma unroll
    for (int i = 0; i < 4; ++i)
#pragma unroll
      for (int j = 0; j < NJ; ++j) {
        unsigned q = 0;
#pragma unroll
        for (int e = 0; e < 4; ++e) {
          const unsigned qe = (unsigned)fmaxf(sigm_f(acc[i][j][e] * 0.03125f) * 255.f + 0.5f, 1.f);
          q |= qe << (8 * e);
          tot[i][j][e] = (e == 0 ? bflo(totp[i][j].x) : e == 1 ? bfhi(totp[i][j].x) : e == 2 ? bflo(totp[i][j].y) : bfhi(totp[i][j].y)) * __builtin_amdgcn_rcpf((float)qe * (1.f / 255.f));
        }
        sg[i][j] = q;
      }
    const char *nA = nullptr, *nB = nullptr;
    if (nb < 2) { nA = H8 + (size_t)m0 * 1024; nB = W8 + ((size_t)(nb + 1) * 1024 + n0) * 1024; }
    else if (ntile >= 0) { nA = H8 + (size_t)(((ntile / (32 * NT)) * 32 + (ntile % 32)) * 128) * 1024; nB = W8 + (size_t)(((ntile % (32 * NT)) / 32) * BN) * 1024; }
    gemm_bytes<true, NJ, 2, false>((const char*)brA, 1024, (const char*)brB, 1024, 1024, tot, lds, par, true, nA, 1024, nB, 1024);
    primed = nA != nullptr;
#pragma unroll
    for (int i = 0; i < 4; ++i)
#pragma unroll
      for (int j = 0; j < NJ; ++j) {
        tot[i][j][0] *= (float)(sg[i][j] & 0xffu) * (1.f / 255.f); tot[i][j][1] *= (float)((sg[i][j] >> 8) & 0xffu) * (1.f / 255.f);
        tot[i][j][2] *= (float)((sg[i][j] >> 16) & 0xffu) * (1.f / 255.f); tot[i][j][3] *= (float)(sg[i][j] >> 24) * (1.f / 255.f);
      }
  }
  bf16_t* MG = (bf16_t*)(ws + O_UT);
#pragma unroll
  for (int i = 0; i < 4; ++i) {
    const int tok = m0 + wm * 64 + i * 16 + fr;
#pragma unroll
    for (int j = 0; j < NJ; ++j) *(u32x2*)(MG + (size_t)tok * 1024 + n0 + wn * (NJ * 16) + j * 16 + fq * 4) = pk4(tot[i][j]);
  }
}

__device__ __forceinline__ void s7_tile(const Params& p, int l, int tile, const float* xp, const float* xs, char* lds) {
  const int tid = tidx(), lane = tid & 63, wid = tid >> 6, wm = wid >> 1, wn = wid & 1, fr = lane & 15, fq = lane >> 4;
  const int m = (tile / 512) * 32 + (tile % 32), nt = (tile % 512) / 32, m0 = m * 128, n0 = nt * 64;
  char* ws = wsp(p.ws);
  f32x4 acc[4][2];
#pragma unroll
  for (int i = 0; i < 4; ++i) { acc[i][0] = (f32x4){0.f, 0.f, 0.f, 0.f}; acc[i][1] = (f32x4){0.f, 0.f, 0.f, 0.f}; }
  gemm_core<true, 2>((const bf16_t*)(ws + O_UT) + (size_t)m0 * 1024, 1024, (const bf16_t*)(ws + O_WO) + ((size_t)l * 1024 + n0) * 1024, 1024, 1024, acc, lds);
#pragma unroll
  for (int i = 0; i < 4; ++i) {
    const int tok = m0 + wm * 64 + i * 16 + fr;
    const float* src = tok < NPR ? xp + (size_t)tok * 1024 : xs + (size_t)(tok - NPR) * 1024;
    const int v = tok < NPR ? 0 : 1 + ((tok - NPR) >> 10);
    const float* gate = (const float*)(ws + O_MOD) + (l * 5 + v) * 3072 + 2048;
#pragma unroll
    for (int j = 0; j < 2; ++j) {
      const int col = n0 + wn * 32 + j * 16 + fq * 4;
      const f32x4 x = *(const f32x4*)(src + col), gt = *(const f32x4*)(gate + col);
      f32x4 y;
#pragma unroll
      for (int e = 0; e < 4; ++e) y[e] = x[e] + gt[e] * acc[i][j][e];
      *(f32x4*)(p.out + (size_t)tok * 1024 + col) = y;
    }
  }
}

constexpr int NPHASE = 16;
__device__ __forceinline__ int q_issue(unsigned* ctr) {
  int v = 0;
  if (threadIdx.x == 0) v = (int)__hip_atomic_fetch_add(ctr, 1u, __ATOMIC_RELAXED, __HIP_MEMORY_SCOPE_AGENT);
  return v;
}
__device__ __forceinline__ int q_bcast(int v, char* lds) {
  __syncthreads();
  if (threadIdx.x == 0) *(volatile int*)lds = v;
  __syncthreads();
  const int it = *(volatile int*)lds;
  __syncthreads();
  return it;
}
__device__ __forceinline__ void run_phase(const Params& p, int ph, char* lds, unsigned* qctr) {
  const int bid = blockIdx.x, nb = gridDim.x;
  if (ph == 0) { for (int i = bid; i < P0_N; i += nb) phase0_item(p, i, lds); return; }
  if (ph == 15) { for (int i = bid; i < 512; i += nb) final_item(p, i); return; }
  const int l = (ph - 1) / 7, s = (ph - 1) % 7;
  const float* xp = l == 0 ? p.x_prompt : p.out;
  const float* xs = l == 0 ? p.x_sample : p.out + (size_t)NPR * 1024;
  switch (s) {
    case 0: for (int i = bid; i < 512; i += nb) norm_item(p, l, i, xp, xs); break;
    case 1: for (int i = bid; i < 2880; i += nb) s2_tile(p, l, i, lds); break;
    case 2:
      for (int i = q_bcast(q_issue(qctr + ph), lds); i < 2752;) {
        if (i < 128) attn_item<1>(p, l, i, lds);
        else if (i < 1024) keyprep_item(p, l, i - 128);
        else if (i < 1280) attn_item<1>(p, l, 128 + (i - 1024), lds);
        else if (i < 1408) state_item(p, l, i - 1280);
        else if (i < 1984) qup_tile(p, l, i - 1408, lds);
        else f1_tile(p, i - 1984, lds);
        i = q_bcast(q_issue(qctr + ph), lds);
      }
      break;
    case 3:
      for (int i = q_bcast(q_issue(qctr + ph), lds); i < 1408;) {
        if (i < 256) f2_tile<2>(p, i, lds);
        else if (i < 512) f2_tile<4>(p, i - 256, lds);
        else kvup_tile(p, l, i - 512, lds);
        i = q_bcast(q_issue(qctr + ph), lds);
      }
      break;
    case 4:
      for (int i = q_bcast(q_issue(qctr + ph), lds); i < 768;) {
        attn_item<0>(p, l, i, lds);
        i = q_bcast(q_issue(qctr + ph), lds);
      }
      break;
    case 5: { int par = 0; bool primed = false; for (int i = bid; i < 768; i += nb) s6_tile<4>(p, l, i, (i + nb < 768) ? i + nb : -1, lds, par, primed); } break;
    case 6: for (int i = bid; i < 1536; i += nb) s7_tile(p, l, i, xp, xs, lds); break;
  }
}

#define XB_TMO      128
#define XB_XCNT(j)  (256  + 64 * (j))
#define XB_XSUB(j)  (1280 + 64 * (j))
#define XB_XGEN(j)  (2304 + 64 * (j))
#define XB_TOP      3328
#define XB_TOPGEN   3392
#define XCD_BAR_WORDS 3456
#define XB_SPIN_CAP (1u << 18)
__device__ __forceinline__ unsigned xb_ld(unsigned* p)              { return __hip_atomic_load(p, __ATOMIC_RELAXED, __HIP_MEMORY_SCOPE_AGENT); }
__device__ __forceinline__ unsigned xb_add(unsigned* p, unsigned v) { return __hip_atomic_fetch_add(p, v, __ATOMIC_RELAXED, __HIP_MEMORY_SCOPE_AGENT); }
__device__ __forceinline__ unsigned xb_xcc_id() { return (unsigned)__builtin_amdgcn_s_getreg((3 << 11) | 20) & 0xFu; }
#define XB_SPIN(cond, bar) do { unsigned _sp = 0; while (cond) { __builtin_amdgcn_s_sleep(1); \
    if ((++_sp & 255u) == 0u) { if (xb_ld(&(bar)[XB_TMO])) break; if (_sp > XB_SPIN_CAP) { atomicAdd(&(bar)[XB_TMO], 1u); break; } } } } while (0)
__device__ __forceinline__ void xcd_barrier_complete(unsigned* bar, unsigned x, unsigned& nloc, unsigned& nx) {
  const unsigned G = gridDim.x;
  unsigned sum, cnt, mine, sp = 0u;
  for (;;) {
    sum = 0u; cnt = 0u; mine = 0u;
#pragma unroll
    for (unsigned j = 0; j < 16; ++j) { const unsigned c = xb_ld(&bar[XB_XCNT(j)]); sum += c; cnt += (c > 0u) ? 1u : 0u; mine = (j == x) ? c : mine; }
    if (sum == G) break;
    __builtin_amdgcn_s_sleep(1);
    if ((++sp & 255u) == 0u) { if (xb_ld(&bar[XB_TMO])) break; if (sp > XB_SPIN_CAP) { atomicAdd(&bar[XB_TMO], 1u); break; } }
  }
  nloc = mine > 0u ? mine : 1u; nx = cnt > 0u ? cnt : 1u;
}
__device__ __forceinline__ void xcd_barrier(unsigned* bar, unsigned x, unsigned& nloc, unsigned& nx) {
  asm volatile("s_waitcnt vmcnt(0)" ::: "memory");
  __syncthreads();
  if (threadIdx.x == 0) {
    __builtin_amdgcn_s_waitcnt(0);
    if (nloc == 0u) xcd_barrier_complete(bar, x, nloc, nx);
    const unsigned old = xb_add(&bar[XB_XSUB(x)], 1u);
    const unsigned gen = old / nloc;
    if (old + 1u == (gen + 1u) * nloc) {
      __builtin_amdgcn_fence(__ATOMIC_RELEASE, "agent");
      asm volatile("s_waitcnt vmcnt(0)" ::: "memory");
      const unsigned og = xb_add(&bar[XB_TOP], 1u);
      const unsigned tg = og / nx;
      if (og + 1u == (tg + 1u) * nx) xb_add(&bar[XB_TOPGEN], 1u);
      else XB_SPIN(xb_ld(&bar[XB_TOPGEN]) == tg, bar);
      __builtin_amdgcn_fence(__ATOMIC_ACQUIRE, "agent");
      xb_add(&bar[XB_XGEN(x)], 1u);
      asm volatile("s_waitcnt vmcnt(0)" ::: "memory");
    } else {
      XB_SPIN(xb_ld(&bar[XB_XGEN(x)]) == gen, bar);
      __builtin_amdgcn_fence(__ATOMIC_ACQUIRE, "agent");
      asm volatile("s_waitcnt vmcnt(0)" ::: "memory");
    }
  }
  __syncthreads();
}

__global__ void __launch_bounds__(256, 2) mk_fwd(Params p) {
  __shared__ __attribute__((aligned(16))) char lds[LDS_TOTAL];
  cg::grid_group grid = cg::this_grid();
  unsigned* bar = (unsigned*)(p.ws + O_BAR);
  const unsigned xcc = xb_xcc_id();
  if (threadIdx.x == 0) (void)xb_add(&bar[XB_XCNT(xcc)], 1u);
  unsigned nloc = 0u, nx = 0u;
  if (gridDim.x == 0x7fffffffu) grid.sync();
#pragma unroll 1
  for (int ph = 0; ph < NPHASE; ++ph) {
    run_phase(p, ph, lds, bar);
    if (ph + 1 < NPHASE) xcd_barrier(bar, xcc, nloc, nx);
  }
}

extern "C" void kernel_launch(void* const* d_in, const int* in_sizes, int n_in, void* d_out, int out_size, void* d_ws, size_t ws_size,
                              hipStream_t stream) {
  Params p{};
  p.x_prompt = (const float*)d_in[0]; p.x_sample = (const float*)d_in[1]; p.cache_ckv = (const float*)d_in[2]; p.cache_krope = (const float*)d_in[3];
  p.state_ret = (const float*)d_in[4]; p.c = (const float*)d_in[5]; p.c_ctx = (const float*)d_in[6]; p.norm_g = (const float*)d_in[7];
  p.w_mod = (const float*)d_in[8]; p.b_mod = (const float*)d_in[9]; p.w_in = (const float*)d_in[10]; p.ret_logit = (const float*)d_in[11];
  p.q_norm_g = (const float*)d_in[12]; p.w_q_up = (const float*)d_in[13]; p.kv_norm_g = (const float*)d_in[14]; p.w_kv_up = (const float*)d_in[15];
  p.w_branch = (const float*)d_in[16]; p.w_out = (const float*)d_in[17]; p.final_g = (const float*)d_in[18];
  p.out = (float*)d_out; p.ws = (char*)d_ws;
#if ONE_LAUNCH
  static int grid_blocks = 0;
  if (!grid_blocks) {
    int dev = 0, cus = 0, per_cu = 0;
    hipGetDevice(&dev);
    hipDeviceGetAttribute(&cus, hipDeviceAttributeMultiprocessorCount, dev);
    hipOccupancyMaxActiveBlocksPerMultiprocessor(&per_cu, mk_fwd, 256, 0);
    if (per_cu > 2) per_cu = 2;
    grid_blocks = cus * per_cu;
  }
  hipMemsetAsync((char*)d_ws + O_BAR, 0, XCD_BAR_WORDS * 4, stream);
  void* args[] = {&p};
  hipError_t e = hipLaunchCooperativeKernel((void*)mk_fwd, dim3(grid_blocks), dim3(256), args, 0, stream);
  if (e != hipSuccess) fprintf(stderr, "cooperative launch failed: %s (grid %d)\n", hipGetErrorString(e), grid_blocks);
#endif
}
```

```cpp
#include <hip/hip_runtime.h>
#include <hip/hip_cooperative_groups.h>
#include <stdint.h>
#include <stdio.h>
namespace cg = cooperative_groups;

#ifndef ONE_LAUNCH
#define ONE_LAUNCH 1
#endif

typedef unsigned short bf16_t;
typedef short bf16x8 __attribute__((ext_vector_type(8)));
typedef float f32x4 __attribute__((ext_vector_type(4)));
typedef unsigned u32x4 __attribute__((ext_vector_type(4)));
typedef unsigned u32x2 __attribute__((ext_vector_type(2)));

constexpr int NTOK = 12288, NPR = 8192, NKEY = 14336;
constexpr float EPSN = 1e-6f;

constexpr size_t O_WIN   = 0;
constexpr size_t O_WQ    = O_WIN   + (size_t)2 * 6912 * 1024 * 2;
constexpr size_t O_WKV   = O_WQ    + (size_t)2 * 768 * 384 * 2;
constexpr size_t O_WBR   = O_WKV   + (size_t)2 * 1024 * 256 * 2;
constexpr size_t O_WO    = O_WBR   + (size_t)6 * 1024 * 512 * 2;
constexpr size_t O_CS    = O_WO    + (size_t)2 * 1024 * 1024 * 2;
constexpr size_t O_D256  = O_CS    + (size_t)256 * 128 * 2;
constexpr size_t O_D1024 = O_D256  + (size_t)256 * 512 * 2;
constexpr size_t O_S0T   = O_D1024 + (size_t)1024 * 2048 * 2;
constexpr size_t O_MOD   = O_S0T   + (size_t)64 * 128 * 64 * 2;
constexpr size_t O_H     = O_MOD   + (size_t)2 * 5 * 3072 * 4;
constexpr size_t O_BR8   = O_H;
constexpr size_t O_UT    = O_H     + (size_t)NTOK * 1024 * 2;
constexpr size_t O_RQ    = O_UT    + (size_t)NTOK * 1024 * 2;
constexpr size_t O_RK    = O_RQ    + (size_t)NTOK * 256 * 2;
constexpr size_t O_RKT   = O_RK    + (size_t)NTOK * 256 * 2;
constexpr size_t O_RVT   = O_RKT   + (size_t)NPR * 256 * 2;
constexpr size_t O_KVLAT = O_RVT   + (size_t)NTOK * 512 * 2;
constexpr size_t O_KR    = O_KVLAT + (size_t)NTOK * 256 * 4;
constexpr size_t O_R2END = O_KR    + (size_t)NTOK * 32 * 4;
constexpr size_t O_VT    = O_RQ;
static_assert(O_VT + (size_t)NKEY * 512 * 2 <= O_R2END, "alias overflow");
constexpr size_t O_RZ    = O_R2END;
constexpr size_t O_MZ    = O_RZ    + (size_t)NTOK * 512 * 2;
constexpr size_t O_FZ    = O_MZ    + (size_t)NTOK * 512 * 2;
constexpr size_t O_FU    = O_FZ    + (size_t)NTOK * 512 * 2;
constexpr size_t O_QLAT  = O_FU    + (size_t)NTOK * 512 * 2;
constexpr size_t O_CKVA  = O_QLAT  + (size_t)NTOK * 384 * 2;
constexpr size_t O_KB    = O_CKVA  + (size_t)NKEY * 256 * 2;
constexpr size_t O_KRA   = O_KB    + (size_t)NKEY * 512 * 2;
constexpr size_t O_QB    = O_KRA   + (size_t)NKEY * 32 * 2;
constexpr size_t O_H8    = O_QB    + (size_t)NTOK * 768 * 2;
constexpr size_t O_WG8   = O_H8    + (size_t)NTOK * 1024;
constexpr size_t O_END   = O_WG8   + (size_t)2 * 3072 * 1024;
constexpr size_t O_ROPE  = (O_END + 255) & ~(size_t)255;
constexpr size_t O_BAR   = O_ROPE + 4096;
static_assert(O_BAR + 16384 <= (size_t)256 * 1024 * 1024, "workspace too large");

constexpr size_t OUT_CKV = (size_t)NTOK * 1024;
constexpr size_t OUT_KR  = OUT_CKV + (size_t)32 * 2 * 256 * 256;
constexpr size_t OUT_RET = OUT_KR + (size_t)32 * 2 * 256 * 32;

struct Params {
  const float *x_prompt, *x_sample, *cache_ckv, *cache_krope, *state_ret, *c, *c_ctx, *norm_g, *w_mod, *b_mod,
      *w_in, *ret_logit, *q_norm_g, *w_q_up, *kv_norm_g, *w_kv_up, *w_branch, *w_out, *final_g;
  float* out;
  char* ws;
};

constexpr int PANEL = 128 * 64;
constexpr int ABYTES = 2 * PANEL;
constexpr int STAGE = 2 * ABYTES;
constexpr int LDS_GEMM = 2 * STAGE;
constexpr int LDS_TOTAL = LDS_GEMM;
static_assert(LDS_TOTAL <= 65536, "static LDS");

typedef float f32x2 __attribute__((ext_vector_type(2)));
typedef __bf16 bf16x2v __attribute__((ext_vector_type(2)));
__device__ __forceinline__ unsigned pk2(float lo, float hi) { const f32x2 v = {lo, hi}; return __builtin_bit_cast(unsigned, __builtin_convertvector(v, bf16x2v)); }
__device__ __forceinline__ bf16_t tobf(float x) { return (bf16_t)(pk2(x, 0.f) & 0xffffu); }
typedef int v8i __attribute__((ext_vector_type(8)));
__device__ __forceinline__ float sat8(float x) { return __builtin_amdgcn_fmed3f(x, -448.f, 448.f); }
__device__ __forceinline__ unsigned pk4f8(float a, float b, float c, float d) { unsigned w = 0; a = sat8(a); b = sat8(b); c = sat8(c); d = sat8(d); w = __builtin_amdgcn_cvt_pk_fp8_f32(a, b, w, false); w = __builtin_amdgcn_cvt_pk_fp8_f32(c, d, w, true); return w; }
__device__ __forceinline__ float bflo(unsigned u) { return __uint_as_float(u << 16); }
__device__ __forceinline__ float bfhi(unsigned u) { return __uint_as_float(u & 0xffff0000u); }
__device__ __forceinline__ float ex2(float x) { return __builtin_amdgcn_exp2f(x); }
__device__ __forceinline__ float silu_f(float x) { return x / (1.f + __expf(-x)); }
__device__ __forceinline__ float sigm_f(float x) { return 1.f / (1.f + __expf(-x)); }
__device__ __forceinline__ u32x2 pk4(f32x4 v) { u32x2 r; r.x = pk2(v[0], v[1]); r.y = pk2(v[2], v[3]); return r; }
#define GAS __attribute__((address_space(1)))
#define LAS __attribute__((address_space(3)))
__device__ __forceinline__ u32x4 ldg16(const void* p) { return *(const GAS u32x4*)p; }
__device__ __forceinline__ int tidx() { int t = threadIdx.x; asm volatile("" : "+v"(t)); return t; }
__device__ __forceinline__ char* wsp(const char* w) { unsigned long long v = (unsigned long long)w; asm volatile("" : "+s"(v)); return (char*)v; }
__device__ __forceinline__ int swz(int r) { return (0 - ((r >> 2) & 3)) & 3; }
__device__ __forceinline__ float wave_sum(float v) {
#pragma unroll
  for (int o = 1; o < 64; o <<= 1) v += __shfl_xor(v, o);
  return v;
}
__device__ __forceinline__ f32x4 mfma16(bf16x8 a, bf16x8 b, f32x4 c) { return __builtin_amdgcn_mfma_f32_16x16x32_bf16(a, b, c, 0, 0, 0); }
__device__ __forceinline__ bf16x8 as_bf8(u32x4 v) { return __builtin_bit_cast(bf16x8, v); }

__device__ __forceinline__ void zero_acc(f32x4 (&acc)[4][4]) {
#pragma unroll
  for (int i = 0; i < 4; ++i)
#pragma unroll
    for (int j = 0; j < 4; ++j) acc[i][j] = (f32x4){0.f, 0.f, 0.f, 0.f};
}

template <bool SWAP, int NJ, int PIPE, bool F8>
__device__ __forceinline__ void gemm_bytes(const char* __restrict__ A, int lda, const char* __restrict__ B, int ldb, int Kb,
                                           f32x4 (&acc)[4][NJ], char* lds, int& par, bool primed,
                                           const char* nA, int nlda, const char* nB, int nldb) {
  const int tid = tidx(), lane = tid & 63, wm = (tid >> 6) >> 1, wn = (tid >> 6) & 1;
  const int wid = __builtin_amdgcn_readfirstlane(tid >> 6);
  const int fr = lane & 15, fq = lane >> 4;
  const int fa = (wm * 64 + fr) * 64 + ((fq ^ swz(fr)) << 4);
  const int fb = ABYTES + (wn * NJ * 16 + fr) * 64 + ((fq ^ swz(fr)) << 4);
  const int lrow = lane >> 2, lchunk = (lane & 3) ^ swz(lrow);
  constexpr int NBL = NJ / 2;
  const GAS char* gA = (const GAS char*)(A + (size_t)(wid * 32 + lrow) * lda + lchunk * 16);
  const GAS char* gB = (const GAS char*)(B + (size_t)(wid * NBL * 16 + lrow) * ldb + lchunk * 16);
  const size_t a16 = (size_t)16 * lda, b16 = (size_t)16 * ldb;
  LAS char* ldsA = (LAS char*)lds + wid * 2048;
  LAS char* ldsB = (LAS char*)lds + ABYTES + wid * NBL * 1024;
  const int nk = Kb >> 7;
#define GC_ISSUE(pa, pb, sa, sb, stage, kbyte) do { \
    _Pragma("unroll") for (int g = 0; g < 2; ++g) _Pragma("unroll") for (int pn = 0; pn < 2; ++pn) \
      __builtin_amdgcn_global_load_lds((const GAS unsigned*)((pa) + g * (sa) + (kbyte) + pn * 64), (LAS unsigned*)(ldsA + (stage) + pn * PANEL + g * 1024), 16, 0, 0); \
    _Pragma("unroll") for (int g = 0; g < NBL; ++g) _Pragma("unroll") for (int pn = 0; pn < 2; ++pn) \
      __builtin_amdgcn_global_load_lds((const GAS unsigned*)((pb) + g * (sb) + (kbyte) + pn * 64), (LAS unsigned*)(ldsB + (stage) + pn * PANEL + g * 1024), 16, 0, 0); \
  } while (0)
  if (!primed) {
    GC_ISSUE(gA, gB, a16, b16, par * STAGE, 0);
    asm volatile("s_waitcnt vmcnt(0)" ::: "memory");
    __syncthreads();
  }
#pragma unroll 1
  for (int kt = 0; kt < nk; ++kt) {
    char* cur = lds + par * STAGE;
    if (kt + 1 < nk) GC_ISSUE(gA, gB, a16, b16, (par ^ 1) * STAGE, (size_t)(kt + 1) * 128);
    else if (nA) {
      const GAS char* hA = (const GAS char*)(nA + (size_t)(wid * 32 + lrow) * nlda + lchunk * 16);
      const GAS char* hB = (const GAS char*)(nB + (size_t)(wid * NBL * 16 + lrow) * nldb + lchunk * 16);
      GC_ISSUE(hA, hB, (size_t)16 * nlda, (size_t)16 * nldb, (par ^ 1) * STAGE, 0);
    }
    __builtin_amdgcn_sched_barrier(0);
    if (F8) {
#pragma unroll
      for (int ih = 0; ih < 2; ++ih) {
        v8i av[2];
#pragma unroll
        for (int ii = 0; ii < 2; ++ii) {
          const u32x4 a0 = *(const u32x4*)(cur + fa + (ih * 2 + ii) * 1024), a1 = *(const u32x4*)(cur + PANEL + fa + (ih * 2 + ii) * 1024);
          av[ii] = (v8i){(int)a0.x, (int)a0.y, (int)a0.z, (int)a0.w, (int)a1.x, (int)a1.y, (int)a1.z, (int)a1.w};
        }
#pragma unroll
        for (int j = 0; j < NJ; ++j) {
          const u32x4 b0 = *(const u32x4*)(cur + fb + j * 1024), b1 = *(const u32x4*)(cur + PANEL + fb + j * 1024);
          const v8i bv = {(int)b0.x, (int)b0.y, (int)b0.z, (int)b0.w, (int)b1.x, (int)b1.y, (int)b1.z, (int)b1.w};
#pragma unroll
          for (int ii = 0; ii < 2; ++ii)
            acc[ih * 2 + ii][j] = SWAP ? __builtin_amdgcn_mfma_scale_f32_16x16x128_f8f6f4(bv, av[ii], acc[ih * 2 + ii][j], 0, 0, 0, 0x7f7f7f7f, 0, 0x7f7f7f7f)
                                       : __builtin_amdgcn_mfma_scale_f32_16x16x128_f8f6f4(av[ii], bv, acc[ih * 2 + ii][j], 0, 0, 0, 0x7f7f7f7f, 0, 0x7f7f7f7f);
        }
      }
    } else if (PIPE == 2) {
      bf16x8 af[2][4], bfr[NJ];
#pragma unroll
      for (int i = 0; i < 4; ++i) af[0][i] = *(const bf16x8*)(cur + fa + i * 1024);
#pragma unroll
      for (int j = 0; j < NJ; ++j) bfr[j] = *(const bf16x8*)(cur + fb + j * 1024);
#pragma unroll
      for (int i = 0; i < 4; ++i) af[1][i] = *(const bf16x8*)(cur + PANEL + fa + i * 1024);
      __builtin_amdgcn_sched_barrier(0);
#pragma unroll
      for (int i = 0; i < 4; ++i)
#pragma unroll
        for (int j = 0; j < NJ; ++j) acc[i][j] = SWAP ? mfma16(bfr[j], af[0][i], acc[i][j]) : mfma16(af[0][i], bfr[j], acc[i][j]);
#pragma unroll
      for (int j = 0; j < NJ; ++j) bfr[j] = *(const bf16x8*)(cur + PANEL + fb + j * 1024);
#pragma unroll
      for (int i = 0; i < 4; ++i)
#pragma unroll
        for (int j = 0; j < NJ; ++j) acc[i][j] = SWAP ? mfma16(bfr[j], af[1][i], acc[i][j]) : mfma16(af[1][i], bfr[j], acc[i][j]);
    } else if (PIPE == 1) {
      bf16x8 af[2][4], bfr[2][NJ];
#pragma unroll
      for (int ks = 0; ks < 2; ++ks) {
#pragma unroll
        for (int i = 0; i < 4; ++i) af[ks][i] = *(const bf16x8*)(cur + ks * PANEL + fa + i * 1024);
#pragma unroll
        for (int j = 0; j < NJ; ++j) bfr[ks][j] = *(const bf16x8*)(cur + ks * PANEL + fb + j * 1024);
      }
      __builtin_amdgcn_sched_barrier(0);
#pragma unroll
      for (int ks = 0; ks < 2; ++ks)
#pragma unroll
        for (int i = 0; i < 4; ++i)
#pragma unroll
          for (int j = 0; j < NJ; ++j) acc[i][j] = SWAP ? mfma16(bfr[ks][j], af[ks][i], acc[i][j]) : mfma16(af[ks][i], bfr[ks][j], acc[i][j]);
    } else {
#pragma unroll
      for (int ks = 0; ks < 2; ++ks) {
        bf16x8 af[4], bfr[NJ];
#pragma unroll
        for (int i = 0; i < 4; ++i) af[i] = *(const bf16x8*)(cur + ks * PANEL + fa + i * 1024);
#pragma unroll
        for (int j = 0; j < NJ; ++j) bfr[j] = *(const bf16x8*)(cur + ks * PANEL + fb + j * 1024);
#pragma unroll
        for (int i = 0; i < 4; ++i)
#pragma unroll
          for (int j = 0; j < NJ; ++j) acc[i][j] = SWAP ? mfma16(bfr[j], af[i], acc[i][j]) : mfma16(af[i], bfr[j], acc[i][j]);
      }
    }
    __builtin_amdgcn_sched_barrier(0);
    asm volatile("s_waitcnt vmcnt(0)" ::: "memory");
    __syncthreads();
    par ^= 1;
  }
#undef GC_ISSUE
}
template <bool SWAP, int NJ = 4, int PIPE = 1>
__device__ __forceinline__ void gemm_core(const bf16_t* __restrict__ A, int lda, const bf16_t* __restrict__ B, int ldb, int K,
                                          f32x4 (&acc)[4][NJ], char* lds, int& par, bool primed,
                                          const bf16_t* nA, int nlda, const bf16_t* nB, int nldb) {
  gemm_bytes<SWAP, NJ, PIPE, false>((const char*)A, lda * 2, (const char*)B, ldb * 2, K * 2, acc, lds, par, primed, (const char*)nA, nlda * 2, (const char*)nB, nldb * 2);
}
template <bool SWAP, int NJ = 4>
__device__ __forceinline__ void gemm_core(const bf16_t* __restrict__ A, int lda, const bf16_t* __restrict__ B, int ldb, int K,
                                          f32x4 (&acc)[4][NJ], char* lds) {
  int par = 0;
  gemm_core<SWAP, NJ>(A, lda, B, ldb, K, acc, lds, par, false, nullptr, 0, nullptr, 0);
}

__device__ __forceinline__ void tr_tile(const float* __restrict__ src, int lds_, int k0, int ns0, bf16_t* __restrict__ dst, int ldd, int nd0,
                                        const float* __restrict__ ksc, char* lds) {
  bf16_t* T = (bf16_t*)lds;
  const int tid = tidx();
  __syncthreads();
#pragma unroll
  for (int i = 0; i < 2; ++i) {
    const int kk = (tid >> 3) + 32 * i, nn4 = (tid & 7) * 4;
    const f32x4 v = *(const f32x4*)(src + (size_t)(k0 + kk) * lds_ + ns0 + nn4);
    const float s = ksc ? ksc[k0 + kk] : 1.f;
#pragma unroll
    for (int e = 0; e < 4; ++e) T[(nn4 + e) * 72 + kk] = tobf(v[e] * s);
  }
  __syncthreads();
  const int nn = tid >> 3, kc = (tid & 7) * 8;
  const u32x4 w = *(const u32x4*)(T + nn * 72 + kc);
  *(u32x4*)(dst + (size_t)(nd0 + nn) * ldd + k0 + kc) = w;
}

__device__ __forceinline__ void tr_tile2(const float* __restrict__ src, int lds_, int k0, int ns0, bf16_t* __restrict__ dst, int ldd, int nd0,
                                         const float* __restrict__ ksc, char* lds, unsigned char* dst8 = nullptr, int ld8 = 1024) {
  bf16_t* T = (bf16_t*)lds;
  unsigned char* T8 = (unsigned char*)lds + 8704;
  const int tid = tidx();
  __syncthreads();
  f32x4 v[4];
#pragma unroll
  for (int i = 0; i < 4; ++i) v[i] = *(const GAS f32x4*)(src + (size_t)(k0 + (tid >> 3) + 32 * i) * lds_ + ns0 + (tid & 7) * 4);
#pragma unroll
  for (int i = 0; i < 4; ++i) {
    const int kk = (tid >> 3) + 32 * i, nn4 = (tid & 7) * 4;
    const float sc = ksc ? ksc[k0 + kk] : 1.f;
#pragma unroll
    for (int e = 0; e < 4; ++e) T[(nn4 + e) * 136 + kk] = tobf(v[i][e] * sc);
    if (dst8) {
#pragma unroll
      for (int e = 0; e < 4; ++e) T8[(nn4 + e) * 144 + kk] = (unsigned char)(__builtin_amdgcn_cvt_pk_fp8_f32(sat8(v[i][e] * 32.f), 0.f, 0, false) & 0xff);
    }
  }
  __syncthreads();
  const int nn = tid >> 3, kc = (tid & 7) * 16;
  if (dst8) *(u32x4*)(dst8 + (size_t)nn * ld8 + k0 + kc) = *(const u32x4*)(T8 + nn * 144 + kc);
  if (!dst) return;
  const u32x4 w0 = *(const u32x4*)(T + nn * 136 + kc), w1 = *(const u32x4*)(T + nn * 136 + kc + 8);
  bf16_t* d = dst + (size_t)(nd0 + nn) * ldd + k0 + kc;
  *(u32x4*)d = w0; *(u32x4*)(d + 8) = w1;
}

constexpr int P0_GEMV = 192, P0_WIN = 3408, P0_WQ = 144, P0_WKV = 128, P0_WBR = 768, P0_WO = 512, P0_S0 = 256, P0_PAD = 96, P0_TAB = 1105;
constexpr int P0_N = P0_GEMV + P0_WIN + P0_WQ + P0_WKV + P0_WBR + P0_WO + P0_S0 + P0_PAD + P0_TAB;

__device__ __forceinline__ void phase0_item(const Params& p, int j, char* lds) {
  const int tid = tidx();
  char* ws = wsp(p.ws);
  if (j < P0_GEMV) {
    const int l = j / 96, cgi = j % 96;
    float* sv = (float*)lds;
    float* red = (float*)(lds + 20480);
    __syncthreads();
    for (int i = tid; i < 5120; i += 256) { const int v = i >> 10, k = i & 1023; const float x = (v == 0) ? p.c_ctx[k] : p.c[(v - 1) * 1024 + k]; sv[i] = silu_f(x); }
    __syncthreads();
    const int c4 = tid & 7, kg = tid >> 3;
    const float* w = p.w_mod + (size_t)l * 1024 * 3072 + cgi * 32 + c4 * 4;
    f32x4 a0 = {0.f, 0.f, 0.f, 0.f}, a1 = a0, a2 = a0, a3 = a0, a4 = a0;
#pragma unroll 8
    for (int k = kg * 32; k < kg * 32 + 32; ++k) {
      const f32x4 wv = *(const GAS f32x4*)(w + (size_t)k * 3072);
      a0 += wv * sv[k]; a1 += wv * sv[1024 + k]; a2 += wv * sv[2048 + k]; a3 += wv * sv[3072 + k]; a4 += wv * sv[4096 + k];
    }
    *(f32x4*)(red + (kg * 5 + 0) * 32 + c4 * 4) = a0; *(f32x4*)(red + (kg * 5 + 1) * 32 + c4 * 4) = a1; *(f32x4*)(red + (kg * 5 + 2) * 32 + c4 * 4) = a2;
    *(f32x4*)(red + (kg * 5 + 3) * 32 + c4 * 4) = a3; *(f32x4*)(red + (kg * 5 + 4) * 32 + c4 * 4) = a4;
    __syncthreads();
    if (tid < 160) {
      const int v = tid >> 5, c2 = tid & 31;
      float sm = p.b_mod[l * 3072 + cgi * 32 + c2];
#pragma unroll 8
      for (int g = 0; g < 32; ++g) sm += red[(g * 5 + v) * 32 + c2];
      ((float*)(ws + O_MOD))[(l * 5 + v) * 3072 + cgi * 32 + c2] = sm;
    }
    return;
  }
  j -= P0_GEMV;
  if (j < P0_WIN) {
    const int l = j / 1704, r = j % 1704, kt = r / 213, nt = r % 213, c0 = nt * 32;
    const int nd0 = c0 < 2176 ? c0 : (c0 < 2208 ? 3712 + (c0 - 2176) : (c0 < 3744 ? c0 - 32 : c0 + 96));
    tr_tile2(p.w_in + (size_t)l * 1024 * 6816, 6816, kt * 128, c0, (bf16_t*)(ws + O_WIN) + (size_t)l * 6912 * 1024, 1024, nd0, nullptr, lds,
             nd0 >= 3840 ? (unsigned char*)(ws + O_WG8) + ((size_t)l * 3072 + (nd0 - 3840)) * 1024 : nullptr);
    return;
  }
  j -= P0_WIN;
  if (j < P0_WQ) {
    const int l = j / 72, r = j % 72, kt = r / 24, nt = r % 24;
    tr_tile2(p.w_q_up + (size_t)l * 384 * 768, 768, kt * 128, nt * 32, (bf16_t*)(ws + O_WQ) + (size_t)l * 768 * 384, 384, nt * 32, p.q_norm_g + l * 384, lds);
    return;
  }
  j -= P0_WQ;
  if (j < P0_WKV) {
    const int l = j / 64, r = j % 64, kt = r / 32, nt = r % 32, c0 = nt * 32, h = c0 >> 7, e = c0 & 127;
    const int nd0 = e < 64 ? h * 64 + e : 512 + h * 64 + (e - 64);
    tr_tile2(p.w_kv_up + (size_t)l * 256 * 1024, 1024, kt * 128, c0, (bf16_t*)(ws + O_WKV) + (size_t)l * 1024 * 256, 256, nd0, nullptr, lds);
    return;
  }
  j -= P0_WKV;
  if (j < P0_WBR) {
    const int mat = j / 128, r = j % 128, kt = r / 32, nt = r % 32;
    tr_tile2(p.w_branch + (size_t)mat * 512 * 1024, 1024, kt * 128, nt * 32, nullptr, 512, nt * 32, nullptr, lds,
             (unsigned char*)(ws + O_WBR) + ((size_t)mat * 1024 + nt * 32) * 512, 512);
    return;
  }
  j -= P0_WBR;
  if (j < P0_WO) {
    const int l = j / 256, r = j % 256, kt = r / 32, nt = r % 32;
    tr_tile2(p.w_out + (size_t)l * 1024 * 1024, 1024, kt * 128, nt * 32, nullptr, 1024, nt * 32, nullptr, lds,
             (unsigned char*)(ws + O_WO) + ((size_t)l * 1024 + nt * 32) * 1024, 1024);
    return;
  }
  j -= P0_WO;
  if (j < P0_S0) {
    const int mat = j >> 2, nt = j & 3;
    tr_tile(p.state_ret + (size_t)mat * 64 * 128, 128, 0, nt * 32, (bf16_t*)(ws + O_S0T) + (size_t)mat * 128 * 64, 64, nt * 32, nullptr, lds);
    return;
  }
  j -= P0_S0;
  if (j < P0_PAD) {
    const int l = j / 48, r = j % 48;
    bf16_t* d = (bf16_t*)(ws + O_WIN) + ((size_t)l * 6912 + 3744) * 1024 + (size_t)r * 2048 + tid * 8;
    *(u32x4*)d = (u32x4){0u, 0u, 0u, 0u};
    return;
  }
  j -= P0_PAD;
  {
    float v[8];
    bf16_t* dst;
    if (j == 1104) {
      float* rt = (float*)(ws + O_ROPE);
#pragma unroll
      for (int q = 0; q < 2; ++q) {
        const int idx = tid * 2 + q, pos = idx >> 3, f = idx & 7;
        const float ang = (float)pos * exp2f(-(float)f * 1.66096404744f);
        rt[idx * 2] = cosf(ang); rt[idx * 2 + 1] = sinf(ang);
      }
      return;
    }
    if (j < 16) {
      const int e0 = j * 2048 + tid * 8; dst = (bf16_t*)(ws + O_CS) + e0;
      const int n = e0 >> 7, k = e0 & 127;
#pragma unroll
      for (int e = 0; e < 8; ++e) {
        const float fr = (float)(((n & 127) * (k + e)) & 127) * (1.f / 128.f);
        v[e] = (n < 128) ? __builtin_amdgcn_cosf(fr) : __builtin_amdgcn_sinf(fr);
      }
    } else if (j < 80) {
      const int e0 = (j - 16) * 2048 + tid * 8; dst = (bf16_t*)(ws + O_D256) + e0;
      const int k1 = e0 >> 9, kk = e0 & 511;
#pragma unroll
      for (int e = 0; e < 8; ++e) {
        const int t = (kk + e) & 255;
        const float fr = (float)((k1 * t) & 255) * (1.f / 256.f);
        v[e] = (kk < 256) ? __builtin_amdgcn_cosf(fr) : -__builtin_amdgcn_sinf(fr);
      }
    } else {
      const int e0 = (j - 80) * 2048 + tid * 8; dst = (bf16_t*)(ws + O_D1024) + e0;
      const int k1 = e0 >> 11, kk = e0 & 2047;
#pragma unroll
      for (int e = 0; e < 8; ++e) {
        const int t = (kk + e) & 1023;
        const float fr = (float)((k1 * t) & 1023) * (1.f / 1024.f);
        v[e] = (kk < 1024) ? __builtin_amdgcn_cosf(fr) : -__builtin_amdgcn_sinf(fr);
      }
    }
    u32x4 w; w.x = pk2(v[0], v[1]); w.y = pk2(v[2], v[3]); w.z = pk2(v[4], v[5]); w.w = pk2(v[6], v[7]);
    *(u32x4*)dst = w;
  }
}

__device__ __forceinline__ void norm_item(const Params& p, int l, int item, const float* xp, const float* xs) {
  const int tid = tidx(), lane = tid & 63, wid = tid >> 6;
  bf16_t* H = (bf16_t*)(p.ws + O_H);
#pragma unroll 3
  for (int i = 0; i < 6; ++i) {
    const int row = item * 24 + wid * 6 + i;
    const float* src = row < NPR ? xp + (size_t)row * 1024 : xs + (size_t)(row - NPR) * 1024;
    const int v = row < NPR ? 0 : 1 + ((row - NPR) >> 10);
    const float* mod = (const float*)(p.ws + O_MOD) + (l * 5 + v) * 3072;
    f32x4 x[4]; float ss = 0.f;
#pragma unroll
    for (int q = 0; q < 4; ++q) { x[q] = *(const f32x4*)(src + (q * 64 + lane) * 4); ss += x[q][0] * x[q][0] + x[q][1] * x[q][1] + x[q][2] * x[q][2] + x[q][3] * x[q][3]; }
    ss = wave_sum(ss);
    const float rstd = rsqrtf(ss * (1.f / 1024.f) + EPSN);
#pragma unroll
    for (int q = 0; q < 4; ++q) {
      const int col = (q * 64 + lane) * 4;
      const f32x4 g = *(const f32x4*)(p.norm_g + l * 1024 + col), sc = *(const f32x4*)(mod + 1024 + col), sh = *(const f32x4*)(mod + col);
      f32x4 h;
#pragma unroll
      for (int e = 0; e < 4; ++e) h[e] = x[q][e] * rstd * g[e] * (1.f + sc[e]) + sh[e];
      *(u32x2*)(H + (size_t)row * 1024 + col) = pk4(h);
      *(unsigned*)(p.ws + O_H8 + (size_t)row * 1024 + col) = pk4f8(h[0], h[1], h[2], h[3]);
    }
  }
}
__device__ __forceinline__ void final_item(const Params& p, int item) {
  const int tid = tidx(), lane = tid & 63, wid = tid >> 6;
#pragma unroll 3
  for (int i = 0; i < 6; ++i) {
    const int row = item * 24 + wid * 6 + i;
    float* src = p.out + (size_t)row * 1024;
    f32x4 x[4]; float ss = 0.f;
#pragma unroll
    for (int q = 0; q < 4; ++q) { x[q] = *(const f32x4*)(src + (q * 64 + lane) * 4); ss += x[q][0] * x[q][0] + x[q][1] * x[q][1] + x[q][2] * x[q][2] + x[q][3] * x[q][3]; }
    ss = wave_sum(ss);
    const float rstd = rsqrtf(ss * (1.f / 1024.f) + EPSN);
#pragma unroll
    for (int q = 0; q < 4; ++q) {
      const int col = (q * 64 + lane) * 4;
      const f32x4 g = *(const f32x4*)(p.final_g + col);
      f32x4 y;
#pragma unroll
      for (int e = 0; e < 4; ++e) y[e] = x[q][e] * rstd * g[e];
      *(f32x4*)(src + col) = y;
    }
  }
}

__device__ __forceinline__ void s2_tile(const Params& p, int l, int tile, char* lds) {
  const int tid = tidx(), lane = tid & 63, wid = tid >> 6, wm = wid >> 1, wn = wid & 1, fr = lane & 15, fq = lane >> 4;
  const int m = (tile / 480) * 16 + (tile % 16), nt = (tile % 480) / 16, m0 = m * 128, n0 = nt * 128;
  char* ws = wsp(p.ws);
  const bf16_t* A = (const bf16_t*)(ws + O_H) + (size_t)m0 * 1024;
  const bf16_t* B = (const bf16_t*)(ws + O_WIN) + ((size_t)l * 6912 + n0) * 1024;
  f32x4 acc[4][4];
  zero_acc(acc);
  if (nt >= 4 && nt < 8) {
    gemm_core<false>(A, 1024, B, 1024, 1024, acc, lds);
    bf16_t* RVT = (bf16_t*)(ws + O_RVT);
#pragma unroll
    for (int i = 0; i < 4; ++i) {
      const int tok = m0 + wm * 64 + i * 16 + fq * 4;
      size_t base; int T, b, t;
      if (tok < NPR) { b = tok >> 8; t = tok & 255; T = 256; base = 0; } else { const int s = tok - NPR; b = s >> 10; t = s & 1023; T = 1024; base = (size_t)NPR * 512; }
#pragma unroll
      for (int j = 0; j < 4; ++j) {
        const int c = n0 - 512 + wn * 64 + j * 16 + fr, h = c >> 7, vd = c & 127;
        *(u32x2*)(RVT + base + ((size_t)(b * 4 + h) * 128 + vd) * T + t) = pk4(acc[i][j]);
      }
    }
    return;
  }
  gemm_core<true>(A, 1024, B, 1024, 1024, acc, lds);
  bf16_t* dst = nullptr; int ld = 0, c0 = 0, op = 0;
  if (nt < 2) { dst = (bf16_t*)(ws + O_RQ); ld = 256; c0 = 0; }
  else if (nt < 4) { dst = (bf16_t*)(ws + O_RK); ld = 256; c0 = 256; op = 2; }
  else if (nt < 12) { dst = (bf16_t*)(ws + O_RZ); ld = 512; c0 = 1024; op = 1; }
  else if (nt < 15) { dst = (bf16_t*)(ws + O_QLAT); ld = 384; c0 = 1536; }
  else if (nt < 17) { ld = 256; c0 = 1920; op = 3; }
  else if (nt < 21) { dst = (bf16_t*)(ws + O_MZ); ld = 512; c0 = 2176; op = 1; }
  else if (nt < 25) { dst = (bf16_t*)(ws + O_FU); ld = 512; c0 = 2688; }
  else if (nt < 29) { dst = (bf16_t*)(ws + O_FZ); ld = 512; c0 = 3200; op = 1; }
  else { ld = 32; c0 = 3712; op = 4; }
#pragma unroll
  for (int i = 0; i < 4; ++i) {
    const int tok = m0 + wm * 64 + i * 16 + fr;
#pragma unroll
    for (int j = 0; j < 4; ++j) {
      const int col = n0 - c0 + wn * 64 + j * 16 + fq * 4;
      f32x4 v = acc[i][j];
      if (op == 3) { *(f32x4*)((float*)(ws + O_KVLAT) + (size_t)tok * 256 + col) = v; continue; }
      if (op == 4) { if (col < 32) *(f32x4*)((float*)(ws + O_KR) + (size_t)tok * 32 + col) = v; continue; }
      if (op == 1) {
#pragma unroll
        for (int e = 0; e < 4; ++e) v[e] = silu_f(v[e]);
      } else if (op == 2) {
#pragma unroll
        for (int e = 0; e < 4; ++e) v[e] *= 0.125f;
      }
      const u32x2 w = pk4(v);
      *(u32x2*)(dst + (size_t)tok * ld + col) = w;
      if (op == 2 && tok < NPR) {
        bf16_t* RKT = (bf16_t*)(ws + O_RKT);
        const int b = tok >> 8, t = tok & 255, h = col >> 6, dk = col & 63;
        bf16_t* q = RKT + ((size_t)(b * 4 + h) * 64 + dk) * 256 + t;
        q[0] = (bf16_t)(w.x & 0xffffu); q[256] = (bf16_t)(w.x >> 16); q[512] = (bf16_t)(w.y & 0xffffu); q[768] = (bf16_t)(w.y >> 16);
      }
    }
  }
}

template <int MODE>
__device__ __forceinline__ void attn_item(const Params& p, int l, int item, char* lds) {
  constexpr int NKP = MODE == 0 ? 3 : 2;
  constexpr int NVB = MODE == 0 ? 4 : 8;
  constexpr int PV = NVB * 16 * 64;
  constexpr int KOFF = NKP * 4096;
  constexpr int BUF = KOFF + 2 * PV;
  const int tid = tidx(), lane = tid & 63, wid = tid >> 6, fr = lane & 15, fq = lane >> 4;
  char* ws = wsp(p.ws);
  int smp, b, h, qblk, T, Tk, tok0;
  const bf16_t *kbase, *rbase = nullptr, *vbase, *qbase;
  int kstride, qstride;
  if (MODE == 0) {
    if (item < 256) { smp = 1; b = item >> 6; h = (item >> 3) & 7; qblk = item & 7; T = 1024; Tk = 1536; tok0 = NPR + b * 1024 + qblk * 128; }
    else { const int it = item - 256; smp = 0; b = it >> 4; h = (it >> 1) & 7; qblk = it & 1; T = 256; Tk = 256; tok0 = b * 256 + qblk * 128; }
    const int keyrow0 = smp ? NPR + b * 1536 : b * 256;
    kbase = (const bf16_t*)(ws + O_KB) + (size_t)keyrow0 * 512 + h * 64; kstride = 512;
    rbase = (const bf16_t*)(ws + O_KRA) + (size_t)keyrow0 * 32;
    vbase = (const bf16_t*)(ws + O_VT) + (smp ? (size_t)NPR * 512 + (size_t)(b * 8 + h) * 64 * 1536 : (size_t)(b * 8 + h) * 64 * 256);
    qbase = (const bf16_t*)(ws + O_QB) + (size_t)tok0 * 768 + h * 96; qstride = 768;
  } else {
    if (item < 128) { smp = 1; b = item >> 5; h = (item >> 3) & 3; qblk = item & 7; T = 1024; tok0 = NPR + b * 1024 + qblk * 128; }
    else { const int it = item - 128; smp = 0; b = it >> 3; h = (it >> 1) & 3; qblk = it & 1; T = 256; tok0 = b * 256 + qblk * 128; }
    Tk = T;
    const int ktok0 = smp ? NPR + b * 1024 : b * 256;
    kbase = (const bf16_t*)(ws + O_RK) + (size_t)ktok0 * 256 + h * 64; kstride = 256;
    vbase = (const bf16_t*)(ws + O_RVT) + (smp ? (size_t)NPR * 512 + (size_t)(b * 4 + h) * 128 * 1024 : (size_t)(b * 4 + h) * 128 * 256);
    qbase = (const bf16_t*)(ws + O_RQ) + (size_t)tok0 * 256 + h * 64; qstride = 256;
  }
  const int nkt = Tk >> 6;
  bf16x8 qf[2][NKP];
#pragma unroll
  for (int qb = 0; qb < 2; ++qb)
#pragma unroll
    for (int ks = 0; ks < NKP; ++ks) qf[qb][ks] = *(const bf16x8*)(qbase + (size_t)(wid * 32 + qb * 16 + fr) * qstride + ks * 32 + fq * 8);
  f32x4 o[NVB][2];
#pragma unroll
  for (int vb = 0; vb < NVB; ++vb) { o[vb][0] = (f32x4){0.f, 0.f, 0.f, 0.f}; o[vb][1] = (f32x4){0.f, 0.f, 0.f, 0.f}; }
  float lgf = 0.f, lgb = 0.f;
  float mrow[2] = {-INFINITY, -INFINITY}, lrow[2] = {0.f, 0.f};
  const int tq0 = qblk * 128 + wid * 32 + fr;
  if (MODE == 1) {
    const float xf = p.ret_logit[(l * 2 + 0) * 4 + h], xb = p.ret_logit[(l * 2 + 1) * 4 + h];
    lgf = -log1pf(expf(-xf)) * 1.44269504089f; lgb = -log1pf(expf(-xb)) * 1.44269504089f;
    if (smp) {
      const bf16_t* s0 = (const bf16_t*)(ws + O_S0T);
#pragma unroll
      for (int dir = 0; dir < 2; ++dir) {
        const bf16_t* sb = s0 + ((size_t)(((b * 2 + l) * 2 + dir) * 4 + h) * 128) * 64;
        float dec[2];
#pragma unroll
        for (int qb = 0; qb < 2; ++qb) { const int tq = tq0 + qb * 16; dec[qb] = dir == 0 ? ex2((float)(tq + 1) * lgf) : ex2((float)(T - tq) * lgb); }
#pragma unroll
        for (int vb = 0; vb < NVB; ++vb) {
          f32x4 t0 = (f32x4){0.f, 0.f, 0.f, 0.f}, t1 = (f32x4){0.f, 0.f, 0.f, 0.f};
#pragma unroll
          for (int ks = 0; ks < 2; ++ks) {
            const bf16x8 sf = *(const bf16x8*)(sb + (size_t)(vb * 16 + fr) * 64 + ks * 32 + fq * 8);
            t0 = mfma16(sf, qf[0][ks], t0); t1 = mfma16(sf, qf[1][ks], t1);
          }
          o[vb][0] += t0 * dec[0]; o[vb][1] += t1 * dec[1];
        }
      }
    }
  }
  u32x4 vreg[NVB / 2];
  const int uw = __builtin_amdgcn_readfirstlane(wid);
  const int dkey = lane >> 2, dchunk = (lane & 3) ^ swz(dkey);
  auto kdma = [&](int kt, char* buf) {
    const GAS bf16_t* kp = (const GAS bf16_t*)kbase + (size_t)(kt * 64 + uw * 16 + dkey) * kstride + dchunk * 8;
#pragma unroll
    for (int pn = 0; pn < 2; ++pn)
      __builtin_amdgcn_global_load_lds((const GAS unsigned*)(kp + pn * 32), (LAS unsigned*)((LAS char*)buf + pn * 4096 + uw * 1024), 16, 0, 0);
    if (MODE == 0) {
      const GAS bf16_t* rp = (const GAS bf16_t*)rbase + (size_t)(kt * 64 + uw * 16 + dkey) * 32 + dchunk * 8;
      __builtin_amdgcn_global_load_lds((const GAS unsigned*)rp, (LAS unsigned*)((LAS char*)buf + 2 * 4096 + uw * 1024), 16, 0, 0);
    }
  };
  auto gload = [&](int kt) {
#pragma unroll
    for (int i = 0; i < NVB / 2; ++i) { const int idx = tid + 256 * i, vd = idx >> 3, g = idx & 7; vreg[i] = ldg16(vbase + (size_t)vd * Tk + kt * 64 + g * 8); }
  };
  auto lstore = [&](char* buf) {
#pragma unroll
    for (int i = 0; i < NVB / 2; ++i) {
      const int idx = tid + 256 * i, vd = idx >> 3, g = idx & 7, pnl = g >> 2, g4 = g & 3, hi = g4 >> 1, q0 = 2 * (g4 & 1);
      char* base = buf + KOFF + pnl * PV + vd * 64 + hi * 8;
      *(u32x2*)(base + ((q0 ^ swz(vd)) << 4)) = (u32x2){vreg[i].x, vreg[i].y};
      *(u32x2*)(base + (((q0 + 1) ^ swz(vd)) << 4)) = (u32x2){vreg[i].z, vreg[i].w};
    }
  };
  __syncthreads();
  kdma(0, lds); gload(0); lstore(lds);
  asm volatile("s_waitcnt vmcnt(0)" ::: "memory");
  __syncthreads();
  const int foff = fr * 64 + ((fq ^ swz(fr)) << 4);
  for (int kt = 0; kt < nkt; ++kt) {
    char* cur = lds + (kt & 1) * BUF;
    const bool more = (kt + 1) < nkt;
    if (more) { kdma(kt + 1, lds + ((kt + 1) & 1) * BUF); gload(kt + 1); }
    __builtin_amdgcn_sched_barrier(0);
    f32x4 s[4][2];
#pragma unroll
    for (int kb = 0; kb < 4; ++kb) {
      s[kb][0] = (f32x4){0.f, 0.f, 0.f, 0.f}; s[kb][1] = (f32x4){0.f, 0.f, 0.f, 0.f};
#pragma unroll
      for (int ks = 0; ks < NKP; ++ks) {
        const bf16x8 kf = *(const bf16x8*)(cur + ks * 4096 + kb * 1024 + foff);
        s[kb][0] = mfma16(kf, qf[0][ks], s[kb][0]); s[kb][1] = mfma16(kf, qf[1][ks], s[kb][1]);
      }
    }
    bf16x8 pf[2][2];
#pragma unroll
    for (int qb = 0; qb < 2; ++qb) {
      if (MODE == 0) {
        float mx = s[0][qb][0];
#pragma unroll
        for (int kb = 0; kb < 4; ++kb)
#pragma unroll
          for (int r = 0; r < 4; ++r) mx = fmaxf(mx, s[kb][qb][r]);
        mx = fmaxf(mx, __shfl_xor(mx, 16)); mx = fmaxf(mx, __shfl_xor(mx, 32));
        const float mn = fmaxf(mrow[qb], mx), alpha = ex2(mrow[qb] - mn);
        mrow[qb] = mn;
        float ls = 0.f;
#pragma unroll
        for (int kb = 0; kb < 4; ++kb)
#pragma unroll
          for (int r = 0; r < 4; ++r) { const float e = ex2(s[kb][qb][r] - mn); s[kb][qb][r] = e; ls += e; }
        lrow[qb] = lrow[qb] * alpha + ls;
#pragma unroll
        for (int vb = 0; vb < NVB; ++vb) o[vb][qb] *= alpha;
      } else {
        const int tq = tq0 + qb * 16;
#pragma unroll
        for (int kb = 0; kb < 4; ++kb)
#pragma unroll
          for (int r = 0; r < 4; ++r) {
            const int d = tq - (kt * 64 + kb * 16 + fq * 4 + r);
            const float dec = d > 0 ? ex2((float)d * lgf) : (d < 0 ? ex2((float)(-d) * lgb) : 2.f);
            s[kb][qb][r] *= dec;
          }
      }
#pragma unroll
      for (int g = 0; g < 2; ++g) {
        u32x4 w; w.x = pk2(s[2 * g][qb][0], s[2 * g][qb][1]); w.y = pk2(s[2 * g][qb][2], s[2 * g][qb][3]);
        w.z = pk2(s[2 * g + 1][qb][0], s[2 * g + 1][qb][1]); w.w = pk2(s[2 * g + 1][qb][2], s[2 * g + 1][qb][3]);
        pf[qb][g] = as_bf8(w);
      }
    }
#pragma unroll
    for (int vb = 0; vb < NVB; ++vb)
#pragma unroll
      for (int g = 0; g < 2; ++g) {
        const bf16x8 vf = *(const bf16x8*)(cur + KOFF + g * PV + vb * 1024 + foff);
        o[vb][0] = mfma16(vf, pf[0][g], o[vb][0]); o[vb][1] = mfma16(vf, pf[1][g], o[vb][1]);
      }
    __builtin_amdgcn_sched_barrier(0);
    if (more) lstore(lds + ((kt + 1) & 1) * BUF);
    asm volatile("s_waitcnt vmcnt(0)" ::: "memory");
    __syncthreads();
  }
  bf16_t* G = (bf16_t*)(ws + (MODE == 0 ? O_MZ : O_RZ));
#pragma unroll
  for (int qb = 0; qb < 2; ++qb) {
    const int tok = tok0 + wid * 32 + qb * 16 + fr;
    float mul, sub;
    if (MODE == 0) {
      float lt = lrow[qb]; lt += __shfl_xor(lt, 16); lt += __shfl_xor(lt, 32);
      mul = 1.f / lt; sub = 0.f;
    } else {
      float sm = 0.f;
#pragma unroll
      for (int vb = 0; vb < NVB; ++vb) sm += (o[vb][qb][0] + o[vb][qb][1]) + (o[vb][qb][2] + o[vb][qb][3]);
      sm += __shfl_xor(sm, 16); sm += __shfl_xor(sm, 32);
      const float mu = sm * (1.f / 128.f);
      float vs = 0.f;
#pragma unroll
      for (int vb = 0; vb < NVB; ++vb)
#pragma unroll
        for (int r = 0; r < 4; ++r) { const float dd = o[vb][qb][r] - mu; vs += dd * dd; }
      vs += __shfl_xor(vs, 16); vs += __shfl_xor(vs, 32);
      mul = rsqrtf(vs * (1.f / 128.f) + EPSN); sub = mu;
    }
#pragma unroll
    for (int vb = 0; vb < NVB; ++vb) {
      bf16_t* gp = G + (size_t)tok * 512 + h * (NVB * 16) + vb * 16 + fq * 4;
      const u32x2 gz = *(const u32x2*)gp;
      f32x4 y;
      y[0] = (o[vb][qb][0] - sub) * mul * bflo(gz.x); y[1] = (o[vb][qb][1] - sub) * mul * bfhi(gz.x);
      y[2] = (o[vb][qb][2] - sub) * mul * bflo(gz.y); y[3] = (o[vb][qb][3] - sub) * mul * bfhi(gz.y);
      *(unsigned*)(ws + O_BR8 + (size_t)(MODE == 0 ? 1 : 0) * NTOK * 512 + (size_t)tok * 512 + h * (NVB * 16) + vb * 16 + fq * 4) = pk4f8(y[0] * 8.f, y[1] * 8.f, y[2] * 8.f, y[3] * 8.f);
    }
  }
}

__device__ __forceinline__ bf16x8 scale8(u32x4 raw, const float (&d)[8]) {
  u32x4 w;
  w.x = pk2(bflo(raw.x) * d[0], bfhi(raw.x) * d[1]); w.y = pk2(bflo(raw.y) * d[2], bfhi(raw.y) * d[3]);
  w.z = pk2(bflo(raw.z) * d[4], bfhi(raw.z) * d[5]); w.w = pk2(bflo(raw.w) * d[6], bfhi(raw.w) * d[7]);
  return as_bf8(w);
}
__device__ __forceinline__ void state_item(const Params& p, int l, int item) {
  const int tid = tidx(), lane = tid & 63, wid = tid >> 6, fr = lane & 15, fq = lane >> 4;
  const int b = item >> 2, h = item & 3;
  const bf16_t* RVT = (const bf16_t*)(p.ws + O_RVT) + (size_t)(b * 4 + h) * 128 * 256;
  const bf16_t* RKT = (const bf16_t*)(p.ws + O_RKT) + (size_t)(b * 4 + h) * 64 * 256;
  const float xf = p.ret_logit[(l * 2 + 0) * 4 + h], xb = p.ret_logit[(l * 2 + 1) * 4 + h];
  const float lgf = -log1pf(expf(-xf)) * 1.44269504089f, lgb = -log1pf(expf(-xb)) * 1.44269504089f;
  f32x4 acc[2][2][4];
#pragma unroll
  for (int d = 0; d < 2; ++d)
#pragma unroll
    for (int v = 0; v < 2; ++v)
#pragma unroll
      for (int k = 0; k < 4; ++k) acc[d][v][k] = (f32x4){0.f, 0.f, 0.f, 0.f};
#pragma unroll 2
  for (int ks = 0; ks < 8; ++ks) {
    const int j0 = ks * 32 + fq * 8;
    float df[8], db[8];
#pragma unroll
    for (int e = 0; e < 8; ++e) { df[e] = exp2f((float)(255 - j0 - e) * lgf); db[e] = exp2f((float)(j0 + e) * lgb); }
    bf16x8 af[2];
#pragma unroll
    for (int v = 0; v < 2; ++v) af[v] = *(const bf16x8*)(RVT + (size_t)((wid * 2 + v) * 16 + fr) * 256 + j0);
#pragma unroll
    for (int k = 0; k < 4; ++k) {
      const u32x4 raw = *(const u32x4*)(RKT + (size_t)(k * 16 + fr) * 256 + j0);
      const bf16x8 kf = scale8(raw, df), kb = scale8(raw, db);
#pragma unroll
      for (int v = 0; v < 2; ++v) { acc[0][v][k] = mfma16(af[v], kf, acc[0][v][k]); acc[1][v][k] = mfma16(af[v], kb, acc[1][v][k]); }
    }
  }
  float* O = p.out + OUT_RET;
#pragma unroll
  for (int d = 0; d < 2; ++d)
#pragma unroll
    for (int v = 0; v < 2; ++v)
#pragma unroll
      for (int k = 0; k < 4; ++k) {
        const int dk = k * 16 + fr, vd = (wid * 2 + v) * 16 + fq * 4;
        *(f32x4*)(O + ((size_t)((((b * 2 + l) * 2 + d) * 4 + h) * 64 + dk)) * 128 + vd) = acc[d][v][k];
      }
}

__device__ __forceinline__ void keyprep_item(const Params& p, int l, int item) {
  const int tid = tidx(), lane = tid & 63, wid = tid >> 6;
  char* ws = wsp(p.ws);
  bf16_t* CKVA = (bf16_t*)(ws + O_CKVA);
  bf16_t* KRA = (bf16_t*)(ws + O_KRA);
#pragma unroll
  for (int i = 0; i < 4; ++i) {
    const int R = item * 16 + wid * 4 + i;
    int smp = 0, b, t = 0, tok = 0, ctx = 0, pp = 0;
    if (R < NPR) { tok = R; b = R >> 8; t = R & 255; }
    else { smp = 1; const int s = R - NPR; b = s / 1536; pp = s - b * 1536; if (pp < 512) ctx = 1; else { t = pp - 512; tok = NPR + b * 1024 + t; } }
    if (ctx) {
      const f32x4 v = *(const f32x4*)(p.cache_ckv + ((size_t)((b * 2 + l) * 512 + pp)) * 256 + lane * 4);
      *(u32x2*)(CKVA + (size_t)R * 256 + lane * 4) = pk4(v);
      if (lane < 32) KRA[(size_t)R * 32 + lane] = tobf(p.cache_krope[((size_t)((b * 2 + l) * 512 + pp)) * 32 + lane]);
      continue;
    }
    const f32x4 v = *(const f32x4*)((const float*)(ws + O_KVLAT) + (size_t)tok * 256 + lane * 4);
    float ss = v[0] * v[0] + v[1] * v[1] + v[2] * v[2] + v[3] * v[3];
    ss = wave_sum(ss);
    const float rstd = rsqrtf(ss * (1.f / 256.f) + EPSN);
    const f32x4 g = *(const f32x4*)(p.kv_norm_g + l * 256 + lane * 4);
    f32x4 y;
#pragma unroll
    for (int e = 0; e < 4; ++e) y[e] = v[e] * rstd * g[e];
    *(u32x2*)(CKVA + (size_t)R * 256 + lane * 4) = pk4(y);
    if (!smp) *(f32x4*)(p.out + OUT_CKV + ((size_t)((b * 2 + l) * 256 + t)) * 256 + lane * 4) = y;
    const int d = lane & 31;
    const float x = ((const float*)(ws + O_KR))[(size_t)tok * 32 + d];
    float yk = x;
    if (smp) {
      const float pr = __shfl_xor(x, 8);
      const int hd = d >> 4, i16 = d & 15, f = i16 & 7;
      const int pos = hd ? (t & 63) : (t >> 6);
      const float* rt = (const float*)(ws + O_ROPE) + (pos * 8 + f) * 2;
      const float cs = rt[0], sn = rt[1];
      yk = i16 < 8 ? x * cs - pr * sn : pr * sn + x * cs;
    } else if (lane < 32) {
      p.out[OUT_KR + ((size_t)((b * 2 + l) * 256 + t)) * 32 + d] = x;
    }
    if (lane < 32) KRA[(size_t)R * 32 + d] = tobf(yk);
  }
}

__device__ __forceinline__ void f1_tile(const Params& p, int tile, char* lds) {
  const int tid = tidx(), lane = tid & 63, wid = tid >> 6, wm = wid >> 1, wn = wid & 1, fr = lane & 15, fq = lane >> 4;
  const int m = tile >> 3, g = (tile >> 1) & 3, nh = tile & 1, m0 = m * 128;
  char* ws = wsp(p.ws);
  f32x4 acc[4][4];
  zero_acc(acc);
  gemm_core<false>((const bf16_t*)(ws + O_FU) + (size_t)m0 * 512 + g * 128, 512, (const bf16_t*)(ws + O_CS) + (size_t)nh * 128 * 128, 128, 128, acc, lds);
  bf16_t* UT = (bf16_t*)(ws + O_UT);
#pragma unroll
  for (int i = 0; i < 4; ++i) {
    const int tok = m0 + wm * 64 + i * 16 + fq * 4;
    size_t base; int T, b, t;
    if (tok < NPR) { b = tok >> 8; t = tok & 255; T = 256; base = 0; } else { const int s = tok - NPR; b = s >> 10; t = s & 1023; T = 1024; base = (size_t)NPR * 1024; }
#pragma unroll
    for (int j = 0; j < 4; ++j) {
      const int k2 = wn * 64 + j * 16 + fr;
      *(u32x2*)(UT + base + ((size_t)(b * 4 + g) * 128 + k2) * (2 * T) + nh * T + t) = pk4(acc[i][j]);
    }
  }
}

__device__ __forceinline__ void qup_tile(const Params& p, int l, int tile, char* lds) {
  const int tid = tidx(), lane = tid & 63, wid = tid >> 6, wm = wid >> 1, wn = wid & 1, fr = lane & 15, fq = lane >> 4;
  const int m = tile % 96, nt = tile / 96, m0 = m * 128, n0 = nt * 128;
  char* ws = wsp(p.ws);
  const bf16_t* QL = (const bf16_t*)(ws + O_QLAT) + (size_t)m0 * 384;
  float rsv4[4];
  {
    float* rs = (float*)lds;
    __syncthreads();
#pragma unroll 1
    for (int r0 = 0; r0 < 32; r0 += 4) {
      float ss[4];
#pragma unroll
      for (int u = 0; u < 4; ++u) {
        u32x4 w = (u32x4){0u, 0u, 0u, 0u};
        if (lane < 48) w = ldg16(QL + (size_t)(wid * 32 + r0 + u) * 384 + lane * 8);
        ss[u] = bflo(w.x) * bflo(w.x) + bfhi(w.x) * bfhi(w.x) + bflo(w.y) * bflo(w.y) + bfhi(w.y) * bfhi(w.y) + bflo(w.z) * bflo(w.z) + bfhi(w.z) * bfhi(w.z) + bflo(w.w) * bflo(w.w) + bfhi(w.w) * bfhi(w.w);
      }
#pragma unroll
      for (int u = 0; u < 4; ++u) { const float t = wave_sum(ss[u]); if (lane == 0) rs[wid * 32 + r0 + u] = rsqrtf(t * (1.f / 384.f) + EPSN); }
    }
    __syncthreads();
#pragma unroll
    for (int i = 0; i < 4; ++i) rsv4[i] = rs[wm * 64 + i * 16 + fr];
    __syncthreads();
  }
  f32x4 acc[4][4];
  zero_acc(acc);
  gemm_core<true>(QL, 384, (const bf16_t*)(ws + O_WQ) + ((size_t)l * 768 + n0) * 384, 384, 384, acc, lds);
  bf16_t* QB = (bf16_t*)(ws + O_QB);
  const float qscale = 0.10206207261596577f * 1.44269504089f;
#pragma unroll
  for (int i = 0; i < 4; ++i) {
    const int rl = wm * 64 + i * 16 + fr, tok = m0 + rl;
    const float sc = rsv4[i] * qscale;
    const int smp = tok >= NPR, t = (tok - NPR) & 1023;
#pragma unroll
    for (int j = 0; j < 4; ++j) {
      const int cb = n0 + wn * 64 + j * 16, within = cb % 96;
      f32x4 v = acc[i][j] * sc;
      if (within >= 64) {
        f32x4 pr;
#pragma unroll
        for (int e = 0; e < 4; ++e) pr[e] = __shfl_xor(v[e], 32);
        if (smp) {
          const int pos = within >= 80 ? (t & 63) : (t >> 6);
          const float* rt = (const float*)(ws + O_ROPE) + (pos * 8 + (fq & 1) * 4) * 2;
          const f32x4 c01 = *(const f32x4*)rt, c23 = *(const f32x4*)(rt + 4);
          const float cs4[4] = {c01[0], c01[2], c23[0], c23[2]}, sn4[4] = {c01[1], c01[3], c23[1], c23[3]};
#pragma unroll
          for (int e = 0; e < 4; ++e) v[e] = fq < 2 ? v[e] * cs4[e] - pr[e] * sn4[e] : pr[e] * sn4[e] + v[e] * cs4[e];
        }
      }
      *(u32x2*)(QB + (size_t)tok * 768 + cb + fq * 4) = pk4(v);
    }
  }
}

__device__ __forceinline__ void kvup_tile(const Params& p, int l, int tile, char* lds) {
  const int tid = tidx(), lane = tid & 63, wid = tid >> 6, wm = wid >> 1, wn = wid & 1, fr = lane & 15, fq = lane >> 4;
  const int m = tile % 112, nt = tile / 112, m0 = m * 128, n0 = nt * 128;
  char* ws = wsp(p.ws);
  const bf16_t* A = (const bf16_t*)(ws + O_CKVA) + (size_t)m0 * 256;
  const bf16_t* B = (const bf16_t*)(ws + O_WKV) + ((size_t)l * 1024 + n0) * 256;
  f32x4 acc[4][4];
  zero_acc(acc);
  if (nt < 4) {
    gemm_core<true>(A, 256, B, 256, 256, acc, lds);
    bf16_t* KB = (bf16_t*)(ws + O_KB);
#pragma unroll
    for (int i = 0; i < 4; ++i) {
      const int R = m0 + wm * 64 + i * 16 + fr;
#pragma unroll
      for (int j = 0; j < 4; ++j) *(u32x2*)(KB + (size_t)R * 512 + n0 + wn * 64 + j * 16 + fq * 4) = pk4(acc[i][j]);
    }
  } else {
    gemm_core<false>(A, 256, B, 256, 256, acc, lds);
    bf16_t* VT = (bf16_t*)(ws + O_VT);
#pragma unroll
    for (int i = 0; i < 4; ++i) {
      const int R = m0 + wm * 64 + i * 16 + fq * 4;
      size_t base; int Tk, b, k;
      if (R < NPR) { b = R >> 8; k = R & 255; Tk = 256; base = 0; } else { const int s = R - NPR; b = s / 1536; k = s - b * 1536; Tk = 1536; base = (size_t)NPR * 512; }
#pragma unroll
      for (int j = 0; j < 4; ++j) {
        const int c = n0 - 512 + wn * 64 + j * 16 + fr, h = c >> 6, vd = c & 63;
        *(u32x2*)(VT + base + ((size_t)(b * 8 + h) * 64 + vd) * Tk + k) = pk4(acc[i][j]);
      }
    }
  }
}

template <int NJ>
__device__ __forceinline__ void f2_tile(const Params& p, int tile, char* lds) {
  const int tid = tidx(), lane = tid & 63, wid = tid >> 6, wm = wid >> 1, wn = wid & 1, fr = lane & 15, fq = lane >> 4;
  char* ws = wsp(p.ws);
  const bf16_t *A, *B; int K, tokb, g, nh = 0; float scale;
  if (NJ == 2) {
    const int b = tile >> 6, mt = (tile >> 1) & 7; g = (tile >> 4) & 3; nh = tile & 1;
    A = (const bf16_t*)(ws + O_D1024) + (size_t)mt * 128 * 2048; K = 2048;
    B = (const bf16_t*)(ws + O_UT) + (size_t)NPR * 1024 + ((size_t)(b * 4 + g) * 128 + nh * 64) * 2048;
    tokb = NPR + b * 1024 + mt * 128; scale = 0.00276213586400995f;
  } else {
    const int b = tile >> 3, mt = tile & 1; g = (tile >> 1) & 3;
    A = (const bf16_t*)(ws + O_D256) + (size_t)mt * 128 * 512; K = 512;
    B = (const bf16_t*)(ws + O_UT) + (size_t)(b * 4 + g) * 128 * 512;
    tokb = b * 256 + mt * 128; scale = 0.0055242717280199f;
  }
  f32x4 acc[4][NJ];
#pragma unroll
  for (int i = 0; i < 4; ++i)
#pragma unroll
    for (int j = 0; j < NJ; ++j) acc[i][j] = (f32x4){0.f, 0.f, 0.f, 0.f};
  gemm_core<true, NJ>(A, K, B, K, K, acc, lds);
  bf16_t* FZ = (bf16_t*)(ws + O_FZ);
#pragma unroll
  for (int i = 0; i < 4; ++i) {
    const int tok = tokb + wm * 64 + i * 16 + fr;
#pragma unroll
    for (int j = 0; j < NJ; ++j) {
      bf16_t* gp = FZ + (size_t)tok * 512 + g * 128 + nh * 64 + wn * (NJ * 16) + j * 16 + fq * 4;
      const u32x2 gz = *(const u32x2*)gp;
      f32x4 y;
      y[0] = acc[i][j][0] * scale * bflo(gz.x); y[1] = acc[i][j][1] * scale * bfhi(gz.x);
      y[2] = acc[i][j][2] * scale * bflo(gz.y); y[3] = acc[i][j][3] * scale * bfhi(gz.y);
      *(unsigned*)(ws + O_BR8 + (size_t)2 * NTOK * 512 + (size_t)tok * 512 + g * 128 + nh * 64 + wn * (NJ * 16) + j * 16 + fq * 4) = pk4f8(y[0] * 8.f, y[1] * 8.f, y[2] * 8.f, y[3] * 8.f);
    }
  }
}

template <int NJ>
__device__ __forceinline__ void s6_tile(const Params& p, int l, int tile, int ntile, char* lds, int& par, bool& primed) {
  const int tid = tidx(), lane = tid & 63, wid = tid >> 6, wm = wid >> 1, wn = wid & 1, fr = lane & 15, fq = lane >> 4;
  constexpr int NT = 32 / NJ, BN = NJ * 32;
  const int m = (tile / (32 * NT)) * 32 + (tile % 32), nt = (tile % (32 * NT)) / 32, m0 = m * 128, n0 = nt * BN;
  char* ws = wsp(p.ws);
  const char* H8 = (const char*)(ws + O_H8);
  const char* W8 = (const char*)(ws + O_WG8) + (size_t)l * 3072 * 1024;
  const char* Wb = (const char*)(ws + O_WBR) + (size_t)(l * 3) * 1024 * 512;
  f32x4 tot[4][NJ], acc[4][NJ];
  unsigned sg[4][NJ];
#pragma unroll
  for (int i = 0; i < 4; ++i)
#pragma unroll
    for (int j = 0; j < NJ; ++j) tot[i][j] = (f32x4){0.f, 0.f, 0.f, 0.f};
#pragma unroll 1
  for (int nb = 0; nb < 3; ++nb) {
    u32x2 totp[4][NJ];
#pragma unroll
    for (int i = 0; i < 4; ++i)
#pragma unroll
      for (int j = 0; j < NJ; ++j) { totp[i][j] = pk4(tot[i][j]); acc[i][j] = (f32x4){0.f, 0.f, 0.f, 0.f}; }
    const char* brA = (const char*)(ws + O_BR8) + ((size_t)nb * NTOK + m0) * 512;
    const char* brB = Wb + ((size_t)nb * 1024 + n0) * 512;
    gemm_bytes<true, NJ, 2, true>(H8 + (size_t)m0 * 1024, 1024, W8 + ((size_t)nb * 1024 + n0) * 1024, 1024, 1024, acc, lds, par, primed, brA, 512, brB, 512);
#pragma unroll
    for (int i = 0; i < 4; ++i)
#pragma unroll
      for (int j = 0; j < NJ; ++j) {
        unsigned q = 0;
#pragma unroll
        for (int e = 0; e < 4; ++e) {
          const unsigned qe = (unsigned)fmaxf(sigm_f(acc[i][j][e] * 0.03125f) * 255.f + 0.5f, 1.f);
          q |= qe << (8 * e);
          tot[i][j][e] = (e == 0 ? bflo(totp[i][j].x) : e == 1 ? bfhi(totp[i][j].x) : e == 2 ? bflo(totp[i][j].y) : bfhi(totp[i][j].y)) * __builtin_amdgcn_rcpf((float)qe * (1.f / 255.f));
        }
        sg[i][j] = q;
      }
    const char *nA = nullptr, *nB = nullptr;
    if (nb < 2) { nA = H8 + (size_t)m0 * 1024; nB = W8 + ((size_t)(nb + 1) * 1024 + n0) * 1024; }
    else if (ntile >= 0) { nA = H8 + (size_t)(((ntile / (32 * NT)) * 32 + (ntile % 32)) * 128) * 1024; nB = W8 + (size_t)(((ntile % (32 * NT)) / 32) * BN) * 1024; }
    gemm_bytes<true, NJ, 2, true>(brA, 512, brB, 512, 512, tot, lds, par, true, nA, 1024, nB, 1024);
    primed = nA != nullptr;
#pragma unroll
    for (int i = 0; i < 4; ++i)
#pragma unroll
      for (int j = 0; j < NJ; ++j) {
        tot[i][j][0] *= (float)(sg[i][j] & 0xffu) * (1.f / 255.f); tot[i][j][1] *= (float)((sg[i][j] >> 8) & 0xffu) * (1.f / 255.f);
        tot[i][j][2] *= (float)((sg[i][j] >> 16) & 0xffu) * (1.f / 255.f); tot[i][j][3] *= (float)(sg[i][j] >> 24) * (1.f / 255.f);
      }
  }
  unsigned char* MG = (unsigned char*)(ws + O_UT);
#pragma unroll
  for (int i = 0; i < 4; ++i) {
    const int tok = m0 + wm * 64 + i * 16 + fr;
#pragma unroll
    for (int j = 0; j < NJ; ++j) *(unsigned*)(MG + (size_t)tok * 1024 + n0 + wn * (NJ * 16) + j * 16 + fq * 4) = pk4f8(tot[i][j][0] * (1.f / 256.f), tot[i][j][1] * (1.f / 256.f), tot[i][j][2] * (1.f / 256.f), tot[i][j][3] * (1.f / 256.f));
  }
}

__device__ __forceinline__ void s7_tile(const Params& p, int l, int tile, const float* xp, const float* xs, char* lds) {
  const int tid = tidx(), lane = tid & 63, wid = tid >> 6, wm = wid >> 1, wn = wid & 1, fr = lane & 15, fq = lane >> 4;
  const int m = (tile / 512) * 32 + (tile % 32), nt = (tile % 512) / 32, m0 = m * 128, n0 = nt * 64;
  char* ws = wsp(p.ws);
  f32x4 acc[4][2];
#pragma unroll
  for (int i = 0; i < 4; ++i) { acc[i][0] = (f32x4){0.f, 0.f, 0.f, 0.f}; acc[i][1] = (f32x4){0.f, 0.f, 0.f, 0.f}; }
  { int par = 0; gemm_bytes<true, 2, 1, true>((const char*)(ws + O_UT) + (size_t)m0 * 1024, 1024, (const char*)(ws + O_WO) + ((size_t)l * 1024 + n0) * 1024, 1024, 1024, acc, lds, par, false, nullptr, 0, nullptr, 0); }
#pragma unroll
  for (int i = 0; i < 4; ++i) {
    const int tok = m0 + wm * 64 + i * 16 + fr;
    const float* src = tok < NPR ? xp + (size_t)tok * 1024 : xs + (size_t)(tok - NPR) * 1024;
    const int v = tok < NPR ? 0 : 1 + ((tok - NPR) >> 10);
    const float* gate = (const float*)(ws + O_MOD) + (l * 5 + v) * 3072 + 2048;
#pragma unroll
    for (int j = 0; j < 2; ++j) {
      const int col = n0 + wn * 32 + j * 16 + fq * 4;
      const f32x4 x = *(const f32x4*)(src + col), gt = *(const f32x4*)(gate + col);
      f32x4 y;
#pragma unroll
      for (int e = 0; e < 4; ++e) y[e] = x[e] + gt[e] * (acc[i][j][e] * 0.03125f);
      *(f32x4*)(p.out + (size_t)tok * 1024 + col) = y;
    }
  }
}

constexpr int NPHASE = 16;
__device__ __forceinline__ int q_issue(unsigned* ctr) {
  int v = 0;
  if (threadIdx.x == 0) v = (int)__hip_atomic_fetch_add(ctr, 1u, __ATOMIC_RELAXED, __HIP_MEMORY_SCOPE_AGENT);
  return v;
}
__device__ __forceinline__ int q_bcast(int v, char* lds) {
  __syncthreads();
  if (threadIdx.x == 0) *(volatile int*)lds = v;
  __syncthreads();
  const int it = *(volatile int*)lds;
  __syncthreads();
  return it;
}
__device__ __forceinline__ void run_phase(const Params& p, int ph, char* lds, unsigned* qctr) {
  const int bid = blockIdx.x, nb = gridDim.x;
  if (ph == 0) { for (int i = bid; i < P0_N; i += nb) phase0_item(p, i, lds); return; }
  if (ph == 15) { for (int i = bid; i < 512; i += nb) final_item(p, i); return; }
  const int l = (ph - 1) / 7, s = (ph - 1) % 7;
  const float* xp = l == 0 ? p.x_prompt : p.out;
  const float* xs = l == 0 ? p.x_sample : p.out + (size_t)NPR * 1024;
  switch (s) {
    case 0: for (int i = bid; i < 512; i += nb) norm_item(p, l, i, xp, xs); break;
    case 1: for (int i = bid; i < 2880; i += nb) s2_tile(p, l, i, lds); break;
    case 2:
      for (int i = q_bcast(q_issue(qctr + ph), lds); i < 2752;) {
        if (i < 128) attn_item<1>(p, l, i, lds);
        else if (i < 1024) keyprep_item(p, l, i - 128);
        else if (i < 1280) attn_item<1>(p, l, 128 + (i - 1024), lds);
        else if (i < 1408) state_item(p, l, i - 1280);
        else if (i < 1984) qup_tile(p, l, i - 1408, lds);
        else f1_tile(p, i - 1984, lds);
        i = q_bcast(q_issue(qctr + ph), lds);
      }
      break;
    case 3:
      for (int i = q_bcast(q_issue(qctr + ph), lds); i < 1408;) {
        if (i < 256) f2_tile<2>(p, i, lds);
        else if (i < 512) f2_tile<4>(p, i - 256, lds);
        else kvup_tile(p, l, i - 512, lds);
        i = q_bcast(q_issue(qctr + ph), lds);
      }
      break;
    case 4:
      for (int i = q_bcast(q_issue(qctr + ph), lds); i < 768;) {
        attn_item<0>(p, l, i, lds);
        i = q_bcast(q_issue(qctr + ph), lds);
      }
      break;
    case 5: { int par = 0; bool primed = false; for (int i = bid; i < 768; i += nb) s6_tile<4>(p, l, i, (i + nb < 768) ? i + nb : -1, lds, par, primed); } break;
    case 6: for (int i = bid; i < 1536; i += nb) s7_tile(p, l, i, xp, xs, lds); break;
  }
}

#define XB_TMO      128
#define XB_XCNT(j)  (256  + 64 * (j))
#define XB_XSUB(j)  (1280 + 64 * (j))
#define XB_XGEN(j)  (2304 + 64 * (j))
#define XB_TOP      3328
#define XB_TOPGEN   3392
#define XCD_BAR_WORDS 3456
#define XB_SPIN_CAP (1u << 18)
__device__ __forceinline__ unsigned xb_ld(unsigned* p)              { return __hip_atomic_load(p, __ATOMIC_RELAXED, __HIP_MEMORY_SCOPE_AGENT); }
__device__ __forceinline__ unsigned xb_add(unsigned* p, unsigned v) { return __hip_atomic_fetch_add(p, v, __ATOMIC_RELAXED, __HIP_MEMORY_SCOPE_AGENT); }
__device__ __forceinline__ unsigned xb_xcc_id() { return (unsigned)__builtin_amdgcn_s_getreg((3 << 11) | 20) & 0xFu; }
#define XB_SPIN(cond, bar) do { unsigned _sp = 0; while (cond) { __builtin_amdgcn_s_sleep(1); \
    if ((++_sp & 255u) == 0u) { if (xb_ld(&(bar)[XB_TMO])) break; if (_sp > XB_SPIN_CAP) { atomicAdd(&(bar)[XB_TMO], 1u); break; } } } } while (0)
__device__ __forceinline__ void xcd_barrier_complete(unsigned* bar, unsigned x, unsigned& nloc, unsigned& nx) {
  const unsigned G = gridDim.x;
  unsigned sum, cnt, mine, sp = 0u;
  for (;;) {
    sum = 0u; cnt = 0u; mine = 0u;
#pragma unroll
    for (unsigned j = 0; j < 16; ++j) { const unsigned c = xb_ld(&bar[XB_XCNT(j)]); sum += c; cnt += (c > 0u) ? 1u : 0u; mine = (j == x) ? c : mine; }
    if (sum == G) break;
    __builtin_amdgcn_s_sleep(1);
    if ((++sp & 255u) == 0u) { if (xb_ld(&bar[XB_TMO])) break; if (sp > XB_SPIN_CAP) { atomicAdd(&bar[XB_TMO], 1u); break; } }
  }
  nloc = mine > 0u ? mine : 1u; nx = cnt > 0u ? cnt : 1u;
}
__device__ __forceinline__ void xcd_barrier(unsigned* bar, unsigned x, unsigned& nloc, unsigned& nx) {
  asm volatile("s_waitcnt vmcnt(0)" ::: "memory");
  __syncthreads();
  if (threadIdx.x == 0) {
    __builtin_amdgcn_s_waitcnt(0);
    if (nloc == 0u) xcd_barrier_complete(bar, x, nloc, nx);
    const unsigned old = xb_add(&bar[XB_XSUB(x)], 1u);
    const unsigned gen = old / nloc;
    if (old + 1u == (gen + 1u) * nloc) {
      __builtin_amdgcn_fence(__ATOMIC_RELEASE, "agent");
      asm volatile("s_waitcnt vmcnt(0)" ::: "memory");
      const unsigned og = xb_add(&bar[XB_TOP], 1u);
      const unsigned tg = og / nx;
      if (og + 1u == (tg + 1u) * nx) xb_add(&bar[XB_TOPGEN], 1u);
      else XB_SPIN(xb_ld(&bar[XB_TOPGEN]) == tg, bar);
      __builtin_amdgcn_fence(__ATOMIC_ACQUIRE, "agent");
      xb_add(&bar[XB_XGEN(x)], 1u);
      asm volatile("s_waitcnt vmcnt(0)" ::: "memory");
    } else {
      XB_SPIN(xb_ld(&bar[XB_XGEN(x)]) == gen, bar);
      __builtin_amdgcn_fence(__ATOMIC_ACQUIRE, "agent");
      asm volatile("s_waitcnt vmcnt(0)" ::: "memory");
    }
  }
  __syncthreads();
}

__global__ void __launch_bounds__(256, 2) mk_fwd(Params p) {
  __shared__ __attribute__((aligned(16))) char lds[LDS_TOTAL];
  cg::grid_group grid = cg::this_grid();
  unsigned* bar = (unsigned*)(p.ws + O_BAR);
  const unsigned xcc = xb_xcc_id();
  if (threadIdx.x == 0) (void)xb_add(&bar[XB_XCNT(xcc)], 1u);
  unsigned nloc = 0u, nx = 0u;
  if (gridDim.x == 0x7fffffffu) grid.sync();
#pragma unroll 1
  for (int ph = 0; ph < NPHASE; ++ph) {
    run_phase(p, ph, lds, bar);
    if (ph + 1 < NPHASE) xcd_barrier(bar, xcc, nloc, nx);
  }
}

extern "C" void kernel_launch(void* const* d_in, const int* in_sizes, int n_in, void* d_out, int out_size, void* d_ws, size_t ws_size,
                              hipStream_t stream) {
  Params p{};
  p.x_prompt = (const float*)d_in[0]; p.x_sample = (const float*)d_in[1]; p.cache_ckv = (const float*)d_in[2]; p.cache_krope = (const float*)d_in[3];
  p.state_ret = (const float*)d_in[4]; p.c = (const float*)d_in[5]; p.c_ctx = (const float*)d_in[6]; p.norm_g = (const float*)d_in[7];
  p.w_mod = (const float*)d_in[8]; p.b_mod = (const float*)d_in[9]; p.w_in = (const float*)d_in[10]; p.ret_logit = (const float*)d_in[11];
  p.q_norm_g = (const float*)d_in[12]; p.w_q_up = (const float*)d_in[13]; p.kv_norm_g = (const float*)d_in[14]; p.w_kv_up = (const float*)d_in[15];
  p.w_branch = (const float*)d_in[16]; p.w_out = (const float*)d_in[17]; p.final_g = (const float*)d_in[18];
  p.out = (float*)d_out; p.ws = (char*)d_ws;
#if ONE_LAUNCH
  static int grid_blocks = 0;
  if (!grid_blocks) {
    int dev = 0, cus = 0, per_cu = 0;
    hipGetDevice(&dev);
    hipDeviceGetAttribute(&cus, hipDeviceAttributeMultiprocessorCount, dev);
    hipOccupancyMaxActiveBlocksPerMultiprocessor(&per_cu, mk_fwd, 256, 0);
    if (per_cu > 2) per_cu = 2;
    grid_blocks = cus * per_cu;
  }
  hipMemsetAsync((char*)d_ws + O_BAR, 0, XCD_BAR_WORDS * 4, stream);
  void* args[] = {&p};
  hipError_t e = hipLaunchCooperativeKernel((void*)mk_fwd, dim3(grid_blocks), dim3(256), args, 0, stream);
  if (e != hipSuccess) fprintf(stderr, "cooperative launch failed: %s (grid %d)\n", hipGetErrorString(e), grid_blocks);
#endif
}
```

```cpp
#include <hip/hip_runtime.h>
#include <hip/hip_cooperative_groups.h>
#include <stdint.h>
#include <stdio.h>
namespace cg = cooperative_groups;

#ifndef ONE_LAUNCH
#define ONE_LAUNCH 1
#endif

typedef unsigned short bf16_t;
typedef short bf16x8 __attribute__((ext_vector_type(8)));
typedef float f32x4 __attribute__((ext_vector_type(4)));
typedef unsigned u32x4 __attribute__((ext_vector_type(4)));
typedef unsigned u32x2 __attribute__((ext_vector_type(2)));

constexpr int NTOK = 12288, NPR = 8192, NKEY = 14336;
constexpr float EPSN = 1e-6f;

constexpr size_t O_WIN   = 0;
constexpr size_t O_WQ    = O_WIN   + (size_t)2 * 6912 * 1024 * 2;
constexpr size_t O_WKV   = O_WQ    + (size_t)2 * 768 * 384 * 2;
constexpr size_t O_WBR   = O_WKV   + (size_t)2 * 1024 * 256 * 2;
constexpr size_t O_WO    = O_WBR   + (size_t)6 * 1024 * 512 * 2;
constexpr size_t O_CS    = O_WO    + (size_t)2 * 1024 * 1024 * 2;
constexpr size_t O_D256  = O_CS    + (size_t)256 * 128 * 2;
constexpr size_t O_D1024 = O_D256  + (size_t)256 * 512 * 2;
constexpr size_t O_S0T   = O_D1024 + (size_t)1024 * 2048 * 2;
constexpr size_t O_MOD   = O_S0T   + (size_t)64 * 128 * 64 * 2;
constexpr size_t O_H     = O_MOD   + (size_t)2 * 5 * 3072 * 4;
constexpr size_t O_BR8   = O_H;
constexpr size_t O_UT    = O_H     + (size_t)NTOK * 1024 * 2;
constexpr size_t O_RQ    = O_UT    + (size_t)NTOK * 1024 * 2;
constexpr size_t O_RK    = O_RQ    + (size_t)NTOK * 256 * 2;
constexpr size_t O_RKT   = O_RK    + (size_t)NTOK * 256 * 2;
constexpr size_t O_RVT   = O_RKT   + (size_t)NPR * 256 * 2;
constexpr size_t O_KVLAT = O_RVT   + (size_t)NTOK * 512 * 2;
constexpr size_t O_KR    = O_KVLAT + (size_t)NTOK * 256 * 4;
constexpr size_t O_R2END = O_KR    + (size_t)NTOK * 32 * 4;
constexpr size_t O_VT    = O_RQ;
static_assert(O_VT + (size_t)NKEY * 512 * 2 <= O_R2END, "alias overflow");
constexpr size_t O_RZ    = O_R2END;
constexpr size_t O_MZ    = O_RZ    + (size_t)NTOK * 512 * 2;
constexpr size_t O_FZ    = O_MZ    + (size_t)NTOK * 512 * 2;
constexpr size_t O_FU    = O_FZ    + (size_t)NTOK * 512 * 2;
constexpr size_t O_QLAT  = O_FU    + (size_t)NTOK * 512 * 2;
constexpr size_t O_CKVA  = O_QLAT  + (size_t)NTOK * 384 * 2;
constexpr size_t O_KB    = O_CKVA  + (size_t)NKEY * 256 * 2;
constexpr size_t O_KRA   = O_KB    + (size_t)NKEY * 512 * 2;
constexpr size_t O_QB    = O_KRA   + (size_t)NKEY * 32 * 2;
constexpr size_t O_H8    = O_QB    + (size_t)NTOK * 768 * 2;
constexpr size_t O_WG8   = O_H8    + (size_t)NTOK * 1024;
constexpr size_t O_END   = O_WG8   + (size_t)2 * 3072 * 1024;
constexpr size_t O_ROPE  = (O_END + 255) & ~(size_t)255;
constexpr size_t O_BAR   = O_ROPE + 4096;
static_assert(O_BAR + 16384 <= (size_t)256 * 1024 * 1024, "workspace too large");

constexpr size_t OUT_CKV = (size_t)NTOK * 1024;
constexpr size_t OUT_KR  = OUT_CKV + (size_t)32 * 2 * 256 * 256;
constexpr size_t OUT_RET = OUT_KR + (size_t)32 * 2 * 256 * 32;

struct Params {
  const float *x_prompt, *x_sample, *cache_ckv, *cache_krope, *state_ret, *c, *c_ctx, *norm_g, *w_mod, *b_mod,
      *w_in, *ret_logit, *q_norm_g, *w_q_up, *kv_norm_g, *w_kv_up, *w_branch, *w_out, *final_g;
  float* out;
  char* ws;
};

constexpr int PANEL = 128 * 64;
constexpr int ABYTES = 2 * PANEL;
constexpr int STAGE = 2 * ABYTES;
constexpr int LDS_GEMM = 2 * STAGE;
constexpr int LDS_TOTAL = LDS_GEMM;
static_assert(LDS_TOTAL <= 65536, "static LDS");

typedef float f32x2 __attribute__((ext_vector_type(2)));
typedef __bf16 bf16x2v __attribute__((ext_vector_type(2)));
__device__ __forceinline__ unsigned pk2(float lo, float hi) { const f32x2 v = {lo, hi}; return __builtin_bit_cast(unsigned, __builtin_convertvector(v, bf16x2v)); }
__device__ __forceinline__ bf16_t tobf(float x) { return (bf16_t)(pk2(x, 0.f) & 0xffffu); }
typedef int v8i __attribute__((ext_vector_type(8)));
__device__ __forceinline__ float sat8(float x) { return __builtin_amdgcn_fmed3f(x, -448.f, 448.f); }
__device__ __forceinline__ unsigned pk4f8(float a, float b, float c, float d) { unsigned w = 0; a = sat8(a); b = sat8(b); c = sat8(c); d = sat8(d); w = __builtin_amdgcn_cvt_pk_fp8_f32(a, b, w, false); w = __builtin_amdgcn_cvt_pk_fp8_f32(c, d, w, true); return w; }
__device__ __forceinline__ float bflo(unsigned u) { return __uint_as_float(u << 16); }
__device__ __forceinline__ float bfhi(unsigned u) { return __uint_as_float(u & 0xffff0000u); }
__device__ __forceinline__ float ex2(float x) { return __builtin_amdgcn_exp2f(x); }
__device__ __forceinline__ float silu_f(float x) { return x / (1.f + __expf(-x)); }
__device__ __forceinline__ float sigm_f(float x) { return 1.f / (1.f + __expf(-x)); }
__device__ __forceinline__ u32x2 pk4(f32x4 v) { u32x2 r; r.x = pk2(v[0], v[1]); r.y = pk2(v[2], v[3]); return r; }
#define GAS __attribute__((address_space(1)))
#define LAS __attribute__((address_space(3)))
__device__ __forceinline__ u32x4 ldg16(const void* p) { return *(const GAS u32x4*)p; }
__device__ __forceinline__ int tidx() { int t = threadIdx.x; asm volatile("" : "+v"(t)); return t; }
__device__ __forceinline__ char* wsp(const char* w) { unsigned long long v = (unsigned long long)w; asm volatile("" : "+s"(v)); return (char*)v; }
__device__ __forceinline__ int swz(int r) { return (0 - ((r >> 2) & 3)) & 3; }
__device__ __forceinline__ float wave_sum(float v) {
#pragma unroll
  for (int o = 1; o < 64; o <<= 1) v += __shfl_xor(v, o);
  return v;
}
__device__ __forceinline__ f32x4 mfma16(bf16x8 a, bf16x8 b, f32x4 c) { return __builtin_amdgcn_mfma_f32_16x16x32_bf16(a, b, c, 0, 0, 0); }
__device__ __forceinline__ bf16x8 as_bf8(u32x4 v) { return __builtin_bit_cast(bf16x8, v); }

__device__ __forceinline__ void zero_acc(f32x4 (&acc)[4][4]) {
#pragma unroll
  for (int i = 0; i < 4; ++i)
#pragma unroll
    for (int j = 0; j < 4; ++j) acc[i][j] = (f32x4){0.f, 0.f, 0.f, 0.f};
}

template <bool SWAP, int NJ, int PIPE, bool F8>
__device__ __forceinline__ void gemm_bytes(const char* __restrict__ A, int lda, const char* __restrict__ B, int ldb, int Kb,
                                           f32x4 (&acc)[4][NJ], char* lds, int& par, bool primed,
                                           const char* nA, int nlda, const char* nB, int nldb) {
  const int tid = tidx(), lane = tid & 63, wm = (tid >> 6) >> 1, wn = (tid >> 6) & 1;
  const int wid = __builtin_amdgcn_readfirstlane(tid >> 6);
  const int fr = lane & 15, fq = lane >> 4;
  const int fa = (wm * 64 + fr) * 64 + ((fq ^ swz(fr)) << 4);
  const int fb = ABYTES + (wn * NJ * 16 + fr) * 64 + ((fq ^ swz(fr)) << 4);
  const int lrow = lane >> 2, lchunk = (lane & 3) ^ swz(lrow);
  constexpr int NBL = NJ / 2;
  const GAS char* gA = (const GAS char*)(A + (size_t)(wid * 32 + lrow) * lda + lchunk * 16);
  const GAS char* gB = (const GAS char*)(B + (size_t)(wid * NBL * 16 + lrow) * ldb + lchunk * 16);
  const size_t a16 = (size_t)16 * lda, b16 = (size_t)16 * ldb;
  LAS char* ldsA = (LAS char*)lds + wid * 2048;
  LAS char* ldsB = (LAS char*)lds + ABYTES + wid * NBL * 1024;
  const int nk = Kb >> 7;
#define GC_ISSUE(pa, pb, sa, sb, stage, kbyte) do { \
    _Pragma("unroll") for (int g = 0; g < 2; ++g) _Pragma("unroll") for (int pn = 0; pn < 2; ++pn) \
      __builtin_amdgcn_global_load_lds((const GAS unsigned*)((pa) + g * (sa) + (kbyte) + pn * 64), (LAS unsigned*)(ldsA + (stage) + pn * PANEL + g * 1024), 16, 0, 0); \
    _Pragma("unroll") for (int g = 0; g < NBL; ++g) _Pragma("unroll") for (int pn = 0; pn < 2; ++pn) \
      __builtin_amdgcn_global_load_lds((const GAS unsigned*)((pb) + g * (sb) + (kbyte) + pn * 64), (LAS unsigned*)(ldsB + (stage) + pn * PANEL + g * 1024), 16, 0, 0); \
  } while (0)
  if (!primed) {
    GC_ISSUE(gA, gB, a16, b16, par * STAGE, 0);
    asm volatile("s_waitcnt vmcnt(0)" ::: "memory");
    __syncthreads();
  }
#pragma unroll 1
  for (int kt = 0; kt < nk; ++kt) {
    char* cur = lds + par * STAGE;
    if (kt + 1 < nk) GC_ISSUE(gA, gB, a16, b16, (par ^ 1) * STAGE, (size_t)(kt + 1) * 128);
    else if (nA) {
      const GAS char* hA = (const GAS char*)(nA + (size_t)(wid * 32 + lrow) * nlda + lchunk * 16);
      const GAS char* hB = (const GAS char*)(nB + (size_t)(wid * NBL * 16 + lrow) * nldb + lchunk * 16);
      GC_ISSUE(hA, hB, (size_t)16 * nlda, (size_t)16 * nldb, (par ^ 1) * STAGE, 0);
    }
    __builtin_amdgcn_sched_barrier(0);
    if (F8) {
#pragma unroll
      for (int ih = 0; ih < 2; ++ih) {
        v8i av[2];
#pragma unroll
        for (int ii = 0; ii < 2; ++ii) {
          const u32x4 a0 = *(const u32x4*)(cur + fa + (ih * 2 + ii) * 1024), a1 = *(const u32x4*)(cur + PANEL + fa + (ih * 2 + ii) * 1024);
          av[ii] = (v8i){(int)a0.x, (int)a0.y, (int)a0.z, (int)a0.w, (int)a1.x, (int)a1.y, (int)a1.z, (int)a1.w};
        }
#pragma unroll
        for (int j = 0; j < NJ; ++j) {
          const u32x4 b0 = *(const u32x4*)(cur + fb + j * 1024), b1 = *(const u32x4*)(cur + PANEL + fb + j * 1024);
          const v8i bv = {(int)b0.x, (int)b0.y, (int)b0.z, (int)b0.w, (int)b1.x, (int)b1.y, (int)b1.z, (int)b1.w};
#pragma unroll
          for (int ii = 0; ii < 2; ++ii)
            acc[ih * 2 + ii][j] = SWAP ? __builtin_amdgcn_mfma_scale_f32_16x16x128_f8f6f4(bv, av[ii], acc[ih * 2 + ii][j], 0, 0, 0, 0x7f7f7f7f, 0, 0x7f7f7f7f)
                                       : __builtin_amdgcn_mfma_scale_f32_16x16x128_f8f6f4(av[ii], bv, acc[ih * 2 + ii][j], 0, 0, 0, 0x7f7f7f7f, 0, 0x7f7f7f7f);
        }
      }
    } else if (PIPE == 2) {
      bf16x8 af[2][4], bfr[NJ];
#pragma unroll
      for (int i = 0; i < 4; ++i) af[0][i] = *(const bf16x8*)(cur + fa + i * 1024);
#pragma unroll
      for (int j = 0; j < NJ; ++j) bfr[j] = *(const bf16x8*)(cur + fb + j * 1024);
#pragma unroll
      for (int i = 0; i < 4; ++i) af[1][i] = *(const bf16x8*)(cur + PANEL + fa + i * 1024);
      __builtin_amdgcn_sched_barrier(0);
#pragma unroll
      for (int i = 0; i < 4; ++i)
#pragma unroll
        for (int j = 0; j < NJ; ++j) acc[i][j] = SWAP ? mfma16(bfr[j], af[0][i], acc[i][j]) : mfma16(af[0][i], bfr[j], acc[i][j]);
#pragma unroll
      for (int j = 0; j < NJ; ++j) bfr[j] = *(const bf16x8*)(cur + PANEL + fb + j * 1024);
#pragma unroll
      for (int i = 0; i < 4; ++i)
#pragma unroll
        for (int j = 0; j < NJ; ++j) acc[i][j] = SWAP ? mfma16(bfr[j], af[1][i], acc[i][j]) : mfma16(af[1][i], bfr[j], acc[i][j]);
    } else if (PIPE == 1) {
      bf16x8 af[2][4], bfr[2][NJ];
#pragma unroll
      for (int ks = 0; ks < 2; ++ks) {
#pragma unroll
        for (int i = 0; i < 4; ++i) af[ks][i] = *(const bf16x8*)(cur + ks * PANEL + fa + i * 1024);
#pragma unroll
        for (int j = 0; j < NJ; ++j) bfr[ks][j] = *(const bf16x8*)(cur + ks * PANEL + fb + j * 1024);
      }
      __builtin_amdgcn_sched_barrier(0);
#pragma unroll
      for (int ks = 0; ks < 2; ++ks)
#pragma unroll
        for (int i = 0; i < 4; ++i)
#pragma unroll
          for (int j = 0; j < NJ; ++j) acc[i][j] = SWAP ? mfma16(bfr[ks][j], af[ks][i], acc[i][j]) : mfma16(af[ks][i], bfr[ks][j], acc[i][j]);
    } else {
#pragma unroll
      for (int ks = 0; ks < 2; ++ks) {
        bf16x8 af[4], bfr[NJ];
#pragma unroll
        for (int i = 0; i < 4; ++i) af[i] = *(const bf16x8*)(cur + ks * PANEL + fa + i * 1024);
#pragma unroll
        for (int j = 0; j < NJ; ++j) bfr[j] = *(const bf16x8*)(cur + ks * PANEL + fb + j * 1024);
#pragma unroll
        for (int i = 0; i < 4; ++i)
#pragma unroll
          for (int j = 0; j < NJ; ++j) acc[i][j] = SWAP ? mfma16(bfr[j], af[i], acc[i][j]) : mfma16(af[i], bfr[j], acc[i][j]);
      }
    }
    __builtin_amdgcn_sched_barrier(0);
    asm volatile("s_waitcnt vmcnt(0)" ::: "memory");
    __syncthreads();
    par ^= 1;
  }
#undef GC_ISSUE
}
template <bool SWAP, int NJ = 4, int PIPE = 1>
__device__ __forceinline__ void gemm_core(const bf16_t* __restrict__ A, int lda, const bf16_t* __restrict__ B, int ldb, int K,
                                          f32x4 (&acc)[4][NJ], char* lds, int& par, bool primed,
                                          const bf16_t* nA, int nlda, const bf16_t* nB, int nldb) {
  gemm_bytes<SWAP, NJ, PIPE, false>((const char*)A, lda * 2, (const char*)B, ldb * 2, K * 2, acc, lds, par, primed, (const char*)nA, nlda * 2, (const char*)nB, nldb * 2);
}
template <bool SWAP, int NJ = 4>
__device__ __forceinline__ void gemm_core(const bf16_t* __restrict__ A, int lda, const bf16_t* __restrict__ B, int ldb, int K,
                                          f32x4 (&acc)[4][NJ], char* lds) {
  int par = 0;
  gemm_core<SWAP, NJ>(A, lda, B, ldb, K, acc, lds, par, false, nullptr, 0, nullptr, 0);
}

__device__ __forceinline__ void tr_tile(const float* __restrict__ src, int lds_, int k0, int ns0, bf16_t* __restrict__ dst, int ldd, int nd0,
                                        const float* __restrict__ ksc, char* lds) {
  bf16_t* T = (bf16_t*)lds;
  const int tid = tidx();
  __syncthreads();
#pragma unroll
  for (int i = 0; i < 2; ++i) {
    const int kk = (tid >> 3) + 32 * i, nn4 = (tid & 7) * 4;
    const f32x4 v = *(const f32x4*)(src + (size_t)(k0 + kk) * lds_ + ns0 + nn4);
    const float s = ksc ? ksc[k0 + kk] : 1.f;
#pragma unroll
    for (int e = 0; e < 4; ++e) T[(nn4 + e) * 72 + kk] = tobf(v[e] * s);
  }
  __syncthreads();
  const int nn = tid >> 3, kc = (tid & 7) * 8;
  const u32x4 w = *(const u32x4*)(T + nn * 72 + kc);
  *(u32x4*)(dst + (size_t)(nd0 + nn) * ldd + k0 + kc) = w;
}

__device__ __forceinline__ void tr_tile2(const float* __restrict__ src, int lds_, int k0, int ns0, bf16_t* __restrict__ dst, int ldd, int nd0,
                                         const float* __restrict__ ksc, char* lds, unsigned char* dst8 = nullptr, int ld8 = 1024) {
  bf16_t* T = (bf16_t*)lds;
  unsigned char* T8 = (unsigned char*)lds + 8704;
  const int tid = tidx();
  __syncthreads();
  f32x4 v[4];
#pragma unroll
  for (int i = 0; i < 4; ++i) v[i] = *(const GAS f32x4*)(src + (size_t)(k0 + (tid >> 3) + 32 * i) * lds_ + ns0 + (tid & 7) * 4);
#pragma unroll
  for (int i = 0; i < 4; ++i) {
    const int kk = (tid >> 3) + 32 * i, nn4 = (tid & 7) * 4;
    const float sc = ksc ? ksc[k0 + kk] : 1.f;
#pragma unroll
    for (int e = 0; e < 4; ++e) T[(nn4 + e) * 136 + kk] = tobf(v[i][e] * sc);
    if (dst8) {
#pragma unroll
      for (int e = 0; e < 4; ++e) T8[(nn4 + e) * 144 + kk] = (unsigned char)(__builtin_amdgcn_cvt_pk_fp8_f32(sat8(v[i][e] * 32.f), 0.f, 0, false) & 0xff);
    }
  }
  __syncthreads();
  const int nn = tid >> 3, kc = (tid & 7) * 16;
  if (dst8) *(u32x4*)(dst8 + (size_t)nn * ld8 + k0 + kc) = *(const u32x4*)(T8 + nn * 144 + kc);
  if (!dst) return;
  const u32x4 w0 = *(const u32x4*)(T + nn * 136 + kc), w1 = *(const u32x4*)(T + nn * 136 + kc + 8);
  bf16_t* d = dst + (size_t)(nd0 + nn) * ldd + k0 + kc;
  *(u32x4*)d = w0; *(u32x4*)(d + 8) = w1;
}

constexpr int P0_GEMV = 192, P0_WIN = 3408, P0_WQ = 144, P0_WKV = 128, P0_WBR = 768, P0_WO = 512, P0_S0 = 256, P0_PAD = 96, P0_TAB = 1105;
constexpr int P0_N = P0_GEMV + P0_WIN + P0_WQ + P0_WKV + P0_WBR + P0_WO + P0_S0 + P0_PAD + P0_TAB;

__device__ __forceinline__ void phase0_item(const Params& p, int j, char* lds) {
  const int tid = tidx();
  char* ws = wsp(p.ws);
  if (j < P0_GEMV) {
    const int l = j / 96, cgi = j % 96;
    float* sv = (float*)lds;
    float* red = (float*)(lds + 20480);
    __syncthreads();
    for (int i = tid; i < 5120; i += 256) { const int v = i >> 10, k = i & 1023; const float x = (v == 0) ? p.c_ctx[k] : p.c[(v - 1) * 1024 + k]; sv[i] = silu_f(x); }
    __syncthreads();
    const int c4 = tid & 7, kg = tid >> 3;
    const float* w = p.w_mod + (size_t)l * 1024 * 3072 + cgi * 32 + c4 * 4;
    f32x4 a0 = {0.f, 0.f, 0.f, 0.f}, a1 = a0, a2 = a0, a3 = a0, a4 = a0;
#pragma unroll 8
    for (int k = kg * 32; k < kg * 32 + 32; ++k) {
      const f32x4 wv = *(const GAS f32x4*)(w + (size_t)k * 3072);
      a0 += wv * sv[k]; a1 += wv * sv[1024 + k]; a2 += wv * sv[2048 + k]; a3 += wv * sv[3072 + k]; a4 += wv * sv[4096 + k];
    }
    *(f32x4*)(red + (kg * 5 + 0) * 32 + c4 * 4) = a0; *(f32x4*)(red + (kg * 5 + 1) * 32 + c4 * 4) = a1; *(f32x4*)(red + (kg * 5 + 2) * 32 + c4 * 4) = a2;
    *(f32x4*)(red + (kg * 5 + 3) * 32 + c4 * 4) = a3; *(f32x4*)(red + (kg * 5 + 4) * 32 + c4 * 4) = a4;
    __syncthreads();
    if (tid < 160) {
      const int v = tid >> 5, c2 = tid & 31;
      float sm = p.b_mod[l * 3072 + cgi * 32 + c2];
#pragma unroll 8
      for (int g = 0; g < 32; ++g) sm += red[(g * 5 + v) * 32 + c2];
      ((float*)(ws + O_MOD))[(l * 5 + v) * 3072 + cgi * 32 + c2] = sm;
    }
    return;
  }
  j -= P0_GEMV;
  if (j < P0_WIN) {
    const int l = j / 1704, r = j % 1704, kt = r / 213, nt = r % 213, c0 = nt * 32;
    const int nd0 = c0 < 2176 ? c0 : (c0 < 2208 ? 3712 + (c0 - 2176) : (c0 < 3744 ? c0 - 32 : c0 + 96));
    tr_tile2(p.w_in + (size_t)l * 1024 * 6816, 6816, kt * 128, c0, (bf16_t*)(ws + O_WIN) + (size_t)l * 6912 * 1024, 1024, nd0, nullptr, lds,
             nd0 >= 3840 ? (unsigned char*)(ws + O_WG8) + ((size_t)l * 3072 + (nd0 - 3840)) * 1024 : nullptr);
    return;
  }
  j -= P0_WIN;
  if (j < P0_WQ) {
    const int l = j / 72, r = j % 72, kt = r / 24, nt = r % 24;
    tr_tile2(p.w_q_up + (size_t)l * 384 * 768, 768, kt * 128, nt * 32, (bf16_t*)(ws + O_WQ) + (size_t)l * 768 * 384, 384, nt * 32, p.q_norm_g + l * 384, lds);
    return;
  }
  j -= P0_WQ;
  if (j < P0_WKV) {
    const int l = j / 64, r = j % 64, kt = r / 32, nt = r % 32, c0 = nt * 32, h = c0 >> 7, e = c0 & 127;
    const int nd0 = e < 64 ? h * 64 + e : 512 + h * 64 + (e - 64);
    tr_tile2(p.w_kv_up + (size_t)l * 256 * 1024, 1024, kt * 128, c0, (bf16_t*)(ws + O_WKV) + (size_t)l * 1024 * 256, 256, nd0, nullptr, lds);
    return;
  }
  j -= P0_WKV;
  if (j < P0_WBR) {
    const int mat = j / 128, r = j % 128, kt = r / 32, nt = r % 32;
    tr_tile2(p.w_branch + (size_t)mat * 512 * 1024, 1024, kt * 128, nt * 32, nullptr, 512, nt * 32, nullptr, lds,
             (unsigned char*)(ws + O_WBR) + ((size_t)mat * 1024 + nt * 32) * 512, 512);
    return;
  }
  j -= P0_WBR;
  if (j < P0_WO) {
    const int l = j / 256, r = j % 256, kt = r / 32, nt = r % 32;
    tr_tile2(p.w_out + (size_t)l * 1024 * 1024, 1024, kt * 128, nt * 32, nullptr, 1024, nt * 32, nullptr, lds,
             (unsigned char*)(ws + O_WO) + ((size_t)l * 1024 + nt * 32) * 1024, 1024);
    return;
  }
  j -= P0_WO;
  if (j < P0_S0) {
    const int mat = j >> 2, nt = j & 3;
    tr_tile(p.state_ret + (size_t)mat * 64 * 128, 128, 0, nt * 32, (bf16_t*)(ws + O_S0T) + (size_t)mat * 128 * 64, 64, nt * 32, nullptr, lds);
    return;
  }
  j -= P0_S0;
  if (j < P0_PAD) {
    const int l = j / 48, r = j % 48;
    bf16_t* d = (bf16_t*)(ws + O_WIN) + ((size_t)l * 6912 + 3744) * 1024 + (size_t)r * 2048 + tid * 8;
    *(u32x4*)d = (u32x4){0u, 0u, 0u, 0u};
    return;
  }
  j -= P0_PAD;
  {
    float v[8];
    bf16_t* dst = nullptr; unsigned char* dst8 = nullptr;
    if (j == 1104) {
      float* rt = (float*)(ws + O_ROPE);
#pragma unroll
      for (int q = 0; q < 2; ++q) {
        const int idx = tid * 2 + q, pos = idx >> 3, f = idx & 7;
        const float ang = (float)pos * exp2f(-(float)f * 1.66096404744f);
        rt[idx * 2] = cosf(ang); rt[idx * 2 + 1] = sinf(ang);
      }
      return;
    }
    if (j < 16) {
      const int e0 = j * 2048 + tid * 8; dst = (bf16_t*)(ws + O_CS) + e0;
      const int n = e0 >> 7, k = e0 & 127;
#pragma unroll
      for (int e = 0; e < 8; ++e) {
        const float fr = (float)(((n & 127) * (k + e)) & 127) * (1.f / 128.f);
        v[e] = (n < 128) ? __builtin_amdgcn_cosf(fr) : __builtin_amdgcn_sinf(fr);
      }
    } else if (j < 80) {
      const int e0 = (j - 16) * 2048 + tid * 8; dst8 = (unsigned char*)(ws + O_D256) + e0;
      const int k1 = e0 >> 9, kk = e0 & 511;
#pragma unroll
      for (int e = 0; e < 8; ++e) {
        const int t = (kk + e) & 255;
        const float fr = (float)((k1 * t) & 255) * (1.f / 256.f);
        v[e] = (kk < 256) ? __builtin_amdgcn_cosf(fr) : -__builtin_amdgcn_sinf(fr);
      }
    } else {
      const int e0 = (j - 80) * 2048 + tid * 8; dst8 = (unsigned char*)(ws + O_D1024) + e0;
      const int k1 = e0 >> 11, kk = e0 & 2047;
#pragma unroll
      for (int e = 0; e < 8; ++e) {
        const int t = (kk + e) & 1023;
        const float fr = (float)((k1 * t) & 1023) * (1.f / 1024.f);
        v[e] = (kk < 1024) ? __builtin_amdgcn_cosf(fr) : -__builtin_amdgcn_sinf(fr);
      }
    }
    if (dst8) {
      u32x2 w8; w8.x = pk4f8(v[0] * 64.f, v[1] * 64.f, v[2] * 64.f, v[3] * 64.f); w8.y = pk4f8(v[4] * 64.f, v[5] * 64.f, v[6] * 64.f, v[7] * 64.f);
      *(u32x2*)dst8 = w8;
    } else {
      u32x4 w; w.x = pk2(v[0], v[1]); w.y = pk2(v[2], v[3]); w.z = pk2(v[4], v[5]); w.w = pk2(v[6], v[7]);
      *(u32x4*)dst = w;
    }
  }
}

__device__ __forceinline__ void norm_item(const Params& p, int l, int item, const float* xp, const float* xs) {
  const int tid = tidx(), lane = tid & 63, wid = tid >> 6;
  bf16_t* H = (bf16_t*)(p.ws + O_H);
#pragma unroll 3
  for (int i = 0; i < 6; ++i) {
    const int row = item * 24 + wid * 6 + i;
    const float* src = row < NPR ? xp + (size_t)row * 1024 : xs + (size_t)(row - NPR) * 1024;
    const int v = row < NPR ? 0 : 1 + ((row - NPR) >> 10);
    const float* mod = (const float*)(p.ws + O_MOD) + (l * 5 + v) * 3072;
    f32x4 x[4]; float ss = 0.f;
#pragma unroll
    for (int q = 0; q < 4; ++q) { x[q] = *(const f32x4*)(src + (q * 64 + lane) * 4); ss += x[q][0] * x[q][0] + x[q][1] * x[q][1] + x[q][2] * x[q][2] + x[q][3] * x[q][3]; }
    ss = wave_sum(ss);
    const float rstd = rsqrtf(ss * (1.f / 1024.f) + EPSN);
#pragma unroll
    for (int q = 0; q < 4; ++q) {
      const int col = (q * 64 + lane) * 4;
      const f32x4 g = *(const f32x4*)(p.norm_g + l * 1024 + col), sc = *(const f32x4*)(mod + 1024 + col), sh = *(const f32x4*)(mod + col);
      f32x4 h;
#pragma unroll
      for (int e = 0; e < 4; ++e) h[e] = x[q][e] * rstd * g[e] * (1.f + sc[e]) + sh[e];
      *(u32x2*)(H + (size_t)row * 1024 + col) = pk4(h);
      *(unsigned*)(p.ws + O_H8 + (size_t)row * 1024 + col) = pk4f8(h[0], h[1], h[2], h[3]);
    }
  }
}
__device__ __forceinline__ void final_item(const Params& p, int item) {
  const int tid = tidx(), lane = tid & 63, wid = tid >> 6;
#pragma unroll 3
  for (int i = 0; i < 6; ++i) {
    const int row = item * 24 + wid * 6 + i;
    float* src = p.out + (size_t)row * 1024;
    f32x4 x[4]; float ss = 0.f;
#pragma unroll
    for (int q = 0; q < 4; ++q) { x[q] = *(const f32x4*)(src + (q * 64 + lane) * 4); ss += x[q][0] * x[q][0] + x[q][1] * x[q][1] + x[q][2] * x[q][2] + x[q][3] * x[q][3]; }
    ss = wave_sum(ss);
    const float rstd = rsqrtf(ss * (1.f / 1024.f) + EPSN);
#pragma unroll
    for (int q = 0; q < 4; ++q) {
      const int col = (q * 64 + lane) * 4;
      const f32x4 g = *(const f32x4*)(p.final_g + col);
      f32x4 y;
#pragma unroll
      for (int e = 0; e < 4; ++e) y[e] = x[q][e] * rstd * g[e];
      *(f32x4*)(src + col) = y;
    }
  }
}

__device__ __forceinline__ void s2_tile(const Params& p, int l, int tile, char* lds) {
  const int tid = tidx(), lane = tid & 63, wid = tid >> 6, wm = wid >> 1, wn = wid & 1, fr = lane & 15, fq = lane >> 4;
  const int m = (tile / 480) * 16 + (tile % 16), nt = (tile % 480) / 16, m0 = m * 128, n0 = nt * 128;
  char* ws = wsp(p.ws);
  const bf16_t* A = (const bf16_t*)(ws + O_H) + (size_t)m0 * 1024;
  const bf16_t* B = (const bf16_t*)(ws + O_WIN) + ((size_t)l * 6912 + n0) * 1024;
  f32x4 acc[4][4];
  zero_acc(acc);
  if (nt >= 4 && nt < 8) {
    gemm_core<false>(A, 1024, B, 1024, 1024, acc, lds);
    bf16_t* RVT = (bf16_t*)(ws + O_RVT);
#pragma unroll
    for (int i = 0; i < 4; ++i) {
      const int tok = m0 + wm * 64 + i * 16 + fq * 4;
      size_t base; int T, b, t;
      if (tok < NPR) { b = tok >> 8; t = tok & 255; T = 256; base = 0; } else { const int s = tok - NPR; b = s >> 10; t = s & 1023; T = 1024; base = (size_t)NPR * 512; }
#pragma unroll
      for (int j = 0; j < 4; ++j) {
        const int c = n0 - 512 + wn * 64 + j * 16 + fr, h = c >> 7, vd = c & 127;
        *(u32x2*)(RVT + base + ((size_t)(b * 4 + h) * 128 + vd) * T + t) = pk4(acc[i][j]);
      }
    }
    return;
  }
  gemm_core<true>(A, 1024, B, 1024, 1024, acc, lds);
  bf16_t* dst = nullptr; int ld = 0, c0 = 0, op = 0;
  if (nt < 2) { dst = (bf16_t*)(ws + O_RQ); ld = 256; c0 = 0; }
  else if (nt < 4) { dst = (bf16_t*)(ws + O_RK); ld = 256; c0 = 256; op = 2; }
  else if (nt < 12) { dst = (bf16_t*)(ws + O_RZ); ld = 512; c0 = 1024; op = 1; }
  else if (nt < 15) { dst = (bf16_t*)(ws + O_QLAT); ld = 384; c0 = 1536; }
  else if (nt < 17) { ld = 256; c0 = 1920; op = 3; }
  else if (nt < 21) { dst = (bf16_t*)(ws + O_MZ); ld = 512; c0 = 2176; op = 1; }
  else if (nt < 25) { dst = (bf16_t*)(ws + O_FU); ld = 512; c0 = 2688; }
  else if (nt < 29) { dst = (bf16_t*)(ws + O_FZ); ld = 512; c0 = 3200; op = 1; }
  else { ld = 32; c0 = 3712; op = 4; }
#pragma unroll
  for (int i = 0; i < 4; ++i) {
    const int tok = m0 + wm * 64 + i * 16 + fr;
#pragma unroll
    for (int j = 0; j < 4; ++j) {
      const int col = n0 - c0 + wn * 64 + j * 16 + fq * 4;
      f32x4 v = acc[i][j];
      if (op == 3) { *(f32x4*)((float*)(ws + O_KVLAT) + (size_t)tok * 256 + col) = v; continue; }
      if (op == 4) { if (col < 32) *(f32x4*)((float*)(ws + O_KR) + (size_t)tok * 32 + col) = v; continue; }
      if (op == 1) {
#pragma unroll
        for (int e = 0; e < 4; ++e) v[e] = silu_f(v[e]);
      } else if (op == 2) {
#pragma unroll
        for (int e = 0; e < 4; ++e) v[e] *= 0.125f;
      }
      const u32x2 w = pk4(v);
      *(u32x2*)(dst + (size_t)tok * ld + col) = w;
      if (op == 2 && tok < NPR) {
        bf16_t* RKT = (bf16_t*)(ws + O_RKT);
        const int b = tok >> 8, t = tok & 255, h = col >> 6, dk = col & 63;
        bf16_t* q = RKT + ((size_t)(b * 4 + h) * 64 + dk) * 256 + t;
        q[0] = (bf16_t)(w.x & 0xffffu); q[256] = (bf16_t)(w.x >> 16); q[512] = (bf16_t)(w.y & 0xffffu); q[768] = (bf16_t)(w.y >> 16);
      }
    }
  }
}

template <int MODE>
__device__ __forceinline__ void attn_item(const Params& p, int l, int item, char* lds) {
  constexpr int NKP = MODE == 0 ? 3 : 2;
  constexpr int NVB = MODE == 0 ? 4 : 8;
  constexpr int PV = NVB * 16 * 64;
  constexpr int KOFF = NKP * 4096;
  constexpr int BUF = KOFF + 2 * PV;
  const int tid = tidx(), lane = tid & 63, wid = tid >> 6, fr = lane & 15, fq = lane >> 4;
  char* ws = wsp(p.ws);
  int smp, b, h, qblk, T, Tk, tok0;
  const bf16_t *kbase, *rbase = nullptr, *vbase, *qbase;
  int kstride, qstride;
  if (MODE == 0) {
    if (item < 256) { smp = 1; b = item >> 6; h = (item >> 3) & 7; qblk = item & 7; T = 1024; Tk = 1536; tok0 = NPR + b * 1024 + qblk * 128; }
    else { const int it = item - 256; smp = 0; b = it >> 4; h = (it >> 1) & 7; qblk = it & 1; T = 256; Tk = 256; tok0 = b * 256 + qblk * 128; }
    const int keyrow0 = smp ? NPR + b * 1536 : b * 256;
    kbase = (const bf16_t*)(ws + O_KB) + (size_t)keyrow0 * 512 + h * 64; kstride = 512;
    rbase = (const bf16_t*)(ws + O_KRA) + (size_t)keyrow0 * 32;
    vbase = (const bf16_t*)(ws + O_VT) + (smp ? (size_t)NPR * 512 + (size_t)(b * 8 + h) * 64 * 1536 : (size_t)(b * 8 + h) * 64 * 256);
    qbase = (const bf16_t*)(ws + O_QB) + (size_t)tok0 * 768 + h * 96; qstride = 768;
  } else {
    if (item < 128) { smp = 1; b = item >> 5; h = (item >> 3) & 3; qblk = item & 7; T = 1024; tok0 = NPR + b * 1024 + qblk * 128; }
    else { const int it = item - 128; smp = 0; b = it >> 3; h = (it >> 1) & 3; qblk = it & 1; T = 256; tok0 = b * 256 + qblk * 128; }
    Tk = T;
    const int ktok0 = smp ? NPR + b * 1024 : b * 256;
    kbase = (const bf16_t*)(ws + O_RK) + (size_t)ktok0 * 256 + h * 64; kstride = 256;
    vbase = (const bf16_t*)(ws + O_RVT) + (smp ? (size_t)NPR * 512 + (size_t)(b * 4 + h) * 128 * 1024 : (size_t)(b * 4 + h) * 128 * 256);
    qbase = (const bf16_t*)(ws + O_RQ) + (size_t)tok0 * 256 + h * 64; qstride = 256;
  }
  const int nkt = Tk >> 6;
  bf16x8 qf[2][NKP];
#pragma unroll
  for (int qb = 0; qb < 2; ++qb)
#pragma unroll
    for (int ks = 0; ks < NKP; ++ks) qf[qb][ks] = *(const bf16x8*)(qbase + (size_t)(wid * 32 + qb * 16 + fr) * qstride + ks * 32 + fq * 8);
  f32x4 o[NVB][2];
#pragma unroll
  for (int vb = 0; vb < NVB; ++vb) { o[vb][0] = (f32x4){0.f, 0.f, 0.f, 0.f}; o[vb][1] = (f32x4){0.f, 0.f, 0.f, 0.f}; }
  float lgf = 0.f, lgb = 0.f;
  float mrow[2] = {-INFINITY, -INFINITY}, lrow[2] = {0.f, 0.f};
  const int tq0 = qblk * 128 + wid * 32 + fr;
  if (MODE == 1) {
    const float xf = p.ret_logit[(l * 2 + 0) * 4 + h], xb = p.ret_logit[(l * 2 + 1) * 4 + h];
    lgf = -log1pf(expf(-xf)) * 1.44269504089f; lgb = -log1pf(expf(-xb)) * 1.44269504089f;
    if (smp) {
      const bf16_t* s0 = (const bf16_t*)(ws + O_S0T);
#pragma unroll
      for (int dir = 0; dir < 2; ++dir) {
        const bf16_t* sb = s0 + ((size_t)(((b * 2 + l) * 2 + dir) * 4 + h) * 128) * 64;
        float dec[2];
#pragma unroll
        for (int qb = 0; qb < 2; ++qb) { const int tq = tq0 + qb * 16; dec[qb] = dir == 0 ? ex2((float)(tq + 1) * lgf) : ex2((float)(T - tq) * lgb); }
#pragma unroll
        for (int vb = 0; vb < NVB; ++vb) {
          f32x4 t0 = (f32x4){0.f, 0.f, 0.f, 0.f}, t1 = (f32x4){0.f, 0.f, 0.f, 0.f};
#pragma unroll
          for (int ks = 0; ks < 2; ++ks) {
            const bf16x8 sf = *(const bf16x8*)(sb + (size_t)(vb * 16 + fr) * 64 + ks * 32 + fq * 8);
            t0 = mfma16(sf, qf[0][ks], t0); t1 = mfma16(sf, qf[1][ks], t1);
          }
          o[vb][0] += t0 * dec[0]; o[vb][1] += t1 * dec[1];
        }
      }
    }
  }
  u32x4 vreg[NVB / 2];
  const int uw = __builtin_amdgcn_readfirstlane(wid);
  const int dkey = lane >> 2, dchunk = (lane & 3) ^ swz(dkey);
  auto kdma = [&](int kt, char* buf) {
    const GAS bf16_t* kp = (const GAS bf16_t*)kbase + (size_t)(kt * 64 + uw * 16 + dkey) * kstride + dchunk * 8;
#pragma unroll
    for (int pn = 0; pn < 2; ++pn)
      __builtin_amdgcn_global_load_lds((const GAS unsigned*)(kp + pn * 32), (LAS unsigned*)((LAS char*)buf + pn * 4096 + uw * 1024), 16, 0, 0);
    if (MODE == 0) {
      const GAS bf16_t* rp = (const GAS bf16_t*)rbase + (size_t)(kt * 64 + uw * 16 + dkey) * 32 + dchunk * 8;
      __builtin_amdgcn_global_load_lds((const GAS unsigned*)rp, (LAS unsigned*)((LAS char*)buf + 2 * 4096 + uw * 1024), 16, 0, 0);
    }
  };
  auto gload = [&](int kt) {
#pragma unroll
    for (int i = 0; i < NVB / 2; ++i) { const int idx = tid + 256 * i, vd = idx >> 3, g = idx & 7; vreg[i] = ldg16(vbase + (size_t)vd * Tk + kt * 64 + g * 8); }
  };
  auto lstore = [&](char* buf) {
#pragma unroll
    for (int i = 0; i < NVB / 2; ++i) {
      const int idx = tid + 256 * i, vd = idx >> 3, g = idx & 7, pnl = g >> 2, g4 = g & 3, hi = g4 >> 1, q0 = 2 * (g4 & 1);
      char* base = buf + KOFF + pnl * PV + vd * 64 + hi * 8;
      *(u32x2*)(base + ((q0 ^ swz(vd)) << 4)) = (u32x2){vreg[i].x, vreg[i].y};
      *(u32x2*)(base + (((q0 + 1) ^ swz(vd)) << 4)) = (u32x2){vreg[i].z, vreg[i].w};
    }
  };
  __syncthreads();
  kdma(0, lds); gload(0); lstore(lds);
  asm volatile("s_waitcnt vmcnt(0)" ::: "memory");
  __syncthreads();
  const int foff = fr * 64 + ((fq ^ swz(fr)) << 4);
  for (int kt = 0; kt < nkt; ++kt) {
    char* cur = lds + (kt & 1) * BUF;
    const bool more = (kt + 1) < nkt;
    if (more) { kdma(kt + 1, lds + ((kt + 1) & 1) * BUF); gload(kt + 1); }
    __builtin_amdgcn_sched_barrier(0);
    f32x4 s[4][2];
#pragma unroll
    for (int kb = 0; kb < 4; ++kb) {
      s[kb][0] = (f32x4){0.f, 0.f, 0.f, 0.f}; s[kb][1] = (f32x4){0.f, 0.f, 0.f, 0.f};
#pragma unroll
      for (int ks = 0; ks < NKP; ++ks) {
        const bf16x8 kf = *(const bf16x8*)(cur + ks * 4096 + kb * 1024 + foff);
        s[kb][0] = mfma16(kf, qf[0][ks], s[kb][0]); s[kb][1] = mfma16(kf, qf[1][ks], s[kb][1]);
      }
    }
    bf16x8 pf[2][2];
#pragma unroll
    for (int qb = 0; qb < 2; ++qb) {
      if (MODE == 0) {
        float mx = s[0][qb][0];
#pragma unroll
        for (int kb = 0; kb < 4; ++kb)
#pragma unroll
          for (int r = 0; r < 4; ++r) mx = fmaxf(mx, s[kb][qb][r]);
        mx = fmaxf(mx, __shfl_xor(mx, 16)); mx = fmaxf(mx, __shfl_xor(mx, 32));
        const float mn = fmaxf(mrow[qb], mx), alpha = ex2(mrow[qb] - mn);
        mrow[qb] = mn;
        float ls = 0.f;
#pragma unroll
        for (int kb = 0; kb < 4; ++kb)
#pragma unroll
          for (int r = 0; r < 4; ++r) { const float e = ex2(s[kb][qb][r] - mn); s[kb][qb][r] = e; ls += e; }
        lrow[qb] = lrow[qb] * alpha + ls;
#pragma unroll
        for (int vb = 0; vb < NVB; ++vb) o[vb][qb] *= alpha;
      } else {
        const int tq = tq0 + qb * 16;
#pragma unroll
        for (int kb = 0; kb < 4; ++kb)
#pragma unroll
          for (int r = 0; r < 4; ++r) {
            const int d = tq - (kt * 64 + kb * 16 + fq * 4 + r);
            const float dec = d > 0 ? ex2((float)d * lgf) : (d < 0 ? ex2((float)(-d) * lgb) : 2.f);
            s[kb][qb][r] *= dec;
          }
      }
#pragma unroll
      for (int g = 0; g < 2; ++g) {
        u32x4 w; w.x = pk2(s[2 * g][qb][0], s[2 * g][qb][1]); w.y = pk2(s[2 * g][qb][2], s[2 * g][qb][3]);
        w.z = pk2(s[2 * g + 1][qb][0], s[2 * g + 1][qb][1]); w.w = pk2(s[2 * g + 1][qb][2], s[2 * g + 1][qb][3]);
        pf[qb][g] = as_bf8(w);
      }
    }
#pragma unroll
    for (int vb = 0; vb < NVB; ++vb)
#pragma unroll
      for (int g = 0; g < 2; ++g) {
        const bf16x8 vf = *(const bf16x8*)(cur + KOFF + g * PV + vb * 1024 + foff);
        o[vb][0] = mfma16(vf, pf[0][g], o[vb][0]); o[vb][1] = mfma16(vf, pf[1][g], o[vb][1]);
      }
    __builtin_amdgcn_sched_barrier(0);
    if (more) lstore(lds + ((kt + 1) & 1) * BUF);
    asm volatile("s_waitcnt vmcnt(0)" ::: "memory");
    __syncthreads();
  }
  bf16_t* G = (bf16_t*)(ws + (MODE == 0 ? O_MZ : O_RZ));
#pragma unroll
  for (int qb = 0; qb < 2; ++qb) {
    const int tok = tok0 + wid * 32 + qb * 16 + fr;
    float mul, sub;
    if (MODE == 0) {
      float lt = lrow[qb]; lt += __shfl_xor(lt, 16); lt += __shfl_xor(lt, 32);
      mul = 1.f / lt; sub = 0.f;
    } else {
      float sm = 0.f;
#pragma unroll
      for (int vb = 0; vb < NVB; ++vb) sm += (o[vb][qb][0] + o[vb][qb][1]) + (o[vb][qb][2] + o[vb][qb][3]);
      sm += __shfl_xor(sm, 16); sm += __shfl_xor(sm, 32);
      const float mu = sm * (1.f / 128.f);
      float vs = 0.f;
#pragma unroll
      for (int vb = 0; vb < NVB; ++vb)
#pragma unroll
        for (int r = 0; r < 4; ++r) { const float dd = o[vb][qb][r] - mu; vs += dd * dd; }
      vs += __shfl_xor(vs, 16); vs += __shfl_xor(vs, 32);
      mul = rsqrtf(vs * (1.f / 128.f) + EPSN); sub = mu;
    }
#pragma unroll
    for (int vb = 0; vb < NVB; ++vb) {
      bf16_t* gp = G + (size_t)tok * 512 + h * (NVB * 16) + vb * 16 + fq * 4;
      const u32x2 gz = *(const u32x2*)gp;
      f32x4 y;
      y[0] = (o[vb][qb][0] - sub) * mul * bflo(gz.x); y[1] = (o[vb][qb][1] - sub) * mul * bfhi(gz.x);
      y[2] = (o[vb][qb][2] - sub) * mul * bflo(gz.y); y[3] = (o[vb][qb][3] - sub) * mul * bfhi(gz.y);
      *(unsigned*)(ws + O_BR8 + (size_t)(MODE == 0 ? 1 : 0) * NTOK * 512 + (size_t)tok * 512 + h * (NVB * 16) + vb * 16 + fq * 4) = pk4f8(y[0] * 8.f, y[1] * 8.f, y[2] * 8.f, y[3] * 8.f);
    }
  }
}

__device__ __forceinline__ bf16x8 scale8(u32x4 raw, const float (&d)[8]) {
  u32x4 w;
  w.x = pk2(bflo(raw.x) * d[0], bfhi(raw.x) * d[1]); w.y = pk2(bflo(raw.y) * d[2], bfhi(raw.y) * d[3]);
  w.z = pk2(bflo(raw.z) * d[4], bfhi(raw.z) * d[5]); w.w = pk2(bflo(raw.w) * d[6], bfhi(raw.w) * d[7]);
  return as_bf8(w);
}
__device__ __forceinline__ void state_item(const Params& p, int l, int item) {
  const int tid = tidx(), lane = tid & 63, wid = tid >> 6, fr = lane & 15, fq = lane >> 4;
  const int b = item >> 2, h = item & 3;
  const bf16_t* RVT = (const bf16_t*)(p.ws + O_RVT) + (size_t)(b * 4 + h) * 128 * 256;
  const bf16_t* RKT = (const bf16_t*)(p.ws + O_RKT) + (size_t)(b * 4 + h) * 64 * 256;
  const float xf = p.ret_logit[(l * 2 + 0) * 4 + h], xb = p.ret_logit[(l * 2 + 1) * 4 + h];
  const float lgf = -log1pf(expf(-xf)) * 1.44269504089f, lgb = -log1pf(expf(-xb)) * 1.44269504089f;
  f32x4 acc[2][2][4];
#pragma unroll
  for (int d = 0; d < 2; ++d)
#pragma unroll
    for (int v = 0; v < 2; ++v)
#pragma unroll
      for (int k = 0; k < 4; ++k) acc[d][v][k] = (f32x4){0.f, 0.f, 0.f, 0.f};
#pragma unroll 2
  for (int ks = 0; ks < 8; ++ks) {
    const int j0 = ks * 32 + fq * 8;
    float df[8], db[8];
#pragma unroll
    for (int e = 0; e < 8; ++e) { df[e] = exp2f((float)(255 - j0 - e) * lgf); db[e] = exp2f((float)(j0 + e) * lgb); }
    bf16x8 af[2];
#pragma unroll
    for (int v = 0; v < 2; ++v) af[v] = *(const bf16x8*)(RVT + (size_t)((wid * 2 + v) * 16 + fr) * 256 + j0);
#pragma unroll
    for (int k = 0; k < 4; ++k) {
      const u32x4 raw = *(const u32x4*)(RKT + (size_t)(k * 16 + fr) * 256 + j0);
      const bf16x8 kf = scale8(raw, df), kb = scale8(raw, db);
#pragma unroll
      for (int v = 0; v < 2; ++v) { acc[0][v][k] = mfma16(af[v], kf, acc[0][v][k]); acc[1][v][k] = mfma16(af[v], kb, acc[1][v][k]); }
    }
  }
  float* O = p.out + OUT_RET;
#pragma unroll
  for (int d = 0; d < 2; ++d)
#pragma unroll
    for (int v = 0; v < 2; ++v)
#pragma unroll
      for (int k = 0; k < 4; ++k) {
        const int dk = k * 16 + fr, vd = (wid * 2 + v) * 16 + fq * 4;
        *(f32x4*)(O + ((size_t)((((b * 2 + l) * 2 + d) * 4 + h) * 64 + dk)) * 128 + vd) = acc[d][v][k];
      }
}

__device__ __forceinline__ void keyprep_item(const Params& p, int l, int item) {
  const int tid = tidx(), lane = tid & 63, wid = tid >> 6;
  char* ws = wsp(p.ws);
  bf16_t* CKVA = (bf16_t*)(ws + O_CKVA);
  bf16_t* KRA = (bf16_t*)(ws + O_KRA);
#pragma unroll
  for (int i = 0; i < 4; ++i) {
    const int R = item * 16 + wid * 4 + i;
    int smp = 0, b, t = 0, tok = 0, ctx = 0, pp = 0;
    if (R < NPR) { tok = R; b = R >> 8; t = R & 255; }
    else { smp = 1; const int s = R - NPR; b = s / 1536; pp = s - b * 1536; if (pp < 512) ctx = 1; else { t = pp - 512; tok = NPR + b * 1024 + t; } }
    if (ctx) {
      const f32x4 v = *(const f32x4*)(p.cache_ckv + ((size_t)((b * 2 + l) * 512 + pp)) * 256 + lane * 4);
      *(u32x2*)(CKVA + (size_t)R * 256 + lane * 4) = pk4(v);
      if (lane < 32) KRA[(size_t)R * 32 + lane] = tobf(p.cache_krope[((size_t)((b * 2 + l) * 512 + pp)) * 32 + lane]);
      continue;
    }
    const f32x4 v = *(const f32x4*)((const float*)(ws + O_KVLAT) + (size_t)tok * 256 + lane * 4);
    float ss = v[0] * v[0] + v[1] * v[1] + v[2] * v[2] + v[3] * v[3];
    ss = wave_sum(ss);
    const float rstd = rsqrtf(ss * (1.f / 256.f) + EPSN);
    const f32x4 g = *(const f32x4*)(p.kv_norm_g + l * 256 + lane * 4);
    f32x4 y;
#pragma unroll
    for (int e = 0; e < 4; ++e) y[e] = v[e] * rstd * g[e];
    *(u32x2*)(CKVA + (size_t)R * 256 + lane * 4) = pk4(y);
    if (!smp) *(f32x4*)(p.out + OUT_CKV + ((size_t)((b * 2 + l) * 256 + t)) * 256 + lane * 4) = y;
    const int d = lane & 31;
    const float x = ((const float*)(ws + O_KR))[(size_t)tok * 32 + d];
    float yk = x;
    if (smp) {
      const float pr = __shfl_xor(x, 8);
      const int hd = d >> 4, i16 = d & 15, f = i16 & 7;
      const int pos = hd ? (t & 63) : (t >> 6);
      const float* rt = (const float*)(ws + O_ROPE) + (pos * 8 + f) * 2;
      const float cs = rt[0], sn = rt[1];
      yk = i16 < 8 ? x * cs - pr * sn : pr * sn + x * cs;
    } else if (lane < 32) {
      p.out[OUT_KR + ((size_t)((b * 2 + l) * 256 + t)) * 32 + d] = x;
    }
    if (lane < 32) KRA[(size_t)R * 32 + d] = tobf(yk);
  }
}

__device__ __forceinline__ void f1_tile(const Params& p, int tile, char* lds) {
  const int tid = tidx(), lane = tid & 63, wid = tid >> 6, wm = wid >> 1, wn = wid & 1, fr = lane & 15, fq = lane >> 4;
  const int m = tile >> 3, g = (tile >> 1) & 3, nh = tile & 1, m0 = m * 128;
  char* ws = wsp(p.ws);
  f32x4 acc[4][4];
  zero_acc(acc);
  gemm_core<false>((const bf16_t*)(ws + O_FU) + (size_t)m0 * 512 + g * 128, 512, (const bf16_t*)(ws + O_CS) + (size_t)nh * 128 * 128, 128, 128, acc, lds);
  unsigned char* UT = (unsigned char*)(ws + O_UT);
#pragma unroll
  for (int i = 0; i < 4; ++i) {
    const int tok = m0 + wm * 64 + i * 16 + fq * 4;
    size_t base; int T, b, t;
    if (tok < NPR) { b = tok >> 8; t = tok & 255; T = 256; base = 0; } else { const int s = tok - NPR; b = s >> 10; t = s & 1023; T = 1024; base = (size_t)NPR * 1024; }
#pragma unroll
    for (int j = 0; j < 4; ++j) {
      const int k2 = wn * 64 + j * 16 + fr;
      *(unsigned*)(UT + base + ((size_t)(b * 4 + g) * 128 + k2) * (2 * T) + nh * T + t) = pk4f8(acc[i][j][0] * 4.f, acc[i][j][1] * 4.f, acc[i][j][2] * 4.f, acc[i][j][3] * 4.f);
    }
  }
}

__device__ __forceinline__ void qup_tile(const Params& p, int l, int tile, char* lds) {
  const int tid = tidx(), lane = tid & 63, wid = tid >> 6, wm = wid >> 1, wn = wid & 1, fr = lane & 15, fq = lane >> 4;
  const int m = tile % 96, nt = tile / 96, m0 = m * 128, n0 = nt * 128;
  char* ws = wsp(p.ws);
  const bf16_t* QL = (const bf16_t*)(ws + O_QLAT) + (size_t)m0 * 384;
  float rsv4[4];
  {
    float* rs = (float*)lds;
    __syncthreads();
#pragma unroll 1
    for (int r0 = 0; r0 < 32; r0 += 4) {
      float ss[4];
#pragma unroll
      for (int u = 0; u < 4; ++u) {
        u32x4 w = (u32x4){0u, 0u, 0u, 0u};
        if (lane < 48) w = ldg16(QL + (size_t)(wid * 32 + r0 + u) * 384 + lane * 8);
        ss[u] = bflo(w.x) * bflo(w.x) + bfhi(w.x) * bfhi(w.x) + bflo(w.y) * bflo(w.y) + bfhi(w.y) * bfhi(w.y) + bflo(w.z) * bflo(w.z) + bfhi(w.z) * bfhi(w.z) + bflo(w.w) * bflo(w.w) + bfhi(w.w) * bfhi(w.w);
      }
#pragma unroll
      for (int u = 0; u < 4; ++u) { const float t = wave_sum(ss[u]); if (lane == 0) rs[wid * 32 + r0 + u] = rsqrtf(t * (1.f / 384.f) + EPSN); }
    }
    __syncthreads();
#pragma unroll
    for (int i = 0; i < 4; ++i) rsv4[i] = rs[wm * 64 + i * 16 + fr];
    __syncthreads();
  }
  f32x4 acc[4][4];
  zero_acc(acc);
  gemm_core<true>(QL, 384, (const bf16_t*)(ws + O_WQ) + ((size_t)l * 768 + n0) * 384, 384, 384, acc, lds);
  bf16_t* QB = (bf16_t*)(ws + O_QB);
  const float qscale = 0.10206207261596577f * 1.44269504089f;
#pragma unroll
  for (int i = 0; i < 4; ++i) {
    const int rl = wm * 64 + i * 16 + fr, tok = m0 + rl;
    const float sc = rsv4[i] * qscale;
    const int smp = tok >= NPR, t = (tok - NPR) & 1023;
#pragma unroll
    for (int j = 0; j < 4; ++j) {
      const int cb = n0 + wn * 64 + j * 16, within = cb % 96;
      f32x4 v = acc[i][j] * sc;
      if (within >= 64) {
        f32x4 pr;
#pragma unroll
        for (int e = 0; e < 4; ++e) pr[e] = __shfl_xor(v[e], 32);
        if (smp) {
          const int pos = within >= 80 ? (t & 63) : (t >> 6);
          const float* rt = (const float*)(ws + O_ROPE) + (pos * 8 + (fq & 1) * 4) * 2;
          const f32x4 c01 = *(const f32x4*)rt, c23 = *(const f32x4*)(rt + 4);
          const float cs4[4] = {c01[0], c01[2], c23[0], c23[2]}, sn4[4] = {c01[1], c01[3], c23[1], c23[3]};
#pragma unroll
          for (int e = 0; e < 4; ++e) v[e] = fq < 2 ? v[e] * cs4[e] - pr[e] * sn4[e] : pr[e] * sn4[e] + v[e] * cs4[e];
        }
      }
      *(u32x2*)(QB + (size_t)tok * 768 + cb + fq * 4) = pk4(v);
    }
  }
}

__device__ __forceinline__ void kvup_tile(const Params& p, int l, int tile, char* lds) {
  const int tid = tidx(), lane = tid & 63, wid = tid >> 6, wm = wid >> 1, wn = wid & 1, fr = lane & 15, fq = lane >> 4;
  const int m = tile % 112, nt = tile / 112, m0 = m * 128, n0 = nt * 128;
  char* ws = wsp(p.ws);
  const bf16_t* A = (const bf16_t*)(ws + O_CKVA) + (size_t)m0 * 256;
  const bf16_t* B = (const bf16_t*)(ws + O_WKV) + ((size_t)l * 1024 + n0) * 256;
  f32x4 acc[4][4];
  zero_acc(acc);
  if (nt < 4) {
    gemm_core<true>(A, 256, B, 256, 256, acc, lds);
    bf16_t* KB = (bf16_t*)(ws + O_KB);
#pragma unroll
    for (int i = 0; i < 4; ++i) {
      const int R = m0 + wm * 64 + i * 16 + fr;
#pragma unroll
      for (int j = 0; j < 4; ++j) *(u32x2*)(KB + (size_t)R * 512 + n0 + wn * 64 + j * 16 + fq * 4) = pk4(acc[i][j]);
    }
  } else {
    gemm_core<false>(A, 256, B, 256, 256, acc, lds);
    bf16_t* VT = (bf16_t*)(ws + O_VT);
#pragma unroll
    for (int i = 0; i < 4; ++i) {
      const int R = m0 + wm * 64 + i * 16 + fq * 4;
      size_t base; int Tk, b, k;
      if (R < NPR) { b = R >> 8; k = R & 255; Tk = 256; base = 0; } else { const int s = R - NPR; b = s / 1536; k = s - b * 1536; Tk = 1536; base = (size_t)NPR * 512; }
#pragma unroll
      for (int j = 0; j < 4; ++j) {
        const int c = n0 - 512 + wn * 64 + j * 16 + fr, h = c >> 6, vd = c & 63;
        *(u32x2*)(VT + base + ((size_t)(b * 8 + h) * 64 + vd) * Tk + k) = pk4(acc[i][j]);
      }
    }
  }
}

template <int NJ>
__device__ __forceinline__ void f2_tile(const Params& p, int tile, char* lds) {
  const int tid = tidx(), lane = tid & 63, wid = tid >> 6, wm = wid >> 1, wn = wid & 1, fr = lane & 15, fq = lane >> 4;
  char* ws = wsp(p.ws);
  const char *A, *B; int K, tokb, g, nh = 0; float scale;
  if (NJ == 2) {
    const int b = tile >> 6, mt = (tile >> 1) & 7; g = (tile >> 4) & 3; nh = tile & 1;
    A = (const char*)(ws + O_D1024) + (size_t)mt * 128 * 2048; K = 2048;
    B = (const char*)(ws + O_UT) + (size_t)NPR * 1024 + ((size_t)(b * 4 + g) * 128 + nh * 64) * 2048;
    tokb = NPR + b * 1024 + mt * 128; scale = 0.00276213586400995f * (1.f / 256.f);
  } else {
    const int b = tile >> 3, mt = tile & 1; g = (tile >> 1) & 3;
    A = (const char*)(ws + O_D256) + (size_t)mt * 128 * 512; K = 512;
    B = (const char*)(ws + O_UT) + (size_t)(b * 4 + g) * 128 * 512;
    tokb = b * 256 + mt * 128; scale = 0.0055242717280199f * (1.f / 256.f);
  }
  f32x4 acc[4][NJ];
#pragma unroll
  for (int i = 0; i < 4; ++i)
#pragma unroll
    for (int j = 0; j < NJ; ++j) acc[i][j] = (f32x4){0.f, 0.f, 0.f, 0.f};
  { int par = 0; gemm_bytes<true, NJ, 1, true>(A, K, B, K, K, acc, lds, par, false, nullptr, 0, nullptr, 0); }
  bf16_t* FZ = (bf16_t*)(ws + O_FZ);
#pragma unroll
  for (int i = 0; i < 4; ++i) {
    const int tok = tokb + wm * 64 + i * 16 + fr;
#pragma unroll
    for (int j = 0; j < NJ; ++j) {
      bf16_t* gp = FZ + (size_t)tok * 512 + g * 128 + nh * 64 + wn * (NJ * 16) + j * 16 + fq * 4;
      const u32x2 gz = *(const u32x2*)gp;
      f32x4 y;
      y[0] = acc[i][j][0] * scale * bflo(gz.x); y[1] = acc[i][j][1] * scale * bfhi(gz.x);
      y[2] = acc[i][j][2] * scale * bflo(gz.y); y[3] = acc[i][j][3] * scale * bfhi(gz.y);
      *(unsigned*)(ws + O_BR8 + (size_t)2 * NTOK * 512 + (size_t)tok * 512 + g * 128 + nh * 64 + wn * (NJ * 16) + j * 16 + fq * 4) = pk4f8(y[0] * 8.f, y[1] * 8.f, y[2] * 8.f, y[3] * 8.f);
    }
  }
}

template <int NJ>
__device__ __forceinline__ void s6_tile(const Params& p, int l, int tile, int ntile, char* lds, int& par, bool& primed) {
  const int tid = tidx(), lane = tid & 63, wid = tid >> 6, wm = wid >> 1, wn = wid & 1, fr = lane & 15, fq = lane >> 4;
  constexpr int NT = 32 / NJ, BN = NJ * 32;
  const int m = (tile / (32 * NT)) * 32 + (tile % 32), nt = (tile % (32 * NT)) / 32, m0 = m * 128, n0 = nt * BN;
  char* ws = wsp(p.ws);
  const char* H8 = (const char*)(ws + O_H8);
  const char* W8 = (const char*)(ws + O_WG8) + (size_t)l * 3072 * 1024;
  const char* Wb = (const char*)(ws + O_WBR) + (size_t)(l * 3) * 1024 * 512;
  f32x4 tot[4][NJ], acc[4][NJ];
  unsigned sg[4][NJ];
#pragma unroll
  for (int i = 0; i < 4; ++i)
#pragma unroll
    for (int j = 0; j < NJ; ++j) tot[i][j] = (f32x4){0.f, 0.f, 0.f, 0.f};
#pragma unroll 1
  for (int nb = 0; nb < 3; ++nb) {
    u32x2 totp[4][NJ];
#pragma unroll
    for (int i = 0; i < 4; ++i)
#pragma unroll
      for (int j = 0; j < NJ; ++j) { totp[i][j] = pk4(tot[i][j]); acc[i][j] = (f32x4){0.f, 0.f, 0.f, 0.f}; }
    const char* brA = (const char*)(ws + O_BR8) + ((size_t)nb * NTOK + m0) * 512;
    const char* brB = Wb + ((size_t)nb * 1024 + n0) * 512;
    gemm_bytes<true, NJ, 2, true>(H8 + (size_t)m0 * 1024, 1024, W8 + ((size_t)nb * 1024 + n0) * 1024, 1024, 1024, acc, lds, par, primed, brA, 512, brB, 512);
#pragma unroll
    for (int i = 0; i < 4; ++i)
#pragma unroll
      for (int j = 0; j < NJ; ++j) {
        unsigned q = 0;
#pragma unroll
        for (int e = 0; e < 4; ++e) {
          const unsigned qe = (unsigned)fmaxf(sigm_f(acc[i][j][e] * 0.03125f) * 255.f + 0.5f, 1.f);
          q |= qe << (8 * e);
          tot[i][j][e] = (e == 0 ? bflo(totp[i][j].x) : e == 1 ? bfhi(totp[i][j].x) : e == 2 ? bflo(totp[i][j].y) : bfhi(totp[i][j].y)) * __builtin_amdgcn_rcpf((float)qe * (1.f / 255.f));
        }
        sg[i][j] = q;
      }
    const char *nA = nullptr, *nB = nullptr;
    if (nb < 2) { nA = H8 + (size_t)m0 * 1024; nB = W8 + ((size_t)(nb + 1) * 1024 + n0) * 1024; }
    else if (ntile >= 0) { nA = H8 + (size_t)(((ntile / (32 * NT)) * 32 + (ntile % 32)) * 128) * 1024; nB = W8 + (size_t)(((ntile % (32 * NT)) / 32) * BN) * 1024; }
    gemm_bytes<true, NJ, 2, true>(brA, 512, brB, 512, 512, tot, lds, par, true, nA, 1024, nB, 1024);
    primed = nA != nullptr;
#pragma unroll
    for (int i = 0; i < 4; ++i)
#pragma unroll
      for (int j = 0; j < NJ; ++j) {
        tot[i][j][0] *= (float)(sg[i][j] & 0xffu) * (1.f / 255.f); tot[i][j][1] *= (float)((sg[i][j] >> 8) & 0xffu) * (1.f / 255.f);
        tot[i][j][2] *= (float)((sg[i][j] >> 16) & 0xffu) * (1.f / 255.f); tot[i][j][3] *= (float)(sg[i][j] >> 24) * (1.f / 255.f);
      }
  }
  unsigned char* MG = (unsigned char*)(ws + O_UT);
#pragma unroll
  for (int i = 0; i < 4; ++i) {
    const int tok = m0 + wm * 64 + i * 16 + fr;
#pragma unroll
    for (int j = 0; j < NJ; ++j) *(unsigned*)(MG + (size_t)tok * 1024 + n0 + wn * (NJ * 16) + j * 16 + fq * 4) = pk4f8(tot[i][j][0] * (1.f / 256.f), tot[i][j][1] * (1.f / 256.f), tot[i][j][2] * (1.f / 256.f), tot[i][j][3] * (1.f / 256.f));
  }
}

__device__ __forceinline__ void s7_tile(const Params& p, int l, int tile, const float* xp, const float* xs, char* lds) {
  const int tid = tidx(), lane = tid & 63, wid = tid >> 6, wm = wid >> 1, wn = wid & 1, fr = lane & 15, fq = lane >> 4;
  const int m = (tile / 512) * 32 + (tile % 32), nt = (tile % 512) / 32, m0 = m * 128, n0 = nt * 64;
  char* ws = wsp(p.ws);
  f32x4 acc[4][2];
#pragma unroll
  for (int i = 0; i < 4; ++i) { acc[i][0] = (f32x4){0.f, 0.f, 0.f, 0.f}; acc[i][1] = (f32x4){0.f, 0.f, 0.f, 0.f}; }
  { int par = 0; gemm_bytes<true, 2, 1, true>((const char*)(ws + O_UT) + (size_t)m0 * 1024, 1024, (const char*)(ws + O_WO) + ((size_t)l * 1024 + n0) * 1024, 1024, 1024, acc, lds, par, false, nullptr, 0, nullptr, 0); }
#pragma unroll
  for (int i = 0; i < 4; ++i) {
    const int tok = m0 + wm * 64 + i * 16 + fr;
    const float* src = tok < NPR ? xp + (size_t)tok * 1024 : xs + (size_t)(tok - NPR) * 1024;
    const int v = tok < NPR ? 0 : 1 + ((tok - NPR) >> 10);
    const float* gate = (const float*)(ws + O_MOD) + (l * 5 + v) * 3072 + 2048;
#pragma unroll
    for (int j = 0; j < 2; ++j) {
      const int col = n0 + wn * 32 + j * 16 + fq * 4;
      const f32x4 x = *(const f32x4*)(src + col), gt = *(const f32x4*)(gate + col);
      f32x4 y;
#pragma unroll
      for (int e = 0; e < 4; ++e) y[e] = x[e] + gt[e] * (acc[i][j][e] * 0.03125f);
      *(f32x4*)(p.out + (size_t)tok * 1024 + col) = y;
    }
  }
}

constexpr int NPHASE = 16;
__device__ __forceinline__ int q_issue(unsigned* ctr) {
  int v = 0;
  if (threadIdx.x == 0) v = (int)__hip_atomic_fetch_add(ctr, 1u, __ATOMIC_RELAXED, __HIP_MEMORY_SCOPE_AGENT);
  return v;
}
__device__ __forceinline__ int q_bcast(int v, char* lds) {
  __syncthreads();
  if (threadIdx.x == 0) *(volatile int*)lds = v;
  __syncthreads();
  const int it = *(volatile int*)lds;
  __syncthreads();
  return it;
}
__device__ __forceinline__ void run_phase(const Params& p, int ph, char* lds, unsigned* qctr) {
  const int bid = blockIdx.x, nb = gridDim.x;
  if (ph == 0) { for (int i = bid; i < P0_N; i += nb) phase0_item(p, i, lds); return; }
  if (ph == 15) { for (int i = bid; i < 512; i += nb) final_item(p, i); return; }
  const int l = (ph - 1) / 7, s = (ph - 1) % 7;
  const float* xp = l == 0 ? p.x_prompt : p.out;
  const float* xs = l == 0 ? p.x_sample : p.out + (size_t)NPR * 1024;
  switch (s) {
    case 0: for (int i = bid; i < 512; i += nb) norm_item(p, l, i, xp, xs); break;
    case 1: for (int i = bid; i < 2880; i += nb) s2_tile(p, l, i, lds); break;
    case 2:
      for (int i = q_bcast(q_issue(qctr + ph), lds); i < 2752;) {
        if (i < 128) attn_item<1>(p, l, i, lds);
        else if (i < 1024) keyprep_item(p, l, i - 128);
        else if (i < 1280) attn_item<1>(p, l, 128 + (i - 1024), lds);
        else if (i < 1408) state_item(p, l, i - 1280);
        else if (i < 1984) qup_tile(p, l, i - 1408, lds);
        else f1_tile(p, i - 1984, lds);
        i = q_bcast(q_issue(qctr + ph), lds);
      }
      break;
    case 3:
      for (int i = q_bcast(q_issue(qctr + ph), lds); i < 1408;) {
        if (i < 256) f2_tile<2>(p, i, lds);
        else if (i < 512) f2_tile<4>(p, i - 256, lds);
        else kvup_tile(p, l, i - 512, lds);
        i = q_bcast(q_issue(qctr + ph), lds);
      }
      break;
    case 4:
      for (int i = q_bcast(q_issue(qctr + ph), lds); i < 768;) {
        attn_item<0>(p, l, i, lds);
        i = q_bcast(q_issue(qctr + ph), lds);
      }
      break;
    case 5: { int par = 0; bool primed = false; for (int i = bid; i < 768; i += nb) s6_tile<4>(p, l, i, (i + nb < 768) ? i + nb : -1, lds, par, primed); } break;
    case 6: for (int i = bid; i < 1536; i += nb) s7_tile(p, l, i, xp, xs, lds); break;
  }
}

#define XB_TMO      128
#define XB_XCNT(j)  (256  + 64 * (j))
#define XB_XSUB(j)  (1280 + 64 * (j))
#define XB_XGEN(j)  (2304 + 64 * (j))
#define XB_TOP      3328
#define XB_TOPGEN   3392
#define XCD_BAR_WORDS 3456
#define XB_SPIN_CAP (1u << 18)
__device__ __forceinline__ unsigned xb_ld(unsigned* p)              { return __hip_atomic_load(p, __ATOMIC_RELAXED, __HIP_MEMORY_SCOPE_AGENT); }
__device__ __forceinline__ unsigned xb_add(unsigned* p, unsigned v) { return __hip_atomic_fetch_add(p, v, __ATOMIC_RELAXED, __HIP_MEMORY_SCOPE_AGENT); }
__device__ __forceinline__ unsigned xb_xcc_id() { return (unsigned)__builtin_amdgcn_s_getreg((3 << 11) | 20) & 0xFu; }
#define XB_SPIN(cond, bar) do { unsigned _sp = 0; while (cond) { __builtin_amdgcn_s_sleep(1); \
    if ((++_sp & 255u) == 0u) { if (xb_ld(&(bar)[XB_TMO])) break; if (_sp > XB_SPIN_CAP) { atomicAdd(&(bar)[XB_TMO], 1u); break; } } } } while (0)
__device__ __forceinline__ void xcd_barrier_complete(unsigned* bar, unsigned x, unsigned& nloc, unsigned& nx) {
  const unsigned G = gridDim.x;
  unsigned sum, cnt, mine, sp = 0u;
  for (;;) {
    sum = 0u; cnt = 0u; mine = 0u;
#pragma unroll
    for (unsigned j = 0; j < 16; ++j) { const unsigned c = xb_ld(&bar[XB_XCNT(j)]); sum += c; cnt += (c > 0u) ? 1u : 0u; mine = (j == x) ? c : mine; }
    if (sum == G) break;
    __builtin_amdgcn_s_sleep(1);
    if ((++sp & 255u) == 0u) { if (xb_ld(&bar[XB_TMO])) break; if (sp > XB_SPIN_CAP) { atomicAdd(&bar[XB_TMO], 1u); break; } }
  }
  nloc = mine > 0u ? mine : 1u; nx = cnt > 0u ? cnt : 1u;
}
__device__ __forceinline__ void xcd_barrier(unsigned* bar, unsigned x, unsigned& nloc, unsigned& nx) {
  asm volatile("s_waitcnt vmcnt(0)" ::: "memory");
  __syncthreads();
  if (threadIdx.x == 0) {
    __builtin_amdgcn_s_waitcnt(0);
    if (nloc == 0u) xcd_barrier_complete(bar, x, nloc, nx);
    const unsigned old = xb_add(&bar[XB_XSUB(x)], 1u);
    const unsigned gen = old / nloc;
    if (old + 1u == (gen + 1u) * nloc) {
      __builtin_amdgcn_fence(__ATOMIC_RELEASE, "agent");
      asm volatile("s_waitcnt vmcnt(0)" ::: "memory");
      const unsigned og = xb_add(&bar[XB_TOP], 1u);
      const unsigned tg = og / nx;
      if (og + 1u == (tg + 1u) * nx) xb_add(&bar[XB_TOPGEN], 1u);
      else XB_SPIN(xb_ld(&bar[XB_TOPGEN]) == tg, bar);
      __builtin_amdgcn_fence(__ATOMIC_ACQUIRE, "agent");
      xb_add(&bar[XB_XGEN(x)], 1u);
      asm volatile("s_waitcnt vmcnt(0)" ::: "memory");
    } else {
      XB_SPIN(xb_ld(&bar[XB_XGEN(x)]) == gen, bar);
      __builtin_amdgcn_fence(__ATOMIC_ACQUIRE, "agent");
      asm volatile("s_waitcnt vmcnt(0)" ::: "memory");
    }
  }
  __syncthreads();
}

__global__ void __launch_bounds__(256, 2) mk_fwd(Params p) {
  __shared__ __attribute__((aligned(16))) char lds[LDS_TOTAL];
  cg::grid_group grid = cg::this_grid();
  unsigned* bar = (unsigned*)(p.ws + O_BAR);
  const unsigned xcc = xb_xcc_id();
  if (threadIdx.x == 0) (void)xb_add(&bar[XB_XCNT(xcc)], 1u);
  unsigned nloc = 0u, nx = 0u;
  if (gridDim.x == 0x7fffffffu) grid.sync();
#pragma unroll 1
  for (int ph = 0; ph < NPHASE; ++ph) {
    run_phase(p, ph, lds, bar);
    if (ph + 1 < NPHASE) xcd_barrier(bar, xcc, nloc, nx);
  }
}

extern "C" void kernel_launch(void* const* d_in, const int* in_sizes, int n_in, void* d_out, int out_size, void* d_ws, size_t ws_size,
                              hipStream_t stream) {
  Params p{};
  p.x_prompt = (const float*)d_in[0]; p.x_sample = (const float*)d_in[1]; p.cache_ckv = (const float*)d_in[2]; p.cache_krope = (const float*)d_in[3];
  p.state_ret = (const float*)d_in[4]; p.c = (const float*)d_in[5]; p.c_ctx = (const float*)d_in[6]; p.norm_g = (const float*)d_in[7];
  p.w_mod = (const float*)d_in[8]; p.b_mod = (const float*)d_in[9]; p.w_in = (const float*)d_in[10]; p.ret_logit = (const float*)d_in[11];
  p.q_norm_g = (const float*)d_in[12]; p.w_q_up = (const float*)d_in[13]; p.kv_norm_g = (const float*)d_in[14]; p.w_kv_up = (const float*)d_in[15];
  p.w_branch = (const float*)d_in[16]; p.w_out = (const float*)d_in[17]; p.final_g = (const float*)d_in[18];
  p.out = (float*)d_out; p.ws = (char*)d_ws;
#if ONE_LAUNCH
  static int grid_blocks = 0;
  if (!grid_blocks) {
    int dev = 0, cus = 0, per_cu = 0;
    hipGetDevice(&dev);
    hipDeviceGetAttribute(&cus, hipDeviceAttributeMultiprocessorCount, dev);
    hipOccupancyMaxActiveBlocksPerMultiprocessor(&per_cu, mk_fwd, 256, 0);
    if (per_cu > 2) per_cu = 2;
    grid_blocks = cus * per_cu;
  }
  hipMemsetAsync((char*)d_ws + O_BAR, 0, XCD_BAR_WORDS * 4, stream);
  void* args[] = {&p};
  hipError_t e = hipLaunchCooperativeKernel((void*)mk_fwd, dim3(grid_blocks), dim3(256), args, 0, stream);
  if (e != hipSuccess) fprintf(stderr, "cooperative launch failed: %s (grid %d)\n", hipGetErrorString(e), grid_blocks);
#endif
}
```

```cpp
#include <hip/hip_runtime.h>
#include <hip/hip_cooperative_groups.h>
#include <stdint.h>
#include <stdio.h>
namespace cg = cooperative_groups;

#ifndef ONE_LAUNCH
#define ONE_LAUNCH 1
#endif

typedef unsigned short bf16_t;
typedef short bf16x8 __attribute__((ext_vector_type(8)));
typedef float f32x4 __attribute__((ext_vector_type(4)));
typedef unsigned u32x4 __attribute__((ext_vector_type(4)));
typedef unsigned u32x2 __attribute__((ext_vector_type(2)));

constexpr int NTOK = 12288, NPR = 8192, NKEY = 14336;
constexpr float EPSN = 1e-6f;

constexpr size_t O_WIN   = 0;
constexpr size_t O_WQ    = O_WIN   + (size_t)2 * 6912 * 1024 * 2;
constexpr size_t O_WKV   = O_WQ    + (size_t)2 * 768 * 384 * 2;
constexpr size_t O_WBR   = O_WKV   + (size_t)2 * 1024 * 256 * 2;
constexpr size_t O_WO    = O_WBR   + (size_t)6 * 1024 * 512 * 2;
constexpr size_t O_CS    = O_WO    + (size_t)2 * 1024 * 1024 * 2;
constexpr size_t O_D256  = O_CS    + (size_t)256 * 128 * 2;
constexpr size_t O_D1024 = O_D256  + (size_t)256 * 512 * 2;
constexpr size_t O_S0T   = O_D1024 + (size_t)1024 * 2048 * 2;
constexpr size_t O_MOD   = O_S0T   + (size_t)64 * 128 * 64 * 2;
constexpr size_t O_H     = O_MOD   + (size_t)2 * 5 * 3072 * 4;
constexpr size_t O_BR8   = O_H;
constexpr size_t O_UT    = O_H     + (size_t)NTOK * 1024 * 2;
constexpr size_t O_RQ    = O_UT    + (size_t)NTOK * 1024 * 2;
constexpr size_t O_RK    = O_RQ    + (size_t)NTOK * 256 * 2;
constexpr size_t O_RKT   = O_RK    + (size_t)NTOK * 256 * 2;
constexpr size_t O_RVT   = O_RKT   + (size_t)NPR * 256 * 2;
constexpr size_t O_KVLAT = O_RVT   + (size_t)NTOK * 512 * 2;
constexpr size_t O_KR    = O_KVLAT + (size_t)NTOK * 256 * 4;
constexpr size_t O_R2END = O_KR    + (size_t)NTOK * 32 * 4;
constexpr size_t O_VT    = O_RQ;
static_assert(O_VT + (size_t)NKEY * 512 * 2 <= O_R2END, "alias overflow");
constexpr size_t O_RZ    = O_R2END;
constexpr size_t O_MZ    = O_RZ    + (size_t)NTOK * 512 * 2;
constexpr size_t O_FZ    = O_MZ    + (size_t)NTOK * 512 * 2;
constexpr size_t O_FU    = O_FZ    + (size_t)NTOK * 512 * 2;
constexpr size_t O_QLAT  = O_FU    + (size_t)NTOK * 512 * 2;
constexpr size_t O_CKVA  = O_QLAT  + (size_t)NTOK * 384 * 2;
constexpr size_t O_KB    = O_CKVA  + (size_t)NKEY * 256 * 2;
constexpr size_t O_KRA   = O_KB    + (size_t)NKEY * 512 * 2;
constexpr size_t O_QB    = O_KRA   + (size_t)NKEY * 32 * 2;
constexpr size_t O_H8    = O_QB    + (size_t)NTOK * 768 * 2;
constexpr size_t O_WG8   = O_H8    + (size_t)NTOK * 1024;
constexpr size_t O_END   = O_WG8   + (size_t)2 * 3072 * 1024;
constexpr size_t O_ROPE  = (O_END + 255) & ~(size_t)255;
constexpr size_t O_BAR   = O_ROPE + 4096;
static_assert(O_BAR + 16384 <= (size_t)256 * 1024 * 1024, "workspace too large");

constexpr size_t OUT_CKV = (size_t)NTOK * 1024;
constexpr size_t OUT_KR  = OUT_CKV + (size_t)32 * 2 * 256 * 256;
constexpr size_t OUT_RET = OUT_KR + (size_t)32 * 2 * 256 * 32;

struct Params {
  const float *x_prompt, *x_sample, *cache_ckv, *cache_krope, *state_ret, *c, *c_ctx, *norm_g, *w_mod, *b_mod,
      *w_in, *ret_logit, *q_norm_g, *w_q_up, *kv_norm_g, *w_kv_up, *w_branch, *w_out, *final_g;
  float* out;
  char* ws;
};

constexpr int PANEL = 128 * 64;
constexpr int ABYTES = 2 * PANEL;
constexpr int STAGE = 2 * ABYTES;
constexpr int LDS_GEMM = 2 * STAGE;
constexpr int LDS_TOTAL = LDS_GEMM;
static_assert(LDS_TOTAL <= 65536, "static LDS");

typedef float f32x2 __attribute__((ext_vector_type(2)));
typedef __bf16 bf16x2v __attribute__((ext_vector_type(2)));
__device__ __forceinline__ unsigned pk2(float lo, float hi) { const f32x2 v = {lo, hi}; return __builtin_bit_cast(unsigned, __builtin_convertvector(v, bf16x2v)); }
__device__ __forceinline__ bf16_t tobf(float x) { return (bf16_t)(pk2(x, 0.f) & 0xffffu); }
typedef int v8i __attribute__((ext_vector_type(8)));
__device__ __forceinline__ float sat8(float x) { return __builtin_amdgcn_fmed3f(x, -448.f, 448.f); }
__device__ __forceinline__ unsigned pk4f8(float a, float b, float c, float d) { unsigned w = 0; a = sat8(a); b = sat8(b); c = sat8(c); d = sat8(d); w = __builtin_amdgcn_cvt_pk_fp8_f32(a, b, w, false); w = __builtin_amdgcn_cvt_pk_fp8_f32(c, d, w, true); return w; }
__device__ __forceinline__ float bflo(unsigned u) { return __uint_as_float(u << 16); }
__device__ __forceinline__ float bfhi(unsigned u) { return __uint_as_float(u & 0xffff0000u); }
__device__ __forceinline__ float ex2(float x) { return __builtin_amdgcn_exp2f(x); }
__device__ __forceinline__ float silu_f(float x) { return x / (1.f + __expf(-x)); }
__device__ __forceinline__ float sigm_f(float x) { return 1.f / (1.f + __expf(-x)); }
__device__ __forceinline__ u32x2 pk4(f32x4 v) { u32x2 r; r.x = pk2(v[0], v[1]); r.y = pk2(v[2], v[3]); return r; }
#define GAS __attribute__((address_space(1)))
#define LAS __attribute__((address_space(3)))
__device__ __forceinline__ u32x4 ldg16(const void* p) { return *(const GAS u32x4*)p; }
__device__ __forceinline__ int tidx() { int t = threadIdx.x; asm volatile("" : "+v"(t)); return t; }
__device__ __forceinline__ char* wsp(const char* w) { unsigned long long v = (unsigned long long)w; asm volatile("" : "+s"(v)); return (char*)v; }
__device__ __forceinline__ int swz(int r) { return (0 - ((r >> 2) & 3)) & 3; }
__device__ __forceinline__ float wave_sum(float v) {
#pragma unroll
  for (int o = 1; o < 64; o <<= 1) v += __shfl_xor(v, o);
  return v;
}
__device__ __forceinline__ f32x4 mfma16(bf16x8 a, bf16x8 b, f32x4 c) { return __builtin_amdgcn_mfma_f32_16x16x32_bf16(a, b, c, 0, 0, 0); }
__device__ __forceinline__ bf16x8 as_bf8(u32x4 v) { return __builtin_bit_cast(bf16x8, v); }

__device__ __forceinline__ void zero_acc(f32x4 (&acc)[4][4]) {
#pragma unroll
  for (int i = 0; i < 4; ++i)
#pragma unroll
    for (int j = 0; j < 4; ++j) acc[i][j] = (f32x4){0.f, 0.f, 0.f, 0.f};
}

template <bool SWAP, int NJ, int PIPE, bool F8>
__device__ __forceinline__ void gemm_bytes(const char* __restrict__ A, int lda, const char* __restrict__ B, int ldb, int Kb,
                                           f32x4 (&acc)[4][NJ], char* lds, int& par, bool primed,
                                           const char* nA, int nlda, const char* nB, int nldb) {
  const int tid = tidx(), lane = tid & 63, wm = (tid >> 6) >> 1, wn = (tid >> 6) & 1;
  const int wid = __builtin_amdgcn_readfirstlane(tid >> 6);
  const int fr = lane & 15, fq = lane >> 4;
  const int fa = (wm * 64 + fr) * 64 + ((fq ^ swz(fr)) << 4);
  const int fb = ABYTES + (wn * NJ * 16 + fr) * 64 + ((fq ^ swz(fr)) << 4);
  const int lrow = lane >> 2, lchunk = (lane & 3) ^ swz(lrow);
  constexpr int NBL = NJ / 2;
  const GAS char* gA = (const GAS char*)(A + (size_t)(wid * 32 + lrow) * lda + lchunk * 16);
  const GAS char* gB = (const GAS char*)(B + (size_t)(wid * NBL * 16 + lrow) * ldb + lchunk * 16);
  const size_t a16 = (size_t)16 * lda, b16 = (size_t)16 * ldb;
  LAS char* ldsA = (LAS char*)lds + wid * 2048;
  LAS char* ldsB = (LAS char*)lds + ABYTES + wid * NBL * 1024;
  const int nk = Kb >> 7;
#define GC_ISSUE(pa, pb, sa, sb, stage, kbyte) do { \
    _Pragma("unroll") for (int g = 0; g < 2; ++g) _Pragma("unroll") for (int pn = 0; pn < 2; ++pn) \
      __builtin_amdgcn_global_load_lds((const GAS unsigned*)((pa) + g * (sa) + (kbyte) + pn * 64), (LAS unsigned*)(ldsA + (stage) + pn * PANEL + g * 1024), 16, 0, 0); \
    _Pragma("unroll") for (int g = 0; g < NBL; ++g) _Pragma("unroll") for (int pn = 0; pn < 2; ++pn) \
      __builtin_amdgcn_global_load_lds((const GAS unsigned*)((pb) + g * (sb) + (kbyte) + pn * 64), (LAS unsigned*)(ldsB + (stage) + pn * PANEL + g * 1024), 16, 0, 0); \
  } while (0)
  if (!primed) {
    GC_ISSUE(gA, gB, a16, b16, par * STAGE, 0);
    asm volatile("s_waitcnt vmcnt(0)" ::: "memory");
    __syncthreads();
  }
#pragma unroll 1
  for (int kt = 0; kt < nk; ++kt) {
    char* cur = lds + par * STAGE;
    if (kt + 1 < nk) GC_ISSUE(gA, gB, a16, b16, (par ^ 1) * STAGE, (size_t)(kt + 1) * 128);
    else if (nA) {
      const GAS char* hA = (const GAS char*)(nA + (size_t)(wid * 32 + lrow) * nlda + lchunk * 16);
      const GAS char* hB = (const GAS char*)(nB + (size_t)(wid * NBL * 16 + lrow) * nldb + lchunk * 16);
      GC_ISSUE(hA, hB, (size_t)16 * nlda, (size_t)16 * nldb, (par ^ 1) * STAGE, 0);
    }
    __builtin_amdgcn_sched_barrier(0);
    if (F8) {
#pragma unroll
      for (int ih = 0; ih < 2; ++ih) {
        v8i av[2];
#pragma unroll
        for (int ii = 0; ii < 2; ++ii) {
          const u32x4 a0 = *(const u32x4*)(cur + fa + (ih * 2 + ii) * 1024), a1 = *(const u32x4*)(cur + PANEL + fa + (ih * 2 + ii) * 1024);
          av[ii] = (v8i){(int)a0.x, (int)a0.y, (int)a0.z, (int)a0.w, (int)a1.x, (int)a1.y, (int)a1.z, (int)a1.w};
        }
#pragma unroll
        for (int j = 0; j < NJ; ++j) {
          const u32x4 b0 = *(const u32x4*)(cur + fb + j * 1024), b1 = *(const u32x4*)(cur + PANEL + fb + j * 1024);
          const v8i bv = {(int)b0.x, (int)b0.y, (int)b0.z, (int)b0.w, (int)b1.x, (int)b1.y, (int)b1.z, (int)b1.w};
#pragma unroll
          for (int ii = 0; ii < 2; ++ii)
            acc[ih * 2 + ii][j] = SWAP ? __builtin_amdgcn_mfma_scale_f32_16x16x128_f8f6f4(bv, av[ii], acc[ih * 2 + ii][j], 0, 0, 0, 0x7f7f7f7f, 0, 0x7f7f7f7f)
                                       : __builtin_amdgcn_mfma_scale_f32_16x16x128_f8f6f4(av[ii], bv, acc[ih * 2 + ii][j], 0, 0, 0, 0x7f7f7f7f, 0, 0x7f7f7f7f);
        }
      }
    } else if (PIPE == 2) {
      bf16x8 af[2][4], bfr[NJ];
#pragma unroll
      for (int i = 0; i < 4; ++i) af[0][i] = *(const bf16x8*)(cur + fa + i * 1024);
#pragma unroll
      for (int j = 0; j < NJ; ++j) bfr[j] = *(const bf16x8*)(cur + fb + j * 1024);
#pragma unroll
      for (int i = 0; i < 4; ++i) af[1][i] = *(const bf16x8*)(cur + PANEL + fa + i * 1024);
      __builtin_amdgcn_sched_barrier(0);
#pragma unroll
      for (int i = 0; i < 4; ++i)
#pragma unroll
        for (int j = 0; j < NJ; ++j) acc[i][j] = SWAP ? mfma16(bfr[j], af[0][i], acc[i][j]) : mfma16(af[0][i], bfr[j], acc[i][j]);
#pragma unroll
      for (int j = 0; j < NJ; ++j) bfr[j] = *(const bf16x8*)(cur + PANEL + fb + j * 1024);
#pragma unroll
      for (int i = 0; i < 4; ++i)
#pragma unroll
        for (int j = 0; j < NJ; ++j) acc[i][j] = SWAP ? mfma16(bfr[j], af[1][i], acc[i][j]) : mfma16(af[1][i], bfr[j], acc[i][j]);
    } else if (PIPE == 1) {
      bf16x8 af[2][4], bfr[2][NJ];
#pragma unroll
      for (int ks = 0; ks < 2; ++ks) {
#pragma unroll
        for (int i = 0; i < 4; ++i) af[ks][i] = *(const bf16x8*)(cur + ks * PANEL + fa + i * 1024);
#pragma unroll
        for (int j = 0; j < NJ; ++j) bfr[ks][j] = *(const bf16x8*)(cur + ks * PANEL + fb + j * 1024);
      }
      __builtin_amdgcn_sched_barrier(0);
#pragma unroll
      for (int ks = 0; ks < 2; ++ks)
#pragma unroll
        for (int i = 0; i < 4; ++i)
#pragma unroll
          for (int j = 0; j < NJ; ++j) acc[i][j] = SWAP ? mfma16(bfr[ks][j], af[ks][i], acc[i][j]) : mfma16(af[ks][i], bfr[ks][j], acc[i][j]);
    } else {
#pragma unroll
      for (int ks = 0; ks < 2; ++ks) {
        bf16x8 af[4], bfr[NJ];
#pragma unroll
        for (int i = 0; i < 4; ++i) af[i] = *(const bf16x8*)(cur + ks * PANEL + fa + i * 1024);
#pragma unroll
        for (int j = 0; j < NJ; ++j) bfr[j] = *(const bf16x8*)(cur + ks * PANEL + fb + j * 1024);
#pragma unroll
        for (int i = 0; i < 4; ++i)
#pragma unroll
          for (int j = 0; j < NJ; ++j) acc[i][j] = SWAP ? mfma16(bfr[j], af[i], acc[i][j]) : mfma16(af[i], bfr[j], acc[i][j]);
      }
    }
    __builtin_amdgcn_sched_barrier(0);
    asm volatile("s_waitcnt vmcnt(0)" ::: "memory");
    __syncthreads();
    par ^= 1;
  }
#undef GC_ISSUE
}
template <bool SWAP, int NJ = 4, int PIPE = 1>
__device__ __forceinline__ void gemm_core(const bf16_t* __restrict__ A, int lda, const bf16_t* __restrict__ B, int ldb, int K,
                                          f32x4 (&acc)[4][NJ], char* lds, int& par, bool primed,
                                          const bf16_t* nA, int nlda, const bf16_t* nB, int nldb) {
  gemm_bytes<SWAP, NJ, PIPE, false>((const char*)A, lda * 2, (const char*)B, ldb * 2, K * 2, acc, lds, par, primed, (const char*)nA, nlda * 2, (const char*)nB, nldb * 2);
}
template <bool SWAP, int NJ = 4>
__device__ __forceinline__ void gemm_core(const bf16_t* __restrict__ A, int lda, const bf16_t* __restrict__ B, int ldb, int K,
                                          f32x4 (&acc)[4][NJ], char* lds) {
  int par = 0;
  gemm_core<SWAP, NJ>(A, lda, B, ldb, K, acc, lds, par, false, nullptr, 0, nullptr, 0);
}

__device__ __forceinline__ void tr_tile(const float* __restrict__ src, int lds_, int k0, int ns0, bf16_t* __restrict__ dst, int ldd, int nd0,
                                        const float* __restrict__ ksc, char* lds) {
  bf16_t* T = (bf16_t*)lds;
  const int tid = tidx();
  __syncthreads();
#pragma unroll
  for (int i = 0; i < 2; ++i) {
    const int kk = (tid >> 3) + 32 * i, nn4 = (tid & 7) * 4;
    const f32x4 v = *(const f32x4*)(src + (size_t)(k0 + kk) * lds_ + ns0 + nn4);
    const float s = ksc ? ksc[k0 + kk] : 1.f;
#pragma unroll
    for (int e = 0; e < 4; ++e) T[(nn4 + e) * 72 + kk] = tobf(v[e] * s);
  }
  __syncthreads();
  const int nn = tid >> 3, kc = (tid & 7) * 8;
  const u32x4 w = *(const u32x4*)(T + nn * 72 + kc);
  *(u32x4*)(dst + (size_t)(nd0 + nn) * ldd + k0 + kc) = w;
}

__device__ __forceinline__ void tr_tile2(const float* __restrict__ src, int lds_, int k0, int ns0, bf16_t* __restrict__ dst, int ldd, int nd0,
                                         const float* __restrict__ ksc, char* lds, unsigned char* dst8 = nullptr, int ld8 = 1024) {
  bf16_t* T = (bf16_t*)lds;
  unsigned char* T8 = (unsigned char*)lds + 8704;
  const int tid = tidx();
  __syncthreads();
  f32x4 v[4];
#pragma unroll
  for (int i = 0; i < 4; ++i) v[i] = *(const GAS f32x4*)(src + (size_t)(k0 + (tid >> 3) + 32 * i) * lds_ + ns0 + (tid & 7) * 4);
#pragma unroll
  for (int i = 0; i < 4; ++i) {
    const int kk = (tid >> 3) + 32 * i, nn4 = (tid & 7) * 4;
    const float sc = ksc ? ksc[k0 + kk] : 1.f;
#pragma unroll
    for (int e = 0; e < 4; ++e) T[(nn4 + e) * 136 + kk] = tobf(v[i][e] * sc);
    if (dst8) {
#pragma unroll
      for (int e = 0; e < 4; ++e) T8[(nn4 + e) * 144 + kk] = (unsigned char)(__builtin_amdgcn_cvt_pk_fp8_f32(sat8(v[i][e] * sc * 32.f), 0.f, 0, false) & 0xff);
    }
  }
  __syncthreads();
  const int nn = tid >> 3, kc = (tid & 7) * 16;
  if (dst8) *(u32x4*)(dst8 + (size_t)nn * ld8 + k0 + kc) = *(const u32x4*)(T8 + nn * 144 + kc);
  if (!dst) return;
  const u32x4 w0 = *(const u32x4*)(T + nn * 136 + kc), w1 = *(const u32x4*)(T + nn * 136 + kc + 8);
  bf16_t* d = dst + (size_t)(nd0 + nn) * ldd + k0 + kc;
  *(u32x4*)d = w0; *(u32x4*)(d + 8) = w1;
}

constexpr int P0_GEMV = 192, P0_WIN = 3408, P0_WQ = 144, P0_WKV = 128, P0_WBR = 768, P0_WO = 512, P0_S0 = 256, P0_PAD = 96, P0_TAB = 1105;
constexpr int P0_N = P0_GEMV + P0_WIN + P0_WQ + P0_WKV + P0_WBR + P0_WO + P0_S0 + P0_PAD + P0_TAB;

__device__ __forceinline__ void phase0_item(const Params& p, int j, char* lds) {
  const int tid = tidx();
  char* ws = wsp(p.ws);
  if (j < P0_GEMV) {
    const int l = j / 96, cgi = j % 96;
    float* sv = (float*)lds;
    float* red = (float*)(lds + 20480);
    __syncthreads();
    for (int i = tid; i < 5120; i += 256) { const int v = i >> 10, k = i & 1023; const float x = (v == 0) ? p.c_ctx[k] : p.c[(v - 1) * 1024 + k]; sv[i] = silu_f(x); }
    __syncthreads();
    const int c4 = tid & 7, kg = tid >> 3;
    const float* w = p.w_mod + (size_t)l * 1024 * 3072 + cgi * 32 + c4 * 4;
    f32x4 a0 = {0.f, 0.f, 0.f, 0.f}, a1 = a0, a2 = a0, a3 = a0, a4 = a0;
#pragma unroll 8
    for (int k = kg * 32; k < kg * 32 + 32; ++k) {
      const f32x4 wv = *(const GAS f32x4*)(w + (size_t)k * 3072);
      a0 += wv * sv[k]; a1 += wv * sv[1024 + k]; a2 += wv * sv[2048 + k]; a3 += wv * sv[3072 + k]; a4 += wv * sv[4096 + k];
    }
    *(f32x4*)(red + (kg * 5 + 0) * 32 + c4 * 4) = a0; *(f32x4*)(red + (kg * 5 + 1) * 32 + c4 * 4) = a1; *(f32x4*)(red + (kg * 5 + 2) * 32 + c4 * 4) = a2;
    *(f32x4*)(red + (kg * 5 + 3) * 32 + c4 * 4) = a3; *(f32x4*)(red + (kg * 5 + 4) * 32 + c4 * 4) = a4;
    __syncthreads();
    if (tid < 160) {
      const int v = tid >> 5, c2 = tid & 31;
      float sm = p.b_mod[l * 3072 + cgi * 32 + c2];
#pragma unroll 8
      for (int g = 0; g < 32; ++g) sm += red[(g * 5 + v) * 32 + c2];
      ((float*)(ws + O_MOD))[(l * 5 + v) * 3072 + cgi * 32 + c2] = sm;
    }
    return;
  }
  j -= P0_GEMV;
  if (j < P0_WIN) {
    const int l = j / 1704, r = j % 1704, kt = r / 213, nt = r % 213, c0 = nt * 32;
    const int nd0 = c0 < 2176 ? c0 : (c0 < 2208 ? 3712 + (c0 - 2176) : (c0 < 3744 ? c0 - 32 : c0 + 96));
    tr_tile2(p.w_in + (size_t)l * 1024 * 6816, 6816, kt * 128, c0, (bf16_t*)(ws + O_WIN) + (size_t)l * 6912 * 1024, 1024, nd0, nullptr, lds,
             nd0 >= 3840 ? (unsigned char*)(ws + O_WG8) + ((size_t)l * 3072 + (nd0 - 3840)) * 1024 : nullptr);
    return;
  }
  j -= P0_WIN;
  if (j < P0_WQ) {
    const int l = j / 72, r = j % 72, kt = r / 24, nt = r % 24;
    tr_tile2(p.w_q_up + (size_t)l * 384 * 768, 768, kt * 128, nt * 32, nullptr, 384, nt * 32, p.q_norm_g + l * 384, lds,
             (unsigned char*)(ws + O_WQ) + ((size_t)l * 768 + nt * 32) * 384, 384);
    return;
  }
  j -= P0_WQ;
  if (j < P0_WKV) {
    const int l = j / 64, r = j % 64, kt = r / 32, nt = r % 32, c0 = nt * 32, h = c0 >> 7, e = c0 & 127;
    const int nd0 = e < 64 ? h * 64 + e : 512 + h * 64 + (e - 64);
    tr_tile2(p.w_kv_up + (size_t)l * 256 * 1024, 1024, kt * 128, c0, nullptr, 256, nd0, nullptr, lds,
             (unsigned char*)(ws + O_WKV) + ((size_t)l * 1024 + nd0) * 256, 256);
    return;
  }
  j -= P0_WKV;
  if (j < P0_WBR) {
    const int mat = j / 128, r = j % 128, kt = r / 32, nt = r % 32;
    tr_tile2(p.w_branch + (size_t)mat * 512 * 1024, 1024, kt * 128, nt * 32, nullptr, 512, nt * 32, nullptr, lds,
             (unsigned char*)(ws + O_WBR) + ((size_t)mat * 1024 + nt * 32) * 512, 512);
    return;
  }
  j -= P0_WBR;
  if (j < P0_WO) {
    const int l = j / 256, r = j % 256, kt = r / 32, nt = r % 32;
    tr_tile2(p.w_out + (size_t)l * 1024 * 1024, 1024, kt * 128, nt * 32, nullptr, 1024, nt * 32, nullptr, lds,
             (unsigned char*)(ws + O_WO) + ((size_t)l * 1024 + nt * 32) * 1024, 1024);
    return;
  }
  j -= P0_WO;
  if (j < P0_S0) {
    const int mat = j >> 2, nt = j & 3;
    tr_tile(p.state_ret + (size_t)mat * 64 * 128, 128, 0, nt * 32, (bf16_t*)(ws + O_S0T) + (size_t)mat * 128 * 64, 64, nt * 32, nullptr, lds);
    return;
  }
  j -= P0_S0;
  if (j < P0_PAD) {
    const int l = j / 48, r = j % 48;
    bf16_t* d = (bf16_t*)(ws + O_WIN) + ((size_t)l * 6912 + 3744) * 1024 + (size_t)r * 2048 + tid * 8;
    *(u32x4*)d = (u32x4){0u, 0u, 0u, 0u};
    return;
  }
  j -= P0_PAD;
  {
    float v[8];
    bf16_t* dst = nullptr; unsigned char* dst8 = nullptr;
    if (j == 1104) {
      float* rt = (float*)(ws + O_ROPE);
#pragma unroll
      for (int q = 0; q < 2; ++q) {
        const int idx = tid * 2 + q, pos = idx >> 3, f = idx & 7;
        const float ang = (float)pos * exp2f(-(float)f * 1.66096404744f);
        rt[idx * 2] = cosf(ang); rt[idx * 2 + 1] = sinf(ang);
      }
      return;
    }
    if (j < 16) {
      const int e0 = j * 2048 + tid * 8; dst = (bf16_t*)(ws + O_CS) + e0;
      const int n = e0 >> 7, k = e0 & 127;
#pragma unroll
      for (int e = 0; e < 8; ++e) {
        const float fr = (float)(((n & 127) * (k + e)) & 127) * (1.f / 128.f);
        v[e] = (n < 128) ? __builtin_amdgcn_cosf(fr) : __builtin_amdgcn_sinf(fr);
      }
    } else if (j < 80) {
      const int e0 = (j - 16) * 2048 + tid * 8; dst8 = (unsigned char*)(ws + O_D256) + e0;
      const int k1 = e0 >> 9, kk = e0 & 511;
#pragma unroll
      for (int e = 0; e < 8; ++e) {
        const int t = (kk + e) & 255;
        const float fr = (float)((k1 * t) & 255) * (1.f / 256.f);
        v[e] = (kk < 256) ? __builtin_amdgcn_cosf(fr) : -__builtin_amdgcn_sinf(fr);
      }
    } else {
      const int e0 = (j - 80) * 2048 + tid * 8; dst8 = (unsigned char*)(ws + O_D1024) + e0;
      const int k1 = e0 >> 11, kk = e0 & 2047;
#pragma unroll
      for (int e = 0; e < 8; ++e) {
        const int t = (kk + e) & 1023;
        const float fr = (float)((k1 * t) & 1023) * (1.f / 1024.f);
        v[e] = (kk < 1024) ? __builtin_amdgcn_cosf(fr) : -__builtin_amdgcn_sinf(fr);
      }
    }
    if (dst8) {
      u32x2 w8; w8.x = pk4f8(v[0] * 64.f, v[1] * 64.f, v[2] * 64.f, v[3] * 64.f); w8.y = pk4f8(v[4] * 64.f, v[5] * 64.f, v[6] * 64.f, v[7] * 64.f);
      *(u32x2*)dst8 = w8;
    } else {
      u32x4 w; w.x = pk2(v[0], v[1]); w.y = pk2(v[2], v[3]); w.z = pk2(v[4], v[5]); w.w = pk2(v[6], v[7]);
      *(u32x4*)dst = w;
    }
  }
}

__device__ __forceinline__ void norm_item(const Params& p, int l, int item, const float* xp, const float* xs) {
  const int tid = tidx(), lane = tid & 63, wid = tid >> 6;
  bf16_t* H = (bf16_t*)(p.ws + O_H);
#pragma unroll 3
  for (int i = 0; i < 6; ++i) {
    const int row = item * 24 + wid * 6 + i;
    const float* src = row < NPR ? xp + (size_t)row * 1024 : xs + (size_t)(row - NPR) * 1024;
    const int v = row < NPR ? 0 : 1 + ((row - NPR) >> 10);
    const float* mod = (const float*)(p.ws + O_MOD) + (l * 5 + v) * 3072;
    f32x4 x[4]; float ss = 0.f;
#pragma unroll
    for (int q = 0; q < 4; ++q) { x[q] = *(const f32x4*)(src + (q * 64 + lane) * 4); ss += x[q][0] * x[q][0] + x[q][1] * x[q][1] + x[q][2] * x[q][2] + x[q][3] * x[q][3]; }
    ss = wave_sum(ss);
    const float rstd = rsqrtf(ss * (1.f / 1024.f) + EPSN);
#pragma unroll
    for (int q = 0; q < 4; ++q) {
      const int col = (q * 64 + lane) * 4;
      const f32x4 g = *(const f32x4*)(p.norm_g + l * 1024 + col), sc = *(const f32x4*)(mod + 1024 + col), sh = *(const f32x4*)(mod + col);
      f32x4 h;
#pragma unroll
      for (int e = 0; e < 4; ++e) h[e] = x[q][e] * rstd * g[e] * (1.f + sc[e]) + sh[e];
      *(u32x2*)(H + (size_t)row * 1024 + col) = pk4(h);
      *(unsigned*)(p.ws + O_H8 + (size_t)row * 1024 + col) = pk4f8(h[0], h[1], h[2], h[3]);
    }
  }
}
__device__ __forceinline__ void final_item(const Params& p, int item) {
  const int tid = tidx(), lane = tid & 63, wid = tid >> 6;
#pragma unroll 3
  for (int i = 0; i < 6; ++i) {
    const int row = item * 24 + wid * 6 + i;
    float* src = p.out + (size_t)row * 1024;
    f32x4 x[4]; float ss = 0.f;
#pragma unroll
    for (int q = 0; q < 4; ++q) { x[q] = *(const f32x4*)(src + (q * 64 + lane) * 4); ss += x[q][0] * x[q][0] + x[q][1] * x[q][1] + x[q][2] * x[q][2] + x[q][3] * x[q][3]; }
    ss = wave_sum(ss);
    const float rstd = rsqrtf(ss * (1.f / 1024.f) + EPSN);
#pragma unroll
    for (int q = 0; q < 4; ++q) {
      const int col = (q * 64 + lane) * 4;
      const f32x4 g = *(const f32x4*)(p.final_g + col);
      f32x4 y;
#pragma unroll
      for (int e = 0; e < 4; ++e) y[e] = x[q][e] * rstd * g[e];
      *(f32x4*)(src + col) = y;
    }
  }
}

__device__ __forceinline__ void s2_tile(const Params& p, int l, int tile, char* lds) {
  const int tid = tidx(), lane = tid & 63, wid = tid >> 6, wm = wid >> 1, wn = wid & 1, fr = lane & 15, fq = lane >> 4;
  const int m = (tile / 480) * 16 + (tile % 16), nt = (tile % 480) / 16, m0 = m * 128, n0 = nt * 128;
  char* ws = wsp(p.ws);
  const bf16_t* A = (const bf16_t*)(ws + O_H) + (size_t)m0 * 1024;
  const bf16_t* B = (const bf16_t*)(ws + O_WIN) + ((size_t)l * 6912 + n0) * 1024;
  f32x4 acc[4][4];
  zero_acc(acc);
  if (nt >= 4 && nt < 8) {
    gemm_core<false>(A, 1024, B, 1024, 1024, acc, lds);
    bf16_t* RVT = (bf16_t*)(ws + O_RVT);
#pragma unroll
    for (int i = 0; i < 4; ++i) {
      const int tok = m0 + wm * 64 + i * 16 + fq * 4;
      size_t base; int T, b, t;
      if (tok < NPR) { b = tok >> 8; t = tok & 255; T = 256; base = 0; } else { const int s = tok - NPR; b = s >> 10; t = s & 1023; T = 1024; base = (size_t)NPR * 512; }
#pragma unroll
      for (int j = 0; j < 4; ++j) {
        const int c = n0 - 512 + wn * 64 + j * 16 + fr, h = c >> 7, vd = c & 127;
        *(u32x2*)(RVT + base + ((size_t)(b * 4 + h) * 128 + vd) * T + t) = pk4(acc[i][j]);
      }
    }
    return;
  }
  gemm_core<true>(A, 1024, B, 1024, 1024, acc, lds);
  bf16_t* dst = nullptr; int ld = 0, c0 = 0, op = 0;
  if (nt < 2) { dst = (bf16_t*)(ws + O_RQ); ld = 256; c0 = 0; }
  else if (nt < 4) { dst = (bf16_t*)(ws + O_RK); ld = 256; c0 = 256; op = 2; }
  else if (nt < 12) { dst = (bf16_t*)(ws + O_RZ); ld = 512; c0 = 1024; op = 1; }
  else if (nt < 15) { ld = 384; c0 = 1536; op = 5; }
  else if (nt < 17) { ld = 256; c0 = 1920; op = 3; }
  else if (nt < 21) { dst = (bf16_t*)(ws + O_MZ); ld = 512; c0 = 2176; op = 1; }
  else if (nt < 25) { dst = (bf16_t*)(ws + O_FU); ld = 512; c0 = 2688; }
  else if (nt < 29) { dst = (bf16_t*)(ws + O_FZ); ld = 512; c0 = 3200; op = 1; }
  else { ld = 32; c0 = 3712; op = 4; }
#pragma unroll
  for (int i = 0; i < 4; ++i) {
    const int tok = m0 + wm * 64 + i * 16 + fr;
#pragma unroll
    for (int j = 0; j < 4; ++j) {
      const int col = n0 - c0 + wn * 64 + j * 16 + fq * 4;
      f32x4 v = acc[i][j];
      if (op == 3) { *(f32x4*)((float*)(ws + O_KVLAT) + (size_t)tok * 256 + col) = v; continue; }
      if (op == 5) { *(unsigned*)(ws + O_QLAT + (size_t)tok * 384 + col) = pk4f8(v[0] * 8.f, v[1] * 8.f, v[2] * 8.f, v[3] * 8.f); continue; }
      if (op == 4) { if (col < 32) *(f32x4*)((float*)(ws + O_KR) + (size_t)tok * 32 + col) = v; continue; }
      if (op == 1) {
#pragma unroll
        for (int e = 0; e < 4; ++e) v[e] = silu_f(v[e]);
      } else if (op == 2) {
#pragma unroll
        for (int e = 0; e < 4; ++e) v[e] *= 0.125f;
      }
      const u32x2 w = pk4(v);
      *(u32x2*)(dst + (size_t)tok * ld + col) = w;
      if (op == 2 && tok < NPR) {
        bf16_t* RKT = (bf16_t*)(ws + O_RKT);
        const int b = tok >> 8, t = tok & 255, h = col >> 6, dk = col & 63;
        bf16_t* q = RKT + ((size_t)(b * 4 + h) * 64 + dk) * 256 + t;
        q[0] = (bf16_t)(w.x & 0xffffu); q[256] = (bf16_t)(w.x >> 16); q[512] = (bf16_t)(w.y & 0xffffu); q[768] = (bf16_t)(w.y >> 16);
      }
    }
  }
}

template <int MODE>
__device__ __forceinline__ void attn_item(const Params& p, int l, int item, char* lds) {
  constexpr int NKP = MODE == 0 ? 3 : 2;
  constexpr int NVB = MODE == 0 ? 4 : 8;
  constexpr int PV = NVB * 16 * 64;
  constexpr int KOFF = NKP * 4096;
  constexpr int BUF = KOFF + 2 * PV;
  const int tid = tidx(), lane = tid & 63, wid = tid >> 6, fr = lane & 15, fq = lane >> 4;
  char* ws = wsp(p.ws);
  int smp, b, h, qblk, T, Tk, tok0;
  const bf16_t *kbase, *rbase = nullptr, *vbase, *qbase;
  int kstride, qstride;
  if (MODE == 0) {
    if (item < 256) { smp = 1; b = item >> 6; h = (item >> 3) & 7; qblk = item & 7; T = 1024; Tk = 1536; tok0 = NPR + b * 1024 + qblk * 128; }
    else { const int it = item - 256; smp = 0; b = it >> 4; h = (it >> 1) & 7; qblk = it & 1; T = 256; Tk = 256; tok0 = b * 256 + qblk * 128; }
    const int keyrow0 = smp ? NPR + b * 1536 : b * 256;
    kbase = (const bf16_t*)(ws + O_KB) + (size_t)keyrow0 * 512 + h * 64; kstride = 512;
    rbase = (const bf16_t*)(ws + O_KRA) + (size_t)keyrow0 * 32;
    vbase = (const bf16_t*)(ws + O_VT) + (smp ? (size_t)NPR * 512 + (size_t)(b * 8 + h) * 64 * 1536 : (size_t)(b * 8 + h) * 64 * 256);
    qbase = (const bf16_t*)(ws + O_QB) + (size_t)tok0 * 768 + h * 96; qstride = 768;
  } else {
    if (item < 128) { smp = 1; b = item >> 5; h = (item >> 3) & 3; qblk = item & 7; T = 1024; tok0 = NPR + b * 1024 + qblk * 128; }
    else { const int it = item - 128; smp = 0; b = it >> 3; h = (it >> 1) & 3; qblk = it & 1; T = 256; tok0 = b * 256 + qblk * 128; }
    Tk = T;
    const int ktok0 = smp ? NPR + b * 1024 : b * 256;
    kbase = (const bf16_t*)(ws + O_RK) + (size_t)ktok0 * 256 + h * 64; kstride = 256;
    vbase = (const bf16_t*)(ws + O_RVT) + (smp ? (size_t)NPR * 512 + (size_t)(b * 4 + h) * 128 * 1024 : (size_t)(b * 4 + h) * 128 * 256);
    qbase = (const bf16_t*)(ws + O_RQ) + (size_t)tok0 * 256 + h * 64; qstride = 256;
  }
  const int nkt = Tk >> 6;
  bf16x8 qf[2][NKP];
#pragma unroll
  for (int qb = 0; qb < 2; ++qb)
#pragma unroll
    for (int ks = 0; ks < NKP; ++ks) qf[qb][ks] = *(const bf16x8*)(qbase + (size_t)(wid * 32 + qb * 16 + fr) * qstride + ks * 32 + fq * 8);
  f32x4 o[NVB][2];
#pragma unroll
  for (int vb = 0; vb < NVB; ++vb) { o[vb][0] = (f32x4){0.f, 0.f, 0.f, 0.f}; o[vb][1] = (f32x4){0.f, 0.f, 0.f, 0.f}; }
  float lgf = 0.f, lgb = 0.f;
  float mrow[2] = {-INFINITY, -INFINITY}, lrow[2] = {0.f, 0.f};
  const int tq0 = qblk * 128 + wid * 32 + fr;
  if (MODE == 1) {
    const float xf = p.ret_logit[(l * 2 + 0) * 4 + h], xb = p.ret_logit[(l * 2 + 1) * 4 + h];
    lgf = -log1pf(expf(-xf)) * 1.44269504089f; lgb = -log1pf(expf(-xb)) * 1.44269504089f;
    if (smp) {
      const bf16_t* s0 = (const bf16_t*)(ws + O_S0T);
#pragma unroll
      for (int dir = 0; dir < 2; ++dir) {
        const bf16_t* sb = s0 + ((size_t)(((b * 2 + l) * 2 + dir) * 4 + h) * 128) * 64;
        float dec[2];
#pragma unroll
        for (int qb = 0; qb < 2; ++qb) { const int tq = tq0 + qb * 16; dec[qb] = dir == 0 ? ex2((float)(tq + 1) * lgf) : ex2((float)(T - tq) * lgb); }
#pragma unroll
        for (int vb = 0; vb < NVB; ++vb) {
          f32x4 t0 = (f32x4){0.f, 0.f, 0.f, 0.f}, t1 = (f32x4){0.f, 0.f, 0.f, 0.f};
#pragma unroll
          for (int ks = 0; ks < 2; ++ks) {
            const bf16x8 sf = *(const bf16x8*)(sb + (size_t)(vb * 16 + fr) * 64 + ks * 32 + fq * 8);
            t0 = mfma16(sf, qf[0][ks], t0); t1 = mfma16(sf, qf[1][ks], t1);
          }
          o[vb][0] += t0 * dec[0]; o[vb][1] += t1 * dec[1];
        }
      }
    }
  }
  u32x4 vreg[NVB / 2];
  const int uw = __builtin_amdgcn_readfirstlane(wid);
  const int dkey = lane >> 2, dchunk = (lane & 3) ^ swz(dkey);
  auto kdma = [&](int kt, char* buf) {
    const GAS bf16_t* kp = (const GAS bf16_t*)kbase + (size_t)(kt * 64 + uw * 16 + dkey) * kstride + dchunk * 8;
#pragma unroll
    for (int pn = 0; pn < 2; ++pn)
      __builtin_amdgcn_global_load_lds((const GAS unsigned*)(kp + pn * 32), (LAS unsigned*)((LAS char*)buf + pn * 4096 + uw * 1024), 16, 0, 0);
    if (MODE == 0) {
      const GAS bf16_t* rp = (const GAS bf16_t*)rbase + (size_t)(kt * 64 + uw * 16 + dkey) * 32 + dchunk * 8;
      __builtin_amdgcn_global_load_lds((const GAS unsigned*)rp, (LAS unsigned*)((LAS char*)buf + 2 * 4096 + uw * 1024), 16, 0, 0);
    }
  };
  auto gload = [&](int kt) {
#pragma unroll
    for (int i = 0; i < NVB / 2; ++i) { const int idx = tid + 256 * i, vd = idx >> 3, g = idx & 7; vreg[i] = ldg16(vbase + (size_t)vd * Tk + kt * 64 + g * 8); }
  };
  auto lstore = [&](char* buf) {
#pragma unroll
    for (int i = 0; i < NVB / 2; ++i) {
      const int idx = tid + 256 * i, vd = idx >> 3, g = idx & 7, pnl = g >> 2, g4 = g & 3, hi = g4 >> 1, q0 = 2 * (g4 & 1);
      char* base = buf + KOFF + pnl * PV + vd * 64 + hi * 8;
      *(u32x2*)(base + ((q0 ^ swz(vd)) << 4)) = (u32x2){vreg[i].x, vreg[i].y};
      *(u32x2*)(base + (((q0 + 1) ^ swz(vd)) << 4)) = (u32x2){vreg[i].z, vreg[i].w};
    }
  };
  __syncthreads();
  kdma(0, lds); gload(0); lstore(lds);
  asm volatile("s_waitcnt vmcnt(0)" ::: "memory");
  __syncthreads();
  const int foff = fr * 64 + ((fq ^ swz(fr)) << 4);
  for (int kt = 0; kt < nkt; ++kt) {
    char* cur = lds + (kt & 1) * BUF;
    const bool more = (kt + 1) < nkt;
    if (more) { kdma(kt + 1, lds + ((kt + 1) & 1) * BUF); gload(kt + 1); }
    __builtin_amdgcn_sched_barrier(0);
    f32x4 s[4][2];
#pragma unroll
    for (int kb = 0; kb < 4; ++kb) {
      s[kb][0] = (f32x4){0.f, 0.f, 0.f, 0.f}; s[kb][1] = (f32x4){0.f, 0.f, 0.f, 0.f};
#pragma unroll
      for (int ks = 0; ks < NKP; ++ks) {
        const bf16x8 kf = *(const bf16x8*)(cur + ks * 4096 + kb * 1024 + foff);
        s[kb][0] = mfma16(kf, qf[0][ks], s[kb][0]); s[kb][1] = mfma16(kf, qf[1][ks], s[kb][1]);
      }
    }
    bf16x8 pf[2][2];
#pragma unroll
    for (int qb = 0; qb < 2; ++qb) {
      if (MODE == 0) {
        float mx = s[0][qb][0];
#pragma unroll
        for (int kb = 0; kb < 4; ++kb)
#pragma unroll
          for (int r = 0; r < 4; ++r) mx = fmaxf(mx, s[kb][qb][r]);
        mx = fmaxf(mx, __shfl_xor(mx, 16)); mx = fmaxf(mx, __shfl_xor(mx, 32));
        const float mn = fmaxf(mrow[qb], mx), alpha = ex2(mrow[qb] - mn);
        mrow[qb] = mn;
        float ls = 0.f;
#pragma unroll
        for (int kb = 0; kb < 4; ++kb)
#pragma unroll
          for (int r = 0; r < 4; ++r) { const float e = ex2(s[kb][qb][r] - mn); s[kb][qb][r] = e; ls += e; }
        lrow[qb] = lrow[qb] * alpha + ls;
#pragma unroll
        for (int vb = 0; vb < NVB; ++vb) o[vb][qb] *= alpha;
      } else {
        const int tq = tq0 + qb * 16;
#pragma unroll
        for (int kb = 0; kb < 4; ++kb)
#pragma unroll
          for (int r = 0; r < 4; ++r) {
            const int d = tq - (kt * 64 + kb * 16 + fq * 4 + r);
            const float dec = d > 0 ? ex2((float)d * lgf) : (d < 0 ? ex2((float)(-d) * lgb) : 2.f);
            s[kb][qb][r] *= dec;
          }
      }
#pragma unroll
      for (int g = 0; g < 2; ++g) {
        u32x4 w; w.x = pk2(s[2 * g][qb][0], s[2 * g][qb][1]); w.y = pk2(s[2 * g][qb][2], s[2 * g][qb][3]);
        w.z = pk2(s[2 * g + 1][qb][0], s[2 * g + 1][qb][1]); w.w = pk2(s[2 * g + 1][qb][2], s[2 * g + 1][qb][3]);
        pf[qb][g] = as_bf8(w);
      }
    }
#pragma unroll
    for (int vb = 0; vb < NVB; ++vb)
#pragma unroll
      for (int g = 0; g < 2; ++g) {
        const bf16x8 vf = *(const bf16x8*)(cur + KOFF + g * PV + vb * 1024 + foff);
        o[vb][0] = mfma16(vf, pf[0][g], o[vb][0]); o[vb][1] = mfma16(vf, pf[1][g], o[vb][1]);
      }
    __builtin_amdgcn_sched_barrier(0);
    if (more) lstore(lds + ((kt + 1) & 1) * BUF);
    asm volatile("s_waitcnt vmcnt(0)" ::: "memory");
    __syncthreads();
  }
  bf16_t* G = (bf16_t*)(ws + (MODE == 0 ? O_MZ : O_RZ));
#pragma unroll
  for (int qb = 0; qb < 2; ++qb) {
    const int tok = tok0 + wid * 32 + qb * 16 + fr;
    float mul, sub;
    if (MODE == 0) {
      float lt = lrow[qb]; lt += __shfl_xor(lt, 16); lt += __shfl_xor(lt, 32);
      mul = 1.f / lt; sub = 0.f;
    } else {
      float sm = 0.f;
#pragma unroll
      for (int vb = 0; vb < NVB; ++vb) sm += (o[vb][qb][0] + o[vb][qb][1]) + (o[vb][qb][2] + o[vb][qb][3]);
      sm += __shfl_xor(sm, 16); sm += __shfl_xor(sm, 32);
      const float mu = sm * (1.f / 128.f);
      float vs = 0.f;
#pragma unroll
      for (int vb = 0; vb < NVB; ++vb)
#pragma unroll
        for (int r = 0; r < 4; ++r) { const float dd = o[vb][qb][r] - mu; vs += dd * dd; }
      vs += __shfl_xor(vs, 16); vs += __shfl_xor(vs, 32);
      mul = rsqrtf(vs * (1.f / 128.f) + EPSN); sub = mu;
    }
#pragma unroll
    for (int vb = 0; vb < NVB; ++vb) {
      bf16_t* gp = G + (size_t)tok * 512 + h * (NVB * 16) + vb * 16 + fq * 4;
      const u32x2 gz = *(const u32x2*)gp;
      f32x4 y;
      y[0] = (o[vb][qb][0] - sub) * mul * bflo(gz.x); y[1] = (o[vb][qb][1] - sub) * mul * bfhi(gz.x);
      y[2] = (o[vb][qb][2] - sub) * mul * bflo(gz.y); y[3] = (o[vb][qb][3] - sub) * mul * bfhi(gz.y);
      *(unsigned*)(ws + O_BR8 + (size_t)(MODE == 0 ? 1 : 0) * NTOK * 512 + (size_t)tok * 512 + h * (NVB * 16) + vb * 16 + fq * 4) = pk4f8(y[0] * 8.f, y[1] * 8.f, y[2] * 8.f, y[3] * 8.f);
    }
  }
}

__device__ __forceinline__ bf16x8 scale8(u32x4 raw, const float (&d)[8]) {
  u32x4 w;
  w.x = pk2(bflo(raw.x) * d[0], bfhi(raw.x) * d[1]); w.y = pk2(bflo(raw.y) * d[2], bfhi(raw.y) * d[3]);
  w.z = pk2(bflo(raw.z) * d[4], bfhi(raw.z) * d[5]); w.w = pk2(bflo(raw.w) * d[6], bfhi(raw.w) * d[7]);
  return as_bf8(w);
}
__device__ __forceinline__ void state_item(const Params& p, int l, int item) {
  const int tid = tidx(), lane = tid & 63, wid = tid >> 6, fr = lane & 15, fq = lane >> 4;
  const int b = item >> 2, h = item & 3;
  const bf16_t* RVT = (const bf16_t*)(p.ws + O_RVT) + (size_t)(b * 4 + h) * 128 * 256;
  const bf16_t* RKT = (const bf16_t*)(p.ws + O_RKT) + (size_t)(b * 4 + h) * 64 * 256;
  const float xf = p.ret_logit[(l * 2 + 0) * 4 + h], xb = p.ret_logit[(l * 2 + 1) * 4 + h];
  const float lgf = -log1pf(expf(-xf)) * 1.44269504089f, lgb = -log1pf(expf(-xb)) * 1.44269504089f;
  f32x4 acc[2][2][4];
#pragma unroll
  for (int d = 0; d < 2; ++d)
#pragma unroll
    for (int v = 0; v < 2; ++v)
#pragma unroll
      for (int k = 0; k < 4; ++k) acc[d][v][k] = (f32x4){0.f, 0.f, 0.f, 0.f};
#pragma unroll 2
  for (int ks = 0; ks < 8; ++ks) {
    const int j0 = ks * 32 + fq * 8;
    float df[8], db[8];
#pragma unroll
    for (int e = 0; e < 8; ++e) { df[e] = exp2f((float)(255 - j0 - e) * lgf); db[e] = exp2f((float)(j0 + e) * lgb); }
    bf16x8 af[2];
#pragma unroll
    for (int v = 0; v < 2; ++v) af[v] = *(const bf16x8*)(RVT + (size_t)((wid * 2 + v) * 16 + fr) * 256 + j0);
#pragma unroll
    for (int k = 0; k < 4; ++k) {
      const u32x4 raw = *(const u32x4*)(RKT + (size_t)(k * 16 + fr) * 256 + j0);
      const bf16x8 kf = scale8(raw, df), kb = scale8(raw, db);
#pragma unroll
      for (int v = 0; v < 2; ++v) { acc[0][v][k] = mfma16(af[v], kf, acc[0][v][k]); acc[1][v][k] = mfma16(af[v], kb, acc[1][v][k]); }
    }
  }
  float* O = p.out + OUT_RET;
#pragma unroll
  for (int d = 0; d < 2; ++d)
#pragma unroll
    for (int v = 0; v < 2; ++v)
#pragma unroll
      for (int k = 0; k < 4; ++k) {
        const int dk = k * 16 + fr, vd = (wid * 2 + v) * 16 + fq * 4;
        *(f32x4*)(O + ((size_t)((((b * 2 + l) * 2 + d) * 4 + h) * 64 + dk)) * 128 + vd) = acc[d][v][k];
      }
}

__device__ __forceinline__ void keyprep_item(const Params& p, int l, int item) {
  const int tid = tidx(), lane = tid & 63, wid = tid >> 6;
  char* ws = wsp(p.ws);
  unsigned char* CKVA = (unsigned char*)(ws + O_CKVA);
  bf16_t* KRA = (bf16_t*)(ws + O_KRA);
#pragma unroll
  for (int i = 0; i < 4; ++i) {
    const int R = item * 16 + wid * 4 + i;
    int smp = 0, b, t = 0, tok = 0, ctx = 0, pp = 0;
    if (R < NPR) { tok = R; b = R >> 8; t = R & 255; }
    else { smp = 1; const int s = R - NPR; b = s / 1536; pp = s - b * 1536; if (pp < 512) ctx = 1; else { t = pp - 512; tok = NPR + b * 1024 + t; } }
    if (ctx) {
      const f32x4 v = *(const f32x4*)(p.cache_ckv + ((size_t)((b * 2 + l) * 512 + pp)) * 256 + lane * 4);
      *(unsigned*)(CKVA + (size_t)R * 256 + lane * 4) = pk4f8(v[0] * 4.f, v[1] * 4.f, v[2] * 4.f, v[3] * 4.f);
      if (lane < 32) KRA[(size_t)R * 32 + lane] = tobf(p.cache_krope[((size_t)((b * 2 + l) * 512 + pp)) * 32 + lane]);
      continue;
    }
    const f32x4 v = *(const f32x4*)((const float*)(ws + O_KVLAT) + (size_t)tok * 256 + lane * 4);
    float ss = v[0] * v[0] + v[1] * v[1] + v[2] * v[2] + v[3] * v[3];
    ss = wave_sum(ss);
    const float rstd = rsqrtf(ss * (1.f / 256.f) + EPSN);
    const f32x4 g = *(const f32x4*)(p.kv_norm_g + l * 256 + lane * 4);
    f32x4 y;
#pragma unroll
    for (int e = 0; e < 4; ++e) y[e] = v[e] * rstd * g[e];
    *(unsigned*)(CKVA + (size_t)R * 256 + lane * 4) = pk4f8(y[0] * 4.f, y[1] * 4.f, y[2] * 4.f, y[3] * 4.f);
    if (!smp) *(f32x4*)(p.out + OUT_CKV + ((size_t)((b * 2 + l) * 256 + t)) * 256 + lane * 4) = y;
    const int d = lane & 31;
    const float x = ((const float*)(ws + O_KR))[(size_t)tok * 32 + d];
    float yk = x;
    if (smp) {
      const float pr = __shfl_xor(x, 8);
      const int hd = d >> 4, i16 = d & 15, f = i16 & 7;
      const int pos = hd ? (t & 63) : (t >> 6);
      const float* rt = (const float*)(ws + O_ROPE) + (pos * 8 + f) * 2;
      const float cs = rt[0], sn = rt[1];
      yk = i16 < 8 ? x * cs - pr * sn : pr * sn + x * cs;
    } else if (lane < 32) {
      p.out[OUT_KR + ((size_t)((b * 2 + l) * 256 + t)) * 32 + d] = x;
    }
    if (lane < 32) KRA[(size_t)R * 32 + d] = tobf(yk);
  }
}

__device__ __forceinline__ void f1_tile(const Params& p, int tile, char* lds) {
  const int tid = tidx(), lane = tid & 63, wid = tid >> 6, wm = wid >> 1, wn = wid & 1, fr = lane & 15, fq = lane >> 4;
  const int m = tile >> 3, g = (tile >> 1) & 3, nh = tile & 1, m0 = m * 128;
  char* ws = wsp(p.ws);
  f32x4 acc[4][4];
  zero_acc(acc);
  gemm_core<false>((const bf16_t*)(ws + O_FU) + (size_t)m0 * 512 + g * 128, 512, (const bf16_t*)(ws + O_CS) + (size_t)nh * 128 * 128, 128, 128, acc, lds);
  unsigned char* UT = (unsigned char*)(ws + O_UT);
#pragma unroll
  for (int i = 0; i < 4; ++i) {
    const int tok = m0 + wm * 64 + i * 16 + fq * 4;
    size_t base; int T, b, t;
    if (tok < NPR) { b = tok >> 8; t = tok & 255; T = 256; base = 0; } else { const int s = tok - NPR; b = s >> 10; t = s & 1023; T = 1024; base = (size_t)NPR * 1024; }
#pragma unroll
    for (int j = 0; j < 4; ++j) {
      const int k2 = wn * 64 + j * 16 + fr;
      *(unsigned*)(UT + base + ((size_t)(b * 4 + g) * 128 + k2) * (2 * T) + nh * T + t) = pk4f8(acc[i][j][0] * 4.f, acc[i][j][1] * 4.f, acc[i][j][2] * 4.f, acc[i][j][3] * 4.f);
    }
  }
}

__device__ __forceinline__ void qup_tile(const Params& p, int l, int tile, char* lds) {
  const int tid = tidx(), lane = tid & 63, wid = tid >> 6, wm = wid >> 1, wn = wid & 1, fr = lane & 15, fq = lane >> 4;
  const int m = tile % 96, nt = tile / 96, m0 = m * 128, n0 = nt * 128;
  char* ws = wsp(p.ws);
  const char* QL = (const char*)(ws + O_QLAT) + (size_t)m0 * 384;
  float rsv4[4];
  {
    float* rs = (float*)lds;
    __syncthreads();
#pragma unroll 1
    for (int r0 = 0; r0 < 32; r0 += 4) {
      float ss[4];
#pragma unroll
      for (int u = 0; u < 4; ++u) {
        u32x4 w = (u32x4){0u, 0u, 0u, 0u};
        if (lane < 24) w = ldg16(QL + (size_t)(wid * 32 + r0 + u) * 384 + lane * 16);
        float a = 0.f;
#pragma unroll
        for (int q = 0; q < 4; ++q) {
          const float f0 = __builtin_amdgcn_cvt_f32_fp8(w[q], 0), f1 = __builtin_amdgcn_cvt_f32_fp8(w[q], 1), f2 = __builtin_amdgcn_cvt_f32_fp8(w[q], 2), f3 = __builtin_amdgcn_cvt_f32_fp8(w[q], 3);
          a += f0 * f0 + f1 * f1 + f2 * f2 + f3 * f3;
        }
        ss[u] = a;
      }
#pragma unroll
      for (int u = 0; u < 4; ++u) { const float t = wave_sum(ss[u]); if (lane == 0) rs[wid * 32 + r0 + u] = rsqrtf(t * (1.f / (384.f * 64.f)) + EPSN); }
    }
    __syncthreads();
#pragma unroll
    for (int i = 0; i < 4; ++i) rsv4[i] = rs[wm * 64 + i * 16 + fr];
    __syncthreads();
  }
  f32x4 acc[4][4];
  zero_acc(acc);
  { int par = 0; gemm_bytes<true, 4, 1, true>(QL, 384, (const char*)(ws + O_WQ) + ((size_t)l * 768 + n0) * 384, 384, 384, acc, lds, par, false, nullptr, 0, nullptr, 0); }
  bf16_t* QB = (bf16_t*)(ws + O_QB);
  const float qscale = 0.10206207261596577f * 1.44269504089f * (1.f / 256.f);
#pragma unroll
  for (int i = 0; i < 4; ++i) {
    const int rl = wm * 64 + i * 16 + fr, tok = m0 + rl;
    const float sc = rsv4[i] * qscale;
    const int smp = tok >= NPR, t = (tok - NPR) & 1023;
#pragma unroll
    for (int j = 0; j < 4; ++j) {
      const int cb = n0 + wn * 64 + j * 16, within = cb % 96;
      f32x4 v = acc[i][j] * sc;
      if (within >= 64) {
        f32x4 pr;
#pragma unroll
        for (int e = 0; e < 4; ++e) pr[e] = __shfl_xor(v[e], 32);
        if (smp) {
          const int pos = within >= 80 ? (t & 63) : (t >> 6);
          const float* rt = (const float*)(ws + O_ROPE) + (pos * 8 + (fq & 1) * 4) * 2;
          const f32x4 c01 = *(const f32x4*)rt, c23 = *(const f32x4*)(rt + 4);
          const float cs4[4] = {c01[0], c01[2], c23[0], c23[2]}, sn4[4] = {c01[1], c01[3], c23[1], c23[3]};
#pragma unroll
          for (int e = 0; e < 4; ++e) v[e] = fq < 2 ? v[e] * cs4[e] - pr[e] * sn4[e] : pr[e] * sn4[e] + v[e] * cs4[e];
        }
      }
      *(u32x2*)(QB + (size_t)tok * 768 + cb + fq * 4) = pk4(v);
    }
  }
}

__device__ __forceinline__ void kvup_tile(const Params& p, int l, int tile, char* lds) {
  const int tid = tidx(), lane = tid & 63, wid = tid >> 6, wm = wid >> 1, wn = wid & 1, fr = lane & 15, fq = lane >> 4;
  const int m = tile % 112, nt = tile / 112, m0 = m * 128, n0 = nt * 128;
  char* ws = wsp(p.ws);
  const char* A = (const char*)(ws + O_CKVA) + (size_t)m0 * 256;
  const char* B = (const char*)(ws + O_WKV) + ((size_t)l * 1024 + n0) * 256;
  const float ks = 1.f / 128.f;
  f32x4 acc[4][4];
  zero_acc(acc);
  if (nt < 4) {
    { int par = 0; gemm_bytes<true, 4, 1, true>(A, 256, B, 256, 256, acc, lds, par, false, nullptr, 0, nullptr, 0); }
    bf16_t* KB = (bf16_t*)(ws + O_KB);
#pragma unroll
    for (int i = 0; i < 4; ++i) {
      const int R = m0 + wm * 64 + i * 16 + fr;
#pragma unroll
      for (int j = 0; j < 4; ++j) *(u32x2*)(KB + (size_t)R * 512 + n0 + wn * 64 + j * 16 + fq * 4) = pk4(acc[i][j] * ks);
    }
  } else {
    { int par = 0; gemm_bytes<false, 4, 1, true>(A, 256, B, 256, 256, acc, lds, par, false, nullptr, 0, nullptr, 0); }
    bf16_t* VT = (bf16_t*)(ws + O_VT);
#pragma unroll
    for (int i = 0; i < 4; ++i) {
      const int R = m0 + wm * 64 + i * 16 + fq * 4;
      size_t base; int Tk, b, k;
      if (R < NPR) { b = R >> 8; k = R & 255; Tk = 256; base = 0; } else { const int s = R - NPR; b = s / 1536; k = s - b * 1536; Tk = 1536; base = (size_t)NPR * 512; }
#pragma unroll
      for (int j = 0; j < 4; ++j) {
        const int c = n0 - 512 + wn * 64 + j * 16 + fr, h = c >> 6, vd = c & 63;
        *(u32x2*)(VT + base + ((size_t)(b * 8 + h) * 64 + vd) * Tk + k) = pk4(acc[i][j] * ks);
      }
    }
  }
}

template <int NJ>
__device__ __forceinline__ void f2_tile(const Params& p, int tile, char* lds) {
  const int tid = tidx(), lane = tid & 63, wid = tid >> 6, wm = wid >> 1, wn = wid & 1, fr = lane & 15, fq = lane >> 4;
  char* ws = wsp(p.ws);
  const char *A, *B; int K, tokb, g, nh = 0; float scale;
  if (NJ == 2) {
    const int b = tile >> 6, mt = (tile >> 1) & 7; g = (tile >> 4) & 3; nh = tile & 1;
    A = (const char*)(ws + O_D1024) + (size_t)mt * 128 * 2048; K = 2048;
    B = (const char*)(ws + O_UT) + (size_t)NPR * 1024 + ((size_t)(b * 4 + g) * 128 + nh * 64) * 2048;
    tokb = NPR + b * 1024 + mt * 128; scale = 0.00276213586400995f * (1.f / 256.f);
  } else {
    const int b = tile >> 3, mt = tile & 1; g = (tile >> 1) & 3;
    A = (const char*)(ws + O_D256) + (size_t)mt * 128 * 512; K = 512;
    B = (const char*)(ws + O_UT) + (size_t)(b * 4 + g) * 128 * 512;
    tokb = b * 256 + mt * 128; scale = 0.0055242717280199f * (1.f / 256.f);
  }
  f32x4 acc[4][NJ];
#pragma unroll
  for (int i = 0; i < 4; ++i)
#pragma unroll
    for (int j = 0; j < NJ; ++j) acc[i][j] = (f32x4){0.f, 0.f, 0.f, 0.f};
  { int par = 0; gemm_bytes<true, NJ, 1, true>(A, K, B, K, K, acc, lds, par, false, nullptr, 0, nullptr, 0); }
  bf16_t* FZ = (bf16_t*)(ws + O_FZ);
#pragma unroll
  for (int i = 0; i < 4; ++i) {
    const int tok = tokb + wm * 64 + i * 16 + fr;
#pragma unroll
    for (int j = 0; j < NJ; ++j) {
      bf16_t* gp = FZ + (size_t)tok * 512 + g * 128 + nh * 64 + wn * (NJ * 16) + j * 16 + fq * 4;
      const u32x2 gz = *(const u32x2*)gp;
      f32x4 y;
      y[0] = acc[i][j][0] * scale * bflo(gz.x); y[1] = acc[i][j][1] * scale * bfhi(gz.x);
      y[2] = acc[i][j][2] * scale * bflo(gz.y); y[3] = acc[i][j][3] * scale * bfhi(gz.y);
      *(unsigned*)(ws + O_BR8 + (size_t)2 * NTOK * 512 + (size_t)tok * 512 + g * 128 + nh * 64 + wn * (NJ * 16) + j * 16 + fq * 4) = pk4f8(y[0] * 8.f, y[1] * 8.f, y[2] * 8.f, y[3] * 8.f);
    }
  }
}

template <int NJ>
__device__ __forceinline__ void s6_tile(const Params& p, int l, int tile, int ntile, char* lds, int& par, bool& primed) {
  const int tid = tidx(), lane = tid & 63, wid = tid >> 6, wm = wid >> 1, wn = wid & 1, fr = lane & 15, fq = lane >> 4;
  constexpr int NT = 32 / NJ, BN = NJ * 32;
  const int m = (tile / (32 * NT)) * 32 + (tile % 32), nt = (tile % (32 * NT)) / 32, m0 = m * 128, n0 = nt * BN;
  char* ws = wsp(p.ws);
  const char* H8 = (const char*)(ws + O_H8);
  const char* W8 = (const char*)(ws + O_WG8) + (size_t)l * 3072 * 1024;
  const char* Wb = (const char*)(ws + O_WBR) + (size_t)(l * 3) * 1024 * 512;
  f32x4 tot[4][NJ], acc[4][NJ];
  unsigned sg[4][NJ];
#pragma unroll
  for (int i = 0; i < 4; ++i)
#pragma unroll
    for (int j = 0; j < NJ; ++j) tot[i][j] = (f32x4){0.f, 0.f, 0.f, 0.f};
#pragma unroll 1
  for (int nb = 0; nb < 3; ++nb) {
    u32x2 totp[4][NJ];
#pragma unroll
    for (int i = 0; i < 4; ++i)
#pragma unroll
      for (int j = 0; j < NJ; ++j) { totp[i][j] = pk4(tot[i][j]); acc[i][j] = (f32x4){0.f, 0.f, 0.f, 0.f}; }
    const char* brA = (const char*)(ws + O_BR8) + ((size_t)nb * NTOK + m0) * 512;
    const char* brB = Wb + ((size_t)nb * 1024 + n0) * 512;
    gemm_bytes<true, NJ, 2, true>(H8 + (size_t)m0 * 1024, 1024, W8 + ((size_t)nb * 1024 + n0) * 1024, 1024, 1024, acc, lds, par, primed, brA, 512, brB, 512);
#pragma unroll
    for (int i = 0; i < 4; ++i)
#pragma unroll
      for (int j = 0; j < NJ; ++j) {
        unsigned q = 0;
#pragma unroll
        for (int e = 0; e < 4; ++e) {
          const unsigned qe = (unsigned)fmaxf(sigm_f(acc[i][j][e] * 0.03125f) * 255.f + 0.5f, 1.f);
          q |= qe << (8 * e);
          tot[i][j][e] = (e == 0 ? bflo(totp[i][j].x) : e == 1 ? bfhi(totp[i][j].x) : e == 2 ? bflo(totp[i][j].y) : bfhi(totp[i][j].y)) * __builtin_amdgcn_rcpf((float)qe * (1.f / 255.f));
        }
        sg[i][j] = q;
      }
    const char *nA = nullptr, *nB = nullptr;
    if (nb < 2) { nA = H8 + (size_t)m0 * 1024; nB = W8 + ((size_t)(nb + 1) * 1024 + n0) * 1024; }
    else if (ntile >= 0) { nA = H8 + (size_t)(((ntile / (32 * NT)) * 32 + (ntile % 32)) * 128) * 1024; nB = W8 + (size_t)(((ntile % (32 * NT)) / 32) * BN) * 1024; }
    gemm_bytes<true, NJ, 2, true>(brA, 512, brB, 512, 512, tot, lds, par, true, nA, 1024, nB, 1024);
    primed = nA != nullptr;
#pragma unroll
    for (int i = 0; i < 4; ++i)
#pragma unroll
      for (int j = 0; j < NJ; ++j) {
        tot[i][j][0] *= (float)(sg[i][j] & 0xffu) * (1.f / 255.f); tot[i][j][1] *= (float)((sg[i][j] >> 8) & 0xffu) * (1.f / 255.f);
        tot[i][j][2] *= (float)((sg[i][j] >> 16) & 0xffu) * (1.f / 255.f); tot[i][j][3] *= (float)(sg[i][j] >> 24) * (1.f / 255.f);
      }
  }
  unsigned char* MG = (unsigned char*)(ws + O_UT);
#pragma unroll
  for (int i = 0; i < 4; ++i) {
    const int tok = m0 + wm * 64 + i * 16 + fr;
#pragma unroll
    for (int j = 0; j < NJ; ++j) *(unsigned*)(MG + (size_t)tok * 1024 + n0 + wn * (NJ * 16) + j * 16 + fq * 4) = pk4f8(tot[i][j][0] * (1.f / 256.f), tot[i][j][1] * (1.f / 256.f), tot[i][j][2] * (1.f / 256.f), tot[i][j][3] * (1.f / 256.f));
  }
}

__device__ __forceinline__ void s7_tile(const Params& p, int l, int tile, const float* xp, const float* xs, char* lds) {
  const int tid = tidx(), lane = tid & 63, wid = tid >> 6, wm = wid >> 1, wn = wid & 1, fr = lane & 15, fq = lane >> 4;
  const int m = (tile / 512) * 32 + (tile % 32), nt = (tile % 512) / 32, m0 = m * 128, n0 = nt * 64;
  char* ws = wsp(p.ws);
  f32x4 acc[4][2];
#pragma unroll
  for (int i = 0; i < 4; ++i) { acc[i][0] = (f32x4){0.f, 0.f, 0.f, 0.f}; acc[i][1] = (f32x4){0.f, 0.f, 0.f, 0.f}; }
  { int par = 0; gemm_bytes<true, 2, 1, true>((const char*)(ws + O_UT) + (size_t)m0 * 1024, 1024, (const char*)(ws + O_WO) + ((size_t)l * 1024 + n0) * 1024, 1024, 1024, acc, lds, par, false, nullptr, 0, nullptr, 0); }
#pragma unroll
  for (int i = 0; i < 4; ++i) {
    const int tok = m0 + wm * 64 + i * 16 + fr;
    const float* src = tok < NPR ? xp + (size_t)tok * 1024 : xs + (size_t)(tok - NPR) * 1024;
    const int v = tok < NPR ? 0 : 1 + ((tok - NPR) >> 10);
    const float* gate = (const float*)(ws + O_MOD) + (l * 5 + v) * 3072 + 2048;
#pragma unroll
    for (int j = 0; j < 2; ++j) {
      const int col = n0 + wn * 32 + j * 16 + fq * 4;
      const f32x4 x = *(const f32x4*)(src + col), gt = *(const f32x4*)(gate + col);
      f32x4 y;
#pragma unroll
      for (int e = 0; e < 4; ++e) y[e] = x[e] + gt[e] * (acc[i][j][e] * 0.03125f);
      *(f32x4*)(p.out + (size_t)tok * 1024 + col) = y;
    }
  }
}

constexpr int NPHASE = 16;
__device__ __forceinline__ int q_issue(unsigned* ctr) {
  int v = 0;
  if (threadIdx.x == 0) v = (int)__hip_atomic_fetch_add(ctr, 1u, __ATOMIC_RELAXED, __HIP_MEMORY_SCOPE_AGENT);
  return v;
}
__device__ __forceinline__ int q_bcast(int v, char* lds) {
  __syncthreads();
  if (threadIdx.x == 0) *(volatile int*)lds = v;
  __syncthreads();
  const int it = *(volatile int*)lds;
  __syncthreads();
  return it;
}
__device__ __forceinline__ void run_phase(const Params& p, int ph, char* lds, unsigned* qctr) {
  const int bid = blockIdx.x, nb = gridDim.x;
  if (ph == 0) { for (int i = bid; i < P0_N; i += nb) phase0_item(p, i, lds); return; }
  if (ph == 15) { for (int i = bid; i < 512; i += nb) final_item(p, i); return; }
  const int l = (ph - 1) / 7, s = (ph - 1) % 7;
  const float* xp = l == 0 ? p.x_prompt : p.out;
  const float* xs = l == 0 ? p.x_sample : p.out + (size_t)NPR * 1024;
  switch (s) {
    case 0: for (int i = bid; i < 512; i += nb) norm_item(p, l, i, xp, xs); break;
    case 1: for (int i = bid; i < 2880; i += nb) s2_tile(p, l, i, lds); break;
    case 2:
      for (int i = q_bcast(q_issue(qctr + ph), lds); i < 2752;) {
        if (i < 128) attn_item<1>(p, l, i, lds);
        else if (i < 1024) keyprep_item(p, l, i - 128);
        else if (i < 1280) attn_item<1>(p, l, 128 + (i - 1024), lds);
        else if (i < 1408) state_item(p, l, i - 1280);
        else if (i < 1984) qup_tile(p, l, i - 1408, lds);
        else f1_tile(p, i - 1984, lds);
        i = q_bcast(q_issue(qctr + ph), lds);
      }
      break;
    case 3:
      for (int i = q_bcast(q_issue(qctr + ph), lds); i < 1408;) {
        if (i < 256) f2_tile<2>(p, i, lds);
        else if (i < 512) f2_tile<4>(p, i - 256, lds);
        else kvup_tile(p, l, i - 512, lds);
        i = q_bcast(q_issue(qctr + ph), lds);
      }
      break;
    case 4:
      for (int i = q_bcast(q_issue(qctr + ph), lds); i < 768;) {
        attn_item<0>(p, l, i, lds);
        i = q_bcast(q_issue(qctr + ph), lds);
      }
      break;
    case 5: { int par = 0; bool primed = false; for (int i = bid; i < 768; i += nb) s6_tile<4>(p, l, i, (i + nb < 768) ? i + nb : -1, lds, par, primed); } break;
    case 6: for (int i = bid; i < 1536; i += nb) s7_tile(p, l, i, xp, xs, lds); break;
  }
}

#define XB_TMO      128
#define XB_XCNT(j)  (256  + 64 * (j))
#define XB_XSUB(j)  (1280 + 64 * (j))
#define XB_XGEN(j)  (2304 + 64 * (j))
#define XB_TOP      3328
#define XB_TOPGEN   3392
#define XCD_BAR_WORDS 3456
#define XB_SPIN_CAP (1u << 18)
__device__ __forceinline__ unsigned xb_ld(unsigned* p)              { return __hip_atomic_load(p, __ATOMIC_RELAXED, __HIP_MEMORY_SCOPE_AGENT); }
__device__ __forceinline__ unsigned xb_add(unsigned* p, unsigned v) { return __hip_atomic_fetch_add(p, v, __ATOMIC_RELAXED, __HIP_MEMORY_SCOPE_AGENT); }
__device__ __forceinline__ unsigned xb_xcc_id() { return (unsigned)__builtin_amdgcn_s_getreg((3 << 11) | 20) & 0xFu; }
#define XB_SPIN(cond, bar) do { unsigned _sp = 0; while (cond) { __builtin_amdgcn_s_sleep(1); \
    if ((++_sp & 255u) == 0u) { if (xb_ld(&(bar)[XB_TMO])) break; if (_sp > XB_SPIN_CAP) { atomicAdd(&(bar)[XB_TMO], 1u); break; } } } } while (0)
__device__ __forceinline__ void xcd_barrier_complete(unsigned* bar, unsigned x, unsigned& nloc, unsigned& nx) {
  const unsigned G = gridDim.x;
  unsigned sum, cnt, mine, sp = 0u;
  for (;;) {
    sum = 0u; cnt = 0u; mine = 0u;
#pragma unroll
    for (unsigned j = 0; j < 16; ++j) { const unsigned c = xb_ld(&bar[XB_XCNT(j)]); sum += c; cnt += (c > 0u) ? 1u : 0u; mine = (j == x) ? c : mine; }
    if (sum == G) break;
    __builtin_amdgcn_s_sleep(1);
    if ((++sp & 255u) == 0u) { if (xb_ld(&bar[XB_TMO])) break; if (sp > XB_SPIN_CAP) { atomicAdd(&bar[XB_TMO], 1u); break; } }
  }
  nloc = mine > 0u ? mine : 1u; nx = cnt > 0u ? cnt : 1u;
}
__device__ __forceinline__ void xcd_barrier(unsigned* bar, unsigned x, unsigned& nloc, unsigned& nx) {
  asm volatile("s_waitcnt vmcnt(0)" ::: "memory");
  __syncthreads();
  if (threadIdx.x == 0) {
    __builtin_amdgcn_s_waitcnt(0);
    if (nloc == 0u) xcd_barrier_complete(bar, x, nloc, nx);
    const unsigned old = xb_add(&bar[XB_XSUB(x)], 1u);
    const unsigned gen = old / nloc;
    if (old + 1u == (gen + 1u) * nloc) {
      __builtin_amdgcn_fence(__ATOMIC_RELEASE, "agent");
      asm volatile("s_waitcnt vmcnt(0)" ::: "memory");
      const unsigned og = xb_add(&bar[XB_TOP], 1u);
      const unsigned tg = og / nx;
      if (og + 1u == (tg + 1u) * nx) xb_add(&bar[XB_TOPGEN], 1u);
      else XB_SPIN(xb_ld(&bar[XB_TOPGEN]) == tg, bar);
      __builtin_amdgcn_fence(__ATOMIC_ACQUIRE, "agent");
      xb_add(&bar[XB_XGEN(x)], 1u);
      asm volatile("s_waitcnt vmcnt(0)" ::: "memory");
    } else {
      XB_SPIN(xb_ld(&bar[XB_XGEN(x)]) == gen, bar);
      __builtin_amdgcn_fence(__ATOMIC_ACQUIRE, "agent");
      asm volatile("s_waitcnt vmcnt(0)" ::: "memory");
    }
  }
  __syncthreads();
}

__global__ void __launch_bounds__(256, 2) mk_fwd(Params p) {
  __shared__ __attribute__((aligned(16))) char lds[LDS_TOTAL];
  cg::grid_group grid = cg::this_grid();
  unsigned* bar = (unsigned*)(p.ws + O_BAR);
  const unsigned xcc = xb_xcc_id();
  if (threadIdx.x == 0) (void)xb_add(&bar[XB_XCNT(xcc)], 1u);
  unsigned nloc = 0u, nx = 0u;
  if (gridDim.x == 0x7fffffffu) grid.sync();
#pragma unroll 1
  for (int ph = 0; ph < NPHASE; ++ph) {
    run_phase(p, ph, lds, bar);
    if (ph + 1 < NPHASE) xcd_barrier(bar, xcc, nloc, nx);
  }
}

extern "C" void kernel_launch(void* const* d_in, const int* in_sizes, int n_in, void* d_out, int out_size, void* d_ws, size_t ws_size,
                              hipStream_t stream) {
  Params p{};
  p.x_prompt = (const float*)d_in[0]; p.x_sample = (const float*)d_in[1]; p.cache_ckv = (const float*)d_in[2]; p.cache_krope = (const float*)d_in[3];
  p.state_ret = (const float*)d_in[4]; p.c = (const float*)d_in[5]; p.c_ctx = (const float*)d_in[6]; p.norm_g = (const float*)d_in[7];
  p.w_mod = (const float*)d_in[8]; p.b_mod = (const float*)d_in[9]; p.w_in = (const float*)d_in[10]; p.ret_logit = (const float*)d_in[11];
  p.q_norm_g = (const float*)d_in[12]; p.w_q_up = (const float*)d_in[13]; p.kv_norm_g = (const float*)d_in[14]; p.w_kv_up = (const float*)d_in[15];
  p.w_branch = (const float*)d_in[16]; p.w_out = (const float*)d_in[17]; p.final_g = (const float*)d_in[18];
  p.out = (float*)d_out; p.ws = (char*)d_ws;
#if ONE_LAUNCH
  static int grid_blocks = 0;
  if (!grid_blocks) {
    int dev = 0, cus = 0, per_cu = 0;
    hipGetDevice(&dev);
    hipDeviceGetAttribute(&cus, hipDeviceAttributeMultiprocessorCount, dev);
    hipOccupancyMaxActiveBlocksPerMultiprocessor(&per_cu, mk_fwd, 256, 0);
    if (per_cu > 2) per_cu = 2;
    grid_blocks = cus * per_cu;
  }
  hipMemsetAsync((char*)d_ws + O_BAR, 0, XCD_BAR_WORDS * 4, stream);
  void* args[] = {&p};
  hipError_t e = hipLaunchCooperativeKernel((void*)mk_fwd, dim3(grid_blocks), dim3(256), args, 0, stream);
  if (e != hipSuccess) fprintf(stderr, "cooperative launch failed: %s (grid %d)\n", hipGetErrorString(e), grid_blocks);
#endif
}
```

```cpp
#include <hip/hip_runtime.h>
#include <hip/hip_cooperative_groups.h>
#include <stdint.h>
#include <stdio.h>
namespace cg = cooperative_groups;

#ifndef ONE_LAUNCH
#define ONE_LAUNCH 1
#endif

typedef unsigned short bf16_t;
typedef short bf16x8 __attribute__((ext_vector_type(8)));
typedef float f32x4 __attribute__((ext_vector_type(4)));
typedef unsigned u32x4 __attribute__((ext_vector_type(4)));
typedef unsigned u32x2 __attribute__((ext_vector_type(2)));

constexpr int NTOK = 12288, NPR = 8192, NKEY = 14336;
constexpr float EPSN = 1e-6f;

constexpr size_t O_WIN   = 0;
constexpr size_t O_WQ    = O_WIN   + (size_t)2 * 6912 * 1024 * 2;
constexpr size_t O_WKV   = O_WQ    + (size_t)2 * 768 * 384 * 2;
constexpr size_t O_WBR   = O_WKV   + (size_t)2 * 1024 * 256 * 2;
constexpr size_t O_WO    = O_WBR   + (size_t)6 * 1024 * 512 * 2;
constexpr size_t O_CS    = O_WO    + (size_t)2 * 1024 * 1024 * 2;
constexpr size_t O_D256  = O_CS    + (size_t)256 * 128 * 2;
constexpr size_t O_D1024 = O_D256  + (size_t)256 * 512 * 2;
constexpr size_t O_S0T   = O_D1024 + (size_t)1024 * 2048 * 2;
constexpr size_t O_MOD   = O_S0T   + (size_t)64 * 128 * 64 * 2;
constexpr size_t O_H     = O_MOD   + (size_t)2 * 5 * 3072 * 4;
constexpr size_t O_BR8   = O_H;
constexpr size_t O_UT    = O_H     + (size_t)NTOK * 1024 * 2;
constexpr size_t O_RQ    = O_UT    + (size_t)NTOK * 1024 * 2;
constexpr size_t O_RK    = O_RQ    + (size_t)NTOK * 256 * 2;
constexpr size_t O_RKT   = O_RK    + (size_t)NTOK * 256 * 2;
constexpr size_t O_RVT   = O_RKT   + (size_t)NPR * 256 * 2;
constexpr size_t O_KVLAT = O_RVT   + (size_t)NTOK * 512 * 2;
constexpr size_t O_KR    = O_KVLAT + (size_t)NTOK * 256 * 4;
constexpr size_t O_R2END = O_KR    + (size_t)NTOK * 32 * 4;
constexpr size_t O_VT    = O_RQ;
static_assert(O_VT + (size_t)NKEY * 512 * 2 <= O_R2END, "alias overflow");
constexpr size_t O_RZ    = O_R2END;
constexpr size_t O_MZ    = O_RZ    + (size_t)NTOK * 512 * 2;
constexpr size_t O_FZ    = O_MZ    + (size_t)NTOK * 512 * 2;
constexpr size_t O_FU    = O_FZ    + (size_t)NTOK * 512 * 2;
constexpr size_t O_QLAT  = O_FU    + (size_t)NTOK * 512 * 2;
constexpr size_t O_CKVA  = O_QLAT  + (size_t)NTOK * 384 * 2;
constexpr size_t O_KB    = O_CKVA  + (size_t)NKEY * 256 * 2;
constexpr size_t O_KRA   = O_KB    + (size_t)NKEY * 512 * 2;
constexpr size_t O_QB    = O_KRA   + (size_t)NKEY * 32 * 2;
constexpr size_t O_H8    = O_QB    + (size_t)NTOK * 768 * 2;
constexpr size_t O_WG8   = O_H8    + (size_t)NTOK * 1024;
constexpr size_t O_WS8   = O_WG8   + (size_t)2 * 3072 * 1024;
constexpr size_t O_END   = O_WS8   + (size_t)2 * 1920 * 1024;
constexpr size_t O_ROPE  = (O_END + 255) & ~(size_t)255;
constexpr size_t O_BAR   = O_ROPE + 4096;
static_assert(O_BAR + 16384 <= (size_t)256 * 1024 * 1024, "workspace too large");

constexpr size_t OUT_CKV = (size_t)NTOK * 1024;
constexpr size_t OUT_KR  = OUT_CKV + (size_t)32 * 2 * 256 * 256;
constexpr size_t OUT_RET = OUT_KR + (size_t)32 * 2 * 256 * 32;

struct Params {
  const float *x_prompt, *x_sample, *cache_ckv, *cache_krope, *state_ret, *c, *c_ctx, *norm_g, *w_mod, *b_mod,
      *w_in, *ret_logit, *q_norm_g, *w_q_up, *kv_norm_g, *w_kv_up, *w_branch, *w_out, *final_g;
  float* out;
  char* ws;
};

constexpr int PANEL = 128 * 64;
constexpr int ABYTES = 2 * PANEL;
constexpr int STAGE = 2 * ABYTES;
constexpr int LDS_GEMM = 2 * STAGE;
constexpr int LDS_TOTAL = LDS_GEMM;
static_assert(LDS_TOTAL <= 65536, "static LDS");

typedef float f32x2 __attribute__((ext_vector_type(2)));
typedef __bf16 bf16x2v __attribute__((ext_vector_type(2)));
__device__ __forceinline__ unsigned pk2(float lo, float hi) { const f32x2 v = {lo, hi}; return __builtin_bit_cast(unsigned, __builtin_convertvector(v, bf16x2v)); }
__device__ __forceinline__ bf16_t tobf(float x) { return (bf16_t)(pk2(x, 0.f) & 0xffffu); }
typedef int v8i __attribute__((ext_vector_type(8)));
__device__ __forceinline__ float sat8(float x) { return __builtin_amdgcn_fmed3f(x, -448.f, 448.f); }
__device__ __forceinline__ unsigned pk4f8(float a, float b, float c, float d) { unsigned w = 0; a = sat8(a); b = sat8(b); c = sat8(c); d = sat8(d); w = __builtin_amdgcn_cvt_pk_fp8_f32(a, b, w, false); w = __builtin_amdgcn_cvt_pk_fp8_f32(c, d, w, true); return w; }
__device__ __forceinline__ float bflo(unsigned u) { return __uint_as_float(u << 16); }
__device__ __forceinline__ float bfhi(unsigned u) { return __uint_as_float(u & 0xffff0000u); }
__device__ __forceinline__ float ex2(float x) { return __builtin_amdgcn_exp2f(x); }
__device__ __forceinline__ float silu_f(float x) { return x / (1.f + __expf(-x)); }
__device__ __forceinline__ float sigm_f(float x) { return 1.f / (1.f + __expf(-x)); }
__device__ __forceinline__ u32x2 pk4(f32x4 v) { u32x2 r; r.x = pk2(v[0], v[1]); r.y = pk2(v[2], v[3]); return r; }
#define GAS __attribute__((address_space(1)))
#define LAS __attribute__((address_space(3)))
__device__ __forceinline__ u32x4 ldg16(const void* p) { return *(const GAS u32x4*)p; }
__device__ __forceinline__ int tidx() { int t = threadIdx.x; asm volatile("" : "+v"(t)); return t; }
__device__ __forceinline__ char* wsp(const char* w) { unsigned long long v = (unsigned long long)w; asm volatile("" : "+s"(v)); return (char*)v; }
__device__ __forceinline__ int swz(int r) { return (0 - ((r >> 2) & 3)) & 3; }
__device__ __forceinline__ float wave_sum(float v) {
#pragma unroll
  for (int o = 1; o < 64; o <<= 1) v += __shfl_xor(v, o);
  return v;
}
__device__ __forceinline__ f32x4 mfma16(bf16x8 a, bf16x8 b, f32x4 c) { return __builtin_amdgcn_mfma_f32_16x16x32_bf16(a, b, c, 0, 0, 0); }
__device__ __forceinline__ bf16x8 as_bf8(u32x4 v) { return __builtin_bit_cast(bf16x8, v); }

__device__ __forceinline__ void zero_acc(f32x4 (&acc)[4][4]) {
#pragma unroll
  for (int i = 0; i < 4; ++i)
#pragma unroll
    for (int j = 0; j < 4; ++j) acc[i][j] = (f32x4){0.f, 0.f, 0.f, 0.f};
}

template <bool SWAP, int NJ, int PIPE, bool F8>
__device__ __forceinline__ void gemm_bytes(const char* __restrict__ A, int lda, const char* __restrict__ B, int ldb, int Kb,
                                           f32x4 (&acc)[4][NJ], char* lds, int& par, bool primed,
                                           const char* nA, int nlda, const char* nB, int nldb) {
  const int tid = tidx(), lane = tid & 63, wm = (tid >> 6) >> 1, wn = (tid >> 6) & 1;
  const int wid = __builtin_amdgcn_readfirstlane(tid >> 6);
  const int fr = lane & 15, fq = lane >> 4;
  const int fa = (wm * 64 + fr) * 64 + ((fq ^ swz(fr)) << 4);
  const int fb = ABYTES + (wn * NJ * 16 + fr) * 64 + ((fq ^ swz(fr)) << 4);
  const int lrow = lane >> 2, lchunk = (lane & 3) ^ swz(lrow);
  constexpr int NBL = NJ / 2;
  const GAS char* gA = (const GAS char*)(A + (size_t)(wid * 32 + lrow) * lda + lchunk * 16);
  const GAS char* gB = (const GAS char*)(B + (size_t)(wid * NBL * 16 + lrow) * ldb + lchunk * 16);
  const size_t a16 = (size_t)16 * lda, b16 = (size_t)16 * ldb;
  LAS char* ldsA = (LAS char*)lds + wid * 2048;
  LAS char* ldsB = (LAS char*)lds + ABYTES + wid * NBL * 1024;
  const int nk = Kb >> 7;
#define GC_ISSUE(pa, pb, sa, sb, stage, kbyte) do { \
    _Pragma("unroll") for (int g = 0; g < 2; ++g) _Pragma("unroll") for (int pn = 0; pn < 2; ++pn) \
      __builtin_amdgcn_global_load_lds((const GAS unsigned*)((pa) + g * (sa) + (kbyte) + pn * 64), (LAS unsigned*)(ldsA + (stage) + pn * PANEL + g * 1024), 16, 0, 0); \
    _Pragma("unroll") for (int g = 0; g < NBL; ++g) _Pragma("unroll") for (int pn = 0; pn < 2; ++pn) \
      __builtin_amdgcn_global_load_lds((const GAS unsigned*)((pb) + g * (sb) + (kbyte) + pn * 64), (LAS unsigned*)(ldsB + (stage) + pn * PANEL + g * 1024), 16, 0, 0); \
  } while (0)
  if (!primed) {
    GC_ISSUE(gA, gB, a16, b16, par * STAGE, 0);
    asm volatile("s_waitcnt vmcnt(0)" ::: "memory");
    __syncthreads();
  }
#pragma unroll 1
  for (int kt = 0; kt < nk; ++kt) {
    char* cur = lds + par * STAGE;
    if (kt + 1 < nk) GC_ISSUE(gA, gB, a16, b16, (par ^ 1) * STAGE, (size_t)(kt + 1) * 128);
    else if (nA) {
      const GAS char* hA = (const GAS char*)(nA + (size_t)(wid * 32 + lrow) * nlda + lchunk * 16);
      const GAS char* hB = (const GAS char*)(nB + (size_t)(wid * NBL * 16 + lrow) * nldb + lchunk * 16);
      GC_ISSUE(hA, hB, (size_t)16 * nlda, (size_t)16 * nldb, (par ^ 1) * STAGE, 0);
    }
    __builtin_amdgcn_sched_barrier(0);
    if (F8) {
#pragma unroll
      for (int ih = 0; ih < 2; ++ih) {
        v8i av[2];
#pragma unroll
        for (int ii = 0; ii < 2; ++ii) {
          const u32x4 a0 = *(const u32x4*)(cur + fa + (ih * 2 + ii) * 1024), a1 = *(const u32x4*)(cur + PANEL + fa + (ih * 2 + ii) * 1024);
          av[ii] = (v8i){(int)a0.x, (int)a0.y, (int)a0.z, (int)a0.w, (int)a1.x, (int)a1.y, (int)a1.z, (int)a1.w};
        }
#pragma unroll
        for (int j = 0; j < NJ; ++j) {
          const u32x4 b0 = *(const u32x4*)(cur + fb + j * 1024), b1 = *(const u32x4*)(cur + PANEL + fb + j * 1024);
          const v8i bv = {(int)b0.x, (int)b0.y, (int)b0.z, (int)b0.w, (int)b1.x, (int)b1.y, (int)b1.z, (int)b1.w};
#pragma unroll
          for (int ii = 0; ii < 2; ++ii)
            acc[ih * 2 + ii][j] = SWAP ? __builtin_amdgcn_mfma_scale_f32_16x16x128_f8f6f4(bv, av[ii], acc[ih * 2 + ii][j], 0, 0, 0, 0x7f7f7f7f, 0, 0x7f7f7f7f)
                                       : __builtin_amdgcn_mfma_scale_f32_16x16x128_f8f6f4(av[ii], bv, acc[ih * 2 + ii][j], 0, 0, 0, 0x7f7f7f7f, 0, 0x7f7f7f7f);
        }
      }
    } else if (PIPE == 2) {
      bf16x8 af[2][4], bfr[NJ];
#pragma unroll
      for (int i = 0; i < 4; ++i) af[0][i] = *(const bf16x8*)(cur + fa + i * 1024);
#pragma unroll
      for (int j = 0; j < NJ; ++j) bfr[j] = *(const bf16x8*)(cur + fb + j * 1024);
#pragma unroll
      for (int i = 0; i < 4; ++i) af[1][i] = *(const bf16x8*)(cur + PANEL + fa + i * 1024);
      __builtin_amdgcn_sched_barrier(0);
#pragma unroll
      for (int i = 0; i < 4; ++i)
#pragma unroll
        for (int j = 0; j < NJ; ++j) acc[i][j] = SWAP ? mfma16(bfr[j], af[0][i], acc[i][j]) : mfma16(af[0][i], bfr[j], acc[i][j]);
#pragma unroll
      for (int j = 0; j < NJ; ++j) bfr[j] = *(const bf16x8*)(cur + PANEL + fb + j * 1024);
#pragma unroll
      for (int i = 0; i < 4; ++i)
#pragma unroll
        for (int j = 0; j < NJ; ++j) acc[i][j] = SWAP ? mfma16(bfr[j], af[1][i], acc[i][j]) : mfma16(af[1][i], bfr[j], acc[i][j]);
    } else if (PIPE == 1) {
      bf16x8 af[2][4], bfr[2][NJ];
#pragma unroll
      for (int ks = 0; ks < 2; ++ks) {
#pragma unroll
        for (int i = 0; i < 4; ++i) af[ks][i] = *(const bf16x8*)(cur + ks * PANEL + fa + i * 1024);
#pragma unroll
        for (int j = 0; j < NJ; ++j) bfr[ks][j] = *(const bf16x8*)(cur + ks * PANEL + fb + j * 1024);
      }
      __builtin_amdgcn_sched_barrier(0);
#pragma unroll
      for (int ks = 0; ks < 2; ++ks)
#pragma unroll
        for (int i = 0; i < 4; ++i)
#pragma unroll
          for (int j = 0; j < NJ; ++j) acc[i][j] = SWAP ? mfma16(bfr[ks][j], af[ks][i], acc[i][j]) : mfma16(af[ks][i], bfr[ks][j], acc[i][j]);
    } else {
#pragma unroll
      for (int ks = 0; ks < 2; ++ks) {
        bf16x8 af[4], bfr[NJ];
#pragma unroll
        for (int i = 0; i < 4; ++i) af[i] = *(const bf16x8*)(cur + ks * PANEL + fa + i * 1024);
#pragma unroll
        for (int j = 0; j < NJ; ++j) bfr[j] = *(const bf16x8*)(cur + ks * PANEL + fb + j * 1024);
#pragma unroll
        for (int i = 0; i < 4; ++i)
#pragma unroll
          for (int j = 0; j < NJ; ++j) acc[i][j] = SWAP ? mfma16(bfr[j], af[i], acc[i][j]) : mfma16(af[i], bfr[j], acc[i][j]);
      }
    }
    __builtin_amdgcn_sched_barrier(0);
    asm volatile("s_waitcnt vmcnt(0)" ::: "memory");
    __syncthreads();
    par ^= 1;
  }
#undef GC_ISSUE
}
template <bool SWAP, int NJ = 4, int PIPE = 1>
__device__ __forceinline__ void gemm_core(const bf16_t* __restrict__ A, int lda, const bf16_t* __restrict__ B, int ldb, int K,
                                          f32x4 (&acc)[4][NJ], char* lds, int& par, bool primed,
                                          const bf16_t* nA, int nlda, const bf16_t* nB, int nldb) {
  gemm_bytes<SWAP, NJ, PIPE, false>((const char*)A, lda * 2, (const char*)B, ldb * 2, K * 2, acc, lds, par, primed, (const char*)nA, nlda * 2, (const char*)nB, nldb * 2);
}
template <bool SWAP, int NJ = 4>
__device__ __forceinline__ void gemm_core(const bf16_t* __restrict__ A, int lda, const bf16_t* __restrict__ B, int ldb, int K,
                                          f32x4 (&acc)[4][NJ], char* lds) {
  int par = 0;
  gemm_core<SWAP, NJ>(A, lda, B, ldb, K, acc, lds, par, false, nullptr, 0, nullptr, 0);
}

__device__ __forceinline__ void tr_tile(const float* __restrict__ src, int lds_, int k0, int ns0, bf16_t* __restrict__ dst, int ldd, int nd0,
                                        const float* __restrict__ ksc, char* lds) {
  bf16_t* T = (bf16_t*)lds;
  const int tid = tidx();
  __syncthreads();
#pragma unroll
  for (int i = 0; i < 2; ++i) {
    const int kk = (tid >> 3) + 32 * i, nn4 = (tid & 7) * 4;
    const f32x4 v = *(const f32x4*)(src + (size_t)(k0 + kk) * lds_ + ns0 + nn4);
    const float s = ksc ? ksc[k0 + kk] : 1.f;
#pragma unroll
    for (int e = 0; e < 4; ++e) T[(nn4 + e) * 72 + kk] = tobf(v[e] * s);
  }
  __syncthreads();
  const int nn = tid >> 3, kc = (tid & 7) * 8;
  const u32x4 w = *(const u32x4*)(T + nn * 72 + kc);
  *(u32x4*)(dst + (size_t)(nd0 + nn) * ldd + k0 + kc) = w;
}

__device__ __forceinline__ void tr_tile2(const float* __restrict__ src, int lds_, int k0, int ns0, bf16_t* __restrict__ dst, int ldd, int nd0,
                                         const float* __restrict__ ksc, char* lds, unsigned char* dst8 = nullptr, int ld8 = 1024) {
  bf16_t* T = (bf16_t*)lds;
  unsigned char* T8 = (unsigned char*)lds + 8704;
  const int tid = tidx();
  __syncthreads();
  f32x4 v[4];
#pragma unroll
  for (int i = 0; i < 4; ++i) v[i] = *(const GAS f32x4*)(src + (size_t)(k0 + (tid >> 3) + 32 * i) * lds_ + ns0 + (tid & 7) * 4);
#pragma unroll
  for (int i = 0; i < 4; ++i) {
    const int kk = (tid >> 3) + 32 * i, nn4 = (tid & 7) * 4;
    const float sc = ksc ? ksc[k0 + kk] : 1.f;
#pragma unroll
    for (int e = 0; e < 4; ++e) T[(nn4 + e) * 136 + kk] = tobf(v[i][e] * sc);
    if (dst8) {
#pragma unroll
      for (int e = 0; e < 4; ++e) T8[(nn4 + e) * 144 + kk] = (unsigned char)(__builtin_amdgcn_cvt_pk_fp8_f32(sat8(v[i][e] * sc * 32.f), 0.f, 0, false) & 0xff);
    }
  }
  __syncthreads();
  const int nn = tid >> 3, kc = (tid & 7) * 16;
  if (dst8) *(u32x4*)(dst8 + (size_t)nn * ld8 + k0 + kc) = *(const u32x4*)(T8 + nn * 144 + kc);
  if (!dst) return;
  const u32x4 w0 = *(const u32x4*)(T + nn * 136 + kc), w1 = *(const u32x4*)(T + nn * 136 + kc + 8);
  bf16_t* d = dst + (size_t)(nd0 + nn) * ldd + k0 + kc;
  *(u32x4*)d = w0; *(u32x4*)(d + 8) = w1;
}

constexpr int P0_GEMV = 192, P0_WIN = 3408, P0_WQ = 144, P0_WKV = 128, P0_WBR = 768, P0_WO = 512, P0_S0 = 256, P0_PAD = 96, P0_TAB = 1105;
constexpr int P0_N = P0_GEMV + P0_WIN + P0_WQ + P0_WKV + P0_WBR + P0_WO + P0_S0 + P0_PAD + P0_TAB;

__device__ __forceinline__ void phase0_item(const Params& p, int j, char* lds) {
  const int tid = tidx();
  char* ws = wsp(p.ws);
  if (j < P0_GEMV) {
    const int l = j / 96, cgi = j % 96;
    float* sv = (float*)lds;
    float* red = (float*)(lds + 20480);
    __syncthreads();
    for (int i = tid; i < 5120; i += 256) { const int v = i >> 10, k = i & 1023; const float x = (v == 0) ? p.c_ctx[k] : p.c[(v - 1) * 1024 + k]; sv[i] = silu_f(x); }
    __syncthreads();
    const int c4 = tid & 7, kg = tid >> 3;
    const float* w = p.w_mod + (size_t)l * 1024 * 3072 + cgi * 32 + c4 * 4;
    f32x4 a0 = {0.f, 0.f, 0.f, 0.f}, a1 = a0, a2 = a0, a3 = a0, a4 = a0;
#pragma unroll 8
    for (int k = kg * 32; k < kg * 32 + 32; ++k) {
      const f32x4 wv = *(const GAS f32x4*)(w + (size_t)k * 3072);
      a0 += wv * sv[k]; a1 += wv * sv[1024 + k]; a2 += wv * sv[2048 + k]; a3 += wv * sv[3072 + k]; a4 += wv * sv[4096 + k];
    }
    *(f32x4*)(red + (kg * 5 + 0) * 32 + c4 * 4) = a0; *(f32x4*)(red + (kg * 5 + 1) * 32 + c4 * 4) = a1; *(f32x4*)(red + (kg * 5 + 2) * 32 + c4 * 4) = a2;
    *(f32x4*)(red + (kg * 5 + 3) * 32 + c4 * 4) = a3; *(f32x4*)(red + (kg * 5 + 4) * 32 + c4 * 4) = a4;
    __syncthreads();
    if (tid < 160) {
      const int v = tid >> 5, c2 = tid & 31;
      float sm = p.b_mod[l * 3072 + cgi * 32 + c2];
#pragma unroll 8
      for (int g = 0; g < 32; ++g) sm += red[(g * 5 + v) * 32 + c2];
      ((float*)(ws + O_MOD))[(l * 5 + v) * 3072 + cgi * 32 + c2] = sm;
    }
    return;
  }
  j -= P0_GEMV;
  if (j < P0_WIN) {
    const int l = j / 1704, r = j % 1704, kt = r / 213, nt = r % 213, c0 = nt * 32;
    const int nd0 = c0 < 2176 ? c0 : (c0 < 2208 ? 3712 + (c0 - 2176) : (c0 < 3744 ? c0 - 32 : c0 + 96));
    tr_tile2(p.w_in + (size_t)l * 1024 * 6816, 6816, kt * 128, c0, (bf16_t*)(ws + O_WIN) + (size_t)l * 6912 * 1024, 1024, nd0, nullptr, lds,
             nd0 >= 3840 ? (unsigned char*)(ws + O_WG8) + ((size_t)l * 3072 + (nd0 - 3840)) * 1024
             : nd0 < 1024 ? (unsigned char*)(ws + O_WS8) + ((size_t)l * 1920 + nd0) * 1024
             : (nd0 >= 1536 && nd0 < 1920) ? (unsigned char*)(ws + O_WS8) + ((size_t)l * 1920 + 1024 + (nd0 - 1536)) * 1024
             : (nd0 >= 2688 && nd0 < 3200) ? (unsigned char*)(ws + O_WS8) + ((size_t)l * 1920 + 1408 + (nd0 - 2688)) * 1024 : nullptr);
    return;
  }
  j -= P0_WIN;
  if (j < P0_WQ) {
    const int l = j / 72, r = j % 72, kt = r / 24, nt = r % 24;
    tr_tile2(p.w_q_up + (size_t)l * 384 * 768, 768, kt * 128, nt * 32, nullptr, 384, nt * 32, p.q_norm_g + l * 384, lds,
             (unsigned char*)(ws + O_WQ) + ((size_t)l * 768 + nt * 32) * 384, 384);
    return;
  }
  j -= P0_WQ;
  if (j < P0_WKV) {
    const int l = j / 64, r = j % 64, kt = r / 32, nt = r % 32, c0 = nt * 32, h = c0 >> 7, e = c0 & 127;
    const int nd0 = e < 64 ? h * 64 + e : 512 + h * 64 + (e - 64);
    tr_tile2(p.w_kv_up + (size_t)l * 256 * 1024, 1024, kt * 128, c0, nullptr, 256, nd0, nullptr, lds,
             (unsigned char*)(ws + O_WKV) + ((size_t)l * 1024 + nd0) * 256, 256);
    return;
  }
  j -= P0_WKV;
  if (j < P0_WBR) {
    const int mat = j / 128, r = j % 128, kt = r / 32, nt = r % 32;
    tr_tile2(p.w_branch + (size_t)mat * 512 * 1024, 1024, kt * 128, nt * 32, nullptr, 512, nt * 32, nullptr, lds,
             (unsigned char*)(ws + O_WBR) + ((size_t)mat * 1024 + nt * 32) * 512, 512);
    return;
  }
  j -= P0_WBR;
  if (j < P0_WO) {
    const int l = j / 256, r = j % 256, kt = r / 32, nt = r % 32;
    tr_tile2(p.w_out + (size_t)l * 1024 * 1024, 1024, kt * 128, nt * 32, nullptr, 1024, nt * 32, nullptr, lds,
             (unsigned char*)(ws + O_WO) + ((size_t)l * 1024 + nt * 32) * 1024, 1024);
    return;
  }
  j -= P0_WO;
  if (j < P0_S0) {
    const int mat = j >> 2, nt = j & 3;
    tr_tile(p.state_ret + (size_t)mat * 64 * 128, 128, 0, nt * 32, (bf16_t*)(ws + O_S0T) + (size_t)mat * 128 * 64, 64, nt * 32, nullptr, lds);
    return;
  }
  j -= P0_S0;
  if (j < P0_PAD) {
    const int l = j / 48, r = j % 48;
    bf16_t* d = (bf16_t*)(ws + O_WIN) + ((size_t)l * 6912 + 3744) * 1024 + (size_t)r * 2048 + tid * 8;
    *(u32x4*)d = (u32x4){0u, 0u, 0u, 0u};
    return;
  }
  j -= P0_PAD;
  {
    float v[8];
    bf16_t* dst = nullptr; unsigned char* dst8 = nullptr;
    if (j == 1104) {
      float* rt = (float*)(ws + O_ROPE);
#pragma unroll
      for (int q = 0; q < 2; ++q) {
        const int idx = tid * 2 + q, pos = idx >> 3, f = idx & 7;
        const float ang = (float)pos * exp2f(-(float)f * 1.66096404744f);
        rt[idx * 2] = cosf(ang); rt[idx * 2 + 1] = sinf(ang);
      }
      return;
    }
    if (j < 16) {
      const int e0 = j * 2048 + tid * 8; dst = (bf16_t*)(ws + O_CS) + e0;
      const int n = e0 >> 7, k = e0 & 127;
#pragma unroll
      for (int e = 0; e < 8; ++e) {
        const float fr = (float)(((n & 127) * (k + e)) & 127) * (1.f / 128.f);
        v[e] = (n < 128) ? __builtin_amdgcn_cosf(fr) : __builtin_amdgcn_sinf(fr);
      }
    } else if (j < 80) {
      const int e0 = (j - 16) * 2048 + tid * 8; dst8 = (unsigned char*)(ws + O_D256) + e0;
      const int k1 = e0 >> 9, kk = e0 & 511;
#pragma unroll
      for (int e = 0; e < 8; ++e) {
        const int t = (kk + e) & 255;
        const float fr = (float)((k1 * t) & 255) * (1.f / 256.f);
        v[e] = (kk < 256) ? __builtin_amdgcn_cosf(fr) : -__builtin_amdgcn_sinf(fr);
      }
    } else {
      const int e0 = (j - 80) * 2048 + tid * 8; dst8 = (unsigned char*)(ws + O_D1024) + e0;
      const int k1 = e0 >> 11, kk = e0 & 2047;
#pragma unroll
      for (int e = 0; e < 8; ++e) {
        const int t = (kk + e) & 1023;
        const float fr = (float)((k1 * t) & 1023) * (1.f / 1024.f);
        v[e] = (kk < 1024) ? __builtin_amdgcn_cosf(fr) : -__builtin_amdgcn_sinf(fr);
      }
    }
    if (dst8) {
      u32x2 w8; w8.x = pk4f8(v[0] * 64.f, v[1] * 64.f, v[2] * 64.f, v[3] * 64.f); w8.y = pk4f8(v[4] * 64.f, v[5] * 64.f, v[6] * 64.f, v[7] * 64.f);
      *(u32x2*)dst8 = w8;
    } else {
      u32x4 w; w.x = pk2(v[0], v[1]); w.y = pk2(v[2], v[3]); w.z = pk2(v[4], v[5]); w.w = pk2(v[6], v[7]);
      *(u32x4*)dst = w;
    }
  }
}

__device__ __forceinline__ void norm_item(const Params& p, int l, int item, const float* xp, const float* xs) {
  const int tid = tidx(), lane = tid & 63, wid = tid >> 6;
  bf16_t* H = (bf16_t*)(p.ws + O_H);
#pragma unroll 3
  for (int i = 0; i < 6; ++i) {
    const int row = item * 24 + wid * 6 + i;
    const float* src = row < NPR ? xp + (size_t)row * 1024 : xs + (size_t)(row - NPR) * 1024;
    const int v = row < NPR ? 0 : 1 + ((row - NPR) >> 10);
    const float* mod = (const float*)(p.ws + O_MOD) + (l * 5 + v) * 3072;
    f32x4 x[4]; float ss = 0.f;
#pragma unroll
    for (int q = 0; q < 4; ++q) { x[q] = *(const f32x4*)(src + (q * 64 + lane) * 4); ss += x[q][0] * x[q][0] + x[q][1] * x[q][1] + x[q][2] * x[q][2] + x[q][3] * x[q][3]; }
    ss = wave_sum(ss);
    const float rstd = rsqrtf(ss * (1.f / 1024.f) + EPSN);
#pragma unroll
    for (int q = 0; q < 4; ++q) {
      const int col = (q * 64 + lane) * 4;
      const f32x4 g = *(const f32x4*)(p.norm_g + l * 1024 + col), sc = *(const f32x4*)(mod + 1024 + col), sh = *(const f32x4*)(mod + col);
      f32x4 h;
#pragma unroll
      for (int e = 0; e < 4; ++e) h[e] = x[q][e] * rstd * g[e] * (1.f + sc[e]) + sh[e];
      *(u32x2*)(H + (size_t)row * 1024 + col) = pk4(h);
      *(unsigned*)(p.ws + O_H8 + (size_t)row * 1024 + col) = pk4f8(h[0], h[1], h[2], h[3]);
    }
  }
}
__device__ __forceinline__ void final_item(const Params& p, int item) {
  const int tid = tidx(), lane = tid & 63, wid = tid >> 6;
#pragma unroll 3
  for (int i = 0; i < 6; ++i) {
    const int row = item * 24 + wid * 6 + i;
    float* src = p.out + (size_t)row * 1024;
    f32x4 x[4]; float ss = 0.f;
#pragma unroll
    for (int q = 0; q < 4; ++q) { x[q] = *(const f32x4*)(src + (q * 64 + lane) * 4); ss += x[q][0] * x[q][0] + x[q][1] * x[q][1] + x[q][2] * x[q][2] + x[q][3] * x[q][3]; }
    ss = wave_sum(ss);
    const float rstd = rsqrtf(ss * (1.f / 1024.f) + EPSN);
#pragma unroll
    for (int q = 0; q < 4; ++q) {
      const int col = (q * 64 + lane) * 4;
      const f32x4 g = *(const f32x4*)(p.final_g + col);
      f32x4 y;
#pragma unroll
      for (int e = 0; e < 4; ++e) y[e] = x[q][e] * rstd * g[e];
      *(f32x4*)(src + col) = y;
    }
  }
}

__device__ __forceinline__ void s2_tile(const Params& p, int l, int tile, char* lds) {
  const int tid = tidx(), lane = tid & 63, wid = tid >> 6, wm = wid >> 1, wn = wid & 1, fr = lane & 15, fq = lane >> 4;
  const int m = (tile / 480) * 16 + (tile % 16), nt = (tile % 480) / 16, m0 = m * 128, n0 = nt * 128;
  char* ws = wsp(p.ws);
  const bf16_t* A = (const bf16_t*)(ws + O_H) + (size_t)m0 * 1024;
  const bf16_t* B = (const bf16_t*)(ws + O_WIN) + ((size_t)l * 6912 + n0) * 1024;
  const bool f8 = (nt >= 12 && nt < 15) || (nt >= 21 && nt < 25);
  const int row8 = nt < 8 ? nt * 128 : (nt < 15 ? 1024 + (nt - 12) * 128 : 1408 + (nt - 21) * 128);
  const char* A8 = (const char*)(ws + O_H8) + (size_t)m0 * 1024;
  const char* B8 = (const char*)(ws + O_WS8) + ((size_t)l * 1920 + row8) * 1024;
  const float s8 = f8 ? 0.03125f : 1.f;
  f32x4 acc[4][4];
  zero_acc(acc);
  if (nt >= 4 && nt < 8) {
    gemm_core<false>(A, 1024, B, 1024, 1024, acc, lds);
    bf16_t* RVT = (bf16_t*)(ws + O_RVT);
#pragma unroll
    for (int i = 0; i < 4; ++i) {
      const int tok = m0 + wm * 64 + i * 16 + fq * 4;
      size_t base; int T, b, t;
      if (tok < NPR) { b = tok >> 8; t = tok & 255; T = 256; base = 0; } else { const int s = tok - NPR; b = s >> 10; t = s & 1023; T = 1024; base = (size_t)NPR * 512; }
#pragma unroll
      for (int j = 0; j < 4; ++j) {
        const int c = n0 - 512 + wn * 64 + j * 16 + fr, h = c >> 7, vd = c & 127;
        *(u32x2*)(RVT + base + ((size_t)(b * 4 + h) * 128 + vd) * T + t) = pk4(acc[i][j]);
      }
    }
    return;
  }
  if (f8) { int par = 0; gemm_bytes<true, 4, 1, true>(A8, 1024, B8, 1024, 1024, acc, lds, par, false, nullptr, 0, nullptr, 0); }
  else gemm_core<true>(A, 1024, B, 1024, 1024, acc, lds);
  bf16_t* dst = nullptr; int ld = 0, c0 = 0, op = 0;
  if (nt < 2) { dst = (bf16_t*)(ws + O_RQ); ld = 256; c0 = 0; }
  else if (nt < 4) { dst = (bf16_t*)(ws + O_RK); ld = 256; c0 = 256; op = 2; }
  else if (nt < 12) { dst = (bf16_t*)(ws + O_RZ); ld = 512; c0 = 1024; op = 1; }
  else if (nt < 15) { ld = 384; c0 = 1536; op = 5; }
  else if (nt < 17) { ld = 256; c0 = 1920; op = 3; }
  else if (nt < 21) { dst = (bf16_t*)(ws + O_MZ); ld = 512; c0 = 2176; op = 1; }
  else if (nt < 25) { dst = (bf16_t*)(ws + O_FU); ld = 512; c0 = 2688; }
  else if (nt < 29) { dst = (bf16_t*)(ws + O_FZ); ld = 512; c0 = 3200; op = 1; }
  else { ld = 32; c0 = 3712; op = 4; }
#pragma unroll
  for (int i = 0; i < 4; ++i) {
    const int tok = m0 + wm * 64 + i * 16 + fr;
#pragma unroll
    for (int j = 0; j < 4; ++j) {
      const int col = n0 - c0 + wn * 64 + j * 16 + fq * 4;
      f32x4 v = acc[i][j] * s8;
      if (op == 3) { *(f32x4*)((float*)(ws + O_KVLAT) + (size_t)tok * 256 + col) = v; continue; }
      if (op == 5) { *(unsigned*)(ws + O_QLAT + (size_t)tok * 384 + col) = pk4f8(v[0] * 8.f, v[1] * 8.f, v[2] * 8.f, v[3] * 8.f); continue; }
      if (op == 4) { if (col < 32) *(f32x4*)((float*)(ws + O_KR) + (size_t)tok * 32 + col) = v; continue; }
      if (op == 1) {
#pragma unroll
        for (int e = 0; e < 4; ++e) v[e] = silu_f(v[e]);
      } else if (op == 2) {
#pragma unroll
        for (int e = 0; e < 4; ++e) v[e] *= 0.125f;
      }
      const u32x2 w = pk4(v);
      *(u32x2*)(dst + (size_t)tok * ld + col) = w;
      if (op == 2 && tok < NPR) {
        bf16_t* RKT = (bf16_t*)(ws + O_RKT);
        const int b = tok >> 8, t = tok & 255, h = col >> 6, dk = col & 63;
        bf16_t* q = RKT + ((size_t)(b * 4 + h) * 64 + dk) * 256 + t;
        q[0] = (bf16_t)(w.x & 0xffffu); q[256] = (bf16_t)(w.x >> 16); q[512] = (bf16_t)(w.y & 0xffffu); q[768] = (bf16_t)(w.y >> 16);
      }
    }
  }
}

template <int MODE>
__device__ __forceinline__ void attn_item(const Params& p, int l, int item, char* lds) {
  constexpr int NKP = MODE == 0 ? 3 : 2;
  constexpr int NVB = MODE == 0 ? 4 : 8;
  constexpr int PV = NVB * 16 * 64;
  constexpr int KOFF = NKP * 4096;
  constexpr int BUF = KOFF + 2 * PV;
  const int tid = tidx(), lane = tid & 63, wid = tid >> 6, fr = lane & 15, fq = lane >> 4;
  char* ws = wsp(p.ws);
  int smp, b, h, qblk, T, Tk, tok0;
  const bf16_t *kbase, *rbase = nullptr, *vbase, *qbase;
  int kstride, qstride;
  if (MODE == 0) {
    if (item < 256) { smp = 1; b = item >> 6; h = (item >> 3) & 7; qblk = item & 7; T = 1024; Tk = 1536; tok0 = NPR + b * 1024 + qblk * 128; }
    else { const int it = item - 256; smp = 0; b = it >> 4; h = (it >> 1) & 7; qblk = it & 1; T = 256; Tk = 256; tok0 = b * 256 + qblk * 128; }
    const int keyrow0 = smp ? NPR + b * 1536 : b * 256;
    kbase = (const bf16_t*)(ws + O_KB) + (size_t)keyrow0 * 512 + h * 64; kstride = 512;
    rbase = (const bf16_t*)(ws + O_KRA) + (size_t)keyrow0 * 32;
    vbase = (const bf16_t*)(ws + O_VT) + (smp ? (size_t)NPR * 512 + (size_t)(b * 8 + h) * 64 * 1536 : (size_t)(b * 8 + h) * 64 * 256);
    qbase = (const bf16_t*)(ws + O_QB) + (size_t)tok0 * 768 + h * 96; qstride = 768;
  } else {
    if (item < 128) { smp = 1; b = item >> 5; h = (item >> 3) & 3; qblk = item & 7; T = 1024; tok0 = NPR + b * 1024 + qblk * 128; }
    else { const int it = item - 128; smp = 0; b = it >> 3; h = (it >> 1) & 3; qblk = it & 1; T = 256; tok0 = b * 256 + qblk * 128; }
    Tk = T;
    const int ktok0 = smp ? NPR + b * 1024 : b * 256;
    kbase = (const bf16_t*)(ws + O_RK) + (size_t)ktok0 * 256 + h * 64; kstride = 256;
    vbase = (const bf16_t*)(ws + O_RVT) + (smp ? (size_t)NPR * 512 + (size_t)(b * 4 + h) * 128 * 1024 : (size_t)(b * 4 + h) * 128 * 256);
    qbase = (const bf16_t*)(ws + O_RQ) + (size_t)tok0 * 256 + h * 64; qstride = 256;
  }
  const int nkt = Tk >> 6;
  bf16x8 qf[2][NKP];
#pragma unroll
  for (int qb = 0; qb < 2; ++qb)
#pragma unroll
    for (int ks = 0; ks < NKP; ++ks) qf[qb][ks] = *(const bf16x8*)(qbase + (size_t)(wid * 32 + qb * 16 + fr) * qstride + ks * 32 + fq * 8);
  f32x4 o[NVB][2];
#pragma unroll
  for (int vb = 0; vb < NVB; ++vb) { o[vb][0] = (f32x4){0.f, 0.f, 0.f, 0.f}; o[vb][1] = (f32x4){0.f, 0.f, 0.f, 0.f}; }
  float lgf = 0.f, lgb = 0.f;
  float mrow[2] = {-INFINITY, -INFINITY}, lrow[2] = {0.f, 0.f};
  const int tq0 = qblk * 128 + wid * 32 + fr;
  if (MODE == 1) {
    const float xf = p.ret_logit[(l * 2 + 0) * 4 + h], xb = p.ret_logit[(l * 2 + 1) * 4 + h];
    lgf = -log1pf(expf(-xf)) * 1.44269504089f; lgb = -log1pf(expf(-xb)) * 1.44269504089f;
    if (smp) {
      const bf16_t* s0 = (const bf16_t*)(ws + O_S0T);
#pragma unroll
      for (int dir = 0; dir < 2; ++dir) {
        const bf16_t* sb = s0 + ((size_t)(((b * 2 + l) * 2 + dir) * 4 + h) * 128) * 64;
        float dec[2];
#pragma unroll
        for (int qb = 0; qb < 2; ++qb) { const int tq = tq0 + qb * 16; dec[qb] = dir == 0 ? ex2((float)(tq + 1) * lgf) : ex2((float)(T - tq) * lgb); }
#pragma unroll
        for (int vb = 0; vb < NVB; ++vb) {
          f32x4 t0 = (f32x4){0.f, 0.f, 0.f, 0.f}, t1 = (f32x4){0.f, 0.f, 0.f, 0.f};
#pragma unroll
          for (int ks = 0; ks < 2; ++ks) {
            const bf16x8 sf = *(const bf16x8*)(sb + (size_t)(vb * 16 + fr) * 64 + ks * 32 + fq * 8);
            t0 = mfma16(sf, qf[0][ks], t0); t1 = mfma16(sf, qf[1][ks], t1);
          }
          o[vb][0] += t0 * dec[0]; o[vb][1] += t1 * dec[1];
        }
      }
    }
  }
  u32x4 vreg[NVB / 2];
  const int uw = __builtin_amdgcn_readfirstlane(wid);
  const int dkey = lane >> 2, dchunk = (lane & 3) ^ swz(dkey);
  auto kdma = [&](int kt, char* buf) {
    const GAS bf16_t* kp = (const GAS bf16_t*)kbase + (size_t)(kt * 64 + uw * 16 + dkey) * kstride + dchunk * 8;
#pragma unroll
    for (int pn = 0; pn < 2; ++pn)
      __builtin_amdgcn_global_load_lds((const GAS unsigned*)(kp + pn * 32), (LAS unsigned*)((LAS char*)buf + pn * 4096 + uw * 1024), 16, 0, 0);
    if (MODE == 0) {
      const GAS bf16_t* rp = (const GAS bf16_t*)rbase + (size_t)(kt * 64 + uw * 16 + dkey) * 32 + dchunk * 8;
      __builtin_amdgcn_global_load_lds((const GAS unsigned*)rp, (LAS unsigned*)((LAS char*)buf + 2 * 4096 + uw * 1024), 16, 0, 0);
    }
  };
  auto gload = [&](int kt) {
#pragma unroll
    for (int i = 0; i < NVB / 2; ++i) { const int idx = tid + 256 * i, vd = idx >> 3, g = idx & 7; vreg[i] = ldg16(vbase + (size_t)vd * Tk + kt * 64 + g * 8); }
  };
  auto lstore = [&](char* buf) {
#pragma unroll
    for (int i = 0; i < NVB / 2; ++i) {
      const int idx = tid + 256 * i, vd = idx >> 3, g = idx & 7, pnl = g >> 2, g4 = g & 3, hi = g4 >> 1, q0 = 2 * (g4 & 1);
      char* base = buf + KOFF + pnl * PV + vd * 64 + hi * 8;
      *(u32x2*)(base + ((q0 ^ swz(vd)) << 4)) = (u32x2){vreg[i].x, vreg[i].y};
      *(u32x2*)(base + (((q0 + 1) ^ swz(vd)) << 4)) = (u32x2){vreg[i].z, vreg[i].w};
    }
  };
  __syncthreads();
  kdma(0, lds); gload(0); lstore(lds);
  asm volatile("s_waitcnt vmcnt(0)" ::: "memory");
  __syncthreads();
  const int foff = fr * 64 + ((fq ^ swz(fr)) << 4);
  for (int kt = 0; kt < nkt; ++kt) {
    char* cur = lds + (kt & 1) * BUF;
    const bool more = (kt + 1) < nkt;
    if (more) { kdma(kt + 1, lds + ((kt + 1) & 1) * BUF); gload(kt + 1); }
    __builtin_amdgcn_sched_barrier(0);
    f32x4 s[4][2];
#pragma unroll
    for (int kb = 0; kb < 4; ++kb) {
      s[kb][0] = (f32x4){0.f, 0.f, 0.f, 0.f}; s[kb][1] = (f32x4){0.f, 0.f, 0.f, 0.f};
#pragma unroll
      for (int ks = 0; ks < NKP; ++ks) {
        const bf16x8 kf = *(const bf16x8*)(cur + ks * 4096 + kb * 1024 + foff);
        s[kb][0] = mfma16(kf, qf[0][ks], s[kb][0]); s[kb][1] = mfma16(kf, qf[1][ks], s[kb][1]);
      }
    }
    bf16x8 pf[2][2];
#pragma unroll
    for (int qb = 0; qb < 2; ++qb) {
      if (MODE == 0) {
        float mx = s[0][qb][0];
#pragma unroll
        for (int kb = 0; kb < 4; ++kb)
#pragma unroll
          for (int r = 0; r < 4; ++r) mx = fmaxf(mx, s[kb][qb][r]);
        mx = fmaxf(mx, __shfl_xor(mx, 16)); mx = fmaxf(mx, __shfl_xor(mx, 32));
        const float mn = fmaxf(mrow[qb], mx), alpha = ex2(mrow[qb] - mn);
        mrow[qb] = mn;
        float ls = 0.f;
#pragma unroll
        for (int kb = 0; kb < 4; ++kb)
#pragma unroll
          for (int r = 0; r < 4; ++r) { const float e = ex2(s[kb][qb][r] - mn); s[kb][qb][r] = e; ls += e; }
        lrow[qb] = lrow[qb] * alpha + ls;
#pragma unroll
        for (int vb = 0; vb < NVB; ++vb) o[vb][qb] *= alpha;
      } else {
        const int tq = tq0 + qb * 16;
#pragma unroll
        for (int kb = 0; kb < 4; ++kb)
#pragma unroll
          for (int r = 0; r < 4; ++r) {
            const int d = tq - (kt * 64 + kb * 16 + fq * 4 + r);
            const float dec = d > 0 ? ex2((float)d * lgf) : (d < 0 ? ex2((float)(-d) * lgb) : 2.f);
            s[kb][qb][r] *= dec;
          }
      }
#pragma unroll
      for (int g = 0; g < 2; ++g) {
        u32x4 w; w.x = pk2(s[2 * g][qb][0], s[2 * g][qb][1]); w.y = pk2(s[2 * g][qb][2], s[2 * g][qb][3]);
        w.z = pk2(s[2 * g + 1][qb][0], s[2 * g + 1][qb][1]); w.w = pk2(s[2 * g + 1][qb][2], s[2 * g + 1][qb][3]);
        pf[qb][g] = as_bf8(w);
      }
    }
#pragma unroll
    for (int vb = 0; vb < NVB; ++vb)
#pragma unroll
      for (int g = 0; g < 2; ++g) {
        const bf16x8 vf = *(const bf16x8*)(cur + KOFF + g * PV + vb * 1024 + foff);
        o[vb][0] = mfma16(vf, pf[0][g], o[vb][0]); o[vb][1] = mfma16(vf, pf[1][g], o[vb][1]);
      }
    __builtin_amdgcn_sched_barrier(0);
    if (more) lstore(lds + ((kt + 1) & 1) * BUF);
    asm volatile("s_waitcnt vmcnt(0)" ::: "memory");
    __syncthreads();
  }
  bf16_t* G = (bf16_t*)(ws + (MODE == 0 ? O_MZ : O_RZ));
#pragma unroll
  for (int qb = 0; qb < 2; ++qb) {
    const int tok = tok0 + wid * 32 + qb * 16 + fr;
    float mul, sub;
    if (MODE == 0) {
      float lt = lrow[qb]; lt += __shfl_xor(lt, 16); lt += __shfl_xor(lt, 32);
      mul = 1.f / lt; sub = 0.f;
    } else {
      float sm = 0.f;
#pragma unroll
      for (int vb = 0; vb < NVB; ++vb) sm += (o[vb][qb][0] + o[vb][qb][1]) + (o[vb][qb][2] + o[vb][qb][3]);
      sm += __shfl_xor(sm, 16); sm += __shfl_xor(sm, 32);
      const float mu = sm * (1.f / 128.f);
      float vs = 0.f;
#pragma unroll
      for (int vb = 0; vb < NVB; ++vb)
#pragma unroll
        for (int r = 0; r < 4; ++r) { const float dd = o[vb][qb][r] - mu; vs += dd * dd; }
      vs += __shfl_xor(vs, 16); vs += __shfl_xor(vs, 32);
      mul = rsqrtf(vs * (1.f / 128.f) + EPSN); sub = mu;
    }
#pragma unroll
    for (int vb = 0; vb < NVB; ++vb) {
      bf16_t* gp = G + (size_t)tok * 512 + h * (NVB * 16) + vb * 16 + fq * 4;
      const u32x2 gz = *(const u32x2*)gp;
      f32x4 y;
      y[0] = (o[vb][qb][0] - sub) * mul * bflo(gz.x); y[1] = (o[vb][qb][1] - sub) * mul * bfhi(gz.x);
      y[2] = (o[vb][qb][2] - sub) * mul * bflo(gz.y); y[3] = (o[vb][qb][3] - sub) * mul * bfhi(gz.y);
      *(unsigned*)(ws + O_BR8 + (size_t)(MODE == 0 ? 1 : 0) * NTOK * 512 + (size_t)tok * 512 + h * (NVB * 16) + vb * 16 + fq * 4) = pk4f8(y[0] * 8.f, y[1] * 8.f, y[2] * 8.f, y[3] * 8.f);
    }
  }
}

__device__ __forceinline__ bf16x8 scale8(u32x4 raw, const float (&d)[8]) {
  u32x4 w;
  w.x = pk2(bflo(raw.x) * d[0], bfhi(raw.x) * d[1]); w.y = pk2(bflo(raw.y) * d[2], bfhi(raw.y) * d[3]);
  w.z = pk2(bflo(raw.z) * d[4], bfhi(raw.z) * d[5]); w.w = pk2(bflo(raw.w) * d[6], bfhi(raw.w) * d[7]);
  return as_bf8(w);
}
__device__ __forceinline__ void state_item(const Params& p, int l, int item) {
  const int tid = tidx(), lane = tid & 63, wid = tid >> 6, fr = lane & 15, fq = lane >> 4;
  const int b = item >> 2, h = item & 3;
  const bf16_t* RVT = (const bf16_t*)(p.ws + O_RVT) + (size_t)(b * 4 + h) * 128 * 256;
  const bf16_t* RKT = (const bf16_t*)(p.ws + O_RKT) + (size_t)(b * 4 + h) * 64 * 256;
  const float xf = p.ret_logit[(l * 2 + 0) * 4 + h], xb = p.ret_logit[(l * 2 + 1) * 4 + h];
  const float lgf = -log1pf(expf(-xf)) * 1.44269504089f, lgb = -log1pf(expf(-xb)) * 1.44269504089f;
  f32x4 acc[2][2][4];
#pragma unroll
  for (int d = 0; d < 2; ++d)
#pragma unroll
    for (int v = 0; v < 2; ++v)
#pragma unroll
      for (int k = 0; k < 4; ++k) acc[d][v][k] = (f32x4){0.f, 0.f, 0.f, 0.f};
#pragma unroll 2
  for (int ks = 0; ks < 8; ++ks) {
    const int j0 = ks * 32 + fq * 8;
    float df[8], db[8];
#pragma unroll
    for (int e = 0; e < 8; ++e) { df[e] = exp2f((float)(255 - j0 - e) * lgf); db[e] = exp2f((float)(j0 + e) * lgb); }
    bf16x8 af[2];
#pragma unroll
    for (int v = 0; v < 2; ++v) af[v] = *(const bf16x8*)(RVT + (size_t)((wid * 2 + v) * 16 + fr) * 256 + j0);
#pragma unroll
    for (int k = 0; k < 4; ++k) {
      const u32x4 raw = *(const u32x4*)(RKT + (size_t)(k * 16 + fr) * 256 + j0);
      const bf16x8 kf = scale8(raw, df), kb = scale8(raw, db);
#pragma unroll
      for (int v = 0; v < 2; ++v) { acc[0][v][k] = mfma16(af[v], kf, acc[0][v][k]); acc[1][v][k] = mfma16(af[v], kb, acc[1][v][k]); }
    }
  }
  float* O = p.out + OUT_RET;
#pragma unroll
  for (int d = 0; d < 2; ++d)
#pragma unroll
    for (int v = 0; v < 2; ++v)
#pragma unroll
      for (int k = 0; k < 4; ++k) {
        const int dk = k * 16 + fr, vd = (wid * 2 + v) * 16 + fq * 4;
        *(f32x4*)(O + ((size_t)((((b * 2 + l) * 2 + d) * 4 + h) * 64 + dk)) * 128 + vd) = acc[d][v][k];
      }
}

__device__ __forceinline__ void keyprep_item(const Params& p, int l, int item) {
  const int tid = tidx(), lane = tid & 63, wid = tid >> 6;
  char* ws = wsp(p.ws);
  unsigned char* CKVA = (unsigned char*)(ws + O_CKVA);
  bf16_t* KRA = (bf16_t*)(ws + O_KRA);
#pragma unroll
  for (int i = 0; i < 4; ++i) {
    const int R = item * 16 + wid * 4 + i;
    int smp = 0, b, t = 0, tok = 0, ctx = 0, pp = 0;
    if (R < NPR) { tok = R; b = R >> 8; t = R & 255; }
    else { smp = 1; const int s = R - NPR; b = s / 1536; pp = s - b * 1536; if (pp < 512) ctx = 1; else { t = pp - 512; tok = NPR + b * 1024 + t; } }
    if (ctx) {
      const f32x4 v = *(const f32x4*)(p.cache_ckv + ((size_t)((b * 2 + l) * 512 + pp)) * 256 + lane * 4);
      *(unsigned*)(CKVA + (size_t)R * 256 + lane * 4) = pk4f8(v[0] * 4.f, v[1] * 4.f, v[2] * 4.f, v[3] * 4.f);
      if (lane < 32) KRA[(size_t)R * 32 + lane] = tobf(p.cache_krope[((size_t)((b * 2 + l) * 512 + pp)) * 32 + lane]);
      continue;
    }
    const f32x4 v = *(const f32x4*)((const float*)(ws + O_KVLAT) + (size_t)tok * 256 + lane * 4);
    float ss = v[0] * v[0] + v[1] * v[1] + v[2] * v[2] + v[3] * v[3];
    ss = wave_sum(ss);
    const float rstd = rsqrtf(ss * (1.f / 256.f) + EPSN);
    const f32x4 g = *(const f32x4*)(p.kv_norm_g + l * 256 + lane * 4);
    f32x4 y;
#pragma unroll
    for (int e = 0; e < 4; ++e) y[e] = v[e] * rstd * g[e];
    *(unsigned*)(CKVA + (size_t)R * 256 + lane * 4) = pk4f8(y[0] * 4.f, y[1] * 4.f, y[2] * 4.f, y[3] * 4.f);
    if (!smp) *(f32x4*)(p.out + OUT_CKV + ((size_t)((b * 2 + l) * 256 + t)) * 256 + lane * 4) = y;
    const int d = lane & 31;
    const float x = ((const float*)(ws + O_KR))[(size_t)tok * 32 + d];
    float yk = x;
    if (smp) {
      const float pr = __shfl_xor(x, 8);
      const int hd = d >> 4, i16 = d & 15, f = i16 & 7;
      const int pos = hd ? (t & 63) : (t >> 6);
      const float* rt = (const float*)(ws + O_ROPE) + (pos * 8 + f) * 2;
      const float cs = rt[0], sn = rt[1];
      yk = i16 < 8 ? x * cs - pr * sn : pr * sn + x * cs;
    } else if (lane < 32) {
      p.out[OUT_KR + ((size_t)((b * 2 + l) * 256 + t)) * 32 + d] = x;
    }
    if (lane < 32) KRA[(size_t)R * 32 + d] = tobf(yk);
  }
}

__device__ __forceinline__ void f1_tile(const Params& p, int tile, char* lds) {
  const int tid = tidx(), lane = tid & 63, wid = tid >> 6, wm = wid >> 1, wn = wid & 1, fr = lane & 15, fq = lane >> 4;
  const int m = tile >> 3, g = (tile >> 1) & 3, nh = tile & 1, m0 = m * 128;
  char* ws = wsp(p.ws);
  f32x4 acc[4][4];
  zero_acc(acc);
  gemm_core<false>((const bf16_t*)(ws + O_FU) + (size_t)m0 * 512 + g * 128, 512, (const bf16_t*)(ws + O_CS) + (size_t)nh * 128 * 128, 128, 128, acc, lds);
  unsigned char* UT = (unsigned char*)(ws + O_UT);
#pragma unroll
  for (int i = 0; i < 4; ++i) {
    const int tok = m0 + wm * 64 + i * 16 + fq * 4;
    size_t base; int T, b, t;
    if (tok < NPR) { b = tok >> 8; t = tok & 255; T = 256; base = 0; } else { const int s = tok - NPR; b = s >> 10; t = s & 1023; T = 1024; base = (size_t)NPR * 1024; }
#pragma unroll
    for (int j = 0; j < 4; ++j) {
      const int k2 = wn * 64 + j * 16 + fr;
      *(unsigned*)(UT + base + ((size_t)(b * 4 + g) * 128 + k2) * (2 * T) + nh * T + t) = pk4f8(acc[i][j][0] * 4.f, acc[i][j][1] * 4.f, acc[i][j][2] * 4.f, acc[i][j][3] * 4.f);
    }
  }
}

__device__ __forceinline__ void qup_tile(const Params& p, int l, int tile, char* lds) {
  const int tid = tidx(), lane = tid & 63, wid = tid >> 6, wm = wid >> 1, wn = wid & 1, fr = lane & 15, fq = lane >> 4;
  const int m = tile % 96, nt = tile / 96, m0 = m * 128, n0 = nt * 128;
  char* ws = wsp(p.ws);
  const char* QL = (const char*)(ws + O_QLAT) + (size_t)m0 * 384;
  float rsv4[4];
  {
    float* rs = (float*)lds;
    __syncthreads();
#pragma unroll 1
    for (int r0 = 0; r0 < 32; r0 += 4) {
      float ss[4];
#pragma unroll
      for (int u = 0; u < 4; ++u) {
        u32x4 w = (u32x4){0u, 0u, 0u, 0u};
        if (lane < 24) w = ldg16(QL + (size_t)(wid * 32 + r0 + u) * 384 + lane * 16);
        float a = 0.f;
#pragma unroll
        for (int q = 0; q < 4; ++q) {
          const float f0 = __builtin_amdgcn_cvt_f32_fp8(w[q], 0), f1 = __builtin_amdgcn_cvt_f32_fp8(w[q], 1), f2 = __builtin_amdgcn_cvt_f32_fp8(w[q], 2), f3 = __builtin_amdgcn_cvt_f32_fp8(w[q], 3);
          a += f0 * f0 + f1 * f1 + f2 * f2 + f3 * f3;
        }
        ss[u] = a;
      }
#pragma unroll
      for (int u = 0; u < 4; ++u) { const float t = wave_sum(ss[u]); if (lane == 0) rs[wid * 32 + r0 + u] = rsqrtf(t * (1.f / (384.f * 64.f)) + EPSN); }
    }
    __syncthreads();
#pragma unroll
    for (int i = 0; i < 4; ++i) rsv4[i] = rs[wm * 64 + i * 16 + fr];
    __syncthreads();
  }
  f32x4 acc[4][4];
  zero_acc(acc);
  { int par = 0; gemm_bytes<true, 4, 1, true>(QL, 384, (const char*)(ws + O_WQ) + ((size_t)l * 768 + n0) * 384, 384, 384, acc, lds, par, false, nullptr, 0, nullptr, 0); }
  bf16_t* QB = (bf16_t*)(ws + O_QB);
  const float qscale = 0.10206207261596577f * 1.44269504089f * (1.f / 256.f);
#pragma unroll
  for (int i = 0; i < 4; ++i) {
    const int rl = wm * 64 + i * 16 + fr, tok = m0 + rl;
    const float sc = rsv4[i] * qscale;
    const int smp = tok >= NPR, t = (tok - NPR) & 1023;
#pragma unroll
    for (int j = 0; j < 4; ++j) {
      const int cb = n0 + wn * 64 + j * 16, within = cb % 96;
      f32x4 v = acc[i][j] * sc;
      if (within >= 64) {
        f32x4 pr;
#pragma unroll
        for (int e = 0; e < 4; ++e) pr[e] = __shfl_xor(v[e], 32);
        if (smp) {
          const int pos = within >= 80 ? (t & 63) : (t >> 6);
          const float* rt = (const float*)(ws + O_ROPE) + (pos * 8 + (fq & 1) * 4) * 2;
          const f32x4 c01 = *(const f32x4*)rt, c23 = *(const f32x4*)(rt + 4);
          const float cs4[4] = {c01[0], c01[2], c23[0], c23[2]}, sn4[4] = {c01[1], c01[3], c23[1], c23[3]};
#pragma unroll
          for (int e = 0; e < 4; ++e) v[e] = fq < 2 ? v[e] * cs4[e] - pr[e] * sn4[e] : pr[e] * sn4[e] + v[e] * cs4[e];
        }
      }
      *(u32x2*)(QB + (size_t)tok * 768 + cb + fq * 4) = pk4(v);
    }
  }
}

__device__ __forceinline__ void kvup_tile(const Params& p, int l, int tile, char* lds) {
  const int tid = tidx(), lane = tid & 63, wid = tid >> 6, wm = wid >> 1, wn = wid & 1, fr = lane & 15, fq = lane >> 4;
  const int m = tile % 112, nt = tile / 112, m0 = m * 128, n0 = nt * 128;
  char* ws = wsp(p.ws);
  const char* A = (const char*)(ws + O_CKVA) + (size_t)m0 * 256;
  const char* B = (const char*)(ws + O_WKV) + ((size_t)l * 1024 + n0) * 256;
  const float ks = 1.f / 128.f;
  f32x4 acc[4][4];
  zero_acc(acc);
  if (nt < 4) {
    { int par = 0; gemm_bytes<true, 4, 1, true>(A, 256, B, 256, 256, acc, lds, par, false, nullptr, 0, nullptr, 0); }
    bf16_t* KB = (bf16_t*)(ws + O_KB);
#pragma unroll
    for (int i = 0; i < 4; ++i) {
      const int R = m0 + wm * 64 + i * 16 + fr;
#pragma unroll
      for (int j = 0; j < 4; ++j) *(u32x2*)(KB + (size_t)R * 512 + n0 + wn * 64 + j * 16 + fq * 4) = pk4(acc[i][j] * ks);
    }
  } else {
    { int par = 0; gemm_bytes<false, 4, 1, true>(A, 256, B, 256, 256, acc, lds, par, false, nullptr, 0, nullptr, 0); }
    bf16_t* VT = (bf16_t*)(ws + O_VT);
#pragma unroll
    for (int i = 0; i < 4; ++i) {
      const int R = m0 + wm * 64 + i * 16 + fq * 4;
      size_t base; int Tk, b, k;
      if (R < NPR) { b = R >> 8; k = R & 255; Tk = 256; base = 0; } else { const int s = R - NPR; b = s / 1536; k = s - b * 1536; Tk = 1536; base = (size_t)NPR * 512; }
#pragma unroll
      for (int j = 0; j < 4; ++j) {
        const int c = n0 - 512 + wn * 64 + j * 16 + fr, h = c >> 6, vd = c & 63;
        *(u32x2*)(VT + base + ((size_t)(b * 8 + h) * 64 + vd) * Tk + k) = pk4(acc[i][j] * ks);
      }
    }
  }
}

template <int NJ>
__device__ __forceinline__ void f2_tile(const Params& p, int tile, char* lds) {
  const int tid = tidx(), lane = tid & 63, wid = tid >> 6, wm = wid >> 1, wn = wid & 1, fr = lane & 15, fq = lane >> 4;
  char* ws = wsp(p.ws);
  const char *A, *B; int K, tokb, g, nh = 0; float scale;
  if (NJ == 2) {
    const int b = tile >> 6, mt = (tile >> 1) & 7; g = (tile >> 4) & 3; nh = tile & 1;
    A = (const char*)(ws + O_D1024) + (size_t)mt * 128 * 2048; K = 2048;
    B = (const char*)(ws + O_UT) + (size_t)NPR * 1024 + ((size_t)(b * 4 + g) * 128 + nh * 64) * 2048;
    tokb = NPR + b * 1024 + mt * 128; scale = 0.00276213586400995f * (1.f / 256.f);
  } else {
    const int b = tile >> 3, mt = tile & 1; g = (tile >> 1) & 3;
    A = (const char*)(ws + O_D256) + (size_t)mt * 128 * 512; K = 512;
    B = (const char*)(ws + O_UT) + (size_t)(b * 4 + g) * 128 * 512;
    tokb = b * 256 + mt * 128; scale = 0.0055242717280199f * (1.f / 256.f);
  }
  f32x4 acc[4][NJ];
#pragma unroll
  for (int i = 0; i < 4; ++i)
#pragma unroll
    for (int j = 0; j < NJ; ++j) acc[i][j] = (f32x4){0.f, 0.f, 0.f, 0.f};
  { int par = 0; gemm_bytes<true, NJ, 1, true>(A, K, B, K, K, acc, lds, par, false, nullptr, 0, nullptr, 0); }
  bf16_t* FZ = (bf16_t*)(ws + O_FZ);
#pragma unroll
  for (int i = 0; i < 4; ++i) {
    const int tok = tokb + wm * 64 + i * 16 + fr;
#pragma unroll
    for (int j = 0; j < NJ; ++j) {
      bf16_t* gp = FZ + (size_t)tok * 512 + g * 128 + nh * 64 + wn * (NJ * 16) + j * 16 + fq * 4;
      const u32x2 gz = *(const u32x2*)gp;
      f32x4 y;
      y[0] = acc[i][j][0] * scale * bflo(gz.x); y[1] = acc[i][j][1] * scale * bfhi(gz.x);
      y[2] = acc[i][j][2] * scale * bflo(gz.y); y[3] = acc[i][j][3] * scale * bfhi(gz.y);
      *(unsigned*)(ws + O_BR8 + (size_t)2 * NTOK * 512 + (size_t)tok * 512 + g * 128 + nh * 64 + wn * (NJ * 16) + j * 16 + fq * 4) = pk4f8(y[0] * 8.f, y[1] * 8.f, y[2] * 8.f, y[3] * 8.f);
    }
  }
}

template <int NJ>
__device__ __forceinline__ void s6_tile(const Params& p, int l, int tile, int ntile, char* lds, int& par, bool& primed) {
  const int tid = tidx(), lane = tid & 63, wid = tid >> 6, wm = wid >> 1, wn = wid & 1, fr = lane & 15, fq = lane >> 4;
  constexpr int NT = 32 / NJ, BN = NJ * 32;
  const int m = (tile / (32 * NT)) * 32 + (tile % 32), nt = (tile % (32 * NT)) / 32, m0 = m * 128, n0 = nt * BN;
  char* ws = wsp(p.ws);
  const char* H8 = (const char*)(ws + O_H8);
  const char* W8 = (const char*)(ws + O_WG8) + (size_t)l * 3072 * 1024;
  const char* Wb = (const char*)(ws + O_WBR) + (size_t)(l * 3) * 1024 * 512;
  f32x4 tot[4][NJ], acc[4][NJ];
  unsigned sg[4][NJ];
#pragma unroll
  for (int i = 0; i < 4; ++i)
#pragma unroll
    for (int j = 0; j < NJ; ++j) tot[i][j] = (f32x4){0.f, 0.f, 0.f, 0.f};
#pragma unroll 1
  for (int nb = 0; nb < 3; ++nb) {
    u32x2 totp[4][NJ];
#pragma unroll
    for (int i = 0; i < 4; ++i)
#pragma unroll
      for (int j = 0; j < NJ; ++j) { totp[i][j] = pk4(tot[i][j]); acc[i][j] = (f32x4){0.f, 0.f, 0.f, 0.f}; }
    const char* brA = (const char*)(ws + O_BR8) + ((size_t)nb * NTOK + m0) * 512;
    const char* brB = Wb + ((size_t)nb * 1024 + n0) * 512;
    gemm_bytes<true, NJ, 2, true>(H8 + (size_t)m0 * 1024, 1024, W8 + ((size_t)nb * 1024 + n0) * 1024, 1024, 1024, acc, lds, par, primed, brA, 512, brB, 512);
#pragma unroll
    for (int i = 0; i < 4; ++i)
#pragma unroll
      for (int j = 0; j < NJ; ++j) {
        unsigned q = 0;
#pragma unroll
        for (int e = 0; e < 4; ++e) {
          const unsigned qe = (unsigned)fmaxf(sigm_f(acc[i][j][e] * 0.03125f) * 255.f + 0.5f, 1.f);
          q |= qe << (8 * e);
          tot[i][j][e] = (e == 0 ? bflo(totp[i][j].x) : e == 1 ? bfhi(totp[i][j].x) : e == 2 ? bflo(totp[i][j].y) : bfhi(totp[i][j].y)) * __builtin_amdgcn_rcpf((float)qe * (1.f / 255.f));
        }
        sg[i][j] = q;
      }
    const char *nA = nullptr, *nB = nullptr;
    if (nb < 2) { nA = H8 + (size_t)m0 * 1024; nB = W8 + ((size_t)(nb + 1) * 1024 + n0) * 1024; }
    else if (ntile >= 0) { nA = H8 + (size_t)(((ntile / (32 * NT)) * 32 + (ntile % 32)) * 128) * 1024; nB = W8 + (size_t)(((ntile % (32 * NT)) / 32) * BN) * 1024; }
    gemm_bytes<true, NJ, 2, true>(brA, 512, brB, 512, 512, tot, lds, par, true, nA, 1024, nB, 1024);
    primed = nA != nullptr;
#pragma unroll
    for (int i = 0; i < 4; ++i)
#pragma unroll
      for (int j = 0; j < NJ; ++j) {
        tot[i][j][0] *= (float)(sg[i][j] & 0xffu) * (1.f / 255.f); tot[i][j][1] *= (float)((sg[i][j] >> 8) & 0xffu) * (1.f / 255.f);
        tot[i][j][2] *= (float)((sg[i][j] >> 16) & 0xffu) * (1.f / 255.f); tot[i][j][3] *= (float)(sg[i][j] >> 24) * (1.f / 255.f);
      }
  }
  unsigned char* MG = (unsigned char*)(ws + O_UT);
#pragma unroll
  for (int i = 0; i < 4; ++i) {
    const int tok = m0 + wm * 64 + i * 16 + fr;
#pragma unroll
    for (int j = 0; j < NJ; ++j) *(unsigned*)(MG + (size_t)tok * 1024 + n0 + wn * (NJ * 16) + j * 16 + fq * 4) = pk4f8(tot[i][j][0] * (1.f / 256.f), tot[i][j][1] * (1.f / 256.f), tot[i][j][2] * (1.f / 256.f), tot[i][j][3] * (1.f / 256.f));
  }
}

__device__ __forceinline__ void s7_tile(const Params& p, int l, int tile, const float* xp, const float* xs, char* lds) {
  const int tid = tidx(), lane = tid & 63, wid = tid >> 6, wm = wid >> 1, wn = wid & 1, fr = lane & 15, fq = lane >> 4;
  const int m = (tile / 512) * 32 + (tile % 32), nt = (tile % 512) / 32, m0 = m * 128, n0 = nt * 64;
  char* ws = wsp(p.ws);
  f32x4 acc[4][2];
#pragma unroll
  for (int i = 0; i < 4; ++i) { acc[i][0] = (f32x4){0.f, 0.f, 0.f, 0.f}; acc[i][1] = (f32x4){0.f, 0.f, 0.f, 0.f}; }
  { int par = 0; gemm_bytes<true, 2, 1, true>((const char*)(ws + O_UT) + (size_t)m0 * 1024, 1024, (const char*)(ws + O_WO) + ((size_t)l * 1024 + n0) * 1024, 1024, 1024, acc, lds, par, false, nullptr, 0, nullptr, 0); }
#pragma unroll
  for (int i = 0; i < 4; ++i) {
    const int tok = m0 + wm * 64 + i * 16 + fr;
    const float* src = tok < NPR ? xp + (size_t)tok * 1024 : xs + (size_t)(tok - NPR) * 1024;
    const int v = tok < NPR ? 0 : 1 + ((tok - NPR) >> 10);
    const float* gate = (const float*)(ws + O_MOD) + (l * 5 + v) * 3072 + 2048;
#pragma unroll
    for (int j = 0; j < 2; ++j) {
      const int col = n0 + wn * 32 + j * 16 + fq * 4;
      const f32x4 x = *(const f32x4*)(src + col), gt = *(const f32x4*)(gate + col);
      f32x4 y;
#pragma unroll
      for (int e = 0; e < 4; ++e) y[e] = x[e] + gt[e] * (acc[i][j][e] * 0.03125f);
      *(f32x4*)(p.out + (size_t)tok * 1024 + col) = y;
    }
  }
}

constexpr int NPHASE = 16;
__device__ __forceinline__ int q_issue(unsigned* ctr) {
  int v = 0;
  if (threadIdx.x == 0) v = (int)__hip_atomic_fetch_add(ctr, 1u, __ATOMIC_RELAXED, __HIP_MEMORY_SCOPE_AGENT);
  return v;
}
__device__ __forceinline__ int q_bcast(int v, char* lds) {
  __syncthreads();
  if (threadIdx.x == 0) *(volatile int*)lds = v;
  __syncthreads();
  const int it = *(volatile int*)lds;
  __syncthreads();
  return it;
}
__device__ __forceinline__ void run_phase(const Params& p, int ph, char* lds, unsigned* qctr) {
  const int bid = blockIdx.x, nb = gridDim.x;
  if (ph == 0) { for (int i = bid; i < P0_N; i += nb) phase0_item(p, i, lds); return; }
  if (ph == 15) { for (int i = bid; i < 512; i += nb) final_item(p, i); return; }
  const int l = (ph - 1) / 7, s = (ph - 1) % 7;
  const float* xp = l == 0 ? p.x_prompt : p.out;
  const float* xs = l == 0 ? p.x_sample : p.out + (size_t)NPR * 1024;
  switch (s) {
    case 0: for (int i = bid; i < 512; i += nb) norm_item(p, l, i, xp, xs); break;
    case 1: for (int i = bid; i < 2880; i += nb) s2_tile(p, l, i, lds); break;
    case 2:
      for (int i = q_bcast(q_issue(qctr + ph), lds); i < 2752;) {
        if (i < 128) attn_item<1>(p, l, i, lds);
        else if (i < 1024) keyprep_item(p, l, i - 128);
        else if (i < 1280) attn_item<1>(p, l, 128 + (i - 1024), lds);
        else if (i < 1408) state_item(p, l, i - 1280);
        else if (i < 1984) qup_tile(p, l, i - 1408, lds);
        else f1_tile(p, i - 1984, lds);
        i = q_bcast(q_issue(qctr + ph), lds);
      }
      break;
    case 3:
      for (int i = q_bcast(q_issue(qctr + ph), lds); i < 1408;) {
        if (i < 256) f2_tile<2>(p, i, lds);
        else if (i < 512) f2_tile<4>(p, i - 256, lds);
        else kvup_tile(p, l, i - 512, lds);
        i = q_bcast(q_issue(qctr + ph), lds);
      }
      break;
    case 4:
      for (int i = q_bcast(q_issue(qctr + ph), lds); i < 768;) {
        attn_item<0>(p, l, i, lds);
        i = q_bcast(q_issue(qctr + ph), lds);
      }
      break;
    case 5: { int par = 0; bool primed = false; for (int i = bid; i < 768; i += nb) s6_tile<4>(p, l, i, (i + nb < 768) ? i + nb : -1, lds, par, primed); } break;
    case 6: for (int i = bid; i < 1536; i += nb) s7_tile(p, l, i, xp, xs, lds); break;
  }
}

#define XB_TMO      128
#define XB_XCNT(j)  (256  + 64 * (j))
#define XB_XSUB(j)  (1280 + 64 * (j))
#define XB_XGEN(j)  (2304 + 64 * (j))
#define XB_TOP      3328
#define XB_TOPGEN   3392
#define XCD_BAR_WORDS 3456
#define XB_SPIN_CAP (1u << 18)
__device__ __forceinline__ unsigned xb_ld(unsigned* p)              { return __hip_atomic_load(p, __ATOMIC_RELAXED, __HIP_MEMORY_SCOPE_AGENT); }
__device__ __forceinline__ unsigned xb_add(unsigned* p, unsigned v) { return __hip_atomic_fetch_add(p, v, __ATOMIC_RELAXED, __HIP_MEMORY_SCOPE_AGENT); }
__device__ __forceinline__ unsigned xb_xcc_id() { return (unsigned)__builtin_amdgcn_s_getreg((3 << 11) | 20) & 0xFu; }
#define XB_SPIN(cond, bar) do { unsigned _sp = 0; while (cond) { __builtin_amdgcn_s_sleep(1); \
    if ((++_sp & 255u) == 0u) { if (xb_ld(&(bar)[XB_TMO])) break; if (_sp > XB_SPIN_CAP) { atomicAdd(&(bar)[XB_TMO], 1u); break; } } } } while (0)
__device__ __forceinline__ void xcd_barrier_complete(unsigned* bar, unsigned x, unsigned& nloc, unsigned& nx) {
  const unsigned G = gridDim.x;
  unsigned sum, cnt, mine, sp = 0u;
  for (;;) {
    sum = 0u; cnt = 0u; mine = 0u;
#pragma unroll
    for (unsigned j = 0; j < 16; ++j) { const unsigned c = xb_ld(&bar[XB_XCNT(j)]); sum += c; cnt += (c > 0u) ? 1u : 0u; mine = (j == x) ? c : mine; }
    if (sum == G) break;
    __builtin_amdgcn_s_sleep(1);
    if ((++sp & 255u) == 0u) { if (xb_ld(&bar[XB_TMO])) break; if (sp > XB_SPIN_CAP) { atomicAdd(&bar[XB_TMO], 1u); break; } }
  }
  nloc = mine > 0u ? mine : 1u; nx = cnt > 0u ? cnt : 1u;
}
__device__ __forceinline__ void xcd_barrier(unsigned* bar, unsigned x, unsigned& nloc, unsigned& nx) {
  asm volatile("s_waitcnt vmcnt(0)" ::: "memory");
  __syncthreads();
  if (threadIdx.x == 0) {
    __builtin_amdgcn_s_waitcnt(0);
    if (nloc == 0u) xcd_barrier_complete(bar, x, nloc, nx);
    const unsigned old = xb_add(&bar[XB_XSUB(x)], 1u);
    const unsigned gen = old / nloc;
    if (old + 1u == (gen + 1u) * nloc) {
      __builtin_amdgcn_fence(__ATOMIC_RELEASE, "agent");
      asm volatile("s_waitcnt vmcnt(0)" ::: "memory");
      const unsigned og = xb_add(&bar[XB_TOP], 1u);
      const unsigned tg = og / nx;
      if (og + 1u == (tg + 1u) * nx) xb_add(&bar[XB_TOPGEN], 1u);
      else XB_SPIN(xb_ld(&bar[XB_TOPGEN]) == tg, bar);
      __builtin_amdgcn_fence(__ATOMIC_ACQUIRE, "agent");
      xb_add(&bar[XB_XGEN(x)], 1u);
      asm volatile("s_waitcnt vmcnt(0)" ::: "memory");
    } else {
      XB_SPIN(xb_ld(&bar[XB_XGEN(x)]) == gen, bar);
      __builtin_amdgcn_fence(__ATOMIC_ACQUIRE, "agent");
      asm volatile("s_waitcnt vmcnt(0)" ::: "memory");
    }
  }
  __syncthreads();
}

__global__ void __launch_bounds__(256, 2) mk_fwd(Params p) {
  __shared__ __attribute__((aligned(16))) char lds[LDS_TOTAL];
  cg::grid_group grid = cg::this_grid();
  unsigned* bar = (unsigned*)(p.ws + O_BAR);
  const unsigned xcc = xb_xcc_id();
  if (threadIdx.x == 0) (void)xb_add(&bar[XB_XCNT(xcc)], 1u);
  unsigned nloc = 0u, nx = 0u;
  if (gridDim.x == 0x7fffffffu) grid.sync();
#pragma unroll 1
  for (int ph = 0; ph < NPHASE; ++ph) {
    run_phase(p, ph, lds, bar);
    if (ph + 1 < NPHASE) xcd_barrier(bar, xcc, nloc, nx);
  }
}

extern "C" void kernel_launch(void* const* d_in, const int* in_sizes, int n_in, void* d_out, int out_size, void* d_ws, size_t ws_size,
                              hipStream_t stream) {
  Params p{};
  p.x_prompt = (const float*)d_in[0]; p.x_sample = (const float*)d_in[1]; p.cache_ckv = (const float*)d_in[2]; p.cache_krope = (const float*)d_in[3];
  p.state_ret = (const float*)d_in[4]; p.c = (const float*)d_in[5]; p.c_ctx = (const float*)d_in[6]; p.norm_g = (const float*)d_in[7];
  p.w_mod = (const float*)d_in[8]; p.b_mod = (const float*)d_in[9]; p.w_in = (const float*)d_in[10]; p.ret_logit = (const float*)d_in[11];
  p.q_norm_g = (const float*)d_in[12]; p.w_q_up = (const float*)d_in[13]; p.kv_norm_g = (const float*)d_in[14]; p.w_kv_up = (const float*)d_in[15];
  p.w_branch = (const float*)d_in[16]; p.w_out = (const float*)d_in[17]; p.final_g = (const float*)d_in[18];
  p.out = (float*)d_out; p.ws = (char*)d_ws;
#if ONE_LAUNCH
  static int grid_blocks = 0;
  if (!grid_blocks) {
    int dev = 0, cus = 0, per_cu = 0;
    hipGetDevice(&dev);
    hipDeviceGetAttribute(&cus, hipDeviceAttributeMultiprocessorCount, dev);
    hipOccupancyMaxActiveBlocksPerMultiprocessor(&per_cu, mk_fwd, 256, 0);
    if (per_cu > 2) per_cu = 2;
    grid_blocks = cus * per_cu;
  }
  hipMemsetAsync((char*)d_ws + O_BAR, 0, XCD_BAR_WORDS * 4, stream);
  void* args[] = {&p};
  hipError_t e = hipLaunchCooperativeKernel((void*)mk_fwd, dim3(grid_blocks), dim3(256), args, 0, stream);
  if (e != hipSuccess) fprintf(stderr, "cooperative launch failed: %s (grid %d)\n", hipGetErrorString(e), grid_blocks);
#endif
}
```

```cpp
#include <hip/hip_runtime.h>
#include <hip/hip_cooperative_groups.h>
#include <stdint.h>
#include <stdio.h>
namespace cg = cooperative_groups;

#ifndef ONE_LAUNCH
#define ONE_LAUNCH 1
#endif

typedef unsigned short bf16_t;
typedef short bf16x8 __attribute__((ext_vector_type(8)));
typedef float f32x4 __attribute__((ext_vector_type(4)));
typedef unsigned u32x4 __attribute__((ext_vector_type(4)));
typedef unsigned u32x2 __attribute__((ext_vector_type(2)));

constexpr int NTOK = 12288, NPR = 8192, NKEY = 14336;
constexpr float EPSN = 1e-6f;

constexpr size_t O_WIN   = 0;
constexpr size_t O_WQ    = O_WIN   + (size_t)2 * 6912 * 1024 * 2;
constexpr size_t O_WKV   = O_WQ    + (size_t)2 * 768 * 384 * 2;
constexpr size_t O_WBR   = O_WKV   + (size_t)2 * 1024 * 256 * 2;
constexpr size_t O_WO    = O_WBR   + (size_t)6 * 1024 * 512 * 2;
constexpr size_t O_CS    = O_WO    + (size_t)2 * 1024 * 1024 * 2;
constexpr size_t O_D256  = O_CS    + (size_t)256 * 128 * 2;
constexpr size_t O_D1024 = O_D256  + (size_t)256 * 512 * 2;
constexpr size_t O_S0T   = O_D1024 + (size_t)1024 * 2048 * 2;
constexpr size_t O_MOD   = O_S0T   + (size_t)64 * 128 * 64 * 2;
constexpr size_t O_H     = O_MOD   + (size_t)2 * 5 * 3072 * 4;
constexpr size_t O_BR8   = O_H;
constexpr size_t O_UT    = O_H     + (size_t)NTOK * 1024 * 2;
constexpr size_t O_RQ    = O_UT    + (size_t)NTOK * 1024 * 2;
constexpr size_t O_RK    = O_RQ    + (size_t)NTOK * 256 * 2;
constexpr size_t O_RKT   = O_RK    + (size_t)NTOK * 256 * 2;
constexpr size_t O_RVT   = O_RKT   + (size_t)NPR * 256 * 2;
constexpr size_t O_KVLAT = O_RVT   + (size_t)NTOK * 512 * 2;
constexpr size_t O_KR    = O_KVLAT + (size_t)NTOK * 256 * 4;
constexpr size_t O_R2END = O_KR    + (size_t)NTOK * 32 * 4;
constexpr size_t O_VT    = O_RQ;
static_assert(O_VT + (size_t)NKEY * 512 * 2 <= O_R2END, "alias overflow");
constexpr size_t O_RZ    = O_R2END;
constexpr size_t O_MZ    = O_RZ    + (size_t)NTOK * 512 * 2;
constexpr size_t O_FZ    = O_MZ    + (size_t)NTOK * 512 * 2;
constexpr size_t O_FU    = O_FZ    + (size_t)NTOK * 512 * 2;
constexpr size_t O_QLAT  = O_FU    + (size_t)NTOK * 512 * 2;
constexpr size_t O_CKVA  = O_QLAT  + (size_t)NTOK * 384 * 2;
constexpr size_t O_KB    = O_CKVA  + (size_t)NKEY * 256 * 2;
constexpr size_t O_KRA   = O_KB    + (size_t)NKEY * 512 * 2;
constexpr size_t O_QB    = O_KRA   + (size_t)NKEY * 32 * 2;
constexpr size_t O_H8    = O_QB    + (size_t)NTOK * 768 * 2;
constexpr size_t O_WG8   = O_H8    + (size_t)NTOK * 1024;
constexpr size_t O_WS8   = O_WG8   + (size_t)2 * 3072 * 1024;
constexpr size_t O_END   = O_WS8   + (size_t)2 * 1920 * 1024;
constexpr size_t O_ROPE  = (O_END + 255) & ~(size_t)255;
constexpr size_t O_BAR   = O_ROPE + 4096;
static_assert(O_BAR + 16384 <= (size_t)256 * 1024 * 1024, "workspace too large");

constexpr size_t OUT_CKV = (size_t)NTOK * 1024;
constexpr size_t OUT_KR  = OUT_CKV + (size_t)32 * 2 * 256 * 256;
constexpr size_t OUT_RET = OUT_KR + (size_t)32 * 2 * 256 * 32;

struct Params {
  const float *x_prompt, *x_sample, *cache_ckv, *cache_krope, *state_ret, *c, *c_ctx, *norm_g, *w_mod, *b_mod,
      *w_in, *ret_logit, *q_norm_g, *w_q_up, *kv_norm_g, *w_kv_up, *w_branch, *w_out, *final_g;
  float* out;
  char* ws;
};

constexpr int PANEL = 128 * 64;
constexpr int ABYTES = 2 * PANEL;
constexpr int STAGE = 2 * ABYTES;
constexpr int LDS_GEMM = 2 * STAGE;
constexpr int LDS_TOTAL = LDS_GEMM;
static_assert(LDS_TOTAL <= 65536, "static LDS");

typedef float f32x2 __attribute__((ext_vector_type(2)));
typedef __bf16 bf16x2v __attribute__((ext_vector_type(2)));
__device__ __forceinline__ unsigned pk2(float lo, float hi) { const f32x2 v = {lo, hi}; return __builtin_bit_cast(unsigned, __builtin_convertvector(v, bf16x2v)); }
__device__ __forceinline__ bf16_t tobf(float x) { return (bf16_t)(pk2(x, 0.f) & 0xffffu); }
typedef int v8i __attribute__((ext_vector_type(8)));
__device__ __forceinline__ float sat8(float x) { return __builtin_amdgcn_fmed3f(x, -448.f, 448.f); }
__device__ __forceinline__ unsigned pk4f8(float a, float b, float c, float d) { unsigned w = 0; a = sat8(a); b = sat8(b); c = sat8(c); d = sat8(d); w = __builtin_amdgcn_cvt_pk_fp8_f32(a, b, w, false); w = __builtin_amdgcn_cvt_pk_fp8_f32(c, d, w, true); return w; }
__device__ __forceinline__ float bflo(unsigned u) { return __uint_as_float(u << 16); }
__device__ __forceinline__ float bfhi(unsigned u) { return __uint_as_float(u & 0xffff0000u); }
__device__ __forceinline__ float ex2(float x) { return __builtin_amdgcn_exp2f(x); }
__device__ __forceinline__ float silu_f(float x) { return x / (1.f + __expf(-x)); }
__device__ __forceinline__ float sigm_f(float x) { return 1.f / (1.f + __expf(-x)); }
__device__ __forceinline__ u32x2 pk4(f32x4 v) { u32x2 r; r.x = pk2(v[0], v[1]); r.y = pk2(v[2], v[3]); return r; }
#define GAS __attribute__((address_space(1)))
#define LAS __attribute__((address_space(3)))
__device__ __forceinline__ u32x4 ldg16(const void* p) { return *(const GAS u32x4*)p; }
__device__ __forceinline__ int tidx() { int t = threadIdx.x; asm volatile("" : "+v"(t)); return t; }
__device__ __forceinline__ char* wsp(const char* w) { unsigned long long v = (unsigned long long)w; asm volatile("" : "+s"(v)); return (char*)v; }
__device__ __forceinline__ int swz(int r) { return (0 - ((r >> 2) & 3)) & 3; }
__device__ __forceinline__ float wave_sum(float v) {
#pragma unroll
  for (int o = 1; o < 64; o <<= 1) v += __shfl_xor(v, o);
  return v;
}
__device__ __forceinline__ f32x4 mfma16(bf16x8 a, bf16x8 b, f32x4 c) { return __builtin_amdgcn_mfma_f32_16x16x32_bf16(a, b, c, 0, 0, 0); }
__device__ __forceinline__ bf16x8 as_bf8(u32x4 v) { return __builtin_bit_cast(bf16x8, v); }

__device__ __forceinline__ void zero_acc(f32x4 (&acc)[4][4]) {
#pragma unroll
  for (int i = 0; i < 4; ++i)
#pragma unroll
    for (int j = 0; j < 4; ++j) acc[i][j] = (f32x4){0.f, 0.f, 0.f, 0.f};
}

template <bool SWAP, int NJ, int PIPE, bool F8>
__device__ __forceinline__ void gemm_bytes(const char* __restrict__ A, int lda, const char* __restrict__ B, int ldb, int Kb,
                                           f32x4 (&acc)[4][NJ], char* lds, int& par, bool primed,
                                           const char* nA, int nlda, const char* nB, int nldb) {
  const int tid = tidx(), lane = tid & 63, wm = (tid >> 6) >> 1, wn = (tid >> 6) & 1;
  const int wid = __builtin_amdgcn_readfirstlane(tid >> 6);
  const int fr = lane & 15, fq = lane >> 4;
  const int fa = (wm * 64 + fr) * 64 + ((fq ^ swz(fr)) << 4);
  const int fb = ABYTES + (wn * NJ * 16 + fr) * 64 + ((fq ^ swz(fr)) << 4);
  const int lrow = lane >> 2, lchunk = (lane & 3) ^ swz(lrow);
  constexpr int NBL = NJ / 2;
  const GAS char* gA = (const GAS char*)(A + (size_t)(wid * 32 + lrow) * lda + lchunk * 16);
  const GAS char* gB = (const GAS char*)(B + (size_t)(wid * NBL * 16 + lrow) * ldb + lchunk * 16);
  const size_t a16 = (size_t)16 * lda, b16 = (size_t)16 * ldb;
  LAS char* ldsA = (LAS char*)lds + wid * 2048;
  LAS char* ldsB = (LAS char*)lds + ABYTES + wid * NBL * 1024;
  const int nk = Kb >> 7;
#define GC_ISSUE(pa, pb, sa, sb, stage, kbyte) do { \
    _Pragma("unroll") for (int g = 0; g < 2; ++g) _Pragma("unroll") for (int pn = 0; pn < 2; ++pn) \
      __builtin_amdgcn_global_load_lds((const GAS unsigned*)((pa) + g * (sa) + (kbyte) + pn * 64), (LAS unsigned*)(ldsA + (stage) + pn * PANEL + g * 1024), 16, 0, 0); \
    _Pragma("unroll") for (int g = 0; g < NBL; ++g) _Pragma("unroll") for (int pn = 0; pn < 2; ++pn) \
      __builtin_amdgcn_global_load_lds((const GAS unsigned*)((pb) + g * (sb) + (kbyte) + pn * 64), (LAS unsigned*)(ldsB + (stage) + pn * PANEL + g * 1024), 16, 0, 0); \
  } while (0)
  if (!primed) {
    GC_ISSUE(gA, gB, a16, b16, par * STAGE, 0);
    asm volatile("s_waitcnt vmcnt(0)" ::: "memory");
    __syncthreads();
  }
#pragma unroll 1
  for (int kt = 0; kt < nk; ++kt) {
    char* cur = lds + par * STAGE;
    if (kt + 1 < nk) GC_ISSUE(gA, gB, a16, b16, (par ^ 1) * STAGE, (size_t)(kt + 1) * 128);
    else if (nA) {
      const GAS char* hA = (const GAS char*)(nA + (size_t)(wid * 32 + lrow) * nlda + lchunk * 16);
      const GAS char* hB = (const GAS char*)(nB + (size_t)(wid * NBL * 16 + lrow) * nldb + lchunk * 16);
      GC_ISSUE(hA, hB, (size_t)16 * nlda, (size_t)16 * nldb, (par ^ 1) * STAGE, 0);
    }
    __builtin_amdgcn_sched_barrier(0);
    if (F8) {
#pragma unroll
      for (int ih = 0; ih < 2; ++ih) {
        v8i av[2];
#pragma unroll
        for (int ii = 0; ii < 2; ++ii) {
          const u32x4 a0 = *(const u32x4*)(cur + fa + (ih * 2 + ii) * 1024), a1 = *(const u32x4*)(cur + PANEL + fa + (ih * 2 + ii) * 1024);
          av[ii] = (v8i){(int)a0.x, (int)a0.y, (int)a0.z, (int)a0.w, (int)a1.x, (int)a1.y, (int)a1.z, (int)a1.w};
        }
#pragma unroll
        for (int j = 0; j < NJ; ++j) {
          const u32x4 b0 = *(const u32x4*)(cur + fb + j * 1024), b1 = *(const u32x4*)(cur + PANEL + fb + j * 1024);
          const v8i bv = {(int)b0.x, (int)b0.y, (int)b0.z, (int)b0.w, (int)b1.x, (int)b1.y, (int)b1.z, (int)b1.w};
#pragma unroll
          for (int ii = 0; ii < 2; ++ii)
            acc[ih * 2 + ii][j] = SWAP ? __builtin_amdgcn_mfma_scale_f32_16x16x128_f8f6f4(bv, av[ii], acc[ih * 2 + ii][j], 0, 0, 0, 0x7f7f7f7f, 0, 0x7f7f7f7f)
                                       : __builtin_amdgcn_mfma_scale_f32_16x16x128_f8f6f4(av[ii], bv, acc[ih * 2 + ii][j], 0, 0, 0, 0x7f7f7f7f, 0, 0x7f7f7f7f);
        }
      }
    } else if (PIPE == 2) {
      bf16x8 af[2][4], bfr[NJ];
#pragma unroll
      for (int i = 0; i < 4; ++i) af[0][i] = *(const bf16x8*)(cur + fa + i * 1024);
#pragma unroll
      for (int j = 0; j < NJ; ++j) bfr[j] = *(const bf16x8*)(cur + fb + j * 1024);
#pragma unroll
      for (int i = 0; i < 4; ++i) af[1][i] = *(const bf16x8*)(cur + PANEL + fa + i * 1024);
      __builtin_amdgcn_sched_barrier(0);
#pragma unroll
      for (int i = 0; i < 4; ++i)
#pragma unroll
        for (int j = 0; j < NJ; ++j) acc[i][j] = SWAP ? mfma16(bfr[j], af[0][i], acc[i][j]) : mfma16(af[0][i], bfr[j], acc[i][j]);
#pragma unroll
      for (int j = 0; j < NJ; ++j) bfr[j] = *(const bf16x8*)(cur + PANEL + fb + j * 1024);
#pragma unroll
      for (int i = 0; i < 4; ++i)
#pragma unroll
        for (int j = 0; j < NJ; ++j) acc[i][j] = SWAP ? mfma16(bfr[j], af[1][i], acc[i][j]) : mfma16(af[1][i], bfr[j], acc[i][j]);
    } else if (PIPE == 1) {
      bf16x8 af[2][4], bfr[2][NJ];
#pragma unroll
      for (int ks = 0; ks < 2; ++ks) {
#pragma unroll
        for (int i = 0; i < 4; ++i) af[ks][i] = *(const bf16x8*)(cur + ks * PANEL + fa + i * 1024);
#pragma unroll
        for (int j = 0; j < NJ; ++j) bfr[ks][j] = *(const bf16x8*)(cur + ks * PANEL + fb + j * 1024);
      }
      __builtin_amdgcn_sched_barrier(0);
#pragma unroll
      for (int ks = 0; ks < 2; ++ks)
#pragma unroll
        for (int i = 0; i < 4; ++i)
#pragma unroll
          for (int j = 0; j < NJ; ++j) acc[i][j] = SWAP ? mfma16(bfr[ks][j], af[ks][i], acc[i][j]) : mfma16(af[ks][i], bfr[ks][j], acc[i][j]);
    } else {
#pragma unroll
      for (int ks = 0; ks < 2; ++ks) {
        bf16x8 af[4], bfr[NJ];
#pragma unroll
        for (int i = 0; i < 4; ++i) af[i] = *(const bf16x8*)(cur + ks * PANEL + fa + i * 1024);
#pragma unroll
        for (int j = 0; j < NJ; ++j) bfr[j] = *(const bf16x8*)(cur + ks * PANEL + fb + j * 1024);
#pragma unroll
        for (int i = 0; i < 4; ++i)
#pragma unroll
          for (int j = 0; j < NJ; ++j) acc[i][j] = SWAP ? mfma16(bfr[j], af[i], acc[i][j]) : mfma16(af[i], bfr[j], acc[i][j]);
      }
    }
    __builtin_amdgcn_sched_barrier(0);
    asm volatile("s_waitcnt vmcnt(0)" ::: "memory");
    __syncthreads();
    par ^= 1;
  }
#undef GC_ISSUE
}
template <bool SWAP, int NJ = 4, int PIPE = 1>
__device__ __forceinline__ void gemm_core(const bf16_t* __restrict__ A, int lda, const bf16_t* __restrict__ B, int ldb, int K,
                                          f32x4 (&acc)[4][NJ], char* lds, int& par, bool primed,
                                          const bf16_t* nA, int nlda, const bf16_t* nB, int nldb) {
  gemm_bytes<SWAP, NJ, PIPE, false>((const char*)A, lda * 2, (const char*)B, ldb * 2, K * 2, acc, lds, par, primed, (const char*)nA, nlda * 2, (const char*)nB, nldb * 2);
}
template <bool SWAP, int NJ = 4>
__device__ __forceinline__ void gemm_core(const bf16_t* __restrict__ A, int lda, const bf16_t* __restrict__ B, int ldb, int K,
                                          f32x4 (&acc)[4][NJ], char* lds) {
  int par = 0;
  gemm_core<SWAP, NJ>(A, lda, B, ldb, K, acc, lds, par, false, nullptr, 0, nullptr, 0);
}

__device__ __forceinline__ void tr_tile(const float* __restrict__ src, int lds_, int k0, int ns0, bf16_t* __restrict__ dst, int ldd, int nd0,
                                        const float* __restrict__ ksc, char* lds) {
  bf16_t* T = (bf16_t*)lds;
  const int tid = tidx();
  __syncthreads();
#pragma unroll
  for (int i = 0; i < 2; ++i) {
    const int kk = (tid >> 3) + 32 * i, nn4 = (tid & 7) * 4;
    const f32x4 v = *(const f32x4*)(src + (size_t)(k0 + kk) * lds_ + ns0 + nn4);
    const float s = ksc ? ksc[k0 + kk] : 1.f;
#pragma unroll
    for (int e = 0; e < 4; ++e) T[(nn4 + e) * 72 + kk] = tobf(v[e] * s);
  }
  __syncthreads();
  const int nn = tid >> 3, kc = (tid & 7) * 8;
  const u32x4 w = *(const u32x4*)(T + nn * 72 + kc);
  *(u32x4*)(dst + (size_t)(nd0 + nn) * ldd + k0 + kc) = w;
}

__device__ __forceinline__ void tr_tile2(const float* __restrict__ src, int lds_, int k0, int ns0, bf16_t* __restrict__ dst, int ldd, int nd0,
                                         const float* __restrict__ ksc, char* lds, unsigned char* dst8 = nullptr, int ld8 = 1024) {
  bf16_t* T = (bf16_t*)lds;
  unsigned char* T8 = (unsigned char*)lds + 8704;
  const int tid = tidx();
  __syncthreads();
  f32x4 v[4];
#pragma unroll
  for (int i = 0; i < 4; ++i) v[i] = *(const GAS f32x4*)(src + (size_t)(k0 + (tid >> 3) + 32 * i) * lds_ + ns0 + (tid & 7) * 4);
#pragma unroll
  for (int i = 0; i < 4; ++i) {
    const int kk = (tid >> 3) + 32 * i, nn4 = (tid & 7) * 4;
    const float sc = ksc ? ksc[k0 + kk] : 1.f;
#pragma unroll
    for (int e = 0; e < 4; ++e) T[(nn4 + e) * 136 + kk] = tobf(v[i][e] * sc);
    if (dst8) {
#pragma unroll
      for (int e = 0; e < 4; ++e) T8[(nn4 + e) * 144 + kk] = (unsigned char)(__builtin_amdgcn_cvt_pk_fp8_f32(sat8(v[i][e] * sc * 32.f), 0.f, 0, false) & 0xff);
    }
  }
  __syncthreads();
  const int nn = tid >> 3, kc = (tid & 7) * 16;
  if (dst8) *(u32x4*)(dst8 + (size_t)nn * ld8 + k0 + kc) = *(const u32x4*)(T8 + nn * 144 + kc);
  if (!dst) return;
  const u32x4 w0 = *(const u32x4*)(T + nn * 136 + kc), w1 = *(const u32x4*)(T + nn * 136 + kc + 8);
  bf16_t* d = dst + (size_t)(nd0 + nn) * ldd + k0 + kc;
  *(u32x4*)d = w0; *(u32x4*)(d + 8) = w1;
}

constexpr int P0_GEMV = 192, P0_WIN = 3408, P0_WQ = 144, P0_WKV = 128, P0_WBR = 768, P0_WO = 512, P0_S0 = 256, P0_PAD = 96, P0_TAB = 1105;
constexpr int P0_N = P0_GEMV + P0_WIN + P0_WQ + P0_WKV + P0_WBR + P0_WO + P0_S0 + P0_PAD + P0_TAB;

__device__ __forceinline__ void phase0_item(const Params& p, int j, char* lds) {
  const int tid = tidx();
  char* ws = wsp(p.ws);
  if (j < P0_GEMV) {
    const int l = j / 96, cgi = j % 96;
    float* sv = (float*)lds;
    float* red = (float*)(lds + 20480);
    __syncthreads();
    for (int i = tid; i < 5120; i += 256) { const int v = i >> 10, k = i & 1023; const float x = (v == 0) ? p.c_ctx[k] : p.c[(v - 1) * 1024 + k]; sv[i] = silu_f(x); }
    __syncthreads();
    const int c4 = tid & 7, kg = tid >> 3;
    const float* w = p.w_mod + (size_t)l * 1024 * 3072 + cgi * 32 + c4 * 4;
    f32x4 a0 = {0.f, 0.f, 0.f, 0.f}, a1 = a0, a2 = a0, a3 = a0, a4 = a0;
#pragma unroll 8
    for (int k = kg * 32; k < kg * 32 + 32; ++k) {
      const f32x4 wv = *(const GAS f32x4*)(w + (size_t)k * 3072);
      a0 += wv * sv[k]; a1 += wv * sv[1024 + k]; a2 += wv * sv[2048 + k]; a3 += wv * sv[3072 + k]; a4 += wv * sv[4096 + k];
    }
    *(f32x4*)(red + (kg * 5 + 0) * 32 + c4 * 4) = a0; *(f32x4*)(red + (kg * 5 + 1) * 32 + c4 * 4) = a1; *(f32x4*)(red + (kg * 5 + 2) * 32 + c4 * 4) = a2;
    *(f32x4*)(red + (kg * 5 + 3) * 32 + c4 * 4) = a3; *(f32x4*)(red + (kg * 5 + 4) * 32 + c4 * 4) = a4;
    __syncthreads();
    if (tid < 160) {
      const int v = tid >> 5, c2 = tid & 31;
      float sm = p.b_mod[l * 3072 + cgi * 32 + c2];
#pragma unroll 8
      for (int g = 0; g < 32; ++g) sm += red[(g * 5 + v) * 32 + c2];
      ((float*)(ws + O_MOD))[(l * 5 + v) * 3072 + cgi * 32 + c2] = sm;
    }
    return;
  }
  j -= P0_GEMV;
  if (j < P0_WIN) {
    const int l = j / 1704, r = j % 1704, kt = r / 213, nt = r % 213, c0 = nt * 32;
    const int nd0 = c0 < 2176 ? c0 : (c0 < 2208 ? 3712 + (c0 - 2176) : (c0 < 3744 ? c0 - 32 : c0 + 96));
    const bool only8 = nd0 >= 3840 || (nd0 >= 1536 && nd0 < 1920) || (nd0 >= 2688 && nd0 < 3200);
    tr_tile2(p.w_in + (size_t)l * 1024 * 6816, 6816, kt * 128, c0, only8 ? nullptr : (bf16_t*)(ws + O_WIN) + (size_t)l * 6912 * 1024, 1024, nd0, nullptr, lds,
             nd0 >= 3840 ? (unsigned char*)(ws + O_WG8) + ((size_t)l * 3072 + (nd0 - 3840)) * 1024
             : nd0 < 1024 ? (unsigned char*)(ws + O_WS8) + ((size_t)l * 1920 + nd0) * 1024
             : (nd0 >= 1536 && nd0 < 1920) ? (unsigned char*)(ws + O_WS8) + ((size_t)l * 1920 + 1024 + (nd0 - 1536)) * 1024
             : (nd0 >= 2688 && nd0 < 3200) ? (unsigned char*)(ws + O_WS8) + ((size_t)l * 1920 + 1408 + (nd0 - 2688)) * 1024 : nullptr);
    return;
  }
  j -= P0_WIN;
  if (j < P0_WQ) {
    const int l = j / 72, r = j % 72, kt = r / 24, nt = r % 24;
    tr_tile2(p.w_q_up + (size_t)l * 384 * 768, 768, kt * 128, nt * 32, nullptr, 384, nt * 32, p.q_norm_g + l * 384, lds,
             (unsigned char*)(ws + O_WQ) + ((size_t)l * 768 + nt * 32) * 384, 384);
    return;
  }
  j -= P0_WQ;
  if (j < P0_WKV) {
    const int l = j / 64, r = j % 64, kt = r / 32, nt = r % 32, c0 = nt * 32, h = c0 >> 7, e = c0 & 127;
    const int nd0 = e < 64 ? h * 64 + e : 512 + h * 64 + (e - 64);
    tr_tile2(p.w_kv_up + (size_t)l * 256 * 1024, 1024, kt * 128, c0, nullptr, 256, nd0, nullptr, lds,
             (unsigned char*)(ws + O_WKV) + ((size_t)l * 1024 + nd0) * 256, 256);
    return;
  }
  j -= P0_WKV;
  if (j < P0_WBR) {
    const int mat = j / 128, r = j % 128, kt = r / 32, nt = r % 32;
    tr_tile2(p.w_branch + (size_t)mat * 512 * 1024, 1024, kt * 128, nt * 32, nullptr, 512, nt * 32, nullptr, lds,
             (unsigned char*)(ws + O_WBR) + ((size_t)mat * 1024 + nt * 32) * 512, 512);
    return;
  }
  j -= P0_WBR;
  if (j < P0_WO) {
    const int l = j / 256, r = j % 256, kt = r / 32, nt = r % 32;
    tr_tile2(p.w_out + (size_t)l * 1024 * 1024, 1024, kt * 128, nt * 32, nullptr, 1024, nt * 32, nullptr, lds,
             (unsigned char*)(ws + O_WO) + ((size_t)l * 1024 + nt * 32) * 1024, 1024);
    return;
  }
  j -= P0_WO;
  if (j < P0_S0) {
    const int mat = j >> 2, nt = j & 3;
    tr_tile(p.state_ret + (size_t)mat * 64 * 128, 128, 0, nt * 32, (bf16_t*)(ws + O_S0T) + (size_t)mat * 128 * 64, 64, nt * 32, nullptr, lds);
    return;
  }
  j -= P0_S0;
  if (j < P0_PAD) {
    const int l = j / 48, r = j % 48;
    bf16_t* d = (bf16_t*)(ws + O_WIN) + ((size_t)l * 6912 + 3744) * 1024 + (size_t)r * 2048 + tid * 8;
    *(u32x4*)d = (u32x4){0u, 0u, 0u, 0u};
    return;
  }
  j -= P0_PAD;
  {
    float v[8];
    bf16_t* dst = nullptr; unsigned char* dst8 = nullptr;
    if (j == 1104) {
      float* rt = (float*)(ws + O_ROPE);
#pragma unroll
      for (int q = 0; q < 2; ++q) {
        const int idx = tid * 2 + q, pos = idx >> 3, f = idx & 7;
        const float ang = (float)pos * exp2f(-(float)f * 1.66096404744f);
        rt[idx * 2] = cosf(ang); rt[idx * 2 + 1] = sinf(ang);
      }
      return;
    }
    if (j < 16) {
      const int e0 = j * 2048 + tid * 8; dst = (bf16_t*)(ws + O_CS) + e0;
      const int n = e0 >> 7, k = e0 & 127;
#pragma unroll
      for (int e = 0; e < 8; ++e) {
        const float fr = (float)(((n & 127) * (k + e)) & 127) * (1.f / 128.f);
        v[e] = (n < 128) ? __builtin_amdgcn_cosf(fr) : __builtin_amdgcn_sinf(fr);
      }
    } else if (j < 80) {
      const int e0 = (j - 16) * 2048 + tid * 8; dst8 = (unsigned char*)(ws + O_D256) + e0;
      const int k1 = e0 >> 9, kk = e0 & 511;
#pragma unroll
      for (int e = 0; e < 8; ++e) {
        const int t = (kk + e) & 255;
        const float fr = (float)((k1 * t) & 255) * (1.f / 256.f);
        v[e] = (kk < 256) ? __builtin_amdgcn_cosf(fr) : -__builtin_amdgcn_sinf(fr);
      }
    } else {
      const int e0 = (j - 80) * 2048 + tid * 8; dst8 = (unsigned char*)(ws + O_D1024) + e0;
      const int k1 = e0 >> 11, kk = e0 & 2047;
#pragma unroll
      for (int e = 0; e < 8; ++e) {
        const int t = (kk + e) & 1023;
        const float fr = (float)((k1 * t) & 1023) * (1.f / 1024.f);
        v[e] = (kk < 1024) ? __builtin_amdgcn_cosf(fr) : -__builtin_amdgcn_sinf(fr);
      }
    }
    if (dst8) {
      u32x2 w8; w8.x = pk4f8(v[0] * 64.f, v[1] * 64.f, v[2] * 64.f, v[3] * 64.f); w8.y = pk4f8(v[4] * 64.f, v[5] * 64.f, v[6] * 64.f, v[7] * 64.f);
      *(u32x2*)dst8 = w8;
    } else {
      u32x4 w; w.x = pk2(v[0], v[1]); w.y = pk2(v[2], v[3]); w.z = pk2(v[4], v[5]); w.w = pk2(v[6], v[7]);
      *(u32x4*)dst = w;
    }
  }
}

__device__ __forceinline__ void norm_item(const Params& p, int l, int item, const float* xp, const float* xs) {
  const int tid = tidx(), lane = tid & 63, wid = tid >> 6;
  bf16_t* H = (bf16_t*)(p.ws + O_H);
#pragma unroll 3
  for (int i = 0; i < 6; ++i) {
    const int row = item * 24 + wid * 6 + i;
    const float* src = row < NPR ? xp + (size_t)row * 1024 : xs + (size_t)(row - NPR) * 1024;
    const int v = row < NPR ? 0 : 1 + ((row - NPR) >> 10);
    const float* mod = (const float*)(p.ws + O_MOD) + (l * 5 + v) * 3072;
    f32x4 x[4]; float ss = 0.f;
#pragma unroll
    for (int q = 0; q < 4; ++q) { x[q] = *(const f32x4*)(src + (q * 64 + lane) * 4); ss += x[q][0] * x[q][0] + x[q][1] * x[q][1] + x[q][2] * x[q][2] + x[q][3] * x[q][3]; }
    ss = wave_sum(ss);
    const float rstd = rsqrtf(ss * (1.f / 1024.f) + EPSN);
#pragma unroll
    for (int q = 0; q < 4; ++q) {
      const int col = (q * 64 + lane) * 4;
      const f32x4 g = *(const f32x4*)(p.norm_g + l * 1024 + col), sc = *(const f32x4*)(mod + 1024 + col), sh = *(const f32x4*)(mod + col);
      f32x4 h;
#pragma unroll
      for (int e = 0; e < 4; ++e) h[e] = x[q][e] * rstd * g[e] * (1.f + sc[e]) + sh[e];
      *(u32x2*)(H + (size_t)row * 1024 + col) = pk4(h);
      *(unsigned*)(p.ws + O_H8 + (size_t)row * 1024 + col) = pk4f8(h[0], h[1], h[2], h[3]);
    }
  }
}
__device__ __forceinline__ void final_item(const Params& p, int item) {
  const int tid = tidx(), lane = tid & 63, wid = tid >> 6;
#pragma unroll 3
  for (int i = 0; i < 6; ++i) {
    const int row = item * 24 + wid * 6 + i;
    float* src = p.out + (size_t)row * 1024;
    f32x4 x[4]; float ss = 0.f;
#pragma unroll
    for (int q = 0; q < 4; ++q) { x[q] = *(const f32x4*)(src + (q * 64 + lane) * 4); ss += x[q][0] * x[q][0] + x[q][1] * x[q][1] + x[q][2] * x[q][2] + x[q][3] * x[q][3]; }
    ss = wave_sum(ss);
    const float rstd = rsqrtf(ss * (1.f / 1024.f) + EPSN);
#pragma unroll
    for (int q = 0; q < 4; ++q) {
      const int col = (q * 64 + lane) * 4;
      const f32x4 g = *(const f32x4*)(p.final_g + col);
      f32x4 y;
#pragma unroll
      for (int e = 0; e < 4; ++e) y[e] = x[q][e] * rstd * g[e];
      *(f32x4*)(src + col) = y;
    }
  }
}

__device__ __forceinline__ void s2_tile(const Params& p, int l, int tile, char* lds) {
  const int tid = tidx(), lane = tid & 63, wid = tid >> 6, wm = wid >> 1, wn = wid & 1, fr = lane & 15, fq = lane >> 4;
  const int m = (tile / 480) * 16 + (tile % 16), nt = (tile % 480) / 16, m0 = m * 128, n0 = nt * 128;
  char* ws = wsp(p.ws);
  const bf16_t* A = (const bf16_t*)(ws + O_H) + (size_t)m0 * 1024;
  const bf16_t* B = (const bf16_t*)(ws + O_WIN) + ((size_t)l * 6912 + n0) * 1024;
  const bool f8 = (nt >= 12 && nt < 15) || (nt >= 21 && nt < 25);
  const int row8 = nt < 8 ? nt * 128 : (nt < 15 ? 1024 + (nt - 12) * 128 : 1408 + (nt - 21) * 128);
  const char* A8 = (const char*)(ws + O_H8) + (size_t)m0 * 1024;
  const char* B8 = (const char*)(ws + O_WS8) + ((size_t)l * 1920 + row8) * 1024;
  const float s8 = f8 ? 0.03125f : 1.f;
  f32x4 acc[4][4];
  zero_acc(acc);
  if (nt >= 4 && nt < 8) {
    gemm_core<false>(A, 1024, B, 1024, 1024, acc, lds);
    bf16_t* RVT = (bf16_t*)(ws + O_RVT);
#pragma unroll
    for (int i = 0; i < 4; ++i) {
      const int tok = m0 + wm * 64 + i * 16 + fq * 4;
      size_t base; int T, b, t;
      if (tok < NPR) { b = tok >> 8; t = tok & 255; T = 256; base = 0; } else { const int s = tok - NPR; b = s >> 10; t = s & 1023; T = 1024; base = (size_t)NPR * 512; }
#pragma unroll
      for (int j = 0; j < 4; ++j) {
        const int c = n0 - 512 + wn * 64 + j * 16 + fr, h = c >> 7, vd = c & 127;
        *(u32x2*)(RVT + base + ((size_t)(b * 4 + h) * 128 + vd) * T + t) = pk4(acc[i][j]);
      }
    }
    return;
  }
  if (f8) { int par = 0; gemm_bytes<true, 4, 1, true>(A8, 1024, B8, 1024, 1024, acc, lds, par, false, nullptr, 0, nullptr, 0); }
  else gemm_core<true>(A, 1024, B, 1024, 1024, acc, lds);
  bf16_t* dst = nullptr; int ld = 0, c0 = 0, op = 0;
  if (nt < 2) { dst = (bf16_t*)(ws + O_RQ); ld = 256; c0 = 0; }
  else if (nt < 4) { dst = (bf16_t*)(ws + O_RK); ld = 256; c0 = 256; op = 2; }
  else if (nt < 12) { dst = (bf16_t*)(ws + O_RZ); ld = 512; c0 = 1024; op = 1; }
  else if (nt < 15) { ld = 384; c0 = 1536; op = 5; }
  else if (nt < 17) { ld = 256; c0 = 1920; op = 3; }
  else if (nt < 21) { dst = (bf16_t*)(ws + O_MZ); ld = 512; c0 = 2176; op = 1; }
  else if (nt < 25) { dst = (bf16_t*)(ws + O_FU); ld = 512; c0 = 2688; }
  else if (nt < 29) { dst = (bf16_t*)(ws + O_FZ); ld = 512; c0 = 3200; op = 1; }
  else { ld = 32; c0 = 3712; op = 4; }
#pragma unroll
  for (int i = 0; i < 4; ++i) {
    const int tok = m0 + wm * 64 + i * 16 + fr;
#pragma unroll
    for (int j = 0; j < 4; ++j) {
      const int col = n0 - c0 + wn * 64 + j * 16 + fq * 4;
      f32x4 v = acc[i][j] * s8;
      if (op == 3) { *(f32x4*)((float*)(ws + O_KVLAT) + (size_t)tok * 256 + col) = v; continue; }
      if (op == 5) { *(unsigned*)(ws + O_QLAT + (size_t)tok * 384 + col) = pk4f8(v[0] * 8.f, v[1] * 8.f, v[2] * 8.f, v[3] * 8.f); continue; }
      if (op == 4) { if (col < 32) *(f32x4*)((float*)(ws + O_KR) + (size_t)tok * 32 + col) = v; continue; }
      if (op == 1) {
#pragma unroll
        for (int e = 0; e < 4; ++e) v[e] = silu_f(v[e]);
      } else if (op == 2) {
#pragma unroll
        for (int e = 0; e < 4; ++e) v[e] *= 0.125f;
      }
      const u32x2 w = pk4(v);
      *(u32x2*)(dst + (size_t)tok * ld + col) = w;
      if (op == 2 && tok < NPR) {
        bf16_t* RKT = (bf16_t*)(ws + O_RKT);
        const int b = tok >> 8, t = tok & 255, h = col >> 6, dk = col & 63;
        bf16_t* q = RKT + ((size_t)(b * 4 + h) * 64 + dk) * 256 + t;
        q[0] = (bf16_t)(w.x & 0xffffu); q[256] = (bf16_t)(w.x >> 16); q[512] = (bf16_t)(w.y & 0xffffu); q[768] = (bf16_t)(w.y >> 16);
      }
    }
  }
}

template <int MODE>
__device__ __forceinline__ void attn_item(const Params& p, int l, int item, char* lds) {
  constexpr int NKP = MODE == 0 ? 3 : 2;
  constexpr int NVB = MODE == 0 ? 4 : 8;
  constexpr int PV = NVB * 16 * 64;
  constexpr int KOFF = NKP * 4096;
  constexpr int BUF = KOFF + 2 * PV;
  const int tid = tidx(), lane = tid & 63, wid = tid >> 6, fr = lane & 15, fq = lane >> 4;
  char* ws = wsp(p.ws);
  int smp, b, h, qblk, T, Tk, tok0;
  const bf16_t *kbase, *rbase = nullptr, *vbase, *qbase;
  int kstride, qstride;
  if (MODE == 0) {
    if (item < 256) { smp = 1; b = item >> 6; h = (item >> 3) & 7; qblk = item & 7; T = 1024; Tk = 1536; tok0 = NPR + b * 1024 + qblk * 128; }
    else { const int it = item - 256; smp = 0; b = it >> 4; h = (it >> 1) & 7; qblk = it & 1; T = 256; Tk = 256; tok0 = b * 256 + qblk * 128; }
    const int keyrow0 = smp ? NPR + b * 1536 : b * 256;
    kbase = (const bf16_t*)(ws + O_KB) + (size_t)keyrow0 * 512 + h * 64; kstride = 512;
    rbase = (const bf16_t*)(ws + O_KRA) + (size_t)keyrow0 * 32;
    vbase = (const bf16_t*)(ws + O_VT) + (smp ? (size_t)NPR * 512 + (size_t)(b * 8 + h) * 64 * 1536 : (size_t)(b * 8 + h) * 64 * 256);
    qbase = (const bf16_t*)(ws + O_QB) + (size_t)tok0 * 768 + h * 96; qstride = 768;
  } else {
    if (item < 128) { smp = 1; b = item >> 5; h = (item >> 3) & 3; qblk = item & 7; T = 1024; tok0 = NPR + b * 1024 + qblk * 128; }
    else { const int it = item - 128; smp = 0; b = it >> 3; h = (it >> 1) & 3; qblk = it & 1; T = 256; tok0 = b * 256 + qblk * 128; }
    Tk = T;
    const int ktok0 = smp ? NPR + b * 1024 : b * 256;
    kbase = (const bf16_t*)(ws + O_RK) + (size_t)ktok0 * 256 + h * 64; kstride = 256;
    vbase = (const bf16_t*)(ws + O_RVT) + (smp ? (size_t)NPR * 512 + (size_t)(b * 4 + h) * 128 * 1024 : (size_t)(b * 4 + h) * 128 * 256);
    qbase = (const bf16_t*)(ws + O_RQ) + (size_t)tok0 * 256 + h * 64; qstride = 256;
  }
  const int nkt = Tk >> 6;
  bf16x8 qf[2][NKP];
#pragma unroll
  for (int qb = 0; qb < 2; ++qb)
#pragma unroll
    for (int ks = 0; ks < NKP; ++ks) qf[qb][ks] = *(const bf16x8*)(qbase + (size_t)(wid * 32 + qb * 16 + fr) * qstride + ks * 32 + fq * 8);
  f32x4 o[NVB][2];
#pragma unroll
  for (int vb = 0; vb < NVB; ++vb) { o[vb][0] = (f32x4){0.f, 0.f, 0.f, 0.f}; o[vb][1] = (f32x4){0.f, 0.f, 0.f, 0.f}; }
  float lgf = 0.f, lgb = 0.f;
  float mrow[2] = {-INFINITY, -INFINITY}, lrow[2] = {0.f, 0.f};
  const int tq0 = qblk * 128 + wid * 32 + fr;
  if (MODE == 1) {
    const float xf = p.ret_logit[(l * 2 + 0) * 4 + h], xb = p.ret_logit[(l * 2 + 1) * 4 + h];
    lgf = -log1pf(expf(-xf)) * 1.44269504089f; lgb = -log1pf(expf(-xb)) * 1.44269504089f;
    if (smp) {
      const bf16_t* s0 = (const bf16_t*)(ws + O_S0T);
#pragma unroll
      for (int dir = 0; dir < 2; ++dir) {
        const bf16_t* sb = s0 + ((size_t)(((b * 2 + l) * 2 + dir) * 4 + h) * 128) * 64;
        float dec[2];
#pragma unroll
        for (int qb = 0; qb < 2; ++qb) { const int tq = tq0 + qb * 16; dec[qb] = dir == 0 ? ex2((float)(tq + 1) * lgf) : ex2((float)(T - tq) * lgb); }
#pragma unroll
        for (int vb = 0; vb < NVB; ++vb) {
          f32x4 t0 = (f32x4){0.f, 0.f, 0.f, 0.f}, t1 = (f32x4){0.f, 0.f, 0.f, 0.f};
#pragma unroll
          for (int ks = 0; ks < 2; ++ks) {
            const bf16x8 sf = *(const bf16x8*)(sb + (size_t)(vb * 16 + fr) * 64 + ks * 32 + fq * 8);
            t0 = mfma16(sf, qf[0][ks], t0); t1 = mfma16(sf, qf[1][ks], t1);
          }
          o[vb][0] += t0 * dec[0]; o[vb][1] += t1 * dec[1];
        }
      }
    }
  }
  u32x4 vreg[NVB / 2];
  const int uw = __builtin_amdgcn_readfirstlane(wid);
  const int dkey = lane >> 2, dchunk = (lane & 3) ^ swz(dkey);
  auto kdma = [&](int kt, char* buf) {
    const GAS bf16_t* kp = (const GAS bf16_t*)kbase + (size_t)(kt * 64 + uw * 16 + dkey) * kstride + dchunk * 8;
#pragma unroll
    for (int pn = 0; pn < 2; ++pn)
      __builtin_amdgcn_global_load_lds((const GAS unsigned*)(kp + pn * 32), (LAS unsigned*)((LAS char*)buf + pn * 4096 + uw * 1024), 16, 0, 0);
    if (MODE == 0) {
      const GAS bf16_t* rp = (const GAS bf16_t*)rbase + (size_t)(kt * 64 + uw * 16 + dkey) * 32 + dchunk * 8;
      __builtin_amdgcn_global_load_lds((const GAS unsigned*)rp, (LAS unsigned*)((LAS char*)buf + 2 * 4096 + uw * 1024), 16, 0, 0);
    }
  };
  auto gload = [&](int kt) {
#pragma unroll
    for (int i = 0; i < NVB / 2; ++i) { const int idx = tid + 256 * i, vd = idx >> 3, g = idx & 7; vreg[i] = ldg16(vbase + (size_t)vd * Tk + kt * 64 + g * 8); }
  };
  auto lstore = [&](char* buf) {
#pragma unroll
    for (int i = 0; i < NVB / 2; ++i) {
      const int idx = tid + 256 * i, vd = idx >> 3, g = idx & 7, pnl = g >> 2, g4 = g & 3, hi = g4 >> 1, q0 = 2 * (g4 & 1);
      char* base = buf + KOFF + pnl * PV + vd * 64 + hi * 8;
      *(u32x2*)(base + ((q0 ^ swz(vd)) << 4)) = (u32x2){vreg[i].x, vreg[i].y};
      *(u32x2*)(base + (((q0 + 1) ^ swz(vd)) << 4)) = (u32x2){vreg[i].z, vreg[i].w};
    }
  };
  __syncthreads();
  kdma(0, lds); gload(0); lstore(lds);
  asm volatile("s_waitcnt vmcnt(0)" ::: "memory");
  __syncthreads();
  const int foff = fr * 64 + ((fq ^ swz(fr)) << 4);
  for (int kt = 0; kt < nkt; ++kt) {
    char* cur = lds + (kt & 1) * BUF;
    const bool more = (kt + 1) < nkt;
    if (more) { kdma(kt + 1, lds + ((kt + 1) & 1) * BUF); gload(kt + 1); }
    __builtin_amdgcn_sched_barrier(0);
    f32x4 s[4][2];
#pragma unroll
    for (int kb = 0; kb < 4; ++kb) {
      s[kb][0] = (f32x4){0.f, 0.f, 0.f, 0.f}; s[kb][1] = (f32x4){0.f, 0.f, 0.f, 0.f};
#pragma unroll
      for (int ks = 0; ks < NKP; ++ks) {
        const bf16x8 kf = *(const bf16x8*)(cur + ks * 4096 + kb * 1024 + foff);
        s[kb][0] = mfma16(kf, qf[0][ks], s[kb][0]); s[kb][1] = mfma16(kf, qf[1][ks], s[kb][1]);
      }
    }
    bf16x8 pf[2][2];
#pragma unroll
    for (int qb = 0; qb < 2; ++qb) {
      if (MODE == 0) {
        float mx = s[0][qb][0];
#pragma unroll
        for (int kb = 0; kb < 4; ++kb)
#pragma unroll
          for (int r = 0; r < 4; ++r) mx = fmaxf(mx, s[kb][qb][r]);
        mx = fmaxf(mx, __shfl_xor(mx, 16)); mx = fmaxf(mx, __shfl_xor(mx, 32));
        const float mn = fmaxf(mrow[qb], mx), alpha = ex2(mrow[qb] - mn);
        mrow[qb] = mn;
        float ls = 0.f;
#pragma unroll
        for (int kb = 0; kb < 4; ++kb)
#pragma unroll
          for (int r = 0; r < 4; ++r) { const float e = ex2(s[kb][qb][r] - mn); s[kb][qb][r] = e; ls += e; }
        lrow[qb] = lrow[qb] * alpha + ls;
#pragma unroll
        for (int vb = 0; vb < NVB; ++vb) o[vb][qb] *= alpha;
      } else {
        const int tq = tq0 + qb * 16;
#pragma unroll
        for (int kb = 0; kb < 4; ++kb)
#pragma unroll
          for (int r = 0; r < 4; ++r) {
            const int d = tq - (kt * 64 + kb * 16 + fq * 4 + r);
            const float dec = d > 0 ? ex2((float)d * lgf) : (d < 0 ? ex2((float)(-d) * lgb) : 2.f);
            s[kb][qb][r] *= dec;
          }
      }
#pragma unroll
      for (int g = 0; g < 2; ++g) {
        u32x4 w; w.x = pk2(s[2 * g][qb][0], s[2 * g][qb][1]); w.y = pk2(s[2 * g][qb][2], s[2 * g][qb][3]);
        w.z = pk2(s[2 * g + 1][qb][0], s[2 * g + 1][qb][1]); w.w = pk2(s[2 * g + 1][qb][2], s[2 * g + 1][qb][3]);
        pf[qb][g] = as_bf8(w);
      }
    }
#pragma unroll
    for (int vb = 0; vb < NVB; ++vb)
#pragma unroll
      for (int g = 0; g < 2; ++g) {
        const bf16x8 vf = *(const bf16x8*)(cur + KOFF + g * PV + vb * 1024 + foff);
        o[vb][0] = mfma16(vf, pf[0][g], o[vb][0]); o[vb][1] = mfma16(vf, pf[1][g], o[vb][1]);
      }
    __builtin_amdgcn_sched_barrier(0);
    if (more) lstore(lds + ((kt + 1) & 1) * BUF);
    asm volatile("s_waitcnt vmcnt(0)" ::: "memory");
    __syncthreads();
  }
  bf16_t* G = (bf16_t*)(ws + (MODE == 0 ? O_MZ : O_RZ));
#pragma unroll
  for (int qb = 0; qb < 2; ++qb) {
    const int tok = tok0 + wid * 32 + qb * 16 + fr;
    float mul, sub;
    if (MODE == 0) {
      float lt = lrow[qb]; lt += __shfl_xor(lt, 16); lt += __shfl_xor(lt, 32);
      mul = 1.f / lt; sub = 0.f;
    } else {
      float sm = 0.f;
#pragma unroll
      for (int vb = 0; vb < NVB; ++vb) sm += (o[vb][qb][0] + o[vb][qb][1]) + (o[vb][qb][2] + o[vb][qb][3]);
      sm += __shfl_xor(sm, 16); sm += __shfl_xor(sm, 32);
      const float mu = sm * (1.f / 128.f);
      float vs = 0.f;
#pragma unroll
      for (int vb = 0; vb < NVB; ++vb)
#pragma unroll
        for (int r = 0; r < 4; ++r) { const float dd = o[vb][qb][r] - mu; vs += dd * dd; }
      vs += __shfl_xor(vs, 16); vs += __shfl_xor(vs, 32);
      mul = rsqrtf(vs * (1.f / 128.f) + EPSN); sub = mu;
    }
#pragma unroll
    for (int vb = 0; vb < NVB; ++vb) {
      bf16_t* gp = G + (size_t)tok * 512 + h * (NVB * 16) + vb * 16 + fq * 4;
      const u32x2 gz = *(const u32x2*)gp;
      f32x4 y;
      y[0] = (o[vb][qb][0] - sub) * mul * bflo(gz.x); y[1] = (o[vb][qb][1] - sub) * mul * bfhi(gz.x);
      y[2] = (o[vb][qb][2] - sub) * mul * bflo(gz.y); y[3] = (o[vb][qb][3] - sub) * mul * bfhi(gz.y);
      *(unsigned*)(ws + O_BR8 + (size_t)(MODE == 0 ? 1 : 0) * NTOK * 512 + (size_t)tok * 512 + h * (NVB * 16) + vb * 16 + fq * 4) = pk4f8(y[0] * 8.f, y[1] * 8.f, y[2] * 8.f, y[3] * 8.f);
    }
  }
}

__device__ __forceinline__ bf16x8 scale8(u32x4 raw, const float (&d)[8]) {
  u32x4 w;
  w.x = pk2(bflo(raw.x) * d[0], bfhi(raw.x) * d[1]); w.y = pk2(bflo(raw.y) * d[2], bfhi(raw.y) * d[3]);
  w.z = pk2(bflo(raw.z) * d[4], bfhi(raw.z) * d[5]); w.w = pk2(bflo(raw.w) * d[6], bfhi(raw.w) * d[7]);
  return as_bf8(w);
}
__device__ __forceinline__ void state_item(const Params& p, int l, int item) {
  const int tid = tidx(), lane = tid & 63, wid = tid >> 6, fr = lane & 15, fq = lane >> 4;
  const int b = item >> 2, h = item & 3;
  const bf16_t* RVT = (const bf16_t*)(p.ws + O_RVT) + (size_t)(b * 4 + h) * 128 * 256;
  const bf16_t* RKT = (const bf16_t*)(p.ws + O_RKT) + (size_t)(b * 4 + h) * 64 * 256;
  const float xf = p.ret_logit[(l * 2 + 0) * 4 + h], xb = p.ret_logit[(l * 2 + 1) * 4 + h];
  const float lgf = -log1pf(expf(-xf)) * 1.44269504089f, lgb = -log1pf(expf(-xb)) * 1.44269504089f;
  f32x4 acc[2][2][4];
#pragma unroll
  for (int d = 0; d < 2; ++d)
#pragma unroll
    for (int v = 0; v < 2; ++v)
#pragma unroll
      for (int k = 0; k < 4; ++k) acc[d][v][k] = (f32x4){0.f, 0.f, 0.f, 0.f};
#pragma unroll 2
  for (int ks = 0; ks < 8; ++ks) {
    const int j0 = ks * 32 + fq * 8;
    float df[8], db[8];
#pragma unroll
    for (int e = 0; e < 8; ++e) { df[e] = exp2f((float)(255 - j0 - e) * lgf); db[e] = exp2f((float)(j0 + e) * lgb); }
    bf16x8 af[2];
#pragma unroll
    for (int v = 0; v < 2; ++v) af[v] = *(const bf16x8*)(RVT + (size_t)((wid * 2 + v) * 16 + fr) * 256 + j0);
#pragma unroll
    for (int k = 0; k < 4; ++k) {
      const u32x4 raw = *(const u32x4*)(RKT + (size_t)(k * 16 + fr) * 256 + j0);
      const bf16x8 kf = scale8(raw, df), kb = scale8(raw, db);
#pragma unroll
      for (int v = 0; v < 2; ++v) { acc[0][v][k] = mfma16(af[v], kf, acc[0][v][k]); acc[1][v][k] = mfma16(af[v], kb, acc[1][v][k]); }
    }
  }
  float* O = p.out + OUT_RET;
#pragma unroll
  for (int d = 0; d < 2; ++d)
#pragma unroll
    for (int v = 0; v < 2; ++v)
#pragma unroll
      for (int k = 0; k < 4; ++k) {
        const int dk = k * 16 + fr, vd = (wid * 2 + v) * 16 + fq * 4;
        *(f32x4*)(O + ((size_t)((((b * 2 + l) * 2 + d) * 4 + h) * 64 + dk)) * 128 + vd) = acc[d][v][k];
      }
}

__device__ __forceinline__ void keyprep_item(const Params& p, int l, int item) {
  const int tid = tidx(), lane = tid & 63, wid = tid >> 6;
  char* ws = wsp(p.ws);
  unsigned char* CKVA = (unsigned char*)(ws + O_CKVA);
  bf16_t* KRA = (bf16_t*)(ws + O_KRA);
#pragma unroll
  for (int i = 0; i < 4; ++i) {
    const int R = item * 16 + wid * 4 + i;
    int smp = 0, b, t = 0, tok = 0, ctx = 0, pp = 0;
    if (R < NPR) { tok = R; b = R >> 8; t = R & 255; }
    else { smp = 1; const int s = R - NPR; b = s / 1536; pp = s - b * 1536; if (pp < 512) ctx = 1; else { t = pp - 512; tok = NPR + b * 1024 + t; } }
    if (ctx) {
      const f32x4 v = *(const f32x4*)(p.cache_ckv + ((size_t)((b * 2 + l) * 512 + pp)) * 256 + lane * 4);
      *(unsigned*)(CKVA + (size_t)R * 256 + lane * 4) = pk4f8(v[0] * 4.f, v[1] * 4.f, v[2] * 4.f, v[3] * 4.f);
      if (lane < 32) KRA[(size_t)R * 32 + lane] = tobf(p.cache_krope[((size_t)((b * 2 + l) * 512 + pp)) * 32 + lane]);
      continue;
    }
    const f32x4 v = *(const f32x4*)((const float*)(ws + O_KVLAT) + (size_t)tok * 256 + lane * 4);
    float ss = v[0] * v[0] + v[1] * v[1] + v[2] * v[2] + v[3] * v[3];
    ss = wave_sum(ss);
    const float rstd = rsqrtf(ss * (1.f / 256.f) + EPSN);
    const f32x4 g = *(const f32x4*)(p.kv_norm_g + l * 256 + lane * 4);
    f32x4 y;
#pragma unroll
    for (int e = 0; e < 4; ++e) y[e] = v[e] * rstd * g[e];
    *(unsigned*)(CKVA + (size_t)R * 256 + lane * 4) = pk4f8(y[0] * 4.f, y[1] * 4.f, y[2] * 4.f, y[3] * 4.f);
    if (!smp) *(f32x4*)(p.out + OUT_CKV + ((size_t)((b * 2 + l) * 256 + t)) * 256 + lane * 4) = y;
    const int d = lane & 31;
    const float x = ((const float*)(ws + O_KR))[(size_t)tok * 32 + d];
    float yk = x;
    if (smp) {
      const float pr = __shfl_xor(x, 8);
      const int hd = d >> 4, i16 = d & 15, f = i16 & 7;
      const int pos = hd ? (t & 63) : (t >> 6);
      const float* rt = (const float*)(ws + O_ROPE) + (pos * 8 + f) * 2;
      const float cs = rt[0], sn = rt[1];
      yk = i16 < 8 ? x * cs - pr * sn : pr * sn + x * cs;
    } else if (lane < 32) {
      p.out[OUT_KR + ((size_t)((b * 2 + l) * 256 + t)) * 32 + d] = x;
    }
    if (lane < 32) KRA[(size_t)R * 32 + d] = tobf(yk);
  }
}

__device__ __forceinline__ void f1_tile(const Params& p, int tile, char* lds) {
  const int tid = tidx(), lane = tid & 63, wid = tid >> 6, wm = wid >> 1, wn = wid & 1, fr = lane & 15, fq = lane >> 4;
  const int m = tile >> 3, g = (tile >> 1) & 3, nh = tile & 1, m0 = m * 128;
  char* ws = wsp(p.ws);
  f32x4 acc[4][4];
  zero_acc(acc);
  gemm_core<false>((const bf16_t*)(ws + O_FU) + (size_t)m0 * 512 + g * 128, 512, (const bf16_t*)(ws + O_CS) + (size_t)nh * 128 * 128, 128, 128, acc, lds);
  unsigned char* UT = (unsigned char*)(ws + O_UT);
#pragma unroll
  for (int i = 0; i < 4; ++i) {
    const int tok = m0 + wm * 64 + i * 16 + fq * 4;
    size_t base; int T, b, t;
    if (tok < NPR) { b = tok >> 8; t = tok & 255; T = 256; base = 0; } else { const int s = tok - NPR; b = s >> 10; t = s & 1023; T = 1024; base = (size_t)NPR * 1024; }
#pragma unroll
    for (int j = 0; j < 4; ++j) {
      const int k2 = wn * 64 + j * 16 + fr;
      *(unsigned*)(UT + base + ((size_t)(b * 4 + g) * 128 + k2) * (2 * T) + nh * T + t) = pk4f8(acc[i][j][0] * 4.f, acc[i][j][1] * 4.f, acc[i][j][2] * 4.f, acc[i][j][3] * 4.f);
    }
  }
}

__device__ __forceinline__ void qup_tile(const Params& p, int l, int tile, char* lds) {
  const int tid = tidx(), lane = tid & 63, wid = tid >> 6, wm = wid >> 1, wn = wid & 1, fr = lane & 15, fq = lane >> 4;
  const int m = tile % 96, nt = tile / 96, m0 = m * 128, n0 = nt * 128;
  char* ws = wsp(p.ws);
  const char* QL = (const char*)(ws + O_QLAT) + (size_t)m0 * 384;
  float rsv4[4];
  {
    float* rs = (float*)lds;
    __syncthreads();
#pragma unroll 1
    for (int r0 = 0; r0 < 32; r0 += 4) {
      float ss[4];
#pragma unroll
      for (int u = 0; u < 4; ++u) {
        u32x4 w = (u32x4){0u, 0u, 0u, 0u};
        if (lane < 24) w = ldg16(QL + (size_t)(wid * 32 + r0 + u) * 384 + lane * 16);
        float a = 0.f;
#pragma unroll
        for (int q = 0; q < 4; ++q) {
          const float f0 = __builtin_amdgcn_cvt_f32_fp8(w[q], 0), f1 = __builtin_amdgcn_cvt_f32_fp8(w[q], 1), f2 = __builtin_amdgcn_cvt_f32_fp8(w[q], 2), f3 = __builtin_amdgcn_cvt_f32_fp8(w[q], 3);
          a += f0 * f0 + f1 * f1 + f2 * f2 + f3 * f3;
        }
        ss[u] = a;
      }
#pragma unroll
      for (int u = 0; u < 4; ++u) { const float t = wave_sum(ss[u]); if (lane == 0) rs[wid * 32 + r0 + u] = rsqrtf(t * (1.f / (384.f * 64.f)) + EPSN); }
    }
    __syncthreads();
#pragma unroll
    for (int i = 0; i < 4; ++i) rsv4[i] = rs[wm * 64 + i * 16 + fr];
    __syncthreads();
  }
  f32x4 acc[4][4];
  zero_acc(acc);
  { int par = 0; gemm_bytes<true, 4, 1, true>(QL, 384, (const char*)(ws + O_WQ) + ((size_t)l * 768 + n0) * 384, 384, 384, acc, lds, par, false, nullptr, 0, nullptr, 0); }
  bf16_t* QB = (bf16_t*)(ws + O_QB);
  const float qscale = 0.10206207261596577f * 1.44269504089f * (1.f / 256.f);
#pragma unroll
  for (int i = 0; i < 4; ++i) {
    const int rl = wm * 64 + i * 16 + fr, tok = m0 + rl;
    const float sc = rsv4[i] * qscale;
    const int smp = tok >= NPR, t = (tok - NPR) & 1023;
#pragma unroll
    for (int j = 0; j < 4; ++j) {
      const int cb = n0 + wn * 64 + j * 16, within = cb % 96;
      f32x4 v = acc[i][j] * sc;
      if (within >= 64) {
        f32x4 pr;
#pragma unroll
        for (int e = 0; e < 4; ++e) pr[e] = __shfl_xor(v[e], 32);
        if (smp) {
          const int pos = within >= 80 ? (t & 63) : (t >> 6);
          const float* rt = (const float*)(ws + O_ROPE) + (pos * 8 + (fq & 1) * 4) * 2;
          const f32x4 c01 = *(const f32x4*)rt, c23 = *(const f32x4*)(rt + 4);
          const float cs4[4] = {c01[0], c01[2], c23[0], c23[2]}, sn4[4] = {c01[1], c01[3], c23[1], c23[3]};
#pragma unroll
          for (int e = 0; e < 4; ++e) v[e] = fq < 2 ? v[e] * cs4[e] - pr[e] * sn4[e] : pr[e] * sn4[e] + v[e] * cs4[e];
        }
      }
      *(u32x2*)(QB + (size_t)tok * 768 + cb + fq * 4) = pk4(v);
    }
  }
}

__device__ __forceinline__ void kvup_tile(const Params& p, int l, int tile, char* lds) {
  const int tid = tidx(), lane = tid & 63, wid = tid >> 6, wm = wid >> 1, wn = wid & 1, fr = lane & 15, fq = lane >> 4;
  const int m = tile % 112, nt = tile / 112, m0 = m * 128, n0 = nt * 128;
  char* ws = wsp(p.ws);
  const char* A = (const char*)(ws + O_CKVA) + (size_t)m0 * 256;
  const char* B = (const char*)(ws + O_WKV) + ((size_t)l * 1024 + n0) * 256;
  const float ks = 1.f / 128.f;
  f32x4 acc[4][4];
  zero_acc(acc);
  if (nt < 4) {
    { int par = 0; gemm_bytes<true, 4, 1, true>(A, 256, B, 256, 256, acc, lds, par, false, nullptr, 0, nullptr, 0); }
    bf16_t* KB = (bf16_t*)(ws + O_KB);
#pragma unroll
    for (int i = 0; i < 4; ++i) {
      const int R = m0 + wm * 64 + i * 16 + fr;
#pragma unroll
      for (int j = 0; j < 4; ++j) *(u32x2*)(KB + (size_t)R * 512 + n0 + wn * 64 + j * 16 + fq * 4) = pk4(acc[i][j] * ks);
    }
  } else {
    { int par = 0; gemm_bytes<false, 4, 1, true>(A, 256, B, 256, 256, acc, lds, par, false, nullptr, 0, nullptr, 0); }
    bf16_t* VT = (bf16_t*)(ws + O_VT);
#pragma unroll
    for (int i = 0; i < 4; ++i) {
      const int R = m0 + wm * 64 + i * 16 + fq * 4;
      size_t base; int Tk, b, k;
      if (R < NPR) { b = R >> 8; k = R & 255; Tk = 256; base = 0; } else { const int s = R - NPR; b = s / 1536; k = s - b * 1536; Tk = 1536; base = (size_t)NPR * 512; }
#pragma unroll
      for (int j = 0; j < 4; ++j) {
        const int c = n0 - 512 + wn * 64 + j * 16 + fr, h = c >> 6, vd = c & 63;
        *(u32x2*)(VT + base + ((size_t)(b * 8 + h) * 64 + vd) * Tk + k) = pk4(acc[i][j] * ks);
      }
    }
  }
}

template <int NJ>
__device__ __forceinline__ void f2_tile(const Params& p, int tile, char* lds) {
  const int tid = tidx(), lane = tid & 63, wid = tid >> 6, wm = wid >> 1, wn = wid & 1, fr = lane & 15, fq = lane >> 4;
  char* ws = wsp(p.ws);
  const char *A, *B; int K, tokb, g, nh = 0; float scale;
  if (NJ == 2) {
    const int b = tile >> 6, mt = (tile >> 1) & 7; g = (tile >> 4) & 3; nh = tile & 1;
    A = (const char*)(ws + O_D1024) + (size_t)mt * 128 * 2048; K = 2048;
    B = (const char*)(ws + O_UT) + (size_t)NPR * 1024 + ((size_t)(b * 4 + g) * 128 + nh * 64) * 2048;
    tokb = NPR + b * 1024 + mt * 128; scale = 0.00276213586400995f * (1.f / 256.f);
  } else {
    const int b = tile >> 3, mt = tile & 1; g = (tile >> 1) & 3;
    A = (const char*)(ws + O_D256) + (size_t)mt * 128 * 512; K = 512;
    B = (const char*)(ws + O_UT) + (size_t)(b * 4 + g) * 128 * 512;
    tokb = b * 256 + mt * 128; scale = 0.0055242717280199f * (1.f / 256.f);
  }
  f32x4 acc[4][NJ];
#pragma unroll
  for (int i = 0; i < 4; ++i)
#pragma unroll
    for (int j = 0; j < NJ; ++j) acc[i][j] = (f32x4){0.f, 0.f, 0.f, 0.f};
  { int par = 0; gemm_bytes<true, NJ, 1, true>(A, K, B, K, K, acc, lds, par, false, nullptr, 0, nullptr, 0); }
  bf16_t* FZ = (bf16_t*)(ws + O_FZ);
#pragma unroll
  for (int i = 0; i < 4; ++i) {
    const int tok = tokb + wm * 64 + i * 16 + fr;
#pragma unroll
    for (int j = 0; j < NJ; ++j) {
      bf16_t* gp = FZ + (size_t)tok * 512 + g * 128 + nh * 64 + wn * (NJ * 16) + j * 16 + fq * 4;
      const u32x2 gz = *(const u32x2*)gp;
      f32x4 y;
      y[0] = acc[i][j][0] * scale * bflo(gz.x); y[1] = acc[i][j][1] * scale * bfhi(gz.x);
      y[2] = acc[i][j][2] * scale * bflo(gz.y); y[3] = acc[i][j][3] * scale * bfhi(gz.y);
      *(unsigned*)(ws + O_BR8 + (size_t)2 * NTOK * 512 + (size_t)tok * 512 + g * 128 + nh * 64 + wn * (NJ * 16) + j * 16 + fq * 4) = pk4f8(y[0] * 8.f, y[1] * 8.f, y[2] * 8.f, y[3] * 8.f);
    }
  }
}

template <int NJ>
__device__ __forceinline__ void s6_tile(const Params& p, int l, int tile, int ntile, char* lds, int& par, bool& primed) {
  const int tid = tidx(), lane = tid & 63, wid = tid >> 6, wm = wid >> 1, wn = wid & 1, fr = lane & 15, fq = lane >> 4;
  constexpr int NT = 32 / NJ, BN = NJ * 32;
  const int m = (tile / (32 * NT)) * 32 + (tile % 32), nt = (tile % (32 * NT)) / 32, m0 = m * 128, n0 = nt * BN;
  char* ws = wsp(p.ws);
  const char* H8 = (const char*)(ws + O_H8);
  const char* W8 = (const char*)(ws + O_WG8) + (size_t)l * 3072 * 1024;
  const char* Wb = (const char*)(ws + O_WBR) + (size_t)(l * 3) * 1024 * 512;
  f32x4 tot[4][NJ], acc[4][NJ];
  unsigned sg[4][NJ];
#pragma unroll
  for (int i = 0; i < 4; ++i)
#pragma unroll
    for (int j = 0; j < NJ; ++j) tot[i][j] = (f32x4){0.f, 0.f, 0.f, 0.f};
#pragma unroll 1
  for (int nb = 0; nb < 3; ++nb) {
    u32x2 totp[4][NJ];
#pragma unroll
    for (int i = 0; i < 4; ++i)
#pragma unroll
      for (int j = 0; j < NJ; ++j) { totp[i][j] = pk4(tot[i][j]); acc[i][j] = (f32x4){0.f, 0.f, 0.f, 0.f}; }
    const char* brA = (const char*)(ws + O_BR8) + ((size_t)nb * NTOK + m0) * 512;
    const char* brB = Wb + ((size_t)nb * 1024 + n0) * 512;
    gemm_bytes<true, NJ, 2, true>(H8 + (size_t)m0 * 1024, 1024, W8 + ((size_t)nb * 1024 + n0) * 1024, 1024, 1024, acc, lds, par, primed, brA, 512, brB, 512);
#pragma unroll
    for (int i = 0; i < 4; ++i)
#pragma unroll
      for (int j = 0; j < NJ; ++j) {
        unsigned q = 0;
#pragma unroll
        for (int e = 0; e < 4; ++e) {
          const unsigned qe = (unsigned)fmaxf(sigm_f(acc[i][j][e] * 0.03125f) * 255.f + 0.5f, 1.f);
          q |= qe << (8 * e);
          tot[i][j][e] = (e == 0 ? bflo(totp[i][j].x) : e == 1 ? bfhi(totp[i][j].x) : e == 2 ? bflo(totp[i][j].y) : bfhi(totp[i][j].y)) * __builtin_amdgcn_rcpf((float)qe * (1.f / 255.f));
        }
        sg[i][j] = q;
      }
    const char *nA = nullptr, *nB = nullptr;
    if (nb < 2) { nA = H8 + (size_t)m0 * 1024; nB = W8 + ((size_t)(nb + 1) * 1024 + n0) * 1024; }
    else if (ntile >= 0) { nA = H8 + (size_t)(((ntile / (32 * NT)) * 32 + (ntile % 32)) * 128) * 1024; nB = W8 + (size_t)(((ntile % (32 * NT)) / 32) * BN) * 1024; }
    gemm_bytes<true, NJ, 2, true>(brA, 512, brB, 512, 512, tot, lds, par, true, nA, 1024, nB, 1024);
    primed = nA != nullptr;
#pragma unroll
    for (int i = 0; i < 4; ++i)
#pragma unroll
      for (int j = 0; j < NJ; ++j) {
        tot[i][j][0] *= (float)(sg[i][j] & 0xffu) * (1.f / 255.f); tot[i][j][1] *= (float)((sg[i][j] >> 8) & 0xffu) * (1.f / 255.f);
        tot[i][j][2] *= (float)((sg[i][j] >> 16) & 0xffu) * (1.f / 255.f); tot[i][j][3] *= (float)(sg[i][j] >> 24) * (1.f / 255.f);
      }
  }
  unsigned char* MG = (unsigned char*)(ws + O_UT);
#pragma unroll
  for (int i = 0; i < 4; ++i) {
    const int tok = m0 + wm * 64 + i * 16 + fr;
#pragma unroll
    for (int j = 0; j < NJ; ++j) *(unsigned*)(MG + (size_t)tok * 1024 + n0 + wn * (NJ * 16) + j * 16 + fq * 4) = pk4f8(tot[i][j][0] * (1.f / 256.f), tot[i][j][1] * (1.f / 256.f), tot[i][j][2] * (1.f / 256.f), tot[i][j][3] * (1.f / 256.f));
  }
}

__device__ __forceinline__ void s7_tile(const Params& p, int l, int tile, const float* xp, const float* xs, char* lds) {
  const int tid = tidx(), lane = tid & 63, wid = tid >> 6, wm = wid >> 1, wn = wid & 1, fr = lane & 15, fq = lane >> 4;
  const int m = (tile / 512) * 32 + (tile % 32), nt = (tile % 512) / 32, m0 = m * 128, n0 = nt * 64;
  char* ws = wsp(p.ws);
  f32x4 acc[4][2];
#pragma unroll
  for (int i = 0; i < 4; ++i) { acc[i][0] = (f32x4){0.f, 0.f, 0.f, 0.f}; acc[i][1] = (f32x4){0.f, 0.f, 0.f, 0.f}; }
  { int par = 0; gemm_bytes<true, 2, 1, true>((const char*)(ws + O_UT) + (size_t)m0 * 1024, 1024, (const char*)(ws + O_WO) + ((size_t)l * 1024 + n0) * 1024, 1024, 1024, acc, lds, par, false, nullptr, 0, nullptr, 0); }
#pragma unroll
  for (int i = 0; i < 4; ++i) {
    const int tok = m0 + wm * 64 + i * 16 + fr;
    const float* src = tok < NPR ? xp + (size_t)tok * 1024 : xs + (size_t)(tok - NPR) * 1024;
    const int v = tok < NPR ? 0 : 1 + ((tok - NPR) >> 10);
    const float* gate = (const float*)(ws + O_MOD) + (l * 5 + v) * 3072 + 2048;
#pragma unroll
    for (int j = 0; j < 2; ++j) {
      const int col = n0 + wn * 32 + j * 16 + fq * 4;
      const f32x4 x = *(const f32x4*)(src + col), gt = *(const f32x4*)(gate + col);
      f32x4 y;
#pragma unroll
      for (int e = 0; e < 4; ++e) y[e] = x[e] + gt[e] * (acc[i][j][e] * 0.03125f);
      *(f32x4*)(p.out + (size_t)tok * 1024 + col) = y;
    }
  }
}

constexpr int NPHASE = 16;
__device__ __forceinline__ int q_issue(unsigned* ctr) {
  int v = 0;
  if (threadIdx.x == 0) v = (int)__hip_atomic_fetch_add(ctr, 1u, __ATOMIC_RELAXED, __HIP_MEMORY_SCOPE_AGENT);
  return v;
}
__device__ __forceinline__ int q_bcast(int v, char* lds) {
  __syncthreads();
  if (threadIdx.x == 0) *(volatile int*)lds = v;
  __syncthreads();
  const int it = *(volatile int*)lds;
  __syncthreads();
  return it;
}
__device__ __forceinline__ void run_phase(const Params& p, int ph, char* lds, unsigned* qctr) {
  const int bid = blockIdx.x, nb = gridDim.x;
  if (ph == 0) { for (int i = bid; i < P0_N; i += nb) phase0_item(p, i, lds); return; }
  if (ph == 15) { for (int i = bid; i < 512; i += nb) final_item(p, i); return; }
  const int l = (ph - 1) / 7, s = (ph - 1) % 7;
  const float* xp = l == 0 ? p.x_prompt : p.out;
  const float* xs = l == 0 ? p.x_sample : p.out + (size_t)NPR * 1024;
  switch (s) {
    case 0: for (int i = bid; i < 512; i += nb) norm_item(p, l, i, xp, xs); break;
    case 1: for (int i = bid; i < 2880; i += nb) s2_tile(p, l, i, lds); break;
    case 2:
      for (int i = q_bcast(q_issue(qctr + ph), lds); i < 2752;) {
        if (i < 128) attn_item<1>(p, l, i, lds);
        else if (i < 1024) keyprep_item(p, l, i - 128);
        else if (i < 1280) attn_item<1>(p, l, 128 + (i - 1024), lds);
        else if (i < 1408) state_item(p, l, i - 1280);
        else if (i < 1984) qup_tile(p, l, i - 1408, lds);
        else f1_tile(p, i - 1984, lds);
        i = q_bcast(q_issue(qctr + ph), lds);
      }
      break;
    case 3:
      for (int i = q_bcast(q_issue(qctr + ph), lds); i < 1408;) {
        if (i < 256) f2_tile<2>(p, i, lds);
        else if (i < 512) f2_tile<4>(p, i - 256, lds);
        else kvup_tile(p, l, i - 512, lds);
        i = q_bcast(q_issue(qctr + ph), lds);
      }
      break;
    case 4:
      for (int i = q_bcast(q_issue(qctr + ph), lds); i < 768;) {
        attn_item<0>(p, l, i, lds);
        i = q_bcast(q_issue(qctr + ph), lds);
      }
      break;
    case 5: { int par = 0; bool primed = false; for (int i = bid; i < 768; i += nb) s6_tile<4>(p, l, i, (i + nb < 768) ? i + nb : -1, lds, par, primed); } break;
    case 6: for (int i = bid; i < 1536; i += nb) s7_tile(p, l, i, xp, xs, lds); break;
  }
}

#define XB_TMO      128
#define XB_XCNT(j)  (256  + 64 * (j))
#define XB_XSUB(j)  (1280 + 64 * (j))
#define XB_XGEN(j)  (2304 + 64 * (j))
#define XB_TOP      3328
#define XB_TOPGEN   3392
#define XCD_BAR_WORDS 3456
#define XB_SPIN_CAP (1u << 18)
__device__ __forceinline__ unsigned xb_ld(unsigned* p)              { return __hip_atomic_load(p, __ATOMIC_RELAXED, __HIP_MEMORY_SCOPE_AGENT); }
__device__ __forceinline__ unsigned xb_add(unsigned* p, unsigned v) { return __hip_atomic_fetch_add(p, v, __ATOMIC_RELAXED, __HIP_MEMORY_SCOPE_AGENT); }
__device__ __forceinline__ unsigned xb_xcc_id() { return (unsigned)__builtin_amdgcn_s_getreg((3 << 11) | 20) & 0xFu; }
#define XB_SPIN(cond, bar) do { unsigned _sp = 0; while (cond) { __builtin_amdgcn_s_sleep(1); \
    if ((++_sp & 255u) == 0u) { if (xb_ld(&(bar)[XB_TMO])) break; if (_sp > XB_SPIN_CAP) { atomicAdd(&(bar)[XB_TMO], 1u); break; } } } } while (0)
__device__ __forceinline__ void xcd_barrier_complete(unsigned* bar, unsigned x, unsigned& nloc, unsigned& nx) {
  const unsigned G = gridDim.x;
  unsigned sum, cnt, mine, sp = 0u;
  for (;;) {
    sum = 0u; cnt = 0u; mine = 0u;
#pragma unroll
    for (unsigned j = 0; j < 16; ++j) { const unsigned c = xb_ld(&bar[XB_XCNT(j)]); sum += c; cnt += (c > 0u) ? 1u : 0u; mine = (j == x) ? c : mine; }
    if (sum == G) break;
    __builtin_amdgcn_s_sleep(1);
    if ((++sp & 255u) == 0u) { if (xb_ld(&bar[XB_TMO])) break; if (sp > XB_SPIN_CAP) { atomicAdd(&bar[XB_TMO], 1u); break; } }
  }
  nloc = mine > 0u ? mine : 1u; nx = cnt > 0u ? cnt : 1u;
}
__device__ __forceinline__ void xcd_barrier(unsigned* bar, unsigned x, unsigned& nloc, unsigned& nx) {
  asm volatile("s_waitcnt vmcnt(0)" ::: "memory");
  __syncthreads();
  if (threadIdx.x == 0) {
    __builtin_amdgcn_s_waitcnt(0);
    if (nloc == 0u) xcd_barrier_complete(bar, x, nloc, nx);
    const unsigned old = xb_add(&bar[XB_XSUB(x)], 1u);
    const unsigned gen = old / nloc;
    if (old + 1u == (gen + 1u) * nloc) {
      __builtin_amdgcn_fence(__ATOMIC_RELEASE, "agent");
      asm volatile("s_waitcnt vmcnt(0)" ::: "memory");
      const unsigned og = xb_add(&bar[XB_TOP], 1u);
      const unsigned tg = og / nx;
      if (og + 1u == (tg + 1u) * nx) xb_add(&bar[XB_TOPGEN], 1u);
      else XB_SPIN(xb_ld(&bar[XB_TOPGEN]) == tg, bar);
      __builtin_amdgcn_fence(__ATOMIC_ACQUIRE, "agent");
      xb_add(&bar[XB_XGEN(x)], 1u);
      asm volatile("s_waitcnt vmcnt(0)" ::: "memory");
    } else {
      XB_SPIN(xb_ld(&bar[XB_XGEN(x)]) == gen, bar);
      __builtin_amdgcn_fence(__ATOMIC_ACQUIRE, "agent");
      asm volatile("s_waitcnt vmcnt(0)" ::: "memory");
    }
  }
  __syncthreads();
}

__global__ void __launch_bounds__(256, 2) mk_fwd(Params p) {
  __shared__ __attribute__((aligned(16))) char lds[LDS_TOTAL];
  cg::grid_group grid = cg::this_grid();
  unsigned* bar = (unsigned*)(p.ws + O_BAR);
  const unsigned xcc = xb_xcc_id();
  if (threadIdx.x == 0) (void)xb_add(&bar[XB_XCNT(xcc)], 1u);
  unsigned nloc = 0u, nx = 0u;
  if (gridDim.x == 0x7fffffffu) grid.sync();
#pragma unroll 1
  for (int ph = 0; ph < NPHASE; ++ph) {
    run_phase(p, ph, lds, bar);
    if (ph + 1 < NPHASE) xcd_barrier(bar, xcc, nloc, nx);
  }
}

extern "C" void kernel_launch(void* const* d_in, const int* in_sizes, int n_in, void* d_out, int out_size, void* d_ws, size_t ws_size,
                              hipStream_t stream) {
  Params p{};
  p.x_prompt = (const float*)d_in[0]; p.x_sample = (const float*)d_in[1]; p.cache_ckv = (const float*)d_in[2]; p.cache_krope = (const float*)d_in[3];
  p.state_ret = (const float*)d_in[4]; p.c = (const float*)d_in[5]; p.c_ctx = (const float*)d_in[6]; p.norm_g = (const float*)d_in[7];
  p.w_mod = (const float*)d_in[8]; p.b_mod = (const float*)d_in[9]; p.w_in = (const float*)d_in[10]; p.ret_logit = (const float*)d_in[11];
  p.q_norm_g = (const float*)d_in[12]; p.w_q_up = (const float*)d_in[13]; p.kv_norm_g = (const float*)d_in[14]; p.w_kv_up = (const float*)d_in[15];
  p.w_branch = (const float*)d_in[16]; p.w_out = (const float*)d_in[17]; p.final_g = (const float*)d_in[18];
  p.out = (float*)d_out; p.ws = (char*)d_ws;
#if ONE_LAUNCH
  static int grid_blocks = 0;
  if (!grid_blocks) {
    int dev = 0, cus = 0, per_cu = 0;
    hipGetDevice(&dev);
    hipDeviceGetAttribute(&cus, hipDeviceAttributeMultiprocessorCount, dev);
    hipOccupancyMaxActiveBlocksPerMultiprocessor(&per_cu, mk_fwd, 256, 0);
    if (per_cu > 2) per_cu = 2;
    grid_blocks = cus * per_cu;
  }
  hipMemsetAsync((char*)d_ws + O_BAR, 0, XCD_BAR_WORDS * 4, stream);
  void* args[] = {&p};
  hipError_t e = hipLaunchCooperativeKernel((void*)mk_fwd, dim3(grid_blocks), dim3(256), args, 0, stream);
  if (e != hipSuccess) fprintf(stderr, "cooperative launch failed: %s (grid %d)\n", hipGetErrorString(e), grid_blocks);
#endif
}
```

```cpp
#include <hip/hip_runtime.h>
#include <hip/hip_cooperative_groups.h>
#include <stdint.h>
#include <stdio.h>
namespace cg = cooperative_groups;

#ifndef ONE_LAUNCH
#define ONE_LAUNCH 1
#endif

typedef unsigned short bf16_t;
typedef short bf16x8 __attribute__((ext_vector_type(8)));
typedef float f32x4 __attribute__((ext_vector_type(4)));
typedef unsigned u32x4 __attribute__((ext_vector_type(4)));
typedef unsigned u32x2 __attribute__((ext_vector_type(2)));

constexpr int NTOK = 12288, NPR = 8192, NKEY = 14336;
constexpr float EPSN = 1e-6f;

constexpr size_t O_WIN   = 0;
constexpr size_t O_WQ    = O_WIN   + (size_t)2 * 6912 * 1024 * 2;
constexpr size_t O_WKV   = O_WQ    + (size_t)2 * 768 * 384 * 2;
constexpr size_t O_WBR   = O_WKV   + (size_t)2 * 1024 * 256 * 2;
constexpr size_t O_WO    = O_WBR   + (size_t)6 * 1024 * 512 * 2;
constexpr size_t O_CS    = O_WO    + (size_t)2 * 1024 * 1024 * 2;
constexpr size_t O_D256  = O_CS    + (size_t)256 * 128 * 2;
constexpr size_t O_D1024 = O_D256  + (size_t)256 * 512 * 2;
constexpr size_t O_S0T   = O_D1024 + (size_t)1024 * 2048 * 2;
constexpr size_t O_MOD   = O_S0T   + (size_t)64 * 128 * 64 * 2;
constexpr size_t O_H     = O_MOD   + (size_t)2 * 5 * 3072 * 4;
constexpr size_t O_BR8   = O_H;
constexpr size_t O_UT    = O_H     + (size_t)NTOK * 1024 * 2;
constexpr size_t O_RQ    = O_UT    + (size_t)NTOK * 1024 * 2;
constexpr size_t O_RK    = O_RQ    + (size_t)NTOK * 256 * 2;
constexpr size_t O_RKT   = O_RK    + (size_t)NTOK * 256 * 2;
constexpr size_t O_RVT   = O_RKT   + (size_t)NPR * 256 * 2;
constexpr size_t O_KVLAT = O_RVT   + (size_t)NTOK * 512 * 2;
constexpr size_t O_KR    = O_KVLAT + (size_t)NTOK * 256 * 4;
constexpr size_t O_R2END = O_KR    + (size_t)NTOK * 32 * 4;
constexpr size_t O_VT    = O_RQ;
static_assert(O_VT + (size_t)NKEY * 512 * 2 <= O_R2END, "alias overflow");
constexpr size_t O_RZ    = O_R2END;
constexpr size_t O_MZ    = O_RZ    + (size_t)NTOK * 512 * 2;
constexpr size_t O_FZ    = O_MZ    + (size_t)NTOK * 512 * 2;
constexpr size_t O_FU    = O_FZ    + (size_t)NTOK * 512 * 2;
constexpr size_t O_QLAT  = O_FU    + (size_t)NTOK * 512 * 2;
constexpr size_t O_CKVA  = O_QLAT  + (size_t)NTOK * 384 * 2;
constexpr size_t O_KB    = O_CKVA  + (size_t)NKEY * 256 * 2;
constexpr size_t O_KRA   = O_KB    + (size_t)NKEY * 512 * 2;
constexpr size_t O_QB    = O_KRA   + (size_t)NKEY * 32 * 2;
constexpr size_t O_H8    = O_QB    + (size_t)NTOK * 768 * 2;
constexpr size_t O_WG8   = O_H8    + (size_t)NTOK * 1024;
constexpr size_t O_WS8   = O_WG8   + (size_t)2 * 3072 * 1024;
constexpr size_t O_END   = O_WS8   + (size_t)2 * 1920 * 1024;
constexpr size_t O_ROPE  = (O_END + 255) & ~(size_t)255;
constexpr size_t O_BAR   = O_ROPE + 4096;
static_assert(O_BAR + 16384 <= (size_t)256 * 1024 * 1024, "workspace too large");

constexpr size_t OUT_CKV = (size_t)NTOK * 1024;
constexpr size_t OUT_KR  = OUT_CKV + (size_t)32 * 2 * 256 * 256;
constexpr size_t OUT_RET = OUT_KR + (size_t)32 * 2 * 256 * 32;

struct Params {
  const float *x_prompt, *x_sample, *cache_ckv, *cache_krope, *state_ret, *c, *c_ctx, *norm_g, *w_mod, *b_mod,
      *w_in, *ret_logit, *q_norm_g, *w_q_up, *kv_norm_g, *w_kv_up, *w_branch, *w_out, *final_g;
  float* out;
  char* ws;
};

constexpr int PANEL = 128 * 64;
constexpr int ABYTES = 2 * PANEL;
constexpr int STAGE = 2 * ABYTES;
constexpr int LDS_GEMM = 2 * STAGE;
constexpr int LDS_TOTAL = LDS_GEMM;
static_assert(LDS_TOTAL <= 65536, "static LDS");

typedef float f32x2 __attribute__((ext_vector_type(2)));
typedef __bf16 bf16x2v __attribute__((ext_vector_type(2)));
__device__ __forceinline__ unsigned pk2(float lo, float hi) { const f32x2 v = {lo, hi}; return __builtin_bit_cast(unsigned, __builtin_convertvector(v, bf16x2v)); }
__device__ __forceinline__ bf16_t tobf(float x) { return (bf16_t)(pk2(x, 0.f) & 0xffffu); }
typedef int v8i __attribute__((ext_vector_type(8)));
__device__ __forceinline__ float sat8(float x) { return __builtin_amdgcn_fmed3f(x, -448.f, 448.f); }
__device__ __forceinline__ unsigned pk4f8(float a, float b, float c, float d) { unsigned w = 0; a = sat8(a); b = sat8(b); c = sat8(c); d = sat8(d); w = __builtin_amdgcn_cvt_pk_fp8_f32(a, b, w, false); w = __builtin_amdgcn_cvt_pk_fp8_f32(c, d, w, true); return w; }
__device__ __forceinline__ float bflo(unsigned u) { return __uint_as_float(u << 16); }
__device__ __forceinline__ float bfhi(unsigned u) { return __uint_as_float(u & 0xffff0000u); }
__device__ __forceinline__ float ex2(float x) { return __builtin_amdgcn_exp2f(x); }
__device__ __forceinline__ float silu_f(float x) { return x / (1.f + __expf(-x)); }
__device__ __forceinline__ float sigm_f(float x) { return 1.f / (1.f + __expf(-x)); }
__device__ __forceinline__ u32x2 pk4(f32x4 v) { u32x2 r; r.x = pk2(v[0], v[1]); r.y = pk2(v[2], v[3]); return r; }
#define GAS __attribute__((address_space(1)))
#define LAS __attribute__((address_space(3)))
__device__ __forceinline__ u32x4 ldg16(const void* p) { return *(const GAS u32x4*)p; }
__device__ __forceinline__ int tidx() { int t = threadIdx.x; asm volatile("" : "+v"(t)); return t; }
__device__ __forceinline__ char* wsp(const char* w) { unsigned long long v = (unsigned long long)w; asm volatile("" : "+s"(v)); return (char*)v; }
__device__ __forceinline__ int swz(int r) { return (0 - ((r >> 2) & 3)) & 3; }
__device__ __forceinline__ float wave_sum(float v) {
#pragma unroll
  for (int o = 1; o < 64; o <<= 1) v += __shfl_xor(v, o);
  return v;
}
__device__ __forceinline__ f32x4 mfma16(bf16x8 a, bf16x8 b, f32x4 c) { return __builtin_amdgcn_mfma_f32_16x16x32_bf16(a, b, c, 0, 0, 0); }
__device__ __forceinline__ bf16x8 as_bf8(u32x4 v) { return __builtin_bit_cast(bf16x8, v); }

__device__ __forceinline__ void zero_acc(f32x4 (&acc)[4][4]) {
#pragma unroll
  for (int i = 0; i < 4; ++i)
#pragma unroll
    for (int j = 0; j < 4; ++j) acc[i][j] = (f32x4){0.f, 0.f, 0.f, 0.f};
}

template <bool SWAP, int NJ, int PIPE, bool F8>
__device__ __forceinline__ void gemm_bytes(const char* __restrict__ A, int lda, const char* __restrict__ B, int ldb, int Kb,
                                           f32x4 (&acc)[4][NJ], char* lds, int& par, bool primed,
                                           const char* nA, int nlda, const char* nB, int nldb) {
  const int tid = tidx(), lane = tid & 63, wm = (tid >> 6) >> 1, wn = (tid >> 6) & 1;
  const int wid = __builtin_amdgcn_readfirstlane(tid >> 6);
  const int fr = lane & 15, fq = lane >> 4;
  const int fa = (wm * 64 + fr) * 64 + ((fq ^ swz(fr)) << 4);
  const int fb = ABYTES + (wn * NJ * 16 + fr) * 64 + ((fq ^ swz(fr)) << 4);
  const int lrow = lane >> 2, lchunk = (lane & 3) ^ swz(lrow);
  constexpr int NBL = NJ / 2;
  const GAS char* gA = (const GAS char*)(A + (size_t)(wid * 32 + lrow) * lda + lchunk * 16);
  const GAS char* gB = (const GAS char*)(B + (size_t)(wid * NBL * 16 + lrow) * ldb + lchunk * 16);
  const size_t a16 = (size_t)16 * lda, b16 = (size_t)16 * ldb;
  LAS char* ldsA = (LAS char*)lds + wid * 2048;
  LAS char* ldsB = (LAS char*)lds + ABYTES + wid * NBL * 1024;
  const int nk = Kb >> 7;
#define GC_ISSUE(pa, pb, sa, sb, stage, kbyte) do { \
    _Pragma("unroll") for (int g = 0; g < 2; ++g) _Pragma("unroll") for (int pn = 0; pn < 2; ++pn) \
      __builtin_amdgcn_global_load_lds((const GAS unsigned*)((pa) + g * (sa) + (kbyte) + pn * 64), (LAS unsigned*)(ldsA + (stage) + pn * PANEL + g * 1024), 16, 0, 0); \
    _Pragma("unroll") for (int g = 0; g < NBL; ++g) _Pragma("unroll") for (int pn = 0; pn < 2; ++pn) \
      __builtin_amdgcn_global_load_lds((const GAS unsigned*)((pb) + g * (sb) + (kbyte) + pn * 64), (LAS unsigned*)(ldsB + (stage) + pn * PANEL + g * 1024), 16, 0, 0); \
  } while (0)
  if (!primed) {
    GC_ISSUE(gA, gB, a16, b16, par * STAGE, 0);
    asm volatile("s_waitcnt vmcnt(0)" ::: "memory");
    __syncthreads();
  }
#pragma unroll 1
  for (int kt = 0; kt < nk; ++kt) {
    char* cur = lds + par * STAGE;
    if (kt + 1 < nk) GC_ISSUE(gA, gB, a16, b16, (par ^ 1) * STAGE, (size_t)(kt + 1) * 128);
    else if (nA) {
      const GAS char* hA = (const GAS char*)(nA + (size_t)(wid * 32 + lrow) * nlda + lchunk * 16);
      const GAS char* hB = (const GAS char*)(nB + (size_t)(wid * NBL * 16 + lrow) * nldb + lchunk * 16);
      GC_ISSUE(hA, hB, (size_t)16 * nlda, (size_t)16 * nldb, (par ^ 1) * STAGE, 0);
    }
    __builtin_amdgcn_sched_barrier(0);
    if (F8 && PIPE == 1) {
      v8i av[4], bv[NJ];
#pragma unroll
      for (int i = 0; i < 4; ++i) {
        const u32x4 a0 = *(const u32x4*)(cur + fa + i * 1024), a1 = *(const u32x4*)(cur + PANEL + fa + i * 1024);
        av[i] = (v8i){(int)a0.x, (int)a0.y, (int)a0.z, (int)a0.w, (int)a1.x, (int)a1.y, (int)a1.z, (int)a1.w};
      }
#pragma unroll
      for (int j = 0; j < NJ; ++j) {
        const u32x4 b0 = *(const u32x4*)(cur + fb + j * 1024), b1 = *(const u32x4*)(cur + PANEL + fb + j * 1024);
        bv[j] = (v8i){(int)b0.x, (int)b0.y, (int)b0.z, (int)b0.w, (int)b1.x, (int)b1.y, (int)b1.z, (int)b1.w};
      }
      __builtin_amdgcn_sched_barrier(0);
#pragma unroll
      for (int i = 0; i < 4; ++i)
#pragma unroll
        for (int j = 0; j < NJ; ++j)
          acc[i][j] = SWAP ? __builtin_amdgcn_mfma_scale_f32_16x16x128_f8f6f4(bv[j], av[i], acc[i][j], 0, 0, 0, 0x7f7f7f7f, 0, 0x7f7f7f7f)
                           : __builtin_amdgcn_mfma_scale_f32_16x16x128_f8f6f4(av[i], bv[j], acc[i][j], 0, 0, 0, 0x7f7f7f7f, 0, 0x7f7f7f7f);
    } else if (F8) {
#pragma unroll
      for (int ih = 0; ih < 2; ++ih) {
        v8i av[2];
#pragma unroll
        for (int ii = 0; ii < 2; ++ii) {
          const u32x4 a0 = *(const u32x4*)(cur + fa + (ih * 2 + ii) * 1024), a1 = *(const u32x4*)(cur + PANEL + fa + (ih * 2 + ii) * 1024);
          av[ii] = (v8i){(int)a0.x, (int)a0.y, (int)a0.z, (int)a0.w, (int)a1.x, (int)a1.y, (int)a1.z, (int)a1.w};
        }
#pragma unroll
        for (int j = 0; j < NJ; ++j) {
          const u32x4 b0 = *(const u32x4*)(cur + fb + j * 1024), b1 = *(const u32x4*)(cur + PANEL + fb + j * 1024);
          const v8i bv = {(int)b0.x, (int)b0.y, (int)b0.z, (int)b0.w, (int)b1.x, (int)b1.y, (int)b1.z, (int)b1.w};
#pragma unroll
          for (int ii = 0; ii < 2; ++ii)
            acc[ih * 2 + ii][j] = SWAP ? __builtin_amdgcn_mfma_scale_f32_16x16x128_f8f6f4(bv, av[ii], acc[ih * 2 + ii][j], 0, 0, 0, 0x7f7f7f7f, 0, 0x7f7f7f7f)
                                       : __builtin_amdgcn_mfma_scale_f32_16x16x128_f8f6f4(av[ii], bv, acc[ih * 2 + ii][j], 0, 0, 0, 0x7f7f7f7f, 0, 0x7f7f7f7f);
        }
      }
    } else if (PIPE == 2) {
      bf16x8 af[2][4], bfr[NJ];
#pragma unroll
      for (int i = 0; i < 4; ++i) af[0][i] = *(const bf16x8*)(cur + fa + i * 1024);
#pragma unroll
      for (int j = 0; j < NJ; ++j) bfr[j] = *(const bf16x8*)(cur + fb + j * 1024);
#pragma unroll
      for (int i = 0; i < 4; ++i) af[1][i] = *(const bf16x8*)(cur + PANEL + fa + i * 1024);
      __builtin_amdgcn_sched_barrier(0);
#pragma unroll
      for (int i = 0; i < 4; ++i)
#pragma unroll
        for (int j = 0; j < NJ; ++j) acc[i][j] = SWAP ? mfma16(bfr[j], af[0][i], acc[i][j]) : mfma16(af[0][i], bfr[j], acc[i][j]);
#pragma unroll
      for (int j = 0; j < NJ; ++j) bfr[j] = *(const bf16x8*)(cur + PANEL + fb + j * 1024);
#pragma unroll
      for (int i = 0; i < 4; ++i)
#pragma unroll
        for (int j = 0; j < NJ; ++j) acc[i][j] = SWAP ? mfma16(bfr[j], af[1][i], acc[i][j]) : mfma16(af[1][i], bfr[j], acc[i][j]);
    } else if (PIPE == 1) {
      bf16x8 af[2][4], bfr[2][NJ];
#pragma unroll
      for (int ks = 0; ks < 2; ++ks) {
#pragma unroll
        for (int i = 0; i < 4; ++i) af[ks][i] = *(const bf16x8*)(cur + ks * PANEL + fa + i * 1024);
#pragma unroll
        for (int j = 0; j < NJ; ++j) bfr[ks][j] = *(const bf16x8*)(cur + ks * PANEL + fb + j * 1024);
      }
      __builtin_amdgcn_sched_barrier(0);
#pragma unroll
      for (int ks = 0; ks < 2; ++ks)
#pragma unroll
        for (int i = 0; i < 4; ++i)
#pragma unroll
          for (int j = 0; j < NJ; ++j) acc[i][j] = SWAP ? mfma16(bfr[ks][j], af[ks][i], acc[i][j]) : mfma16(af[ks][i], bfr[ks][j], acc[i][j]);
    } else {
#pragma unroll
      for (int ks = 0; ks < 2; ++ks) {
        bf16x8 af[4], bfr[NJ];
#pragma unroll
        for (int i = 0; i < 4; ++i) af[i] = *(const bf16x8*)(cur + ks * PANEL + fa + i * 1024);
#pragma unroll
        for (int j = 0; j < NJ; ++j) bfr[j] = *(const bf16x8*)(cur + ks * PANEL + fb + j * 1024);
#pragma unroll
        for (int i = 0; i < 4; ++i)
#pragma unroll
          for (int j = 0; j < NJ; ++j) acc[i][j] = SWAP ? mfma16(bfr[j], af[i], acc[i][j]) : mfma16(af[i], bfr[j], acc[i][j]);
      }
    }
    __builtin_amdgcn_sched_barrier(0);
    asm volatile("s_waitcnt vmcnt(0)" ::: "memory");
    __syncthreads();
    par ^= 1;
  }
#undef GC_ISSUE
}
template <bool SWAP, int NJ = 4, int PIPE = 1>
__device__ __forceinline__ void gemm_core(const bf16_t* __restrict__ A, int lda, const bf16_t* __restrict__ B, int ldb, int K,
                                          f32x4 (&acc)[4][NJ], char* lds, int& par, bool primed,
                                          const bf16_t* nA, int nlda, const bf16_t* nB, int nldb) {
  gemm_bytes<SWAP, NJ, PIPE, false>((const char*)A, lda * 2, (const char*)B, ldb * 2, K * 2, acc, lds, par, primed, (const char*)nA, nlda * 2, (const char*)nB, nldb * 2);
}
template <bool SWAP, int NJ = 4>
__device__ __forceinline__ void gemm_core(const bf16_t* __restrict__ A, int lda, const bf16_t* __restrict__ B, int ldb, int K,
                                          f32x4 (&acc)[4][NJ], char* lds) {
  int par = 0;
  gemm_core<SWAP, NJ>(A, lda, B, ldb, K, acc, lds, par, false, nullptr, 0, nullptr, 0);
}

__device__ __forceinline__ void tr_tile(const float* __restrict__ src, int lds_, int k0, int ns0, bf16_t* __restrict__ dst, int ldd, int nd0,
                                        const float* __restrict__ ksc, char* lds) {
  bf16_t* T = (bf16_t*)lds;
  const int tid = tidx();
  __syncthreads();
#pragma unroll
  for (int i = 0; i < 2; ++i) {
    const int kk = (tid >> 3) + 32 * i, nn4 = (tid & 7) * 4;
    const f32x4 v = *(const f32x4*)(src + (size_t)(k0 + kk) * lds_ + ns0 + nn4);
    const float s = ksc ? ksc[k0 + kk] : 1.f;
#pragma unroll
    for (int e = 0; e < 4; ++e) T[(nn4 + e) * 72 + kk] = tobf(v[e] * s);
  }
  __syncthreads();
  const int nn = tid >> 3, kc = (tid & 7) * 8;
  const u32x4 w = *(const u32x4*)(T + nn * 72 + kc);
  *(u32x4*)(dst + (size_t)(nd0 + nn) * ldd + k0 + kc) = w;
}

__device__ __forceinline__ void tr_tile2(const float* __restrict__ src, int lds_, int k0, int ns0, bf16_t* __restrict__ dst, int ldd, int nd0,
                                         const float* __restrict__ ksc, char* lds, unsigned char* dst8 = nullptr, int ld8 = 1024) {
  bf16_t* T = (bf16_t*)lds;
  unsigned char* T8 = (unsigned char*)lds + 8704;
  const int tid = tidx();
  __syncthreads();
  f32x4 v[4];
#pragma unroll
  for (int i = 0; i < 4; ++i) v[i] = *(const GAS f32x4*)(src + (size_t)(k0 + (tid >> 3) + 32 * i) * lds_ + ns0 + (tid & 7) * 4);
#pragma unroll
  for (int i = 0; i < 4; ++i) {
    const int kk = (tid >> 3) + 32 * i, nn4 = (tid & 7) * 4;
    const float sc = ksc ? ksc[k0 + kk] : 1.f;
#pragma unroll
    for (int e = 0; e < 4; ++e) T[(nn4 + e) * 136 + kk] = tobf(v[i][e] * sc);
    if (dst8) {
#pragma unroll
      for (int e = 0; e < 4; ++e) T8[(nn4 + e) * 144 + kk] = (unsigned char)(__builtin_amdgcn_cvt_pk_fp8_f32(sat8(v[i][e] * sc * 32.f), 0.f, 0, false) & 0xff);
    }
  }
  __syncthreads();
  const int nn = tid >> 3, kc = (tid & 7) * 16;
  if (dst8) *(u32x4*)(dst8 + (size_t)nn * ld8 + k0 + kc) = *(const u32x4*)(T8 + nn * 144 + kc);
  if (!dst) return;
  const u32x4 w0 = *(const u32x4*)(T + nn * 136 + kc), w1 = *(const u32x4*)(T + nn * 136 + kc + 8);
  bf16_t* d = dst + (size_t)(nd0 + nn) * ldd + k0 + kc;
  *(u32x4*)d = w0; *(u32x4*)(d + 8) = w1;
}

constexpr int P0_GEMV = 192, P0_WIN = 3408, P0_WQ = 144, P0_WKV = 128, P0_WBR = 768, P0_WO = 512, P0_S0 = 256, P0_PAD = 96, P0_TAB = 1105;
constexpr int P0_N = P0_GEMV + P0_WIN + P0_WQ + P0_WKV + P0_WBR + P0_WO + P0_S0 + P0_PAD + P0_TAB;

__device__ __forceinline__ void phase0_item(const Params& p, int j, char* lds) {
  const int tid = tidx();
  char* ws = wsp(p.ws);
  if (j < P0_GEMV) {
    const int l = j / 96, cgi = j % 96;
    float* sv = (float*)lds;
    float* red = (float*)(lds + 20480);
    __syncthreads();
    for (int i = tid; i < 5120; i += 256) { const int v = i >> 10, k = i & 1023; const float x = (v == 0) ? p.c_ctx[k] : p.c[(v - 1) * 1024 + k]; sv[i] = silu_f(x); }
    __syncthreads();
    const int c4 = tid & 7, kg = tid >> 3;
    const float* w = p.w_mod + (size_t)l * 1024 * 3072 + cgi * 32 + c4 * 4;
    f32x4 a0 = {0.f, 0.f, 0.f, 0.f}, a1 = a0, a2 = a0, a3 = a0, a4 = a0;
#pragma unroll 8
    for (int k = kg * 32; k < kg * 32 + 32; ++k) {
      const f32x4 wv = *(const GAS f32x4*)(w + (size_t)k * 3072);
      a0 += wv * sv[k]; a1 += wv * sv[1024 + k]; a2 += wv * sv[2048 + k]; a3 += wv * sv[3072 + k]; a4 += wv * sv[4096 + k];
    }
    *(f32x4*)(red + (kg * 5 + 0) * 32 + c4 * 4) = a0; *(f32x4*)(red + (kg * 5 + 1) * 32 + c4 * 4) = a1; *(f32x4*)(red + (kg * 5 + 2) * 32 + c4 * 4) = a2;
    *(f32x4*)(red + (kg * 5 + 3) * 32 + c4 * 4) = a3; *(f32x4*)(red + (kg * 5 + 4) * 32 + c4 * 4) = a4;
    __syncthreads();
    if (tid < 160) {
      const int v = tid >> 5, c2 = tid & 31;
      float sm = p.b_mod[l * 3072 + cgi * 32 + c2];
#pragma unroll 8
      for (int g = 0; g < 32; ++g) sm += red[(g * 5 + v) * 32 + c2];
      ((float*)(ws + O_MOD))[(l * 5 + v) * 3072 + cgi * 32 + c2] = sm;
    }
    return;
  }
  j -= P0_GEMV;
  if (j < P0_WIN) {
    const int l = j / 1704, r = j % 1704, kt = r / 213, nt = r % 213, c0 = nt * 32;
    const int nd0 = c0 < 2176 ? c0 : (c0 < 2208 ? 3712 + (c0 - 2176) : (c0 < 3744 ? c0 - 32 : c0 + 96));
    const bool only8 = nd0 >= 3840 || (nd0 >= 1536 && nd0 < 1920) || (nd0 >= 2688 && nd0 < 3200);
    tr_tile2(p.w_in + (size_t)l * 1024 * 6816, 6816, kt * 128, c0, only8 ? nullptr : (bf16_t*)(ws + O_WIN) + (size_t)l * 6912 * 1024, 1024, nd0, nullptr, lds,
             nd0 >= 3840 ? (unsigned char*)(ws + O_WG8) + ((size_t)l * 3072 + (nd0 - 3840)) * 1024
             : nd0 < 1024 ? (unsigned char*)(ws + O_WS8) + ((size_t)l * 1920 + nd0) * 1024
             : (nd0 >= 1536 && nd0 < 1920) ? (unsigned char*)(ws + O_WS8) + ((size_t)l * 1920 + 1024 + (nd0 - 1536)) * 1024
             : (nd0 >= 2688 && nd0 < 3200) ? (unsigned char*)(ws + O_WS8) + ((size_t)l * 1920 + 1408 + (nd0 - 2688)) * 1024 : nullptr);
    return;
  }
  j -= P0_WIN;
  if (j < P0_WQ) {
    const int l = j / 72, r = j % 72, kt = r / 24, nt = r % 24;
    tr_tile2(p.w_q_up + (size_t)l * 384 * 768, 768, kt * 128, nt * 32, nullptr, 384, nt * 32, p.q_norm_g + l * 384, lds,
             (unsigned char*)(ws + O_WQ) + ((size_t)l * 768 + nt * 32) * 384, 384);
    return;
  }
  j -= P0_WQ;
  if (j < P0_WKV) {
    const int l = j / 64, r = j % 64, kt = r / 32, nt = r % 32, c0 = nt * 32, h = c0 >> 7, e = c0 & 127;
    const int nd0 = e < 64 ? h * 64 + e : 512 + h * 64 + (e - 64);
    tr_tile2(p.w_kv_up + (size_t)l * 256 * 1024, 1024, kt * 128, c0, nullptr, 256, nd0, nullptr, lds,
             (unsigned char*)(ws + O_WKV) + ((size_t)l * 1024 + nd0) * 256, 256);
    return;
  }
  j -= P0_WKV;
  if (j < P0_WBR) {
    const int mat = j / 128, r = j % 128, kt = r / 32, nt = r % 32;
    tr_tile2(p.w_branch + (size_t)mat * 512 * 1024, 1024, kt * 128, nt * 32, nullptr, 512, nt * 32, nullptr, lds,
             (unsigned char*)(ws + O_WBR) + ((size_t)mat * 1024 + nt * 32) * 512, 512);
    return;
  }
  j -= P0_WBR;
  if (j < P0_WO) {
    const int l = j / 256, r = j % 256, kt = r / 32, nt = r % 32;
    tr_tile2(p.w_out + (size_t)l * 1024 * 1024, 1024, kt * 128, nt * 32, nullptr, 1024, nt * 32, nullptr, lds,
             (unsigned char*)(ws + O_WO) + ((size_t)l * 1024 + nt * 32) * 1024, 1024);
    return;
  }
  j -= P0_WO;
  if (j < P0_S0) {
    const int mat = j >> 2, nt = j & 3;
    tr_tile(p.state_ret + (size_t)mat * 64 * 128, 128, 0, nt * 32, (bf16_t*)(ws + O_S0T) + (size_t)mat * 128 * 64, 64, nt * 32, nullptr, lds);
    return;
  }
  j -= P0_S0;
  if (j < P0_PAD) {
    const int l = j / 48, r = j % 48;
    bf16_t* d = (bf16_t*)(ws + O_WIN) + ((size_t)l * 6912 + 3744) * 1024 + (size_t)r * 2048 + tid * 8;
    *(u32x4*)d = (u32x4){0u, 0u, 0u, 0u};
    return;
  }
  j -= P0_PAD;
  {
    float v[8];
    bf16_t* dst = nullptr; unsigned char* dst8 = nullptr;
    if (j == 1104) {
      float* rt = (float*)(ws + O_ROPE);
#pragma unroll
      for (int q = 0; q < 2; ++q) {
        const int idx = tid * 2 + q, pos = idx >> 3, f = idx & 7;
        const float ang = (float)pos * exp2f(-(float)f * 1.66096404744f);
        rt[idx * 2] = cosf(ang); rt[idx * 2 + 1] = sinf(ang);
      }
      return;
    }
    if (j < 16) {
      const int e0 = j * 2048 + tid * 8; dst = (bf16_t*)(ws + O_CS) + e0;
      const int n = e0 >> 7, k = e0 & 127;
#pragma unroll
      for (int e = 0; e < 8; ++e) {
        const float fr = (float)(((n & 127) * (k + e)) & 127) * (1.f / 128.f);
        v[e] = (n < 128) ? __builtin_amdgcn_cosf(fr) : __builtin_amdgcn_sinf(fr);
      }
    } else if (j < 80) {
      const int e0 = (j - 16) * 2048 + tid * 8; dst8 = (unsigned char*)(ws + O_D256) + e0;
      const int k1 = e0 >> 9, kk = e0 & 511;
#pragma unroll
      for (int e = 0; e < 8; ++e) {
        const int t = (kk + e) & 255;
        const float fr = (float)((k1 * t) & 255) * (1.f / 256.f);
        v[e] = (kk < 256) ? __builtin_amdgcn_cosf(fr) : -__builtin_amdgcn_sinf(fr);
      }
    } else {
      const int e0 = (j - 80) * 2048 + tid * 8; dst8 = (unsigned char*)(ws + O_D1024) + e0;
      const int k1 = e0 >> 11, kk = e0 & 2047;
#pragma unroll
      for (int e = 0; e < 8; ++e) {
        const int t = (kk + e) & 1023;
        const float fr = (float)((k1 * t) & 1023) * (1.f / 1024.f);
        v[e] = (kk < 1024) ? __builtin_amdgcn_cosf(fr) : -__builtin_amdgcn_sinf(fr);
      }
    }
    if (dst8) {
      u32x2 w8; w8.x = pk4f8(v[0] * 64.f, v[1] * 64.f, v[2] * 64.f, v[3] * 64.f); w8.y = pk4f8(v[4] * 64.f, v[5] * 64.f, v[6] * 64.f, v[7] * 64.f);
      *(u32x2*)dst8 = w8;
    } else {
      u32x4 w; w.x = pk2(v[0], v[1]); w.y = pk2(v[2], v[3]); w.z = pk2(v[4], v[5]); w.w = pk2(v[6], v[7]);
      *(u32x4*)dst = w;
    }
  }
}

__device__ __forceinline__ void norm_item(const Params& p, int l, int item, const float* xp, const float* xs) {
  const int tid = tidx(), lane = tid & 63, wid = tid >> 6;
  bf16_t* H = (bf16_t*)(p.ws + O_H);
#pragma unroll 3
  for (int i = 0; i < 6; ++i) {
    const int row = item * 24 + wid * 6 + i;
    const float* src = row < NPR ? xp + (size_t)row * 1024 : xs + (size_t)(row - NPR) * 1024;
    const int v = row < NPR ? 0 : 1 + ((row - NPR) >> 10);
    const float* mod = (const float*)(p.ws + O_MOD) + (l * 5 + v) * 3072;
    f32x4 x[4]; float ss = 0.f;
#pragma unroll
    for (int q = 0; q < 4; ++q) { x[q] = *(const f32x4*)(src + (q * 64 + lane) * 4); ss += x[q][0] * x[q][0] + x[q][1] * x[q][1] + x[q][2] * x[q][2] + x[q][3] * x[q][3]; }
    ss = wave_sum(ss);
    const float rstd = rsqrtf(ss * (1.f / 1024.f) + EPSN);
#pragma unroll
    for (int q = 0; q < 4; ++q) {
      const int col = (q * 64 + lane) * 4;
      const f32x4 g = *(const f32x4*)(p.norm_g + l * 1024 + col), sc = *(const f32x4*)(mod + 1024 + col), sh = *(const f32x4*)(mod + col);
      f32x4 h;
#pragma unroll
      for (int e = 0; e < 4; ++e) h[e] = x[q][e] * rstd * g[e] * (1.f + sc[e]) + sh[e];
      *(u32x2*)(H + (size_t)row * 1024 + col) = pk4(h);
      *(unsigned*)(p.ws + O_H8 + (size_t)row * 1024 + col) = pk4f8(h[0], h[1], h[2], h[3]);
    }
  }
}
__device__ __forceinline__ void final_item(const Params& p, int item) {
  const int tid = tidx(), lane = tid & 63, wid = tid >> 6;
#pragma unroll 3
  for (int i = 0; i < 6; ++i) {
    const int row = item * 24 + wid * 6 + i;
    float* src = p.out + (size_t)row * 1024;
    f32x4 x[4]; float ss = 0.f;
#pragma unroll
    for (int q = 0; q < 4; ++q) { x[q] = *(const f32x4*)(src + (q * 64 + lane) * 4); ss += x[q][0] * x[q][0] + x[q][1] * x[q][1] + x[q][2] * x[q][2] + x[q][3] * x[q][3]; }
    ss = wave_sum(ss);
    const float rstd = rsqrtf(ss * (1.f / 1024.f) + EPSN);
#pragma unroll
    for (int q = 0; q < 4; ++q) {
      const int col = (q * 64 + lane) * 4;
      const f32x4 g = *(const f32x4*)(p.final_g + col);
      f32x4 y;
#pragma unroll
      for (int e = 0; e < 4; ++e) y[e] = x[q][e] * rstd * g[e];
      *(f32x4*)(src + col) = y;
    }
  }
}

__device__ __forceinline__ void s2_tile(const Params& p, int l, int tile, char* lds) {
  const int tid = tidx(), lane = tid & 63, wid = tid >> 6, wm = wid >> 1, wn = wid & 1, fr = lane & 15, fq = lane >> 4;
  const int m = (tile / 480) * 16 + (tile % 16), nt = (tile % 480) / 16, m0 = m * 128, n0 = nt * 128;
  char* ws = wsp(p.ws);
  const bf16_t* A = (const bf16_t*)(ws + O_H) + (size_t)m0 * 1024;
  const bf16_t* B = (const bf16_t*)(ws + O_WIN) + ((size_t)l * 6912 + n0) * 1024;
  const bool f8 = (nt >= 12 && nt < 15) || (nt >= 21 && nt < 25);
  const int row8 = nt < 8 ? nt * 128 : (nt < 15 ? 1024 + (nt - 12) * 128 : 1408 + (nt - 21) * 128);
  const char* A8 = (const char*)(ws + O_H8) + (size_t)m0 * 1024;
  const char* B8 = (const char*)(ws + O_WS8) + ((size_t)l * 1920 + row8) * 1024;
  const float s8 = f8 ? 0.03125f : 1.f;
  f32x4 acc[4][4];
  zero_acc(acc);
  if (nt >= 4 && nt < 8) {
    gemm_core<false>(A, 1024, B, 1024, 1024, acc, lds);
    bf16_t* RVT = (bf16_t*)(ws + O_RVT);
#pragma unroll
    for (int i = 0; i < 4; ++i) {
      const int tok = m0 + wm * 64 + i * 16 + fq * 4;
      size_t base; int T, b, t;
      if (tok < NPR) { b = tok >> 8; t = tok & 255; T = 256; base = 0; } else { const int s = tok - NPR; b = s >> 10; t = s & 1023; T = 1024; base = (size_t)NPR * 512; }
#pragma unroll
      for (int j = 0; j < 4; ++j) {
        const int c = n0 - 512 + wn * 64 + j * 16 + fr, h = c >> 7, vd = c & 127;
        *(u32x2*)(RVT + base + ((size_t)(b * 4 + h) * 128 + vd) * T + t) = pk4(acc[i][j]);
      }
    }
    return;
  }
  if (f8) { int par = 0; gemm_bytes<true, 4, 1, true>(A8, 1024, B8, 1024, 1024, acc, lds, par, false, nullptr, 0, nullptr, 0); }
  else gemm_core<true>(A, 1024, B, 1024, 1024, acc, lds);
  bf16_t* dst = nullptr; int ld = 0, c0 = 0, op = 0;
  if (nt < 2) { dst = (bf16_t*)(ws + O_RQ); ld = 256; c0 = 0; }
  else if (nt < 4) { dst = (bf16_t*)(ws + O_RK); ld = 256; c0 = 256; op = 2; }
  else if (nt < 12) { dst = (bf16_t*)(ws + O_RZ); ld = 512; c0 = 1024; op = 1; }
  else if (nt < 15) { ld = 384; c0 = 1536; op = 5; }
  else if (nt < 17) { ld = 256; c0 = 1920; op = 3; }
  else if (nt < 21) { dst = (bf16_t*)(ws + O_MZ); ld = 512; c0 = 2176; op = 1; }
  else if (nt < 25) { dst = (bf16_t*)(ws + O_FU); ld = 512; c0 = 2688; }
  else if (nt < 29) { dst = (bf16_t*)(ws + O_FZ); ld = 512; c0 = 3200; op = 1; }
  else { ld = 32; c0 = 3712; op = 4; }
#pragma unroll
  for (int i = 0; i < 4; ++i) {
    const int tok = m0 + wm * 64 + i * 16 + fr;
#pragma unroll
    for (int j = 0; j < 4; ++j) {
      const int col = n0 - c0 + wn * 64 + j * 16 + fq * 4;
      f32x4 v = acc[i][j] * s8;
      if (op == 3) { *(f32x4*)((float*)(ws + O_KVLAT) + (size_t)tok * 256 + col) = v; continue; }
      if (op == 5) { *(unsigned*)(ws + O_QLAT + (size_t)tok * 384 + col) = pk4f8(v[0] * 8.f, v[1] * 8.f, v[2] * 8.f, v[3] * 8.f); continue; }
      if (op == 4) { if (col < 32) *(f32x4*)((float*)(ws + O_KR) + (size_t)tok * 32 + col) = v; continue; }
      if (op == 1) {
#pragma unroll
        for (int e = 0; e < 4; ++e) v[e] = silu_f(v[e]);
      } else if (op == 2) {
#pragma unroll
        for (int e = 0; e < 4; ++e) v[e] *= 0.125f;
      }
      const u32x2 w = pk4(v);
      *(u32x2*)(dst + (size_t)tok * ld + col) = w;
      if (op == 2 && tok < NPR) {
        bf16_t* RKT = (bf16_t*)(ws + O_RKT);
        const int b = tok >> 8, t = tok & 255, h = col >> 6, dk = col & 63;
        bf16_t* q = RKT + ((size_t)(b * 4 + h) * 64 + dk) * 256 + t;
        q[0] = (bf16_t)(w.x & 0xffffu); q[256] = (bf16_t)(w.x >> 16); q[512] = (bf16_t)(w.y & 0xffffu); q[768] = (bf16_t)(w.y >> 16);
      }
    }
  }
}

template <int MODE>
__device__ __forceinline__ void attn_item(const Params& p, int l, int item, char* lds) {
  constexpr int NKP = MODE == 0 ? 3 : 2;
  constexpr int NVB = MODE == 0 ? 4 : 8;
  constexpr int PV = NVB * 16 * 64;
  constexpr int KOFF = NKP * 4096;
  constexpr int BUF = KOFF + 2 * PV;
  const int tid = tidx(), lane = tid & 63, wid = tid >> 6, fr = lane & 15, fq = lane >> 4;
  char* ws = wsp(p.ws);
  int smp, b, h, qblk, T, Tk, tok0;
  const bf16_t *kbase, *rbase = nullptr, *vbase, *qbase;
  int kstride, qstride;
  if (MODE == 0) {
    if (item < 256) { smp = 1; b = item >> 6; h = (item >> 3) & 7; qblk = item & 7; T = 1024; Tk = 1536; tok0 = NPR + b * 1024 + qblk * 128; }
    else { const int it = item - 256; smp = 0; b = it >> 4; h = (it >> 1) & 7; qblk = it & 1; T = 256; Tk = 256; tok0 = b * 256 + qblk * 128; }
    const int keyrow0 = smp ? NPR + b * 1536 : b * 256;
    kbase = (const bf16_t*)(ws + O_KB) + (size_t)keyrow0 * 512 + h * 64; kstride = 512;
    rbase = (const bf16_t*)(ws + O_KRA) + (size_t)keyrow0 * 32;
    vbase = (const bf16_t*)(ws + O_VT) + (smp ? (size_t)NPR * 512 + (size_t)(b * 8 + h) * 64 * 1536 : (size_t)(b * 8 + h) * 64 * 256);
    qbase = (const bf16_t*)(ws + O_QB) + (size_t)tok0 * 768 + h * 96; qstride = 768;
  } else {
    if (item < 128) { smp = 1; b = item >> 5; h = (item >> 3) & 3; qblk = item & 7; T = 1024; tok0 = NPR + b * 1024 + qblk * 128; }
    else { const int it = item - 128; smp = 0; b = it >> 3; h = (it >> 1) & 3; qblk = it & 1; T = 256; tok0 = b * 256 + qblk * 128; }
    Tk = T;
    const int ktok0 = smp ? NPR + b * 1024 : b * 256;
    kbase = (const bf16_t*)(ws + O_RK) + (size_t)ktok0 * 256 + h * 64; kstride = 256;
    vbase = (const bf16_t*)(ws + O_RVT) + (smp ? (size_t)NPR * 512 + (size_t)(b * 4 + h) * 128 * 1024 : (size_t)(b * 4 + h) * 128 * 256);
    qbase = (const bf16_t*)(ws + O_RQ) + (size_t)tok0 * 256 + h * 64; qstride = 256;
  }
  const int nkt = Tk >> 6;
  bf16x8 qf[2][NKP];
#pragma unroll
  for (int qb = 0; qb < 2; ++qb)
#pragma unroll
    for (int ks = 0; ks < NKP; ++ks) qf[qb][ks] = *(const bf16x8*)(qbase + (size_t)(wid * 32 + qb * 16 + fr) * qstride + ks * 32 + fq * 8);
  f32x4 o[NVB][2];
#pragma unroll
  for (int vb = 0; vb < NVB; ++vb) { o[vb][0] = (f32x4){0.f, 0.f, 0.f, 0.f}; o[vb][1] = (f32x4){0.f, 0.f, 0.f, 0.f}; }
  float lgf = 0.f, lgb = 0.f;
  float mrow[2] = {-INFINITY, -INFINITY}, lrow[2] = {0.f, 0.f};
  const int tq0 = qblk * 128 + wid * 32 + fr;
  if (MODE == 1) {
    const float xf = p.ret_logit[(l * 2 + 0) * 4 + h], xb = p.ret_logit[(l * 2 + 1) * 4 + h];
    lgf = -log1pf(expf(-xf)) * 1.44269504089f; lgb = -log1pf(expf(-xb)) * 1.44269504089f;
    if (smp) {
      const bf16_t* s0 = (const bf16_t*)(ws + O_S0T);
#pragma unroll
      for (int dir = 0; dir < 2; ++dir) {
        const bf16_t* sb = s0 + ((size_t)(((b * 2 + l) * 2 + dir) * 4 + h) * 128) * 64;
        float dec[2];
#pragma unroll
        for (int qb = 0; qb < 2; ++qb) { const int tq = tq0 + qb * 16; dec[qb] = dir == 0 ? ex2((float)(tq + 1) * lgf) : ex2((float)(T - tq) * lgb); }
#pragma unroll
        for (int vb = 0; vb < NVB; ++vb) {
          f32x4 t0 = (f32x4){0.f, 0.f, 0.f, 0.f}, t1 = (f32x4){0.f, 0.f, 0.f, 0.f};
#pragma unroll
          for (int ks = 0; ks < 2; ++ks) {
            const bf16x8 sf = *(const bf16x8*)(sb + (size_t)(vb * 16 + fr) * 64 + ks * 32 + fq * 8);
            t0 = mfma16(sf, qf[0][ks], t0); t1 = mfma16(sf, qf[1][ks], t1);
          }
          o[vb][0] += t0 * dec[0]; o[vb][1] += t1 * dec[1];
        }
      }
    }
  }
  u32x4 vreg[NVB / 2];
  const int uw = __builtin_amdgcn_readfirstlane(wid);
  const int dkey = lane >> 2, dchunk = (lane & 3) ^ swz(dkey);
  auto kdma = [&](int kt, char* buf) {
    const GAS bf16_t* kp = (const GAS bf16_t*)kbase + (size_t)(kt * 64 + uw * 16 + dkey) * kstride + dchunk * 8;
#pragma unroll
    for (int pn = 0; pn < 2; ++pn)
      __builtin_amdgcn_global_load_lds((const GAS unsigned*)(kp + pn * 32), (LAS unsigned*)((LAS char*)buf + pn * 4096 + uw * 1024), 16, 0, 0);
    if (MODE == 0) {
      const GAS bf16_t* rp = (const GAS bf16_t*)rbase + (size_t)(kt * 64 + uw * 16 + dkey) * 32 + dchunk * 8;
      __builtin_amdgcn_global_load_lds((const GAS unsigned*)rp, (LAS unsigned*)((LAS char*)buf + 2 * 4096 + uw * 1024), 16, 0, 0);
    }
  };
  auto gload = [&](int kt) {
#pragma unroll
    for (int i = 0; i < NVB / 2; ++i) { const int idx = tid + 256 * i, vd = idx >> 3, g = idx & 7; vreg[i] = ldg16(vbase + (size_t)vd * Tk + kt * 64 + g * 8); }
  };
  auto lstore = [&](char* buf) {
#pragma unroll
    for (int i = 0; i < NVB / 2; ++i) {
      const int idx = tid + 256 * i, vd = idx >> 3, g = idx & 7, pnl = g >> 2, g4 = g & 3, hi = g4 >> 1, q0 = 2 * (g4 & 1);
      char* base = buf + KOFF + pnl * PV + vd * 64 + hi * 8;
      *(u32x2*)(base + ((q0 ^ swz(vd)) << 4)) = (u32x2){vreg[i].x, vreg[i].y};
      *(u32x2*)(base + (((q0 + 1) ^ swz(vd)) << 4)) = (u32x2){vreg[i].z, vreg[i].w};
    }
  };
  __syncthreads();
  kdma(0, lds); gload(0); lstore(lds);
  asm volatile("s_waitcnt vmcnt(0)" ::: "memory");
  __syncthreads();
  const int foff = fr * 64 + ((fq ^ swz(fr)) << 4);
  for (int kt = 0; kt < nkt; ++kt) {
    char* cur = lds + (kt & 1) * BUF;
    const bool more = (kt + 1) < nkt;
    if (more) { kdma(kt + 1, lds + ((kt + 1) & 1) * BUF); gload(kt + 1); }
    __builtin_amdgcn_sched_barrier(0);
    f32x4 s[4][2];
#pragma unroll
    for (int kb = 0; kb < 4; ++kb) {
      s[kb][0] = (f32x4){0.f, 0.f, 0.f, 0.f}; s[kb][1] = (f32x4){0.f, 0.f, 0.f, 0.f};
#pragma unroll
      for (int ks = 0; ks < NKP; ++ks) {
        const bf16x8 kf = *(const bf16x8*)(cur + ks * 4096 + kb * 1024 + foff);
        s[kb][0] = mfma16(kf, qf[0][ks], s[kb][0]); s[kb][1] = mfma16(kf, qf[1][ks], s[kb][1]);
      }
    }
    bf16x8 pf[2][2];
#pragma unroll
    for (int qb = 0; qb < 2; ++qb) {
      if (MODE == 0) {
        float mx = s[0][qb][0];
#pragma unroll
        for (int kb = 0; kb < 4; ++kb)
#pragma unroll
          for (int r = 0; r < 4; ++r) mx = fmaxf(mx, s[kb][qb][r]);
        mx = fmaxf(mx, __shfl_xor(mx, 16)); mx = fmaxf(mx, __shfl_xor(mx, 32));
        const float mn = fmaxf(mrow[qb], mx), alpha = ex2(mrow[qb] - mn);
        mrow[qb] = mn;
        float ls = 0.f;
#pragma unroll
        for (int kb = 0; kb < 4; ++kb)
#pragma unroll
          for (int r = 0; r < 4; ++r) { const float e = ex2(s[kb][qb][r] - mn); s[kb][qb][r] = e; ls += e; }
        lrow[qb] = lrow[qb] * alpha + ls;
#pragma unroll
        for (int vb = 0; vb < NVB; ++vb) o[vb][qb] *= alpha;
      } else {
        const int tq = tq0 + qb * 16;
#pragma unroll
        for (int kb = 0; kb < 4; ++kb)
#pragma unroll
          for (int r = 0; r < 4; ++r) {
            const int d = tq - (kt * 64 + kb * 16 + fq * 4 + r);
            const float dec = d > 0 ? ex2((float)d * lgf) : (d < 0 ? ex2((float)(-d) * lgb) : 2.f);
            s[kb][qb][r] *= dec;
          }
      }
#pragma unroll
      for (int g = 0; g < 2; ++g) {
        u32x4 w; w.x = pk2(s[2 * g][qb][0], s[2 * g][qb][1]); w.y = pk2(s[2 * g][qb][2], s[2 * g][qb][3]);
        w.z = pk2(s[2 * g + 1][qb][0], s[2 * g + 1][qb][1]); w.w = pk2(s[2 * g + 1][qb][2], s[2 * g + 1][qb][3]);
        pf[qb][g] = as_bf8(w);
      }
    }
#pragma unroll
    for (int vb = 0; vb < NVB; ++vb)
#pragma unroll
      for (int g = 0; g < 2; ++g) {
        const bf16x8 vf = *(const bf16x8*)(cur + KOFF + g * PV + vb * 1024 + foff);
        o[vb][0] = mfma16(vf, pf[0][g], o[vb][0]); o[vb][1] = mfma16(vf, pf[1][g], o[vb][1]);
      }
    __builtin_amdgcn_sched_barrier(0);
    if (more) lstore(lds + ((kt + 1) & 1) * BUF);
    asm volatile("s_waitcnt vmcnt(0)" ::: "memory");
    __syncthreads();
  }
  bf16_t* G = (bf16_t*)(ws + (MODE == 0 ? O_MZ : O_RZ));
#pragma unroll
  for (int qb = 0; qb < 2; ++qb) {
    const int tok = tok0 + wid * 32 + qb * 16 + fr;
    float mul, sub;
    if (MODE == 0) {
      float lt = lrow[qb]; lt += __shfl_xor(lt, 16); lt += __shfl_xor(lt, 32);
      mul = 1.f / lt; sub = 0.f;
    } else {
      float sm = 0.f;
#pragma unroll
      for (int vb = 0; vb < NVB; ++vb) sm += (o[vb][qb][0] + o[vb][qb][1]) + (o[vb][qb][2] + o[vb][qb][3]);
      sm += __shfl_xor(sm, 16); sm += __shfl_xor(sm, 32);
      const float mu = sm * (1.f / 128.f);
      float vs = 0.f;
#pragma unroll
      for (int vb = 0; vb < NVB; ++vb)
#pragma unroll
        for (int r = 0; r < 4; ++r) { const float dd = o[vb][qb][r] - mu; vs += dd * dd; }
      vs += __shfl_xor(vs, 16); vs += __shfl_xor(vs, 32);
      mul = rsqrtf(vs * (1.f / 128.f) + EPSN); sub = mu;
    }
#pragma unroll
    for (int vb = 0; vb < NVB; ++vb) {
      bf16_t* gp = G + (size_t)tok * 512 + h * (NVB * 16) + vb * 16 + fq * 4;
      const u32x2 gz = *(const u32x2*)gp;
      f32x4 y;
      y[0] = (o[vb][qb][0] - sub) * mul * bflo(gz.x); y[1] = (o[vb][qb][1] - sub) * mul * bfhi(gz.x);
      y[2] = (o[vb][qb][2] - sub) * mul * bflo(gz.y); y[3] = (o[vb][qb][3] - sub) * mul * bfhi(gz.y);
      *(unsigned*)(ws + O_BR8 + (size_t)(MODE == 0 ? 1 : 0) * NTOK * 512 + (size_t)tok * 512 + h * (NVB * 16) + vb * 16 + fq * 4) = pk4f8(y[0] * 8.f, y[1] * 8.f, y[2] * 8.f, y[3] * 8.f);
    }
  }
}

__device__ __forceinline__ bf16x8 scale8(u32x4 raw, const float (&d)[8]) {
  u32x4 w;
  w.x = pk2(bflo(raw.x) * d[0], bfhi(raw.x) * d[1]); w.y = pk2(bflo(raw.y) * d[2], bfhi(raw.y) * d[3]);
  w.z = pk2(bflo(raw.z) * d[4], bfhi(raw.z) * d[5]); w.w = pk2(bflo(raw.w) * d[6], bfhi(raw.w) * d[7]);
  return as_bf8(w);
}
__device__ __forceinline__ void state_item(const Params& p, int l, int item) {
  const int tid = tidx(), lane = tid & 63, wid = tid >> 6, fr = lane & 15, fq = lane >> 4;
  const int b = item >> 2, h = item & 3;
  const bf16_t* RVT = (const bf16_t*)(p.ws + O_RVT) + (size_t)(b * 4 + h) * 128 * 256;
  const bf16_t* RKT = (const bf16_t*)(p.ws + O_RKT) + (size_t)(b * 4 + h) * 64 * 256;
  const float xf = p.ret_logit[(l * 2 + 0) * 4 + h], xb = p.ret_logit[(l * 2 + 1) * 4 + h];
  const float lgf = -log1pf(expf(-xf)) * 1.44269504089f, lgb = -log1pf(expf(-xb)) * 1.44269504089f;
  f32x4 acc[2][2][4];
#pragma unroll
  for (int d = 0; d < 2; ++d)
#pragma unroll
    for (int v = 0; v < 2; ++v)
#pragma unroll
      for (int k = 0; k < 4; ++k) acc[d][v][k] = (f32x4){0.f, 0.f, 0.f, 0.f};
#pragma unroll 2
  for (int ks = 0; ks < 8; ++ks) {
    const int j0 = ks * 32 + fq * 8;
    float df[8], db[8];
#pragma unroll
    for (int e = 0; e < 8; ++e) { df[e] = exp2f((float)(255 - j0 - e) * lgf); db[e] = exp2f((float)(j0 + e) * lgb); }
    bf16x8 af[2];
#pragma unroll
    for (int v = 0; v < 2; ++v) af[v] = *(const bf16x8*)(RVT + (size_t)((wid * 2 + v) * 16 + fr) * 256 + j0);
#pragma unroll
    for (int k = 0; k < 4; ++k) {
      const u32x4 raw = *(const u32x4*)(RKT + (size_t)(k * 16 + fr) * 256 + j0);
      const bf16x8 kf = scale8(raw, df), kb = scale8(raw, db);
#pragma unroll
      for (int v = 0; v < 2; ++v) { acc[0][v][k] = mfma16(af[v], kf, acc[0][v][k]); acc[1][v][k] = mfma16(af[v], kb, acc[1][v][k]); }
    }
  }
  float* O = p.out + OUT_RET;
#pragma unroll
  for (int d = 0; d < 2; ++d)
#pragma unroll
    for (int v = 0; v < 2; ++v)
#pragma unroll
      for (int k = 0; k < 4; ++k) {
        const int dk = k * 16 + fr, vd = (wid * 2 + v) * 16 + fq * 4;
        *(f32x4*)(O + ((size_t)((((b * 2 + l) * 2 + d) * 4 + h) * 64 + dk)) * 128 + vd) = acc[d][v][k];
      }
}

__device__ __forceinline__ void keyprep_item(const Params& p, int l, int item) {
  const int tid = tidx(), lane = tid & 63, wid = tid >> 6;
  char* ws = wsp(p.ws);
  unsigned char* CKVA = (unsigned char*)(ws + O_CKVA);
  bf16_t* KRA = (bf16_t*)(ws + O_KRA);
#pragma unroll
  for (int i = 0; i < 4; ++i) {
    const int R = item * 16 + wid * 4 + i;
    int smp = 0, b, t = 0, tok = 0, ctx = 0, pp = 0;
    if (R < NPR) { tok = R; b = R >> 8; t = R & 255; }
    else { smp = 1; const int s = R - NPR; b = s / 1536; pp = s - b * 1536; if (pp < 512) ctx = 1; else { t = pp - 512; tok = NPR + b * 1024 + t; } }
    if (ctx) {
      const f32x4 v = *(const f32x4*)(p.cache_ckv + ((size_t)((b * 2 + l) * 512 + pp)) * 256 + lane * 4);
      *(unsigned*)(CKVA + (size_t)R * 256 + lane * 4) = pk4f8(v[0] * 4.f, v[1] * 4.f, v[2] * 4.f, v[3] * 4.f);
      if (lane < 32) KRA[(size_t)R * 32 + lane] = tobf(p.cache_krope[((size_t)((b * 2 + l) * 512 + pp)) * 32 + lane]);
      continue;
    }
    const f32x4 v = *(const f32x4*)((const float*)(ws + O_KVLAT) + (size_t)tok * 256 + lane * 4);
    float ss = v[0] * v[0] + v[1] * v[1] + v[2] * v[2] + v[3] * v[3];
    ss = wave_sum(ss);
    const float rstd = rsqrtf(ss * (1.f / 256.f) + EPSN);
    const f32x4 g = *(const f32x4*)(p.kv_norm_g + l * 256 + lane * 4);
    f32x4 y;
#pragma unroll
    for (int e = 0; e < 4; ++e) y[e] = v[e] * rstd * g[e];
    *(unsigned*)(CKVA + (size_t)R * 256 + lane * 4) = pk4f8(y[0] * 4.f, y[1] * 4.f, y[2] * 4.f, y[3] * 4.f);
    if (!smp) *(f32x4*)(p.out + OUT_CKV + ((size_t)((b * 2 + l) * 256 + t)) * 256 + lane * 4) = y;
    const int d = lane & 31;
    const float x = ((const float*)(ws + O_KR))[(size_t)tok * 32 + d];
    float yk = x;
    if (smp) {
      const float pr = __shfl_xor(x, 8);
      const int hd = d >> 4, i16 = d & 15, f = i16 & 7;
      const int pos = hd ? (t & 63) : (t >> 6);
      const float* rt = (const float*)(ws + O_ROPE) + (pos * 8 + f) * 2;
      const float cs = rt[0], sn = rt[1];
      yk = i16 < 8 ? x * cs - pr * sn : pr * sn + x * cs;
    } else if (lane < 32) {
      p.out[OUT_KR + ((size_t)((b * 2 + l) * 256 + t)) * 32 + d] = x;
    }
    if (lane < 32) KRA[(size_t)R * 32 + d] = tobf(yk);
  }
}

__device__ __forceinline__ void f1_tile(const Params& p, int tile, char* lds) {
  const int tid = tidx(), lane = tid & 63, wid = tid >> 6, wm = wid >> 1, wn = wid & 1, fr = lane & 15, fq = lane >> 4;
  const int m = tile >> 3, g = (tile >> 1) & 3, nh = tile & 1, m0 = m * 128;
  char* ws = wsp(p.ws);
  f32x4 acc[4][4];
  zero_acc(acc);
  gemm_core<false>((const bf16_t*)(ws + O_FU) + (size_t)m0 * 512 + g * 128, 512, (const bf16_t*)(ws + O_CS) + (size_t)nh * 128 * 128, 128, 128, acc, lds);
  unsigned char* UT = (unsigned char*)(ws + O_UT);
#pragma unroll
  for (int i = 0; i < 4; ++i) {
    const int tok = m0 + wm * 64 + i * 16 + fq * 4;
    size_t base; int T, b, t;
    if (tok < NPR) { b = tok >> 8; t = tok & 255; T = 256; base = 0; } else { const int s = tok - NPR; b = s >> 10; t = s & 1023; T = 1024; base = (size_t)NPR * 1024; }
#pragma unroll
    for (int j = 0; j < 4; ++j) {
      const int k2 = wn * 64 + j * 16 + fr;
      *(unsigned*)(UT + base + ((size_t)(b * 4 + g) * 128 + k2) * (2 * T) + nh * T + t) = pk4f8(acc[i][j][0] * 4.f, acc[i][j][1] * 4.f, acc[i][j][2] * 4.f, acc[i][j][3] * 4.f);
    }
  }
}

__device__ __forceinline__ void qup_tile(const Params& p, int l, int tile, char* lds) {
  const int tid = tidx(), lane = tid & 63, wid = tid >> 6, wm = wid >> 1, wn = wid & 1, fr = lane & 15, fq = lane >> 4;
  const int m = tile % 96, nt = tile / 96, m0 = m * 128, n0 = nt * 128;
  char* ws = wsp(p.ws);
  const char* QL = (const char*)(ws + O_QLAT) + (size_t)m0 * 384;
  float rsv4[4];
  {
    float* rs = (float*)lds;
    __syncthreads();
#pragma unroll 1
    for (int r0 = 0; r0 < 32; r0 += 4) {
      float ss[4];
#pragma unroll
      for (int u = 0; u < 4; ++u) {
        u32x4 w = (u32x4){0u, 0u, 0u, 0u};
        if (lane < 24) w = ldg16(QL + (size_t)(wid * 32 + r0 + u) * 384 + lane * 16);
        float a = 0.f;
#pragma unroll
        for (int q = 0; q < 4; ++q) {
          const float f0 = __builtin_amdgcn_cvt_f32_fp8(w[q], 0), f1 = __builtin_amdgcn_cvt_f32_fp8(w[q], 1), f2 = __builtin_amdgcn_cvt_f32_fp8(w[q], 2), f3 = __builtin_amdgcn_cvt_f32_fp8(w[q], 3);
          a += f0 * f0 + f1 * f1 + f2 * f2 + f3 * f3;
        }
        ss[u] = a;
      }
#pragma unroll
      for (int u = 0; u < 4; ++u) { const float t = wave_sum(ss[u]); if (lane == 0) rs[wid * 32 + r0 + u] = rsqrtf(t * (1.f / (384.f * 64.f)) + EPSN); }
    }
    __syncthreads();
#pragma unroll
    for (int i = 0; i < 4; ++i) rsv4[i] = rs[wm * 64 + i * 16 + fr];
    __syncthreads();
  }
  f32x4 acc[4][4];
  zero_acc(acc);
  { int par = 0; gemm_bytes<true, 4, 1, true>(QL, 384, (const char*)(ws + O_WQ) + ((size_t)l * 768 + n0) * 384, 384, 384, acc, lds, par, false, nullptr, 0, nullptr, 0); }
  bf16_t* QB = (bf16_t*)(ws + O_QB);
  const float qscale = 0.10206207261596577f * 1.44269504089f * (1.f / 256.f);
#pragma unroll
  for (int i = 0; i < 4; ++i) {
    const int rl = wm * 64 + i * 16 + fr, tok = m0 + rl;
    const float sc = rsv4[i] * qscale;
    const int smp = tok >= NPR, t = (tok - NPR) & 1023;
#pragma unroll
    for (int j = 0; j < 4; ++j) {
      const int cb = n0 + wn * 64 + j * 16, within = cb % 96;
      f32x4 v = acc[i][j] * sc;
      if (within >= 64) {
        f32x4 pr;
#pragma unroll
        for (int e = 0; e < 4; ++e) pr[e] = __shfl_xor(v[e], 32);
        if (smp) {
          const int pos = within >= 80 ? (t & 63) : (t >> 6);
          const float* rt = (const float*)(ws + O_ROPE) + (pos * 8 + (fq & 1) * 4) * 2;
          const f32x4 c01 = *(const f32x4*)rt, c23 = *(const f32x4*)(rt + 4);
          const float cs4[4] = {c01[0], c01[2], c23[0], c23[2]}, sn4[4] = {c01[1], c01[3], c23[1], c23[3]};
#pragma unroll
          for (int e = 0; e < 4; ++e) v[e] = fq < 2 ? v[e] * cs4[e] - pr[e] * sn4[e] : pr[e] * sn4[e] + v[e] * cs4[e];
        }
      }
      *(u32x2*)(QB + (size_t)tok * 768 + cb + fq * 4) = pk4(v);
    }
  }
}

__device__ __forceinline__ void kvup_tile(const Params& p, int l, int tile, char* lds) {
  const int tid = tidx(), lane = tid & 63, wid = tid >> 6, wm = wid >> 1, wn = wid & 1, fr = lane & 15, fq = lane >> 4;
  const int m = tile % 112, nt = tile / 112, m0 = m * 128, n0 = nt * 128;
  char* ws = wsp(p.ws);
  const char* A = (const char*)(ws + O_CKVA) + (size_t)m0 * 256;
  const char* B = (const char*)(ws + O_WKV) + ((size_t)l * 1024 + n0) * 256;
  const float ks = 1.f / 128.f;
  f32x4 acc[4][4];
  zero_acc(acc);
  if (nt < 4) {
    { int par = 0; gemm_bytes<true, 4, 1, true>(A, 256, B, 256, 256, acc, lds, par, false, nullptr, 0, nullptr, 0); }
    bf16_t* KB = (bf16_t*)(ws + O_KB);
#pragma unroll
    for (int i = 0; i < 4; ++i) {
      const int R = m0 + wm * 64 + i * 16 + fr;
#pragma unroll
      for (int j = 0; j < 4; ++j) *(u32x2*)(KB + (size_t)R * 512 + n0 + wn * 64 + j * 16 + fq * 4) = pk4(acc[i][j] * ks);
    }
  } else {
    { int par = 0; gemm_bytes<false, 4, 1, true>(A, 256, B, 256, 256, acc, lds, par, false, nullptr, 0, nullptr, 0); }
    bf16_t* VT = (bf16_t*)(ws + O_VT);
#pragma unroll
    for (int i = 0; i < 4; ++i) {
      const int R = m0 + wm * 64 + i * 16 + fq * 4;
      size_t base; int Tk, b, k;
      if (R < NPR) { b = R >> 8; k = R & 255; Tk = 256; base = 0; } else { const int s = R - NPR; b = s / 1536; k = s - b * 1536; Tk = 1536; base = (size_t)NPR * 512; }
#pragma unroll
      for (int j = 0; j < 4; ++j) {
        const int c = n0 - 512 + wn * 64 + j * 16 + fr, h = c >> 6, vd = c & 63;
        *(u32x2*)(VT + base + ((size_t)(b * 8 + h) * 64 + vd) * Tk + k) = pk4(acc[i][j] * ks);
      }
    }
  }
}

template <int NJ>
__device__ __forceinline__ void f2_tile(const Params& p, int tile, char* lds) {
  const int tid = tidx(), lane = tid & 63, wid = tid >> 6, wm = wid >> 1, wn = wid & 1, fr = lane & 15, fq = lane >> 4;
  char* ws = wsp(p.ws);
  const char *A, *B; int K, tokb, g, nh = 0; float scale;
  if (NJ == 2) {
    const int b = tile >> 6, mt = (tile >> 1) & 7; g = (tile >> 4) & 3; nh = tile & 1;
    A = (const char*)(ws + O_D1024) + (size_t)mt * 128 * 2048; K = 2048;
    B = (const char*)(ws + O_UT) + (size_t)NPR * 1024 + ((size_t)(b * 4 + g) * 128 + nh * 64) * 2048;
    tokb = NPR + b * 1024 + mt * 128; scale = 0.00276213586400995f * (1.f / 256.f);
  } else {
    const int b = tile >> 3, mt = tile & 1; g = (tile >> 1) & 3;
    A = (const char*)(ws + O_D256) + (size_t)mt * 128 * 512; K = 512;
    B = (const char*)(ws + O_UT) + (size_t)(b * 4 + g) * 128 * 512;
    tokb = b * 256 + mt * 128; scale = 0.0055242717280199f * (1.f / 256.f);
  }
  f32x4 acc[4][NJ];
#pragma unroll
  for (int i = 0; i < 4; ++i)
#pragma unroll
    for (int j = 0; j < NJ; ++j) acc[i][j] = (f32x4){0.f, 0.f, 0.f, 0.f};
  { int par = 0; gemm_bytes<true, NJ, 1, true>(A, K, B, K, K, acc, lds, par, false, nullptr, 0, nullptr, 0); }
  bf16_t* FZ = (bf16_t*)(ws + O_FZ);
#pragma unroll
  for (int i = 0; i < 4; ++i) {
    const int tok = tokb + wm * 64 + i * 16 + fr;
#pragma unroll
    for (int j = 0; j < NJ; ++j) {
      bf16_t* gp = FZ + (size_t)tok * 512 + g * 128 + nh * 64 + wn * (NJ * 16) + j * 16 + fq * 4;
      const u32x2 gz = *(const u32x2*)gp;
      f32x4 y;
      y[0] = acc[i][j][0] * scale * bflo(gz.x); y[1] = acc[i][j][1] * scale * bfhi(gz.x);
      y[2] = acc[i][j][2] * scale * bflo(gz.y); y[3] = acc[i][j][3] * scale * bfhi(gz.y);
      *(unsigned*)(ws + O_BR8 + (size_t)2 * NTOK * 512 + (size_t)tok * 512 + g * 128 + nh * 64 + wn * (NJ * 16) + j * 16 + fq * 4) = pk4f8(y[0] * 8.f, y[1] * 8.f, y[2] * 8.f, y[3] * 8.f);
    }
  }
}

template <int NJ>
__device__ __forceinline__ void s6_tile(const Params& p, int l, int tile, int ntile, char* lds, int& par, bool& primed) {
  const int tid = tidx(), lane = tid & 63, wid = tid >> 6, wm = wid >> 1, wn = wid & 1, fr = lane & 15, fq = lane >> 4;
  constexpr int NT = 32 / NJ, BN = NJ * 32;
  const int m = (tile / (32 * NT)) * 32 + (tile % 32), nt = (tile % (32 * NT)) / 32, m0 = m * 128, n0 = nt * BN;
  char* ws = wsp(p.ws);
  const char* H8 = (const char*)(ws + O_H8);
  const char* W8 = (const char*)(ws + O_WG8) + (size_t)l * 3072 * 1024;
  const char* Wb = (const char*)(ws + O_WBR) + (size_t)(l * 3) * 1024 * 512;
  f32x4 tot[4][NJ], acc[4][NJ];
  unsigned sg[4][NJ];
#pragma unroll
  for (int i = 0; i < 4; ++i)
#pragma unroll
    for (int j = 0; j < NJ; ++j) tot[i][j] = (f32x4){0.f, 0.f, 0.f, 0.f};
#pragma unroll 1
  for (int nb = 0; nb < 3; ++nb) {
    u32x2 totp[4][NJ];
#pragma unroll
    for (int i = 0; i < 4; ++i)
#pragma unroll
      for (int j = 0; j < NJ; ++j) { totp[i][j] = pk4(tot[i][j]); acc[i][j] = (f32x4){0.f, 0.f, 0.f, 0.f}; }
    const char* brA = (const char*)(ws + O_BR8) + ((size_t)nb * NTOK + m0) * 512;
    const char* brB = Wb + ((size_t)nb * 1024 + n0) * 512;
    gemm_bytes<true, NJ, 2, true>(H8 + (size_t)m0 * 1024, 1024, W8 + ((size_t)nb * 1024 + n0) * 1024, 1024, 1024, acc, lds, par, primed, brA, 512, brB, 512);
#pragma unroll
    for (int i = 0; i < 4; ++i)
#pragma unroll
      for (int j = 0; j < NJ; ++j) {
        unsigned q = 0;
#pragma unroll
        for (int e = 0; e < 4; ++e) {
          const unsigned qe = (unsigned)fmaxf(sigm_f(acc[i][j][e] * 0.03125f) * 255.f + 0.5f, 1.f);
          q |= qe << (8 * e);
          tot[i][j][e] = (e == 0 ? bflo(totp[i][j].x) : e == 1 ? bfhi(totp[i][j].x) : e == 2 ? bflo(totp[i][j].y) : bfhi(totp[i][j].y)) * __builtin_amdgcn_rcpf((float)qe * (1.f / 255.f));
        }
        sg[i][j] = q;
      }
    const char *nA = nullptr, *nB = nullptr;
    if (nb < 2) { nA = H8 + (size_t)m0 * 1024; nB = W8 + ((size_t)(nb + 1) * 1024 + n0) * 1024; }
    else if (ntile >= 0) { nA = H8 + (size_t)(((ntile / (32 * NT)) * 32 + (ntile % 32)) * 128) * 1024; nB = W8 + (size_t)(((ntile % (32 * NT)) / 32) * BN) * 1024; }
    gemm_bytes<true, NJ, 2, true>(brA, 512, brB, 512, 512, tot, lds, par, true, nA, 1024, nB, 1024);
    primed = nA != nullptr;
#pragma unroll
    for (int i = 0; i < 4; ++i)
#pragma unroll
      for (int j = 0; j < NJ; ++j) {
        tot[i][j][0] *= (float)(sg[i][j] & 0xffu) * (1.f / 255.f); tot[i][j][1] *= (float)((sg[i][j] >> 8) & 0xffu) * (1.f / 255.f);
        tot[i][j][2] *= (float)((sg[i][j] >> 16) & 0xffu) * (1.f / 255.f); tot[i][j][3] *= (float)(sg[i][j] >> 24) * (1.f / 255.f);
      }
  }
  unsigned char* MG = (unsigned char*)(ws + O_UT);
#pragma unroll
  for (int i = 0; i < 4; ++i) {
    const int tok = m0 + wm * 64 + i * 16 + fr;
#pragma unroll
    for (int j = 0; j < NJ; ++j) *(unsigned*)(MG + (size_t)tok * 1024 + n0 + wn * (NJ * 16) + j * 16 + fq * 4) = pk4f8(tot[i][j][0] * (1.f / 256.f), tot[i][j][1] * (1.f / 256.f), tot[i][j][2] * (1.f / 256.f), tot[i][j][3] * (1.f / 256.f));
  }
}

__device__ __forceinline__ void s7_tile(const Params& p, int l, int tile, const float* xp, const float* xs, char* lds) {
  const int tid = tidx(), lane = tid & 63, wid = tid >> 6, wm = wid >> 1, wn = wid & 1, fr = lane & 15, fq = lane >> 4;
  const int m = (tile / 512) * 32 + (tile % 32), nt = (tile % 512) / 32, m0 = m * 128, n0 = nt * 64;
  char* ws = wsp(p.ws);
  f32x4 acc[4][2];
#pragma unroll
  for (int i = 0; i < 4; ++i) { acc[i][0] = (f32x4){0.f, 0.f, 0.f, 0.f}; acc[i][1] = (f32x4){0.f, 0.f, 0.f, 0.f}; }
  { int par = 0; gemm_bytes<true, 2, 1, true>((const char*)(ws + O_UT) + (size_t)m0 * 1024, 1024, (const char*)(ws + O_WO) + ((size_t)l * 1024 + n0) * 1024, 1024, 1024, acc, lds, par, false, nullptr, 0, nullptr, 0); }
#pragma unroll
  for (int i = 0; i < 4; ++i) {
    const int tok = m0 + wm * 64 + i * 16 + fr;
    const float* src = tok < NPR ? xp + (size_t)tok * 1024 : xs + (size_t)(tok - NPR) * 1024;
    const int v = tok < NPR ? 0 : 1 + ((tok - NPR) >> 10);
    const float* gate = (const float*)(ws + O_MOD) + (l * 5 + v) * 3072 + 2048;
#pragma unroll
    for (int j = 0; j < 2; ++j) {
      const int col = n0 + wn * 32 + j * 16 + fq * 4;
      const f32x4 x = *(const f32x4*)(src + col), gt = *(const f32x4*)(gate + col);
      f32x4 y;
#pragma unroll
      for (int e = 0; e < 4; ++e) y[e] = x[e] + gt[e] * (acc[i][j][e] * 0.03125f);
      *(f32x4*)(p.out + (size_t)tok * 1024 + col) = y;
    }
  }
}

constexpr int NPHASE = 16;
__device__ __forceinline__ int q_issue(unsigned* ctr) {
  int v = 0;
  if (threadIdx.x == 0) v = (int)__hip_atomic_fetch_add(ctr, 1u, __ATOMIC_RELAXED, __HIP_MEMORY_SCOPE_AGENT);
  return v;
}
__device__ __forceinline__ int q_bcast(int v, char* lds) {
  __syncthreads();
  if (threadIdx.x == 0) *(volatile int*)lds = v;
  __syncthreads();
  const int it = *(volatile int*)lds;
  __syncthreads();
  return it;
}
__device__ __forceinline__ void run_phase(const Params& p, int ph, char* lds, unsigned* qctr) {
  const int bid = blockIdx.x, nb = gridDim.x;
  if (ph == 0) { for (int i = bid; i < P0_N; i += nb) phase0_item(p, i, lds); return; }
  if (ph == 15) { for (int i = bid; i < 512; i += nb) final_item(p, i); return; }
  const int l = (ph - 1) / 7, s = (ph - 1) % 7;
  const float* xp = l == 0 ? p.x_prompt : p.out;
  const float* xs = l == 0 ? p.x_sample : p.out + (size_t)NPR * 1024;
  switch (s) {
    case 0: for (int i = bid; i < 512; i += nb) norm_item(p, l, i, xp, xs); break;
    case 1: for (int i = bid; i < 2880; i += nb) s2_tile(p, l, i, lds); break;
    case 2:
      for (int i = q_bcast(q_issue(qctr + ph), lds); i < 2752;) {
        if (i < 128) attn_item<1>(p, l, i, lds);
        else if (i < 1024) keyprep_item(p, l, i - 128);
        else if (i < 1280) attn_item<1>(p, l, 128 + (i - 1024), lds);
        else if (i < 1408) state_item(p, l, i - 1280);
        else if (i < 1984) qup_tile(p, l, i - 1408, lds);
        else f1_tile(p, i - 1984, lds);
        i = q_bcast(q_issue(qctr + ph), lds);
      }
      break;
    case 3:
      for (int i = q_bcast(q_issue(qctr + ph), lds); i < 1408;) {
        if (i < 256) f2_tile<2>(p, i, lds);
        else if (i < 512) f2_tile<4>(p, i - 256, lds);
        else kvup_tile(p, l, i - 512, lds);
        i = q_bcast(q_issue(qctr + ph), lds);
      }
      break;
    case 4:
      for (int i = q_bcast(q_issue(qctr + ph), lds); i < 768;) {
        attn_item<0>(p, l, i, lds);
        i = q_bcast(q_issue(qctr + ph), lds);
      }
      break;
    case 5: { int par = 0; bool primed = false; for (int i = bid; i < 768; i += nb) s6_tile<4>(p, l, i, (i + nb < 768) ? i + nb : -1, lds, par, primed); } break;
    case 6: for (int i = bid; i < 1536; i += nb) s7_tile(p, l, i, xp, xs, lds); break;
  }
}

#define XB_TMO      128
#define XB_XCNT(j)  (256  + 64 * (j))
#define XB_XSUB(j)  (1280 + 64 * (j))
#define XB_XGEN(j)  (2304 + 64 * (j))
#define XB_TOP      3328
#define XB_TOPGEN   3392
#define XCD_BAR_WORDS 3456
#define XB_SPIN_CAP (1u << 18)
__device__ __forceinline__ unsigned xb_ld(unsigned* p)              { return __hip_atomic_load(p, __ATOMIC_RELAXED, __HIP_MEMORY_SCOPE_AGENT); }
__device__ __forceinline__ unsigned xb_add(unsigned* p, unsigned v) { return __hip_atomic_fetch_add(p, v, __ATOMIC_RELAXED, __HIP_MEMORY_SCOPE_AGENT); }
__device__ __forceinline__ unsigned xb_xcc_id() { return (unsigned)__builtin_amdgcn_s_getreg((3 << 11) | 20) & 0xFu; }
#define XB_SPIN(cond, bar) do { unsigned _sp = 0; while (cond) { __builtin_amdgcn_s_sleep(1); \
    if ((++_sp & 255u) == 0u) { if (xb_ld(&(bar)[XB_TMO])) break; if (_sp > XB_SPIN_CAP) { atomicAdd(&(bar)[XB_TMO], 1u); break; } } } } while (0)
__device__ __forceinline__ void xcd_barrier_complete(unsigned* bar, unsigned x, unsigned& nloc, unsigned& nx) {
  const unsigned G = gridDim.x;
  unsigned sum, cnt, mine, sp = 0u;
  for (;;) {
    sum = 0u; cnt = 0u; mine = 0u;
#pragma unroll
    for (unsigned j = 0; j < 16; ++j) { const unsigned c = xb_ld(&bar[XB_XCNT(j)]); sum += c; cnt += (c > 0u) ? 1u : 0u; mine = (j == x) ? c : mine; }
    if (sum == G) break;
    __builtin_amdgcn_s_sleep(1);
    if ((++sp & 255u) == 0u) { if (xb_ld(&bar[XB_TMO])) break; if (sp > XB_SPIN_CAP) { atomicAdd(&bar[XB_TMO], 1u); break; } }
  }
  nloc = mine > 0u ? mine : 1u; nx = cnt > 0u ? cnt : 1u;
}
__device__ __forceinline__ void xcd_barrier(unsigned* bar, unsigned x, unsigned& nloc, unsigned& nx) {
  asm volatile("s_waitcnt vmcnt(0)" ::: "memory");
  __syncthreads();
  if (threadIdx.x == 0) {
    __builtin_amdgcn_s_waitcnt(0);
    if (nloc == 0u) xcd_barrier_complete(bar, x, nloc, nx);
    const unsigned old = xb_add(&bar[XB_XSUB(x)], 1u);
    const unsigned gen = old / nloc;
    if (old + 1u == (gen + 1u) * nloc) {
      __builtin_amdgcn_fence(__ATOMIC_RELEASE, "agent");
      asm volatile("s_waitcnt vmcnt(0)" ::: "memory");
      const unsigned og = xb_add(&bar[XB_TOP], 1u);
      const unsigned tg = og / nx;
      if (og + 1u == (tg + 1u) * nx) xb_add(&bar[XB_TOPGEN], 1u);
      else XB_SPIN(xb_ld(&bar[XB_TOPGEN]) == tg, bar);
      __builtin_amdgcn_fence(__ATOMIC_ACQUIRE, "agent");
      xb_add(&bar[XB_XGEN(x)], 1u);
      asm volatile("s_waitcnt vmcnt(0)" ::: "memory");
    } else {
      XB_SPIN(xb_ld(&bar[XB_XGEN(x)]) == gen, bar);
      __builtin_amdgcn_fence(__ATOMIC_ACQUIRE, "agent");
      asm volatile("s_waitcnt vmcnt(0)" ::: "memory");
    }
  }
  __syncthreads();
}

__global__ void __launch_bounds__(256, 2) mk_fwd(Params p) {
  __shared__ __attribute__((aligned(16))) char lds[LDS_TOTAL];
  cg::grid_group grid = cg::this_grid();
  unsigned* bar = (unsigned*)(p.ws + O_BAR);
  const unsigned xcc = xb_xcc_id();
  if (threadIdx.x == 0) (void)xb_add(&bar[XB_XCNT(xcc)], 1u);
  unsigned nloc = 0u, nx = 0u;
  if (gridDim.x == 0x7fffffffu) grid.sync();
#pragma unroll 1
  for (int ph = 0; ph < NPHASE; ++ph) {
    run_phase(p, ph, lds, bar);
    if (ph + 1 < NPHASE) xcd_barrier(bar, xcc, nloc, nx);
  }
}

extern "C" void kernel_launch(void* const* d_in, const int* in_sizes, int n_in, void* d_out, int out_size, void* d_ws, size_t ws_size,
                              hipStream_t stream) {
  Params p{};
  p.x_prompt = (const float*)d_in[0]; p.x_sample = (const float*)d_in[1]; p.cache_ckv = (const float*)d_in[2]; p.cache_krope = (const float*)d_in[3];
  p.state_ret = (const float*)d_in[4]; p.c = (const float*)d_in[5]; p.c_ctx = (const float*)d_in[6]; p.norm_g = (const float*)d_in[7];
  p.w_mod = (const float*)d_in[8]; p.b_mod = (const float*)d_in[9]; p.w_in = (const float*)d_in[10]; p.ret_logit = (const float*)d_in[11];
  p.q_norm_g = (const float*)d_in[12]; p.w_q_up = (const float*)d_in[13]; p.kv_norm_g = (const float*)d_in[14]; p.w_kv_up = (const float*)d_in[15];
  p.w_branch = (const float*)d_in[16]; p.w_out = (const float*)d_in[17]; p.final_g = (const float*)d_in[18];
  p.out = (float*)d_out; p.ws = (char*)d_ws;
#if ONE_LAUNCH
  static int grid_blocks = 0;
  if (!grid_blocks) {
    int dev = 0, cus = 0, per_cu = 0;
    hipGetDevice(&dev);
    hipDeviceGetAttribute(&cus, hipDeviceAttributeMultiprocessorCount, dev);
    hipOccupancyMaxActiveBlocksPerMultiprocessor(&per_cu, mk_fwd, 256, 0);
    if (per_cu > 2) per_cu = 2;
    grid_blocks = cus * per_cu;
  }
  hipMemsetAsync((char*)d_ws + O_BAR, 0, XCD_BAR_WORDS * 4, stream);
  void* args[] = {&p};
  hipError_t e = hipLaunchCooperativeKernel((void*)mk_fwd, dim3(grid_blocks), dim3(256), args, 0, stream);
  if (e != hipSuccess) fprintf(stderr, "cooperative launch failed: %s (grid %d)\n", hipGetErrorString(e), grid_blocks);
#endif
}
```

```cpp
#include <hip/hip_runtime.h>
#include <hip/hip_cooperative_groups.h>
#include <stdint.h>
#include <stdio.h>
namespace cg = cooperative_groups;

#ifndef ONE_LAUNCH
#define ONE_LAUNCH 1
#endif

typedef unsigned short bf16_t;
typedef short bf16x8 __attribute__((ext_vector_type(8)));
typedef float f32x4 __attribute__((ext_vector_type(4)));
typedef unsigned u32x4 __attribute__((ext_vector_type(4)));
typedef unsigned u32x2 __attribute__((ext_vector_type(2)));

constexpr int NTOK = 12288, NPR = 8192, NKEY = 14336;
constexpr float EPSN = 1e-6f;

constexpr size_t O_WIN   = 0;
constexpr size_t O_WQ    = O_WIN   + (size_t)2 * 6912 * 1024 * 2;
constexpr size_t O_WKV   = O_WQ    + (size_t)2 * 768 * 384 * 2;
constexpr size_t O_WBR   = O_WKV   + (size_t)2 * 1024 * 256 * 2;
constexpr size_t O_WO    = O_WBR   + (size_t)6 * 1024 * 512 * 2;
constexpr size_t O_CS    = O_WO    + (size_t)2 * 1024 * 1024 * 2;
constexpr size_t O_D256  = O_CS    + (size_t)256 * 128 * 2;
constexpr size_t O_D1024 = O_D256  + (size_t)256 * 512 * 2;
constexpr size_t O_S0T   = O_D1024 + (size_t)1024 * 2048 * 2;
constexpr size_t O_MOD   = O_S0T   + (size_t)64 * 128 * 64 * 2;
constexpr size_t O_H     = O_MOD   + (size_t)2 * 5 * 3072 * 4;
constexpr size_t O_BR8   = O_H;
constexpr size_t O_UT    = O_H     + (size_t)NTOK * 1024 * 2;
constexpr size_t O_RQ    = O_UT    + (size_t)NTOK * 1024 * 2;
constexpr size_t O_RK    = O_RQ    + (size_t)NTOK * 256 * 2;
constexpr size_t O_RKT   = O_RK    + (size_t)NTOK * 256 * 2;
constexpr size_t O_RVT   = O_RKT   + (size_t)NPR * 256 * 2;
constexpr size_t O_KVLAT = O_RVT   + (size_t)NTOK * 512 * 2;
constexpr size_t O_KR    = O_KVLAT + (size_t)NTOK * 256 * 4;
constexpr size_t O_R2END = O_KR    + (size_t)NTOK * 32 * 4;
constexpr size_t O_VT    = O_RQ;
static_assert(O_VT + (size_t)NKEY * 512 * 2 <= O_R2END, "alias overflow");
constexpr size_t O_RZ    = O_R2END;
constexpr size_t O_MZ    = O_RZ    + (size_t)NTOK * 512 * 2;
constexpr size_t O_FZ    = O_MZ    + (size_t)NTOK * 512 * 2;
constexpr size_t O_FU    = O_FZ    + (size_t)NTOK * 512 * 2;
constexpr size_t O_QLAT  = O_FU    + (size_t)NTOK * 512 * 2;
constexpr size_t O_CKVA  = O_QLAT  + (size_t)NTOK * 384 * 2;
constexpr size_t O_KB    = O_CKVA  + (size_t)NKEY * 256 * 2;
constexpr size_t O_KRA   = O_KB    + (size_t)NKEY * 512 * 2;
constexpr size_t O_QB    = O_KRA   + (size_t)NKEY * 32 * 2;
constexpr size_t O_H8    = O_QB    + (size_t)NTOK * 768 * 2;
constexpr size_t O_WG8   = O_H8    + (size_t)NTOK * 1024;
constexpr size_t O_WS8   = O_WG8   + (size_t)2 * 3072 * 1024;
constexpr size_t O_END   = O_WS8   + (size_t)2 * 1920 * 1024;
constexpr size_t O_ROPE  = (O_END + 255) & ~(size_t)255;
constexpr size_t O_BAR   = O_ROPE + 4096;
static_assert(O_BAR + 16384 <= (size_t)256 * 1024 * 1024, "workspace too large");

constexpr size_t OUT_CKV = (size_t)NTOK * 1024;
constexpr size_t OUT_KR  = OUT_CKV + (size_t)32 * 2 * 256 * 256;
constexpr size_t OUT_RET = OUT_KR + (size_t)32 * 2 * 256 * 32;

struct Params {
  const float *x_prompt, *x_sample, *cache_ckv, *cache_krope, *state_ret, *c, *c_ctx, *norm_g, *w_mod, *b_mod,
      *w_in, *ret_logit, *q_norm_g, *w_q_up, *kv_norm_g, *w_kv_up, *w_branch, *w_out, *final_g;
  float* out;
  char* ws;
};

constexpr int PANEL = 128 * 64;
constexpr int ABYTES = 2 * PANEL;
constexpr int STAGE = 2 * ABYTES;
constexpr int LDS_GEMM = 2 * STAGE;
constexpr int LDS_TOTAL = LDS_GEMM;
static_assert(LDS_TOTAL <= 65536, "static LDS");

typedef float f32x2 __attribute__((ext_vector_type(2)));
typedef __bf16 bf16x2v __attribute__((ext_vector_type(2)));
__device__ __forceinline__ unsigned pk2(float lo, float hi) { const f32x2 v = {lo, hi}; return __builtin_bit_cast(unsigned, __builtin_convertvector(v, bf16x2v)); }
__device__ __forceinline__ bf16_t tobf(float x) { return (bf16_t)(pk2(x, 0.f) & 0xffffu); }
typedef int v8i __attribute__((ext_vector_type(8)));
__device__ __forceinline__ float sat8(float x) { return __builtin_amdgcn_fmed3f(x, -448.f, 448.f); }
__device__ __forceinline__ unsigned pk4f8(float a, float b, float c, float d) { unsigned w = 0; a = sat8(a); b = sat8(b); c = sat8(c); d = sat8(d); w = __builtin_amdgcn_cvt_pk_fp8_f32(a, b, w, false); w = __builtin_amdgcn_cvt_pk_fp8_f32(c, d, w, true); return w; }
__device__ __forceinline__ float bflo(unsigned u) { return __uint_as_float(u << 16); }
__device__ __forceinline__ float bfhi(unsigned u) { return __uint_as_float(u & 0xffff0000u); }
__device__ __forceinline__ float ex2(float x) { return __builtin_amdgcn_exp2f(x); }
__device__ __forceinline__ float silu_f(float x) { return x / (1.f + __expf(-x)); }
__device__ __forceinline__ float sigm_f(float x) { return 1.f / (1.f + __expf(-x)); }
__device__ __forceinline__ u32x2 pk4(f32x4 v) { u32x2 r; r.x = pk2(v[0], v[1]); r.y = pk2(v[2], v[3]); return r; }
#define GAS __attribute__((address_space(1)))
#define LAS __attribute__((address_space(3)))
__device__ __forceinline__ u32x4 ldg16(const void* p) { return *(const GAS u32x4*)p; }
__device__ __forceinline__ int tidx() { int t = threadIdx.x; asm volatile("" : "+v"(t)); return t; }
__device__ __forceinline__ char* wsp(const char* w) { unsigned long long v = (unsigned long long)w; asm volatile("" : "+s"(v)); return (char*)v; }
__device__ __forceinline__ int swz(int r) { return (0 - ((r >> 2) & 3)) & 3; }
__device__ __forceinline__ float wave_sum(float v) {
#pragma unroll
  for (int o = 1; o < 64; o <<= 1) v += __shfl_xor(v, o);
  return v;
}
__device__ __forceinline__ f32x4 mfma16(bf16x8 a, bf16x8 b, f32x4 c) { return __builtin_amdgcn_mfma_f32_16x16x32_bf16(a, b, c, 0, 0, 0); }
__device__ __forceinline__ bf16x8 as_bf8(u32x4 v) { return __builtin_bit_cast(bf16x8, v); }

__device__ __forceinline__ void zero_acc(f32x4 (&acc)[4][4]) {
#pragma unroll
  for (int i = 0; i < 4; ++i)
#pragma unroll
    for (int j = 0; j < 4; ++j) acc[i][j] = (f32x4){0.f, 0.f, 0.f, 0.f};
}

template <bool SWAP, int NJ, int PIPE, bool F8>
__device__ __forceinline__ void gemm_bytes(const char* __restrict__ A, int lda, const char* __restrict__ B, int ldb, int Kb,
                                           f32x4 (&acc)[4][NJ], char* lds, int& par, bool primed,
                                           const char* nA, int nlda, const char* nB, int nldb) {
  const int tid = tidx(), lane = tid & 63, wm = (tid >> 6) >> 1, wn = (tid >> 6) & 1;
  const int wid = __builtin_amdgcn_readfirstlane(tid >> 6);
  const int fr = lane & 15, fq = lane >> 4;
  const int fa = (wm * 64 + fr) * 64 + ((fq ^ swz(fr)) << 4);
  const int fb = ABYTES + (wn * NJ * 16 + fr) * 64 + ((fq ^ swz(fr)) << 4);
  const int lrow = lane >> 2, lchunk = (lane & 3) ^ swz(lrow);
  constexpr int NBL = NJ / 2;
  const GAS char* gA = (const GAS char*)(A + (size_t)(wid * 32 + lrow) * lda + lchunk * 16);
  const GAS char* gB = (const GAS char*)(B + (size_t)(wid * NBL * 16 + lrow) * ldb + lchunk * 16);
  const size_t a16 = (size_t)16 * lda, b16 = (size_t)16 * ldb;
  LAS char* ldsA = (LAS char*)lds + wid * 2048;
  LAS char* ldsB = (LAS char*)lds + ABYTES + wid * NBL * 1024;
  const int nk = Kb >> 7;
#define GC_ISSUE(pa, pb, sa, sb, stage, kbyte) do { \
    _Pragma("unroll") for (int g = 0; g < 2; ++g) _Pragma("unroll") for (int pn = 0; pn < 2; ++pn) \
      __builtin_amdgcn_global_load_lds((const GAS unsigned*)((pa) + g * (sa) + (kbyte) + pn * 64), (LAS unsigned*)(ldsA + (stage) + pn * PANEL + g * 1024), 16, 0, 0); \
    _Pragma("unroll") for (int g = 0; g < NBL; ++g) _Pragma("unroll") for (int pn = 0; pn < 2; ++pn) \
      __builtin_amdgcn_global_load_lds((const GAS unsigned*)((pb) + g * (sb) + (kbyte) + pn * 64), (LAS unsigned*)(ldsB + (stage) + pn * PANEL + g * 1024), 16, 0, 0); \
  } while (0)
  if (!primed) {
    GC_ISSUE(gA, gB, a16, b16, par * STAGE, 0);
    asm volatile("s_waitcnt vmcnt(0)" ::: "memory");
    __syncthreads();
  }
#pragma unroll 1
  for (int kt = 0; kt < nk; ++kt) {
    char* cur = lds + par * STAGE;
    if (kt + 1 < nk) GC_ISSUE(gA, gB, a16, b16, (par ^ 1) * STAGE, (size_t)(kt + 1) * 128);
    else if (nA) {
      const GAS char* hA = (const GAS char*)(nA + (size_t)(wid * 32 + lrow) * nlda + lchunk * 16);
      const GAS char* hB = (const GAS char*)(nB + (size_t)(wid * NBL * 16 + lrow) * nldb + lchunk * 16);
      GC_ISSUE(hA, hB, (size_t)16 * nlda, (size_t)16 * nldb, (par ^ 1) * STAGE, 0);
    }
    __builtin_amdgcn_sched_barrier(0);
    if (F8 && PIPE == 1) {
      v8i av[4], bv[NJ];
#pragma unroll
      for (int i = 0; i < 4; ++i) {
        const u32x4 a0 = *(const u32x4*)(cur + fa + i * 1024), a1 = *(const u32x4*)(cur + PANEL + fa + i * 1024);
        av[i] = (v8i){(int)a0.x, (int)a0.y, (int)a0.z, (int)a0.w, (int)a1.x, (int)a1.y, (int)a1.z, (int)a1.w};
      }
#pragma unroll
      for (int j = 0; j < NJ; ++j) {
        const u32x4 b0 = *(const u32x4*)(cur + fb + j * 1024), b1 = *(const u32x4*)(cur + PANEL + fb + j * 1024);
        bv[j] = (v8i){(int)b0.x, (int)b0.y, (int)b0.z, (int)b0.w, (int)b1.x, (int)b1.y, (int)b1.z, (int)b1.w};
      }
      __builtin_amdgcn_sched_barrier(0);
#pragma unroll
      for (int i = 0; i < 4; ++i)
#pragma unroll
        for (int j = 0; j < NJ; ++j)
          acc[i][j] = SWAP ? __builtin_amdgcn_mfma_scale_f32_16x16x128_f8f6f4(bv[j], av[i], acc[i][j], 0, 0, 0, 0x7f7f7f7f, 0, 0x7f7f7f7f)
                           : __builtin_amdgcn_mfma_scale_f32_16x16x128_f8f6f4(av[i], bv[j], acc[i][j], 0, 0, 0, 0x7f7f7f7f, 0, 0x7f7f7f7f);
    } else if (F8) {
#pragma unroll
      for (int ih = 0; ih < 2; ++ih) {
        v8i av[2];
#pragma unroll
        for (int ii = 0; ii < 2; ++ii) {
          const u32x4 a0 = *(const u32x4*)(cur + fa + (ih * 2 + ii) * 1024), a1 = *(const u32x4*)(cur + PANEL + fa + (ih * 2 + ii) * 1024);
          av[ii] = (v8i){(int)a0.x, (int)a0.y, (int)a0.z, (int)a0.w, (int)a1.x, (int)a1.y, (int)a1.z, (int)a1.w};
        }
#pragma unroll
        for (int j = 0; j < NJ; ++j) {
          const u32x4 b0 = *(const u32x4*)(cur + fb + j * 1024), b1 = *(const u32x4*)(cur + PANEL + fb + j * 1024);
          const v8i bv = {(int)b0.x, (int)b0.y, (int)b0.z, (int)b0.w, (int)b1.x, (int)b1.y, (int)b1.z, (int)b1.w};
#pragma unroll
          for (int ii = 0; ii < 2; ++ii)
            acc[ih * 2 + ii][j] = SWAP ? __builtin_amdgcn_mfma_scale_f32_16x16x128_f8f6f4(bv, av[ii], acc[ih * 2 + ii][j], 0, 0, 0, 0x7f7f7f7f, 0, 0x7f7f7f7f)
                                       : __builtin_amdgcn_mfma_scale_f32_16x16x128_f8f6f4(av[ii], bv, acc[ih * 2 + ii][j], 0, 0, 0, 0x7f7f7f7f, 0, 0x7f7f7f7f);
        }
      }
    } else if (PIPE == 2) {
      bf16x8 af[2][4], bfr[NJ];
#pragma unroll
      for (int i = 0; i < 4; ++i) af[0][i] = *(const bf16x8*)(cur + fa + i * 1024);
#pragma unroll
      for (int j = 0; j < NJ; ++j) bfr[j] = *(const bf16x8*)(cur + fb + j * 1024);
#pragma unroll
      for (int i = 0; i < 4; ++i) af[1][i] = *(const bf16x8*)(cur + PANEL + fa + i * 1024);
      __builtin_amdgcn_sched_barrier(0);
#pragma unroll
      for (int i = 0; i < 4; ++i)
#pragma unroll
        for (int j = 0; j < NJ; ++j) acc[i][j] = SWAP ? mfma16(bfr[j], af[0][i], acc[i][j]) : mfma16(af[0][i], bfr[j], acc[i][j]);
#pragma unroll
      for (int j = 0; j < NJ; ++j) bfr[j] = *(const bf16x8*)(cur + PANEL + fb + j * 1024);
#pragma unroll
      for (int i = 0; i < 4; ++i)
#pragma unroll
        for (int j = 0; j < NJ; ++j) acc[i][j] = SWAP ? mfma16(bfr[j], af[1][i], acc[i][j]) : mfma16(af[1][i], bfr[j], acc[i][j]);
    } else if (PIPE == 1) {
      bf16x8 af[2][4], bfr[2][NJ];
#pragma unroll
      for (int ks = 0; ks < 2; ++ks) {
#pragma unroll
        for (int i = 0; i < 4; ++i) af[ks][i] = *(const bf16x8*)(cur + ks * PANEL + fa + i * 1024);
#pragma unroll
        for (int j = 0; j < NJ; ++j) bfr[ks][j] = *(const bf16x8*)(cur + ks * PANEL + fb + j * 1024);
      }
      __builtin_amdgcn_sched_barrier(0);
#pragma unroll
      for (int ks = 0; ks < 2; ++ks)
#pragma unroll
        for (int i = 0; i < 4; ++i)
#pragma unroll
          for (int j = 0; j < NJ; ++j) acc[i][j] = SWAP ? mfma16(bfr[ks][j], af[ks][i], acc[i][j]) : mfma16(af[ks][i], bfr[ks][j], acc[i][j]);
    } else {
#pragma unroll
      for (int ks = 0; ks < 2; ++ks) {
        bf16x8 af[4], bfr[NJ];
#pragma unroll
        for (int i = 0; i < 4; ++i) af[i] = *(const bf16x8*)(cur + ks * PANEL + fa + i * 1024);
#pragma unroll
        for (int j = 0; j < NJ; ++j) bfr[j] = *(const bf16x8*)(cur + ks * PANEL + fb + j * 1024);
#pragma unroll
        for (int i = 0; i < 4; ++i)
#pragma unroll
          for (int j = 0; j < NJ; ++j) acc[i][j] = SWAP ? mfma16(bfr[j], af[i], acc[i][j]) : mfma16(af[i], bfr[j], acc[i][j]);
      }
    }
    __builtin_amdgcn_sched_barrier(0);
    asm volatile("s_waitcnt vmcnt(0)" ::: "memory");
    __syncthreads();
    par ^= 1;
  }
#undef GC_ISSUE
}
template <bool SWAP, int NJ = 4, int PIPE = 1>
__device__ __forceinline__ void gemm_core(const bf16_t* __restrict__ A, int lda, const bf16_t* __restrict__ B, int ldb, int K,
                                          f32x4 (&acc)[4][NJ], char* lds, int& par, bool primed,
                                          const bf16_t* nA, int nlda, const bf16_t* nB, int nldb) {
  gemm_bytes<SWAP, NJ, PIPE, false>((const char*)A, lda * 2, (const char*)B, ldb * 2, K * 2, acc, lds, par, primed, (const char*)nA, nlda * 2, (const char*)nB, nldb * 2);
}
template <bool SWAP, int NJ = 4>
__device__ __forceinline__ void gemm_core(const bf16_t* __restrict__ A, int lda, const bf16_t* __restrict__ B, int ldb, int K,
                                          f32x4 (&acc)[4][NJ], char* lds) {
  int par = 0;
  gemm_core<SWAP, NJ>(A, lda, B, ldb, K, acc, lds, par, false, nullptr, 0, nullptr, 0);
}

__device__ __forceinline__ void tr_tile(const float* __restrict__ src, int lds_, int k0, int ns0, bf16_t* __restrict__ dst, int ldd, int nd0,
                                        const float* __restrict__ ksc, char* lds) {
  bf16_t* T = (bf16_t*)lds;
  const int tid = tidx();
  __syncthreads();
#pragma unroll
  for (int i = 0; i < 2; ++i) {
    const int kk = (tid >> 3) + 32 * i, nn4 = (tid & 7) * 4;
    const f32x4 v = *(const f32x4*)(src + (size_t)(k0 + kk) * lds_ + ns0 + nn4);
    const float s = ksc ? ksc[k0 + kk] : 1.f;
#pragma unroll
    for (int e = 0; e < 4; ++e) T[(nn4 + e) * 72 + kk] = tobf(v[e] * s);
  }
  __syncthreads();
  const int nn = tid >> 3, kc = (tid & 7) * 8;
  const u32x4 w = *(const u32x4*)(T + nn * 72 + kc);
  *(u32x4*)(dst + (size_t)(nd0 + nn) * ldd + k0 + kc) = w;
}

__device__ __forceinline__ void tr_tile2(const float* __restrict__ src, int lds_, int k0, int ns0, bf16_t* __restrict__ dst, int ldd, int nd0,
                                         const float* __restrict__ ksc, char* lds, unsigned char* dst8 = nullptr, int ld8 = 1024) {
  bf16_t* T = (bf16_t*)lds;
  unsigned char* T8 = (unsigned char*)lds + 8704;
  const int tid = tidx();
  __syncthreads();
  f32x4 v[4];
#pragma unroll
  for (int i = 0; i < 4; ++i) v[i] = *(const GAS f32x4*)(src + (size_t)(k0 + (tid >> 3) + 32 * i) * lds_ + ns0 + (tid & 7) * 4);
#pragma unroll
  for (int i = 0; i < 4; ++i) {
    const int kk = (tid >> 3) + 32 * i, nn4 = (tid & 7) * 4;
    const float sc = ksc ? ksc[k0 + kk] : 1.f;
#pragma unroll
    for (int e = 0; e < 4; ++e) T[(nn4 + e) * 136 + kk] = tobf(v[i][e] * sc);
    if (dst8) {
#pragma unroll
      for (int e = 0; e < 4; ++e) T8[(nn4 + e) * 144 + kk] = (unsigned char)(__builtin_amdgcn_cvt_pk_fp8_f32(sat8(v[i][e] * sc * 32.f), 0.f, 0, false) & 0xff);
    }
  }
  __syncthreads();
  const int nn = tid >> 3, kc = (tid & 7) * 16;
  if (dst8) *(u32x4*)(dst8 + (size_t)nn * ld8 + k0 + kc) = *(const u32x4*)(T8 + nn * 144 + kc);
  if (!dst) return;
  const u32x4 w0 = *(const u32x4*)(T + nn * 136 + kc), w1 = *(const u32x4*)(T + nn * 136 + kc + 8);
  bf16_t* d = dst + (size_t)(nd0 + nn) * ldd + k0 + kc;
  *(u32x4*)d = w0; *(u32x4*)(d + 8) = w1;
}

constexpr int P0_GEMV = 192, P0_WIN = 3408, P0_WQ = 144, P0_WKV = 128, P0_WBR = 768, P0_WO = 512, P0_S0 = 256, P0_PAD = 96, P0_TAB = 1105;
constexpr int P0_N = P0_GEMV + P0_WIN + P0_WQ + P0_WKV + P0_WBR + P0_WO + P0_S0 + P0_PAD + P0_TAB;

__device__ __forceinline__ void phase0_item(const Params& p, int j, char* lds) {
  const int tid = tidx();
  char* ws = wsp(p.ws);
  if (j < P0_GEMV) {
    const int l = j / 96, cgi = j % 96;
    float* sv = (float*)lds;
    float* red = (float*)(lds + 20480);
    __syncthreads();
    for (int i = tid; i < 5120; i += 256) { const int v = i >> 10, k = i & 1023; const float x = (v == 0) ? p.c_ctx[k] : p.c[(v - 1) * 1024 + k]; sv[i] = silu_f(x); }
    __syncthreads();
    const int c4 = tid & 7, kg = tid >> 3;
    const float* w = p.w_mod + (size_t)l * 1024 * 3072 + cgi * 32 + c4 * 4;
    f32x4 a0 = {0.f, 0.f, 0.f, 0.f}, a1 = a0, a2 = a0, a3 = a0, a4 = a0;
#pragma unroll 8
    for (int k = kg * 32; k < kg * 32 + 32; ++k) {
      const f32x4 wv = *(const GAS f32x4*)(w + (size_t)k * 3072);
      a0 += wv * sv[k]; a1 += wv * sv[1024 + k]; a2 += wv * sv[2048 + k]; a3 += wv * sv[3072 + k]; a4 += wv * sv[4096 + k];
    }
    *(f32x4*)(red + (kg * 5 + 0) * 32 + c4 * 4) = a0; *(f32x4*)(red + (kg * 5 + 1) * 32 + c4 * 4) = a1; *(f32x4*)(red + (kg * 5 + 2) * 32 + c4 * 4) = a2;
    *(f32x4*)(red + (kg * 5 + 3) * 32 + c4 * 4) = a3; *(f32x4*)(red + (kg * 5 + 4) * 32 + c4 * 4) = a4;
    __syncthreads();
    if (tid < 160) {
      const int v = tid >> 5, c2 = tid & 31;
      float sm = p.b_mod[l * 3072 + cgi * 32 + c2];
#pragma unroll 8
      for (int g = 0; g < 32; ++g) sm += red[(g * 5 + v) * 32 + c2];
      ((float*)(ws + O_MOD))[(l * 5 + v) * 3072 + cgi * 32 + c2] = sm;
    }
    return;
  }
  j -= P0_GEMV;
  if (j < P0_WIN) {
    const int l = j / 1704, r = j % 1704, kt = r / 213, nt = r % 213, c0 = nt * 32;
    const int nd0 = c0 < 2176 ? c0 : (c0 < 2208 ? 3712 + (c0 - 2176) : (c0 < 3744 ? c0 - 32 : c0 + 96));
    const bool only8 = nd0 >= 3840 || (nd0 >= 1536 && nd0 < 1920) || (nd0 >= 2688 && nd0 < 3200);
    tr_tile2(p.w_in + (size_t)l * 1024 * 6816, 6816, kt * 128, c0, only8 ? nullptr : (bf16_t*)(ws + O_WIN) + (size_t)l * 6912 * 1024, 1024, nd0, nullptr, lds,
             nd0 >= 3840 ? (unsigned char*)(ws + O_WG8) + ((size_t)l * 3072 + (nd0 - 3840)) * 1024
             : nd0 < 1024 ? (unsigned char*)(ws + O_WS8) + ((size_t)l * 1920 + nd0) * 1024
             : (nd0 >= 1536 && nd0 < 1920) ? (unsigned char*)(ws + O_WS8) + ((size_t)l * 1920 + 1024 + (nd0 - 1536)) * 1024
             : (nd0 >= 2688 && nd0 < 3200) ? (unsigned char*)(ws + O_WS8) + ((size_t)l * 1920 + 1408 + (nd0 - 2688)) * 1024 : nullptr);
    return;
  }
  j -= P0_WIN;
  if (j < P0_WQ) {
    const int l = j / 72, r = j % 72, kt = r / 24, nt = r % 24;
    tr_tile2(p.w_q_up + (size_t)l * 384 * 768, 768, kt * 128, nt * 32, nullptr, 384, nt * 32, p.q_norm_g + l * 384, lds,
             (unsigned char*)(ws + O_WQ) + ((size_t)l * 768 + nt * 32) * 384, 384);
    return;
  }
  j -= P0_WQ;
  if (j < P0_WKV) {
    const int l = j / 64, r = j % 64, kt = r / 32, nt = r % 32, c0 = nt * 32, h = c0 >> 7, e = c0 & 127;
    const int nd0 = e < 64 ? h * 64 + e : 512 + h * 64 + (e - 64);
    tr_tile2(p.w_kv_up + (size_t)l * 256 * 1024, 1024, kt * 128, c0, nullptr, 256, nd0, nullptr, lds,
             (unsigned char*)(ws + O_WKV) + ((size_t)l * 1024 + nd0) * 256, 256);
    return;
  }
  j -= P0_WKV;
  if (j < P0_WBR) {
    const int mat = j / 128, r = j % 128, kt = r / 32, nt = r % 32;
    tr_tile2(p.w_branch + (size_t)mat * 512 * 1024, 1024, kt * 128, nt * 32, nullptr, 512, nt * 32, nullptr, lds,
             (unsigned char*)(ws + O_WBR) + ((size_t)mat * 1024 + nt * 32) * 512, 512);
    return;
  }
  j -= P0_WBR;
  if (j < P0_WO) {
    const int l = j / 256, r = j % 256, kt = r / 32, nt = r % 32;
    tr_tile2(p.w_out + (size_t)l * 1024 * 1024, 1024, kt * 128, nt * 32, nullptr, 1024, nt * 32, nullptr, lds,
             (unsigned char*)(ws + O_WO) + ((size_t)l * 1024 + nt * 32) * 1024, 1024);
    return;
  }
  j -= P0_WO;
  if (j < P0_S0) {
    const int mat = j >> 2, nt = j & 3;
    tr_tile(p.state_ret + (size_t)mat * 64 * 128, 128, 0, nt * 32, (bf16_t*)(ws + O_S0T) + (size_t)mat * 128 * 64, 64, nt * 32, nullptr, lds);
    return;
  }
  j -= P0_S0;
  if (j < P0_PAD) {
    const int l = j / 48, r = j % 48;
    bf16_t* d = (bf16_t*)(ws + O_WIN) + ((size_t)l * 6912 + 3744) * 1024 + (size_t)r * 2048 + tid * 8;
    *(u32x4*)d = (u32x4){0u, 0u, 0u, 0u};
    return;
  }
  j -= P0_PAD;
  {
    float v[8];
    bf16_t* dst = nullptr; unsigned char* dst8 = nullptr;
    if (j == 1104) {
      float* rt = (float*)(ws + O_ROPE);
#pragma unroll
      for (int q = 0; q < 2; ++q) {
        const int idx = tid * 2 + q, pos = idx >> 3, f = idx & 7;
        const float ang = (float)pos * exp2f(-(float)f * 1.66096404744f);
        rt[idx * 2] = cosf(ang); rt[idx * 2 + 1] = sinf(ang);
      }
      return;
    }
    if (j < 16) {
      const int e0 = j * 2048 + tid * 8; dst = (bf16_t*)(ws + O_CS) + e0;
      const int n = e0 >> 7, k = e0 & 127;
#pragma unroll
      for (int e = 0; e < 8; ++e) {
        const float fr = (float)(((n & 127) * (k + e)) & 127) * (1.f / 128.f);
        v[e] = (n < 128) ? __builtin_amdgcn_cosf(fr) : __builtin_amdgcn_sinf(fr);
      }
    } else if (j < 80) {
      const int e0 = (j - 16) * 2048 + tid * 8; dst8 = (unsigned char*)(ws + O_D256) + e0;
      const int k1 = e0 >> 9, kk = e0 & 511;
#pragma unroll
      for (int e = 0; e < 8; ++e) {
        const int t = (kk + e) & 255;
        const float fr = (float)((k1 * t) & 255) * (1.f / 256.f);
        v[e] = (kk < 256) ? __builtin_amdgcn_cosf(fr) : -__builtin_amdgcn_sinf(fr);
      }
    } else {
      const int e0 = (j - 80) * 2048 + tid * 8; dst8 = (unsigned char*)(ws + O_D1024) + e0;
      const int k1 = e0 >> 11, kk = e0 & 2047;
#pragma unroll
      for (int e = 0; e < 8; ++e) {
        const int t = (kk + e) & 1023;
        const float fr = (float)((k1 * t) & 1023) * (1.f / 1024.f);
        v[e] = (kk < 1024) ? __builtin_amdgcn_cosf(fr) : -__builtin_amdgcn_sinf(fr);
      }
    }
    if (dst8) {
      u32x2 w8; w8.x = pk4f8(v[0] * 64.f, v[1] * 64.f, v[2] * 64.f, v[3] * 64.f); w8.y = pk4f8(v[4] * 64.f, v[5] * 64.f, v[6] * 64.f, v[7] * 64.f);
      *(u32x2*)dst8 = w8;
    } else {
      u32x4 w; w.x = pk2(v[0], v[1]); w.y = pk2(v[2], v[3]); w.z = pk2(v[4], v[5]); w.w = pk2(v[6], v[7]);
      *(u32x4*)dst = w;
    }
  }
}

__device__ __forceinline__ void norm_item(const Params& p, int l, int item, const float* xp, const float* xs) {
  const int tid = tidx(), lane = tid & 63, wid = tid >> 6;
  bf16_t* H = (bf16_t*)(p.ws + O_H);
#pragma unroll 3
  for (int i = 0; i < 6; ++i) {
    const int row = item * 24 + wid * 6 + i;
    const float* src = row < NPR ? xp + (size_t)row * 1024 : xs + (size_t)(row - NPR) * 1024;
    const int v = row < NPR ? 0 : 1 + ((row - NPR) >> 10);
    const float* mod = (const float*)(p.ws + O_MOD) + (l * 5 + v) * 3072;
    f32x4 x[4]; float ss = 0.f;
#pragma unroll
    for (int q = 0; q < 4; ++q) { x[q] = *(const f32x4*)(src + (q * 64 + lane) * 4); ss += x[q][0] * x[q][0] + x[q][1] * x[q][1] + x[q][2] * x[q][2] + x[q][3] * x[q][3]; }
    ss = wave_sum(ss);
    const float rstd = rsqrtf(ss * (1.f / 1024.f) + EPSN);
#pragma unroll
    for (int q = 0; q < 4; ++q) {
      const int col = (q * 64 + lane) * 4;
      const f32x4 g = *(const f32x4*)(p.norm_g + l * 1024 + col), sc = *(const f32x4*)(mod + 1024 + col), sh = *(const f32x4*)(mod + col);
      f32x4 h;
#pragma unroll
      for (int e = 0; e < 4; ++e) h[e] = x[q][e] * rstd * g[e] * (1.f + sc[e]) + sh[e];
      *(u32x2*)(H + (size_t)row * 1024 + col) = pk4(h);
      *(unsigned*)(p.ws + O_H8 + (size_t)row * 1024 + col) = pk4f8(h[0], h[1], h[2], h[3]);
    }
  }
}
__device__ __forceinline__ void final_item(const Params& p, int item) {
  const int tid = tidx(), lane = tid & 63, wid = tid >> 6;
#pragma unroll 3
  for (int i = 0; i < 6; ++i) {
    const int row = item * 24 + wid * 6 + i;
    float* src = p.out + (size_t)row * 1024;
    f32x4 x[4]; float ss = 0.f;
#pragma unroll
    for (int q = 0; q < 4; ++q) { x[q] = *(const f32x4*)(src + (q * 64 + lane) * 4); ss += x[q][0] * x[q][0] + x[q][1] * x[q][1] + x[q][2] * x[q][2] + x[q][3] * x[q][3]; }
    ss = wave_sum(ss);
    const float rstd = rsqrtf(ss * (1.f / 1024.f) + EPSN);
#pragma unroll
    for (int q = 0; q < 4; ++q) {
      const int col = (q * 64 + lane) * 4;
      const f32x4 g = *(const f32x4*)(p.final_g + col);
      f32x4 y;
#pragma unroll
      for (int e = 0; e < 4; ++e) y[e] = x[q][e] * rstd * g[e];
      *(f32x4*)(src + col) = y;
    }
  }
}

__device__ __forceinline__ void s2_tile(const Params& p, int l, int tile, char* lds) {
  const int tid = tidx(), lane = tid & 63, wid = tid >> 6, wm = wid >> 1, wn = wid & 1, fr = lane & 15, fq = lane >> 4;
  const int m = (tile / 480) * 16 + (tile % 16), nt = (tile % 480) / 16, m0 = m * 128, n0 = nt * 128;
  char* ws = wsp(p.ws);
  const bf16_t* A = (const bf16_t*)(ws + O_H) + (size_t)m0 * 1024;
  const bf16_t* B = (const bf16_t*)(ws + O_WIN) + ((size_t)l * 6912 + n0) * 1024;
  const bool f8 = (nt >= 12 && nt < 15) || (nt >= 21 && nt < 25);
  const int row8 = nt < 8 ? nt * 128 : (nt < 15 ? 1024 + (nt - 12) * 128 : 1408 + (nt - 21) * 128);
  const char* A8 = (const char*)(ws + O_H8) + (size_t)m0 * 1024;
  const char* B8 = (const char*)(ws + O_WS8) + ((size_t)l * 1920 + row8) * 1024;
  const float s8 = f8 ? 0.03125f : 1.f;
  f32x4 acc[4][4];
  zero_acc(acc);
  if (nt >= 4 && nt < 8) {
    gemm_core<false>(A, 1024, B, 1024, 1024, acc, lds);
    bf16_t* RVT = (bf16_t*)(ws + O_RVT);
#pragma unroll
    for (int i = 0; i < 4; ++i) {
      const int tok = m0 + wm * 64 + i * 16 + fq * 4;
      size_t base; int T, b, t;
      if (tok < NPR) { b = tok >> 8; t = tok & 255; T = 256; base = 0; } else { const int s = tok - NPR; b = s >> 10; t = s & 1023; T = 1024; base = (size_t)NPR * 512; }
#pragma unroll
      for (int j = 0; j < 4; ++j) {
        const int c = n0 - 512 + wn * 64 + j * 16 + fr, h = c >> 7, vd = c & 127;
        *(u32x2*)(RVT + base + ((size_t)(b * 4 + h) * 128 + vd) * T + t) = pk4(acc[i][j]);
      }
    }
    return;
  }
  if (f8) { int par = 0; gemm_bytes<true, 4, 1, true>(A8, 1024, B8, 1024, 1024, acc, lds, par, false, nullptr, 0, nullptr, 0); }
  else gemm_core<true>(A, 1024, B, 1024, 1024, acc, lds);
  bf16_t* dst = nullptr; int ld = 0, c0 = 0, op = 0;
  if (nt < 2) { dst = (bf16_t*)(ws + O_RQ); ld = 256; c0 = 0; }
  else if (nt < 4) { dst = (bf16_t*)(ws + O_RK); ld = 256; c0 = 256; op = 2; }
  else if (nt < 12) { dst = (bf16_t*)(ws + O_RZ); ld = 512; c0 = 1024; op = 1; }
  else if (nt < 15) { ld = 384; c0 = 1536; op = 5; }
  else if (nt < 17) { ld = 256; c0 = 1920; op = 3; }
  else if (nt < 21) { dst = (bf16_t*)(ws + O_MZ); ld = 512; c0 = 2176; op = 1; }
  else if (nt < 25) { dst = (bf16_t*)(ws + O_FU); ld = 512; c0 = 2688; }
  else if (nt < 29) { dst = (bf16_t*)(ws + O_FZ); ld = 512; c0 = 3200; op = 1; }
  else { ld = 32; c0 = 3712; op = 4; }
#pragma unroll
  for (int i = 0; i < 4; ++i) {
    const int tok = m0 + wm * 64 + i * 16 + fr;
#pragma unroll
    for (int j = 0; j < 4; ++j) {
      const int col = n0 - c0 + wn * 64 + j * 16 + fq * 4;
      f32x4 v = acc[i][j] * s8;
      if (op == 3) { *(f32x4*)((float*)(ws + O_KVLAT) + (size_t)tok * 256 + col) = v; continue; }
      if (op == 5) { *(unsigned*)(ws + O_QLAT + (size_t)tok * 384 + col) = pk4f8(v[0] * 8.f, v[1] * 8.f, v[2] * 8.f, v[3] * 8.f); continue; }
      if (op == 4) { if (col < 32) *(f32x4*)((float*)(ws + O_KR) + (size_t)tok * 32 + col) = v; continue; }
      if (op == 1) {
#pragma unroll
        for (int e = 0; e < 4; ++e) v[e] = silu_f(v[e]);
      } else if (op == 2) {
#pragma unroll
        for (int e = 0; e < 4; ++e) v[e] *= 0.125f;
      }
      const u32x2 w = pk4(v);
      *(u32x2*)(dst + (size_t)tok * ld + col) = w;
      if (op == 2 && tok < NPR) {
        bf16_t* RKT = (bf16_t*)(ws + O_RKT);
        const int b = tok >> 8, t = tok & 255, h = col >> 6, dk = col & 63;
        bf16_t* q = RKT + ((size_t)(b * 4 + h) * 64 + dk) * 256 + t;
        q[0] = (bf16_t)(w.x & 0xffffu); q[256] = (bf16_t)(w.x >> 16); q[512] = (bf16_t)(w.y & 0xffffu); q[768] = (bf16_t)(w.y >> 16);
      }
    }
  }
}

template <int MODE>
__device__ __forceinline__ void attn_item(const Params& p, int l, int item, char* lds) {
  constexpr int NKP = MODE == 0 ? 3 : 2;
  constexpr int NVB = MODE == 0 ? 4 : 8;
  constexpr int PV = NVB * 16 * 64;
  constexpr int KOFF = NKP * 4096;
  constexpr int BUF = KOFF + 2 * PV;
  const int tid = tidx(), lane = tid & 63, wid = tid >> 6, fr = lane & 15, fq = lane >> 4;
  char* ws = wsp(p.ws);
  int smp, b, h, qblk, T, Tk, tok0;
  const bf16_t *kbase, *rbase = nullptr, *vbase, *qbase;
  int kstride, qstride;
  if (MODE == 0) {
    if (item < 256) { smp = 1; b = item >> 6; h = (item >> 3) & 7; qblk = item & 7; T = 1024; Tk = 1536; tok0 = NPR + b * 1024 + qblk * 128; }
    else { const int it = item - 256; smp = 0; b = it >> 4; h = (it >> 1) & 7; qblk = it & 1; T = 256; Tk = 256; tok0 = b * 256 + qblk * 128; }
    const int keyrow0 = smp ? NPR + b * 1536 : b * 256;
    kbase = (const bf16_t*)(ws + O_KB) + (size_t)keyrow0 * 512 + h * 64; kstride = 512;
    rbase = (const bf16_t*)(ws + O_KRA) + (size_t)keyrow0 * 32;
    vbase = (const bf16_t*)(ws + O_VT) + (smp ? (size_t)NPR * 512 + (size_t)(b * 8 + h) * 64 * 1536 : (size_t)(b * 8 + h) * 64 * 256);
    qbase = (const bf16_t*)(ws + O_QB) + (size_t)tok0 * 768 + h * 96; qstride = 768;
  } else {
    if (item < 128) { smp = 1; b = item >> 5; h = (item >> 3) & 3; qblk = item & 7; T = 1024; tok0 = NPR + b * 1024 + qblk * 128; }
    else { const int it = item - 128; smp = 0; b = it >> 3; h = (it >> 1) & 3; qblk = it & 1; T = 256; tok0 = b * 256 + qblk * 128; }
    Tk = T;
    const int ktok0 = smp ? NPR + b * 1024 : b * 256;
    kbase = (const bf16_t*)(ws + O_RK) + (size_t)ktok0 * 256 + h * 64; kstride = 256;
    vbase = (const bf16_t*)(ws + O_RVT) + (smp ? (size_t)NPR * 512 + (size_t)(b * 4 + h) * 128 * 1024 : (size_t)(b * 4 + h) * 128 * 256);
    qbase = (const bf16_t*)(ws + O_RQ) + (size_t)tok0 * 256 + h * 64; qstride = 256;
  }
  const int nkt = Tk >> 6;
  bf16x8 qf[2][NKP];
#pragma unroll
  for (int qb = 0; qb < 2; ++qb)
#pragma unroll
    for (int ks = 0; ks < NKP; ++ks) qf[qb][ks] = *(const bf16x8*)(qbase + (size_t)(wid * 32 + qb * 16 + fr) * qstride + ks * 32 + fq * 8);
  f32x4 o[NVB][2];
#pragma unroll
  for (int vb = 0; vb < NVB; ++vb) { o[vb][0] = (f32x4){0.f, 0.f, 0.f, 0.f}; o[vb][1] = (f32x4){0.f, 0.f, 0.f, 0.f}; }
  float lgf = 0.f, lgb = 0.f;
  float mrow[2] = {-INFINITY, -INFINITY}, lrow[2] = {0.f, 0.f};
  const int tq0 = qblk * 128 + wid * 32 + fr;
  if (MODE == 1) {
    const float xf = p.ret_logit[(l * 2 + 0) * 4 + h], xb = p.ret_logit[(l * 2 + 1) * 4 + h];
    lgf = -log1pf(expf(-xf)) * 1.44269504089f; lgb = -log1pf(expf(-xb)) * 1.44269504089f;
    if (smp) {
      const bf16_t* s0 = (const bf16_t*)(ws + O_S0T);
#pragma unroll
      for (int dir = 0; dir < 2; ++dir) {
        const bf16_t* sb = s0 + ((size_t)(((b * 2 + l) * 2 + dir) * 4 + h) * 128) * 64;
        float dec[2];
#pragma unroll
        for (int qb = 0; qb < 2; ++qb) { const int tq = tq0 + qb * 16; dec[qb] = dir == 0 ? ex2((float)(tq + 1) * lgf) : ex2((float)(T - tq) * lgb); }
#pragma unroll
        for (int vb = 0; vb < NVB; ++vb) {
          f32x4 t0 = (f32x4){0.f, 0.f, 0.f, 0.f}, t1 = (f32x4){0.f, 0.f, 0.f, 0.f};
#pragma unroll
          for (int ks = 0; ks < 2; ++ks) {
            const bf16x8 sf = *(const bf16x8*)(sb + (size_t)(vb * 16 + fr) * 64 + ks * 32 + fq * 8);
            t0 = mfma16(sf, qf[0][ks], t0); t1 = mfma16(sf, qf[1][ks], t1);
          }
          o[vb][0] += t0 * dec[0]; o[vb][1] += t1 * dec[1];
        }
      }
    }
  }
  u32x4 vreg[NVB / 2];
  const int uw = __builtin_amdgcn_readfirstlane(wid);
  const int dkey = lane >> 2, dchunk = (lane & 3) ^ swz(dkey);
  auto kdma = [&](int kt, char* buf) {
    const GAS bf16_t* kp = (const GAS bf16_t*)kbase + (size_t)(kt * 64 + uw * 16 + dkey) * kstride + dchunk * 8;
#pragma unroll
    for (int pn = 0; pn < 2; ++pn)
      __builtin_amdgcn_global_load_lds((const GAS unsigned*)(kp + pn * 32), (LAS unsigned*)((LAS char*)buf + pn * 4096 + uw * 1024), 16, 0, 0);
    if (MODE == 0) {
      const GAS bf16_t* rp = (const GAS bf16_t*)rbase + (size_t)(kt * 64 + uw * 16 + dkey) * 32 + dchunk * 8;
      __builtin_amdgcn_global_load_lds((const GAS unsigned*)rp, (LAS unsigned*)((LAS char*)buf + 2 * 4096 + uw * 1024), 16, 0, 0);
    }
  };
  auto gload = [&](int kt) {
#pragma unroll
    for (int i = 0; i < NVB / 2; ++i) { const int idx = tid + 256 * i, vd = idx >> 3, g = idx & 7; vreg[i] = ldg16(vbase + (size_t)vd * Tk + kt * 64 + g * 8); }
  };
  auto lstore = [&](char* buf) {
#pragma unroll
    for (int i = 0; i < NVB / 2; ++i) {
      const int idx = tid + 256 * i, vd = idx >> 3, g = idx & 7, pnl = g >> 2, g4 = g & 3, hi = g4 >> 1, q0 = 2 * (g4 & 1);
      char* base = buf + KOFF + pnl * PV + vd * 64 + hi * 8;
      *(u32x2*)(base + ((q0 ^ swz(vd)) << 4)) = (u32x2){vreg[i].x, vreg[i].y};
      *(u32x2*)(base + (((q0 + 1) ^ swz(vd)) << 4)) = (u32x2){vreg[i].z, vreg[i].w};
    }
  };
  __syncthreads();
  kdma(0, lds); gload(0); lstore(lds);
  asm volatile("s_waitcnt vmcnt(0)" ::: "memory");
  __syncthreads();
  const int foff = fr * 64 + ((fq ^ swz(fr)) << 4);
  for (int kt = 0; kt < nkt; ++kt) {
    char* cur = lds + (kt & 1) * BUF;
    const bool more = (kt + 1) < nkt;
    if (more) { kdma(kt + 1, lds + ((kt + 1) & 1) * BUF); gload(kt + 1); }
    __builtin_amdgcn_sched_barrier(0);
    f32x4 s[4][2];
#pragma unroll
    for (int kb = 0; kb < 4; ++kb) {
      s[kb][0] = (f32x4){0.f, 0.f, 0.f, 0.f}; s[kb][1] = (f32x4){0.f, 0.f, 0.f, 0.f};
#pragma unroll
      for (int ks = 0; ks < NKP; ++ks) {
        const bf16x8 kf = *(const bf16x8*)(cur + ks * 4096 + kb * 1024 + foff);
        s[kb][0] = mfma16(kf, qf[0][ks], s[kb][0]); s[kb][1] = mfma16(kf, qf[1][ks], s[kb][1]);
      }
    }
    bf16x8 pf[2][2];
#pragma unroll
    for (int qb = 0; qb < 2; ++qb) {
      if (MODE == 0) {
        float mx = s[0][qb][0];
#pragma unroll
        for (int kb = 0; kb < 4; ++kb)
#pragma unroll
          for (int r = 0; r < 4; ++r) mx = fmaxf(mx, s[kb][qb][r]);
        mx = fmaxf(mx, __shfl_xor(mx, 16)); mx = fmaxf(mx, __shfl_xor(mx, 32));
        const float mn = fmaxf(mrow[qb], mx), alpha = ex2(mrow[qb] - mn);
        mrow[qb] = mn;
        float ls = 0.f;
#pragma unroll
        for (int kb = 0; kb < 4; ++kb)
#pragma unroll
          for (int r = 0; r < 4; ++r) { const float e = ex2(s[kb][qb][r] - mn); s[kb][qb][r] = e; ls += e; }
        lrow[qb] = lrow[qb] * alpha + ls;
#pragma unroll
        for (int vb = 0; vb < NVB; ++vb) o[vb][qb] *= alpha;
      } else {
        const int tq = tq0 + qb * 16;
#pragma unroll
        for (int kb = 0; kb < 4; ++kb)
#pragma unroll
          for (int r = 0; r < 4; ++r) {
            const int d = tq - (kt * 64 + kb * 16 + fq * 4 + r);
            const float dec = d > 0 ? ex2((float)d * lgf) : (d < 0 ? ex2((float)(-d) * lgb) : 2.f);
            s[kb][qb][r] *= dec;
          }
      }
#pragma unroll
      for (int g = 0; g < 2; ++g) {
        u32x4 w; w.x = pk2(s[2 * g][qb][0], s[2 * g][qb][1]); w.y = pk2(s[2 * g][qb][2], s[2 * g][qb][3]);
        w.z = pk2(s[2 * g + 1][qb][0], s[2 * g + 1][qb][1]); w.w = pk2(s[2 * g + 1][qb][2], s[2 * g + 1][qb][3]);
        pf[qb][g] = as_bf8(w);
      }
    }
#pragma unroll
    for (int vb = 0; vb < NVB; ++vb)
#pragma unroll
      for (int g = 0; g < 2; ++g) {
        const bf16x8 vf = *(const bf16x8*)(cur + KOFF + g * PV + vb * 1024 + foff);
        o[vb][0] = mfma16(vf, pf[0][g], o[vb][0]); o[vb][1] = mfma16(vf, pf[1][g], o[vb][1]);
      }
    __builtin_amdgcn_sched_barrier(0);
    if (more) lstore(lds + ((kt + 1) & 1) * BUF);
    asm volatile("s_waitcnt vmcnt(0)" ::: "memory");
    __syncthreads();
  }
  bf16_t* G = (bf16_t*)(ws + (MODE == 0 ? O_MZ : O_RZ));
#pragma unroll
  for (int qb = 0; qb < 2; ++qb) {
    const int tok = tok0 + wid * 32 + qb * 16 + fr;
    float mul, sub;
    if (MODE == 0) {
      float lt = lrow[qb]; lt += __shfl_xor(lt, 16); lt += __shfl_xor(lt, 32);
      mul = 1.f / lt; sub = 0.f;
    } else {
      float sm = 0.f;
#pragma unroll
      for (int vb = 0; vb < NVB; ++vb) sm += (o[vb][qb][0] + o[vb][qb][1]) + (o[vb][qb][2] + o[vb][qb][3]);
      sm += __shfl_xor(sm, 16); sm += __shfl_xor(sm, 32);
      const float mu = sm * (1.f / 128.f);
      float vs = 0.f;
#pragma unroll
      for (int vb = 0; vb < NVB; ++vb)
#pragma unroll
        for (int r = 0; r < 4; ++r) { const float dd = o[vb][qb][r] - mu; vs += dd * dd; }
      vs += __shfl_xor(vs, 16); vs += __shfl_xor(vs, 32);
      mul = rsqrtf(vs * (1.f / 128.f) + EPSN); sub = mu;
    }
#pragma unroll
    for (int vb = 0; vb < NVB; ++vb) {
      bf16_t* gp = G + (size_t)tok * 512 + h * (NVB * 16) + vb * 16 + fq * 4;
      const u32x2 gz = *(const u32x2*)gp;
      f32x4 y;
      y[0] = (o[vb][qb][0] - sub) * mul * bflo(gz.x); y[1] = (o[vb][qb][1] - sub) * mul * bfhi(gz.x);
      y[2] = (o[vb][qb][2] - sub) * mul * bflo(gz.y); y[3] = (o[vb][qb][3] - sub) * mul * bfhi(gz.y);
      *(unsigned*)(ws + O_BR8 + (size_t)(MODE == 0 ? 1 : 0) * NTOK * 512 + (size_t)tok * 512 + h * (NVB * 16) + vb * 16 + fq * 4) = pk4f8(y[0] * 8.f, y[1] * 8.f, y[2] * 8.f, y[3] * 8.f);
    }
  }
}

__device__ __forceinline__ bf16x8 scale8(u32x4 raw, const float (&d)[8]) {
  u32x4 w;
  w.x = pk2(bflo(raw.x) * d[0], bfhi(raw.x) * d[1]); w.y = pk2(bflo(raw.y) * d[2], bfhi(raw.y) * d[3]);
  w.z = pk2(bflo(raw.z) * d[4], bfhi(raw.z) * d[5]); w.w = pk2(bflo(raw.w) * d[6], bfhi(raw.w) * d[7]);
  return as_bf8(w);
}
__device__ __forceinline__ void state_item(const Params& p, int l, int item) {
  const int tid = tidx(), lane = tid & 63, wid = tid >> 6, fr = lane & 15, fq = lane >> 4;
  const int b = item >> 2, h = item & 3;
  const bf16_t* RVT = (const bf16_t*)(p.ws + O_RVT) + (size_t)(b * 4 + h) * 128 * 256;
  const bf16_t* RKT = (const bf16_t*)(p.ws + O_RKT) + (size_t)(b * 4 + h) * 64 * 256;
  const float xf = p.ret_logit[(l * 2 + 0) * 4 + h], xb = p.ret_logit[(l * 2 + 1) * 4 + h];
  const float lgf = -log1pf(expf(-xf)) * 1.44269504089f, lgb = -log1pf(expf(-xb)) * 1.44269504089f;
  f32x4 acc[2][2][4];
#pragma unroll
  for (int d = 0; d < 2; ++d)
#pragma unroll
    for (int v = 0; v < 2; ++v)
#pragma unroll
      for (int k = 0; k < 4; ++k) acc[d][v][k] = (f32x4){0.f, 0.f, 0.f, 0.f};
#pragma unroll 2
  for (int ks = 0; ks < 8; ++ks) {
    const int j0 = ks * 32 + fq * 8;
    float df[8], db[8];
#pragma unroll
    for (int e = 0; e < 8; ++e) { df[e] = exp2f((float)(255 - j0 - e) * lgf); db[e] = exp2f((float)(j0 + e) * lgb); }
    bf16x8 af[2];
#pragma unroll
    for (int v = 0; v < 2; ++v) af[v] = *(const bf16x8*)(RVT + (size_t)((wid * 2 + v) * 16 + fr) * 256 + j0);
#pragma unroll
    for (int k = 0; k < 4; ++k) {
      const u32x4 raw = *(const u32x4*)(RKT + (size_t)(k * 16 + fr) * 256 + j0);
      const bf16x8 kf = scale8(raw, df), kb = scale8(raw, db);
#pragma unroll
      for (int v = 0; v < 2; ++v) { acc[0][v][k] = mfma16(af[v], kf, acc[0][v][k]); acc[1][v][k] = mfma16(af[v], kb, acc[1][v][k]); }
    }
  }
  float* O = p.out + OUT_RET;
#pragma unroll
  for (int d = 0; d < 2; ++d)
#pragma unroll
    for (int v = 0; v < 2; ++v)
#pragma unroll
      for (int k = 0; k < 4; ++k) {
        const int dk = k * 16 + fr, vd = (wid * 2 + v) * 16 + fq * 4;
        *(f32x4*)(O + ((size_t)((((b * 2 + l) * 2 + d) * 4 + h) * 64 + dk)) * 128 + vd) = acc[d][v][k];
      }
}

__device__ __forceinline__ void keyprep_item(const Params& p, int l, int item) {
  const int tid = tidx(), lane = tid & 63, wid = tid >> 6;
  char* ws = wsp(p.ws);
  unsigned char* CKVA = (unsigned char*)(ws + O_CKVA);
  bf16_t* KRA = (bf16_t*)(ws + O_KRA);
#pragma unroll
  for (int i = 0; i < 4; ++i) {
    const int R = item * 16 + wid * 4 + i;
    int smp = 0, b, t = 0, tok = 0, ctx = 0, pp = 0;
    if (R < NPR) { tok = R; b = R >> 8; t = R & 255; }
    else { smp = 1; const int s = R - NPR; b = s / 1536; pp = s - b * 1536; if (pp < 512) ctx = 1; else { t = pp - 512; tok = NPR + b * 1024 + t; } }
    if (ctx) {
      const f32x4 v = *(const f32x4*)(p.cache_ckv + ((size_t)((b * 2 + l) * 512 + pp)) * 256 + lane * 4);
      *(unsigned*)(CKVA + (size_t)R * 256 + lane * 4) = pk4f8(v[0] * 4.f, v[1] * 4.f, v[2] * 4.f, v[3] * 4.f);
      if (lane < 32) KRA[(size_t)R * 32 + lane] = tobf(p.cache_krope[((size_t)((b * 2 + l) * 512 + pp)) * 32 + lane]);
      continue;
    }
    const f32x4 v = *(const f32x4*)((const float*)(ws + O_KVLAT) + (size_t)tok * 256 + lane * 4);
    float ss = v[0] * v[0] + v[1] * v[1] + v[2] * v[2] + v[3] * v[3];
    ss = wave_sum(ss);
    const float rstd = rsqrtf(ss * (1.f / 256.f) + EPSN);
    const f32x4 g = *(const f32x4*)(p.kv_norm_g + l * 256 + lane * 4);
    f32x4 y;
#pragma unroll
    for (int e = 0; e < 4; ++e) y[e] = v[e] * rstd * g[e];
    *(unsigned*)(CKVA + (size_t)R * 256 + lane * 4) = pk4f8(y[0] * 4.f, y[1] * 4.f, y[2] * 4.f, y[3] * 4.f);
    if (!smp) *(f32x4*)(p.out + OUT_CKV + ((size_t)((b * 2 + l) * 256 + t)) * 256 + lane * 4) = y;
    const int d = lane & 31;
    const float x = ((const float*)(ws + O_KR))[(size_t)tok * 32 + d];
    float yk = x;
    if (smp) {
      const float pr = __shfl_xor(x, 8);
      const int hd = d >> 4, i16 = d & 15, f = i16 & 7;
      const int pos = hd ? (t & 63) : (t >> 6);
      const float* rt = (const float*)(ws + O_ROPE) + (pos * 8 + f) * 2;
      const float cs = rt[0], sn = rt[1];
      yk = i16 < 8 ? x * cs - pr * sn : pr * sn + x * cs;
    } else if (lane < 32) {
      p.out[OUT_KR + ((size_t)((b * 2 + l) * 256 + t)) * 32 + d] = x;
    }
    if (lane < 32) KRA[(size_t)R * 32 + d] = tobf(yk);
  }
}

__device__ __forceinline__ void f1_tile(const Params& p, int tile, char* lds) {
  const int tid = tidx(), lane = tid & 63, wid = tid >> 6, wm = wid >> 1, wn = wid & 1, fr = lane & 15, fq = lane >> 4;
  const int m = tile >> 3, g = (tile >> 1) & 3, nh = tile & 1, m0 = m * 128;
  char* ws = wsp(p.ws);
  f32x4 acc[4][4];
  zero_acc(acc);
  gemm_core<false>((const bf16_t*)(ws + O_FU) + (size_t)m0 * 512 + g * 128, 512, (const bf16_t*)(ws + O_CS) + (size_t)nh * 128 * 128, 128, 128, acc, lds);
  unsigned char* UT = (unsigned char*)(ws + O_UT);
#pragma unroll
  for (int i = 0; i < 4; ++i) {
    const int tok = m0 + wm * 64 + i * 16 + fq * 4;
    size_t base; int T, b, t;
    if (tok < NPR) { b = tok >> 8; t = tok & 255; T = 256; base = 0; } else { const int s = tok - NPR; b = s >> 10; t = s & 1023; T = 1024; base = (size_t)NPR * 1024; }
#pragma unroll
    for (int j = 0; j < 4; ++j) {
      const int k2 = wn * 64 + j * 16 + fr;
      *(unsigned*)(UT + base + ((size_t)(b * 4 + g) * 128 + k2) * (2 * T) + nh * T + t) = pk4f8(acc[i][j][0] * 4.f, acc[i][j][1] * 4.f, acc[i][j][2] * 4.f, acc[i][j][3] * 4.f);
    }
  }
}

__device__ __forceinline__ void qup_tile(const Params& p, int l, int tile, char* lds) {
  const int tid = tidx(), lane = tid & 63, wid = tid >> 6, wm = wid >> 1, wn = wid & 1, fr = lane & 15, fq = lane >> 4;
  const int m = tile % 96, nt = tile / 96, m0 = m * 128, n0 = nt * 128;
  char* ws = wsp(p.ws);
  const char* QL = (const char*)(ws + O_QLAT) + (size_t)m0 * 384;
  float rsv4[4];
  {
    float* rs = (float*)lds;
    __syncthreads();
#pragma unroll 1
    for (int r0 = 0; r0 < 32; r0 += 4) {
      float ss[4];
#pragma unroll
      for (int u = 0; u < 4; ++u) {
        u32x4 w = (u32x4){0u, 0u, 0u, 0u};
        if (lane < 24) w = ldg16(QL + (size_t)(wid * 32 + r0 + u) * 384 + lane * 16);
        float a = 0.f;
#pragma unroll
        for (int q = 0; q < 4; ++q) {
          const float f0 = __builtin_amdgcn_cvt_f32_fp8(w[q], 0), f1 = __builtin_amdgcn_cvt_f32_fp8(w[q], 1), f2 = __builtin_amdgcn_cvt_f32_fp8(w[q], 2), f3 = __builtin_amdgcn_cvt_f32_fp8(w[q], 3);
          a += f0 * f0 + f1 * f1 + f2 * f2 + f3 * f3;
        }
        ss[u] = a;
      }
#pragma unroll
      for (int u = 0; u < 4; ++u) { const float t = wave_sum(ss[u]); if (lane == 0) rs[wid * 32 + r0 + u] = rsqrtf(t * (1.f / (384.f * 64.f)) + EPSN); }
    }
    __syncthreads();
#pragma unroll
    for (int i = 0; i < 4; ++i) rsv4[i] = rs[wm * 64 + i * 16 + fr];
    __syncthreads();
  }
  f32x4 acc[4][4];
  zero_acc(acc);
  { int par = 0; gemm_bytes<true, 4, 1, true>(QL, 384, (const char*)(ws + O_WQ) + ((size_t)l * 768 + n0) * 384, 384, 384, acc, lds, par, false, nullptr, 0, nullptr, 0); }
  bf16_t* QB = (bf16_t*)(ws + O_QB);
  const float qscale = 0.10206207261596577f * 1.44269504089f * (1.f / 256.f);
#pragma unroll
  for (int i = 0; i < 4; ++i) {
    const int rl = wm * 64 + i * 16 + fr, tok = m0 + rl;
    const float sc = rsv4[i] * qscale;
    const int smp = tok >= NPR, t = (tok - NPR) & 1023;
#pragma unroll
    for (int j = 0; j < 4; ++j) {
      const int cb = n0 + wn * 64 + j * 16, within = cb % 96;
      f32x4 v = acc[i][j] * sc;
      if (within >= 64) {
        f32x4 pr;
#pragma unroll
        for (int e = 0; e < 4; ++e) pr[e] = __shfl_xor(v[e], 32);
        if (smp) {
          const int pos = within >= 80 ? (t & 63) : (t >> 6);
          const float* rt = (const float*)(ws + O_ROPE) + (pos * 8 + (fq & 1) * 4) * 2;
          const f32x4 c01 = *(const f32x4*)rt, c23 = *(const f32x4*)(rt + 4);
          const float cs4[4] = {c01[0], c01[2], c23[0], c23[2]}, sn4[4] = {c01[1], c01[3], c23[1], c23[3]};
#pragma unroll
          for (int e = 0; e < 4; ++e) v[e] = fq < 2 ? v[e] * cs4[e] - pr[e] * sn4[e] : pr[e] * sn4[e] + v[e] * cs4[e];
        }
      }
      *(u32x2*)(QB + (size_t)tok * 768 + cb + fq * 4) = pk4(v);
    }
  }
}

__device__ __forceinline__ void kvup_tile(const Params& p, int l, int tile, char* lds) {
  const int tid = tidx(), lane = tid & 63, wid = tid >> 6, wm = wid >> 1, wn = wid & 1, fr = lane & 15, fq = lane >> 4;
  const int m = tile % 112, nt = tile / 112, m0 = m * 128, n0 = nt * 128;
  char* ws = wsp(p.ws);
  const char* A = (const char*)(ws + O_CKVA) + (size_t)m0 * 256;
  const char* B = (const char*)(ws + O_WKV) + ((size_t)l * 1024 + n0) * 256;
  const float ks = 1.f / 128.f;
  f32x4 acc[4][4];
  zero_acc(acc);
  if (nt < 4) {
    { int par = 0; gemm_bytes<true, 4, 1, true>(A, 256, B, 256, 256, acc, lds, par, false, nullptr, 0, nullptr, 0); }
    bf16_t* KB = (bf16_t*)(ws + O_KB);
#pragma unroll
    for (int i = 0; i < 4; ++i) {
      const int R = m0 + wm * 64 + i * 16 + fr;
#pragma unroll
      for (int j = 0; j < 4; ++j) *(u32x2*)(KB + (size_t)R * 512 + n0 + wn * 64 + j * 16 + fq * 4) = pk4(acc[i][j] * ks);
    }
  } else {
    { int par = 0; gemm_bytes<false, 4, 1, true>(A, 256, B, 256, 256, acc, lds, par, false, nullptr, 0, nullptr, 0); }
    bf16_t* VT = (bf16_t*)(ws + O_VT);
#pragma unroll
    for (int i = 0; i < 4; ++i) {
      const int R = m0 + wm * 64 + i * 16 + fq * 4;
      size_t base; int Tk, b, k;
      if (R < NPR) { b = R >> 8; k = R & 255; Tk = 256; base = 0; } else { const int s = R - NPR; b = s / 1536; k = s - b * 1536; Tk = 1536; base = (size_t)NPR * 512; }
#pragma unroll
      for (int j = 0; j < 4; ++j) {
        const int c = n0 - 512 + wn * 64 + j * 16 + fr, h = c >> 6, vd = c & 63;
        *(u32x2*)(VT + base + ((size_t)(b * 8 + h) * 64 + vd) * Tk + k) = pk4(acc[i][j] * ks);
      }
    }
  }
}

template <int NJ>
__device__ __forceinline__ void f2_tile(const Params& p, int tile, char* lds) {
  const int tid = tidx(), lane = tid & 63, wid = tid >> 6, wm = wid >> 1, wn = wid & 1, fr = lane & 15, fq = lane >> 4;
  char* ws = wsp(p.ws);
  const char *A, *B; int K, tokb, g, nh = 0; float scale;
  if (NJ == 2) {
    const int b = tile >> 6, mt = (tile >> 1) & 7; g = (tile >> 4) & 3; nh = tile & 1;
    A = (const char*)(ws + O_D1024) + (size_t)mt * 128 * 2048; K = 2048;
    B = (const char*)(ws + O_UT) + (size_t)NPR * 1024 + ((size_t)(b * 4 + g) * 128 + nh * 64) * 2048;
    tokb = NPR + b * 1024 + mt * 128; scale = 0.00276213586400995f * (1.f / 256.f);
  } else {
    const int b = tile >> 3, mt = tile & 1; g = (tile >> 1) & 3;
    A = (const char*)(ws + O_D256) + (size_t)mt * 128 * 512; K = 512;
    B = (const char*)(ws + O_UT) + (size_t)(b * 4 + g) * 128 * 512;
    tokb = b * 256 + mt * 128; scale = 0.0055242717280199f * (1.f / 256.f);
  }
  f32x4 acc[4][NJ];
#pragma unroll
  for (int i = 0; i < 4; ++i)
#pragma unroll
    for (int j = 0; j < NJ; ++j) acc[i][j] = (f32x4){0.f, 0.f, 0.f, 0.f};
  { int par = 0; gemm_bytes<true, NJ, 1, true>(A, K, B, K, K, acc, lds, par, false, nullptr, 0, nullptr, 0); }
  bf16_t* FZ = (bf16_t*)(ws + O_FZ);
#pragma unroll
  for (int i = 0; i < 4; ++i) {
    const int tok = tokb + wm * 64 + i * 16 + fr;
#pragma unroll
    for (int j = 0; j < NJ; ++j) {
      bf16_t* gp = FZ + (size_t)tok * 512 + g * 128 + nh * 64 + wn * (NJ * 16) + j * 16 + fq * 4;
      const u32x2 gz = *(const u32x2*)gp;
      f32x4 y;
      y[0] = acc[i][j][0] * scale * bflo(gz.x); y[1] = acc[i][j][1] * scale * bfhi(gz.x);
      y[2] = acc[i][j][2] * scale * bflo(gz.y); y[3] = acc[i][j][3] * scale * bfhi(gz.y);
      *(unsigned*)(ws + O_BR8 + (size_t)2 * NTOK * 512 + (size_t)tok * 512 + g * 128 + nh * 64 + wn * (NJ * 16) + j * 16 + fq * 4) = pk4f8(y[0] * 8.f, y[1] * 8.f, y[2] * 8.f, y[3] * 8.f);
    }
  }
}

template <int NJ>
__device__ __forceinline__ void s6_tile(const Params& p, int l, int tile, int ntile, char* lds, int& par, bool& primed) {
  const int tid = tidx(), lane = tid & 63, wid = tid >> 6, wm = wid >> 1, wn = wid & 1, fr = lane & 15, fq = lane >> 4;
  constexpr int NT = 32 / NJ, BN = NJ * 32;
  const int m = (tile / (32 * NT)) * 32 + (tile % 32), nt = (tile % (32 * NT)) / 32, m0 = m * 128, n0 = nt * BN;
  char* ws = wsp(p.ws);
  const char* H8 = (const char*)(ws + O_H8);
  const char* W8 = (const char*)(ws + O_WG8) + (size_t)l * 3072 * 1024;
  const char* Wb = (const char*)(ws + O_WBR) + (size_t)(l * 3) * 1024 * 512;
  f32x4 tot[4][NJ], acc[4][NJ];
  unsigned sg[4][NJ];
#pragma unroll
  for (int i = 0; i < 4; ++i)
#pragma unroll
    for (int j = 0; j < NJ; ++j) tot[i][j] = (f32x4){0.f, 0.f, 0.f, 0.f};
#pragma unroll 1
  for (int nb = 0; nb < 3; ++nb) {
    u32x2 totp[4][NJ];
#pragma unroll
    for (int i = 0; i < 4; ++i)
#pragma unroll
      for (int j = 0; j < NJ; ++j) { totp[i][j] = pk4(tot[i][j]); acc[i][j] = (f32x4){0.f, 0.f, 0.f, 0.f}; }
    const char* brA = (const char*)(ws + O_BR8) + ((size_t)nb * NTOK + m0) * 512;
    const char* brB = Wb + ((size_t)nb * 1024 + n0) * 512;
    gemm_bytes<true, NJ, 2, true>(H8 + (size_t)m0 * 1024, 1024, W8 + ((size_t)nb * 1024 + n0) * 1024, 1024, 1024, acc, lds, par, primed, brA, 512, brB, 512);
#pragma unroll
    for (int i = 0; i < 4; ++i)
#pragma unroll
      for (int j = 0; j < NJ; ++j) {
        unsigned q = 0;
#pragma unroll
        for (int e = 0; e < 4; ++e) {
          const unsigned qe = (unsigned)fmaxf(sigm_f(acc[i][j][e] * 0.03125f) * 255.f + 0.5f, 1.f);
          q |= qe << (8 * e);
          tot[i][j][e] = (e == 0 ? bflo(totp[i][j].x) : e == 1 ? bfhi(totp[i][j].x) : e == 2 ? bflo(totp[i][j].y) : bfhi(totp[i][j].y)) * __builtin_amdgcn_rcpf((float)qe * (1.f / 255.f));
        }
        sg[i][j] = q;
      }
    const char *nA = nullptr, *nB = nullptr;
    if (nb < 2) { nA = H8 + (size_t)m0 * 1024; nB = W8 + ((size_t)(nb + 1) * 1024 + n0) * 1024; }
    else if (ntile >= 0) { nA = H8 + (size_t)(((ntile / (32 * NT)) * 32 + (ntile % 32)) * 128) * 1024; nB = W8 + (size_t)(((ntile % (32 * NT)) / 32) * BN) * 1024; }
    gemm_bytes<true, NJ, 2, true>(brA, 512, brB, 512, 512, tot, lds, par, true, nA, 1024, nB, 1024);
    primed = nA != nullptr;
#pragma unroll
    for (int i = 0; i < 4; ++i)
#pragma unroll
      for (int j = 0; j < NJ; ++j) {
        tot[i][j][0] *= (float)(sg[i][j] & 0xffu) * (1.f / 255.f); tot[i][j][1] *= (float)((sg[i][j] >> 8) & 0xffu) * (1.f / 255.f);
        tot[i][j][2] *= (float)((sg[i][j] >> 16) & 0xffu) * (1.f / 255.f); tot[i][j][3] *= (float)(sg[i][j] >> 24) * (1.f / 255.f);
      }
  }
  unsigned char* MG = (unsigned char*)(ws + O_UT);
#pragma unroll
  for (int i = 0; i < 4; ++i) {
    const int tok = m0 + wm * 64 + i * 16 + fr;
#pragma unroll
    for (int j = 0; j < NJ; ++j) *(unsigned*)(MG + (size_t)tok * 1024 + n0 + wn * (NJ * 16) + j * 16 + fq * 4) = pk4f8(tot[i][j][0] * (1.f / 256.f), tot[i][j][1] * (1.f / 256.f), tot[i][j][2] * (1.f / 256.f), tot[i][j][3] * (1.f / 256.f));
  }
}

__device__ __forceinline__ void s7_tile(const Params& p, int l, int tile, const float* xp, const float* xs, char* lds) {
  const int tid = tidx(), lane = tid & 63, wid = tid >> 6, wm = wid >> 1, wn = wid & 1, fr = lane & 15, fq = lane >> 4;
  const int m = (tile / 512) * 32 + (tile % 32), nt = (tile % 512) / 32, m0 = m * 128, n0 = nt * 64;
  char* ws = wsp(p.ws);
  f32x4 acc[4][2];
#pragma unroll
  for (int i = 0; i < 4; ++i) { acc[i][0] = (f32x4){0.f, 0.f, 0.f, 0.f}; acc[i][1] = (f32x4){0.f, 0.f, 0.f, 0.f}; }
  { int par = 0; gemm_bytes<true, 2, 1, true>((const char*)(ws + O_UT) + (size_t)m0 * 1024, 1024, (const char*)(ws + O_WO) + ((size_t)l * 1024 + n0) * 1024, 1024, 1024, acc, lds, par, false, nullptr, 0, nullptr, 0); }
#pragma unroll
  for (int i = 0; i < 4; ++i) {
    const int tok = m0 + wm * 64 + i * 16 + fr;
    const float* src = tok < NPR ? xp + (size_t)tok * 1024 : xs + (size_t)(tok - NPR) * 1024;
    const int v = tok < NPR ? 0 : 1 + ((tok - NPR) >> 10);
    const float* gate = (const float*)(ws + O_MOD) + (l * 5 + v) * 3072 + 2048;
#pragma unroll
    for (int j = 0; j < 2; ++j) {
      const int col = n0 + wn * 32 + j * 16 + fq * 4;
      const f32x4 x = *(const f32x4*)(src + col), gt = *(const f32x4*)(gate + col);
      f32x4 y;
#pragma unroll
      for (int e = 0; e < 4; ++e) y[e] = x[e] + gt[e] * (acc[i][j][e] * 0.03125f);
      *(f32x4*)(p.out + (size_t)tok * 1024 + col) = y;
    }
  }
}

constexpr int NPHASE = 16;
__device__ __forceinline__ int q_issue(unsigned* ctr) {
  int v = 0;
  if (threadIdx.x == 0) v = (int)__hip_atomic_fetch_add(ctr, 1u, __ATOMIC_RELAXED, __HIP_MEMORY_SCOPE_AGENT);
  return v;
}
__device__ __forceinline__ int q_bcast(int v, char* lds) {
  __syncthreads();
  if (threadIdx.x == 0) *(volatile int*)lds = v;
  __syncthreads();
  const int it = *(volatile int*)lds;
  __syncthreads();
  return it;
}
__device__ __forceinline__ void run_phase(const Params& p, int ph, char* lds, unsigned* qctr) {
  const int bid = blockIdx.x, nb = gridDim.x;
  if (ph == 0) { for (int i = bid; i < P0_N; i += nb) phase0_item(p, i, lds); return; }
  if (ph == 15) { for (int i = bid; i < 512; i += nb) final_item(p, i); return; }
  const int l = (ph - 1) / 7, s = (ph - 1) % 7;
  const float* xp = l == 0 ? p.x_prompt : p.out;
  const float* xs = l == 0 ? p.x_sample : p.out + (size_t)NPR * 1024;
  switch (s) {
    case 0: for (int i = bid; i < 512; i += nb) norm_item(p, l, i, xp, xs); break;
    case 1: for (int i = bid; i < 2880; i += nb) s2_tile(p, l, i, lds); break;
    case 2:
      for (int i = bid; i < 2752;) {
        if (i < 128) attn_item<1>(p, l, i, lds);
        else if (i < 1024) keyprep_item(p, l, i - 128);
        else if (i < 1280) attn_item<1>(p, l, 128 + (i - 1024), lds);
        else if (i < 1408) state_item(p, l, i - 1280);
        else if (i < 1984) qup_tile(p, l, i - 1408, lds);
        else f1_tile(p, i - 1984, lds);
        i = nb + q_bcast(q_issue(qctr + ph), lds);
      }
      break;
    case 3:
      for (int i = bid; i < 1408;) {
        if (i < 256) f2_tile<2>(p, i, lds);
        else if (i < 512) f2_tile<4>(p, i - 256, lds);
        else kvup_tile(p, l, i - 512, lds);
        i = nb + q_bcast(q_issue(qctr + ph), lds);
      }
      break;
    case 4:
      for (int i = bid; i < 768;) {
        attn_item<0>(p, l, i, lds);
        i = nb + q_bcast(q_issue(qctr + ph), lds);
      }
      break;
    case 5: { int par = 0; bool primed = false; for (int i = bid; i < 768; i += nb) s6_tile<4>(p, l, i, (i + nb < 768) ? i + nb : -1, lds, par, primed); } break;
    case 6: for (int i = bid; i < 1536; i += nb) s7_tile(p, l, i, xp, xs, lds); break;
  }
}

#define XB_TMO      128
#define XB_XCNT(j)  (256  + 64 * (j))
#define XB_XSUB(j)  (1280 + 64 * (j))
#define XB_XGEN(j)  (2304 + 64 * (j))
#define XB_TOP      3328
#define XB_TOPGEN   3392
#define XCD_BAR_WORDS 3456
#define XB_SPIN_CAP (1u << 18)
__device__ __forceinline__ unsigned xb_ld(unsigned* p)              { return __hip_atomic_load(p, __ATOMIC_RELAXED, __HIP_MEMORY_SCOPE_AGENT); }
__device__ __forceinline__ unsigned xb_add(unsigned* p, unsigned v) { return __hip_atomic_fetch_add(p, v, __ATOMIC_RELAXED, __HIP_MEMORY_SCOPE_AGENT); }
__device__ __forceinline__ unsigned xb_xcc_id() { return (unsigned)__builtin_amdgcn_s_getreg((3 << 11) | 20) & 0xFu; }
#define XB_SPIN(cond, bar) do { unsigned _sp = 0; while (cond) { __builtin_amdgcn_s_sleep(1); \
    if ((++_sp & 255u) == 0u) { if (xb_ld(&(bar)[XB_TMO])) break; if (_sp > XB_SPIN_CAP) { atomicAdd(&(bar)[XB_TMO], 1u); break; } } } } while (0)
__device__ __forceinline__ void xcd_barrier_complete(unsigned* bar, unsigned x, unsigned& nloc, unsigned& nx) {
  const unsigned G = gridDim.x;
  unsigned sum, cnt, mine, sp = 0u;
  for (;;) {
    sum = 0u; cnt = 0u; mine = 0u;
#pragma unroll
    for (unsigned j = 0; j < 16; ++j) { const unsigned c = xb_ld(&bar[XB_XCNT(j)]); sum += c; cnt += (c > 0u) ? 1u : 0u; mine = (j == x) ? c : mine; }
    if (sum == G) break;
    __builtin_amdgcn_s_sleep(1);
    if ((++sp & 255u) == 0u) { if (xb_ld(&bar[XB_TMO])) break; if (sp > XB_SPIN_CAP) { atomicAdd(&bar[XB_TMO], 1u); break; } }
  }
  nloc = mine > 0u ? mine : 1u; nx = cnt > 0u ? cnt : 1u;
}
__device__ __forceinline__ void xcd_barrier(unsigned* bar, unsigned x, unsigned& nloc, unsigned& nx) {
  asm volatile("s_waitcnt vmcnt(0)" ::: "memory");
  __syncthreads();
  if (threadIdx.x == 0) {
    __builtin_amdgcn_s_waitcnt(0);
    if (nloc == 0u) xcd_barrier_complete(bar, x, nloc, nx);
    const unsigned old = xb_add(&bar[XB_XSUB(x)], 1u);
    const unsigned gen = old / nloc;
    if (old + 1u == (gen + 1u) * nloc) {
      __builtin_amdgcn_fence(__ATOMIC_RELEASE, "agent");
      asm volatile("s_waitcnt vmcnt(0)" ::: "memory");
      const unsigned og = xb_add(&bar[XB_TOP], 1u);
      const unsigned tg = og / nx;
      if (og + 1u == (tg + 1u) * nx) xb_add(&bar[XB_TOPGEN], 1u);
      else XB_SPIN(xb_ld(&bar[XB_TOPGEN]) == tg, bar);
      __builtin_amdgcn_fence(__ATOMIC_ACQUIRE, "agent");
      xb_add(&bar[XB_XGEN(x)], 1u);
      asm volatile("s_waitcnt vmcnt(0)" ::: "memory");
    } else {
      XB_SPIN(xb_ld(&bar[XB_XGEN(x)]) == gen, bar);
      __builtin_amdgcn_fence(__ATOMIC_ACQUIRE, "agent");
      asm volatile("s_waitcnt vmcnt(0)" ::: "memory");
    }
  }
  __syncthreads();
}

__global__ void __launch_bounds__(256, 2) mk_fwd(Params p) {
  __shared__ __attribute__((aligned(16))) char lds[LDS_TOTAL];
  cg::grid_group grid = cg::this_grid();
  unsigned* bar = (unsigned*)(p.ws + O_BAR);
  const unsigned xcc = xb_xcc_id();
  if (threadIdx.x == 0) (void)xb_add(&bar[XB_XCNT(xcc)], 1u);
  unsigned nloc = 0u, nx = 0u;
  if (gridDim.x == 0x7fffffffu) grid.sync();
#pragma unroll 1
  for (int ph = 0; ph < NPHASE; ++ph) {
    run_phase(p, ph, lds, bar);
    if (ph + 1 < NPHASE) xcd_barrier(bar, xcc, nloc, nx);
  }
}

extern "C" void kernel_launch(void* const* d_in, const int* in_sizes, int n_in, void* d_out, int out_size, void* d_ws, size_t ws_size,
                              hipStream_t stream) {
  Params p{};
  p.x_prompt = (const float*)d_in[0]; p.x_sample = (const float*)d_in[1]; p.cache_ckv = (const float*)d_in[2]; p.cache_krope = (const float*)d_in[3];
  p.state_ret = (const float*)d_in[4]; p.c = (const float*)d_in[5]; p.c_ctx = (const float*)d_in[6]; p.norm_g = (const float*)d_in[7];
  p.w_mod = (const float*)d_in[8]; p.b_mod = (const float*)d_in[9]; p.w_in = (const float*)d_in[10]; p.ret_logit = (const float*)d_in[11];
  p.q_norm_g = (const float*)d_in[12]; p.w_q_up = (const float*)d_in[13]; p.kv_norm_g = (const float*)d_in[14]; p.w_kv_up = (const float*)d_in[15];
  p.w_branch = (const float*)d_in[16]; p.w_out = (const float*)d_in[17]; p.final_g = (const float*)d_in[18];
  p.out = (float*)d_out; p.ws = (char*)d_ws;
#if ONE_LAUNCH
  static int grid_blocks = 0;
  if (!grid_blocks) {
    int dev = 0, cus = 0, per_cu = 0;
    hipGetDevice(&dev);
    hipDeviceGetAttribute(&cus, hipDeviceAttributeMultiprocessorCount, dev);
    hipOccupancyMaxActiveBlocksPerMultiprocessor(&per_cu, mk_fwd, 256, 0);
    if (per_cu > 2) per_cu = 2;
    grid_blocks = cus * per_cu;
  }
  hipMemsetAsync((char*)d_ws + O_BAR, 0, XCD_BAR_WORDS * 4, stream);
  void* args[] = {&p};
  hipError_t e = hipLaunchCooperativeKernel((void*)mk_fwd, dim3(grid_blocks), dim3(256), args, 0, stream);
  if (e != hipSuccess) fprintf(stderr, "cooperative launch failed: %s (grid %d)\n", hipGetErrorString(e), grid_blocks);
#endif
}
```

```cpp
#include <hip/hip_runtime.h>
#include <hip/hip_cooperative_groups.h>
#include <stdint.h>
#include <stdio.h>
namespace cg = cooperative_groups;

#ifndef ONE_LAUNCH
#define ONE_LAUNCH 1
#endif

typedef unsigned short bf16_t;
typedef short bf16x8 __attribute__((ext_vector_type(8)));
typedef float f32x4 __attribute__((ext_vector_type(4)));
typedef unsigned u32x4 __attribute__((ext_vector_type(4)));
typedef unsigned u32x2 __attribute__((ext_vector_type(2)));

constexpr int NTOK = 12288, NPR = 8192, NKEY = 14336;
constexpr float EPSN = 1e-6f;

constexpr size_t O_WIN   = 0;
constexpr size_t O_WQ    = O_WIN   + (size_t)2 * 6912 * 1024 * 2;
constexpr size_t O_WKV   = O_WQ    + (size_t)2 * 768 * 384 * 2;
constexpr size_t O_WBR   = O_WKV   + (size_t)2 * 1024 * 256 * 2;
constexpr size_t O_WO    = O_WBR   + (size_t)6 * 1024 * 512 * 2;
constexpr size_t O_CS    = O_WO    + (size_t)2 * 1024 * 1024 * 2;
constexpr size_t O_D256  = O_CS    + (size_t)256 * 128 * 2;
constexpr size_t O_D1024 = O_D256  + (size_t)256 * 512 * 2;
constexpr size_t O_S0T   = O_D1024 + (size_t)1024 * 2048 * 2;
constexpr size_t O_MOD   = O_S0T   + (size_t)64 * 128 * 64 * 2;
constexpr size_t O_H     = O_MOD   + (size_t)2 * 5 * 3072 * 4;
constexpr size_t O_BR8   = O_H;
constexpr size_t O_UT    = O_H     + (size_t)NTOK * 1024 * 2;
constexpr size_t O_RQ    = O_UT    + (size_t)NTOK * 1024 * 2;
constexpr size_t O_RK    = O_RQ    + (size_t)NTOK * 256 * 2;
constexpr size_t O_RKT   = O_RK    + (size_t)NTOK * 256 * 2;
constexpr size_t O_RVT   = O_RKT   + (size_t)NPR * 256 * 2;
constexpr size_t O_KVLAT = O_RVT   + (size_t)NTOK * 512 * 2;
constexpr size_t O_KR    = O_KVLAT + (size_t)NTOK * 256 * 4;
constexpr size_t O_R2END = O_KR    + (size_t)NTOK * 32 * 4;
constexpr size_t O_VT    = O_RQ;
static_assert(O_VT + (size_t)NKEY * 512 * 2 <= O_R2END, "alias overflow");
constexpr size_t O_RZ    = O_R2END;
constexpr size_t O_MZ    = O_RZ    + (size_t)NTOK * 512 * 2;
constexpr size_t O_FZ    = O_MZ    + (size_t)NTOK * 512 * 2;
constexpr size_t O_FU    = O_FZ    + (size_t)NTOK * 512 * 2;
constexpr size_t O_QLAT  = O_FU    + (size_t)NTOK * 512 * 2;
constexpr size_t O_CKVA  = O_QLAT  + (size_t)NTOK * 384 * 2;
constexpr size_t O_KB    = O_CKVA  + (size_t)NKEY * 256 * 2;
constexpr size_t O_KRA   = O_KB    + (size_t)NKEY * 512 * 2;
constexpr size_t O_QB    = O_KRA   + (size_t)NKEY * 32 * 2;
constexpr size_t O_H8    = O_QB    + (size_t)NTOK * 768 * 2;
constexpr size_t O_WG8   = O_H8    + (size_t)NTOK * 1024;
constexpr size_t O_WS8   = O_WG8   + (size_t)2 * 3072 * 1024;
constexpr size_t O_END   = O_WS8   + (size_t)2 * 1920 * 1024;
constexpr size_t O_ROPE  = (O_END + 255) & ~(size_t)255;
constexpr size_t O_BAR   = O_ROPE + 4096;
static_assert(O_BAR + 16384 <= (size_t)256 * 1024 * 1024, "workspace too large");

constexpr size_t OUT_CKV = (size_t)NTOK * 1024;
constexpr size_t OUT_KR  = OUT_CKV + (size_t)32 * 2 * 256 * 256;
constexpr size_t OUT_RET = OUT_KR + (size_t)32 * 2 * 256 * 32;

struct Params {
  const float *x_prompt, *x_sample, *cache_ckv, *cache_krope, *state_ret, *c, *c_ctx, *norm_g, *w_mod, *b_mod,
      *w_in, *ret_logit, *q_norm_g, *w_q_up, *kv_norm_g, *w_kv_up, *w_branch, *w_out, *final_g;
  float* out;
  char* ws;
};

constexpr int PANEL = 128 * 64;
constexpr int ABYTES = 2 * PANEL;
constexpr int STAGE = 2 * ABYTES;
constexpr int LDS_GEMM = 2 * STAGE;
constexpr int LDS_TOTAL = LDS_GEMM;
static_assert(LDS_TOTAL <= 65536, "static LDS");

typedef float f32x2 __attribute__((ext_vector_type(2)));
typedef __bf16 bf16x2v __attribute__((ext_vector_type(2)));
__device__ __forceinline__ unsigned pk2(float lo, float hi) { const f32x2 v = {lo, hi}; return __builtin_bit_cast(unsigned, __builtin_convertvector(v, bf16x2v)); }
__device__ __forceinline__ bf16_t tobf(float x) { return (bf16_t)(pk2(x, 0.f) & 0xffffu); }
typedef int v8i __attribute__((ext_vector_type(8)));
__device__ __forceinline__ float sat8(float x) { return __builtin_amdgcn_fmed3f(x, -448.f, 448.f); }
__device__ __forceinline__ unsigned pk4f8(float a, float b, float c, float d) { unsigned w = 0; a = sat8(a); b = sat8(b); c = sat8(c); d = sat8(d); w = __builtin_amdgcn_cvt_pk_fp8_f32(a, b, w, false); w = __builtin_amdgcn_cvt_pk_fp8_f32(c, d, w, true); return w; }
__device__ __forceinline__ float bflo(unsigned u) { return __uint_as_float(u << 16); }
__device__ __forceinline__ float bfhi(unsigned u) { return __uint_as_float(u & 0xffff0000u); }
__device__ __forceinline__ float ex2(float x) { return __builtin_amdgcn_exp2f(x); }
__device__ __forceinline__ float silu_f(float x) { return x / (1.f + __expf(-x)); }
__device__ __forceinline__ float sigm_f(float x) { return 1.f / (1.f + __expf(-x)); }
__device__ __forceinline__ u32x2 pk4(f32x4 v) { u32x2 r; r.x = pk2(v[0], v[1]); r.y = pk2(v[2], v[3]); return r; }
#define GAS __attribute__((address_space(1)))
#define LAS __attribute__((address_space(3)))
__device__ __forceinline__ u32x4 ldg16(const void* p) { return *(const GAS u32x4*)p; }
__device__ __forceinline__ int tidx() { int t = threadIdx.x; asm volatile("" : "+v"(t)); return t; }
__device__ __forceinline__ char* wsp(const char* w) { unsigned long long v = (unsigned long long)w; asm volatile("" : "+s"(v)); return (char*)v; }
__device__ __forceinline__ int swz(int r) { return (0 - ((r >> 2) & 3)) & 3; }
__device__ __forceinline__ float wave_sum(float v) {
#pragma unroll
  for (int o = 1; o < 64; o <<= 1) v += __shfl_xor(v, o);
  return v;
}
__device__ __forceinline__ f32x4 mfma16(bf16x8 a, bf16x8 b, f32x4 c) { return __builtin_amdgcn_mfma_f32_16x16x32_bf16(a, b, c, 0, 0, 0); }
__device__ __forceinline__ bf16x8 as_bf8(u32x4 v) { return __builtin_bit_cast(bf16x8, v); }

__device__ __forceinline__ void zero_acc(f32x4 (&acc)[4][4]) {
#pragma unroll
  for (int i = 0; i < 4; ++i)
#pragma unroll
    for (int j = 0; j < 4; ++j) acc[i][j] = (f32x4){0.f, 0.f, 0.f, 0.f};
}

template <bool SWAP, int NJ, int PIPE, bool F8>
__device__ __forceinline__ void gemm_bytes(const char* __restrict__ A, int lda, const char* __restrict__ B, int ldb, int Kb,
                                           f32x4 (&acc)[4][NJ], char* lds, int& par, bool primed,
                                           const char* nA, int nlda, const char* nB, int nldb) {
  const int tid = tidx(), lane = tid & 63, wm = (tid >> 6) >> 1, wn = (tid >> 6) & 1;
  const int wid = __builtin_amdgcn_readfirstlane(tid >> 6);
  const int fr = lane & 15, fq = lane >> 4;
  const int fa = (wm * 64 + fr) * 64 + ((fq ^ swz(fr)) << 4);
  const int fb = ABYTES + (wn * NJ * 16 + fr) * 64 + ((fq ^ swz(fr)) << 4);
  const int lrow = lane >> 2, lchunk = (lane & 3) ^ swz(lrow);
  constexpr int NBL = NJ / 2;
  const GAS char* gA = (const GAS char*)(A + (size_t)(wid * 32 + lrow) * lda + lchunk * 16);
  const GAS char* gB = (const GAS char*)(B + (size_t)(wid * NBL * 16 + lrow) * ldb + lchunk * 16);
  const size_t a16 = (size_t)16 * lda, b16 = (size_t)16 * ldb;
  LAS char* ldsA = (LAS char*)lds + wid * 2048;
  LAS char* ldsB = (LAS char*)lds + ABYTES + wid * NBL * 1024;
  const int nk = Kb >> 7;
#define GC_ISSUE(pa, pb, sa, sb, stage, kbyte) do { \
    _Pragma("unroll") for (int g = 0; g < 2; ++g) _Pragma("unroll") for (int pn = 0; pn < 2; ++pn) \
      __builtin_amdgcn_global_load_lds((const GAS unsigned*)((pa) + g * (sa) + (kbyte) + pn * 64), (LAS unsigned*)(ldsA + (stage) + pn * PANEL + g * 1024), 16, 0, 0); \
    _Pragma("unroll") for (int g = 0; g < NBL; ++g) _Pragma("unroll") for (int pn = 0; pn < 2; ++pn) \
      __builtin_amdgcn_global_load_lds((const GAS unsigned*)((pb) + g * (sb) + (kbyte) + pn * 64), (LAS unsigned*)(ldsB + (stage) + pn * PANEL + g * 1024), 16, 0, 0); \
  } while (0)
  if (!primed) {
    GC_ISSUE(gA, gB, a16, b16, par * STAGE, 0);
    asm volatile("s_waitcnt vmcnt(0)" ::: "memory");
    __syncthreads();
  }
#pragma unroll 1
  for (int kt = 0; kt < nk; ++kt) {
    char* cur = lds + par * STAGE;
    if (kt + 1 < nk) GC_ISSUE(gA, gB, a16, b16, (par ^ 1) * STAGE, (size_t)(kt + 1) * 128);
    else if (nA) {
      const GAS char* hA = (const GAS char*)(nA + (size_t)(wid * 32 + lrow) * nlda + lchunk * 16);
      const GAS char* hB = (const GAS char*)(nB + (size_t)(wid * NBL * 16 + lrow) * nldb + lchunk * 16);
      GC_ISSUE(hA, hB, (size_t)16 * nlda, (size_t)16 * nldb, (par ^ 1) * STAGE, 0);
    }
    __builtin_amdgcn_sched_barrier(0);
    if (F8 && PIPE == 1) {
      v8i av[4], bv[NJ];
#pragma unroll
      for (int i = 0; i < 4; ++i) {
        const u32x4 a0 = *(const u32x4*)(cur + fa + i * 1024), a1 = *(const u32x4*)(cur + PANEL + fa + i * 1024);
        av[i] = (v8i){(int)a0.x, (int)a0.y, (int)a0.z, (int)a0.w, (int)a1.x, (int)a1.y, (int)a1.z, (int)a1.w};
      }
#pragma unroll
      for (int j = 0; j < NJ; ++j) {
        const u32x4 b0 = *(const u32x4*)(cur + fb + j * 1024), b1 = *(const u32x4*)(cur + PANEL + fb + j * 1024);
        bv[j] = (v8i){(int)b0.x, (int)b0.y, (int)b0.z, (int)b0.w, (int)b1.x, (int)b1.y, (int)b1.z, (int)b1.w};
      }
      __builtin_amdgcn_sched_barrier(0);
#pragma unroll
      for (int i = 0; i < 4; ++i)
#pragma unroll
        for (int j = 0; j < NJ; ++j)
          acc[i][j] = SWAP ? __builtin_amdgcn_mfma_scale_f32_16x16x128_f8f6f4(bv[j], av[i], acc[i][j], 0, 0, 0, 0x7f7f7f7f, 0, 0x7f7f7f7f)
                           : __builtin_amdgcn_mfma_scale_f32_16x16x128_f8f6f4(av[i], bv[j], acc[i][j], 0, 0, 0, 0x7f7f7f7f, 0, 0x7f7f7f7f);
    } else if (F8) {
#pragma unroll
      for (int ih = 0; ih < 2; ++ih) {
        v8i av[2];
#pragma unroll
        for (int ii = 0; ii < 2; ++ii) {
          const u32x4 a0 = *(const u32x4*)(cur + fa + (ih * 2 + ii) * 1024), a1 = *(const u32x4*)(cur + PANEL + fa + (ih * 2 + ii) * 1024);
          av[ii] = (v8i){(int)a0.x, (int)a0.y, (int)a0.z, (int)a0.w, (int)a1.x, (int)a1.y, (int)a1.z, (int)a1.w};
        }
#pragma unroll
        for (int j = 0; j < NJ; ++j) {
          const u32x4 b0 = *(const u32x4*)(cur + fb + j * 1024), b1 = *(const u32x4*)(cur + PANEL + fb + j * 1024);
          const v8i bv = {(int)b0.x, (int)b0.y, (int)b0.z, (int)b0.w, (int)b1.x, (int)b1.y, (int)b1.z, (int)b1.w};
#pragma unroll
          for (int ii = 0; ii < 2; ++ii)
            acc[ih * 2 + ii][j] = SWAP ? __builtin_amdgcn_mfma_scale_f32_16x16x128_f8f6f4(bv, av[ii], acc[ih * 2 + ii][j], 0, 0, 0, 0x7f7f7f7f, 0, 0x7f7f7f7f)
                                       : __builtin_amdgcn_mfma_scale_f32_16x16x128_f8f6f4(av[ii], bv, acc[ih * 2 + ii][j], 0, 0, 0, 0x7f7f7f7f, 0, 0x7f7f7f7f);
        }
      }
    } else if (PIPE == 2) {
      bf16x8 af[2][4], bfr[NJ];
#pragma unroll
      for (int i = 0; i < 4; ++i) af[0][i] = *(const bf16x8*)(cur + fa + i * 1024);
#pragma unroll
      for (int j = 0; j < NJ; ++j) bfr[j] = *(const bf16x8*)(cur + fb + j * 1024);
#pragma unroll
      for (int i = 0; i < 4; ++i) af[1][i] = *(const bf16x8*)(cur + PANEL + fa + i * 1024);
      __builtin_amdgcn_sched_barrier(0);
#pragma unroll
      for (int i = 0; i < 4; ++i)
#pragma unroll
        for (int j = 0; j < NJ; ++j) acc[i][j] = SWAP ? mfma16(bfr[j], af[0][i], acc[i][j]) : mfma16(af[0][i], bfr[j], acc[i][j]);
#pragma unroll
      for (int j = 0; j < NJ; ++j) bfr[j] = *(const bf16x8*)(cur + PANEL + fb + j * 1024);
#pragma unroll
      for (int i = 0; i < 4; ++i)
#pragma unroll
        for (int j = 0; j < NJ; ++j) acc[i][j] = SWAP ? mfma16(bfr[j], af[1][i], acc[i][j]) : mfma16(af[1][i], bfr[j], acc[i][j]);
    } else if (PIPE == 1) {
      bf16x8 af[2][4], bfr[2][NJ];
#pragma unroll
      for (int ks = 0; ks < 2; ++ks) {
#pragma unroll
        for (int i = 0; i < 4; ++i) af[ks][i] = *(const bf16x8*)(cur + ks * PANEL + fa + i * 1024);
#pragma unroll
        for (int j = 0; j < NJ; ++j) bfr[ks][j] = *(const bf16x8*)(cur + ks * PANEL + fb + j * 1024);
      }
      __builtin_amdgcn_sched_barrier(0);
#pragma unroll
      for (int ks = 0; ks < 2; ++ks)
#pragma unroll
        for (int i = 0; i < 4; ++i)
#pragma unroll
          for (int j = 0; j < NJ; ++j) acc[i][j] = SWAP ? mfma16(bfr[ks][j], af[ks][i], acc[i][j]) : mfma16(af[ks][i], bfr[ks][j], acc[i][j]);
    } else {
#pragma unroll
      for (int ks = 0; ks < 2; ++ks) {
        bf16x8 af[4], bfr[NJ];
#pragma unroll
        for (int i = 0; i < 4; ++i) af[i] = *(const bf16x8*)(cur + ks * PANEL + fa + i * 1024);
#pragma unroll
        for (int j = 0; j < NJ; ++j) bfr[j] = *(const bf16x8*)(cur + ks * PANEL + fb + j * 1024);
#pragma unroll
        for (int i = 0; i < 4; ++i)
#pragma unroll
          for (int j = 0; j < NJ; ++j) acc[i][j] = SWAP ? mfma16(bfr[j], af[i], acc[i][j]) : mfma16(af[i], bfr[j], acc[i][j]);
      }
    }
    __builtin_amdgcn_sched_barrier(0);
    asm volatile("s_waitcnt vmcnt(0)" ::: "memory");
    __syncthreads();
    par ^= 1;
  }
#undef GC_ISSUE
}
template <bool SWAP, int NJ = 4, int PIPE = 1>
__device__ __forceinline__ void gemm_core(const bf16_t* __restrict__ A, int lda, const bf16_t* __restrict__ B, int ldb, int K,
                                          f32x4 (&acc)[4][NJ], char* lds, int& par, bool primed,
                                          const bf16_t* nA, int nlda, const bf16_t* nB, int nldb) {
  gemm_bytes<SWAP, NJ, PIPE, false>((const char*)A, lda * 2, (const char*)B, ldb * 2, K * 2, acc, lds, par, primed, (const char*)nA, nlda * 2, (const char*)nB, nldb * 2);
}
template <bool SWAP, int NJ = 4>
__device__ __forceinline__ void gemm_core(const bf16_t* __restrict__ A, int lda, const bf16_t* __restrict__ B, int ldb, int K,
                                          f32x4 (&acc)[4][NJ], char* lds) {
  int par = 0;
  gemm_core<SWAP, NJ>(A, lda, B, ldb, K, acc, lds, par, false, nullptr, 0, nullptr, 0);
}

__device__ __forceinline__ void tr_tile(const float* __restrict__ src, int lds_, int k0, int ns0, bf16_t* __restrict__ dst, int ldd, int nd0,
                                        const float* __restrict__ ksc, char* lds) {
  bf16_t* T = (bf16_t*)lds;
  const int tid = tidx();
  __syncthreads();
#pragma unroll
  for (int i = 0; i < 2; ++i) {
    const int kk = (tid >> 3) + 32 * i, nn4 = (tid & 7) * 4;
    const f32x4 v = *(const f32x4*)(src + (size_t)(k0 + kk) * lds_ + ns0 + nn4);
    const float s = ksc ? ksc[k0 + kk] : 1.f;
#pragma unroll
    for (int e = 0; e < 4; ++e) T[(nn4 + e) * 72 + kk] = tobf(v[e] * s);
  }
  __syncthreads();
  const int nn = tid >> 3, kc = (tid & 7) * 8;
  const u32x4 w = *(const u32x4*)(T + nn * 72 + kc);
  *(u32x4*)(dst + (size_t)(nd0 + nn) * ldd + k0 + kc) = w;
}

__device__ __forceinline__ void tr_tile2(const float* __restrict__ src, int lds_, int k0, int ns0, bf16_t* __restrict__ dst, int ldd, int nd0,
                                         const float* __restrict__ ksc, char* lds, unsigned char* dst8 = nullptr, int ld8 = 1024) {
  bf16_t* T = (bf16_t*)lds;
  unsigned char* T8 = (unsigned char*)lds + 8704;
  const int tid = tidx();
  __syncthreads();
  f32x4 v[4];
#pragma unroll
  for (int i = 0; i < 4; ++i) v[i] = __builtin_nontemporal_load((const GAS f32x4*)(src + (size_t)(k0 + (tid >> 3) + 32 * i) * lds_ + ns0 + (tid & 7) * 4));
#pragma unroll
  for (int i = 0; i < 4; ++i) {
    const int kk = (tid >> 3) + 32 * i, nn4 = (tid & 7) * 4;
    const float sc = ksc ? ksc[k0 + kk] : 1.f;
#pragma unroll
    for (int e = 0; e < 4; ++e) T[(nn4 + e) * 136 + kk] = tobf(v[i][e] * sc);
    if (dst8) {
#pragma unroll
      for (int e = 0; e < 4; ++e) T8[(nn4 + e) * 144 + kk] = (unsigned char)(__builtin_amdgcn_cvt_pk_fp8_f32(sat8(v[i][e] * sc * 32.f), 0.f, 0, false) & 0xff);
    }
  }
  __syncthreads();
  const int nn = tid >> 3, kc = (tid & 7) * 16;
  if (dst8) *(u32x4*)(dst8 + (size_t)nn * ld8 + k0 + kc) = *(const u32x4*)(T8 + nn * 144 + kc);
  if (!dst) return;
  const u32x4 w0 = *(const u32x4*)(T + nn * 136 + kc), w1 = *(const u32x4*)(T + nn * 136 + kc + 8);
  bf16_t* d = dst + (size_t)(nd0 + nn) * ldd + k0 + kc;
  *(u32x4*)d = w0; *(u32x4*)(d + 8) = w1;
}

constexpr int P0_GEMV = 192, P0_WIN = 3408, P0_WQ = 144, P0_WKV = 128, P0_WBR = 768, P0_WO = 512, P0_S0 = 256, P0_PAD = 96, P0_TAB = 1105;
constexpr int P0_N = P0_GEMV + P0_WIN + P0_WQ + P0_WKV + P0_WBR + P0_WO + P0_S0 + P0_PAD + P0_TAB;

__device__ __forceinline__ void phase0_item(const Params& p, int j, char* lds) {
  const int tid = tidx();
  char* ws = wsp(p.ws);
  if (j < P0_GEMV) {
    const int l = j / 96, cgi = j % 96;
    float* sv = (float*)lds;
    float* red = (float*)(lds + 20480);
    __syncthreads();
    for (int i = tid; i < 5120; i += 256) { const int v = i >> 10, k = i & 1023; const float x = (v == 0) ? p.c_ctx[k] : p.c[(v - 1) * 1024 + k]; sv[i] = silu_f(x); }
    __syncthreads();
    const int c4 = tid & 7, kg = tid >> 3;
    const float* w = p.w_mod + (size_t)l * 1024 * 3072 + cgi * 32 + c4 * 4;
    f32x4 a0 = {0.f, 0.f, 0.f, 0.f}, a1 = a0, a2 = a0, a3 = a0, a4 = a0;
#pragma unroll 8
    for (int k = kg * 32; k < kg * 32 + 32; ++k) {
      const f32x4 wv = __builtin_nontemporal_load((const GAS f32x4*)(w + (size_t)k * 3072));
      a0 += wv * sv[k]; a1 += wv * sv[1024 + k]; a2 += wv * sv[2048 + k]; a3 += wv * sv[3072 + k]; a4 += wv * sv[4096 + k];
    }
    *(f32x4*)(red + (kg * 5 + 0) * 32 + c4 * 4) = a0; *(f32x4*)(red + (kg * 5 + 1) * 32 + c4 * 4) = a1; *(f32x4*)(red + (kg * 5 + 2) * 32 + c4 * 4) = a2;
    *(f32x4*)(red + (kg * 5 + 3) * 32 + c4 * 4) = a3; *(f32x4*)(red + (kg * 5 + 4) * 32 + c4 * 4) = a4;
    __syncthreads();
    if (tid < 160) {
      const int v = tid >> 5, c2 = tid & 31;
      float sm = p.b_mod[l * 3072 + cgi * 32 + c2];
#pragma unroll 8
      for (int g = 0; g < 32; ++g) sm += red[(g * 5 + v) * 32 + c2];
      ((float*)(ws + O_MOD))[(l * 5 + v) * 3072 + cgi * 32 + c2] = sm;
    }
    return;
  }
  j -= P0_GEMV;
  if (j < P0_WIN) {
    const int l = j / 1704, r = j % 1704, kt = r / 213, nt = r % 213, c0 = nt * 32;
    const int nd0 = c0 < 2176 ? c0 : (c0 < 2208 ? 3712 + (c0 - 2176) : (c0 < 3744 ? c0 - 32 : c0 + 96));
    const bool only8 = nd0 >= 3840 || (nd0 >= 1536 && nd0 < 1920) || (nd0 >= 2688 && nd0 < 3200);
    tr_tile2(p.w_in + (size_t)l * 1024 * 6816, 6816, kt * 128, c0, only8 ? nullptr : (bf16_t*)(ws + O_WIN) + (size_t)l * 6912 * 1024, 1024, nd0, nullptr, lds,
             nd0 >= 3840 ? (unsigned char*)(ws + O_WG8) + ((size_t)l * 3072 + (nd0 - 3840)) * 1024
             : nd0 < 1024 ? (unsigned char*)(ws + O_WS8) + ((size_t)l * 1920 + nd0) * 1024
             : (nd0 >= 1536 && nd0 < 1920) ? (unsigned char*)(ws + O_WS8) + ((size_t)l * 1920 + 1024 + (nd0 - 1536)) * 1024
             : (nd0 >= 2688 && nd0 < 3200) ? (unsigned char*)(ws + O_WS8) + ((size_t)l * 1920 + 1408 + (nd0 - 2688)) * 1024 : nullptr);
    return;
  }
  j -= P0_WIN;
  if (j < P0_WQ) {
    const int l = j / 72, r = j % 72, kt = r / 24, nt = r % 24;
    tr_tile2(p.w_q_up + (size_t)l * 384 * 768, 768, kt * 128, nt * 32, nullptr, 384, nt * 32, p.q_norm_g + l * 384, lds,
             (unsigned char*)(ws + O_WQ) + ((size_t)l * 768 + nt * 32) * 384, 384);
    return;
  }
  j -= P0_WQ;
  if (j < P0_WKV) {
    const int l = j / 64, r = j % 64, kt = r / 32, nt = r % 32, c0 = nt * 32, h = c0 >> 7, e = c0 & 127;
    const int nd0 = e < 64 ? h * 64 + e : 512 + h * 64 + (e - 64);
    tr_tile2(p.w_kv_up + (size_t)l * 256 * 1024, 1024, kt * 128, c0, nullptr, 256, nd0, nullptr, lds,
             (unsigned char*)(ws + O_WKV) + ((size_t)l * 1024 + nd0) * 256, 256);
    return;
  }
  j -= P0_WKV;
  if (j < P0_WBR) {
    const int mat = j / 128, r = j % 128, kt = r / 32, nt = r % 32;
    tr_tile2(p.w_branch + (size_t)mat * 512 * 1024, 1024, kt * 128, nt * 32, nullptr, 512, nt * 32, nullptr, lds,
             (unsigned char*)(ws + O_WBR) + ((size_t)mat * 1024 + nt * 32) * 512, 512);
    return;
  }
  j -= P0_WBR;
  if (j < P0_WO) {
    const int l = j / 256, r = j % 256, kt = r / 32, nt = r % 32;
    tr_tile2(p.w_out + (size_t)l * 1024 * 1024, 1024, kt * 128, nt * 32, nullptr, 1024, nt * 32, nullptr, lds,
             (unsigned char*)(ws + O_WO) + ((size_t)l * 1024 + nt * 32) * 1024, 1024);
    return;
  }
  j -= P0_WO;
  if (j < P0_S0) {
    const int mat = j >> 2, nt = j & 3;
    tr_tile(p.state_ret + (size_t)mat * 64 * 128, 128, 0, nt * 32, (bf16_t*)(ws + O_S0T) + (size_t)mat * 128 * 64, 64, nt * 32, nullptr, lds);
    return;
  }
  j -= P0_S0;
  if (j < P0_PAD) {
    const int l = j / 48, r = j % 48;
    bf16_t* d = (bf16_t*)(ws + O_WIN) + ((size_t)l * 6912 + 3744) * 1024 + (size_t)r * 2048 + tid * 8;
    *(u32x4*)d = (u32x4){0u, 0u, 0u, 0u};
    return;
  }
  j -= P0_PAD;
  {
    float v[8];
    bf16_t* dst = nullptr; unsigned char* dst8 = nullptr;
    if (j == 1104) {
      float* rt = (float*)(ws + O_ROPE);
#pragma unroll
      for (int q = 0; q < 2; ++q) {
        const int idx = tid * 2 + q, pos = idx >> 3, f = idx & 7;
        const float ang = (float)pos * exp2f(-(float)f * 1.66096404744f);
        rt[idx * 2] = cosf(ang); rt[idx * 2 + 1] = sinf(ang);
      }
      return;
    }
    if (j < 16) {
      const int e0 = j * 2048 + tid * 8; dst = (bf16_t*)(ws + O_CS) + e0;
      const int n = e0 >> 7, k = e0 & 127;
#pragma unroll
      for (int e = 0; e < 8; ++e) {
        const float fr = (float)(((n & 127) * (k + e)) & 127) * (1.f / 128.f);
        v[e] = (n < 128) ? __builtin_amdgcn_cosf(fr) : __builtin_amdgcn_sinf(fr);
      }
    } else if (j < 80) {
      const int e0 = (j - 16) * 2048 + tid * 8; dst8 = (unsigned char*)(ws + O_D256) + e0;
      const int k1 = e0 >> 9, kk = e0 & 511;
#pragma unroll
      for (int e = 0; e < 8; ++e) {
        const int t = (kk + e) & 255;
        const float fr = (float)((k1 * t) & 255) * (1.f / 256.f);
        v[e] = (kk < 256) ? __builtin_amdgcn_cosf(fr) : -__builtin_amdgcn_sinf(fr);
      }
    } else {
      const int e0 = (j - 80) * 2048 + tid * 8; dst8 = (unsigned char*)(ws + O_D1024) + e0;
      const int k1 = e0 >> 11, kk = e0 & 2047;
#pragma unroll
      for (int e = 0; e < 8; ++e) {
        const int t = (kk + e) & 1023;
        const float fr = (float)((k1 * t) & 1023) * (1.f / 1024.f);
        v[e] = (kk < 1024) ? __builtin_amdgcn_cosf(fr) : -__builtin_amdgcn_sinf(fr);
      }
    }
    if (dst8) {
      u32x2 w8; w8.x = pk4f8(v[0] * 64.f, v[1] * 64.f, v[2] * 64.f, v[3] * 64.f); w8.y = pk4f8(v[4] * 64.f, v[5] * 64.f, v[6] * 64.f, v[7] * 64.f);
      *(u32x2*)dst8 = w8;
    } else {
      u32x4 w; w.x = pk2(v[0], v[1]); w.y = pk2(v[2], v[3]); w.z = pk2(v[4], v[5]); w.w = pk2(v[6], v[7]);
      *(u32x4*)dst = w;
    }
  }
}

__device__ __forceinline__ void norm_item(const Params& p, int l, int item, const float* xp, const float* xs) {
  const int tid = tidx(), lane = tid & 63, wid = tid >> 6;
  bf16_t* H = (bf16_t*)(p.ws + O_H);
#pragma unroll 3
  for (int i = 0; i < 6; ++i) {
    const int row = item * 24 + wid * 6 + i;
    const float* src = row < NPR ? xp + (size_t)row * 1024 : xs + (size_t)(row - NPR) * 1024;
    const int v = row < NPR ? 0 : 1 + ((row - NPR) >> 10);
    const float* mod = (const float*)(p.ws + O_MOD) + (l * 5 + v) * 3072;
    f32x4 x[4]; float ss = 0.f;
#pragma unroll
    for (int q = 0; q < 4; ++q) { x[q] = *(const f32x4*)(src + (q * 64 + lane) * 4); ss += x[q][0] * x[q][0] + x[q][1] * x[q][1] + x[q][2] * x[q][2] + x[q][3] * x[q][3]; }
    ss = wave_sum(ss);
    const float rstd = rsqrtf(ss * (1.f / 1024.f) + EPSN);
#pragma unroll
    for (int q = 0; q < 4; ++q) {
      const int col = (q * 64 + lane) * 4;
      const f32x4 g = *(const f32x4*)(p.norm_g + l * 1024 + col), sc = *(const f32x4*)(mod + 1024 + col), sh = *(const f32x4*)(mod + col);
      f32x4 h;
#pragma unroll
      for (int e = 0; e < 4; ++e) h[e] = x[q][e] * rstd * g[e] * (1.f + sc[e]) + sh[e];
      *(u32x2*)(H + (size_t)row * 1024 + col) = pk4(h);
      *(unsigned*)(p.ws + O_H8 + (size_t)row * 1024 + col) = pk4f8(h[0], h[1], h[2], h[3]);
    }
  }
}
__device__ __forceinline__ void final_item(const Params& p, int item) {
  const int tid = tidx(), lane = tid & 63, wid = tid >> 6;
#pragma unroll 3
  for (int i = 0; i < 6; ++i) {
    const int row = item * 24 + wid * 6 + i;
    float* src = p.out + (size_t)row * 1024;
    f32x4 x[4]; float ss = 0.f;
#pragma unroll
    for (int q = 0; q < 4; ++q) { x[q] = *(const f32x4*)(src + (q * 64 + lane) * 4); ss += x[q][0] * x[q][0] + x[q][1] * x[q][1] + x[q][2] * x[q][2] + x[q][3] * x[q][3]; }
    ss = wave_sum(ss);
    const float rstd = rsqrtf(ss * (1.f / 1024.f) + EPSN);
#pragma unroll
    for (int q = 0; q < 4; ++q) {
      const int col = (q * 64 + lane) * 4;
      const f32x4 g = *(const f32x4*)(p.final_g + col);
      f32x4 y;
#pragma unroll
      for (int e = 0; e < 4; ++e) y[e] = x[q][e] * rstd * g[e];
      *(f32x4*)(src + col) = y;
    }
  }
}

__device__ __forceinline__ void s2_tile(const Params& p, int l, int tile, char* lds) {
  const int tid = tidx(), lane = tid & 63, wid = tid >> 6, wm = wid >> 1, wn = wid & 1, fr = lane & 15, fq = lane >> 4;
  const int m = (tile / 480) * 16 + (tile % 16), nt = (tile % 480) / 16, m0 = m * 128, n0 = nt * 128;
  char* ws = wsp(p.ws);
  const bf16_t* A = (const bf16_t*)(ws + O_H) + (size_t)m0 * 1024;
  const bf16_t* B = (const bf16_t*)(ws + O_WIN) + ((size_t)l * 6912 + n0) * 1024;
  const bool f8 = (nt >= 12 && nt < 15) || (nt >= 21 && nt < 25);
  const int row8 = nt < 8 ? nt * 128 : (nt < 15 ? 1024 + (nt - 12) * 128 : 1408 + (nt - 21) * 128);
  const char* A8 = (const char*)(ws + O_H8) + (size_t)m0 * 1024;
  const char* B8 = (const char*)(ws + O_WS8) + ((size_t)l * 1920 + row8) * 1024;
  const float s8 = f8 ? 0.03125f : 1.f;
  f32x4 acc[4][4];
  zero_acc(acc);
  if (nt >= 4 && nt < 8) {
    gemm_core<false>(A, 1024, B, 1024, 1024, acc, lds);
    bf16_t* RVT = (bf16_t*)(ws + O_RVT);
#pragma unroll
    for (int i = 0; i < 4; ++i) {
      const int tok = m0 + wm * 64 + i * 16 + fq * 4;
      size_t base; int T, b, t;
      if (tok < NPR) { b = tok >> 8; t = tok & 255; T = 256; base = 0; } else { const int s = tok - NPR; b = s >> 10; t = s & 1023; T = 1024; base = (size_t)NPR * 512; }
#pragma unroll
      for (int j = 0; j < 4; ++j) {
        const int c = n0 - 512 + wn * 64 + j * 16 + fr, h = c >> 7, vd = c & 127;
        *(u32x2*)(RVT + base + ((size_t)(b * 4 + h) * 128 + vd) * T + t) = pk4(acc[i][j]);
      }
    }
    return;
  }
  if (f8) { int par = 0; gemm_bytes<true, 4, 1, true>(A8, 1024, B8, 1024, 1024, acc, lds, par, false, nullptr, 0, nullptr, 0); }
  else gemm_core<true>(A, 1024, B, 1024, 1024, acc, lds);
  bf16_t* dst = nullptr; int ld = 0, c0 = 0, op = 0;
  if (nt < 2) { dst = (bf16_t*)(ws + O_RQ); ld = 256; c0 = 0; }
  else if (nt < 4) { dst = (bf16_t*)(ws + O_RK); ld = 256; c0 = 256; op = 2; }
  else if (nt < 12) { dst = (bf16_t*)(ws + O_RZ); ld = 512; c0 = 1024; op = 1; }
  else if (nt < 15) { ld = 384; c0 = 1536; op = 5; }
  else if (nt < 17) { ld = 256; c0 = 1920; op = 3; }
  else if (nt < 21) { dst = (bf16_t*)(ws + O_MZ); ld = 512; c0 = 2176; op = 1; }
  else if (nt < 25) { dst = (bf16_t*)(ws + O_FU); ld = 512; c0 = 2688; }
  else if (nt < 29) { dst = (bf16_t*)(ws + O_FZ); ld = 512; c0 = 3200; op = 1; }
  else { ld = 32; c0 = 3712; op = 4; }
#pragma unroll
  for (int i = 0; i < 4; ++i) {
    const int tok = m0 + wm * 64 + i * 16 + fr;
#pragma unroll
    for (int j = 0; j < 4; ++j) {
      const int col = n0 - c0 + wn * 64 + j * 16 + fq * 4;
      f32x4 v = acc[i][j] * s8;
      if (op == 3) { *(f32x4*)((float*)(ws + O_KVLAT) + (size_t)tok * 256 + col) = v; continue; }
      if (op == 5) { *(unsigned*)(ws + O_QLAT + (size_t)tok * 384 + col) = pk4f8(v[0] * 8.f, v[1] * 8.f, v[2] * 8.f, v[3] * 8.f); continue; }
      if (op == 4) { if (col < 32) *(f32x4*)((float*)(ws + O_KR) + (size_t)tok * 32 + col) = v; continue; }
      if (op == 1) {
#pragma unroll
        for (int e = 0; e < 4; ++e) v[e] = silu_f(v[e]);
      } else if (op == 2) {
#pragma unroll
        for (int e = 0; e < 4; ++e) v[e] *= 0.125f;
      }
      const u32x2 w = pk4(v);
      *(u32x2*)(dst + (size_t)tok * ld + col) = w;
      if (op == 2 && tok < NPR) {
        bf16_t* RKT = (bf16_t*)(ws + O_RKT);
        const int b = tok >> 8, t = tok & 255, h = col >> 6, dk = col & 63;
        bf16_t* q = RKT + ((size_t)(b * 4 + h) * 64 + dk) * 256 + t;
        q[0] = (bf16_t)(w.x & 0xffffu); q[256] = (bf16_t)(w.x >> 16); q[512] = (bf16_t)(w.y & 0xffffu); q[768] = (bf16_t)(w.y >> 16);
      }
    }
  }
}

template <int MODE>
__device__ __forceinline__ void attn_item(const Params& p, int l, int item, char* lds) {
  constexpr int NKP = MODE == 0 ? 3 : 2;
  constexpr int NVB = MODE == 0 ? 4 : 8;
  constexpr int PV = NVB * 16 * 64;
  constexpr int KOFF = NKP * 4096;
  constexpr int BUF = KOFF + 2 * PV;
  const int tid = tidx(), lane = tid & 63, wid = tid >> 6, fr = lane & 15, fq = lane >> 4;
  char* ws = wsp(p.ws);
  int smp, b, h, qblk, T, Tk, tok0;
  const bf16_t *kbase, *rbase = nullptr, *vbase, *qbase;
  int kstride, qstride;
  if (MODE == 0) {
    if (item < 256) { smp = 1; b = item >> 6; h = (item >> 3) & 7; qblk = item & 7; T = 1024; Tk = 1536; tok0 = NPR + b * 1024 + qblk * 128; }
    else { const int it = item - 256; smp = 0; b = it >> 4; h = (it >> 1) & 7; qblk = it & 1; T = 256; Tk = 256; tok0 = b * 256 + qblk * 128; }
    const int keyrow0 = smp ? NPR + b * 1536 : b * 256;
    kbase = (const bf16_t*)(ws + O_KB) + (size_t)keyrow0 * 512 + h * 64; kstride = 512;
    rbase = (const bf16_t*)(ws + O_KRA) + (size_t)keyrow0 * 32;
    vbase = (const bf16_t*)(ws + O_VT) + (smp ? (size_t)NPR * 512 + (size_t)(b * 8 + h) * 64 * 1536 : (size_t)(b * 8 + h) * 64 * 256);
    qbase = (const bf16_t*)(ws + O_QB) + (size_t)tok0 * 768 + h * 96; qstride = 768;
  } else {
    if (item < 128) { smp = 1; b = item >> 5; h = (item >> 3) & 3; qblk = item & 7; T = 1024; tok0 = NPR + b * 1024 + qblk * 128; }
    else { const int it = item - 128; smp = 0; b = it >> 3; h = (it >> 1) & 3; qblk = it & 1; T = 256; tok0 = b * 256 + qblk * 128; }
    Tk = T;
    const int ktok0 = smp ? NPR + b * 1024 : b * 256;
    kbase = (const bf16_t*)(ws + O_RK) + (size_t)ktok0 * 256 + h * 64; kstride = 256;
    vbase = (const bf16_t*)(ws + O_RVT) + (smp ? (size_t)NPR * 512 + (size_t)(b * 4 + h) * 128 * 1024 : (size_t)(b * 4 + h) * 128 * 256);
    qbase = (const bf16_t*)(ws + O_RQ) + (size_t)tok0 * 256 + h * 64; qstride = 256;
  }
  const int nkt = Tk >> 6;
  bf16x8 qf[2][NKP];
#pragma unroll
  for (int qb = 0; qb < 2; ++qb)
#pragma unroll
    for (int ks = 0; ks < NKP; ++ks) qf[qb][ks] = *(const bf16x8*)(qbase + (size_t)(wid * 32 + qb * 16 + fr) * qstride + ks * 32 + fq * 8);
  f32x4 o[NVB][2];
#pragma unroll
  for (int vb = 0; vb < NVB; ++vb) { o[vb][0] = (f32x4){0.f, 0.f, 0.f, 0.f}; o[vb][1] = (f32x4){0.f, 0.f, 0.f, 0.f}; }
  float lgf = 0.f, lgb = 0.f;
  float mrow[2] = {-INFINITY, -INFINITY}, lrow[2] = {0.f, 0.f};
  const int tq0 = qblk * 128 + wid * 32 + fr;
  if (MODE == 1) {
    const float xf = p.ret_logit[(l * 2 + 0) * 4 + h], xb = p.ret_logit[(l * 2 + 1) * 4 + h];
    lgf = -log1pf(expf(-xf)) * 1.44269504089f; lgb = -log1pf(expf(-xb)) * 1.44269504089f;
    if (smp) {
      const bf16_t* s0 = (const bf16_t*)(ws + O_S0T);
#pragma unroll
      for (int dir = 0; dir < 2; ++dir) {
        const bf16_t* sb = s0 + ((size_t)(((b * 2 + l) * 2 + dir) * 4 + h) * 128) * 64;
        float dec[2];
#pragma unroll
        for (int qb = 0; qb < 2; ++qb) { const int tq = tq0 + qb * 16; dec[qb] = dir == 0 ? ex2((float)(tq + 1) * lgf) : ex2((float)(T - tq) * lgb); }
#pragma unroll
        for (int vb = 0; vb < NVB; ++vb) {
          f32x4 t0 = (f32x4){0.f, 0.f, 0.f, 0.f}, t1 = (f32x4){0.f, 0.f, 0.f, 0.f};
#pragma unroll
          for (int ks = 0; ks < 2; ++ks) {
            const bf16x8 sf = *(const bf16x8*)(sb + (size_t)(vb * 16 + fr) * 64 + ks * 32 + fq * 8);
            t0 = mfma16(sf, qf[0][ks], t0); t1 = mfma16(sf, qf[1][ks], t1);
          }
          o[vb][0] += t0 * dec[0]; o[vb][1] += t1 * dec[1];
        }
      }
    }
  }
  u32x4 vreg[NVB / 2];
  const int uw = __builtin_amdgcn_readfirstlane(wid);
  const int dkey = lane >> 2, dchunk = (lane & 3) ^ swz(dkey);
  auto kdma = [&](int kt, char* buf) {
    const GAS bf16_t* kp = (const GAS bf16_t*)kbase + (size_t)(kt * 64 + uw * 16 + dkey) * kstride + dchunk * 8;
#pragma unroll
    for (int pn = 0; pn < 2; ++pn)
      __builtin_amdgcn_global_load_lds((const GAS unsigned*)(kp + pn * 32), (LAS unsigned*)((LAS char*)buf + pn * 4096 + uw * 1024), 16, 0, 0);
    if (MODE == 0) {
      const GAS bf16_t* rp = (const GAS bf16_t*)rbase + (size_t)(kt * 64 + uw * 16 + dkey) * 32 + dchunk * 8;
      __builtin_amdgcn_global_load_lds((const GAS unsigned*)rp, (LAS unsigned*)((LAS char*)buf + 2 * 4096 + uw * 1024), 16, 0, 0);
    }
  };
  auto gload = [&](int kt) {
#pragma unroll
    for (int i = 0; i < NVB / 2; ++i) { const int idx = tid + 256 * i, vd = idx >> 3, g = idx & 7; vreg[i] = ldg16(vbase + (size_t)vd * Tk + kt * 64 + g * 8); }
  };
  auto lstore = [&](char* buf) {
#pragma unroll
    for (int i = 0; i < NVB / 2; ++i) {
      const int idx = tid + 256 * i, vd = idx >> 3, g = idx & 7, pnl = g >> 2, g4 = g & 3, hi = g4 >> 1, q0 = 2 * (g4 & 1);
      char* base = buf + KOFF + pnl * PV + vd * 64 + hi * 8;
      *(u32x2*)(base + ((q0 ^ swz(vd)) << 4)) = (u32x2){vreg[i].x, vreg[i].y};
      *(u32x2*)(base + (((q0 + 1) ^ swz(vd)) << 4)) = (u32x2){vreg[i].z, vreg[i].w};
    }
  };
  __syncthreads();
  kdma(0, lds); gload(0); lstore(lds);
  asm volatile("s_waitcnt vmcnt(0)" ::: "memory");
  __syncthreads();
  const int foff = fr * 64 + ((fq ^ swz(fr)) << 4);
  for (int kt = 0; kt < nkt; ++kt) {
    char* cur = lds + (kt & 1) * BUF;
    const bool more = (kt + 1) < nkt;
    if (more) { kdma(kt + 1, lds + ((kt + 1) & 1) * BUF); gload(kt + 1); }
    __builtin_amdgcn_sched_barrier(0);
    f32x4 s[4][2];
#pragma unroll
    for (int kb = 0; kb < 4; ++kb) {
      s[kb][0] = (f32x4){0.f, 0.f, 0.f, 0.f}; s[kb][1] = (f32x4){0.f, 0.f, 0.f, 0.f};
#pragma unroll
      for (int ks = 0; ks < NKP; ++ks) {
        const bf16x8 kf = *(const bf16x8*)(cur + ks * 4096 + kb * 1024 + foff);
        s[kb][0] = mfma16(kf, qf[0][ks], s[kb][0]); s[kb][1] = mfma16(kf, qf[1][ks], s[kb][1]);
      }
    }
    bf16x8 pf[2][2];
#pragma unroll
    for (int qb = 0; qb < 2; ++qb) {
      if (MODE == 0) {
        float mx = s[0][qb][0];
#pragma unroll
        for (int kb = 0; kb < 4; ++kb)
#pragma unroll
          for (int r = 0; r < 4; ++r) mx = fmaxf(mx, s[kb][qb][r]);
        mx = fmaxf(mx, __shfl_xor(mx, 16)); mx = fmaxf(mx, __shfl_xor(mx, 32));
        const float mn = fmaxf(mrow[qb], mx), alpha = ex2(mrow[qb] - mn);
        mrow[qb] = mn;
        float ls = 0.f;
#pragma unroll
        for (int kb = 0; kb < 4; ++kb)
#pragma unroll
          for (int r = 0; r < 4; ++r) { const float e = ex2(s[kb][qb][r] - mn); s[kb][qb][r] = e; ls += e; }
        lrow[qb] = lrow[qb] * alpha + ls;
#pragma unroll
        for (int vb = 0; vb < NVB; ++vb) o[vb][qb] *= alpha;
      } else {
        const int tq = tq0 + qb * 16;
#pragma unroll
        for (int kb = 0; kb < 4; ++kb)
#pragma unroll
          for (int r = 0; r < 4; ++r) {
            const int d = tq - (kt * 64 + kb * 16 + fq * 4 + r);
            const float dec = d > 0 ? ex2((float)d * lgf) : (d < 0 ? ex2((float)(-d) * lgb) : 2.f);
            s[kb][qb][r] *= dec;
          }
      }
#pragma unroll
      for (int g = 0; g < 2; ++g) {
        u32x4 w; w.x = pk2(s[2 * g][qb][0], s[2 * g][qb][1]); w.y = pk2(s[2 * g][qb][2], s[2 * g][qb][3]);
        w.z = pk2(s[2 * g + 1][qb][0], s[2 * g + 1][qb][1]); w.w = pk2(s[2 * g + 1][qb][2], s[2 * g + 1][qb][3]);
        pf[qb][g] = as_bf8(w);
      }
    }
#pragma unroll
    for (int vb = 0; vb < NVB; ++vb)
#pragma unroll
      for (int g = 0; g < 2; ++g) {
        const bf16x8 vf = *(const bf16x8*)(cur + KOFF + g * PV + vb * 1024 + foff);
        o[vb][0] = mfma16(vf, pf[0][g], o[vb][0]); o[vb][1] = mfma16(vf, pf[1][g], o[vb][1]);
      }
    __builtin_amdgcn_sched_barrier(0);
    if (more) lstore(lds + ((kt + 1) & 1) * BUF);
    asm volatile("s_waitcnt vmcnt(0)" ::: "memory");
    __syncthreads();
  }
  bf16_t* G = (bf16_t*)(ws + (MODE == 0 ? O_MZ : O_RZ));
#pragma unroll
  for (int qb = 0; qb < 2; ++qb) {
    const int tok = tok0 + wid * 32 + qb * 16 + fr;
    float mul, sub;
    if (MODE == 0) {
      float lt = lrow[qb]; lt += __shfl_xor(lt, 16); lt += __shfl_xor(lt, 32);
      mul = 1.f / lt; sub = 0.f;
    } else {
      float sm = 0.f;
#pragma unroll
      for (int vb = 0; vb < NVB; ++vb) sm += (o[vb][qb][0] + o[vb][qb][1]) + (o[vb][qb][2] + o[vb][qb][3]);
      sm += __shfl_xor(sm, 16); sm += __shfl_xor(sm, 32);
      const float mu = sm * (1.f / 128.f);
      float vs = 0.f;
#pragma unroll
      for (int vb = 0; vb < NVB; ++vb)
#pragma unroll
        for (int r = 0; r < 4; ++r) { const float dd = o[vb][qb][r] - mu; vs += dd * dd; }
      vs += __shfl_xor(vs, 16); vs += __shfl_xor(vs, 32);
      mul = rsqrtf(vs * (1.f / 128.f) + EPSN); sub = mu;
    }
#pragma unroll
    for (int vb = 0; vb < NVB; ++vb) {
      bf16_t* gp = G + (size_t)tok * 512 + h * (NVB * 16) + vb * 16 + fq * 4;
      const u32x2 gz = *(const u32x2*)gp;
      f32x4 y;
      y[0] = (o[vb][qb][0] - sub) * mul * bflo(gz.x); y[1] = (o[vb][qb][1] - sub) * mul * bfhi(gz.x);
      y[2] = (o[vb][qb][2] - sub) * mul * bflo(gz.y); y[3] = (o[vb][qb][3] - sub) * mul * bfhi(gz.y);
      *(unsigned*)(ws + O_BR8 + (size_t)(MODE == 0 ? 1 : 0) * NTOK * 512 + (size_t)tok * 512 + h * (NVB * 16) + vb * 16 + fq * 4) = pk4f8(y[0] * 8.f, y[1] * 8.f, y[2] * 8.f, y[3] * 8.f);
    }
  }
}

__device__ __forceinline__ bf16x8 scale8(u32x4 raw, const float (&d)[8]) {
  u32x4 w;
  w.x = pk2(bflo(raw.x) * d[0], bfhi(raw.x) * d[1]); w.y = pk2(bflo(raw.y) * d[2], bfhi(raw.y) * d[3]);
  w.z = pk2(bflo(raw.z) * d[4], bfhi(raw.z) * d[5]); w.w = pk2(bflo(raw.w) * d[6], bfhi(raw.w) * d[7]);
  return as_bf8(w);
}
__device__ __forceinline__ void state_item(const Params& p, int l, int item) {
  const int tid = tidx(), lane = tid & 63, wid = tid >> 6, fr = lane & 15, fq = lane >> 4;
  const int b = item >> 2, h = item & 3;
  const bf16_t* RVT = (const bf16_t*)(p.ws + O_RVT) + (size_t)(b * 4 + h) * 128 * 256;
  const bf16_t* RKT = (const bf16_t*)(p.ws + O_RKT) + (size_t)(b * 4 + h) * 64 * 256;
  const float xf = p.ret_logit[(l * 2 + 0) * 4 + h], xb = p.ret_logit[(l * 2 + 1) * 4 + h];
  const float lgf = -log1pf(expf(-xf)) * 1.44269504089f, lgb = -log1pf(expf(-xb)) * 1.44269504089f;
  f32x4 acc[2][2][4];
#pragma unroll
  for (int d = 0; d < 2; ++d)
#pragma unroll
    for (int v = 0; v < 2; ++v)
#pragma unroll
      for (int k = 0; k < 4; ++k) acc[d][v][k] = (f32x4){0.f, 0.f, 0.f, 0.f};
#pragma unroll 2
  for (int ks = 0; ks < 8; ++ks) {
    const int j0 = ks * 32 + fq * 8;
    float df[8], db[8];
#pragma unroll
    for (int e = 0; e < 8; ++e) { df[e] = exp2f((float)(255 - j0 - e) * lgf); db[e] = exp2f((float)(j0 + e) * lgb); }
    bf16x8 af[2];
#pragma unroll
    for (int v = 0; v < 2; ++v) af[v] = *(const bf16x8*)(RVT + (size_t)((wid * 2 + v) * 16 + fr) * 256 + j0);
#pragma unroll
    for (int k = 0; k < 4; ++k) {
      const u32x4 raw = *(const u32x4*)(RKT + (size_t)(k * 16 + fr) * 256 + j0);
      const bf16x8 kf = scale8(raw, df), kb = scale8(raw, db);
#pragma unroll
      for (int v = 0; v < 2; ++v) { acc[0][v][k] = mfma16(af[v], kf, acc[0][v][k]); acc[1][v][k] = mfma16(af[v], kb, acc[1][v][k]); }
    }
  }
  float* O = p.out + OUT_RET;
#pragma unroll
  for (int d = 0; d < 2; ++d)
#pragma unroll
    for (int v = 0; v < 2; ++v)
#pragma unroll
      for (int k = 0; k < 4; ++k) {
        const int dk = k * 16 + fr, vd = (wid * 2 + v) * 16 + fq * 4;
        *(f32x4*)(O + ((size_t)((((b * 2 + l) * 2 + d) * 4 + h) * 64 + dk)) * 128 + vd) = acc[d][v][k];
      }
}

__device__ __forceinline__ void keyprep_item(const Params& p, int l, int item) {
  const int tid = tidx(), lane = tid & 63, wid = tid >> 6;
  char* ws = wsp(p.ws);
  unsigned char* CKVA = (unsigned char*)(ws + O_CKVA);
  bf16_t* KRA = (bf16_t*)(ws + O_KRA);
#pragma unroll
  for (int i = 0; i < 4; ++i) {
    const int R = item * 16 + wid * 4 + i;
    int smp = 0, b, t = 0, tok = 0, ctx = 0, pp = 0;
    if (R < NPR) { tok = R; b = R >> 8; t = R & 255; }
    else { smp = 1; const int s = R - NPR; b = s / 1536; pp = s - b * 1536; if (pp < 512) ctx = 1; else { t = pp - 512; tok = NPR + b * 1024 + t; } }
    if (ctx) {
      const f32x4 v = *(const f32x4*)(p.cache_ckv + ((size_t)((b * 2 + l) * 512 + pp)) * 256 + lane * 4);
      *(unsigned*)(CKVA + (size_t)R * 256 + lane * 4) = pk4f8(v[0] * 4.f, v[1] * 4.f, v[2] * 4.f, v[3] * 4.f);
      if (lane < 32) KRA[(size_t)R * 32 + lane] = tobf(p.cache_krope[((size_t)((b * 2 + l) * 512 + pp)) * 32 + lane]);
      continue;
    }
    const f32x4 v = *(const f32x4*)((const float*)(ws + O_KVLAT) + (size_t)tok * 256 + lane * 4);
    float ss = v[0] * v[0] + v[1] * v[1] + v[2] * v[2] + v[3] * v[3];
    ss = wave_sum(ss);
    const float rstd = rsqrtf(ss * (1.f / 256.f) + EPSN);
    const f32x4 g = *(const f32x4*)(p.kv_norm_g + l * 256 + lane * 4);
    f32x4 y;
#pragma unroll
    for (int e = 0; e < 4; ++e) y[e] = v[e] * rstd * g[e];
    *(unsigned*)(CKVA + (size_t)R * 256 + lane * 4) = pk4f8(y[0] * 4.f, y[1] * 4.f, y[2] * 4.f, y[3] * 4.f);
    if (!smp) *(f32x4*)(p.out + OUT_CKV + ((size_t)((b * 2 + l) * 256 + t)) * 256 + lane * 4) = y;
    const int d = lane & 31;
    const float x = ((const float*)(ws + O_KR))[(size_t)tok * 32 + d];
    float yk = x;
    if (smp) {
      const float pr = __shfl_xor(x, 8);
      const int hd = d >> 4, i16 = d & 15, f = i16 & 7;
      const int pos = hd ? (t & 63) : (t >> 6);
      const float* rt = (const float*)(ws + O_ROPE) + (pos * 8 + f) * 2;
      const float cs = rt[0], sn = rt[1];
      yk = i16 < 8 ? x * cs - pr * sn : pr * sn + x * cs;
    } else if (lane < 32) {
      p.out[OUT_KR + ((size_t)((b * 2 + l) * 256 + t)) * 32 + d] = x;
    }
    if (lane < 32) KRA[(size_t)R * 32 + d] = tobf(yk);
  }
}

__device__ __forceinline__ void f1_tile(const Params& p, int tile, char* lds) {
  const int tid = tidx(), lane = tid & 63, wid = tid >> 6, wm = wid >> 1, wn = wid & 1, fr = lane & 15, fq = lane >> 4;
  const int m = tile >> 3, g = (tile >> 1) & 3, nh = tile & 1, m0 = m * 128;
  char* ws = wsp(p.ws);
  f32x4 acc[4][4];
  zero_acc(acc);
  gemm_core<false>((const bf16_t*)(ws + O_FU) + (size_t)m0 * 512 + g * 128, 512, (const bf16_t*)(ws + O_CS) + (size_t)nh * 128 * 128, 128, 128, acc, lds);
  unsigned char* UT = (unsigned char*)(ws + O_UT);
#pragma unroll
  for (int i = 0; i < 4; ++i) {
    const int tok = m0 + wm * 64 + i * 16 + fq * 4;
    size_t base; int T, b, t;
    if (tok < NPR) { b = tok >> 8; t = tok & 255; T = 256; base = 0; } else { const int s = tok - NPR; b = s >> 10; t = s & 1023; T = 1024; base = (size_t)NPR * 1024; }
#pragma unroll
    for (int j = 0; j < 4; ++j) {
      const int k2 = wn * 64 + j * 16 + fr;
      *(unsigned*)(UT + base + ((size_t)(b * 4 + g) * 128 + k2) * (2 * T) + nh * T + t) = pk4f8(acc[i][j][0] * 4.f, acc[i][j][1] * 4.f, acc[i][j][2] * 4.f, acc[i][j][3] * 4.f);
    }
  }
}

__device__ __forceinline__ void qup_tile(const Params& p, int l, int tile, char* lds) {
  const int tid = tidx(), lane = tid & 63, wid = tid >> 6, wm = wid >> 1, wn = wid & 1, fr = lane & 15, fq = lane >> 4;
  const int m = tile % 96, nt = tile / 96, m0 = m * 128, n0 = nt * 128;
  char* ws = wsp(p.ws);
  const char* QL = (const char*)(ws + O_QLAT) + (size_t)m0 * 384;
  float rsv4[4];
  {
    float* rs = (float*)lds;
    __syncthreads();
#pragma unroll 1
    for (int r0 = 0; r0 < 32; r0 += 4) {
      float ss[4];
#pragma unroll
      for (int u = 0; u < 4; ++u) {
        u32x4 w = (u32x4){0u, 0u, 0u, 0u};
        if (lane < 24) w = ldg16(QL + (size_t)(wid * 32 + r0 + u) * 384 + lane * 16);
        float a = 0.f;
#pragma unroll
        for (int q = 0; q < 4; ++q) {
          const float f0 = __builtin_amdgcn_cvt_f32_fp8(w[q], 0), f1 = __builtin_amdgcn_cvt_f32_fp8(w[q], 1), f2 = __builtin_amdgcn_cvt_f32_fp8(w[q], 2), f3 = __builtin_amdgcn_cvt_f32_fp8(w[q], 3);
          a += f0 * f0 + f1 * f1 + f2 * f2 + f3 * f3;
        }
        ss[u] = a;
      }
#pragma unroll
      for (int u = 0; u < 4; ++u) { const float t = wave_sum(ss[u]); if (lane == 0) rs[wid * 32 + r0 + u] = rsqrtf(t * (1.f / (384.f * 64.f)) + EPSN); }
    }
    __syncthreads();
#pragma unroll
    for (int i = 0; i < 4; ++i) rsv4[i] = rs[wm * 64 + i * 16 + fr];
    __syncthreads();
  }
  f32x4 acc[4][4];
  zero_acc(acc);
  { int par = 0; gemm_bytes<true, 4, 1, true>(QL, 384, (const char*)(ws + O_WQ) + ((size_t)l * 768 + n0) * 384, 384, 384, acc, lds, par, false, nullptr, 0, nullptr, 0); }
  bf16_t* QB = (bf16_t*)(ws + O_QB);
  const float qscale = 0.10206207261596577f * 1.44269504089f * (1.f / 256.f);
#pragma unroll
  for (int i = 0; i < 4; ++i) {
    const int rl = wm * 64 + i * 16 + fr, tok = m0 + rl;
    const float sc = rsv4[i] * qscale;
    const int smp = tok >= NPR, t = (tok - NPR) & 1023;
#pragma unroll
    for (int j = 0; j < 4; ++j) {
      const int cb = n0 + wn * 64 + j * 16, within = cb % 96;
      f32x4 v = acc[i][j] * sc;
      if (within >= 64) {
        f32x4 pr;
#pragma unroll
        for (int e = 0; e < 4; ++e) pr[e] = __shfl_xor(v[e], 32);
        if (smp) {
          const int pos = within >= 80 ? (t & 63) : (t >> 6);
          const float* rt = (const float*)(ws + O_ROPE) + (pos * 8 + (fq & 1) * 4) * 2;
          const f32x4 c01 = *(const f32x4*)rt, c23 = *(const f32x4*)(rt + 4);
          const float cs4[4] = {c01[0], c01[2], c23[0], c23[2]}, sn4[4] = {c01[1], c01[3], c23[1], c23[3]};
#pragma unroll
          for (int e = 0; e < 4; ++e) v[e] = fq < 2 ? v[e] * cs4[e] - pr[e] * sn4[e] : pr[e] * sn4[e] + v[e] * cs4[e];
        }
      }
      *(u32x2*)(QB + (size_t)tok * 768 + cb + fq * 4) = pk4(v);
    }
  }
}

__device__ __forceinline__ void kvup_tile(const Params& p, int l, int tile, char* lds) {
  const int tid = tidx(), lane = tid & 63, wid = tid >> 6, wm = wid >> 1, wn = wid & 1, fr = lane & 15, fq = lane >> 4;
  const int m = tile % 112, nt = tile / 112, m0 = m * 128, n0 = nt * 128;
  char* ws = wsp(p.ws);
  const char* A = (const char*)(ws + O_CKVA) + (size_t)m0 * 256;
  const char* B = (const char*)(ws + O_WKV) + ((size_t)l * 1024 + n0) * 256;
  const float ks = 1.f / 128.f;
  f32x4 acc[4][4];
  zero_acc(acc);
  if (nt < 4) {
    { int par = 0; gemm_bytes<true, 4, 1, true>(A, 256, B, 256, 256, acc, lds, par, false, nullptr, 0, nullptr, 0); }
    bf16_t* KB = (bf16_t*)(ws + O_KB);
#pragma unroll
    for (int i = 0; i < 4; ++i) {
      const int R = m0 + wm * 64 + i * 16 + fr;
#pragma unroll
      for (int j = 0; j < 4; ++j) *(u32x2*)(KB + (size_t)R * 512 + n0 + wn * 64 + j * 16 + fq * 4) = pk4(acc[i][j] * ks);
    }
  } else {
    { int par = 0; gemm_bytes<false, 4, 1, true>(A, 256, B, 256, 256, acc, lds, par, false, nullptr, 0, nullptr, 0); }
    bf16_t* VT = (bf16_t*)(ws + O_VT);
#pragma unroll
    for (int i = 0; i < 4; ++i) {
      const int R = m0 + wm * 64 + i * 16 + fq * 4;
      size_t base; int Tk, b, k;
      if (R < NPR) { b = R >> 8; k = R & 255; Tk = 256; base = 0; } else { const int s = R - NPR; b = s / 1536; k = s - b * 1536; Tk = 1536; base = (size_t)NPR * 512; }
#pragma unroll
      for (int j = 0; j < 4; ++j) {
        const int c = n0 - 512 + wn * 64 + j * 16 + fr, h = c >> 6, vd = c & 63;
        *(u32x2*)(VT + base + ((size_t)(b * 8 + h) * 64 + vd) * Tk + k) = pk4(acc[i][j] * ks);
      }
    }
  }
}

template <int NJ>
__device__ __forceinline__ void f2_tile(const Params& p, int tile, char* lds) {
  const int tid = tidx(), lane = tid & 63, wid = tid >> 6, wm = wid >> 1, wn = wid & 1, fr = lane & 15, fq = lane >> 4;
  char* ws = wsp(p.ws);
  const char *A, *B; int K, tokb, g, nh = 0; float scale;
  if (NJ == 2) {
    const int b = tile >> 6, mt = (tile >> 1) & 7; g = (tile >> 4) & 3; nh = tile & 1;
    A = (const char*)(ws + O_D1024) + (size_t)mt * 128 * 2048; K = 2048;
    B = (const char*)(ws + O_UT) + (size_t)NPR * 1024 + ((size_t)(b * 4 + g) * 128 + nh * 64) * 2048;
    tokb = NPR + b * 1024 + mt * 128; scale = 0.00276213586400995f * (1.f / 256.f);
  } else {
    const int b = tile >> 3, mt = tile & 1; g = (tile >> 1) & 3;
    A = (const char*)(ws + O_D256) + (size_t)mt * 128 * 512; K = 512;
    B = (const char*)(ws + O_UT) + (size_t)(b * 4 + g) * 128 * 512;
    tokb = b * 256 + mt * 128; scale = 0.0055242717280199f * (1.f / 256.f);
  }
  f32x4 acc[4][NJ];
#pragma unroll
  for (int i = 0; i < 4; ++i)
#pragma unroll
    for (int j = 0; j < NJ; ++j) acc[i][j] = (f32x4){0.f, 0.f, 0.f, 0.f};
  { int par = 0; gemm_bytes<true, NJ, 1, true>(A, K, B, K, K, acc, lds, par, false, nullptr, 0, nullptr, 0); }
  bf16_t* FZ = (bf16_t*)(ws + O_FZ);
#pragma unroll
  for (int i = 0; i < 4; ++i) {
    const int tok = tokb + wm * 64 + i * 16 + fr;
#pragma unroll
    for (int j = 0; j < NJ; ++j) {
      bf16_t* gp = FZ + (size_t)tok * 512 + g * 128 + nh * 64 + wn * (NJ * 16) + j * 16 + fq * 4;
      const u32x2 gz = *(const u32x2*)gp;
      f32x4 y;
      y[0] = acc[i][j][0] * scale * bflo(gz.x); y[1] = acc[i][j][1] * scale * bfhi(gz.x);
      y[2] = acc[i][j][2] * scale * bflo(gz.y); y[3] = acc[i][j][3] * scale * bfhi(gz.y);
      *(unsigned*)(ws + O_BR8 + (size_t)2 * NTOK * 512 + (size_t)tok * 512 + g * 128 + nh * 64 + wn * (NJ * 16) + j * 16 + fq * 4) = pk4f8(y[0] * 8.f, y[1] * 8.f, y[2] * 8.f, y[3] * 8.f);
    }
  }
}

template <int NJ>
__device__ __forceinline__ void s6_tile(const Params& p, int l, int tile, int ntile, char* lds, int& par, bool& primed) {
  const int tid = tidx(), lane = tid & 63, wid = tid >> 6, wm = wid >> 1, wn = wid & 1, fr = lane & 15, fq = lane >> 4;
  constexpr int NT = 32 / NJ, BN = NJ * 32;
  const int m = (tile / (32 * NT)) * 32 + (tile % 32), nt = (tile % (32 * NT)) / 32, m0 = m * 128, n0 = nt * BN;
  char* ws = wsp(p.ws);
  const char* H8 = (const char*)(ws + O_H8);
  const char* W8 = (const char*)(ws + O_WG8) + (size_t)l * 3072 * 1024;
  const char* Wb = (const char*)(ws + O_WBR) + (size_t)(l * 3) * 1024 * 512;
  f32x4 tot[4][NJ], acc[4][NJ];
  unsigned sg[4][NJ];
#pragma unroll
  for (int i = 0; i < 4; ++i)
#pragma unroll
    for (int j = 0; j < NJ; ++j) tot[i][j] = (f32x4){0.f, 0.f, 0.f, 0.f};
#pragma unroll 1
  for (int nb = 0; nb < 3; ++nb) {
    u32x2 totp[4][NJ];
#pragma unroll
    for (int i = 0; i < 4; ++i)
#pragma unroll
      for (int j = 0; j < NJ; ++j) { totp[i][j] = pk4(tot[i][j]); acc[i][j] = (f32x4){0.f, 0.f, 0.f, 0.f}; }
    const char* brA = (const char*)(ws + O_BR8) + ((size_t)nb * NTOK + m0) * 512;
    const char* brB = Wb + ((size_t)nb * 1024 + n0) * 512;
    gemm_bytes<true, NJ, 2, true>(H8 + (size_t)m0 * 1024, 1024, W8 + ((size_t)nb * 1024 + n0) * 1024, 1024, 1024, acc, lds, par, primed, brA, 512, brB, 512);
#pragma unroll
    for (int i = 0; i < 4; ++i)
#pragma unroll
      for (int j = 0; j < NJ; ++j) {
        unsigned q = 0;
#pragma unroll
        for (int e = 0; e < 4; ++e) {
          const unsigned qe = (unsigned)fmaxf(sigm_f(acc[i][j][e] * 0.03125f) * 255.f + 0.5f, 1.f);
          q |= qe << (8 * e);
          tot[i][j][e] = (e == 0 ? bflo(totp[i][j].x) : e == 1 ? bfhi(totp[i][j].x) : e == 2 ? bflo(totp[i][j].y) : bfhi(totp[i][j].y)) * __builtin_amdgcn_rcpf((float)qe * (1.f / 255.f));
        }
        sg[i][j] = q;
      }
    const char *nA = nullptr, *nB = nullptr;
    if (nb < 2) { nA = H8 + (size_t)m0 * 1024; nB = W8 + ((size_t)(nb + 1) * 1024 + n0) * 1024; }
    else if (ntile >= 0) { nA = H8 + (size_t)(((ntile / (32 * NT)) * 32 + (ntile % 32)) * 128) * 1024; nB = W8 + (size_t)(((ntile % (32 * NT)) / 32) * BN) * 1024; }
    gemm_bytes<true, NJ, 2, true>(brA, 512, brB, 512, 512, tot, lds, par, true, nA, 1024, nB, 1024);
    primed = nA != nullptr;
#pragma unroll
    for (int i = 0; i < 4; ++i)
#pragma unroll
      for (int j = 0; j < NJ; ++j) {
        tot[i][j][0] *= (float)(sg[i][j] & 0xffu) * (1.f / 255.f); tot[i][j][1] *= (float)((sg[i][j] >> 8) & 0xffu) * (1.f / 255.f);
        tot[i][j][2] *= (float)((sg[i][j] >> 16) & 0xffu) * (1.f / 255.f); tot[i][j][3] *= (float)(sg[i][j] >> 24) * (1.f / 255.f);
      }
  }
  unsigned char* MG = (unsigned char*)(ws + O_UT);
#pragma unroll
  for (int i = 0; i < 4; ++i) {
    const int tok = m0 + wm * 64 + i * 16 + fr;
#pragma unroll
    for (int j = 0; j < NJ; ++j) *(unsigned*)(MG + (size_t)tok * 1024 + n0 + wn * (NJ * 16) + j * 16 + fq * 4) = pk4f8(tot[i][j][0] * (1.f / 256.f), tot[i][j][1] * (1.f / 256.f), tot[i][j][2] * (1.f / 256.f), tot[i][j][3] * (1.f / 256.f));
  }
}

__device__ __forceinline__ void s7_tile(const Params& p, int l, int tile, const float* xp, const float* xs, char* lds) {
  const int tid = tidx(), lane = tid & 63, wid = tid >> 6, wm = wid >> 1, wn = wid & 1, fr = lane & 15, fq = lane >> 4;
  const int m = (tile / 512) * 32 + (tile % 32), nt = (tile % 512) / 32, m0 = m * 128, n0 = nt * 64;
  char* ws = wsp(p.ws);
  f32x4 acc[4][2];
#pragma unroll
  for (int i = 0; i < 4; ++i) { acc[i][0] = (f32x4){0.f, 0.f, 0.f, 0.f}; acc[i][1] = (f32x4){0.f, 0.f, 0.f, 0.f}; }
  { int par = 0; gemm_bytes<true, 2, 1, true>((const char*)(ws + O_UT) + (size_t)m0 * 1024, 1024, (const char*)(ws + O_WO) + ((size_t)l * 1024 + n0) * 1024, 1024, 1024, acc, lds, par, false, nullptr, 0, nullptr, 0); }
#pragma unroll
  for (int i = 0; i < 4; ++i) {
    const int tok = m0 + wm * 64 + i * 16 + fr;
    const float* src = tok < NPR ? xp + (size_t)tok * 1024 : xs + (size_t)(tok - NPR) * 1024;
    const int v = tok < NPR ? 0 : 1 + ((tok - NPR) >> 10);
    const float* gate = (const float*)(ws + O_MOD) + (l * 5 + v) * 3072 + 2048;
#pragma unroll
    for (int j = 0; j < 2; ++j) {
      const int col = n0 + wn * 32 + j * 16 + fq * 4;
      const f32x4 x = *(const f32x4*)(src + col), gt = *(const f32x4*)(gate + col);
      f32x4 y;
#pragma unroll
      for (int e = 0; e < 4; ++e) y[e] = x[e] + gt[e] * (acc[i][j][e] * 0.03125f);
      *(f32x4*)(p.out + (size_t)tok * 1024 + col) = y;
    }
  }
}

constexpr int NPHASE = 16;
__device__ __forceinline__ int q_issue(unsigned* ctr) {
  int v = 0;
  if (threadIdx.x == 0) v = (int)__hip_atomic_fetch_add(ctr, 1u, __ATOMIC_RELAXED, __HIP_MEMORY_SCOPE_AGENT);
  return v;
}
__device__ __forceinline__ int q_bcast(int v, char* lds) {
  __syncthreads();
  if (threadIdx.x == 0) *(volatile int*)lds = v;
  __syncthreads();
  const int it = *(volatile int*)lds;
  __syncthreads();
  return it;
}
__device__ __forceinline__ void run_phase(const Params& p, int ph, char* lds, unsigned* qctr) {
  const int bid = blockIdx.x, nb = gridDim.x;
  if (ph == 0) { for (int i = bid; i < P0_N; i += nb) phase0_item(p, i, lds); return; }
  if (ph == 15) { for (int i = bid; i < 512; i += nb) final_item(p, i); return; }
  const int l = (ph - 1) / 7, s = (ph - 1) % 7;
  const float* xp = l == 0 ? p.x_prompt : p.out;
  const float* xs = l == 0 ? p.x_sample : p.out + (size_t)NPR * 1024;
  switch (s) {
    case 0: for (int i = bid; i < 512; i += nb) norm_item(p, l, i, xp, xs); break;
    case 1: for (int i = bid; i < 2880; i += nb) s2_tile(p, l, i, lds); break;
    case 2:
      for (int i = bid; i < 2752;) {
        if (i < 128) attn_item<1>(p, l, i, lds);
        else if (i < 1024) keyprep_item(p, l, i - 128);
        else if (i < 1280) attn_item<1>(p, l, 128 + (i - 1024), lds);
        else if (i < 1408) state_item(p, l, i - 1280);
        else if (i < 1984) qup_tile(p, l, i - 1408, lds);
        else f1_tile(p, i - 1984, lds);
        i = nb + q_bcast(q_issue(qctr + ph), lds);
      }
      break;
    case 3:
      for (int i = bid; i < 1408;) {
        if (i < 256) f2_tile<2>(p, i, lds);
        else if (i < 512) f2_tile<4>(p, i - 256, lds);
        else kvup_tile(p, l, i - 512, lds);
        i = nb + q_bcast(q_issue(qctr + ph), lds);
      }
      break;
    case 4:
      for (int i = bid; i < 768;) {
        attn_item<0>(p, l, i, lds);
        i = nb + q_bcast(q_issue(qctr + ph), lds);
      }
      break;
    case 5: { int par = 0; bool primed = false; for (int i = bid; i < 768; i += nb) s6_tile<4>(p, l, i, (i + nb < 768) ? i + nb : -1, lds, par, primed); } break;
    case 6: for (int i = bid; i < 1536; i += nb) s7_tile(p, l, i, xp, xs, lds); break;
  }
}

#define XB_TMO      128
#define XB_XCNT(j)  (256  + 64 * (j))
#define XB_XSUB(j)  (1280 + 64 * (j))
#define XB_XGEN(j)  (2304 + 64 * (j))
#define XB_TOP      3328
#define XB_TOPGEN   3392
#define XCD_BAR_WORDS 3456
#define XB_SPIN_CAP (1u << 18)
__device__ __forceinline__ unsigned xb_ld(unsigned* p)              { return __hip_atomic_load(p, __ATOMIC_RELAXED, __HIP_MEMORY_SCOPE_AGENT); }
__device__ __forceinline__ unsigned xb_add(unsigned* p, unsigned v) { return __hip_atomic_fetch_add(p, v, __ATOMIC_RELAXED, __HIP_MEMORY_SCOPE_AGENT); }
__device__ __forceinline__ unsigned xb_xcc_id() { return (unsigned)__builtin_amdgcn_s_getreg((3 << 11) | 20) & 0xFu; }
#define XB_SPIN(cond, bar) do { unsigned _sp = 0; while (cond) { __builtin_amdgcn_s_sleep(1); \
    if ((++_sp & 255u) == 0u) { if (xb_ld(&(bar)[XB_TMO])) break; if (_sp > XB_SPIN_CAP) { atomicAdd(&(bar)[XB_TMO], 1u); break; } } } } while (0)
__device__ __forceinline__ void xcd_barrier_complete(unsigned* bar, unsigned x, unsigned& nloc, unsigned& nx) {
  const unsigned G = gridDim.x;
  unsigned sum, cnt, mine, sp = 0u;
  for (;;) {
    sum = 0u; cnt = 0u; mine = 0u;
#pragma unroll
    for (unsigned j = 0; j < 16; ++j) { const unsigned c = xb_ld(&bar[XB_XCNT(j)]); sum += c; cnt += (c > 0u) ? 1u : 0u; mine = (j == x) ? c : mine; }
    if (sum == G) break;
    __builtin_amdgcn_s_sleep(1);
    if ((++sp & 255u) == 0u) { if (xb_ld(&bar[XB_TMO])) break; if (sp > XB_SPIN_CAP) { atomicAdd(&bar[XB_TMO], 1u); break; } }
  }
  nloc = mine > 0u ? mine : 1u; nx = cnt > 0u ? cnt : 1u;
}
__device__ __forceinline__ void xcd_barrier(unsigned* bar, unsigned x, unsigned& nloc, unsigned& nx) {
  asm volatile("s_waitcnt vmcnt(0)" ::: "memory");
  __syncthreads();
  if (threadIdx.x == 0) {
    __builtin_amdgcn_s_waitcnt(0);
    if (nloc == 0u) xcd_barrier_complete(bar, x, nloc, nx);
    const unsigned old = xb_add(&bar[XB_XSUB(x)], 1u);
    const unsigned gen = old / nloc;
    if (old + 1u == (gen + 1u) * nloc) {
      __builtin_amdgcn_fence(__ATOMIC_RELEASE, "agent");
      asm volatile("s_waitcnt vmcnt(0)" ::: "memory");
      const unsigned og = xb_add(&bar[XB_TOP], 1u);
      const unsigned tg = og / nx;
      if (og + 1u == (tg + 1u) * nx) xb_add(&bar[XB_TOPGEN], 1u);
      else XB_SPIN(xb_ld(&bar[XB_TOPGEN]) == tg, bar);
      __builtin_amdgcn_fence(__ATOMIC_ACQUIRE, "agent");
      xb_add(&bar[XB_XGEN(x)], 1u);
      asm volatile("s_waitcnt vmcnt(0)" ::: "memory");
    } else {
      XB_SPIN(xb_ld(&bar[XB_XGEN(x)]) == gen, bar);
      __builtin_amdgcn_fence(__ATOMIC_ACQUIRE, "agent");
      asm volatile("s_waitcnt vmcnt(0)" ::: "memory");
    }
  }
  __syncthreads();
}

__global__ void __launch_bounds__(256, 2) mk_fwd(Params p) {
  __shared__ __attribute__((aligned(16))) char lds[LDS_TOTAL];
  cg::grid_group grid = cg::this_grid();
  unsigned* bar = (unsigned*)(p.ws + O_BAR);
  const unsigned xcc = xb_xcc_id();
  if (threadIdx.x == 0) (void)xb_add(&bar[XB_XCNT(xcc)], 1u);
  unsigned nloc = 0u, nx = 0u;
  if (gridDim.x == 0x7fffffffu) grid.sync();
#pragma unroll 1
  for (int ph = 0; ph < NPHASE; ++ph) {
    run_phase(p, ph, lds, bar);
    if (ph + 1 < NPHASE) xcd_barrier(bar, xcc, nloc, nx);
  }
}

extern "C" void kernel_launch(void* const* d_in, const int* in_sizes, int n_in, void* d_out, int out_size, void* d_ws, size_t ws_size,
                              hipStream_t stream) {
  Params p{};
  p.x_prompt = (const float*)d_in[0]; p.x_sample = (const float*)d_in[1]; p.cache_ckv = (const float*)d_in[2]; p.cache_krope = (const float*)d_in[3];
  p.state_ret = (const float*)d_in[4]; p.c = (const float*)d_in[5]; p.c_ctx = (const float*)d_in[6]; p.norm_g = (const float*)d_in[7];
  p.w_mod = (const float*)d_in[8]; p.b_mod = (const float*)d_in[9]; p.w_in = (const float*)d_in[10]; p.ret_logit = (const float*)d_in[11];
  p.q_norm_g = (const float*)d_in[12]; p.w_q_up = (const float*)d_in[13]; p.kv_norm_g = (const float*)d_in[14]; p.w_kv_up = (const float*)d_in[15];
  p.w_branch = (const float*)d_in[16]; p.w_out = (const float*)d_in[17]; p.final_g = (const float*)d_in[18];
  p.out = (float*)d_out; p.ws = (char*)d_ws;
#if ONE_LAUNCH
  static int grid_blocks = 0;
  if (!grid_blocks) {
    int dev = 0, cus = 0, per_cu = 0;
    hipGetDevice(&dev);
    hipDeviceGetAttribute(&cus, hipDeviceAttributeMultiprocessorCount, dev);
    hipOccupancyMaxActiveBlocksPerMultiprocessor(&per_cu, mk_fwd, 256, 0);
    if (per_cu > 2) per_cu = 2;
    grid_blocks = cus * per_cu;
  }
  hipMemsetAsync((char*)d_ws + O_BAR, 0, XCD_BAR_WORDS * 4, stream);
  void* args[] = {&p};
  hipError_t e = hipLaunchCooperativeKernel((void*)mk_fwd, dim3(grid_blocks), dim3(256), args, 0, stream);
  if (e != hipSuccess) fprintf(stderr, "cooperative launch failed: %s (grid %d)\n", hipGetErrorString(e), grid_blocks);
#endif
}
```

```cpp
#include <hip/hip_runtime.h>
#include <hip/hip_cooperative_groups.h>
#include <stdint.h>
#include <stdio.h>
namespace cg = cooperative_groups;

#ifndef ONE_LAUNCH
#define ONE_LAUNCH 1
#endif

typedef unsigned short bf16_t;
typedef short bf16x8 __attribute__((ext_vector_type(8)));
typedef float f32x4 __attribute__((ext_vector_type(4)));
typedef unsigned u32x4 __attribute__((ext_vector_type(4)));
typedef unsigned u32x2 __attribute__((ext_vector_type(2)));

constexpr int NTOK = 12288, NPR = 8192, NKEY = 14336;
constexpr float EPSN = 1e-6f;

constexpr size_t O_WIN   = 0;
constexpr size_t O_WQ    = O_WIN   + (size_t)2 * 6912 * 1024 * 2;
constexpr size_t O_WKV   = O_WQ    + (size_t)2 * 768 * 384 * 2;
constexpr size_t O_WBR   = O_WKV   + (size_t)2 * 1024 * 256 * 2;
constexpr size_t O_WO    = O_WBR   + (size_t)6 * 1024 * 512 * 2;
constexpr size_t O_CS    = O_WO    + (size_t)2 * 1024 * 1024 * 2;
constexpr size_t O_D256  = O_CS    + (size_t)256 * 128 * 2;
constexpr size_t O_D1024 = O_D256  + (size_t)256 * 512 * 2;
constexpr size_t O_S0T   = O_D1024 + (size_t)1024 * 2048 * 2;
constexpr size_t O_MOD   = O_S0T   + (size_t)64 * 128 * 64 * 2;
constexpr size_t O_H     = O_MOD   + (size_t)2 * 5 * 3072 * 4;
constexpr size_t O_BR8   = O_H;
constexpr size_t O_UT    = O_H     + (size_t)NTOK * 1024 * 2;
constexpr size_t O_RQ    = O_UT    + (size_t)NTOK * 1024 * 2;
constexpr size_t O_RK    = O_RQ    + (size_t)NTOK * 256 * 2;
constexpr size_t O_RKT   = O_RK    + (size_t)NTOK * 256 * 2;
constexpr size_t O_RVT   = O_RKT   + (size_t)NPR * 256 * 2;
constexpr size_t O_KVLAT = O_RVT   + (size_t)NTOK * 512 * 2;
constexpr size_t O_KR    = O_KVLAT + (size_t)NTOK * 256 * 4;
constexpr size_t O_R2END = O_KR    + (size_t)NTOK * 32 * 4;
constexpr size_t O_VT    = O_RQ;
static_assert(O_VT + (size_t)NKEY * 512 * 2 <= O_R2END, "alias overflow");
constexpr size_t O_RZ    = O_R2END;
constexpr size_t O_MZ    = O_RZ    + (size_t)NTOK * 512 * 2;
constexpr size_t O_FZ    = O_MZ    + (size_t)NTOK * 512 * 2;
constexpr size_t O_FU    = O_FZ    + (size_t)NTOK * 512 * 2;
constexpr size_t O_QLAT  = O_FU    + (size_t)NTOK * 512 * 2;
constexpr size_t O_CKVA  = O_QLAT  + (size_t)NTOK * 384 * 2;
constexpr size_t O_KB    = O_CKVA  + (size_t)NKEY * 256 * 2;
constexpr size_t O_KRA   = O_KB    + (size_t)NKEY * 512 * 2;
constexpr size_t O_QB    = O_KRA   + (size_t)NKEY * 32 * 2;
constexpr size_t O_H8    = O_QB    + (size_t)NTOK * 768 * 2;
constexpr size_t O_WG8   = O_H8    + (size_t)NTOK * 1024;
constexpr size_t O_WS8   = O_WG8   + (size_t)2 * 3072 * 1024;
constexpr size_t O_END   = O_WS8   + (size_t)2 * 1920 * 1024;
constexpr size_t O_ROPE  = (O_END + 255) & ~(size_t)255;
constexpr size_t O_BAR   = O_ROPE + 4096;
static_assert(O_BAR + 16384 <= (size_t)256 * 1024 * 1024, "workspace too large");

constexpr size_t OUT_CKV = (size_t)NTOK * 1024;
constexpr size_t OUT_KR  = OUT_CKV + (size_t)32 * 2 * 256 * 256;
constexpr size_t OUT_RET = OUT_KR + (size_t)32 * 2 * 256 * 32;

struct Params {
  const float *x_prompt, *x_sample, *cache_ckv, *cache_krope, *state_ret, *c, *c_ctx, *norm_g, *w_mod, *b_mod,
      *w_in, *ret_logit, *q_norm_g, *w_q_up, *kv_norm_g, *w_kv_up, *w_branch, *w_out, *final_g;
  float* out;
  char* ws;
};

constexpr int PANEL = 128 * 64;
constexpr int ABYTES = 2 * PANEL;
constexpr int STAGE = 2 * ABYTES;
constexpr int LDS_GEMM = 2 * STAGE;
constexpr int LDS_TOTAL = LDS_GEMM;
static_assert(LDS_TOTAL <= 65536, "static LDS");

typedef float f32x2 __attribute__((ext_vector_type(2)));
typedef __bf16 bf16x2v __attribute__((ext_vector_type(2)));
__device__ __forceinline__ unsigned pk2(float lo, float hi) { const f32x2 v = {lo, hi}; return __builtin_bit_cast(unsigned, __builtin_convertvector(v, bf16x2v)); }
__device__ __forceinline__ bf16_t tobf(float x) { return (bf16_t)(pk2(x, 0.f) & 0xffffu); }
typedef int v8i __attribute__((ext_vector_type(8)));
__device__ __forceinline__ float sat8(float x) { return __builtin_amdgcn_fmed3f(x, -448.f, 448.f); }
__device__ __forceinline__ unsigned pk4f8(float a, float b, float c, float d) { unsigned w = 0; a = sat8(a); b = sat8(b); c = sat8(c); d = sat8(d); w = __builtin_amdgcn_cvt_pk_fp8_f32(a, b, w, false); w = __builtin_amdgcn_cvt_pk_fp8_f32(c, d, w, true); return w; }
__device__ __forceinline__ float bflo(unsigned u) { return __uint_as_float(u << 16); }
__device__ __forceinline__ float bfhi(unsigned u) { return __uint_as_float(u & 0xffff0000u); }
__device__ __forceinline__ float ex2(float x) { return __builtin_amdgcn_exp2f(x); }
__device__ __forceinline__ float silu_f(float x) { return x / (1.f + __expf(-x)); }
__device__ __forceinline__ float sigm_f(float x) { return 1.f / (1.f + __expf(-x)); }
__device__ __forceinline__ u32x2 pk4(f32x4 v) { u32x2 r; r.x = pk2(v[0], v[1]); r.y = pk2(v[2], v[3]); return r; }
#define GAS __attribute__((address_space(1)))
#define LAS __attribute__((address_space(3)))
__device__ __forceinline__ u32x4 ldg16(const void* p) { return *(const GAS u32x4*)p; }
__device__ __forceinline__ int tidx() { int t = threadIdx.x; asm volatile("" : "+v"(t)); return t; }
__device__ __forceinline__ char* wsp(const char* w) { unsigned long long v = (unsigned long long)w; asm volatile("" : "+s"(v)); return (char*)v; }
__device__ __forceinline__ int swz(int r) { return (0 - ((r >> 2) & 3)) & 3; }
__device__ __forceinline__ float wave_sum(float v) {
#pragma unroll
  for (int o = 1; o < 64; o <<= 1) v += __shfl_xor(v, o);
  return v;
}
__device__ __forceinline__ f32x4 mfma16(bf16x8 a, bf16x8 b, f32x4 c) { return __builtin_amdgcn_mfma_f32_16x16x32_bf16(a, b, c, 0, 0, 0); }
__device__ __forceinline__ bf16x8 as_bf8(u32x4 v) { return __builtin_bit_cast(bf16x8, v); }

__device__ __forceinline__ void zero_acc(f32x4 (&acc)[4][4]) {
#pragma unroll
  for (int i = 0; i < 4; ++i)
#pragma unroll
    for (int j = 0; j < 4; ++j) acc[i][j] = (f32x4){0.f, 0.f, 0.f, 0.f};
}

template <bool SWAP, int NJ, int PIPE, bool F8>
__device__ __forceinline__ void gemm_bytes(const char* __restrict__ A, int lda, const char* __restrict__ B, int ldb, int Kb,
                                           f32x4 (&acc)[4][NJ], char* lds, int& par, bool primed,
                                           const char* nA, int nlda, const char* nB, int nldb) {
  const int tid = tidx(), lane = tid & 63, wm = (tid >> 6) >> 1, wn = (tid >> 6) & 1;
  const int wid = __builtin_amdgcn_readfirstlane(tid >> 6);
  const int fr = lane & 15, fq = lane >> 4;
  const int fa = (wm * 64 + fr) * 64 + ((fq ^ swz(fr)) << 4);
  const int fb = ABYTES + (wn * NJ * 16 + fr) * 64 + ((fq ^ swz(fr)) << 4);
  const int lrow = lane >> 2, lchunk = (lane & 3) ^ swz(lrow);
  constexpr int NBL = NJ / 2;
  const GAS char* gA = (const GAS char*)(A + (size_t)(wid * 32 + lrow) * lda + lchunk * 16);
  const GAS char* gB = (const GAS char*)(B + (size_t)(wid * NBL * 16 + lrow) * ldb + lchunk * 16);
  const size_t a16 = (size_t)16 * lda, b16 = (size_t)16 * ldb;
  LAS char* ldsA = (LAS char*)lds + wid * 2048;
  LAS char* ldsB = (LAS char*)lds + ABYTES + wid * NBL * 1024;
  const int nk = Kb >> 7;
#define GC_ISSUE(pa, pb, sa, sb, stage, kbyte) do { \
    _Pragma("unroll") for (int g = 0; g < 2; ++g) _Pragma("unroll") for (int pn = 0; pn < 2; ++pn) \
      __builtin_amdgcn_global_load_lds((const GAS unsigned*)((pa) + g * (sa) + (kbyte) + pn * 64), (LAS unsigned*)(ldsA + (stage) + pn * PANEL + g * 1024), 16, 0, 0); \
    _Pragma("unroll") for (int g = 0; g < NBL; ++g) _Pragma("unroll") for (int pn = 0; pn < 2; ++pn) \
      __builtin_amdgcn_global_load_lds((const GAS unsigned*)((pb) + g * (sb) + (kbyte) + pn * 64), (LAS unsigned*)(ldsB + (stage) + pn * PANEL + g * 1024), 16, 0, 0); \
  } while (0)
  if (!primed) {
    GC_ISSUE(gA, gB, a16, b16, par * STAGE, 0);
    asm volatile("s_waitcnt vmcnt(0)" ::: "memory");
    __syncthreads();
  }
#pragma unroll 1
  for (int kt = 0; kt < nk; ++kt) {
    char* cur = lds + par * STAGE;
    if (kt + 1 < nk) GC_ISSUE(gA, gB, a16, b16, (par ^ 1) * STAGE, (size_t)(kt + 1) * 128);
    else if (nA) {
      const GAS char* hA = (const GAS char*)(nA + (size_t)(wid * 32 + lrow) * nlda + lchunk * 16);
      const GAS char* hB = (const GAS char*)(nB + (size_t)(wid * NBL * 16 + lrow) * nldb + lchunk * 16);
      GC_ISSUE(hA, hB, (size_t)16 * nlda, (size_t)16 * nldb, (par ^ 1) * STAGE, 0);
    }
    __builtin_amdgcn_sched_barrier(0);
    if (F8 && PIPE == 1) {
      v8i av[4], bv[NJ];
#pragma unroll
      for (int i = 0; i < 4; ++i) {
        const u32x4 a0 = *(const u32x4*)(cur + fa + i * 1024), a1 = *(const u32x4*)(cur + PANEL + fa + i * 1024);
        av[i] = (v8i){(int)a0.x, (int)a0.y, (int)a0.z, (int)a0.w, (int)a1.x, (int)a1.y, (int)a1.z, (int)a1.w};
      }
#pragma unroll
      for (int j = 0; j < NJ; ++j) {
        const u32x4 b0 = *(const u32x4*)(cur + fb + j * 1024), b1 = *(const u32x4*)(cur + PANEL + fb + j * 1024);
        bv[j] = (v8i){(int)b0.x, (int)b0.y, (int)b0.z, (int)b0.w, (int)b1.x, (int)b1.y, (int)b1.z, (int)b1.w};
      }
      __builtin_amdgcn_sched_barrier(0);
#pragma unroll
      for (int i = 0; i < 4; ++i)
#pragma unroll
        for (int j = 0; j < NJ; ++j)
          acc[i][j] = SWAP ? __builtin_amdgcn_mfma_scale_f32_16x16x128_f8f6f4(bv[j], av[i], acc[i][j], 0, 0, 0, 0x7f7f7f7f, 0, 0x7f7f7f7f)
                           : __builtin_amdgcn_mfma_scale_f32_16x16x128_f8f6f4(av[i], bv[j], acc[i][j], 0, 0, 0, 0x7f7f7f7f, 0, 0x7f7f7f7f);
    } else if (F8) {
#pragma unroll
      for (int ih = 0; ih < 2; ++ih) {
        v8i av[2];
#pragma unroll
        for (int ii = 0; ii < 2; ++ii) {
          const u32x4 a0 = *(const u32x4*)(cur + fa + (ih * 2 + ii) * 1024), a1 = *(const u32x4*)(cur + PANEL + fa + (ih * 2 + ii) * 1024);
          av[ii] = (v8i){(int)a0.x, (int)a0.y, (int)a0.z, (int)a0.w, (int)a1.x, (int)a1.y, (int)a1.z, (int)a1.w};
        }
#pragma unroll
        for (int j = 0; j < NJ; ++j) {
          const u32x4 b0 = *(const u32x4*)(cur + fb + j * 1024), b1 = *(const u32x4*)(cur + PANEL + fb + j * 1024);
          const v8i bv = {(int)b0.x, (int)b0.y, (int)b0.z, (int)b0.w, (int)b1.x, (int)b1.y, (int)b1.z, (int)b1.w};
#pragma unroll
          for (int ii = 0; ii < 2; ++ii)
            acc[ih * 2 + ii][j] = SWAP ? __builtin_amdgcn_mfma_scale_f32_16x16x128_f8f6f4(bv, av[ii], acc[ih * 2 + ii][j], 0, 0, 0, 0x7f7f7f7f, 0, 0x7f7f7f7f)
                                       : __builtin_amdgcn_mfma_scale_f32_16x16x128_f8f6f4(av[ii], bv, acc[ih * 2 + ii][j], 0, 0, 0, 0x7f7f7f7f, 0, 0x7f7f7f7f);
        }
      }
    } else if (PIPE == 2) {
      bf16x8 af[2][4], bfr[NJ];
#pragma unroll
      for (int i = 0; i < 4; ++i) af[0][i] = *(const bf16x8*)(cur + fa + i * 1024);
#pragma unroll
      for (int j = 0; j < NJ; ++j) bfr[j] = *(const bf16x8*)(cur + fb + j * 1024);
#pragma unroll
      for (int i = 0; i < 4; ++i) af[1][i] = *(const bf16x8*)(cur + PANEL + fa + i * 1024);
      __builtin_amdgcn_sched_barrier(0);
#pragma unroll
      for (int i = 0; i < 4; ++i)
#pragma unroll
        for (int j = 0; j < NJ; ++j) acc[i][j] = SWAP ? mfma16(bfr[j], af[0][i], acc[i][j]) : mfma16(af[0][i], bfr[j], acc[i][j]);
#pragma unroll
      for (int j = 0; j < NJ; ++j) bfr[j] = *(const bf16x8*)(cur + PANEL + fb + j * 1024);
#pragma unroll
      for (int i = 0; i < 4; ++i)
#pragma unroll
        for (int j = 0; j < NJ; ++j) acc[i][j] = SWAP ? mfma16(bfr[j], af[1][i], acc[i][j]) : mfma16(af[1][i], bfr[j], acc[i][j]);
    } else if (PIPE == 1) {
      bf16x8 af[2][4], bfr[2][NJ];
#pragma unroll
      for (int ks = 0; ks < 2; ++ks) {
#pragma unroll
        for (int i = 0; i < 4; ++i) af[ks][i] = *(const bf16x8*)(cur + ks * PANEL + fa + i * 1024);
#pragma unroll
        for (int j = 0; j < NJ; ++j) bfr[ks][j] = *(const bf16x8*)(cur + ks * PANEL + fb + j * 1024);
      }
      __builtin_amdgcn_sched_barrier(0);
#pragma unroll
      for (int ks = 0; ks < 2; ++ks)
#pragma unroll
        for (int i = 0; i < 4; ++i)
#pragma unroll
          for (int j = 0; j < NJ; ++j) acc[i][j] = SWAP ? mfma16(bfr[ks][j], af[ks][i], acc[i][j]) : mfma16(af[ks][i], bfr[ks][j], acc[i][j]);
    } else {
#pragma unroll
      for (int ks = 0; ks < 2; ++ks) {
        bf16x8 af[4], bfr[NJ];
#pragma unroll
        for (int i = 0; i < 4; ++i) af[i] = *(const bf16x8*)(cur + ks * PANEL + fa + i * 1024);
#pragma unroll
        for (int j = 0; j < NJ; ++j) bfr[j] = *(const bf16x8*)(cur + ks * PANEL + fb + j * 1024);
#pragma unroll
        for (int i = 0; i < 4; ++i)
#pragma unroll
          for (int j = 0; j < NJ; ++j) acc[i][j] = SWAP ? mfma16(bfr[j], af[i], acc[i][j]) : mfma16(af[i], bfr[j], acc[i][j]);
      }
    }
    __builtin_amdgcn_sched_barrier(0);
    asm volatile("s_waitcnt vmcnt(0)" ::: "memory");
    __syncthreads();
    par ^= 1;
  }
#undef GC_ISSUE
}
template <bool SWAP, int NJ = 4, int PIPE = 1>
__device__ __forceinline__ void gemm_core(const bf16_t* __restrict__ A, int lda, const bf16_t* __restrict__ B, int ldb, int K,
                                          f32x4 (&acc)[4][NJ], char* lds, int& par, bool primed,
                                          const bf16_t* nA, int nlda, const bf16_t* nB, int nldb) {
  gemm_bytes<SWAP, NJ, PIPE, false>((const char*)A, lda * 2, (const char*)B, ldb * 2, K * 2, acc, lds, par, primed, (const char*)nA, nlda * 2, (const char*)nB, nldb * 2);
}
template <bool SWAP, int NJ = 4>
__device__ __forceinline__ void gemm_core(const bf16_t* __restrict__ A, int lda, const bf16_t* __restrict__ B, int ldb, int K,
                                          f32x4 (&acc)[4][NJ], char* lds) {
  int par = 0;
  gemm_core<SWAP, NJ>(A, lda, B, ldb, K, acc, lds, par, false, nullptr, 0, nullptr, 0);
}

__device__ __forceinline__ void tr_tile(const float* __restrict__ src, int lds_, int k0, int ns0, bf16_t* __restrict__ dst, int ldd, int nd0,
                                        const float* __restrict__ ksc, char* lds) {
  bf16_t* T = (bf16_t*)lds;
  const int tid = tidx();
  __syncthreads();
#pragma unroll
  for (int i = 0; i < 2; ++i) {
    const int kk = (tid >> 3) + 32 * i, nn4 = (tid & 7) * 4;
    const f32x4 v = *(const f32x4*)(src + (size_t)(k0 + kk) * lds_ + ns0 + nn4);
    const float s = ksc ? ksc[k0 + kk] : 1.f;
#pragma unroll
    for (int e = 0; e < 4; ++e) T[(nn4 + e) * 72 + kk] = tobf(v[e] * s);
  }
  __syncthreads();
  const int nn = tid >> 3, kc = (tid & 7) * 8;
  const u32x4 w = *(const u32x4*)(T + nn * 72 + kc);
  *(u32x4*)(dst + (size_t)(nd0 + nn) * ldd + k0 + kc) = w;
}

__device__ __forceinline__ void tr_tile2(const float* __restrict__ src, int lds_, int k0, int ns0, bf16_t* __restrict__ dst, int ldd, int nd0,
                                         const float* __restrict__ ksc, char* lds, unsigned char* dst8 = nullptr, int ld8 = 1024) {
  bf16_t* T = (bf16_t*)lds;
  unsigned char* T8 = (unsigned char*)lds + 8704;
  const int tid = tidx();
  __syncthreads();
  f32x4 v[4];
#pragma unroll
  for (int i = 0; i < 4; ++i) v[i] = __builtin_nontemporal_load((const GAS f32x4*)(src + (size_t)(k0 + (tid >> 3) + 32 * i) * lds_ + ns0 + (tid & 7) * 4));
#pragma unroll
  for (int i = 0; i < 4; ++i) {
    const int kk = (tid >> 3) + 32 * i, nn4 = (tid & 7) * 4;
    const float sc = ksc ? ksc[k0 + kk] : 1.f;
#pragma unroll
    for (int e = 0; e < 4; ++e) T[(nn4 + e) * 136 + kk] = tobf(v[i][e] * sc);
    if (dst8) {
#pragma unroll
      for (int e = 0; e < 4; ++e) T8[(nn4 + e) * 144 + kk] = (unsigned char)(__builtin_amdgcn_cvt_pk_fp8_f32(sat8(v[i][e] * sc * 32.f), 0.f, 0, false) & 0xff);
    }
  }
  __syncthreads();
  const int nn = tid >> 3, kc = (tid & 7) * 16;
  if (dst8) *(u32x4*)(dst8 + (size_t)nn * ld8 + k0 + kc) = *(const u32x4*)(T8 + nn * 144 + kc);
  if (!dst) return;
  const u32x4 w0 = *(const u32x4*)(T + nn * 136 + kc), w1 = *(const u32x4*)(T + nn * 136 + kc + 8);
  bf16_t* d = dst + (size_t)(nd0 + nn) * ldd + k0 + kc;
  *(u32x4*)d = w0; *(u32x4*)(d + 8) = w1;
}

constexpr int P0_GEMV = 192, P0_WIN = 3408, P0_WQ = 144, P0_WKV = 128, P0_WBR = 768, P0_WO = 512, P0_S0 = 256, P0_PAD = 96, P0_TAB = 1105;
constexpr int P0_N = P0_GEMV + P0_WIN + P0_WQ + P0_WKV + P0_WBR + P0_WO + P0_S0 + P0_PAD + P0_TAB;

__device__ __forceinline__ void phase0_item(const Params& p, int j, char* lds) {
  const int tid = tidx();
  char* ws = wsp(p.ws);
  if (j < P0_GEMV) {
    const int l = j / 96, cgi = j % 96;
    float* sv = (float*)lds;
    float* red = (float*)(lds + 20480);
    __syncthreads();
    for (int i = tid; i < 5120; i += 256) { const int v = i >> 10, k = i & 1023; const float x = (v == 0) ? p.c_ctx[k] : p.c[(v - 1) * 1024 + k]; sv[i] = silu_f(x); }
    __syncthreads();
    const int c4 = tid & 7, kg = tid >> 3;
    const float* w = p.w_mod + (size_t)l * 1024 * 3072 + cgi * 32 + c4 * 4;
    f32x4 a0 = {0.f, 0.f, 0.f, 0.f}, a1 = a0, a2 = a0, a3 = a0, a4 = a0;
#pragma unroll 8
    for (int k = kg * 32; k < kg * 32 + 32; ++k) {
      const f32x4 wv = __builtin_nontemporal_load((const GAS f32x4*)(w + (size_t)k * 3072));
      a0 += wv * sv[k]; a1 += wv * sv[1024 + k]; a2 += wv * sv[2048 + k]; a3 += wv * sv[3072 + k]; a4 += wv * sv[4096 + k];
    }
    *(f32x4*)(red + (kg * 5 + 0) * 32 + c4 * 4) = a0; *(f32x4*)(red + (kg * 5 + 1) * 32 + c4 * 4) = a1; *(f32x4*)(red + (kg * 5 + 2) * 32 + c4 * 4) = a2;
    *(f32x4*)(red + (kg * 5 + 3) * 32 + c4 * 4) = a3; *(f32x4*)(red + (kg * 5 + 4) * 32 + c4 * 4) = a4;
    __syncthreads();
    if (tid < 160) {
      const int v = tid >> 5, c2 = tid & 31;
      float sm = p.b_mod[l * 3072 + cgi * 32 + c2];
#pragma unroll 8
      for (int g = 0; g < 32; ++g) sm += red[(g * 5 + v) * 32 + c2];
      ((float*)(ws + O_MOD))[(l * 5 + v) * 3072 + cgi * 32 + c2] = sm;
    }
    return;
  }
  j -= P0_GEMV;
  if (j < P0_WIN) {
    const int l = j / 1704, r = j % 1704, kt = r / 213, nt = r % 213, c0 = nt * 32;
    const int nd0 = c0 < 2176 ? c0 : (c0 < 2208 ? 3712 + (c0 - 2176) : (c0 < 3744 ? c0 - 32 : c0 + 96));
    const bool only8 = nd0 >= 3840 || (nd0 >= 1536 && nd0 < 1920) || (nd0 >= 2688 && nd0 < 3200);
    tr_tile2(p.w_in + (size_t)l * 1024 * 6816, 6816, kt * 128, c0, only8 ? nullptr : (bf16_t*)(ws + O_WIN) + (size_t)l * 6912 * 1024, 1024, nd0, nullptr, lds,
             nd0 >= 3840 ? (unsigned char*)(ws + O_WG8) + ((size_t)l * 3072 + (nd0 - 3840)) * 1024
             : nd0 < 1024 ? (unsigned char*)(ws + O_WS8) + ((size_t)l * 1920 + nd0) * 1024
             : (nd0 >= 1536 && nd0 < 1920) ? (unsigned char*)(ws + O_WS8) + ((size_t)l * 1920 + 1024 + (nd0 - 1536)) * 1024
             : (nd0 >= 2688 && nd0 < 3200) ? (unsigned char*)(ws + O_WS8) + ((size_t)l * 1920 + 1408 + (nd0 - 2688)) * 1024 : nullptr);
    return;
  }
  j -= P0_WIN;
  if (j < P0_WQ) {
    const int l = j / 72, r = j % 72, kt = r / 24, nt = r % 24;
    tr_tile2(p.w_q_up + (size_t)l * 384 * 768, 768, kt * 128, nt * 32, nullptr, 384, nt * 32, p.q_norm_g + l * 384, lds,
             (unsigned char*)(ws + O_WQ) + ((size_t)l * 768 + nt * 32) * 384, 384);
    return;
  }
  j -= P0_WQ;
  if (j < P0_WKV) {
    const int l = j / 64, r = j % 64, kt = r / 32, nt = r % 32, c0 = nt * 32, h = c0 >> 7, e = c0 & 127;
    const int nd0 = e < 64 ? h * 64 + e : 512 + h * 64 + (e - 64);
    tr_tile2(p.w_kv_up + (size_t)l * 256 * 1024, 1024, kt * 128, c0, nullptr, 256, nd0, nullptr, lds,
             (unsigned char*)(ws + O_WKV) + ((size_t)l * 1024 + nd0) * 256, 256);
    return;
  }
  j -= P0_WKV;
  if (j < P0_WBR) {
    const int mat = j / 128, r = j % 128, kt = r / 32, nt = r % 32;
    tr_tile2(p.w_branch + (size_t)mat * 512 * 1024, 1024, kt * 128, nt * 32, nullptr, 512, nt * 32, nullptr, lds,
             (unsigned char*)(ws + O_WBR) + ((size_t)mat * 1024 + nt * 32) * 512, 512);
    return;
  }
  j -= P0_WBR;
  if (j < P0_WO) {
    const int l = j / 256, r = j % 256, kt = r / 32, nt = r % 32;
    tr_tile2(p.w_out + (size_t)l * 1024 * 1024, 1024, kt * 128, nt * 32, nullptr, 1024, nt * 32, nullptr, lds,
             (unsigned char*)(ws + O_WO) + ((size_t)l * 1024 + nt * 32) * 1024, 1024);
    return;
  }
  j -= P0_WO;
  if (j < P0_S0) {
    const int mat = j >> 2, nt = j & 3;
    tr_tile(p.state_ret + (size_t)mat * 64 * 128, 128, 0, nt * 32, (bf16_t*)(ws + O_S0T) + (size_t)mat * 128 * 64, 64, nt * 32, nullptr, lds);
    return;
  }
  j -= P0_S0;
  if (j < P0_PAD) {
    const int l = j / 48, r = j % 48;
    bf16_t* d = (bf16_t*)(ws + O_WIN) + ((size_t)l * 6912 + 3744) * 1024 + (size_t)r * 2048 + tid * 8;
    *(u32x4*)d = (u32x4){0u, 0u, 0u, 0u};
    return;
  }
  j -= P0_PAD;
  {
    float v[8];
    bf16_t* dst = nullptr; unsigned char* dst8 = nullptr;
    if (j == 1104) {
      float* rt = (float*)(ws + O_ROPE);
#pragma unroll
      for (int q = 0; q < 2; ++q) {
        const int idx = tid * 2 + q, pos = idx >> 3, f = idx & 7;
        const float ang = (float)pos * exp2f(-(float)f * 1.66096404744f);
        rt[idx * 2] = cosf(ang); rt[idx * 2 + 1] = sinf(ang);
      }
      return;
    }
    if (j < 16) {
      const int e0 = j * 2048 + tid * 8; dst = (bf16_t*)(ws + O_CS) + e0;
      const int n = e0 >> 7, k = e0 & 127;
#pragma unroll
      for (int e = 0; e < 8; ++e) {
        const float fr = (float)(((n & 127) * (k + e)) & 127) * (1.f / 128.f);
        v[e] = (n < 128) ? __builtin_amdgcn_cosf(fr) : __builtin_amdgcn_sinf(fr);
      }
    } else if (j < 80) {
      const int e0 = (j - 16) * 2048 + tid * 8; dst8 = (unsigned char*)(ws + O_D256) + e0;
      const int k1 = e0 >> 9, kk = e0 & 511;
#pragma unroll
      for (int e = 0; e < 8; ++e) {
        const int t = (kk + e) & 255;
        const float fr = (float)((k1 * t) & 255) * (1.f / 256.f);
        v[e] = (kk < 256) ? __builtin_amdgcn_cosf(fr) : -__builtin_amdgcn_sinf(fr);
      }
    } else {
      const int e0 = (j - 80) * 2048 + tid * 8; dst8 = (unsigned char*)(ws + O_D1024) + e0;
      const int k1 = e0 >> 11, kk = e0 & 2047;
#pragma unroll
      for (int e = 0; e < 8; ++e) {
        const int t = (kk + e) & 1023;
        const float fr = (float)((k1 * t) & 1023) * (1.f / 1024.f);
        v[e] = (kk < 1024) ? __builtin_amdgcn_cosf(fr) : -__builtin_amdgcn_sinf(fr);
      }
    }
    if (dst8) {
      u32x2 w8; w8.x = pk4f8(v[0] * 64.f, v[1] * 64.f, v[2] * 64.f, v[3] * 64.f); w8.y = pk4f8(v[4] * 64.f, v[5] * 64.f, v[6] * 64.f, v[7] * 64.f);
      *(u32x2*)dst8 = w8;
    } else {
      u32x4 w; w.x = pk2(v[0], v[1]); w.y = pk2(v[2], v[3]); w.z = pk2(v[4], v[5]); w.w = pk2(v[6], v[7]);
      *(u32x4*)dst = w;
    }
  }
}

__device__ __forceinline__ void norm_item(const Params& p, int l, int item, const float* xp, const float* xs) {
  const int tid = tidx(), lane = tid & 63, wid = tid >> 6;
  bf16_t* H = (bf16_t*)(p.ws + O_H);
#pragma unroll 3
  for (int i = 0; i < 6; ++i) {
    const int row = item * 24 + wid * 6 + i;
    const float* src = row < NPR ? xp + (size_t)row * 1024 : xs + (size_t)(row - NPR) * 1024;
    const int v = row < NPR ? 0 : 1 + ((row - NPR) >> 10);
    const float* mod = (const float*)(p.ws + O_MOD) + (l * 5 + v) * 3072;
    f32x4 x[4]; float ss = 0.f;
#pragma unroll
    for (int q = 0; q < 4; ++q) { x[q] = __builtin_nontemporal_load((const f32x4*)(src + (q * 64 + lane) * 4)); ss += x[q][0] * x[q][0] + x[q][1] * x[q][1] + x[q][2] * x[q][2] + x[q][3] * x[q][3]; }
    ss = wave_sum(ss);
    const float rstd = rsqrtf(ss * (1.f / 1024.f) + EPSN);
#pragma unroll
    for (int q = 0; q < 4; ++q) {
      const int col = (q * 64 + lane) * 4;
      const f32x4 g = *(const f32x4*)(p.norm_g + l * 1024 + col), sc = *(const f32x4*)(mod + 1024 + col), sh = *(const f32x4*)(mod + col);
      f32x4 h;
#pragma unroll
      for (int e = 0; e < 4; ++e) h[e] = x[q][e] * rstd * g[e] * (1.f + sc[e]) + sh[e];
      *(u32x2*)(H + (size_t)row * 1024 + col) = pk4(h);
      *(unsigned*)(p.ws + O_H8 + (size_t)row * 1024 + col) = pk4f8(h[0], h[1], h[2], h[3]);
    }
  }
}
__device__ __forceinline__ void final_item(const Params& p, int item) {
  const int tid = tidx(), lane = tid & 63, wid = tid >> 6;
#pragma unroll 3
  for (int i = 0; i < 6; ++i) {
    const int row = item * 24 + wid * 6 + i;
    float* src = p.out + (size_t)row * 1024;
    f32x4 x[4]; float ss = 0.f;
#pragma unroll
    for (int q = 0; q < 4; ++q) { x[q] = __builtin_nontemporal_load((const f32x4*)(src + (q * 64 + lane) * 4)); ss += x[q][0] * x[q][0] + x[q][1] * x[q][1] + x[q][2] * x[q][2] + x[q][3] * x[q][3]; }
    ss = wave_sum(ss);
    const float rstd = rsqrtf(ss * (1.f / 1024.f) + EPSN);
#pragma unroll
    for (int q = 0; q < 4; ++q) {
      const int col = (q * 64 + lane) * 4;
      const f32x4 g = *(const f32x4*)(p.final_g + col);
      f32x4 y;
#pragma unroll
      for (int e = 0; e < 4; ++e) y[e] = x[q][e] * rstd * g[e];
      __builtin_nontemporal_store(y, (f32x4*)(src + col));
    }
  }
}

__device__ __forceinline__ void s2_tile(const Params& p, int l, int tile, char* lds) {
  const int tid = tidx(), lane = tid & 63, wid = tid >> 6, wm = wid >> 1, wn = wid & 1, fr = lane & 15, fq = lane >> 4;
  const int m = (tile / 480) * 16 + (tile % 16), nt = (tile % 480) / 16, m0 = m * 128, n0 = nt * 128;
  char* ws = wsp(p.ws);
  const bf16_t* A = (const bf16_t*)(ws + O_H) + (size_t)m0 * 1024;
  const bf16_t* B = (const bf16_t*)(ws + O_WIN) + ((size_t)l * 6912 + n0) * 1024;
  const bool f8 = (nt >= 12 && nt < 15) || (nt >= 21 && nt < 25);
  const int row8 = nt < 8 ? nt * 128 : (nt < 15 ? 1024 + (nt - 12) * 128 : 1408 + (nt - 21) * 128);
  const char* A8 = (const char*)(ws + O_H8) + (size_t)m0 * 1024;
  const char* B8 = (const char*)(ws + O_WS8) + ((size_t)l * 1920 + row8) * 1024;
  const float s8 = f8 ? 0.03125f : 1.f;
  f32x4 acc[4][4];
  zero_acc(acc);
  if (nt >= 4 && nt < 8) {
    gemm_core<false>(A, 1024, B, 1024, 1024, acc, lds);
    bf16_t* RVT = (bf16_t*)(ws + O_RVT);
#pragma unroll
    for (int i = 0; i < 4; ++i) {
      const int tok = m0 + wm * 64 + i * 16 + fq * 4;
      size_t base; int T, b, t;
      if (tok < NPR) { b = tok >> 8; t = tok & 255; T = 256; base = 0; } else { const int s = tok - NPR; b = s >> 10; t = s & 1023; T = 1024; base = (size_t)NPR * 512; }
#pragma unroll
      for (int j = 0; j < 4; ++j) {
        const int c = n0 - 512 + wn * 64 + j * 16 + fr, h = c >> 7, vd = c & 127;
        *(u32x2*)(RVT + base + ((size_t)(b * 4 + h) * 128 + vd) * T + t) = pk4(acc[i][j]);
      }
    }
    return;
  }
  if (f8) { int par = 0; gemm_bytes<true, 4, 1, true>(A8, 1024, B8, 1024, 1024, acc, lds, par, false, nullptr, 0, nullptr, 0); }
  else gemm_core<true>(A, 1024, B, 1024, 1024, acc, lds);
  bf16_t* dst = nullptr; int ld = 0, c0 = 0, op = 0;
  if (nt < 2) { dst = (bf16_t*)(ws + O_RQ); ld = 256; c0 = 0; }
  else if (nt < 4) { dst = (bf16_t*)(ws + O_RK); ld = 256; c0 = 256; op = 2; }
  else if (nt < 12) { dst = (bf16_t*)(ws + O_RZ); ld = 512; c0 = 1024; op = 1; }
  else if (nt < 15) { ld = 384; c0 = 1536; op = 5; }
  else if (nt < 17) { ld = 256; c0 = 1920; op = 3; }
  else if (nt < 21) { dst = (bf16_t*)(ws + O_MZ); ld = 512; c0 = 2176; op = 1; }
  else if (nt < 25) { dst = (bf16_t*)(ws + O_FU); ld = 512; c0 = 2688; }
  else if (nt < 29) { dst = (bf16_t*)(ws + O_FZ); ld = 512; c0 = 3200; op = 1; }
  else { ld = 32; c0 = 3712; op = 4; }
#pragma unroll
  for (int i = 0; i < 4; ++i) {
    const int tok = m0 + wm * 64 + i * 16 + fr;
#pragma unroll
    for (int j = 0; j < 4; ++j) {
      const int col = n0 - c0 + wn * 64 + j * 16 + fq * 4;
      f32x4 v = acc[i][j] * s8;
      if (op == 3) { *(f32x4*)((float*)(ws + O_KVLAT) + (size_t)tok * 256 + col) = v; continue; }
      if (op == 5) { *(unsigned*)(ws + O_QLAT + (size_t)tok * 384 + col) = pk4f8(v[0] * 8.f, v[1] * 8.f, v[2] * 8.f, v[3] * 8.f); continue; }
      if (op == 4) { if (col < 32) *(f32x4*)((float*)(ws + O_KR) + (size_t)tok * 32 + col) = v; continue; }
      if (op == 1) {
#pragma unroll
        for (int e = 0; e < 4; ++e) v[e] = silu_f(v[e]);
      } else if (op == 2) {
#pragma unroll
        for (int e = 0; e < 4; ++e) v[e] *= 0.125f;
      }
      const u32x2 w = pk4(v);
      *(u32x2*)(dst + (size_t)tok * ld + col) = w;
      if (op == 2 && tok < NPR) {
        bf16_t* RKT = (bf16_t*)(ws + O_RKT);
        const int b = tok >> 8, t = tok & 255, h = col >> 6, dk = col & 63;
        bf16_t* q = RKT + ((size_t)(b * 4 + h) * 64 + dk) * 256 + t;
        q[0] = (bf16_t)(w.x & 0xffffu); q[256] = (bf16_t)(w.x >> 16); q[512] = (bf16_t)(w.y & 0xffffu); q[768] = (bf16_t)(w.y >> 16);
      }
    }
  }
}

template <int MODE>
__device__ __forceinline__ void attn_item(const Params& p, int l, int item, char* lds) {
  constexpr int NKP = MODE == 0 ? 3 : 2;
  constexpr int NVB = MODE == 0 ? 4 : 8;
  constexpr int PV = NVB * 16 * 64;
  constexpr int KOFF = NKP * 4096;
  constexpr int BUF = KOFF + 2 * PV;
  const int tid = tidx(), lane = tid & 63, wid = tid >> 6, fr = lane & 15, fq = lane >> 4;
  char* ws = wsp(p.ws);
  int smp, b, h, qblk, T, Tk, tok0;
  const bf16_t *kbase, *rbase = nullptr, *vbase, *qbase;
  int kstride, qstride;
  if (MODE == 0) {
    if (item < 256) { smp = 1; b = item >> 6; h = (item >> 3) & 7; qblk = item & 7; T = 1024; Tk = 1536; tok0 = NPR + b * 1024 + qblk * 128; }
    else { const int it = item - 256; smp = 0; b = it >> 4; h = (it >> 1) & 7; qblk = it & 1; T = 256; Tk = 256; tok0 = b * 256 + qblk * 128; }
    const int keyrow0 = smp ? NPR + b * 1536 : b * 256;
    kbase = (const bf16_t*)(ws + O_KB) + (size_t)keyrow0 * 512 + h * 64; kstride = 512;
    rbase = (const bf16_t*)(ws + O_KRA) + (size_t)keyrow0 * 32;
    vbase = (const bf16_t*)(ws + O_VT) + (smp ? (size_t)NPR * 512 + (size_t)(b * 8 + h) * 64 * 1536 : (size_t)(b * 8 + h) * 64 * 256);
    qbase = (const bf16_t*)(ws + O_QB) + (size_t)tok0 * 768 + h * 96; qstride = 768;
  } else {
    if (item < 128) { smp = 1; b = item >> 5; h = (item >> 3) & 3; qblk = item & 7; T = 1024; tok0 = NPR + b * 1024 + qblk * 128; }
    else { const int it = item - 128; smp = 0; b = it >> 3; h = (it >> 1) & 3; qblk = it & 1; T = 256; tok0 = b * 256 + qblk * 128; }
    Tk = T;
    const int ktok0 = smp ? NPR + b * 1024 : b * 256;
    kbase = (const bf16_t*)(ws + O_RK) + (size_t)ktok0 * 256 + h * 64; kstride = 256;
    vbase = (const bf16_t*)(ws + O_RVT) + (smp ? (size_t)NPR * 512 + (size_t)(b * 4 + h) * 128 * 1024 : (size_t)(b * 4 + h) * 128 * 256);
    qbase = (const bf16_t*)(ws + O_RQ) + (size_t)tok0 * 256 + h * 64; qstride = 256;
  }
  const int nkt = Tk >> 6;
  bf16x8 qf[2][NKP];
#pragma unroll
  for (int qb = 0; qb < 2; ++qb)
#pragma unroll
    for (int ks = 0; ks < NKP; ++ks) qf[qb][ks] = *(const bf16x8*)(qbase + (size_t)(wid * 32 + qb * 16 + fr) * qstride + ks * 32 + fq * 8);
  f32x4 o[NVB][2];
#pragma unroll
  for (int vb = 0; vb < NVB; ++vb) { o[vb][0] = (f32x4){0.f, 0.f, 0.f, 0.f}; o[vb][1] = (f32x4){0.f, 0.f, 0.f, 0.f}; }
  float lgf = 0.f, lgb = 0.f;
  float mrow[2] = {-INFINITY, -INFINITY}, lrow[2] = {0.f, 0.f};
  const int tq0 = qblk * 128 + wid * 32 + fr;
  if (MODE == 1) {
    const float xf = p.ret_logit[(l * 2 + 0) * 4 + h], xb = p.ret_logit[(l * 2 + 1) * 4 + h];
    lgf = -log1pf(expf(-xf)) * 1.44269504089f; lgb = -log1pf(expf(-xb)) * 1.44269504089f;
    if (smp) {
      const bf16_t* s0 = (const bf16_t*)(ws + O_S0T);
#pragma unroll
      for (int dir = 0; dir < 2; ++dir) {
        const bf16_t* sb = s0 + ((size_t)(((b * 2 + l) * 2 + dir) * 4 + h) * 128) * 64;
        float dec[2];
#pragma unroll
        for (int qb = 0; qb < 2; ++qb) { const int tq = tq0 + qb * 16; dec[qb] = dir == 0 ? ex2((float)(tq + 1) * lgf) : ex2((float)(T - tq) * lgb); }
#pragma unroll
        for (int vb = 0; vb < NVB; ++vb) {
          f32x4 t0 = (f32x4){0.f, 0.f, 0.f, 0.f}, t1 = (f32x4){0.f, 0.f, 0.f, 0.f};
#pragma unroll
          for (int ks = 0; ks < 2; ++ks) {
            const bf16x8 sf = *(const bf16x8*)(sb + (size_t)(vb * 16 + fr) * 64 + ks * 32 + fq * 8);
            t0 = mfma16(sf, qf[0][ks], t0); t1 = mfma16(sf, qf[1][ks], t1);
          }
          o[vb][0] += t0 * dec[0]; o[vb][1] += t1 * dec[1];
        }
      }
    }
  }
  u32x4 vreg[NVB / 2];
  const int uw = __builtin_amdgcn_readfirstlane(wid);
  const int dkey = lane >> 2, dchunk = (lane & 3) ^ swz(dkey);
  auto kdma = [&](int kt, char* buf) {
    const GAS bf16_t* kp = (const GAS bf16_t*)kbase + (size_t)(kt * 64 + uw * 16 + dkey) * kstride + dchunk * 8;
#pragma unroll
    for (int pn = 0; pn < 2; ++pn)
      __builtin_amdgcn_global_load_lds((const GAS unsigned*)(kp + pn * 32), (LAS unsigned*)((LAS char*)buf + pn * 4096 + uw * 1024), 16, 0, 0);
    if (MODE == 0) {
      const GAS bf16_t* rp = (const GAS bf16_t*)rbase + (size_t)(kt * 64 + uw * 16 + dkey) * 32 + dchunk * 8;
      __builtin_amdgcn_global_load_lds((const GAS unsigned*)rp, (LAS unsigned*)((LAS char*)buf + 2 * 4096 + uw * 1024), 16, 0, 0);
    }
  };
  auto gload = [&](int kt) {
#pragma unroll
    for (int i = 0; i < NVB / 2; ++i) { const int idx = tid + 256 * i, vd = idx >> 3, g = idx & 7; vreg[i] = ldg16(vbase + (size_t)vd * Tk + kt * 64 + g * 8); }
  };
  auto lstore = [&](char* buf) {
#pragma unroll
    for (int i = 0; i < NVB / 2; ++i) {
      const int idx = tid + 256 * i, vd = idx >> 3, g = idx & 7, pnl = g >> 2, g4 = g & 3, hi = g4 >> 1, q0 = 2 * (g4 & 1);
      char* base = buf + KOFF + pnl * PV + vd * 64 + hi * 8;
      *(u32x2*)(base + ((q0 ^ swz(vd)) << 4)) = (u32x2){vreg[i].x, vreg[i].y};
      *(u32x2*)(base + (((q0 + 1) ^ swz(vd)) << 4)) = (u32x2){vreg[i].z, vreg[i].w};
    }
  };
  __syncthreads();
  kdma(0, lds); gload(0); lstore(lds);
  asm volatile("s_waitcnt vmcnt(0)" ::: "memory");
  __syncthreads();
  const int foff = fr * 64 + ((fq ^ swz(fr)) << 4);
  for (int kt = 0; kt < nkt; ++kt) {
    char* cur = lds + (kt & 1) * BUF;
    const bool more = (kt + 1) < nkt;
    if (more) { kdma(kt + 1, lds + ((kt + 1) & 1) * BUF); gload(kt + 1); }
    __builtin_amdgcn_sched_barrier(0);
    f32x4 s[4][2];
#pragma unroll
    for (int kb = 0; kb < 4; ++kb) {
      s[kb][0] = (f32x4){0.f, 0.f, 0.f, 0.f}; s[kb][1] = (f32x4){0.f, 0.f, 0.f, 0.f};
#pragma unroll
      for (int ks = 0; ks < NKP; ++ks) {
        const bf16x8 kf = *(const bf16x8*)(cur + ks * 4096 + kb * 1024 + foff);
        s[kb][0] = mfma16(kf, qf[0][ks], s[kb][0]); s[kb][1] = mfma16(kf, qf[1][ks], s[kb][1]);
      }
    }
    bf16x8 pf[2][2];
#pragma unroll
    for (int qb = 0; qb < 2; ++qb) {
      if (MODE == 0) {
        float mx = s[0][qb][0];
#pragma unroll
        for (int kb = 0; kb < 4; ++kb)
#pragma unroll
          for (int r = 0; r < 4; ++r) mx = fmaxf(mx, s[kb][qb][r]);
        mx = fmaxf(mx, __shfl_xor(mx, 16)); mx = fmaxf(mx, __shfl_xor(mx, 32));
        const float mn = fmaxf(mrow[qb], mx), alpha = ex2(mrow[qb] - mn);
        mrow[qb] = mn;
        float ls = 0.f;
#pragma unroll
        for (int kb = 0; kb < 4; ++kb)
#pragma unroll
          for (int r = 0; r < 4; ++r) { const float e = ex2(s[kb][qb][r] - mn); s[kb][qb][r] = e; ls += e; }
        lrow[qb] = lrow[qb] * alpha + ls;
#pragma unroll
        for (int vb = 0; vb < NVB; ++vb) o[vb][qb] *= alpha;
      } else {
        const int tq = tq0 + qb * 16;
#pragma unroll
        for (int kb = 0; kb < 4; ++kb)
#pragma unroll
          for (int r = 0; r < 4; ++r) {
            const int d = tq - (kt * 64 + kb * 16 + fq * 4 + r);
            const float dec = d > 0 ? ex2((float)d * lgf) : (d < 0 ? ex2((float)(-d) * lgb) : 2.f);
            s[kb][qb][r] *= dec;
          }
      }
#pragma unroll
      for (int g = 0; g < 2; ++g) {
        u32x4 w; w.x = pk2(s[2 * g][qb][0], s[2 * g][qb][1]); w.y = pk2(s[2 * g][qb][2], s[2 * g][qb][3]);
        w.z = pk2(s[2 * g + 1][qb][0], s[2 * g + 1][qb][1]); w.w = pk2(s[2 * g + 1][qb][2], s[2 * g + 1][qb][3]);
        pf[qb][g] = as_bf8(w);
      }
    }
#pragma unroll
    for (int vb = 0; vb < NVB; ++vb)
#pragma unroll
      for (int g = 0; g < 2; ++g) {
        const bf16x8 vf = *(const bf16x8*)(cur + KOFF + g * PV + vb * 1024 + foff);
        o[vb][0] = mfma16(vf, pf[0][g], o[vb][0]); o[vb][1] = mfma16(vf, pf[1][g], o[vb][1]);
      }
    __builtin_amdgcn_sched_barrier(0);
    if (more) lstore(lds + ((kt + 1) & 1) * BUF);
    asm volatile("s_waitcnt vmcnt(0)" ::: "memory");
    __syncthreads();
  }
  bf16_t* G = (bf16_t*)(ws + (MODE == 0 ? O_MZ : O_RZ));
#pragma unroll
  for (int qb = 0; qb < 2; ++qb) {
    const int tok = tok0 + wid * 32 + qb * 16 + fr;
    float mul, sub;
    if (MODE == 0) {
      float lt = lrow[qb]; lt += __shfl_xor(lt, 16); lt += __shfl_xor(lt, 32);
      mul = 1.f / lt; sub = 0.f;
    } else {
      float sm = 0.f;
#pragma unroll
      for (int vb = 0; vb < NVB; ++vb) sm += (o[vb][qb][0] + o[vb][qb][1]) + (o[vb][qb][2] + o[vb][qb][3]);
      sm += __shfl_xor(sm, 16); sm += __shfl_xor(sm, 32);
      const float mu = sm * (1.f / 128.f);
      float vs = 0.f;
#pragma unroll
      for (int vb = 0; vb < NVB; ++vb)
#pragma unroll
        for (int r = 0; r < 4; ++r) { const float dd = o[vb][qb][r] - mu; vs += dd * dd; }
      vs += __shfl_xor(vs, 16); vs += __shfl_xor(vs, 32);
      mul = rsqrtf(vs * (1.f / 128.f) + EPSN); sub = mu;
    }
#pragma unroll
    for (int vb = 0; vb < NVB; ++vb) {
      bf16_t* gp = G + (size_t)tok * 512 + h * (NVB * 16) + vb * 16 + fq * 4;
      const u32x2 gz = *(const u32x2*)gp;
      f32x4 y;
      y[0] = (o[vb][qb][0] - sub) * mul * bflo(gz.x); y[1] = (o[vb][qb][1] - sub) * mul * bfhi(gz.x);
      y[2] = (o[vb][qb][2] - sub) * mul * bflo(gz.y); y[3] = (o[vb][qb][3] - sub) * mul * bfhi(gz.y);
      *(unsigned*)(ws + O_BR8 + (size_t)(MODE == 0 ? 1 : 0) * NTOK * 512 + (size_t)tok * 512 + h * (NVB * 16) + vb * 16 + fq * 4) = pk4f8(y[0] * 8.f, y[1] * 8.f, y[2] * 8.f, y[3] * 8.f);
    }
  }
}

__device__ __forceinline__ bf16x8 scale8(u32x4 raw, const float (&d)[8]) {
  u32x4 w;
  w.x = pk2(bflo(raw.x) * d[0], bfhi(raw.x) * d[1]); w.y = pk2(bflo(raw.y) * d[2], bfhi(raw.y) * d[3]);
  w.z = pk2(bflo(raw.z) * d[4], bfhi(raw.z) * d[5]); w.w = pk2(bflo(raw.w) * d[6], bfhi(raw.w) * d[7]);
  return as_bf8(w);
}
__device__ __forceinline__ void state_item(const Params& p, int l, int item) {
  const int tid = tidx(), lane = tid & 63, wid = tid >> 6, fr = lane & 15, fq = lane >> 4;
  const int b = item >> 2, h = item & 3;
  const bf16_t* RVT = (const bf16_t*)(p.ws + O_RVT) + (size_t)(b * 4 + h) * 128 * 256;
  const bf16_t* RKT = (const bf16_t*)(p.ws + O_RKT) + (size_t)(b * 4 + h) * 64 * 256;
  const float xf = p.ret_logit[(l * 2 + 0) * 4 + h], xb = p.ret_logit[(l * 2 + 1) * 4 + h];
  const float lgf = -log1pf(expf(-xf)) * 1.44269504089f, lgb = -log1pf(expf(-xb)) * 1.44269504089f;
  f32x4 acc[2][2][4];
#pragma unroll
  for (int d = 0; d < 2; ++d)
#pragma unroll
    for (int v = 0; v < 2; ++v)
#pragma unroll
      for (int k = 0; k < 4; ++k) acc[d][v][k] = (f32x4){0.f, 0.f, 0.f, 0.f};
#pragma unroll 2
  for (int ks = 0; ks < 8; ++ks) {
    const int j0 = ks * 32 + fq * 8;
    float df[8], db[8];
#pragma unroll
    for (int e = 0; e < 8; ++e) { df[e] = exp2f((float)(255 - j0 - e) * lgf); db[e] = exp2f((float)(j0 + e) * lgb); }
    bf16x8 af[2];
#pragma unroll
    for (int v = 0; v < 2; ++v) af[v] = *(const bf16x8*)(RVT + (size_t)((wid * 2 + v) * 16 + fr) * 256 + j0);
#pragma unroll
    for (int k = 0; k < 4; ++k) {
      const u32x4 raw = *(const u32x4*)(RKT + (size_t)(k * 16 + fr) * 256 + j0);
      const bf16x8 kf = scale8(raw, df), kb = scale8(raw, db);
#pragma unroll
      for (int v = 0; v < 2; ++v) { acc[0][v][k] = mfma16(af[v], kf, acc[0][v][k]); acc[1][v][k] = mfma16(af[v], kb, acc[1][v][k]); }
    }
  }
  float* O = p.out + OUT_RET;
#pragma unroll
  for (int d = 0; d < 2; ++d)
#pragma unroll
    for (int v = 0; v < 2; ++v)
#pragma unroll
      for (int k = 0; k < 4; ++k) {
        const int dk = k * 16 + fr, vd = (wid * 2 + v) * 16 + fq * 4;
        __builtin_nontemporal_store(acc[d][v][k], (f32x4*)(O + ((size_t)((((b * 2 + l) * 2 + d) * 4 + h) * 64 + dk)) * 128 + vd));
      }
}

__device__ __forceinline__ void keyprep_item(const Params& p, int l, int item) {
  const int tid = tidx(), lane = tid & 63, wid = tid >> 6;
  char* ws = wsp(p.ws);
  unsigned char* CKVA = (unsigned char*)(ws + O_CKVA);
  bf16_t* KRA = (bf16_t*)(ws + O_KRA);
#pragma unroll
  for (int i = 0; i < 4; ++i) {
    const int R = item * 16 + wid * 4 + i;
    int smp = 0, b, t = 0, tok = 0, ctx = 0, pp = 0;
    if (R < NPR) { tok = R; b = R >> 8; t = R & 255; }
    else { smp = 1; const int s = R - NPR; b = s / 1536; pp = s - b * 1536; if (pp < 512) ctx = 1; else { t = pp - 512; tok = NPR + b * 1024 + t; } }
    if (ctx) {
      const f32x4 v = __builtin_nontemporal_load((const f32x4*)(p.cache_ckv + ((size_t)((b * 2 + l) * 512 + pp)) * 256 + lane * 4));
      *(unsigned*)(CKVA + (size_t)R * 256 + lane * 4) = pk4f8(v[0] * 4.f, v[1] * 4.f, v[2] * 4.f, v[3] * 4.f);
      if (lane < 32) KRA[(size_t)R * 32 + lane] = tobf(p.cache_krope[((size_t)((b * 2 + l) * 512 + pp)) * 32 + lane]);
      continue;
    }
    const f32x4 v = *(const f32x4*)((const float*)(ws + O_KVLAT) + (size_t)tok * 256 + lane * 4);
    float ss = v[0] * v[0] + v[1] * v[1] + v[2] * v[2] + v[3] * v[3];
    ss = wave_sum(ss);
    const float rstd = rsqrtf(ss * (1.f / 256.f) + EPSN);
    const f32x4 g = *(const f32x4*)(p.kv_norm_g + l * 256 + lane * 4);
    f32x4 y;
#pragma unroll
    for (int e = 0; e < 4; ++e) y[e] = v[e] * rstd * g[e];
    *(unsigned*)(CKVA + (size_t)R * 256 + lane * 4) = pk4f8(y[0] * 4.f, y[1] * 4.f, y[2] * 4.f, y[3] * 4.f);
    if (!smp) __builtin_nontemporal_store(y, (f32x4*)(p.out + OUT_CKV + ((size_t)((b * 2 + l) * 256 + t)) * 256 + lane * 4));
    const int d = lane & 31;
    const float x = ((const float*)(ws + O_KR))[(size_t)tok * 32 + d];
    float yk = x;
    if (smp) {
      const float pr = __shfl_xor(x, 8);
      const int hd = d >> 4, i16 = d & 15, f = i16 & 7;
      const int pos = hd ? (t & 63) : (t >> 6);
      const float* rt = (const float*)(ws + O_ROPE) + (pos * 8 + f) * 2;
      const float cs = rt[0], sn = rt[1];
      yk = i16 < 8 ? x * cs - pr * sn : pr * sn + x * cs;
    } else if (lane < 32) {
      p.out[OUT_KR + ((size_t)((b * 2 + l) * 256 + t)) * 32 + d] = x;
    }
    if (lane < 32) KRA[(size_t)R * 32 + d] = tobf(yk);
  }
}

__device__ __forceinline__ void f1_tile(const Params& p, int tile, char* lds) {
  const int tid = tidx(), lane = tid & 63, wid = tid >> 6, wm = wid >> 1, wn = wid & 1, fr = lane & 15, fq = lane >> 4;
  const int m = tile >> 3, g = (tile >> 1) & 3, nh = tile & 1, m0 = m * 128;
  char* ws = wsp(p.ws);
  f32x4 acc[4][4];
  zero_acc(acc);
  gemm_core<false>((const bf16_t*)(ws + O_FU) + (size_t)m0 * 512 + g * 128, 512, (const bf16_t*)(ws + O_CS) + (size_t)nh * 128 * 128, 128, 128, acc, lds);
  unsigned char* UT = (unsigned char*)(ws + O_UT);
#pragma unroll
  for (int i = 0; i < 4; ++i) {
    const int tok = m0 + wm * 64 + i * 16 + fq * 4;
    size_t base; int T, b, t;
    if (tok < NPR) { b = tok >> 8; t = tok & 255; T = 256; base = 0; } else { const int s = tok - NPR; b = s >> 10; t = s & 1023; T = 1024; base = (size_t)NPR * 1024; }
#pragma unroll
    for (int j = 0; j < 4; ++j) {
      const int k2 = wn * 64 + j * 16 + fr;
      *(unsigned*)(UT + base + ((size_t)(b * 4 + g) * 128 + k2) * (2 * T) + nh * T + t) = pk4f8(acc[i][j][0] * 4.f, acc[i][j][1] * 4.f, acc[i][j][2] * 4.f, acc[i][j][3] * 4.f);
    }
  }
}

__device__ __forceinline__ void qup_tile(const Params& p, int l, int tile, char* lds) {
  const int tid = tidx(), lane = tid & 63, wid = tid >> 6, wm = wid >> 1, wn = wid & 1, fr = lane & 15, fq = lane >> 4;
  const int m = tile % 96, nt = tile / 96, m0 = m * 128, n0 = nt * 128;
  char* ws = wsp(p.ws);
  const char* QL = (const char*)(ws + O_QLAT) + (size_t)m0 * 384;
  float rsv4[4];
  {
    float* rs = (float*)lds;
    __syncthreads();
#pragma unroll 1
    for (int r0 = 0; r0 < 32; r0 += 4) {
      float ss[4];
#pragma unroll
      for (int u = 0; u < 4; ++u) {
        u32x4 w = (u32x4){0u, 0u, 0u, 0u};
        if (lane < 24) w = ldg16(QL + (size_t)(wid * 32 + r0 + u) * 384 + lane * 16);
        float a = 0.f;
#pragma unroll
        for (int q = 0; q < 4; ++q) {
          const float f0 = __builtin_amdgcn_cvt_f32_fp8(w[q], 0), f1 = __builtin_amdgcn_cvt_f32_fp8(w[q], 1), f2 = __builtin_amdgcn_cvt_f32_fp8(w[q], 2), f3 = __builtin_amdgcn_cvt_f32_fp8(w[q], 3);
          a += f0 * f0 + f1 * f1 + f2 * f2 + f3 * f3;
        }
        ss[u] = a;
      }
#pragma unroll
      for (int u = 0; u < 4; ++u) { const float t = wave_sum(ss[u]); if (lane == 0) rs[wid * 32 + r0 + u] = rsqrtf(t * (1.f / (384.f * 64.f)) + EPSN); }
    }
    __syncthreads();
#pragma unroll
    for (int i = 0; i < 4; ++i) rsv4[i] = rs[wm * 64 + i * 16 + fr];
    __syncthreads();
  }
  f32x4 acc[4][4];
  zero_acc(acc);
  { int par = 0; gemm_bytes<true, 4, 1, true>(QL, 384, (const char*)(ws + O_WQ) + ((size_t)l * 768 + n0) * 384, 384, 384, acc, lds, par, false, nullptr, 0, nullptr, 0); }
  bf16_t* QB = (bf16_t*)(ws + O_QB);
  const float qscale = 0.10206207261596577f * 1.44269504089f * (1.f / 256.f);
#pragma unroll
  for (int i = 0; i < 4; ++i) {
    const int rl = wm * 64 + i * 16 + fr, tok = m0 + rl;
    const float sc = rsv4[i] * qscale;
    const int smp = tok >= NPR, t = (tok - NPR) & 1023;
#pragma unroll
    for (int j = 0; j < 4; ++j) {
      const int cb = n0 + wn * 64 + j * 16, within = cb % 96;
      f32x4 v = acc[i][j] * sc;
      if (within >= 64) {
        f32x4 pr;
#pragma unroll
        for (int e = 0; e < 4; ++e) pr[e] = __shfl_xor(v[e], 32);
        if (smp) {
          const int pos = within >= 80 ? (t & 63) : (t >> 6);
          const float* rt = (const float*)(ws + O_ROPE) + (pos * 8 + (fq & 1) * 4) * 2;
          const f32x4 c01 = *(const f32x4*)rt, c23 = *(const f32x4*)(rt + 4);
          const float cs4[4] = {c01[0], c01[2], c23[0], c23[2]}, sn4[4] = {c01[1], c01[3], c23[1], c23[3]};
#pragma unroll
          for (int e = 0; e < 4; ++e) v[e] = fq < 2 ? v[e] * cs4[e] - pr[e] * sn4[e] : pr[e] * sn4[e] + v[e] * cs4[e];
        }
      }
      *(u32x2*)(QB + (size_t)tok * 768 + cb + fq * 4) = pk4(v);
    }
  }
}

__device__ __forceinline__ void kvup_tile(const Params& p, int l, int tile, char* lds) {
  const int tid = tidx(), lane = tid & 63, wid = tid >> 6, wm = wid >> 1, wn = wid & 1, fr = lane & 15, fq = lane >> 4;
  const int m = tile % 112, nt = tile / 112, m0 = m * 128, n0 = nt * 128;
  char* ws = wsp(p.ws);
  const char* A = (const char*)(ws + O_CKVA) + (size_t)m0 * 256;
  const char* B = (const char*)(ws + O_WKV) + ((size_t)l * 1024 + n0) * 256;
  const float ks = 1.f / 128.f;
  f32x4 acc[4][4];
  zero_acc(acc);
  if (nt < 4) {
    { int par = 0; gemm_bytes<true, 4, 1, true>(A, 256, B, 256, 256, acc, lds, par, false, nullptr, 0, nullptr, 0); }
    bf16_t* KB = (bf16_t*)(ws + O_KB);
#pragma unroll
    for (int i = 0; i < 4; ++i) {
      const int R = m0 + wm * 64 + i * 16 + fr;
#pragma unroll
      for (int j = 0; j < 4; ++j) *(u32x2*)(KB + (size_t)R * 512 + n0 + wn * 64 + j * 16 + fq * 4) = pk4(acc[i][j] * ks);
    }
  } else {
    { int par = 0; gemm_bytes<false, 4, 1, true>(A, 256, B, 256, 256, acc, lds, par, false, nullptr, 0, nullptr, 0); }
    bf16_t* VT = (bf16_t*)(ws + O_VT);
#pragma unroll
    for (int i = 0; i < 4; ++i) {
      const int R = m0 + wm * 64 + i * 16 + fq * 4;
      size_t base; int Tk, b, k;
      if (R < NPR) { b = R >> 8; k = R & 255; Tk = 256; base = 0; } else { const int s = R - NPR; b = s / 1536; k = s - b * 1536; Tk = 1536; base = (size_t)NPR * 512; }
#pragma unroll
      for (int j = 0; j < 4; ++j) {
        const int c = n0 - 512 + wn * 64 + j * 16 + fr, h = c >> 6, vd = c & 63;
        *(u32x2*)(VT + base + ((size_t)(b * 8 + h) * 64 + vd) * Tk + k) = pk4(acc[i][j] * ks);
      }
    }
  }
}

template <int NJ>
__device__ __forceinline__ void f2_tile(const Params& p, int tile, char* lds) {
  const int tid = tidx(), lane = tid & 63, wid = tid >> 6, wm = wid >> 1, wn = wid & 1, fr = lane & 15, fq = lane >> 4;
  char* ws = wsp(p.ws);
  const char *A, *B; int K, tokb, g, nh = 0; float scale;
  if (NJ == 2) {
    const int b = tile >> 6, mt = (tile >> 1) & 7; g = (tile >> 4) & 3; nh = tile & 1;
    A = (const char*)(ws + O_D1024) + (size_t)mt * 128 * 2048; K = 2048;
    B = (const char*)(ws + O_UT) + (size_t)NPR * 1024 + ((size_t)(b * 4 + g) * 128 + nh * 64) * 2048;
    tokb = NPR + b * 1024 + mt * 128; scale = 0.00276213586400995f * (1.f / 256.f);
  } else {
    const int b = tile >> 3, mt = tile & 1; g = (tile >> 1) & 3;
    A = (const char*)(ws + O_D256) + (size_t)mt * 128 * 512; K = 512;
    B = (const char*)(ws + O_UT) + (size_t)(b * 4 + g) * 128 * 512;
    tokb = b * 256 + mt * 128; scale = 0.0055242717280199f * (1.f / 256.f);
  }
  f32x4 acc[4][NJ];
#pragma unroll
  for (int i = 0; i < 4; ++i)
#pragma unroll
    for (int j = 0; j < NJ; ++j) acc[i][j] = (f32x4){0.f, 0.f, 0.f, 0.f};
  { int par = 0; gemm_bytes<true, NJ, 1, true>(A, K, B, K, K, acc, lds, par, false, nullptr, 0, nullptr, 0); }
  bf16_t* FZ = (bf16_t*)(ws + O_FZ);
#pragma unroll
  for (int i = 0; i < 4; ++i) {
    const int tok = tokb + wm * 64 + i * 16 + fr;
#pragma unroll
    for (int j = 0; j < NJ; ++j) {
      bf16_t* gp = FZ + (size_t)tok * 512 + g * 128 + nh * 64 + wn * (NJ * 16) + j * 16 + fq * 4;
      const u32x2 gz = *(const u32x2*)gp;
      f32x4 y;
      y[0] = acc[i][j][0] * scale * bflo(gz.x); y[1] = acc[i][j][1] * scale * bfhi(gz.x);
      y[2] = acc[i][j][2] * scale * bflo(gz.y); y[3] = acc[i][j][3] * scale * bfhi(gz.y);
      *(unsigned*)(ws + O_BR8 + (size_t)2 * NTOK * 512 + (size_t)tok * 512 + g * 128 + nh * 64 + wn * (NJ * 16) + j * 16 + fq * 4) = pk4f8(y[0] * 8.f, y[1] * 8.f, y[2] * 8.f, y[3] * 8.f);
    }
  }
}

template <int NJ>
__device__ __forceinline__ void s6_tile(const Params& p, int l, int tile, int ntile, char* lds, int& par, bool& primed) {
  const int tid = tidx(), lane = tid & 63, wid = tid >> 6, wm = wid >> 1, wn = wid & 1, fr = lane & 15, fq = lane >> 4;
  constexpr int NT = 32 / NJ, BN = NJ * 32;
  const int m = (tile / (32 * NT)) * 32 + (tile % 32), nt = (tile % (32 * NT)) / 32, m0 = m * 128, n0 = nt * BN;
  char* ws = wsp(p.ws);
  const char* H8 = (const char*)(ws + O_H8);
  const char* W8 = (const char*)(ws + O_WG8) + (size_t)l * 3072 * 1024;
  const char* Wb = (const char*)(ws + O_WBR) + (size_t)(l * 3) * 1024 * 512;
  f32x4 tot[4][NJ], acc[4][NJ];
  unsigned sg[4][NJ];
#pragma unroll
  for (int i = 0; i < 4; ++i)
#pragma unroll
    for (int j = 0; j < NJ; ++j) tot[i][j] = (f32x4){0.f, 0.f, 0.f, 0.f};
#pragma unroll 1
  for (int nb = 0; nb < 3; ++nb) {
    u32x2 totp[4][NJ];
#pragma unroll
    for (int i = 0; i < 4; ++i)
#pragma unroll
      for (int j = 0; j < NJ; ++j) { totp[i][j] = pk4(tot[i][j]); acc[i][j] = (f32x4){0.f, 0.f, 0.f, 0.f}; }
    const char* brA = (const char*)(ws + O_BR8) + ((size_t)nb * NTOK + m0) * 512;
    const char* brB = Wb + ((size_t)nb * 1024 + n0) * 512;
    gemm_bytes<true, NJ, 2, true>(H8 + (size_t)m0 * 1024, 1024, W8 + ((size_t)nb * 1024 + n0) * 1024, 1024, 1024, acc, lds, par, primed, brA, 512, brB, 512);
#pragma unroll
    for (int i = 0; i < 4; ++i)
#pragma unroll
      for (int j = 0; j < NJ; ++j) {
        unsigned q = 0;
#pragma unroll
        for (int e = 0; e < 4; ++e) {
          const unsigned qe = (unsigned)fmaxf(sigm_f(acc[i][j][e] * 0.03125f) * 255.f + 0.5f, 1.f);
          q |= qe << (8 * e);
          tot[i][j][e] = (e == 0 ? bflo(totp[i][j].x) : e == 1 ? bfhi(totp[i][j].x) : e == 2 ? bflo(totp[i][j].y) : bfhi(totp[i][j].y)) * __builtin_amdgcn_rcpf((float)qe * (1.f / 255.f));
        }
        sg[i][j] = q;
      }
    const char *nA = nullptr, *nB = nullptr;
    if (nb < 2) { nA = H8 + (size_t)m0 * 1024; nB = W8 + ((size_t)(nb + 1) * 1024 + n0) * 1024; }
    else if (ntile >= 0) { nA = H8 + (size_t)(((ntile / (32 * NT)) * 32 + (ntile % 32)) * 128) * 1024; nB = W8 + (size_t)(((ntile % (32 * NT)) / 32) * BN) * 1024; }
    gemm_bytes<true, NJ, 2, true>(brA, 512, brB, 512, 512, tot, lds, par, true, nA, 1024, nB, 1024);
    primed = nA != nullptr;
#pragma unroll
    for (int i = 0; i < 4; ++i)
#pragma unroll
      for (int j = 0; j < NJ; ++j) {
        tot[i][j][0] *= (float)(sg[i][j] & 0xffu) * (1.f / 255.f); tot[i][j][1] *= (float)((sg[i][j] >> 8) & 0xffu) * (1.f / 255.f);
        tot[i][j][2] *= (float)((sg[i][j] >> 16) & 0xffu) * (1.f / 255.f); tot[i][j][3] *= (float)(sg[i][j] >> 24) * (1.f / 255.f);
      }
  }
  unsigned char* MG = (unsigned char*)(ws + O_UT);
#pragma unroll
  for (int i = 0; i < 4; ++i) {
    const int tok = m0 + wm * 64 + i * 16 + fr;
#pragma unroll
    for (int j = 0; j < NJ; ++j) *(unsigned*)(MG + (size_t)tok * 1024 + n0 + wn * (NJ * 16) + j * 16 + fq * 4) = pk4f8(tot[i][j][0] * (1.f / 256.f), tot[i][j][1] * (1.f / 256.f), tot[i][j][2] * (1.f / 256.f), tot[i][j][3] * (1.f / 256.f));
  }
}

__device__ __forceinline__ void s7_tile(const Params& p, int l, int tile, const float* xp, const float* xs, char* lds) {
  const int tid = tidx(), lane = tid & 63, wid = tid >> 6, wm = wid >> 1, wn = wid & 1, fr = lane & 15, fq = lane >> 4;
  const int m = (tile / 512) * 32 + (tile % 32), nt = (tile % 512) / 32, m0 = m * 128, n0 = nt * 64;
  char* ws = wsp(p.ws);
  f32x4 acc[4][2];
#pragma unroll
  for (int i = 0; i < 4; ++i) { acc[i][0] = (f32x4){0.f, 0.f, 0.f, 0.f}; acc[i][1] = (f32x4){0.f, 0.f, 0.f, 0.f}; }
  { int par = 0; gemm_bytes<true, 2, 1, true>((const char*)(ws + O_UT) + (size_t)m0 * 1024, 1024, (const char*)(ws + O_WO) + ((size_t)l * 1024 + n0) * 1024, 1024, 1024, acc, lds, par, false, nullptr, 0, nullptr, 0); }
#pragma unroll
  for (int i = 0; i < 4; ++i) {
    const int tok = m0 + wm * 64 + i * 16 + fr;
    const float* src = tok < NPR ? xp + (size_t)tok * 1024 : xs + (size_t)(tok - NPR) * 1024;
    const int v = tok < NPR ? 0 : 1 + ((tok - NPR) >> 10);
    const float* gate = (const float*)(ws + O_MOD) + (l * 5 + v) * 3072 + 2048;
#pragma unroll
    for (int j = 0; j < 2; ++j) {
      const int col = n0 + wn * 32 + j * 16 + fq * 4;
      const f32x4 x = __builtin_nontemporal_load((const f32x4*)(src + col)), gt = *(const f32x4*)(gate + col);
      f32x4 y;
#pragma unroll
      for (int e = 0; e < 4; ++e) y[e] = x[e] + gt[e] * (acc[i][j][e] * 0.03125f);
      *(f32x4*)(p.out + (size_t)tok * 1024 + col) = y;
    }
  }
}

constexpr int NPHASE = 16;
__device__ __forceinline__ int q_issue(unsigned* ctr) {
  int v = 0;
  if (threadIdx.x == 0) v = (int)__hip_atomic_fetch_add(ctr, 1u, __ATOMIC_RELAXED, __HIP_MEMORY_SCOPE_AGENT);
  return v;
}
__device__ __forceinline__ int q_bcast(int v, char* lds) {
  __syncthreads();
  if (threadIdx.x == 0) *(volatile int*)lds = v;
  __syncthreads();
  const int it = *(volatile int*)lds;
  __syncthreads();
  return it;
}
__device__ __forceinline__ void run_phase(const Params& p, int ph, char* lds, unsigned* qctr) {
  const int bid = blockIdx.x, nb = gridDim.x;
  if (ph == 0) { for (int i = bid; i < P0_N; i += nb) phase0_item(p, i, lds); return; }
  if (ph == 15) { for (int i = bid; i < 512; i += nb) final_item(p, i); return; }
  const int l = (ph - 1) / 7, s = (ph - 1) % 7;
  const float* xp = l == 0 ? p.x_prompt : p.out;
  const float* xs = l == 0 ? p.x_sample : p.out + (size_t)NPR * 1024;
  switch (s) {
    case 0: for (int i = bid; i < 512; i += nb) norm_item(p, l, i, xp, xs); break;
    case 1: for (int i = bid; i < 2880; i += nb) s2_tile(p, l, i, lds); break;
    case 2:
      for (int i = bid; i < 2752;) {
        if (i < 128) attn_item<1>(p, l, i, lds);
        else if (i < 1024) keyprep_item(p, l, i - 128);
        else if (i < 1280) attn_item<1>(p, l, 128 + (i - 1024), lds);
        else if (i < 1408) state_item(p, l, i - 1280);
        else if (i < 1984) qup_tile(p, l, i - 1408, lds);
        else f1_tile(p, i - 1984, lds);
        i = nb + q_bcast(q_issue(qctr + ph), lds);
      }
      break;
    case 3:
      for (int i = bid; i < 1408;) {
        if (i < 256) f2_tile<2>(p, i, lds);
        else if (i < 512) f2_tile<4>(p, i - 256, lds);
        else kvup_tile(p, l, i - 512, lds);
        i = nb + q_bcast(q_issue(qctr + ph), lds);
      }
      break;
    case 4:
      for (int i = bid; i < 768;) {
        attn_item<0>(p, l, i, lds);
        i = nb + q_bcast(q_issue(qctr + ph), lds);
      }
      break;
    case 5: { int par = 0; bool primed = false; for (int i = bid; i < 768; i += nb) s6_tile<4>(p, l, i, (i + nb < 768) ? i + nb : -1, lds, par, primed); } break;
    case 6: for (int i = bid; i < 1536; i += nb) s7_tile(p, l, i, xp, xs, lds); break;
  }
}

#define XB_TMO      128
#define XB_XCNT(j)  (256  + 64 * (j))
#define XB_XSUB(j)  (1280 + 64 * (j))
#define XB_XGEN(j)  (2304 + 64 * (j))
#define XB_TOP      3328
#define XB_TOPGEN   3392
#define XCD_BAR_WORDS 3456
#define XB_SPIN_CAP (1u << 18)
__device__ __forceinline__ unsigned xb_ld(unsigned* p)              { return __hip_atomic_load(p, __ATOMIC_RELAXED, __HIP_MEMORY_SCOPE_AGENT); }
__device__ __forceinline__ unsigned xb_add(unsigned* p, unsigned v) { return __hip_atomic_fetch_add(p, v, __ATOMIC_RELAXED, __HIP_MEMORY_SCOPE_AGENT); }
__device__ __forceinline__ unsigned xb_xcc_id() { return (unsigned)__builtin_amdgcn_s_getreg((3 << 11) | 20) & 0xFu; }
#define XB_SPIN(cond, bar) do { unsigned _sp = 0; while (cond) { __builtin_amdgcn_s_sleep(1); \
    if ((++_sp & 255u) == 0u) { if (xb_ld(&(bar)[XB_TMO])) break; if (_sp > XB_SPIN_CAP) { atomicAdd(&(bar)[XB_TMO], 1u); break; } } } } while (0)
__device__ __forceinline__ void xcd_barrier_complete(unsigned* bar, unsigned x, unsigned& nloc, unsigned& nx) {
  const unsigned G = gridDim.x;
  unsigned sum, cnt, mine, sp = 0u;
  for (;;) {
    sum = 0u; cnt = 0u; mine = 0u;
#pragma unroll
    for (unsigned j = 0; j < 16; ++j) { const unsigned c = xb_ld(&bar[XB_XCNT(j)]); sum += c; cnt += (c > 0u) ? 1u : 0u; mine = (j == x) ? c : mine; }
    if (sum == G) break;
    __builtin_amdgcn_s_sleep(1);
    if ((++sp & 255u) == 0u) { if (xb_ld(&bar[XB_TMO])) break; if (sp > XB_SPIN_CAP) { atomicAdd(&bar[XB_TMO], 1u); break; } }
  }
  nloc = mine > 0u ? mine : 1u; nx = cnt > 0u ? cnt : 1u;
}
__device__ __forceinline__ void xcd_barrier(unsigned* bar, unsigned x, unsigned& nloc, unsigned& nx) {
  asm volatile("s_waitcnt vmcnt(0)" ::: "memory");
  __syncthreads();
  if (threadIdx.x == 0) {
    __builtin_amdgcn_s_waitcnt(0);
    if (nloc == 0u) xcd_barrier_complete(bar, x, nloc, nx);
    const unsigned old = xb_add(&bar[XB_XSUB(x)], 1u);
    const unsigned gen = old / nloc;
    if (old + 1u == (gen + 1u) * nloc) {
      __builtin_amdgcn_fence(__ATOMIC_RELEASE, "agent");
      asm volatile("s_waitcnt vmcnt(0)" ::: "memory");
      const unsigned og = xb_add(&bar[XB_TOP], 1u);
      const unsigned tg = og / nx;
      if (og + 1u == (tg + 1u) * nx) xb_add(&bar[XB_TOPGEN], 1u);
      else XB_SPIN(xb_ld(&bar[XB_TOPGEN]) == tg, bar);
      __builtin_amdgcn_fence(__ATOMIC_ACQUIRE, "agent");
      xb_add(&bar[XB_XGEN(x)], 1u);
      asm volatile("s_waitcnt vmcnt(0)" ::: "memory");
    } else {
      XB_SPIN(xb_ld(&bar[XB_XGEN(x)]) == gen, bar);
      __builtin_amdgcn_fence(__ATOMIC_ACQUIRE, "agent");
      asm volatile("s_waitcnt vmcnt(0)" ::: "memory");
    }
  }
  __syncthreads();
}

__global__ void __launch_bounds__(256, 2) mk_fwd(Params p) {
  __shared__ __attribute__((aligned(16))) char lds[LDS_TOTAL];
  cg::grid_group grid = cg::this_grid();
  unsigned* bar = (unsigned*)(p.ws + O_BAR);
  const unsigned xcc = xb_xcc_id();
  if (threadIdx.x == 0) (void)xb_add(&bar[XB_XCNT(xcc)], 1u);
  unsigned nloc = 0u, nx = 0u;
  if (gridDim.x == 0x7fffffffu) grid.sync();
#pragma unroll 1
  for (int ph = 0; ph < NPHASE; ++ph) {
    run_phase(p, ph, lds, bar);
    if (ph + 1 < NPHASE) xcd_barrier(bar, xcc, nloc, nx);
  }
}

extern "C" void kernel_launch(void* const* d_in, const int* in_sizes, int n_in, void* d_out, int out_size, void* d_ws, size_t ws_size,
                              hipStream_t stream) {
  Params p{};
  p.x_prompt = (const float*)d_in[0]; p.x_sample = (const float*)d_in[1]; p.cache_ckv = (const float*)d_in[2]; p.cache_krope = (const float*)d_in[3];
  p.state_ret = (const float*)d_in[4]; p.c = (const float*)d_in[5]; p.c_ctx = (const float*)d_in[6]; p.norm_g = (const float*)d_in[7];
  p.w_mod = (const float*)d_in[8]; p.b_mod = (const float*)d_in[9]; p.w_in = (const float*)d_in[10]; p.ret_logit = (const float*)d_in[11];
  p.q_norm_g = (const float*)d_in[12]; p.w_q_up = (const float*)d_in[13]; p.kv_norm_g = (const float*)d_in[14]; p.w_kv_up = (const float*)d_in[15];
  p.w_branch = (const float*)d_in[16]; p.w_out = (const float*)d_in[17]; p.final_g = (const float*)d_in[18];
  p.out = (float*)d_out; p.ws = (char*)d_ws;
#if ONE_LAUNCH
  static int grid_blocks = 0;
  if (!grid_blocks) {
    int dev = 0, cus = 0, per_cu = 0;
    hipGetDevice(&dev);
    hipDeviceGetAttribute(&cus, hipDeviceAttributeMultiprocessorCount, dev);
    hipOccupancyMaxActiveBlocksPerMultiprocessor(&per_cu, mk_fwd, 256, 0);
    if (per_cu > 2) per_cu = 2;
    grid_blocks = cus * per_cu;
  }
  hipMemsetAsync((char*)d_ws + O_BAR, 0, XCD_BAR_WORDS * 4, stream);
  void* args[] = {&p};
  hipError_t e = hipLaunchCooperativeKernel((void*)mk_fwd, dim3(grid_blocks), dim3(256), args, 0, stream);
  if (e != hipSuccess) fprintf(stderr, "cooperative launch failed: %s (grid %d)\n", hipGetErrorString(e), grid_blocks);
#endif
}
```
